# Optimizing an MI355X kernel written in HIP

```python
import jax, jax.numpy as jnp
from jax import lax
import numpy as np

D_MODEL = 1024
BATCH = 8
SEQ = 2048
DEPTH = 2

CTX_LEN = 256
GRID_W = 64
HEAD_DIM = 64
GLA_HEADS = 4
GLA_DK = 32
GLA_DV = 64
GLA_RANK = 16
GLA_TAU = 16.0
GLA_CHUNK = 64
NAT_HEADS = 4
NAT_WIN_ROWS = 8
NAT_WIN_COLS = 16
SWA_Q_HEADS = 8
SWA_KV_HEADS = 2
SWA_WINDOW = 128
SWA_BLOCK = SWA_WINDOW
ROPE_BASE = 10000.0
N_EXPERTS = 16
EXPERT_FF = 1024
CAPACITY_FACTOR = 2
NORM_EPS = 1e-6

GLA_WIDTH = GLA_HEADS * GLA_DV
NAT_WIDTH = NAT_HEADS * HEAD_DIM
SWA_WIDTH = SWA_Q_HEADS * HEAD_DIM
MIX_WIDTH = GLA_WIDTH + NAT_WIDTH + SWA_WIDTH
KV_WIDTHS = (GLA_HEADS * GLA_DK, GLA_WIDTH, GLA_RANK, GLA_RANK, NAT_WIDTH, NAT_WIDTH, SWA_KV_HEADS * HEAD_DIM, SWA_KV_HEADS * HEAD_DIM)
Q_WIDTHS = (GLA_HEADS * GLA_DK, GLA_WIDTH, NAT_WIDTH, SWA_WIDTH)
KV_WIDTH = sum(KV_WIDTHS)
IN_WIDTH = KV_WIDTH + sum(Q_WIDTHS)

kernel_name = 'hybrid_dit_gla_natten_swa_ecmoe'


def _split(a, widths):
    idx = np.cumsum(widths)[:-1].tolist()
    return jnp.split(a, idx, axis=-1)


def _heads(a, n):
    return a.reshape(a.shape[0], a.shape[1], n, -1)


def _flip(a):
    return jnp.flip(a, axis=1)


def rms_norm(x, gain):
    xf = x.astype(jnp.float32)
    y = xf * lax.rsqrt(jnp.mean(xf * xf, axis=-1, keepdims=True) + NORM_EPS)
    return (y * gain.astype(jnp.float32)).astype(x.dtype)


def modulate(x, shift, scale):
    return x * (1 + scale) + shift


def _rope_axis(x, pos):
    half = x.shape[-1] // 2
    freqs = ROPE_BASE ** (-jnp.arange(half, dtype=jnp.float32) / half)
    ang = pos.astype(jnp.float32)[:, None] * freqs
    cos = jnp.cos(ang)[:, None, :]
    sin = jnp.sin(ang)[:, None, :]
    xf = x.astype(jnp.float32)
    x1, x2 = xf[..., :half], xf[..., half:]
    return jnp.concatenate([x1 * cos - x2 * sin, x2 * cos + x1 * sin], axis=-1).astype(x.dtype)


def axial_rope(x):
    t = jnp.arange(x.shape[1])
    half = x.shape[-1] // 2
    return jnp.concatenate([_rope_axis(x[..., :half], t // GRID_W), _rope_axis(x[..., half:], t % GRID_W)], axis=-1)


def gla_log_decay(a_low, w_up, b_up):
    z = (a_low @ w_up + b_up).astype(jnp.float32)
    la = jax.nn.log_sigmoid(z) / GLA_TAU
    return la.reshape(la.shape[0], la.shape[1], GLA_HEADS, GLA_DK)


def gla_chunk_scan(q, k, v, log_a, s0):
    bsz, t, h, _ = q.shape
    nc = t // GLA_CHUNK

    def to_chunks(a):
        return a.reshape(bsz, nc, GLA_CHUNK, *a.shape[2:]).swapaxes(0, 1)

    causal = jnp.tril(jnp.ones((GLA_CHUNK, GLA_CHUNK), dtype=bool))[None, :, :, None, None]

    def step(state, inp):
        qc, kc, vc, lc = inp
        cum = jnp.cumsum(lc, axis=1)
        inter = jnp.einsum('bchk,bhkv->bchv', qc * jnp.exp(cum), state)
        diff = jnp.where(causal, cum[:, :, None] - cum[:, None, :], -jnp.inf)
        scores = jnp.einsum('bihk,bjhk,bijhk->bhij', qc, kc, jnp.exp(diff))
        intra = jnp.einsum('bhij,bjhv->bihv', scores, vc)
        last = cum[:, -1]
        state = jnp.exp(last)[..., None] * state + jnp.einsum('bjhk,bjhv->bhkv', kc * jnp.exp(last[:, None] - cum), vc)
        return state, inter + intra

    s_fin, o = lax.scan(step, s0, (to_chunks(q), to_chunks(k), to_chunks(v), to_chunks(log_a)))
    return o.swapaxes(0, 1).reshape(bsz, t, h, v.shape[-1]), s_fin


def gla_bidir(q, k, v, la_f, la_b, s0_f, s0_b):
    o_f, s_f = gla_chunk_scan(q, k, v, la_f, s0_f)
    o_b, s_b = gla_chunk_scan(_flip(q), _flip(k), _flip(v), _flip(la_b), s0_b)
    return o_f + _flip(o_b), s_f, s_b


def gla_final_state(k, v, log_a):
    cum = jnp.cumsum(log_a, axis=1)
    return jnp.einsum('bthk,bthv->bhkv', k * jnp.exp(cum[:, -1:] - cum), v)


def gla_group_out(o, gate, gain, dtype):
    o = rms_norm(o, gain)
    return (o.reshape(o.shape[0], o.shape[1], -1) * jax.nn.silu(gate.astype(jnp.float32))).astype(dtype)


def neighborhood_attention(q, k, v, k_ctx, v_ctx, rpb):
    bsz, s, h, d = q.shape
    rows = s // GRID_W
    wr = min(NAT_WIN_ROWS, rows)
    n_loc = wr * NAT_WIN_COLS
    qg = q.reshape(bsz, rows, GRID_W, h, d)
    kg = k.reshape(bsz, rows, GRID_W, h, d)
    vg = v.reshape(bsz, rows, GRID_W, h, d)
    cols = jnp.arange(GRID_W)
    col_start = jnp.clip(cols - NAT_WIN_COLS // 2, 0, GRID_W - NAT_WIN_COLS)
    col_idx = col_start[:, None] + jnp.arange(NAT_WIN_COLS)
    col_bias_idx = col_idx - cols[:, None] + NAT_WIN_COLS - 1
    scale = d ** -0.5

    def row_block(r):
        r_start = jnp.clip(r - wr // 2, 0, rows - wr)
        q_r = lax.dynamic_index_in_dim(qg, r, axis=1, keepdims=False)
        k_nb = lax.dynamic_slice_in_dim(kg, r_start, wr, axis=1)[:, :, col_idx]
        v_nb = lax.dynamic_slice_in_dim(vg, r_start, wr, axis=1)[:, :, col_idx]
        s_loc = jnp.einsum('bchd,brckhd->bhcrk', q_r, k_nb).astype(jnp.float32) * scale
        row_bias_idx = r_start + jnp.arange(wr) - r + NAT_WIN_ROWS - 1
        bias = rpb[:, row_bias_idx][:, :, col_bias_idx]
        s_loc = s_loc + bias.transpose(0, 2, 1, 3).astype(jnp.float32)[None]
        s_ctx = jnp.einsum('bchd,bmhd->bhcm', q_r, k_ctx).astype(jnp.float32) * scale
        logits = jnp.concatenate([s_loc.reshape(bsz, h, GRID_W, n_loc), s_ctx], axis=-1)
        p = jax.nn.softmax(logits, axis=-1).astype(v.dtype)
        p_loc = p[..., :n_loc].reshape(bsz, h, GRID_W, wr, NAT_WIN_COLS)
        return (jnp.einsum('bhcrk,brckhd->bchd', p_loc, v_nb)
                + jnp.einsum('bhcm,bmhd->bchd', p[..., n_loc:], v_ctx))

    out = lax.map(row_block, jnp.arange(rows))
    return out.transpose(1, 0, 2, 3, 4).reshape(bsz, s, h * d)


def sliding_window_attention(q, k, v, k_ctx, v_ctx, sink):
    bsz, s, hq, d = q.shape
    hkv = k.shape[2]
    g = hq // hkv
    nb = s // SWA_BLOCK
    n_loc = 3 * SWA_BLOCK
    m = k_ctx.shape[1]
    scale = d ** -0.5
    qb = q.reshape(bsz, nb, SWA_BLOCK, hkv, g, d)

    def band(a):
        ap = jnp.pad(a, ((0, 0), (SWA_BLOCK, SWA_BLOCK), (0, 0), (0, 0)))
        ab = ap.reshape(bsz, nb + 2, SWA_BLOCK, hkv, d)
        return jnp.concatenate([ab[:, :-2], ab[:, 1:-1], ab[:, 2:]], axis=2)

    kb, vb = band(k), band(v)
    blk = jnp.arange(nb)[:, None] * SWA_BLOCK
    q_pos = (blk + jnp.arange(SWA_BLOCK))[:, :, None]
    k_pos = (blk - SWA_BLOCK + jnp.arange(n_loc))[:, None, :]
    valid = (jnp.abs(k_pos - q_pos) <= SWA_WINDOW) & (k_pos >= 0) & (k_pos < s)
    s_loc = jnp.einsum('bnqhgd,bnkhd->bnhgqk', qb, kb).astype(jnp.float32) * scale
    s_loc = jnp.where(valid[None, :, None, None], s_loc, -jnp.inf)
    s_ctx = jnp.einsum('bnqhgd,bmhd->bnhgqm', qb, k_ctx).astype(jnp.float32) * scale
    sink_col = jnp.broadcast_to(sink.astype(jnp.float32).reshape(1, 1, hkv, g, 1, 1), (bsz, nb, hkv, g, SWA_BLOCK, 1))
    p = jax.nn.softmax(jnp.concatenate([s_loc, s_ctx, sink_col], axis=-1), axis=-1).astype(v.dtype)
    out = (jnp.einsum('bnhgqk,bnkhd->bnqhgd', p[..., :n_loc], vb)
           + jnp.einsum('bnhgqm,bmhd->bnqhgd', p[..., n_loc:n_loc + m], v_ctx))
    return out.reshape(bsz, s, hq * d)


def dense_ctx_attention(q, k, v, sink):
    bsz, m, hq, d = q.shape
    hkv = k.shape[2]
    g = hq // hkv
    n_keys = k.shape[1]
    qg = q.reshape(bsz, m, hkv, g, d)
    logits = jnp.einsum('bqhgd,bkhd->bhgqk', qg, k).astype(jnp.float32) * d ** -0.5
    if sink is not None:
        sink_col = jnp.broadcast_to(sink.astype(jnp.float32).reshape(1, hkv, g, 1, 1), (bsz, hkv, g, m, 1))
        logits = jnp.concatenate([logits, sink_col], axis=-1)
    p = jax.nn.softmax(logits, axis=-1)[..., :n_keys].astype(v.dtype)
    return jnp.einsum('bhgqk,bkhd->bqhgd', p, v).reshape(bsz, m, hq * d)


def token_mixers(h, hc, w_in, a_up, a_bias, gla_gain, rpb, sink, update_ctx):
    f32 = jnp.float32
    bsz = h.shape[0]
    (gk, gv, gaf, gab, nk, nv, sk, sv, gq, gg, nq, sq) = _split(h @ w_in, KV_WIDTHS + Q_WIDTHS)
    if update_ctx:
        (cgk, cgv, cgaf, cgab, cnk, cnv, csk, csv, cgq, cgg, cnq, csq) = _split(hc @ w_in, KV_WIDTHS + Q_WIDTHS)
    else:
        (cgk, cgv, cgaf, cgab, cnk, cnv, csk, csv) = _split(hc @ w_in[:, :KV_WIDTH], KV_WIDTHS)

    ck = _heads(cgk, GLA_HEADS).astype(f32)
    cv = _heads(cgv, GLA_HEADS).astype(f32)
    cla_f = gla_log_decay(cgaf, a_up[0], a_bias[0])
    cla_b = gla_log_decay(cgab, a_up[1], a_bias[1])
    if update_ctx:
        cq = _heads(cgq, GLA_HEADS).astype(f32) * GLA_DK ** -0.5
        zero = jnp.zeros((bsz, GLA_HEADS, GLA_DK, GLA_DV), f32)
        co, s_f, s_b = gla_bidir(cq, ck, cv, cla_f, cla_b, zero, zero)
    else:
        s_f = gla_final_state(ck, cv, cla_f)
        s_b = gla_final_state(_flip(ck), _flip(cv), _flip(cla_b))
    q = _heads(gq, GLA_HEADS).astype(f32) * GLA_DK ** -0.5
    k = _heads(gk, GLA_HEADS).astype(f32)
    v = _heads(gv, GLA_HEADS).astype(f32)
    la_f = gla_log_decay(gaf, a_up[0], a_bias[0])
    la_b = gla_log_decay(gab, a_up[1], a_bias[1])
    o, _, _ = gla_bidir(q, k, v, la_f, la_b, s_f, s_b)
    gla_lat = gla_group_out(o, gg, gla_gain, h.dtype)

    nk_c, nv_c = _heads(cnk, NAT_HEADS), _heads(cnv, NAT_HEADS)
    nat_lat = neighborhood_attention(_heads(nq, NAT_HEADS), _heads(nk, NAT_HEADS), _heads(nv, NAT_HEADS), nk_c, nv_c, rpb)

    sk_c, sv_c = _heads(csk, SWA_KV_HEADS), _heads(csv, SWA_KV_HEADS)
    swa_lat = sliding_window_attention(axial_rope(_heads(sq, SWA_Q_HEADS)), axial_rope(_heads(sk, SWA_KV_HEADS)),
                                       _heads(sv, SWA_KV_HEADS), sk_c, sv_c, sink)

    lat = jnp.concatenate([gla_lat, nat_lat, swa_lat], axis=-1)
    if not update_ctx:
        return lat, None
    ctx_out = jnp.concatenate([
        gla_group_out(co, cgg, gla_gain, hc.dtype),
        dense_ctx_attention(_heads(cnq, NAT_HEADS), nk_c, nv_c, None),
        dense_ctx_attention(_heads(csq, SWA_Q_HEADS), sk_c, sv_c, sink),
    ], axis=-1)
    return lat, ctx_out


def expert_choice_ffn(h, w_router, w_gate, w_up, w_down):
    bsz, n, _ = h.shape
    cap = CAPACITY_FACTOR * n // N_EXPERTS
    aff = jax.nn.softmax(jnp.einsum('bnd,de->bne', h, w_router).astype(jnp.float32), axis=-1)
    g, idx = lax.top_k(aff.transpose(0, 2, 1), cap)
    bidx = jnp.arange(bsz)[:, None, None]
    xs = h[bidx, idx]
    hid = jax.nn.silu(jnp.einsum('becd,edf->becf', xs, w_gate)) * jnp.einsum('becd,edf->becf', xs, w_up)
    y = jnp.einsum('becf,efd->becd', hid, w_down) * g[..., None].astype(h.dtype)
    return jnp.zeros_like(h).at[bidx, idx].add(y)


def setup_inputs(seed: int = 0) -> dict:
    key = jax.random.key(seed)
    ks = jax.random.split(key, 18)

    def nrm(k, shape, scale):
        return jax.random.normal(k, shape, jnp.float32) * scale

    return {
        'x': nrm(ks[0], (BATCH, SEQ, D_MODEL), 1.0),
        'c': nrm(ks[1], (BATCH, D_MODEL), 1.0),
        'ctx': nrm(ks[2], (BATCH, CTX_LEN, D_MODEL), 1.0),
        'c_ctx': nrm(ks[3], (D_MODEL,), 1.0),
        'w_mod': nrm(ks[4], (DEPTH, D_MODEL, 6 * D_MODEL), 0.5 * D_MODEL ** -0.5),
        'b_mod': nrm(ks[5], (DEPTH, 6 * D_MODEL), 0.02),
        'norm_gains': 1.0 + nrm(ks[6], (DEPTH, 4, D_MODEL), 0.05),
        'w_in': nrm(ks[7], (DEPTH, D_MODEL, IN_WIDTH), D_MODEL ** -0.5),
        'w_out': nrm(ks[8], (DEPTH, MIX_WIDTH, D_MODEL), MIX_WIDTH ** -0.5),
        'gla_a_up': nrm(ks[9], (DEPTH, 2, GLA_RANK, GLA_HEADS * GLA_DK), GLA_RANK ** -0.5),
        'gla_a_bias': 1.0 + nrm(ks[10], (DEPTH, 2, GLA_HEADS * GLA_DK), 0.5),
        'gla_norm': 1.0 + nrm(ks[11], (DEPTH, GLA_DV), 0.05),
        'nat_rpb': nrm(ks[12], (DEPTH, NAT_HEADS, 2 * NAT_WIN_ROWS - 1, 2 * NAT_WIN_COLS - 1), 0.02),
        'swa_sink': nrm(ks[13], (DEPTH, SWA_Q_HEADS), 0.5),
        'w_router': nrm(ks[14], (DEPTH, D_MODEL, N_EXPERTS), D_MODEL ** -0.5),
        'w_gate': nrm(ks[15], (DEPTH, N_EXPERTS, D_MODEL, EXPERT_FF), D_MODEL ** -0.5),
        'w_up': nrm(ks[16], (DEPTH, N_EXPERTS, D_MODEL, EXPERT_FF), D_MODEL ** -0.5),
        'w_down': nrm(ks[17], (DEPTH, N_EXPERTS, EXPERT_FF, D_MODEL), EXPERT_FF ** -0.5),
    }


def reference(x, c, ctx, c_ctx, w_mod, b_mod, norm_gains, w_in, w_out, gla_a_up, gla_a_bias, gla_norm,
              nat_rpb, swa_sink, w_router, w_gate, w_up, w_down):
    xc = ctx
    for l in range(DEPTH):
        update_ctx = l < DEPTH - 1
        mod = jax.nn.silu(c) @ w_mod[l] + b_mod[l]
        mod_c = jax.nn.silu(c_ctx) @ w_mod[l] + b_mod[l]
        sh_a, sc_a, gt_a, sh_f, sc_f, gt_f = jnp.split(mod[:, None, :], 6, axis=-1)
        csh_a, csc_a, cgt_a, csh_f, csc_f, cgt_f = jnp.split(mod_c, 6, axis=-1)
        g_pre_a, g_post_a, g_pre_f, g_post_f = norm_gains[l]

        h = modulate(rms_norm(x, g_pre_a), sh_a, sc_a)
        hc = modulate(rms_norm(xc, g_pre_a), csh_a, csc_a)
        mix, mix_c = token_mixers(h, hc, w_in[l], gla_a_up[l], gla_a_bias[l], gla_norm[l], nat_rpb[l], swa_sink[l], update_ctx)
        x = x + gt_a * rms_norm(mix @ w_out[l], g_post_a)
        if update_ctx:
            xc = xc + cgt_a * rms_norm(mix_c @ w_out[l], g_post_a)

        h = modulate(rms_norm(x, g_pre_f), sh_f, sc_f)
        x = x + gt_f * rms_norm(expert_choice_ffn(h, w_router[l], w_gate[l], w_up[l], w_down[l]), g_post_f)
        if update_ctx:
            hc = modulate(rms_norm(xc, g_pre_f), csh_f, csc_f)
            xc = xc + cgt_f * rms_norm(expert_choice_ffn(hc, w_router[l], w_gate[l], w_up[l], w_down[l]), g_post_f)
    return x
```

```cpp
#include <hip/hip_runtime.h>
#include <cstdio>
#include <cstdint>
#include <cmath>

namespace pg8 {
#define PG8_LAS __attribute__((address_space(3)))
typedef unsigned short bf16_t;
typedef short bf16x8 __attribute__((ext_vector_type(8)));
typedef float f32x4 __attribute__((ext_vector_type(4)));
typedef unsigned u32x4 __attribute__((ext_vector_type(4)));
constexpr int BM = 256, BK = 64, HALF = 128, HTB = HALF * BK * 2  , STAGE_BYTES = 8 * HTB, NXCD = 8, WGM = 8;

__host__ __device__ __forceinline__ int lds_byte(int r, int c) { const int st = (r >> 4) * 2 + (c >> 5), rr = r & 15, cc = c & 31, ob = rr * 64 + cc * 2; return st * 1024 + (ob ^ (((ob >> 9) & 1) << 5)); }
__host__ __device__ __forceinline__ void stage_rc(int b, int& R, int& C) { const int st = b / 1024, sb = b % 1024, swz = sb ^ (((sb >> 9) & 1) << 5); R = (st >> 1) * 16 + swz / 64; C = (st & 1) * 32 + (swz % 64) / 2; }
__host__ __device__ __forceinline__ int perm32(int rho) { const int n = rho >> 4, i = rho & 15; return 8 * (i >> 2) + 4 * n + (i & 3); }

struct Unit { int pm, pn, pb; };
struct Gemm { const bf16_t* A; const bf16_t* Bt; int M, N, K; };

struct StaticOrder {
    int nM, nN, nwg, G, c;
    __host__ __device__ void init(int M, int N, int G_, int c_) { nM = M / BM; nN = N / BM; nwg = nM * nN; G = G_; c = c_; }
    __host__ __device__ bool next(int i, Unit& u) const {
        const long L = (long)i * G + c; if (L >= nwg) return false;
        int wgid = (int)L; { const int q = nwg / NXCD, r = nwg % NXCD, xcd = wgid % NXCD, off = wgid / NXCD; wgid = (xcd < r ? xcd * (q + 1) : r * (q + 1) + (xcd - r) * q) + off; }
        const int nig = WGM * nN, gid = wgid / nig, fm = gid * WGM, gsz = (nM - fm) < WGM ? (nM - fm) : WGM;
        u.pm = fm + ((wgid % nig) % gsz); u.pn = (wgid % nig) / gsz; u.pb = u.pn; return true;
    }
    __device__ __forceinline__ void a_ready(const Unit&) const {}
    __device__ __forceinline__ void done(const Unit&) const {}
};

__device__ __forceinline__ unsigned cvt_pk_bf16(float lo, float hi) { unsigned r; asm volatile("v_cvt_pk_bf16_f32 %0, %1, %2" : "=v"(r) : "v"(lo), "v"(hi)); return r; }
typedef float f32x2 __attribute__((ext_vector_type(2)));
struct EpiStore {
    static constexpr bool PERM = true, AFTER_DRAIN = false;
    bf16_t* O; int ldc;
    __device__ __forceinline__ void operator()(const f32x4 (&acc)[2][2][4][2], const Unit& u, int wr, int wc, int fr, int fq) const {
        const int row0 = u.pm * BM + wr * 64 + fr, col0 = u.pn * BM + wc * 32 + 8 * fq;
#pragma unroll
        for (int ai = 0; ai < 2; ++ai)
#pragma unroll
            for (int m = 0; m < 4; ++m) { bf16_t* rowp = O + (size_t)(row0 + ai * HALF + m * 16) * ldc + col0;
#pragma unroll
                for (int bj = 0; bj < 2; ++bj) { const f32x4 v0 = acc[ai][bj][m][0], v1 = acc[ai][bj][m][1];
                    u32x4 w; w.x = cvt_pk_bf16(v0[0], v0[1]); w.y = cvt_pk_bf16(v0[2], v0[3]); w.z = cvt_pk_bf16(v1[0], v1[1]); w.w = cvt_pk_bf16(v1[2], v1[3]);
                    *(u32x4*)(rowp + bj * HALF) = w; } }
    }
};
struct EpiProj {
    static constexpr bool PERM = true, AFTER_DRAIN = false;
    bf16_t* O; int ldc; const f32x2* tab; int ml;
    __device__ __forceinline__ void operator()(const f32x4 (&acc)[2][2][4][2], const Unit& u, int wr, int wc, int fr, int fq) const {
        const int row0 = u.pm * BM + wr * 64 + fr;
        const bool latent = (u.pm * BM) < ml;
#pragma unroll
        for (int bj = 0; bj < 2; ++bj) {
            const int c0 = u.pn * BM + bj * HALF + wc * 32;
            const bool rope = latent && ((c0 >= 928 && c0 < 1056) || (c0 >= 1824 && c0 < 2336));
            const bool rowhalf = (((c0 - 32) & 63) == 0);
#pragma unroll
            for (int ai = 0; ai < 2; ++ai)
#pragma unroll
                for (int m = 0; m < 4; ++m) {
                    const int row = row0 + ai * HALF + m * 16;
                    f32x4 v0 = acc[ai][bj][m][0], v1 = acc[ai][bj][m][1];
                    if (rope) {
                        const int t = row & 2047, pos = rowhalf ? (t >> 6) : (t & 63);
                        const f32x2* tp = tab + pos * 16 + 8 * (fq & 1);
                        const float sg = (fq < 2) ? -1.f : 1.f;
#pragma unroll
                        for (int e = 0; e < 4; ++e) {
                            const float x0 = v0[e], x1 = v1[e];
                            const float p0 = __shfl_xor(x0, 32), p1 = __shfl_xor(x1, 32);
                            const f32x2 c0s = tp[e], c1s = tp[4 + e];
                            v0[e] = x0 * c0s.x + sg * p0 * c0s.y; v1[e] = x1 * c1s.x + sg * p1 * c1s.y;
                        }
                    }
                    u32x4 w; w.x = cvt_pk_bf16(v0[0], v0[1]); w.y = cvt_pk_bf16(v0[2], v0[3]); w.z = cvt_pk_bf16(v1[0], v1[1]); w.w = cvt_pk_bf16(v1[2], v1[3]);
                    *(u32x4*)(O + (size_t)row * ldc + c0 + 8 * fq) = w;
                }
        }
    }
};
struct EpiSwiGLU {
    static constexpr bool PERM = true, AFTER_DRAIN = false;
    bf16_t* O; int ldc;
    __device__ __forceinline__ void operator()(const f32x4 (&acc)[2][2][4][2], const Unit& u, int wr, int wc, int fr, int fq) const {
        const int row0 = u.pm * BM + wr * 64 + fr, col0 = u.pn * HALF + wc * 32 + 8 * fq;
#pragma unroll
        for (int ai = 0; ai < 2; ++ai)
#pragma unroll
            for (int m = 0; m < 4; ++m) {
                float h[8];
#pragma unroll
                for (int n = 0; n < 2; ++n)
#pragma unroll
                    for (int e = 0; e < 4; ++e) { const float g = acc[ai][0][m][n][e], up = acc[ai][1][m][n][e];
                        h[n * 4 + e] = g * __builtin_amdgcn_rcpf(1.f + __builtin_amdgcn_exp2f(-1.4426950408889634f * g)) * up; }
                u32x4 w; w.x = cvt_pk_bf16(h[0], h[1]); w.y = cvt_pk_bf16(h[2], h[3]); w.z = cvt_pk_bf16(h[4], h[5]); w.w = cvt_pk_bf16(h[6], h[7]);
                *(u32x4*)(O + (size_t)(row0 + ai * HALF + m * 16) * ldc + col0) = w;
            }
    }
};
struct MoeOrder {
    int npe, nN, nwg, G, c;
    __host__ __device__ void init(int npe_, int nN_, int G_, int c_) { npe = npe_; nN = nN_; nwg = 16 * npe * nN; G = G_; c = c_; }
    __host__ __device__ bool next(int i, Unit& u) const {
        const long L = (long)i * G + c; if (L >= nwg) return false;
        int wgid = (int)L; { const int q = nwg / NXCD, r = nwg % NXCD, xcd = wgid % NXCD, off = wgid / NXCD; wgid = (xcd < r ? xcd * (q + 1) : r * (q + 1) + (xcd - r) * q) + off; }
        const int per = npe * nN, e = wgid / per, rem = wgid % per, j = rem / nN, pn = rem % nN;
        u.pm = (j < 8) ? (j * 16 + e) : (128 + e); u.pn = pn; u.pb = e * nN + pn; return true;
    }
    __device__ __forceinline__ void a_ready(const Unit&) const {}
    __device__ __forceinline__ void done(const Unit&) const {}
};

template <class Epi, class Sched, bool ALIGN_EPI = false, bool SP2 = false>
__device__ __forceinline__ void gemm_phase(PG8_LAS unsigned char* lds, const Gemm g, const Sched& S, const Epi& E) {
    int tid_ = threadIdx.x; asm volatile("" : "+v"(tid_));
    const int tid = tid_, wid = __builtin_amdgcn_readfirstlane(tid >> 6), lane = tid & 63, wr = wid >> 2, wc = wid & 3, fr = lane & 15, fq = lane >> 4;
    const int K = g.K, nt = K / BK;
    unsigned voffA[2], voffB[2];
#pragma unroll
    for (int i = 0; i < 2; ++i) { int R, C; stage_rc(tid * 16 + i * 8192, R, C); const int Rb = Epi::PERM ? ((R & ~31) + perm32(R & 31)) : R;
        voffA[i] = (unsigned)(R * K + C) * 2u; voffB[i] = (unsigned)(Rb * K + C) * 2u; }
    const size_t kstep = (size_t)(BK * 2);
    const size_t hstep = (size_t)HALF * K * 2;
    const size_t tstep = 2 * hstep;
    const unsigned ldsw = (unsigned)wid * 1024u;
    const int aoff = lds_byte(wr * 64 + fr, fq * 8), boff = lds_byte(wc * 32 + fr, fq * 8);
#define PG8_SA(b, h) (((b) * 2 + (h)) * HTB)
#define PG8_SB(b, h) ((4 + (b) * 2 + (h)) * HTB)
#define PG8_STAGE(bufoff, gbase, voff) do { _Pragma("unroll") for (int _i = 0; _i < 2; ++_i) \
        __builtin_amdgcn_global_load_lds((const unsigned*)((const char*)(gbase) + (voff)[_i]), (PG8_LAS unsigned*)(lds + (bufoff) + ldsw + _i * 8192), 16, 0, 0); } while (0)
#define PG8_LDA(dst, b, h) do { _Pragma("unroll") for (int m = 0; m < 4; ++m) _Pragma("unroll") for (int k = 0; k < 2; ++k) dst[m][k] = *(const PG8_LAS bf16x8*)(lds + PG8_SA(b, h) + aoff + m * 2048 + k * 1024); } while (0)
#define PG8_LDB(dst, b, h) do { _Pragma("unroll") for (int n = 0; n < 2; ++n) _Pragma("unroll") for (int k = 0; k < 2; ++k) dst[n][k] = *(const PG8_LAS bf16x8*)(lds + PG8_SB(b, h) + boff + n * 2048 + k * 1024); } while (0)
#define PG8_MMA(ai, bj, At, Bt) do { __builtin_amdgcn_s_setprio(1); _Pragma("unroll") for (int m = 0; m < 4; ++m) _Pragma("unroll") for (int n = 0; n < 2; ++n) _Pragma("unroll") for (int k = 0; k < 2; ++k) \
        acc[ai][bj][m][n] = __builtin_amdgcn_mfma_f32_16x16x32_bf16(Bt[n][k], At[m][k], acc[ai][bj][m][n], 0, 0, 0); __builtin_amdgcn_s_setprio(0); } while (0)
#define PG8_WAIT_V(n) asm volatile("s_waitcnt vmcnt(" #n ")" ::: "memory")
#define PG8_WAIT_L(n) asm volatile("s_waitcnt lgkmcnt(" #n ")" ::: "memory")
#define PG8_BAR __builtin_amdgcn_s_barrier()
#define PG8_SCHED __builtin_amdgcn_sched_barrier(0)
    Unit cur, nxt; int ui = 0;
    if (!S.next(0, cur)) return;
    f32x4 acc[2][2][4][2];
#pragma unroll
    for (int a = 0; a < 2; ++a)
#pragma unroll
        for (int b = 0; b < 2; ++b)
#pragma unroll
            for (int m = 0; m < 4; ++m)
#pragma unroll
                for (int n = 0; n < 2; ++n) acc[a][b][m][n] = (f32x4){0.f, 0.f, 0.f, 0.f};
    bf16x8 At[4][2], B0[2][2], B1[2][2];
    const char* cA = (const char*)g.A + (size_t)cur.pm * tstep; const char* cB = (const char*)g.Bt + (size_t)cur.pb * tstep;
    S.a_ready(cur);
    if constexpr (SP2) {
        PG8_STAGE(PG8_SB(0, 0), cB, voffB); PG8_STAGE(PG8_SB(0, 1), cB + hstep, voffB); PG8_STAGE(PG8_SA(0, 0), cA, voffA); PG8_STAGE(PG8_SA(0, 1), cA + hstep, voffA);
        if (wr == 1) PG8_BAR;
        PG8_WAIT_V(2); PG8_BAR;
        PG8_STAGE(PG8_SB(1, 0), cB + kstep, voffB); PG8_STAGE(PG8_SA(1, 0), cA + kstep, voffA); PG8_STAGE(PG8_SB(1, 1), cB + hstep + kstep, voffB);
        PG8_WAIT_V(6); PG8_BAR;
    } else {
        PG8_STAGE(PG8_SB(0, 0), cB, voffB); PG8_STAGE(PG8_SA(0, 0), cA, voffA); PG8_STAGE(PG8_SB(0, 1), cB + hstep, voffB); PG8_STAGE(PG8_SA(0, 1), cA + hstep, voffA);
        if (wr == 1) PG8_BAR;
        PG8_WAIT_V(4); PG8_BAR;
        PG8_STAGE(PG8_SB(1, 0), cB + kstep, voffB); PG8_STAGE(PG8_SA(1, 0), cA + kstep, voffA); PG8_STAGE(PG8_SB(1, 1), cB + hstep + kstep, voffB);
        PG8_WAIT_V(6); PG8_BAR;
    }
    for (;;) {
        const bool has_next = S.next(ui + 1, nxt);
        const char* nA = has_next ? (const char*)g.A + (size_t)nxt.pm * tstep : cA; const char* nB = has_next ? (const char*)g.Bt + (size_t)nxt.pb * tstep : cB;
        for (int t = 0; t < nt; t += 2) {
            const bool last = (t == nt - 2);
            const char* a1 = cA + (size_t)(t + 1) * kstep;
            const char* a2 = last ? nA : cA + (size_t)(t + 2) * kstep; const char* b2 = last ? nB : cB + (size_t)(t + 2) * kstep;
            const char* a3 = a2 + kstep; const char* b3 = b2 + kstep;
            if (last && has_next) S.a_ready(nxt);
            if constexpr (SP2) {
            PG8_LDB(B0, 0, 0); PG8_LDB(B1, 0, 1); PG8_SCHED; PG8_LDA(At, 0, 0); PG8_STAGE(PG8_SA(1, 1), a1 + hstep, voffA);
            PG8_WAIT_V(8); PG8_WAIT_L(0); PG8_BAR; PG8_MMA(0, 0, At, B0); PG8_MMA(0, 1, At, B1); PG8_BAR; PG8_SCHED;
            PG8_LDA(At, 0, 1); PG8_STAGE(PG8_SB(0, 0), b2, voffB); PG8_STAGE(PG8_SB(0, 1), b2 + hstep, voffB); PG8_STAGE(PG8_SA(0, 0), a2, voffA);
            PG8_WAIT_V(8); PG8_WAIT_L(0); PG8_BAR; PG8_MMA(1, 0, At, B0); PG8_MMA(1, 1, At, B1); PG8_BAR; PG8_SCHED;
            PG8_LDB(B0, 1, 0); PG8_LDB(B1, 1, 1); PG8_SCHED; PG8_LDA(At, 1, 0); PG8_STAGE(PG8_SA(0, 1), a2 + hstep, voffA);
            PG8_WAIT_V(8); PG8_WAIT_L(0); PG8_BAR; PG8_MMA(0, 0, At, B0); PG8_MMA(0, 1, At, B1); PG8_BAR; PG8_SCHED;
            PG8_LDA(At, 1, 1); PG8_STAGE(PG8_SB(1, 0), b3, voffB); PG8_STAGE(PG8_SB(1, 1), b3 + hstep, voffB); PG8_STAGE(PG8_SA(1, 0), a3, voffA);
            PG8_WAIT_V(8); PG8_WAIT_L(0); PG8_BAR; PG8_MMA(1, 0, At, B0); PG8_MMA(1, 1, At, B1); PG8_BAR; PG8_SCHED;
            } else {
            PG8_LDB(B0, 0, 0); PG8_SCHED; PG8_LDA(At, 0, 0); PG8_STAGE(PG8_SA(1, 1), a1 + hstep, voffA);
            PG8_WAIT_L(8); PG8_BAR; PG8_WAIT_L(0); PG8_MMA(0, 0, At, B0); PG8_BAR; PG8_SCHED;
            PG8_LDB(B1, 0, 1); PG8_STAGE(PG8_SB(0, 0), b2, voffB);
            PG8_BAR; PG8_WAIT_L(0); PG8_MMA(0, 1, At, B1); PG8_BAR;
            PG8_LDA(At, 0, 1); PG8_STAGE(PG8_SA(0, 0), a2, voffA);
            PG8_BAR; PG8_WAIT_L(0); PG8_MMA(1, 0, At, B0); PG8_BAR; PG8_SCHED;
            PG8_STAGE(PG8_SB(0, 1), b2 + hstep, voffB);
            PG8_WAIT_V(6); PG8_BAR; PG8_MMA(1, 1, At, B1); PG8_BAR;
            PG8_LDB(B0, 1, 0); PG8_SCHED; PG8_LDA(At, 1, 0); PG8_STAGE(PG8_SA(0, 1), a2 + hstep, voffA);
            PG8_WAIT_L(8); PG8_BAR; PG8_WAIT_L(0); PG8_MMA(0, 0, At, B0); PG8_BAR; PG8_SCHED;
            PG8_LDB(B1, 1, 1); PG8_STAGE(PG8_SB(1, 0), b3, voffB);
            PG8_BAR; PG8_WAIT_L(0); PG8_MMA(0, 1, At, B1); PG8_BAR;
            PG8_LDA(At, 1, 1); PG8_STAGE(PG8_SA(1, 0), a3, voffA);
            PG8_BAR; PG8_WAIT_L(0); PG8_MMA(1, 0, At, B0); PG8_BAR; PG8_SCHED;
            PG8_STAGE(PG8_SB(1, 1), b3 + hstep, voffB);
            PG8_WAIT_V(6); PG8_BAR; PG8_MMA(1, 1, At, B1); PG8_BAR;
            }
        }
        if constexpr (ALIGN_EPI) { if (wr == 0) PG8_BAR; }
        if constexpr (!Epi::AFTER_DRAIN) { E(acc, cur, wr, wc, fr, fq); S.done(cur); }
        if (!has_next) break;
#pragma unroll
        for (int a = 0; a < 2; ++a)
#pragma unroll
            for (int b = 0; b < 2; ++b)
#pragma unroll
                for (int m = 0; m < 4; ++m)
#pragma unroll
                    for (int n = 0; n < 2; ++n) acc[a][b][m][n] = (f32x4){0.f, 0.f, 0.f, 0.f};
        cur = nxt; cA = nA; cB = nB; ++ui;
        if constexpr (ALIGN_EPI) { if (wr == 1) PG8_BAR; }
    }
    PG8_WAIT_V(0);
    if constexpr (!ALIGN_EPI) { if (wr == 0) PG8_BAR; }
    PG8_BAR;
    if constexpr (Epi::AFTER_DRAIN) { E.fused(acc, cur, wr, wc, fr, fq, lds, wid, lane); S.done(cur); }
#undef PG8_SA
#undef PG8_SB
#undef PG8_STAGE
#undef PG8_LDA
#undef PG8_LDB
#undef PG8_MMA
#undef PG8_WAIT_V
#undef PG8_WAIT_L
#undef PG8_BAR
#undef PG8_SCHED
}
}
constexpr int NB = 8, SEQ = 2048, DM = 1024, CTXL = 256, ML = NB * SEQ, MC = NB * CTXL, MT = ML + MC;
constexpr int PP = 2560;
constexpr int INW = 2336;
constexpr int C_GK = 0, C_GV = 128, C_GAF = 384, C_GAB = 400, C_NK = 416, C_NV = 672, C_SK = 928, C_SV = 1056, C_GQ = 1184, C_GG = 1312, C_NQ = 1568, C_SQ = 1824;
constexpr int NWAVES = 8;
constexpr float NEPS = 1e-6f;
constexpr float LOG2E = 1.4426950408889634f;

constexpr size_t MiB = 1u << 20;
constexpr size_t WS_CTL = 0, CTL_ZERO_BYTES = 1 * MiB;
constexpr size_t WS_TAB = 1 * MiB;
constexpr size_t WS_MOD = 1 * MiB + 65536;
constexpr size_t WS_MODP = 2 * MiB;
constexpr size_t WS_WIN = 6 * MiB;
constexpr size_t WS_WOUT = 16 * MiB;
constexpr size_t WS_WGU = 20 * MiB;
constexpr size_t WS_WD = 148 * MiB;
constexpr size_t WS_H = 212 * MiB;
constexpr size_t WS_R1 = 248 * MiB;
constexpr size_t WS_R2 = 338 * MiB;
constexpr size_t WS_XC = 410 * MiB;
constexpr size_t WS_UST = 418 * MiB;
constexpr size_t WS_MISC = 436 * MiB;
constexpr size_t WS_DEC = WS_MISC;
constexpr size_t WS_AFF = WS_MISC + 1 * MiB;
constexpr size_t WS_AFFC = WS_MISC + 2 * MiB;
constexpr size_t WS_GATE = WS_MISC + 2 * MiB + 262144;
constexpr size_t WS_GATEC = WS_MISC + 2 * MiB + 524288;
constexpr size_t WS_INV = WS_MISC + 3 * MiB;
constexpr size_t WS_END = 440 * MiB;
constexpr int CW_BAR = 4096;

constexpr int WAVE_LDS = 19456;
constexpr int RING_BYTES = NWAVES * WAVE_LDS;
constexpr int LDSCTL_OFF = RING_BYTES, MISC_OFF = LDSCTL_OFF + 320;
constexpr int LDS_BYTES = RING_BYTES + 1024;
static_assert(RING_BYTES >= pg8::STAGE_BYTES && LDS_BYTES <= 163840, "LDS map");

#define GAS __attribute__((address_space(1)))
#define LAS __attribute__((address_space(3)))
typedef unsigned short bf16_t;
typedef unsigned v4u __attribute__((ext_vector_type(4)));
typedef unsigned v2u __attribute__((ext_vector_type(2)));
typedef float f32x4 __attribute__((ext_vector_type(4)));
typedef float f32x2 __attribute__((ext_vector_type(2)));
typedef float f32x16 __attribute__((ext_vector_type(16)));
typedef short bf16x8 __attribute__((ext_vector_type(8)));
typedef short s16x4 __attribute__((ext_vector_type(4)));
typedef GAS unsigned gu32;
#define RLX_AGENT __ATOMIC_RELAXED, __HIP_MEMORY_SCOPE_AGENT
typedef __bf16 bf16x2_t __attribute__((ext_vector_type(2)));
__device__ __forceinline__ unsigned pk2(float lo, float hi) { f32x2 v = {lo, hi}; bf16x2_t b = __builtin_convertvector(v, bf16x2_t); return __builtin_bit_cast(unsigned, b); }
__device__ __forceinline__ float bflo(unsigned w) { return __uint_as_float(w << 16); }
__device__ __forceinline__ float bfhi(unsigned w) { return __uint_as_float(w & 0xffff0000u); }
__device__ __forceinline__ float bf1(bf16_t w) { return __uint_as_float((unsigned)w << 16); }
__device__ __forceinline__ float wave_sum(float v) {
#pragma unroll
    for (int o = 1; o < 64; o <<= 1) v += __shfl_xor(v, o);
    return v;
}
__device__ __forceinline__ float fexp2(float x) { return __builtin_amdgcn_exp2f(x); }
__device__ __forceinline__ float fexp(float x) { return __builtin_amdgcn_exp2f(x * LOG2E); }
__device__ __forceinline__ float flog(float x) { return __builtin_amdgcn_logf(x) * 0.6931471805599453f; }
__device__ __forceinline__ float frcp(float x) { return __builtin_amdgcn_rcpf(x); }
__device__ __forceinline__ float silu_f(float x) { return x * frcp(1.f + fexp(-x)); }
__device__ __forceinline__ int crow(int r, int hi) { return (r & 3) + 8 * (r >> 2) + 4 * hi; }
__device__ __forceinline__ s16x4 tr_read(LAS const unsigned char* p) { return __builtin_bit_cast(s16x4, __builtin_amdgcn_ds_read_tr16_b64_v4i16((LAS s16x4*)p)); }
__device__ __forceinline__ bf16x8 cat4(s16x4 a, s16x4 b) { return (bf16x8){a[0], a[1], a[2], a[3], b[0], b[1], b[2], b[3]}; }
__device__ __forceinline__ bf16x8 pack8(float a0, float a1, float a2, float a3, float a4, float a5, float a6, float a7) {
    v4u w; w.x = pk2(a0, a1); w.y = pk2(a2, a3); w.z = pk2(a4, a5); w.w = pk2(a6, a7); return __builtin_bit_cast(bf16x8, w); }
#define MFMA32(a, b, c) __builtin_amdgcn_mfma_f32_32x32x16_bf16((a), (b), (c), 0, 0, 0)

#define XB_TMO      128
#define XB_XCNT(j)  (256  + 64 * (j))
#define XB_XSUB(j)  (1280 + 64 * (j))
#define XB_XGEN(j)  (2304 + 64 * (j))
#define XB_TOP      3328
#define XB_TOPGEN   3392
#define XCD_BAR_WORDS 3456
#define XB_SPIN_CAP (1u << 18)

__device__ __forceinline__ unsigned xb_ld(unsigned* p)              { return __hip_atomic_load(p, __ATOMIC_RELAXED, __HIP_MEMORY_SCOPE_AGENT); }
__device__ __forceinline__ unsigned xb_add(unsigned* p, unsigned v) { return __hip_atomic_fetch_add(p, v, __ATOMIC_RELAXED, __HIP_MEMORY_SCOPE_AGENT); }
__device__ __forceinline__ unsigned xb_xcc_id() { return (unsigned)__builtin_amdgcn_s_getreg((3 << 11) | 20) & 0xFu; }
#define XB_SPIN(cond, bar) do { unsigned _sp = 0; while (cond) { __builtin_amdgcn_s_sleep(1); \
    if ((++_sp & 255u) == 0u) { if (xb_ld(&(bar)[XB_TMO])) break; if (_sp > XB_SPIN_CAP) { atomicAdd(&(bar)[XB_TMO], 1u); break; } } } } while (0)

struct XcdBarrier {
    unsigned* bar; unsigned x;
    volatile LAS unsigned* st;
};

__device__ __forceinline__ XcdBarrier xcd_barrier_post(unsigned* bar, volatile LAS unsigned* st) {
    XcdBarrier b; b.bar = bar; b.x = xb_xcc_id(); b.st = st;
    if (threadIdx.x == 0) (void)xb_add(&bar[XB_XCNT(b.x)], 1u);
    return b;
}
__device__ __forceinline__ void xcd_barrier_complete(unsigned* bar, unsigned x, unsigned& nloc, unsigned& nx) {
    const unsigned G = gridDim.x * gridDim.y * gridDim.z;
    unsigned sum, cnt, mine, sp = 0u;
    for (;;) {
        sum = 0u; cnt = 0u; mine = 0u;
#pragma unroll
        for (unsigned j = 0; j < 16; ++j) { const unsigned c = xb_ld(&bar[XB_XCNT(j)]); sum += c; cnt += (c > 0u) ? 1u : 0u; mine = (j == x) ? c : mine; }
        if (sum == G) break;
        __builtin_amdgcn_s_sleep(1);
        if ((++sp & 255u) == 0u) { if (xb_ld(&bar[XB_TMO])) break; if (sp > XB_SPIN_CAP) { atomicAdd(&bar[XB_TMO], 1u); break; } }
    }
    nloc = mine > 0u ? mine : 1u; nx = cnt > 0u ? cnt : 1u;
}

__device__ __forceinline__ void xcd_barrier(const XcdBarrier& b) {
    asm volatile("s_waitcnt vmcnt(0)" ::: "memory");
    __syncthreads();
    if (threadIdx.x == 0) {
        unsigned* bar = b.bar;
        __builtin_amdgcn_s_waitcnt(0);
        unsigned nloc = b.st[0], nx = b.st[1];
        if (nloc == 0u) { xcd_barrier_complete(bar, b.x, nloc, nx); b.st[0] = nloc; b.st[1] = nx; }
        const unsigned old = xb_add(&bar[XB_XSUB(b.x)], 1u);
        const unsigned gen = old / nloc;
        if (old + 1u == (gen + 1u) * nloc) {
            __builtin_amdgcn_fence(__ATOMIC_RELEASE, "agent");
            asm volatile("s_waitcnt vmcnt(0)" ::: "memory");
            const unsigned og = xb_add(&bar[XB_TOP], 1u);
            const unsigned tg = og / nx;
            if (og + 1u == (tg + 1u) * nx) xb_add(&bar[XB_TOPGEN], 1u);
            else XB_SPIN(xb_ld(&bar[XB_TOPGEN]) == tg, bar);
            __builtin_amdgcn_fence(__ATOMIC_ACQUIRE, "agent");
            xb_add(&bar[XB_XGEN(b.x)], 1u);
            asm volatile("s_waitcnt vmcnt(0)" ::: "memory");
        } else {
            XB_SPIN(xb_ld(&bar[XB_XGEN(b.x)]) == gen, bar);
            __builtin_amdgcn_fence(__ATOMIC_ACQUIRE, "agent");
            asm volatile("s_waitcnt vmcnt(0)" ::: "memory");
        }
    }
    __syncthreads();
}
__device__ __forceinline__ void ld_row_f32(const float* p, int lane, f32x4 (&v)[4]) {
#pragma unroll
    for (int j = 0; j < 4; ++j) v[j] = *(const f32x4*)(p + 256 * j + 4 * lane);
}
__device__ __forceinline__ void st_row_f32(float* p, int lane, const f32x4 (&v)[4]) {
#pragma unroll
    for (int j = 0; j < 4; ++j) *(f32x4*)(p + 256 * j + 4 * lane) = v[j];
}
__device__ __forceinline__ void ld_row_bf16(const bf16_t* p, int lane, f32x4 (&v)[4]) {
#pragma unroll
    for (int j = 0; j < 4; ++j) { const v2u w = *(const v2u*)(p + 256 * j + 4 * lane); v[j] = (f32x4){bflo(w.x), bfhi(w.x), bflo(w.y), bfhi(w.y)}; }
}
__device__ __forceinline__ void st_row_bf16(bf16_t* p, int lane, const f32x4 (&v)[4]) {
#pragma unroll
    for (int j = 0; j < 4; ++j) { v2u w; w.x = pk2(v[j].x, v[j].y); w.y = pk2(v[j].z, v[j].w); *(v2u*)(p + 256 * j + 4 * lane) = w; }
}
__device__ __forceinline__ void ld_vec_lds(LAS const float* p, int lane, f32x4 (&v)[4]) {
#pragma unroll
    for (int j = 0; j < 4; ++j) v[j] = *(LAS const f32x4*)(p + 256 * j + 4 * lane);
}
__device__ __forceinline__ float sumsq16(const f32x4 (&v)[4]) {
    float s = 0.f;
#pragma unroll
    for (int j = 0; j < 4; ++j) s += (v[j].x * v[j].x + v[j].y * v[j].y) + (v[j].z * v[j].z + v[j].w * v[j].w);
    return s;
}
__device__ __forceinline__ float modfin(const float* modp, const float* bmod, int l, int r, int n) {
    float s = bmod[l * 6144 + n];
#pragma unroll
    for (int kc = 0; kc < 8; ++kc) s += modp[((size_t)(l * 8 + kc) * 9 + r) * 6144 + n];
    return s;
}

__device__ __forceinline__ void tr_item64(const float* W, int N, int Nvalid, bf16_t* WT, int Kd, int k0, int n0, int dst_row0, LAS float* scr, int lane) {
    const int q = lane & 15, kr = lane >> 4;
    f32x4 t[16];
#pragma unroll
    for (int i = 0; i < 16; ++i) { const int kk = 4 * i + kr; const int n = n0 + 4 * q;
        t[i] = (n < Nvalid) ? *(const f32x4*)(W + (size_t)(k0 + kk) * N + n) : (f32x4){0.f, 0.f, 0.f, 0.f}; }
#pragma unroll
    for (int i = 0; i < 16; ++i) { const int kk = 4 * i + kr; LAS float* d = scr + kk * 65 + 4 * q; d[0] = t[i].x; d[1] = t[i].y; d[2] = t[i].z; d[3] = t[i].w; }
    const int c = lane & 7, nl = lane >> 3;
#pragma unroll
    for (int j = 0; j < 8; ++j) { const int n = nl + 8 * j; LAS const float* s = scr + (8 * c) * 65 + n;
        v4u o; o.x = pk2(s[0 * 65], s[1 * 65]); o.y = pk2(s[2 * 65], s[3 * 65]); o.z = pk2(s[4 * 65], s[5 * 65]); o.w = pk2(s[6 * 65], s[7 * 65]);
        *(v4u*)(WT + (size_t)(dst_row0 + n) * Kd + k0 + 8 * c) = o; }
}
__device__ __forceinline__ void phase_p0(const float* const* in, unsigned char* ws, LAS unsigned char* wl, int gw, int NGW, int lane) {
    const float* cvec = in[1]; const float* cctx = in[3]; const float* wmod = in[4];
    const float* w_in = in[7]; const float* w_out = in[8]; const float* w_gate = in[15]; const float* w_up = in[16]; const float* w_down = in[17];
    float* modp = (float*)(ws + WS_MODP);
    constexpr int NI_MOD = 2 * 8 * 24, NI_ROPE = 16;
    constexpr int NI_IN = 16 * 40, NI_OUT = 16 * 16, NI_E = 16 * 16 * 16;
    constexpr int NI_L = NI_IN + NI_OUT + 3 * NI_E;
    constexpr int NITEMS = NI_MOD + NI_ROPE + 2 * NI_L;
    LAS float* scr = (LAS float*)wl;
    for (int it = gw; it < NITEMS; it += NGW) {
        int r = it;
        if (r < NI_MOD) {
            const int cb = r % 24, kc = (r / 24) & 7, l = r / 192;
            for (int idx = lane; idx < 128 * 9; idx += 64) { const int rr = idx / 128, k = idx % 128; const float cv = (rr < 8) ? cvec[rr * 1024 + kc * 128 + k] : cctx[kc * 128 + k]; scr[k * 12 + rr] = silu_f(cv); }
            f32x4 acc[9];
#pragma unroll
            for (int rr = 0; rr < 9; ++rr) acc[rr] = (f32x4){0.f, 0.f, 0.f, 0.f};
            const float* wp = wmod + ((size_t)l * 1024 + kc * 128) * 6144 + cb * 256 + 4 * lane;
#pragma unroll 4
            for (int k = 0; k < 128; ++k) { const f32x4 w = *(const f32x4*)(wp + (size_t)k * 6144);
                const f32x4 s0 = *(LAS const f32x4*)(scr + k * 12), s1 = *(LAS const f32x4*)(scr + k * 12 + 4); const float s8 = scr[k * 12 + 8];
                acc[0] += w * s0.x; acc[1] += w * s0.y; acc[2] += w * s0.z; acc[3] += w * s0.w; acc[4] += w * s1.x; acc[5] += w * s1.y; acc[6] += w * s1.z; acc[7] += w * s1.w; acc[8] += w * s8; }
#pragma unroll
            for (int rr = 0; rr < 9; ++rr) *(f32x4*)(modp + ((size_t)(l * 8 + kc) * 9 + rr) * 6144 + cb * 256 + 4 * lane) = acc[rr];
            continue;
        }
        r -= NI_MOD;
        if (r < NI_ROPE) {
            const int id = r * 64 + lane, pos = id >> 4, i = id & 15;
            const float fr = fexp2(-(float)i * (13.287712379549449f / 16.f));
            float rev = (float)pos * fr * 0.15915494309189535f; rev -= floorf(rev);
            f32x2 cs; cs.x = __builtin_amdgcn_cosf(rev); cs.y = __builtin_amdgcn_sinf(rev);
            ((f32x2*)(ws + WS_TAB))[id] = cs;
            continue;
        }
        r -= NI_ROPE;
        const int l = r / NI_L; r -= l * NI_L;
        if (r < NI_IN) { const int kb = r / 40, nb = r % 40;
            tr_item64(w_in + (size_t)l * 1024 * INW, INW, INW, (bf16_t*)(ws + WS_WIN) + (size_t)l * PP * 1024, 1024, 64 * kb, 64 * nb, 64 * nb, scr, lane); continue; }
        r -= NI_IN;
        if (r < NI_OUT) { const int kb = r / 16, nb = r % 16;
            tr_item64(w_out + (size_t)l * 1024 * 1024, 1024, 1024, (bf16_t*)(ws + WS_WOUT) + (size_t)l * 1024 * 1024, 1024, 64 * kb, 64 * nb, 64 * nb, scr, lane); continue; }
        r -= NI_OUT;
        const int which = r / NI_E; r -= which * NI_E;
        const int e = r / 256, kb = (r % 256) / 16, nb = r % 16, n0 = 64 * nb;
        const size_t eoff = (size_t)(l * 16 + e) * 1024 * 1024;
        if (which == 0) tr_item64(w_gate + eoff, 1024, 1024, (bf16_t*)(ws + WS_WGU) + 2 * eoff, 1024, 64 * kb, n0, (n0 >> 7) * 256 + (n0 & 127), scr, lane);
        else if (which == 1) tr_item64(w_up + eoff, 1024, 1024, (bf16_t*)(ws + WS_WGU) + 2 * eoff, 1024, 64 * kb, n0, (n0 >> 7) * 256 + 128 + (n0 & 127), scr, lane);
        else tr_item64(w_down + eoff, 1024, 1024, (bf16_t*)(ws + WS_WD) + eoff, 1024, 64 * kb, n0, n0, scr, lane);
    }
}

__device__ __forceinline__ void phase_a0(const float* const* in, unsigned char* ws, LAS unsigned char* lds, int G, int tid, int wave, int lane) {
    const float* x = in[0]; const float* ctx = in[2]; const float* bmod = in[5]; const float* gains = in[6];
    const float* modp = (const float*)(ws + WS_MODP); float* mod = (float*)(ws + WS_MOD); bf16_t* H = (bf16_t*)(ws + WS_H);
    LAS float* V = (LAS float*)lds;
    for (int row = blockIdx.x; row < 18; row += G) { const int l = row / 9, r = row % 9;
        for (int n = tid; n < 6144; n += 512) mod[(size_t)row * 6144 + n] = modfin(modp, bmod, l, r, n); }
    for (int t = blockIdx.x; t < 256; t += G) {
        const int b = t >> 5;
        __syncthreads();
        for (int n = tid; n < 1024; n += 512) { const float g = gains[n];
            V[n] = g * (1.f + modfin(modp, bmod, 0, b, 1024 + n)); V[1024 + n] = modfin(modp, bmod, 0, b, n);
            V[2048 + n] = g * (1.f + modfin(modp, bmod, 0, 8, 1024 + n)); V[3072 + n] = modfin(modp, bmod, 0, 8, n); }
        __syncthreads();
        for (int i = 0; i < 9; ++i) {
            const bool isc = (i == 8);
            const int row = isc ? (ML + 8 * t + wave) : (64 * t + 8 * wave + i);
            const float* src = isc ? (ctx + (size_t)(8 * t + wave) * 1024) : (x + (size_t)row * 1024);
            f32x4 v[4], a[4], s[4]; ld_row_f32(src, lane, v);
            const float rstd = __builtin_amdgcn_rsqf(wave_sum(sumsq16(v)) * (1.f / 1024.f) + NEPS);
            ld_vec_lds(V + (isc ? 2048 : 0), lane, a); ld_vec_lds(V + (isc ? 3072 : 1024), lane, s);
#pragma unroll
            for (int j = 0; j < 4; ++j) v[j] = v[j] * rstd * a[j] + s[j];
            st_row_bf16(H + (size_t)row * 1024, lane, v);
        }
    }
}
constexpr int VP = 192;
template <int MODE>
__device__ __forceinline__ void attn_item(const bf16_t* P, bf16_t* MIX, int item, LAS unsigned char* wl, int lane,
                                          const float* __restrict__ rpb, const float* __restrict__ sink) {
    const int ql = lane & 31, hi = lane >> 5;
    int b, hq, qcol, kcol, vcol, ocol, qrow0, r = 0, rs = 0, qt = 0, p0 = 0, nloc, lb_lo = 0;
    if (MODE == 0) { qt = item & 1; r = (item >> 1) & 31; hq = (item >> 6) & 3; b = item >> 8;
        qcol = C_NQ + hq * 64; kcol = C_NK + hq * 64; vcol = C_NV + hq * 64; ocol = 256 + hq * 64; qrow0 = b * SEQ + r * 64 + qt * 32;
        rs = r - 4; rs = rs < 0 ? 0 : (rs > 24 ? 24 : rs); nloc = 16; }
    else if (MODE == 1) { const int q32 = item & 63; p0 = q32 * 32; hq = (item >> 6) & 7; b = item >> 9;
        qcol = C_SQ + hq * 64; kcol = C_SK + (hq >> 2) * 64; vcol = C_SV + (hq >> 2) * 64; ocol = 512 + hq * 64; qrow0 = b * SEQ + p0;
        lb_lo = 4 - q32; if (lb_lo < 0) lb_lo = 0; int lb_hi = 4 + (63 - q32); if (lb_hi > 8) lb_hi = 8; nloc = lb_hi - lb_lo + 1; }
    else if (MODE == 2) { qt = item & 7; hq = (item >> 3) & 3; b = item >> 5;
        qcol = C_NQ + hq * 64; kcol = C_NK + hq * 64; vcol = C_NV + hq * 64; ocol = 256 + hq * 64; qrow0 = ML + b * CTXL + qt * 32; nloc = 0; }
    else { qt = item & 7; hq = (item >> 3) & 7; b = item >> 6;
        qcol = C_SQ + hq * 64; kcol = C_SK + (hq >> 2) * 64; vcol = C_SV + (hq >> 2) * 64; ocol = 512 + hq * 64; qrow0 = ML + b * CTXL + qt * 32; nloc = 0; }
    const int nblk = 8 + nloc;
    LAS unsigned char* vl = wl;
    LAS float* rl = (LAS float*)(wl + 32 * VP);
    if (MODE == 0) { for (int i = lane; i < 465; i += 64) rl[i] = rpb[hq * 465 + i] * LOG2E; }
    bf16x8 qf[4];
    { const bf16_t* qp = P + (size_t)(qrow0 + ql) * PP + qcol + 8 * hi;
#pragma unroll
      for (int ds = 0; ds < 4; ++ds) qf[ds] = *(const bf16x8*)(qp + 16 * ds); }
    auto blk_row0 = [&](int blk) -> int {
        if (blk < 8) return ML + b * CTXL + blk * 32;
        const int lb = blk - 8;
        if (MODE == 0) return b * SEQ + (rs + (lb >> 1)) * 64 + (lb & 1) * 32;
        return b * SEQ + p0 + 32 * (lb_lo + lb - 4);
    };
    bf16x8 kn[4]; v4u vn[4];
    auto load_blk = [&](int blk) {
        const int r0 = blk_row0(blk);
        const bf16_t* kp = P + (size_t)(r0 + ql) * PP + kcol + 8 * hi;
#pragma unroll
        for (int ds = 0; ds < 4; ++ds) kn[ds] = *(const bf16x8*)(kp + 16 * ds);
#pragma unroll
        for (int i = 0; i < 4; ++i) { const int c = lane + 64 * i; vn[i] = *(const v4u*)(P + (size_t)(r0 + (c >> 3)) * PP + vcol + (c & 7) * 8); }
    };
    float m = -INFINITY, lsum = 0.f;
    f32x16 o0, o1;
#pragma unroll
    for (int i = 0; i < 16; ++i) { o0[i] = 0.f; o1[i] = 0.f; }
    const float SC = 0.125f * LOG2E;
    const int tr_off = (4 * hi + ((lane & 15) >> 2)) * VP + (16 * ((lane >> 4) & 1) + 4 * (lane & 3)) * 2;
    load_blk(0);
    for (int blk = 0; blk < nblk; ++blk) {
        bf16x8 kf[4]; v4u vr[4];
#pragma unroll
        for (int i = 0; i < 4; ++i) { kf[i] = kn[i]; vr[i] = vn[i]; }
        if (blk + 1 < nblk) load_blk(blk + 1);
#pragma unroll
        for (int i = 0; i < 4; ++i) { const int c = lane + 64 * i; *(LAS v4u*)(vl + (c >> 3) * VP + (c & 7) * 16) = vr[i]; }
        f32x16 s;
#pragma unroll
        for (int i = 0; i < 16; ++i) s[i] = 0.f;
#pragma unroll
        for (int ds = 0; ds < 4; ++ds) s = MFMA32(kf[ds], qf[ds], s);
        if (MODE == 0 && blk >= 8) {
            const int lb = blk - 8, j = lb >> 1, ch = lb & 1, c = qt * 32 + ql;
            int cs = c - 8; cs = cs < 0 ? 0 : (cs > 48 ? 48 : cs);
            LAS const float* rrow = rl + (rs + j - r + 7) * 31 + (15 - c);
#pragma unroll
            for (int i = 0; i < 16; ++i) { const int kc = ch * 32 + crow(i, hi); const bool ok = (kc >= cs) && (kc < cs + 16);
                const float bias = rrow[ok ? kc : c];
                s[i] = ok ? (s[i] * SC + bias) : -INFINITY; }
        } else if (MODE == 1 && blk >= 8) {
            const int lb = lb_lo + blk - 8;
#pragma unroll
            for (int i = 0; i < 16; ++i) { const int kk = crow(i, hi); const bool ok = (lb == 0) ? (kk >= ql) : ((lb == 8) ? (kk <= ql) : true);
                s[i] = ok ? s[i] * SC : -INFINITY; }
        } else {
#pragma unroll
            for (int i = 0; i < 16; ++i) s[i] *= SC;
        }
        float bm = s[0];
#pragma unroll
        for (int i = 1; i < 16; ++i) bm = fmaxf(bm, s[i]);
        bm = fmaxf(bm, __shfl_xor(bm, 32));
        const float mn = fmaxf(m, bm), alpha = fexp2(m - mn);
        m = mn;
        float ps = 0.f;
#pragma unroll
        for (int i = 0; i < 16; ++i) { s[i] = fexp2(s[i] - mn); ps += s[i]; }
        lsum = lsum * alpha + ps;
#pragma unroll
        for (int i = 0; i < 16; ++i) { o0[i] *= alpha; o1[i] *= alpha; }
#pragma unroll
        for (int ks = 0; ks < 2; ++ks) {
            const bf16x8 pf = pack8(s[8 * ks + 0], s[8 * ks + 1], s[8 * ks + 2], s[8 * ks + 3], s[8 * ks + 4], s[8 * ks + 5], s[8 * ks + 6], s[8 * ks + 7]);
            LAS const unsigned char* vb = vl + tr_off + 16 * ks * VP;
            const bf16x8 v0 = cat4(tr_read(vb), tr_read(vb + 8 * VP));
            const bf16x8 v1 = cat4(tr_read(vb + 64), tr_read(vb + 8 * VP + 64));
            o0 = MFMA32(v0, pf, o0); o1 = MFMA32(v1, pf, o1);
        }
    }
    float lt = lsum + __shfl_xor(lsum, 32);
    if (MODE == 1 || MODE == 3) lt += fexp2(sink[hq] * LOG2E - m);
    const float inv = frcp(lt);
    bf16_t* op = MIX + (size_t)(qrow0 + ql) * 1024 + ocol + 4 * hi;
#pragma unroll
    for (int g = 0; g < 4; ++g) {
        v2u w0, w1; w0.x = pk2(o0[4 * g] * inv, o0[4 * g + 1] * inv); w0.y = pk2(o0[4 * g + 2] * inv, o0[4 * g + 3] * inv);
        w1.x = pk2(o1[4 * g] * inv, o1[4 * g + 1] * inv); w1.y = pk2(o1[4 * g + 2] * inv, o1[4 * g + 3] * inv);
        *(v2u*)(op + 8 * g) = w0; *(v2u*)(op + 32 + 8 * g) = w1;
    }
}
constexpr int GP = 144;
constexpr int G_V = 0, G_A = 64 * GP, G_B = 64 * GP + 32 * GP;
static_assert(G_B + 32 * GP <= WAVE_LDS, "gla LDS");

struct GlaCum { float cum[2][16]; float tot; };
__device__ __forceinline__ void gla_cum(const bf16_t* P, int row0, int hh, int dir, const float* __restrict__ a_up, const float* __restrict__ a_bias, int lane, GlaCum& C) {
    const int kk = lane & 31, hi = lane >> 5;
    const float* up = a_up + (size_t)dir * 16 * 128 + (size_t)(8 * hi) * 128 + hh * 32 + kk;
    const bf16x8 ub = pack8(up[0], up[128], up[256], up[384], up[512], up[640], up[768], up[896]);
    const float bias = a_bias[dir * 128 + hh * 32 + kk];
    float gs[2][4];
#pragma unroll
    for (int tt = 0; tt < 2; ++tt) {
        const bf16x8 al = *(const bf16x8*)(P + (size_t)(row0 + 32 * tt + kk) * PP + C_GAF + 16 * dir + 8 * hi);
        f32x16 z;
#pragma unroll
        for (int i = 0; i < 16; ++i) z[i] = 0.f;
        z = MFMA32(al, ub, z);
#pragma unroll
        for (int g = 0; g < 4; ++g) { float run = 0.f;
#pragma unroll
            for (int e = 0; e < 4; ++e) { const float zz = z[4 * g + e] + bias; const float ls = fminf(zz, 0.f) - flog(1.f + fexp(-fabsf(zz)));
                const float l = ls * (1.f / 16.f);
                if (dir == 0) { run += l; C.cum[tt][4 * g + e] = run; } else { C.cum[tt][4 * g + e] = run; run += l; } }
            gs[tt][g] = run; }
    }
    float off = 0.f;
#pragma unroll
    for (int tt = 0; tt < 2; ++tt)
#pragma unroll
        for (int g = 0; g < 4; ++g) { const float other = __shfl_xor(gs[tt][g], 32); const float mine = off + (hi ? other : 0.f);
#pragma unroll
            for (int e = 0; e < 4; ++e) C.cum[tt][4 * g + e] += mine;
            off += gs[tt][g] + other; }
    C.tot = off;
    if (dir == 1) {
#pragma unroll
        for (int tt = 0; tt < 2; ++tt)
#pragma unroll
            for (int r = 0; r < 16; ++r) C.cum[tt][r] = off - C.cum[tt][r];
    }
}
__device__ __forceinline__ void gla_ld_tc(const bf16_t* P, int row0, int col, int lane, float (&x)[2][16]) {
    const int kk = lane & 31, hi = lane >> 5;
#pragma unroll
    for (int tt = 0; tt < 2; ++tt)
#pragma unroll
        for (int r = 0; r < 16; ++r) x[tt][r] = bf1(P[(size_t)(row0 + 32 * tt + crow(r, hi)) * PP + col + kk]);
}
__device__ __forceinline__ void gla_st_img(LAS unsigned char* img, int lane, const float (&x)[2][16]) {
    const int kk = lane & 31, hi = lane >> 5;
#pragma unroll
    for (int tt = 0; tt < 2; ++tt)
#pragma unroll
        for (int g = 0; g < 4; ++g) { v2u w; w.x = pk2(x[tt][4 * g], x[tt][4 * g + 1]); w.y = pk2(x[tt][4 * g + 2], x[tt][4 * g + 3]);
            *(LAS v2u*)(img + kk * GP + (32 * tt + 8 * g + 4 * hi) * 2) = w; }
}
__device__ __forceinline__ void gla_stage_v(const bf16_t* P, int row0, int hh, LAS unsigned char* wl, int lane) {
#pragma unroll
    for (int i = 0; i < 8; ++i) { const int c = lane + 64 * i; const v4u v = *(const v4u*)(P + (size_t)(row0 + (c >> 3)) * PP + C_GV + hh * 64 + (c & 7) * 8);
        *(LAS v4u*)(wl + G_V + (c >> 3) * GP + (c & 7) * 16) = v; }
}
__device__ __forceinline__ int gla_row0(int b, int nc) { return nc < 4 ? (ML + b * CTXL + 64 * nc) : (b * SEQ + 64 * (nc - 4)); }

__device__ __forceinline__ void gla_local_item(const bf16_t* P, float* UST, float* DEC, int item, LAS unsigned char* wl, int lane,
                                               const float* __restrict__ a_up, const float* __restrict__ a_bias) {
    const int nc = item % 36, hh = (item / 36) & 3, b = item / 144;
    const int row0 = gla_row0(b, nc), kk = lane & 31, hi = lane >> 5;
    gla_stage_v(P, row0, hh, wl, lane);
    float kv[2][16]; gla_ld_tc(P, row0, C_GK + hh * 32, lane, kv);
#pragma unroll
    for (int dir = 0; dir < 2; ++dir) {
        GlaCum C; gla_cum(P, row0, hh, dir, a_up, a_bias, lane, C);
        float kd[2][16];
#pragma unroll
        for (int tt = 0; tt < 2; ++tt)
#pragma unroll
            for (int r = 0; r < 16; ++r) kd[tt][r] = kv[tt][r] * fexp(C.tot - C.cum[tt][r]);
        gla_st_img(wl + (dir == 0 ? G_A : G_B), lane, kd);
        if (hi == 0) DEC[((size_t)((b * 4 + hh) * 2 + dir) * 36 + nc) * 32 + kk] = fexp(C.tot);
    }
    const int trv = ((lane & 15) >> 2) * GP + (16 * ((lane >> 4) & 1) + 4 * (lane & 3)) * 2;
#pragma unroll
    for (int dir = 0; dir < 2; ++dir) {
        f32x16 u0, u1;
#pragma unroll
        for (int i = 0; i < 16; ++i) { u0[i] = 0.f; u1[i] = 0.f; }
        LAS const unsigned char* img = wl + (dir == 0 ? G_A : G_B);
#pragma unroll
        for (int s = 0; s < 4; ++s) {
            const bf16x8 kb = *(LAS const bf16x8*)(img + kk * GP + (16 * s + 8 * hi) * 2);
            LAS const unsigned char* vb = wl + G_V + trv + (16 * s + 8 * hi) * GP;
            const bf16x8 v0 = cat4(tr_read(vb), tr_read(vb + 4 * GP));
            const bf16x8 v1 = cat4(tr_read(vb + 64), tr_read(vb + 4 * GP + 64));
            u0 = MFMA32(v0, kb, u0); u1 = MFMA32(v1, kb, u1);
        }
        float* up = UST + ((size_t)((b * 4 + hh) * 2 + dir) * 36 + nc) * 2048 + kk;
#pragma unroll
        for (int i = 0; i < 16; ++i) { up[(size_t)crow(i, hi) * 32] = u0[i]; up[(size_t)(32 + crow(i, hi)) * 32] = u1[i]; }
    }
}

__device__ __forceinline__ void gla_prefix(float* UST, const float* DEC, int gid) {
    const int bhd = gid >> 11, e = gid & 2047, k = e & 31, dir = bhd & 1;
    float* base = UST + (size_t)bhd * 36 * 2048 + e; const float* dec = DEC + (size_t)bhd * 36 * 32 + k;
    float s = 0.f;
#pragma unroll 4
    for (int ci = 0; ci < 36; ++ci) {
        const int sl = dir == 0 ? ci : (ci < 4 ? 3 - ci : 39 - ci);
        const float u = base[(size_t)sl * 2048], d = dec[sl * 32];
        base[(size_t)sl * 2048] = s; s = d * s + u;
    }
}

__device__ __forceinline__ void gla_out_item(const bf16_t* P, const float* UST, bf16_t* MIX, int item, LAS unsigned char* wl, int lane,
                                             const float* __restrict__ a_up, const float* __restrict__ a_bias, const float* __restrict__ gnorm) {
    const int nc = item % 36, hh = (item / 36) & 3, b = item / 144;
    const int row0 = gla_row0(b, nc), kk = lane & 31, hi = lane >> 5;
    gla_stage_v(P, row0, hh, wl, lane);
    f32x16 o[2][2];
#pragma unroll
    for (int a = 0; a < 2; ++a)
#pragma unroll
        for (int c = 0; c < 2; ++c)
#pragma unroll
            for (int i = 0; i < 16; ++i) o[a][c][i] = 0.f;
    const int g16 = (lane >> 4) & 1, qq = (lane & 15) >> 2, pp = lane & 3;
    const int tri = (8 * hi + qq) * GP + (16 * g16 + 4 * pp) * 2;
    const int trv = (4 * hi + qq) * GP + (16 * g16 + 4 * pp) * 2;
#pragma unroll
    for (int dir = 0; dir < 2; ++dir) {
        GlaCum C; gla_cum(P, row0, hh, dir, a_up, a_bias, lane, C);
#pragma unroll
        for (int tt = 0; tt < 2; ++tt) {
            float cum[16];
#pragma unroll
            for (int r = 0; r < 16; ++r) cum[r] = C.cum[tt][r];
#pragma unroll
            for (int g = 0; g < 4; ++g) {
                float xq[4], xk[4];
#pragma unroll
                for (int e = 0; e < 4; ++e) { const size_t ro = (size_t)(row0 + 32 * tt + 8 * g + 4 * hi + e) * PP + hh * 32 + kk;
                    xq[e] = bf1(P[ro + C_GQ]) * 0.17677669529663687f * fexp(cum[4 * g + e]); xk[e] = bf1(P[ro + C_GK]) * fexp(-cum[4 * g + e]); }
                v2u wq, wk; wq.x = pk2(xq[0], xq[1]); wq.y = pk2(xq[2], xq[3]); wk.x = pk2(xk[0], xk[1]); wk.y = pk2(xk[2], xk[3]);
                const int off = kk * GP + (32 * tt + 8 * g + 4 * hi) * 2;
                *(LAS v2u*)(wl + G_A + off) = wq; *(LAS v2u*)(wl + G_B + off) = wk;
                if (g & 1) asm volatile("" ::: "memory");
            }
        }
        const float* sp = UST + ((size_t)((b * 4 + hh) * 2 + dir) * 36 + nc) * 2048;
        bf16x8 sf[2][2];
#pragma unroll
        for (int vb = 0; vb < 2; ++vb)
#pragma unroll
            for (int s = 0; s < 2; ++s) { const float* p = sp + (size_t)(32 * vb + kk) * 32 + 16 * s + 8 * hi; const f32x4 a = *(const f32x4*)p, c = *(const f32x4*)(p + 4);
                sf[vb][s] = pack8(a.x, a.y, a.z, a.w, c.x, c.y, c.z, c.w); }
#pragma unroll
        for (int it = 0; it < 2; ++it) {
            bf16x8 qf[2];
#pragma unroll
            for (int s = 0; s < 2; ++s) { LAS const unsigned char* p = wl + G_A + tri + 16 * s * GP + 64 * it; qf[s] = cat4(tr_read(p), tr_read(p + 4 * GP)); }
#pragma unroll
            for (int vb = 0; vb < 2; ++vb)
#pragma unroll
                for (int s = 0; s < 2; ++s) o[vb][it] = MFMA32(sf[vb][s], qf[s], o[vb][it]);
#pragma unroll
            for (int jt = 0; jt < 2; ++jt) {
                if (dir == 0 ? (jt > it) : (jt < it)) continue;
                f32x16 sc;
#pragma unroll
                for (int i = 0; i < 16; ++i) sc[i] = 0.f;
#pragma unroll
                for (int s = 0; s < 2; ++s) { LAS const unsigned char* p = wl + G_B + tri + 16 * s * GP + 64 * jt; const bf16x8 kf = cat4(tr_read(p), tr_read(p + 4 * GP)); sc = MFMA32(kf, qf[s], sc); }
                if (jt == it) {
#pragma unroll
                    for (int i = 0; i < 16; ++i) { const int j = crow(i, hi); const bool ok = dir == 0 ? (j <= kk) : (j >= kk); sc[i] = ok ? sc[i] : 0.f; }
                }
#pragma unroll
                for (int s2 = 0; s2 < 2; ++s2) {
                    const bf16x8 pf = pack8(sc[8 * s2 + 0], sc[8 * s2 + 1], sc[8 * s2 + 2], sc[8 * s2 + 3], sc[8 * s2 + 4], sc[8 * s2 + 5], sc[8 * s2 + 6], sc[8 * s2 + 7]);
                    LAS const unsigned char* vp = wl + G_V + trv + (32 * jt + 16 * s2) * GP;
                    const bf16x8 v0 = cat4(tr_read(vp), tr_read(vp + 8 * GP));
                    const bf16x8 v1 = cat4(tr_read(vp + 64), tr_read(vp + 8 * GP + 64));
                    o[0][it] = MFMA32(v0, pf, o[0][it]); o[1][it] = MFMA32(v1, pf, o[1][it]);
                }
                __builtin_amdgcn_sched_barrier(0);
            }
            __builtin_amdgcn_sched_barrier(0);
        }
    }
#pragma unroll
    for (int it = 0; it < 2; ++it) {
        float ss = 0.f;
#pragma unroll
        for (int vb = 0; vb < 2; ++vb)
#pragma unroll
            for (int i = 0; i < 16; ++i) ss += o[vb][it][i] * o[vb][it][i];
        ss += __shfl_xor(ss, 32);
        const float rstd = __builtin_amdgcn_rsqf(ss * (1.f / 64.f) + NEPS);
        const size_t row = (size_t)(row0 + 32 * it + kk);
#pragma unroll
        for (int vb = 0; vb < 2; ++vb)
#pragma unroll
            for (int g = 0; g < 4; ++g) { const int v = 32 * vb + 8 * g + 4 * hi;
                const f32x4 gn = *(const f32x4*)(gnorm + v); const v2u gw = *(const v2u*)(P + row * PP + C_GG + hh * 64 + v);
                const float g0 = bflo(gw.x), g1 = bfhi(gw.x), g2 = bflo(gw.y), g3 = bfhi(gw.y);
                v2u w; w.x = pk2(o[vb][it][4 * g] * rstd * gn.x * silu_f(g0), o[vb][it][4 * g + 1] * rstd * gn.y * silu_f(g1));
                w.y = pk2(o[vb][it][4 * g + 2] * rstd * gn.z * silu_f(g2), o[vb][it][4 * g + 3] * rstd * gn.w * silu_f(g3));
                *(v2u*)(MIX + row * 1024 + hh * 64 + v) = w; }
    }
}
__device__ __forceinline__ void phase_r1(const float* const* in, float* xout, unsigned char* ws, LAS unsigned char* lds, int l, bool upd, int G, int tid, int wave, int lane) {
    const float* x0 = in[0]; const float* ctx0 = in[2]; const float* gains = in[6] + (size_t)l * 4096; const float* wr = in[14] + (size_t)l * 1024 * 16;
    const float* mod = (const float*)(ws + WS_MOD) + (size_t)l * 9 * 6144;
    const bf16_t* Y = (const bf16_t*)(ws + WS_R2 + (size_t)MT * 2048); bf16_t* H = (bf16_t*)(ws + WS_H); float* XC = (float*)(ws + WS_XC);
    float* AFF = (float*)(ws + WS_AFF); float* AFFC = (float*)(ws + WS_AFFC);
    LAS float* V = (LAS float*)lds;
    LAS float* RT = V + 6144;
    __syncthreads();
    for (int i = tid; i < 16384; i += 512) { const int d = i >> 4, e = i & 15; RT[e * 1024 + d] = wr[i]; }
    for (int t = blockIdx.x; t < 256; t += G) {
        const int b = t >> 5;
        __syncthreads();
        for (int n = tid; n < 1024; n += 512) { const float gpa = gains[1024 + n], gpf = gains[2048 + n];
            V[n] = gpa * mod[b * 6144 + 2048 + n]; V[1024 + n] = gpf * (1.f + mod[b * 6144 + 4096 + n]); V[2048 + n] = mod[b * 6144 + 3072 + n];
            V[3072 + n] = gpa * mod[8 * 6144 + 2048 + n]; V[4096 + n] = gpf * (1.f + mod[8 * 6144 + 4096 + n]); V[5120 + n] = mod[8 * 6144 + 3072 + n]; }
        __syncthreads();
        const int nrows = upd ? 9 : 8;
        for (int i = 0; i < nrows; ++i) {
            const bool isc = (i == 8);
            const int row = isc ? (ML + 8 * t + wave) : (64 * t + 8 * wave + i);
            const float* xs = isc ? ((l == 0 ? ctx0 : XC) + (size_t)(8 * t + wave) * 1024) : ((l == 0 ? x0 : xout) + (size_t)row * 1024);
            float* xd = isc ? (XC + (size_t)(8 * t + wave) * 1024) : (xout + (size_t)row * 1024);
            LAS const float* vv = V + (isc ? 3072 : 0);
            f32x4 y[4], xv[4], a[4];
            ld_row_bf16(Y + (size_t)row * 1024, lane, y); ld_row_f32(xs, lane, xv);
            const float rsy = __builtin_amdgcn_rsqf(wave_sum(sumsq16(y)) * (1.f / 1024.f) + NEPS);
            ld_vec_lds(vv, lane, a);
#pragma unroll
            for (int j = 0; j < 4; ++j) xv[j] = xv[j] + a[j] * (y[j] * rsy);
            st_row_f32(xd, lane, xv);
            const float rs1 = __builtin_amdgcn_rsqf(wave_sum(sumsq16(xv)) * (1.f / 1024.f) + NEPS);
            f32x4 s[4]; ld_vec_lds(vv + 1024, lane, a); ld_vec_lds(vv + 2048, lane, s);
#pragma unroll
            for (int j = 0; j < 4; ++j) xv[j] = xv[j] * rs1 * a[j] + s[j];
            st_row_bf16(H + (size_t)row * 1024, lane, xv);
            float lg[16];
#pragma unroll
            for (int e = 0; e < 16; ++e) { float p = 0.f;
#pragma unroll
                for (int j = 0; j < 4; ++j) { const f32x4 w = *(LAS const f32x4*)(RT + e * 1024 + 256 * j + 4 * lane); p += (xv[j].x * w.x + xv[j].y * w.y) + (xv[j].z * w.z + xv[j].w * w.w); }
                lg[e] = p;
                if ((e & 3) == 3) asm volatile("" ::: "memory"); }
#pragma unroll
            for (int i = 0; i < 8; ++i) { const bool up = (lane & 32) != 0; const float keep = up ? lg[i + 8] : lg[i], send = up ? lg[i] : lg[i + 8]; lg[i] = keep + __shfl_xor(send, 32); }
#pragma unroll
            for (int i = 0; i < 4; ++i) { const bool up = (lane & 16) != 0; const float keep = up ? lg[i + 4] : lg[i], send = up ? lg[i] : lg[i + 4]; lg[i] = keep + __shfl_xor(send, 16); }
#pragma unroll
            for (int i = 0; i < 2; ++i) { const bool up = (lane & 8) != 0; const float keep = up ? lg[i + 2] : lg[i], send = up ? lg[i] : lg[i + 2]; lg[i] = keep + __shfl_xor(send, 8); }
            { const bool up = (lane & 4) != 0; const float keep = up ? lg[1] : lg[0], send = up ? lg[0] : lg[1]; lg[0] = keep + __shfl_xor(send, 4); }
            float lgt = lg[0]; lgt += __shfl_xor(lgt, 1); lgt += __shfl_xor(lgt, 2);
            const int ex = ((lane >> 5) & 1) * 8 + ((lane >> 4) & 1) * 4 + ((lane >> 3) & 1) * 2 + ((lane >> 2) & 1);
            float mx = lgt;
            mx = fmaxf(mx, __shfl_xor(mx, 4)); mx = fmaxf(mx, __shfl_xor(mx, 8)); mx = fmaxf(mx, __shfl_xor(mx, 16)); mx = fmaxf(mx, __shfl_xor(mx, 32));
            const float pe = fexp(lgt - mx);
            float den = pe; den += __shfl_xor(den, 4); den += __shfl_xor(den, 8); den += __shfl_xor(den, 16); den += __shfl_xor(den, 32);
            const float mine = pe / den;
            if ((lane & 3) == 0) {
                if (isc) { const int cr = 8 * t + wave; AFFC[((size_t)(cr >> 8) * 16 + ex) * 256 + (cr & 255)] = mine; }
                else AFF[((size_t)(row >> 11) * 16 + ex) * 2048 + (row & 2047)] = mine;
            }
        }
    }
}

template <bool CTX>
__device__ __forceinline__ void topk_item(unsigned char* ws, int item, LAS unsigned char* wl, int lane) {
    constexpr int NT = CTX ? 256 : 2048, CAP = CTX ? 32 : 256, NSL = NT / 64;
    const int sl = item % NSL, e = (item / NSL) & 15, b = item / (NSL * 16);
    const float* arow = (const float*)(ws + (CTX ? WS_AFFC : WS_AFF)) + (size_t)(b * 16 + e) * NT;
    float* gate = (float*)(ws + (CTX ? WS_GATEC : WS_GATE)) + (size_t)(b * 16 + e) * CAP;
    short* INV = (short*)(ws + WS_INV);
    const bf16_t* H = (const bf16_t*)(ws + WS_H); bf16_t* XS = (bf16_t*)(ws + WS_R1);
    LAS float* av = (LAS float*)wl;
#pragma unroll
    for (int i = 0; i < NT / 256; ++i) *(LAS f32x4*)(av + (i * 64 + lane) * 4) = *(const f32x4*)(arow + (i * 64 + lane) * 4);
    const int n0 = sl * 64, n = n0 + lane;
    const float an = av[n];
    int cnt = 0;
    for (int m4 = 0; m4 < n0 / 4; ++m4) { const f32x4 q = *(LAS const f32x4*)(av + 4 * m4); cnt += (q.x >= an) + (q.y >= an) + (q.z >= an) + (q.w >= an); }
#pragma unroll 4
    for (int m4 = n0 / 4; m4 < n0 / 4 + 16; ++m4) { const f32x4 q = *(LAS const f32x4*)(av + 4 * m4); const int m = 4 * m4;
        cnt += ((q.x > an) || (q.x == an && m < n)) + ((q.y > an) || (q.y == an && m + 1 < n)) + ((q.z > an) || (q.z == an && m + 2 < n)) + ((q.w > an) || (q.w == an && m + 3 < n)); }
    for (int m4 = n0 / 4 + 16; m4 < NT / 4; ++m4) { const f32x4 q = *(LAS const f32x4*)(av + 4 * m4); cnt += (q.x > an) + (q.y > an) + (q.z > an) + (q.w > an); }
    const bool sel = cnt < CAP;
    const int grow = CTX ? (ML + b * CTXL + n) : (b * SEQ + n);
    INV[(size_t)grow * 16 + e] = sel ? (short)cnt : (short)-1;
    if (sel) gate[cnt] = an;
    unsigned long long mask = __ballot(sel);
    while (mask) {
        const int src = __ffsll((long long)mask) - 1; mask &= mask - 1;
        const int rk = __shfl(cnt, src);
        const int srow = CTX ? (ML + b * CTXL + n0 + src) : (b * SEQ + n0 + src);
        const size_t drow = CTX ? ((size_t)(128 + e) * 256 + b * 32 + rk) : ((size_t)(b * 16 + e) * 256 + rk);
        const v4u* sp = (const v4u*)(H + (size_t)srow * 1024); v4u* dp = (v4u*)(XS + drow * 1024);
        const v4u a0 = sp[lane], a1 = sp[64 + lane]; dp[lane] = a0; dp[64 + lane] = a1;
    }
}

__device__ __forceinline__ void phase_r5(const float* const* in, float* xout, unsigned char* ws, LAS unsigned char* lds, int l, bool upd, int G, int tid, int wave, int lane) {
    const float* gains = in[6];
    const float* mod = (const float*)(ws + WS_MOD);
    const bf16_t* YE = (const bf16_t*)(ws + WS_R1); bf16_t* H = (bf16_t*)(ws + WS_H); float* XC = (float*)(ws + WS_XC);
    const float* GATE = (const float*)(ws + WS_GATE); const float* GATEC = (const float*)(ws + WS_GATEC); const short* INV = (const short*)(ws + WS_INV);
    LAS float* V = (LAS float*)lds;
    for (int t = blockIdx.x; t < 256; t += G) {
        const int b = t >> 5;
        __syncthreads();
        for (int n = tid; n < 1024; n += 512) { const float gpf = gains[(size_t)l * 4096 + 3072 + n];
            V[n] = gpf * mod[((size_t)l * 9 + b) * 6144 + 5120 + n]; V[3072 + n] = gpf * mod[((size_t)l * 9 + 8) * 6144 + 5120 + n];
            if (l == 0) { const float gna = gains[4096 + n];
                V[1024 + n] = gna * (1.f + mod[((size_t)9 + b) * 6144 + 1024 + n]); V[2048 + n] = mod[((size_t)9 + b) * 6144 + n];
                V[4096 + n] = gna * (1.f + mod[((size_t)9 + 8) * 6144 + 1024 + n]); V[5120 + n] = mod[((size_t)9 + 8) * 6144 + n]; } }
        __syncthreads();
        const int nrows = upd ? 9 : 8;
        for (int i = 0; i < nrows; ++i) {
            const bool isc = (i == 8);
            const int row = isc ? (ML + 8 * t + wave) : (64 * t + 8 * wave + i);
            float* xd = isc ? (XC + (size_t)(8 * t + wave) * 1024) : (xout + (size_t)row * 1024);
            LAS const float* vv = V + (isc ? 3072 : 0);
            const v4u i0 = *(const v4u*)(INV + (size_t)row * 16), i1 = *(const v4u*)(INV + (size_t)row * 16 + 8);
            const unsigned iw[8] = {i0.x, i0.y, i0.z, i0.w, i1.x, i1.y, i1.z, i1.w};
            f32x4 acc[4];
#pragma unroll
            for (int j = 0; j < 4; ++j) acc[j] = (f32x4){0.f, 0.f, 0.f, 0.f};
#pragma unroll
            for (int e = 0; e < 16; ++e) {
                const int slot = (int)(short)((iw[e >> 1] >> (16 * (e & 1))) & 0xffffu);
                if (slot >= 0) {
                    const int bb = isc ? ((8 * t + wave) >> 8) : (row >> 11);
                    const float g = isc ? GATEC[(size_t)(bb * 16 + e) * 32 + slot] : GATE[(size_t)(bb * 16 + e) * 256 + slot];
                    const size_t yr = isc ? ((size_t)(128 + e) * 256 + bb * 32 + slot) : ((size_t)(bb * 16 + e) * 256 + slot);
                    f32x4 yv[4]; ld_row_bf16(YE + yr * 1024, lane, yv);
#pragma unroll
                    for (int j = 0; j < 4; ++j) acc[j] += yv[j] * g;
                }
            }
            const float rsm = __builtin_amdgcn_rsqf(wave_sum(sumsq16(acc)) * (1.f / 1024.f) + NEPS);
            f32x4 xv[4], a[4]; ld_row_f32(xd, lane, xv); ld_vec_lds(vv, lane, a);
#pragma unroll
            for (int j = 0; j < 4; ++j) xv[j] = xv[j] + a[j] * (acc[j] * rsm);
            st_row_f32(xd, lane, xv);
            if (l == 0) {
                const float rs2 = __builtin_amdgcn_rsqf(wave_sum(sumsq16(xv)) * (1.f / 1024.f) + NEPS);
                f32x4 s[4]; ld_vec_lds(vv + 1024, lane, a); ld_vec_lds(vv + 2048, lane, s);
#pragma unroll
                for (int j = 0; j < 4; ++j) xv[j] = xv[j] * rs2 * a[j] + s[j];
                st_row_bf16(H + (size_t)row * 1024, lane, xv);
            }
        }
    }
}
#ifndef MK_PER_PHASE
#define MK_PER_PHASE 0
#endif
constexpr int N_PHASES = 22;
struct Args { const float* in[18]; float* out; unsigned char* ws; int ph_lo, ph_hi; };
__device__ __forceinline__ const Args* kargs_opaque() {
    auto p = __builtin_amdgcn_kernarg_segment_ptr(); asm volatile("" : "+s"(p)); return (const Args*)p; }
#define PHASE_REGS() int tid = threadIdx.x; asm volatile("" : "+v"(tid)); const int lane = tid & 63, wave = __builtin_amdgcn_readfirstlane(tid >> 6); \
    const Args* A = kargs_opaque(); unsigned char* ws = A->ws; const int G = gridDim.x, bx = blockIdx.x; \
    const int vcu = (G % 8 == 0) ? (bx % 8) * (G / 8) + bx / 8 : bx; const int gw = vcu * NWAVES + wave, NGW = G * NWAVES; \
    LAS unsigned char* wl = lds + wave * WAVE_LDS; (void)gw; (void)NGW; (void)wl; (void)lane; (void)ws
#ifndef PH_MASK
#define PH_MASK 0xFFFFFFFFu
#endif
#define EN(j) (((PH_MASK) >> (j)) & 1u)
__global__ void __launch_bounds__(NWAVES * 64, 2) fwd_kernel(Args args) {
    extern __shared__ __attribute__((aligned(16))) unsigned char lds_raw[];
    LAS unsigned char* lds = (LAS unsigned char*)lds_raw;
    volatile LAS unsigned* MISC = (volatile LAS unsigned*)(lds + MISC_OFF);
    for (int u = threadIdx.x; u < (LDS_BYTES - LDSCTL_OFF) / 4; u += NWAVES * 64) ((LAS unsigned*)(lds + LDSCTL_OFF))[u] = 0u;
    __syncthreads();
    const int lo = args.ph_lo, hi = args.ph_hi;
    XcdBarrier bar; bar.bar = (unsigned*)(args.ws + WS_CTL) + CW_BAR; bar.x = 0; bar.st = nullptr;
    if (hi - lo > 1) bar = xcd_barrier_post((unsigned*)(args.ws + WS_CTL) + CW_BAR, MISC + 8);
#define IN(k) (lo <= (k) && (k) < hi)
#define SEAM(k) do { if (IN((k) + 1)) xcd_barrier(bar); } while (0)
    if (EN(0) && IN(0)) { PHASE_REGS(); phase_p0(A->in, ws, wl, gw, NGW, lane); SEAM(0); }
    if (EN(1) && IN(1)) { PHASE_REGS(); phase_a0(A->in, ws, lds, G, tid, wave, lane); SEAM(1); }
    for (int l = 0; l < 2; ++l) {
        const int base = 2 + 10 * l; const bool upd = (l == 0);
        if (EN(2) && IN(base + 0)) {
            PHASE_REGS();
            pg8::Gemm g{(const bf16_t*)(ws + WS_H), (const bf16_t*)(ws + WS_WIN) + (size_t)l * PP * 1024, MT, PP, 1024}; pg8::StaticOrder S; S.init(MT, PP, G, bx);
            pg8::EpiProj E{(bf16_t*)(ws + WS_R1), PP, (const pg8::f32x2*)(ws + WS_TAB), ML};
            pg8::gemm_phase<pg8::EpiProj, pg8::StaticOrder, true, true>(lds, g, S, E);
            SEAM(base + 0);
        }
        if (EN(3) && IN(base + 1)) {
            PHASE_REGS();
            const bf16_t* PROJ = (const bf16_t*)(ws + WS_R1); bf16_t* MIX = (bf16_t*)(ws + WS_R2);
            const float* a_up = A->in[9] + (size_t)l * 2 * 16 * 128; const float* a_bias = A->in[10] + (size_t)l * 2 * 128;
            const float* rpb = A->in[12] + (size_t)l * 4 * 465; const float* sink = A->in[13] + (size_t)l * 8;
            const int n_swa = 4096, n_nat = 2048, n_gla = 1152, n_cn = upd ? 256 : 0, n_cs = upd ? 512 : 0;
            const int total = n_swa + n_nat + n_gla + n_cn + n_cs;
            for (int it = gw; it < total; it += NGW) {
                int r = it;
                if (r < n_swa) { attn_item<1>(PROJ, MIX, r, wl, lane, rpb, sink); continue; } r -= n_swa;
                if (r < n_nat) { attn_item<0>(PROJ, MIX, r, wl, lane, rpb, sink); continue; } r -= n_nat;
                if (r < n_gla) { gla_local_item(PROJ, (float*)(ws + WS_UST), (float*)(ws + WS_DEC), r, wl, lane, a_up, a_bias); continue; } r -= n_gla;
                if (r < n_cn) { attn_item<2>(PROJ, MIX, r, wl, lane, rpb, sink); continue; } r -= n_cn;
                attn_item<3>(PROJ, MIX, r, wl, lane, rpb, sink);
            }
            SEAM(base + 1);
        }
        if (EN(4) && IN(base + 2)) {
            PHASE_REGS();
            for (int gid = bx * (NWAVES * 64) + tid; gid < 64 * 2048; gid += G * NWAVES * 64) gla_prefix((float*)(ws + WS_UST), (const float*)(ws + WS_DEC), gid);
            SEAM(base + 2);
        }
        if (EN(5) && IN(base + 3)) {
            PHASE_REGS();
            const float* a_up = A->in[9] + (size_t)l * 2 * 16 * 128; const float* a_bias = A->in[10] + (size_t)l * 2 * 128; const float* gnorm = A->in[11] + (size_t)l * 64;
            for (int it = gw; it < 1152; it += NGW) { if (!upd && (it % 36) < 4) continue;
                gla_out_item((const bf16_t*)(ws + WS_R1), (const float*)(ws + WS_UST), (bf16_t*)(ws + WS_R2), it, wl, lane, a_up, a_bias, gnorm); }
            SEAM(base + 3);
        }
        if (EN(6) && IN(base + 4)) {
            PHASE_REGS();
            const int M2 = upd ? MT : ML;
            pg8::Gemm g{(const bf16_t*)(ws + WS_R2), (const bf16_t*)(ws + WS_WOUT) + (size_t)l * 1024 * 1024, M2, 1024, 1024}; pg8::StaticOrder S; S.init(M2, 1024, G, bx);
            pg8::EpiStore E{(bf16_t*)(ws + WS_R2 + (size_t)MT * 2048), 1024};
            pg8::gemm_phase<pg8::EpiStore, pg8::StaticOrder, true, true>(lds, g, S, E);
            SEAM(base + 4);
        }
        if (EN(7) && IN(base + 5)) { PHASE_REGS(); phase_r1(A->in, A->out, ws, lds, l, upd, G, tid, wave, lane); SEAM(base + 5); }
        if (EN(8) && IN(base + 6)) {
            PHASE_REGS();
            const int n_lat = 8 * 16 * 32, n_ctx = upd ? 8 * 16 * 4 : 0;
            for (int it = gw; it < n_lat + n_ctx; it += NGW) { if (it < n_lat) topk_item<false>(ws, it, wl, lane); else topk_item<true>(ws, it - n_lat, wl, lane); }
            SEAM(base + 6);
        }
        if (EN(9) && IN(base + 7)) {
            PHASE_REGS();
            pg8::Gemm g{(const bf16_t*)(ws + WS_R1), (const bf16_t*)(ws + WS_WGU) + (size_t)l * 16 * 2048 * 1024, 0, 0, 1024}; pg8::MoeOrder S; S.init(upd ? 9 : 8, 8, G, bx);
            pg8::EpiSwiGLU E{(bf16_t*)(ws + WS_R2), 1024};
            pg8::gemm_phase<pg8::EpiSwiGLU, pg8::MoeOrder, true, true>(lds, g, S, E);
            SEAM(base + 7);
        }
        if (EN(10) && IN(base + 8)) {
            PHASE_REGS();
            pg8::Gemm g{(const bf16_t*)(ws + WS_R2), (const bf16_t*)(ws + WS_WD) + (size_t)l * 16 * 1024 * 1024, 0, 0, 1024}; pg8::MoeOrder S; S.init(upd ? 9 : 8, 4, G, bx);
            pg8::EpiStore E{(bf16_t*)(ws + WS_R1), 1024};
            pg8::gemm_phase<pg8::EpiStore, pg8::MoeOrder, true, true>(lds, g, S, E);
            SEAM(base + 8);
        }
        if (EN(11) && IN(base + 9)) { PHASE_REGS(); phase_r5(A->in, A->out, ws, lds, l, upd, G, tid, wave, lane); SEAM(base + 9); }
    }
#undef IN
#undef SEAM
}

extern "C" void kernel_launch(void* const* d_in, const int* in_sizes, int n_in, void* d_out, int out_size, void* d_ws, size_t ws_size, hipStream_t stream) {
    static int grid = 0;
    if (grid == 0) {
        if (n_in != 18 || out_size != ML * DM || ws_size < WS_END) { fprintf(stderr, "kernel_launch: unexpected sizes: n_in %d out %d ws %zu (need %zu)\n", n_in, out_size, ws_size, (size_t)WS_END); grid = -1; return; }
        int dev = 0, cus = 0, per_cu = 0;
        if (hipGetDevice(&dev) != hipSuccess || hipDeviceGetAttribute(&cus, hipDeviceAttributeMultiprocessorCount, dev) != hipSuccess) { grid = -1; return; }
        if (hipFuncSetAttribute((const void*)fwd_kernel, hipFuncAttributeMaxDynamicSharedMemorySize, LDS_BYTES) != hipSuccess) { fprintf(stderr, "kernel_launch: hipFuncSetAttribute failed\n"); grid = -1; return; }
        if (hipOccupancyMaxActiveBlocksPerMultiprocessor(&per_cu, (const void*)fwd_kernel, NWAVES * 64, LDS_BYTES) != hipSuccess || per_cu < 1) { fprintf(stderr, "kernel_launch: occupancy query says %d blocks per CU\n", per_cu); (void)hipGetLastError(); grid = -1; return; }
        grid = cus;
    }
    if (grid < 0) return;
    (void)hipMemsetAsync((char*)d_ws + WS_CTL, 0, CTL_ZERO_BYTES, stream);
    Args a{};
    for (int i = 0; i < 18; ++i) a.in[i] = (const float*)d_in[i];
    a.out = (float*)d_out; a.ws = (unsigned char*)d_ws;
#if MK_PER_PHASE
    for (int p = 0; p < N_PHASES; ++p) { a.ph_lo = p; a.ph_hi = p + 1; hipLaunchKernelGGL(fwd_kernel, dim3(grid), dim3(NWAVES * 64), LDS_BYTES, stream, a); }
#else
    a.ph_lo = 0; a.ph_hi = N_PHASES;
    void* kargs[] = {&a};
    hipError_t e = hipLaunchCooperativeKernel((const void*)fwd_kernel, dim3(grid), dim3(NWAVES * 64), kargs, LDS_BYTES, stream);
    if (e != hipSuccess) fprintf(stderr, "kernel_launch: cooperative launch failed: %s (grid %d)\n", hipGetErrorString(e), grid);
#endif
}
```

```cpp
#include <hip/hip_runtime.h>
#include <cstdio>
#include <cstdint>
#include <cmath>

namespace pg8 {
#define PG8_LAS __attribute__((address_space(3)))
typedef unsigned short bf16_t;
typedef short bf16x8 __attribute__((ext_vector_type(8)));
typedef float f32x4 __attribute__((ext_vector_type(4)));
typedef unsigned u32x4 __attribute__((ext_vector_type(4)));
constexpr int BM = 256, BK = 64, HALF = 128, HTB = HALF * BK * 2  , STAGE_BYTES = 8 * HTB, NXCD = 8, WGM = 8;

__host__ __device__ __forceinline__ int lds_byte(int r, int c) { const int st = (r >> 4) * 2 + (c >> 5), rr = r & 15, cc = c & 31, ob = rr * 64 + cc * 2; return st * 1024 + (ob ^ (((ob >> 9) & 1) << 5)); }
__host__ __device__ __forceinline__ void stage_rc(int b, int& R, int& C) { const int st = b / 1024, sb = b % 1024, swz = sb ^ (((sb >> 9) & 1) << 5); R = (st >> 1) * 16 + swz / 64; C = (st & 1) * 32 + (swz % 64) / 2; }
__host__ __device__ __forceinline__ int perm32(int rho) { const int n = rho >> 4, i = rho & 15; return 8 * (i >> 2) + 4 * n + (i & 3); }

struct Unit { int pm, pn, pb; };
struct Gemm { const bf16_t* A; const bf16_t* Bt; int M, N, K; };

struct StaticOrder {
    int nM, nN, nwg, G, c;
    __host__ __device__ void init(int M, int N, int G_, int c_) { nM = M / BM; nN = N / BM; nwg = nM * nN; G = G_; c = c_; }
    __host__ __device__ bool next(int i, Unit& u) const {
        const long L = (long)i * G + c; if (L >= nwg) return false;
        int wgid = (int)L; { const int q = nwg / NXCD, r = nwg % NXCD, xcd = wgid % NXCD, off = wgid / NXCD; wgid = (xcd < r ? xcd * (q + 1) : r * (q + 1) + (xcd - r) * q) + off; }
        const int nig = WGM * nN, gid = wgid / nig, fm = gid * WGM, gsz = (nM - fm) < WGM ? (nM - fm) : WGM;
        u.pm = fm + ((wgid % nig) % gsz); u.pn = (wgid % nig) / gsz; u.pb = u.pn; return true;
    }
    __device__ __forceinline__ void a_ready(const Unit&) const {}
    __device__ __forceinline__ void done(const Unit&) const {}
};

__device__ __forceinline__ unsigned cvt_pk_bf16(float lo, float hi) { unsigned r; asm volatile("v_cvt_pk_bf16_f32 %0, %1, %2" : "=v"(r) : "v"(lo), "v"(hi)); return r; }
typedef float f32x2 __attribute__((ext_vector_type(2)));
struct EpiStore {
    static constexpr bool PERM = true, AFTER_DRAIN = false;
    bf16_t* O; int ldc;
    __device__ __forceinline__ void operator()(const f32x4 (&acc)[2][2][4][2], const Unit& u, int wr, int wc, int fr, int fq) const {
        const int row0 = u.pm * BM + wr * 64 + fr, col0 = u.pn * BM + wc * 32 + 8 * fq;
#pragma unroll
        for (int ai = 0; ai < 2; ++ai)
#pragma unroll
            for (int m = 0; m < 4; ++m) { bf16_t* rowp = O + (size_t)(row0 + ai * HALF + m * 16) * ldc + col0;
#pragma unroll
                for (int bj = 0; bj < 2; ++bj) { const f32x4 v0 = acc[ai][bj][m][0], v1 = acc[ai][bj][m][1];
                    u32x4 w; w.x = cvt_pk_bf16(v0[0], v0[1]); w.y = cvt_pk_bf16(v0[2], v0[3]); w.z = cvt_pk_bf16(v1[0], v1[1]); w.w = cvt_pk_bf16(v1[2], v1[3]);
                    *(u32x4*)(rowp + bj * HALF) = w; } }
    }
};
struct EpiProj {
    static constexpr bool PERM = true, AFTER_DRAIN = false;
    bf16_t* O; int ldc; const f32x2* tab; int ml;
    __device__ __forceinline__ void operator()(const f32x4 (&acc)[2][2][4][2], const Unit& u, int wr, int wc, int fr, int fq) const {
        const int row0 = u.pm * BM + wr * 64 + fr;
        const bool latent = (u.pm * BM) < ml;
#pragma unroll
        for (int bj = 0; bj < 2; ++bj) {
            const int c0 = u.pn * BM + bj * HALF + wc * 32;
            const bool rope = latent && ((c0 >= 928 && c0 < 1056) || (c0 >= 1824 && c0 < 2336));
            const bool rowhalf = (((c0 - 32) & 63) == 0);
            const bool qscale = (c0 >= 1568 && c0 < 2336);
#pragma unroll
            for (int ai = 0; ai < 2; ++ai)
#pragma unroll
                for (int m = 0; m < 4; ++m) {
                    const int row = row0 + ai * HALF + m * 16;
                    f32x4 v0 = acc[ai][bj][m][0], v1 = acc[ai][bj][m][1];
                    if (rope) {
                        const int t = row & 2047, pos = rowhalf ? (t >> 6) : (t & 63);
                        const f32x2* tp = tab + pos * 16 + 8 * (fq & 1);
                        const float sg = (fq < 2) ? -1.f : 1.f;
#pragma unroll
                        for (int e = 0; e < 4; ++e) {
                            const float x0 = v0[e], x1 = v1[e];
                            const float p0 = __shfl_xor(x0, 32), p1 = __shfl_xor(x1, 32);
                            const f32x2 c0s = tp[e], c1s = tp[4 + e];
                            v0[e] = x0 * c0s.x + sg * p0 * c0s.y; v1[e] = x1 * c1s.x + sg * p1 * c1s.y;
                        }
                    }
                    if (qscale) { v0 = v0 * 0.18033688011112042f; v1 = v1 * 0.18033688011112042f; }
                    u32x4 w; w.x = cvt_pk_bf16(v0[0], v0[1]); w.y = cvt_pk_bf16(v0[2], v0[3]); w.z = cvt_pk_bf16(v1[0], v1[1]); w.w = cvt_pk_bf16(v1[2], v1[3]);
                    *(u32x4*)(O + (size_t)row * ldc + c0 + 8 * fq) = w;
                }
        }
    }
};
struct EpiSwiGLU {
    static constexpr bool PERM = true, AFTER_DRAIN = false;
    bf16_t* O; int ldc;
    __device__ __forceinline__ void operator()(const f32x4 (&acc)[2][2][4][2], const Unit& u, int wr, int wc, int fr, int fq) const {
        const int row0 = u.pm * BM + wr * 64 + fr, col0 = u.pn * HALF + wc * 32 + 8 * fq;
#pragma unroll
        for (int ai = 0; ai < 2; ++ai)
#pragma unroll
            for (int m = 0; m < 4; ++m) {
                float h[8];
#pragma unroll
                for (int n = 0; n < 2; ++n)
#pragma unroll
                    for (int e = 0; e < 4; ++e) { const float g = acc[ai][0][m][n][e], up = acc[ai][1][m][n][e];
                        h[n * 4 + e] = g * __builtin_amdgcn_rcpf(1.f + __builtin_amdgcn_exp2f(-1.4426950408889634f * g)) * up; }
                u32x4 w; w.x = cvt_pk_bf16(h[0], h[1]); w.y = cvt_pk_bf16(h[2], h[3]); w.z = cvt_pk_bf16(h[4], h[5]); w.w = cvt_pk_bf16(h[6], h[7]);
                *(u32x4*)(O + (size_t)(row0 + ai * HALF + m * 16) * ldc + col0) = w;
            }
    }
};
struct MoeOrder {
    int npe, nN, nwg, G, c;
    __host__ __device__ void init(int npe_, int nN_, int G_, int c_) { npe = npe_; nN = nN_; nwg = 16 * npe * nN; G = G_; c = c_; }
    __host__ __device__ bool next(int i, Unit& u) const {
        const long L = (long)i * G + c; if (L >= nwg) return false;
        int wgid = (int)L; { const int q = nwg / NXCD, r = nwg % NXCD, xcd = wgid % NXCD, off = wgid / NXCD; wgid = (xcd < r ? xcd * (q + 1) : r * (q + 1) + (xcd - r) * q) + off; }
        const int per = npe * nN, e = wgid / per, rem = wgid % per, j = rem / nN, pn = rem % nN;
        u.pm = (j < 8) ? (j * 16 + e) : (128 + e); u.pn = pn; u.pb = e * nN + pn; return true;
    }
    __device__ __forceinline__ void a_ready(const Unit&) const {}
    __device__ __forceinline__ void done(const Unit&) const {}
};

template <class Epi, class Sched, bool ALIGN_EPI = false, bool SP2 = false>
__device__ __forceinline__ void gemm_phase(PG8_LAS unsigned char* lds, const Gemm g, const Sched& S, const Epi& E) {
    int tid_ = threadIdx.x; asm volatile("" : "+v"(tid_));
    const int tid = tid_, wid = __builtin_amdgcn_readfirstlane(tid >> 6), lane = tid & 63, wr = wid >> 2, wc = wid & 3, fr = lane & 15, fq = lane >> 4;
    const int K = g.K, nt = K / BK;
    unsigned voffA[2], voffB[2];
#pragma unroll
    for (int i = 0; i < 2; ++i) { int R, C; stage_rc(tid * 16 + i * 8192, R, C); const int Rb = Epi::PERM ? ((R & ~31) + perm32(R & 31)) : R;
        voffA[i] = (unsigned)(R * K + C) * 2u; voffB[i] = (unsigned)(Rb * K + C) * 2u; }
    const size_t kstep = (size_t)(BK * 2);
    const size_t hstep = (size_t)HALF * K * 2;
    const size_t tstep = 2 * hstep;
    const unsigned ldsw = (unsigned)wid * 1024u;
    const int aoff = lds_byte(wr * 64 + fr, fq * 8), boff = lds_byte(wc * 32 + fr, fq * 8);
#define PG8_SA(b, h) (((b) * 2 + (h)) * HTB)
#define PG8_SB(b, h) ((4 + (b) * 2 + (h)) * HTB)
#define PG8_STAGE(bufoff, gbase, voff) do { _Pragma("unroll") for (int _i = 0; _i < 2; ++_i) \
        __builtin_amdgcn_global_load_lds((const unsigned*)((const char*)(gbase) + (voff)[_i]), (PG8_LAS unsigned*)(lds + (bufoff) + ldsw + _i * 8192), 16, 0, 0); } while (0)
#define PG8_LDA(dst, b, h) do { _Pragma("unroll") for (int m = 0; m < 4; ++m) _Pragma("unroll") for (int k = 0; k < 2; ++k) dst[m][k] = *(const PG8_LAS bf16x8*)(lds + PG8_SA(b, h) + aoff + m * 2048 + k * 1024); } while (0)
#define PG8_LDB(dst, b, h) do { _Pragma("unroll") for (int n = 0; n < 2; ++n) _Pragma("unroll") for (int k = 0; k < 2; ++k) dst[n][k] = *(const PG8_LAS bf16x8*)(lds + PG8_SB(b, h) + boff + n * 2048 + k * 1024); } while (0)
#define PG8_MMA(ai, bj, At, Bt) do { __builtin_amdgcn_s_setprio(1); _Pragma("unroll") for (int m = 0; m < 4; ++m) _Pragma("unroll") for (int n = 0; n < 2; ++n) _Pragma("unroll") for (int k = 0; k < 2; ++k) \
        acc[ai][bj][m][n] = __builtin_amdgcn_mfma_f32_16x16x32_bf16(Bt[n][k], At[m][k], acc[ai][bj][m][n], 0, 0, 0); __builtin_amdgcn_s_setprio(0); } while (0)
#define PG8_WAIT_V(n) asm volatile("s_waitcnt vmcnt(" #n ")" ::: "memory")
#define PG8_WAIT_L(n) asm volatile("s_waitcnt lgkmcnt(" #n ")" ::: "memory")
#define PG8_BAR __builtin_amdgcn_s_barrier()
#define PG8_SCHED __builtin_amdgcn_sched_barrier(0)
    Unit cur, nxt; int ui = 0;
    if (!S.next(0, cur)) return;
    f32x4 acc[2][2][4][2];
#pragma unroll
    for (int a = 0; a < 2; ++a)
#pragma unroll
        for (int b = 0; b < 2; ++b)
#pragma unroll
            for (int m = 0; m < 4; ++m)
#pragma unroll
                for (int n = 0; n < 2; ++n) acc[a][b][m][n] = (f32x4){0.f, 0.f, 0.f, 0.f};
    bf16x8 At[4][2], B0[2][2], B1[2][2];
    const char* cA = (const char*)g.A + (size_t)cur.pm * tstep; const char* cB = (const char*)g.Bt + (size_t)cur.pb * tstep;
    S.a_ready(cur);
    if constexpr (SP2) {
        PG8_STAGE(PG8_SB(0, 0), cB, voffB); PG8_STAGE(PG8_SB(0, 1), cB + hstep, voffB); PG8_STAGE(PG8_SA(0, 0), cA, voffA); PG8_STAGE(PG8_SA(0, 1), cA + hstep, voffA);
        if (wr == 1) PG8_BAR;
        PG8_WAIT_V(2); PG8_BAR;
        PG8_STAGE(PG8_SB(1, 0), cB + kstep, voffB); PG8_STAGE(PG8_SA(1, 0), cA + kstep, voffA); PG8_STAGE(PG8_SB(1, 1), cB + hstep + kstep, voffB);
        PG8_WAIT_V(6); PG8_BAR;
    } else {
        PG8_STAGE(PG8_SB(0, 0), cB, voffB); PG8_STAGE(PG8_SA(0, 0), cA, voffA); PG8_STAGE(PG8_SB(0, 1), cB + hstep, voffB); PG8_STAGE(PG8_SA(0, 1), cA + hstep, voffA);
        if (wr == 1) PG8_BAR;
        PG8_WAIT_V(4); PG8_BAR;
        PG8_STAGE(PG8_SB(1, 0), cB + kstep, voffB); PG8_STAGE(PG8_SA(1, 0), cA + kstep, voffA); PG8_STAGE(PG8_SB(1, 1), cB + hstep + kstep, voffB);
        PG8_WAIT_V(6); PG8_BAR;
    }
    for (;;) {
        const bool has_next = S.next(ui + 1, nxt);
        const char* nA = has_next ? (const char*)g.A + (size_t)nxt.pm * tstep : cA; const char* nB = has_next ? (const char*)g.Bt + (size_t)nxt.pb * tstep : cB;
        for (int t = 0; t < nt; t += 2) {
            const bool last = (t == nt - 2);
            const char* a1 = cA + (size_t)(t + 1) * kstep;
            const char* a2 = last ? nA : cA + (size_t)(t + 2) * kstep; const char* b2 = last ? nB : cB + (size_t)(t + 2) * kstep;
            const char* a3 = a2 + kstep; const char* b3 = b2 + kstep;
            if (last && has_next) S.a_ready(nxt);
            if constexpr (SP2) {
            PG8_LDB(B0, 0, 0); PG8_LDB(B1, 0, 1); PG8_SCHED; PG8_LDA(At, 0, 0); PG8_STAGE(PG8_SA(1, 1), a1 + hstep, voffA);
            PG8_WAIT_V(8); PG8_WAIT_L(0); PG8_BAR; PG8_MMA(0, 0, At, B0); PG8_MMA(0, 1, At, B1); PG8_BAR; PG8_SCHED;
            PG8_LDA(At, 0, 1); PG8_STAGE(PG8_SB(0, 0), b2, voffB); PG8_STAGE(PG8_SB(0, 1), b2 + hstep, voffB); PG8_STAGE(PG8_SA(0, 0), a2, voffA);
            PG8_WAIT_V(8); PG8_WAIT_L(0); PG8_BAR; PG8_MMA(1, 0, At, B0); PG8_MMA(1, 1, At, B1); PG8_BAR; PG8_SCHED;
            PG8_LDB(B0, 1, 0); PG8_LDB(B1, 1, 1); PG8_SCHED; PG8_LDA(At, 1, 0); PG8_STAGE(PG8_SA(0, 1), a2 + hstep, voffA);
            PG8_WAIT_V(8); PG8_WAIT_L(0); PG8_BAR; PG8_MMA(0, 0, At, B0); PG8_MMA(0, 1, At, B1); PG8_BAR; PG8_SCHED;
            PG8_LDA(At, 1, 1); PG8_STAGE(PG8_SB(1, 0), b3, voffB); PG8_STAGE(PG8_SB(1, 1), b3 + hstep, voffB); PG8_STAGE(PG8_SA(1, 0), a3, voffA);
            PG8_WAIT_V(8); PG8_WAIT_L(0); PG8_BAR; PG8_MMA(1, 0, At, B0); PG8_MMA(1, 1, At, B1); PG8_BAR; PG8_SCHED;
            } else {
            PG8_LDB(B0, 0, 0); PG8_SCHED; PG8_LDA(At, 0, 0); PG8_STAGE(PG8_SA(1, 1), a1 + hstep, voffA);
            PG8_WAIT_L(8); PG8_BAR; PG8_WAIT_L(0); PG8_MMA(0, 0, At, B0); PG8_BAR; PG8_SCHED;
            PG8_LDB(B1, 0, 1); PG8_STAGE(PG8_SB(0, 0), b2, voffB);
            PG8_BAR; PG8_WAIT_L(0); PG8_MMA(0, 1, At, B1); PG8_BAR;
            PG8_LDA(At, 0, 1); PG8_STAGE(PG8_SA(0, 0), a2, voffA);
            PG8_BAR; PG8_WAIT_L(0); PG8_MMA(1, 0, At, B0); PG8_BAR; PG8_SCHED;
            PG8_STAGE(PG8_SB(0, 1), b2 + hstep, voffB);
            PG8_WAIT_V(6); PG8_BAR; PG8_MMA(1, 1, At, B1); PG8_BAR;
            PG8_LDB(B0, 1, 0); PG8_SCHED; PG8_LDA(At, 1, 0); PG8_STAGE(PG8_SA(0, 1), a2 + hstep, voffA);
            PG8_WAIT_L(8); PG8_BAR; PG8_WAIT_L(0); PG8_MMA(0, 0, At, B0); PG8_BAR; PG8_SCHED;
            PG8_LDB(B1, 1, 1); PG8_STAGE(PG8_SB(1, 0), b3, voffB);
            PG8_BAR; PG8_WAIT_L(0); PG8_MMA(0, 1, At, B1); PG8_BAR;
            PG8_LDA(At, 1, 1); PG8_STAGE(PG8_SA(1, 0), a3, voffA);
            PG8_BAR; PG8_WAIT_L(0); PG8_MMA(1, 0, At, B0); PG8_BAR; PG8_SCHED;
            PG8_STAGE(PG8_SB(1, 1), b3 + hstep, voffB);
            PG8_WAIT_V(6); PG8_BAR; PG8_MMA(1, 1, At, B1); PG8_BAR;
            }
        }
        if constexpr (ALIGN_EPI) { if (wr == 0) PG8_BAR; }
        if constexpr (!Epi::AFTER_DRAIN) { E(acc, cur, wr, wc, fr, fq); S.done(cur); }
        if (!has_next) break;
#pragma unroll
        for (int a = 0; a < 2; ++a)
#pragma unroll
            for (int b = 0; b < 2; ++b)
#pragma unroll
                for (int m = 0; m < 4; ++m)
#pragma unroll
                    for (int n = 0; n < 2; ++n) acc[a][b][m][n] = (f32x4){0.f, 0.f, 0.f, 0.f};
        cur = nxt; cA = nA; cB = nB; ++ui;
        if constexpr (ALIGN_EPI) { if (wr == 1) PG8_BAR; }
    }
    PG8_WAIT_V(0);
    if constexpr (!ALIGN_EPI) { if (wr == 0) PG8_BAR; }
    PG8_BAR;
    if constexpr (Epi::AFTER_DRAIN) { E.fused(acc, cur, wr, wc, fr, fq, lds, wid, lane); S.done(cur); }
#undef PG8_SA
#undef PG8_SB
#undef PG8_STAGE
#undef PG8_LDA
#undef PG8_LDB
#undef PG8_MMA
#undef PG8_WAIT_V
#undef PG8_WAIT_L
#undef PG8_BAR
#undef PG8_SCHED
}
}
constexpr int NB = 8, SEQ = 2048, DM = 1024, CTXL = 256, ML = NB * SEQ, MC = NB * CTXL, MT = ML + MC;
constexpr int PP = 2560;
constexpr int INW = 2336;
constexpr int C_GK = 0, C_GV = 128, C_GAF = 384, C_GAB = 400, C_NK = 416, C_NV = 672, C_SK = 928, C_SV = 1056, C_GQ = 1184, C_GG = 1312, C_NQ = 1568, C_SQ = 1824;
constexpr int NWAVES = 8;
constexpr float NEPS = 1e-6f;
constexpr float LOG2E = 1.4426950408889634f;

constexpr size_t MiB = 1u << 20;
constexpr size_t WS_CTL = 0, CTL_ZERO_BYTES = 1 * MiB;
constexpr size_t WS_TAB = 1 * MiB;
constexpr size_t WS_MOD = 1 * MiB + 65536;
constexpr size_t WS_MODP = 2 * MiB;
constexpr size_t WS_WIN = 6 * MiB;
constexpr size_t WS_WOUT = 16 * MiB;
constexpr size_t WS_WGU = 20 * MiB;
constexpr size_t WS_WD = 148 * MiB;
constexpr size_t WS_H = 212 * MiB;
constexpr size_t WS_R1 = 248 * MiB;
constexpr size_t WS_R2 = 338 * MiB;
constexpr size_t WS_XC = 410 * MiB;
constexpr size_t WS_UST = 418 * MiB;
constexpr size_t WS_MISC = 436 * MiB;
constexpr size_t WS_DEC = WS_MISC;
constexpr size_t WS_AFF = WS_MISC + 1 * MiB;
constexpr size_t WS_AFFC = WS_MISC + 2 * MiB;
constexpr size_t WS_GATE = WS_MISC + 2 * MiB + 262144;
constexpr size_t WS_GATEC = WS_MISC + 2 * MiB + 524288;
constexpr size_t WS_INV = WS_MISC + 3 * MiB;
constexpr size_t WS_END = 440 * MiB;
constexpr int CW_BAR = 4096;
constexpr int CW_QUEUE = 1024;

constexpr int WAVE_LDS = 19456;
constexpr int RING_BYTES = NWAVES * WAVE_LDS;
constexpr int LDSCTL_OFF = RING_BYTES, MISC_OFF = LDSCTL_OFF + 320;
constexpr int LDS_BYTES = RING_BYTES + 1024;
static_assert(RING_BYTES >= pg8::STAGE_BYTES && LDS_BYTES <= 163840, "LDS map");

#define GAS __attribute__((address_space(1)))
#define LAS __attribute__((address_space(3)))
typedef unsigned short bf16_t;
typedef unsigned v4u __attribute__((ext_vector_type(4)));
typedef unsigned v2u __attribute__((ext_vector_type(2)));
typedef float f32x4 __attribute__((ext_vector_type(4)));
typedef float f32x2 __attribute__((ext_vector_type(2)));
typedef float f32x16 __attribute__((ext_vector_type(16)));
typedef short bf16x8 __attribute__((ext_vector_type(8)));
typedef short s16x4 __attribute__((ext_vector_type(4)));
typedef GAS unsigned gu32;
#define RLX_AGENT __ATOMIC_RELAXED, __HIP_MEMORY_SCOPE_AGENT
typedef __bf16 bf16x2_t __attribute__((ext_vector_type(2)));
__device__ __forceinline__ unsigned pk2(float lo, float hi) { f32x2 v = {lo, hi}; bf16x2_t b = __builtin_convertvector(v, bf16x2_t); return __builtin_bit_cast(unsigned, b); }
__device__ __forceinline__ float bflo(unsigned w) { return __uint_as_float(w << 16); }
__device__ __forceinline__ float bfhi(unsigned w) { return __uint_as_float(w & 0xffff0000u); }
__device__ __forceinline__ float bf1(bf16_t w) { return __uint_as_float((unsigned)w << 16); }
__device__ __forceinline__ float wave_sum(float v) {
#pragma unroll
    for (int o = 1; o < 64; o <<= 1) v += __shfl_xor(v, o);
    return v;
}
__device__ __forceinline__ float fexp2(float x) { return __builtin_amdgcn_exp2f(x); }
__device__ __forceinline__ float fexp(float x) { return __builtin_amdgcn_exp2f(x * LOG2E); }
__device__ __forceinline__ float flog(float x) { return __builtin_amdgcn_logf(x) * 0.6931471805599453f; }
__device__ __forceinline__ float frcp(float x) { return __builtin_amdgcn_rcpf(x); }
__device__ __forceinline__ float silu_f(float x) { return x * frcp(1.f + fexp(-x)); }
__device__ __forceinline__ int crow(int r, int hi) { return (r & 3) + 8 * (r >> 2) + 4 * hi; }
__device__ __forceinline__ s16x4 tr_read(LAS const unsigned char* p) { return __builtin_bit_cast(s16x4, __builtin_amdgcn_ds_read_tr16_b64_v4i16((LAS s16x4*)p)); }
__device__ __forceinline__ bf16x8 cat4(s16x4 a, s16x4 b) { return (bf16x8){a[0], a[1], a[2], a[3], b[0], b[1], b[2], b[3]}; }
__device__ __forceinline__ bf16x8 pack8(float a0, float a1, float a2, float a3, float a4, float a5, float a6, float a7) {
    v4u w; w.x = pk2(a0, a1); w.y = pk2(a2, a3); w.z = pk2(a4, a5); w.w = pk2(a6, a7); return __builtin_bit_cast(bf16x8, w); }
#define MFMA32(a, b, c) __builtin_amdgcn_mfma_f32_32x32x16_bf16((a), (b), (c), 0, 0, 0)

#define XB_TMO      128
#define XB_XCNT(j)  (256  + 64 * (j))
#define XB_XSUB(j)  (1280 + 64 * (j))
#define XB_XGEN(j)  (2304 + 64 * (j))
#define XB_TOP      3328
#define XB_TOPGEN   3392
#define XCD_BAR_WORDS 3456
#define XB_SPIN_CAP (1u << 18)

__device__ __forceinline__ unsigned xb_ld(unsigned* p)              { return __hip_atomic_load(p, __ATOMIC_RELAXED, __HIP_MEMORY_SCOPE_AGENT); }
__device__ __forceinline__ unsigned xb_add(unsigned* p, unsigned v) { return __hip_atomic_fetch_add(p, v, __ATOMIC_RELAXED, __HIP_MEMORY_SCOPE_AGENT); }
__device__ __forceinline__ unsigned xb_xcc_id() { return (unsigned)__builtin_amdgcn_s_getreg((3 << 11) | 20) & 0xFu; }
#define XB_SPIN(cond, bar) do { unsigned _sp = 0; while (cond) { __builtin_amdgcn_s_sleep(1); \
    if ((++_sp & 255u) == 0u) { if (xb_ld(&(bar)[XB_TMO])) break; if (_sp > XB_SPIN_CAP) { atomicAdd(&(bar)[XB_TMO], 1u); break; } } } } while (0)

struct XcdBarrier {
    unsigned* bar; unsigned x;
    volatile LAS unsigned* st;
};

__device__ __forceinline__ XcdBarrier xcd_barrier_post(unsigned* bar, volatile LAS unsigned* st) {
    XcdBarrier b; b.bar = bar; b.x = xb_xcc_id(); b.st = st;
    if (threadIdx.x == 0) (void)xb_add(&bar[XB_XCNT(b.x)], 1u);
    return b;
}
__device__ __forceinline__ void xcd_barrier_complete(unsigned* bar, unsigned x, unsigned& nloc, unsigned& nx) {
    const unsigned G = gridDim.x * gridDim.y * gridDim.z;
    unsigned sum, cnt, mine, sp = 0u;
    for (;;) {
        sum = 0u; cnt = 0u; mine = 0u;
#pragma unroll
        for (unsigned j = 0; j < 16; ++j) { const unsigned c = xb_ld(&bar[XB_XCNT(j)]); sum += c; cnt += (c > 0u) ? 1u : 0u; mine = (j == x) ? c : mine; }
        if (sum == G) break;
        __builtin_amdgcn_s_sleep(1);
        if ((++sp & 255u) == 0u) { if (xb_ld(&bar[XB_TMO])) break; if (sp > XB_SPIN_CAP) { atomicAdd(&bar[XB_TMO], 1u); break; } }
    }
    nloc = mine > 0u ? mine : 1u; nx = cnt > 0u ? cnt : 1u;
}

__device__ __forceinline__ void xcd_barrier(const XcdBarrier& b) {
    asm volatile("s_waitcnt vmcnt(0)" ::: "memory");
    __syncthreads();
    if (threadIdx.x == 0) {
        unsigned* bar = b.bar;
        __builtin_amdgcn_s_waitcnt(0);
        unsigned nloc = b.st[0], nx = b.st[1];
        if (nloc == 0u) { xcd_barrier_complete(bar, b.x, nloc, nx); b.st[0] = nloc; b.st[1] = nx; }
        const unsigned old = xb_add(&bar[XB_XSUB(b.x)], 1u);
        const unsigned gen = old / nloc;
        if (old + 1u == (gen + 1u) * nloc) {
            __builtin_amdgcn_fence(__ATOMIC_RELEASE, "agent");
            asm volatile("s_waitcnt vmcnt(0)" ::: "memory");
            const unsigned og = xb_add(&bar[XB_TOP], 1u);
            const unsigned tg = og / nx;
            if (og + 1u == (tg + 1u) * nx) xb_add(&bar[XB_TOPGEN], 1u);
            else XB_SPIN(xb_ld(&bar[XB_TOPGEN]) == tg, bar);
            __builtin_amdgcn_fence(__ATOMIC_ACQUIRE, "agent");
            xb_add(&bar[XB_XGEN(b.x)], 1u);
            asm volatile("s_waitcnt vmcnt(0)" ::: "memory");
        } else {
            XB_SPIN(xb_ld(&bar[XB_XGEN(b.x)]) == gen, bar);
            __builtin_amdgcn_fence(__ATOMIC_ACQUIRE, "agent");
            asm volatile("s_waitcnt vmcnt(0)" ::: "memory");
        }
    }
    __syncthreads();
}
__device__ __forceinline__ void ld_row_f32(const float* p, int lane, f32x4 (&v)[4]) {
#pragma unroll
    for (int j = 0; j < 4; ++j) v[j] = *(const f32x4*)(p + 256 * j + 4 * lane);
}
__device__ __forceinline__ void st_row_f32(float* p, int lane, const f32x4 (&v)[4]) {
#pragma unroll
    for (int j = 0; j < 4; ++j) *(f32x4*)(p + 256 * j + 4 * lane) = v[j];
}
__device__ __forceinline__ void ld_row_bf16(const bf16_t* p, int lane, f32x4 (&v)[4]) {
#pragma unroll
    for (int j = 0; j < 4; ++j) { const v2u w = *(const v2u*)(p + 256 * j + 4 * lane); v[j] = (f32x4){bflo(w.x), bfhi(w.x), bflo(w.y), bfhi(w.y)}; }
}
__device__ __forceinline__ void st_row_bf16(bf16_t* p, int lane, const f32x4 (&v)[4]) {
#pragma unroll
    for (int j = 0; j < 4; ++j) { v2u w; w.x = pk2(v[j].x, v[j].y); w.y = pk2(v[j].z, v[j].w); *(v2u*)(p + 256 * j + 4 * lane) = w; }
}
__device__ __forceinline__ void ld_vec_lds(LAS const float* p, int lane, f32x4 (&v)[4]) {
#pragma unroll
    for (int j = 0; j < 4; ++j) v[j] = *(LAS const f32x4*)(p + 256 * j + 4 * lane);
}
__device__ __forceinline__ float sumsq16(const f32x4 (&v)[4]) {
    float s = 0.f;
#pragma unroll
    for (int j = 0; j < 4; ++j) s += (v[j].x * v[j].x + v[j].y * v[j].y) + (v[j].z * v[j].z + v[j].w * v[j].w);
    return s;
}
__device__ __forceinline__ float modfin(const float* modp, const float* bmod, int l, int r, int n) {
    float s = bmod[l * 6144 + n];
#pragma unroll
    for (int kc = 0; kc < 8; ++kc) s += modp[((size_t)(l * 8 + kc) * 9 + r) * 6144 + n];
    return s;
}

__device__ __forceinline__ void tr_item64(const float* W, int N, int Nvalid, bf16_t* WT, int Kd, int k0, int n0, int dst_row0, LAS float* scr, int lane) {
    const int q = lane & 15, kr = lane >> 4;
    f32x4 t[16];
#pragma unroll
    for (int i = 0; i < 16; ++i) { const int kk = 4 * i + kr; const int n = n0 + 4 * q;
        t[i] = (n < Nvalid) ? *(const f32x4*)(W + (size_t)(k0 + kk) * N + n) : (f32x4){0.f, 0.f, 0.f, 0.f}; }
#pragma unroll
    for (int i = 0; i < 16; ++i) { const int kk = 4 * i + kr; LAS float* d = scr + kk * 65 + 4 * q; d[0] = t[i].x; d[1] = t[i].y; d[2] = t[i].z; d[3] = t[i].w; }
    const int c = lane & 7, nl = lane >> 3;
#pragma unroll
    for (int j = 0; j < 8; ++j) { const int n = nl + 8 * j; LAS const float* s = scr + (8 * c) * 65 + n;
        v4u o; o.x = pk2(s[0 * 65], s[1 * 65]); o.y = pk2(s[2 * 65], s[3 * 65]); o.z = pk2(s[4 * 65], s[5 * 65]); o.w = pk2(s[6 * 65], s[7 * 65]);
        *(v4u*)(WT + (size_t)(dst_row0 + n) * Kd + k0 + 8 * c) = o; }
}
__device__ __forceinline__ void phase_p0(const float* const* in, unsigned char* ws, LAS unsigned char* wl, int gw, int NGW, int lane) {
    const float* cvec = in[1]; const float* cctx = in[3]; const float* wmod = in[4];
    const float* w_in = in[7]; const float* w_out = in[8]; const float* w_gate = in[15]; const float* w_up = in[16]; const float* w_down = in[17];
    float* modp = (float*)(ws + WS_MODP);
    constexpr int NI_MOD = 2 * 8 * 24, NI_ROPE = 16;
    constexpr int NI_IN = 16 * 40, NI_OUT = 16 * 16, NI_E = 16 * 16 * 16;
    constexpr int NI_L = NI_IN + NI_OUT + 3 * NI_E;
    constexpr int NITEMS = NI_MOD + NI_ROPE + 2 * NI_L;
    LAS float* scr = (LAS float*)wl;
    for (int it = gw; it < NITEMS; it += NGW) {
        int r = it;
        if (r < NI_MOD) {
            const int cb = r % 24, kc = (r / 24) & 7, l = r / 192;
            for (int idx = lane; idx < 128 * 9; idx += 64) { const int rr = idx / 128, k = idx % 128; const float cv = (rr < 8) ? cvec[rr * 1024 + kc * 128 + k] : cctx[kc * 128 + k]; scr[k * 12 + rr] = silu_f(cv); }
            f32x4 acc[9];
#pragma unroll
            for (int rr = 0; rr < 9; ++rr) acc[rr] = (f32x4){0.f, 0.f, 0.f, 0.f};
            const float* wp = wmod + ((size_t)l * 1024 + kc * 128) * 6144 + cb * 256 + 4 * lane;
#pragma unroll 4
            for (int k = 0; k < 128; ++k) { const f32x4 w = *(const f32x4*)(wp + (size_t)k * 6144);
                const f32x4 s0 = *(LAS const f32x4*)(scr + k * 12), s1 = *(LAS const f32x4*)(scr + k * 12 + 4); const float s8 = scr[k * 12 + 8];
                acc[0] += w * s0.x; acc[1] += w * s0.y; acc[2] += w * s0.z; acc[3] += w * s0.w; acc[4] += w * s1.x; acc[5] += w * s1.y; acc[6] += w * s1.z; acc[7] += w * s1.w; acc[8] += w * s8; }
#pragma unroll
            for (int rr = 0; rr < 9; ++rr) *(f32x4*)(modp + ((size_t)(l * 8 + kc) * 9 + rr) * 6144 + cb * 256 + 4 * lane) = acc[rr];
            continue;
        }
        r -= NI_MOD;
        if (r < NI_ROPE) {
            const int id = r * 64 + lane, pos = id >> 4, i = id & 15;
            const float fr = fexp2(-(float)i * (13.287712379549449f / 16.f));
            float rev = (float)pos * fr * 0.15915494309189535f; rev -= floorf(rev);
            f32x2 cs; cs.x = __builtin_amdgcn_cosf(rev); cs.y = __builtin_amdgcn_sinf(rev);
            ((f32x2*)(ws + WS_TAB))[id] = cs;
            continue;
        }
        r -= NI_ROPE;
        const int l = r / NI_L; r -= l * NI_L;
        if (r < NI_IN) { const int kb = r / 40, nb = r % 40;
            tr_item64(w_in + (size_t)l * 1024 * INW, INW, INW, (bf16_t*)(ws + WS_WIN) + (size_t)l * PP * 1024, 1024, 64 * kb, 64 * nb, 64 * nb, scr, lane); continue; }
        r -= NI_IN;
        if (r < NI_OUT) { const int kb = r / 16, nb = r % 16;
            tr_item64(w_out + (size_t)l * 1024 * 1024, 1024, 1024, (bf16_t*)(ws + WS_WOUT) + (size_t)l * 1024 * 1024, 1024, 64 * kb, 64 * nb, 64 * nb, scr, lane); continue; }
        r -= NI_OUT;
        const int which = r / NI_E; r -= which * NI_E;
        const int e = r / 256, kb = (r % 256) / 16, nb = r % 16, n0 = 64 * nb;
        const size_t eoff = (size_t)(l * 16 + e) * 1024 * 1024;
        if (which == 0) tr_item64(w_gate + eoff, 1024, 1024, (bf16_t*)(ws + WS_WGU) + 2 * eoff, 1024, 64 * kb, n0, (n0 >> 7) * 256 + (n0 & 127), scr, lane);
        else if (which == 1) tr_item64(w_up + eoff, 1024, 1024, (bf16_t*)(ws + WS_WGU) + 2 * eoff, 1024, 64 * kb, n0, (n0 >> 7) * 256 + 128 + (n0 & 127), scr, lane);
        else tr_item64(w_down + eoff, 1024, 1024, (bf16_t*)(ws + WS_WD) + eoff, 1024, 64 * kb, n0, n0, scr, lane);
    }
}

__device__ __forceinline__ void phase_a0(const float* const* in, unsigned char* ws, LAS unsigned char* lds, int G, int tid, int wave, int lane) {
    const float* x = in[0]; const float* ctx = in[2]; const float* bmod = in[5]; const float* gains = in[6];
    const float* modp = (const float*)(ws + WS_MODP); float* mod = (float*)(ws + WS_MOD); bf16_t* H = (bf16_t*)(ws + WS_H);
    LAS float* V = (LAS float*)lds;
    for (int row = blockIdx.x; row < 18; row += G) { const int l = row / 9, r = row % 9;
        for (int n = tid; n < 6144; n += 512) mod[(size_t)row * 6144 + n] = modfin(modp, bmod, l, r, n); }
    for (int t = blockIdx.x; t < 256; t += G) {
        const int b = t >> 5;
        __syncthreads();
        for (int n = tid; n < 1024; n += 512) { const float g = gains[n];
            V[n] = g * (1.f + modfin(modp, bmod, 0, b, 1024 + n)); V[1024 + n] = modfin(modp, bmod, 0, b, n);
            V[2048 + n] = g * (1.f + modfin(modp, bmod, 0, 8, 1024 + n)); V[3072 + n] = modfin(modp, bmod, 0, 8, n); }
        __syncthreads();
#pragma unroll 1
        for (int i0 = 0; i0 < 9; i0 += 3) {
            f32x4 xq[3][4];
#pragma unroll
            for (int k = 0; k < 3; ++k) { const int i = i0 + k; const bool isc = (i == 8);
                const float* src = isc ? (ctx + (size_t)(8 * t + wave) * 1024) : (x + (size_t)(64 * t + 8 * wave + i) * 1024); ld_row_f32(src, lane, xq[k]); }
#pragma unroll
            for (int k = 0; k < 3; ++k) { const int i = i0 + k; const bool isc = (i == 8);
                const int row = isc ? (ML + 8 * t + wave) : (64 * t + 8 * wave + i);
                f32x4 (&v)[4] = xq[k]; f32x4 a[4], s[4];
                const float rstd = __builtin_amdgcn_rsqf(wave_sum(sumsq16(v)) * (1.f / 1024.f) + NEPS);
                ld_vec_lds(V + (isc ? 2048 : 0), lane, a); ld_vec_lds(V + (isc ? 3072 : 1024), lane, s);
#pragma unroll
                for (int j = 0; j < 4; ++j) v[j] = v[j] * rstd * a[j] + s[j];
                st_row_bf16(H + (size_t)row * 1024, lane, v);
            }
        }
    }
}
constexpr int VP = 192;
struct AttnTile { f32x16 o0, o1; float m, lsum; };
__device__ __forceinline__ void attn_softmax(f32x16& s, AttnTile& T) {
    float bm = fmaxf(fmaxf(s[0], s[1]), fmaxf(s[2], s[3]));
#pragma unroll
    for (int i = 4; i < 16; i += 4) bm = fmaxf(bm, fmaxf(fmaxf(s[i], s[i + 1]), fmaxf(s[i + 2], s[i + 3])));
    bm = fmaxf(bm, __shfl_xor(bm, 32));
    const float mo = T.m, mn = fmaxf(mo, bm);
    T.m = mn;
    float ps = 0.f;
#pragma unroll
    for (int i = 0; i < 16; ++i) { s[i] = fexp2(s[i] - mn); ps += s[i]; }
    if (__any(mn != mo)) {
        const float alpha = fexp2(mo - mn);
        T.lsum *= alpha;
#pragma unroll
        for (int i = 0; i < 16; ++i) { T.o0[i] *= alpha; T.o1[i] *= alpha; }
    }
    T.lsum += ps;
}
__device__ __forceinline__ void attn_item(const int MODE, const bf16_t* P, bf16_t* MIX, int item, LAS unsigned char* wl, int lane,
                                          const float* __restrict__ rpb, const float* __restrict__ sink, const bool dry = false) {
    asm volatile("" : "+v"(lane));
    const int ql = lane & 31, hi = lane >> 5;
    int b, hq, qcol, kcol, vcol, ocol, qrow0, r = 0, rs = 0, q64 = 0, nloc, kb_lo = 0;
    if (MODE == 0) { r = item & 31; hq = (item >> 5) & 3; b = item >> 7;
        qcol = C_NQ + hq * 64; kcol = C_NK + hq * 64; vcol = C_NV + hq * 64; ocol = 256 + hq * 64; qrow0 = b * SEQ + r * 64;
        rs = r - 4; rs = rs < 0 ? 0 : (rs > 24 ? 24 : rs); nloc = 16; }
    else if (MODE == 1) { q64 = item & 31; hq = (item >> 5) & 7; b = item >> 8;
        qcol = C_SQ + hq * 64; kcol = C_SK + (hq >> 2) * 64; vcol = C_SV + (hq >> 2) * 64; ocol = 512 + hq * 64; qrow0 = b * SEQ + q64 * 64;
        kb_lo = 2 * q64 - 4; if (kb_lo < 0) kb_lo = 0; int kb_hi = 2 * q64 + 5; if (kb_hi > 63) kb_hi = 63; nloc = kb_hi - kb_lo + 1; }
    else if (MODE == 2) { q64 = item & 3; hq = (item >> 2) & 3; b = item >> 4;
        qcol = C_NQ + hq * 64; kcol = C_NK + hq * 64; vcol = C_NV + hq * 64; ocol = 256 + hq * 64; qrow0 = ML + b * CTXL + q64 * 64; nloc = 0; }
    else { q64 = item & 3; hq = (item >> 2) & 7; b = item >> 5;
        qcol = C_SQ + hq * 64; kcol = C_SK + (hq >> 2) * 64; vcol = C_SV + (hq >> 2) * 64; ocol = 512 + hq * 64; qrow0 = ML + b * CTXL + q64 * 64; nloc = 0; }
    const int nblk = 8 + nloc;
    LAS unsigned char* vl = wl;
    LAS float* rl = (LAS float*)(wl + 32 * VP);
    if (MODE == 0) { for (int i = lane; i < 465; i += 64) rl[i] = rpb[hq * 465 + i] * LOG2E; }
    LAS unsigned char* qimg = wl + 32 * VP + 1920;
    constexpr int QP = 144;
#pragma unroll
    for (int i = 0; i < 8; ++i) { const int c = lane + 64 * i; const v4u v = *(const v4u*)(P + (size_t)(qrow0 + (c >> 3)) * PP + qcol + (c & 7) * 8); *(LAS v4u*)(qimg + (c >> 3) * QP + (c & 7) * 16) = v; }
    LAS const unsigned char* qrd = qimg + ql * QP + 16 * hi;
    auto blk_row0 = [&](int blk) -> int {
        if (blk < 8) return ML + b * CTXL + blk * 32;
        const int lb = blk - 8;
        if (MODE == 0) return b * SEQ + (rs + (lb >> 1)) * 64 + (lb & 1) * 32;
        return b * SEQ + 32 * (kb_lo + lb);
    };
    auto load_blk = [&](int blk, bf16x8 (&kn)[4], v4u (&vn)[4]) {
        const int r0 = blk_row0(blk);
        const bf16_t* kp = P + (size_t)(r0 + ql) * PP + kcol + 8 * hi;
#pragma unroll
        for (int ds = 0; ds < 4; ++ds) kn[ds] = *(const bf16x8*)(kp + 16 * ds);
#pragma unroll
        for (int i = 0; i < 4; ++i) { const int c = lane + 64 * i; vn[i] = *(const v4u*)(P + (size_t)(r0 + (c >> 3)) * PP + vcol + (c & 7) * 8); }
    };
    AttnTile T[2];
#pragma unroll
    for (int t = 0; t < 2; ++t) { T[t].m = -INFINITY; T[t].lsum = 0.f;
#pragma unroll
        for (int i = 0; i < 16; ++i) { T[t].o0[i] = 0.f; T[t].o1[i] = 0.f; } }
    const int tr_off = (4 * hi + ((lane & 15) >> 2)) * VP + (16 * ((lane >> 4) & 1) + 4 * (lane & 3)) * 2;
    auto step = [&](int blk, bf16x8 (&kf)[4], v4u (&vr)[4]) {
#pragma unroll
        for (int i = 0; i < 4; ++i) { const int c = lane + 64 * i; *(LAS v4u*)(vl + (c >> 3) * VP + (c & 7) * 16) = vr[i]; }
        f32x16 sc[2];
#pragma unroll
        for (int t = 0; t < 2; ++t) {
#pragma unroll
            for (int i = 0; i < 16; ++i) sc[t][i] = 0.f;
#pragma unroll
            for (int ds = 0; ds < 4; ++ds) sc[t] = MFMA32(kf[ds], *(LAS const bf16x8*)(qrd + 32 * t * QP + 32 * ds), sc[t]);
        }
        if (blk + 2 < nblk) load_blk(blk + 2, kf, vr);
        bf16x8 vf[2][2];
#pragma unroll
        for (int ks = 0; ks < 2; ++ks) { LAS const unsigned char* vb = vl + tr_off + 16 * ks * VP;
            vf[ks][0] = cat4(tr_read(vb), tr_read(vb + 8 * VP)); vf[ks][1] = cat4(tr_read(vb + 64), tr_read(vb + 8 * VP + 64)); }
#pragma unroll
        for (int t = 0; t < 2; ++t) {
            f32x16& s = sc[t];
            if (MODE == 0 && blk >= 8) {
                const int lb = blk - 8, j = lb >> 1, ch = lb & 1, c = t * 32 + ql;
                int cs = c - 8; cs = cs < 0 ? 0 : (cs > 48 ? 48 : cs);
                LAS const float* rrow = rl + (rs + j - r + 7) * 31 + (15 - c);
#pragma unroll
                for (int i = 0; i < 16; ++i) { const int kc = ch * 32 + crow(i, hi); const bool ok = (kc >= cs) && (kc < cs + 16);
                    const float bias = rrow[ok ? kc : c];
                    s[i] = ok ? (s[i] + bias) : -INFINITY; }
            } else if (MODE == 1 && blk >= 8) {
                const int rel = (kb_lo + blk - 8) - (2 * q64 + t);
                if (rel <= -4 || rel >= 4) {
#pragma unroll
                    for (int i = 0; i < 16; ++i) { const int kk = crow(i, hi); const bool ok = (rel == -4) ? (kk >= ql) : ((rel == 4) ? (kk <= ql) : false);
                        s[i] = ok ? s[i] : -INFINITY; }
                }
            }
            attn_softmax(s, T[t]);
#pragma unroll
            for (int ks = 0; ks < 2; ++ks) {
                const bf16x8 pf = pack8(s[8 * ks + 0], s[8 * ks + 1], s[8 * ks + 2], s[8 * ks + 3], s[8 * ks + 4], s[8 * ks + 5], s[8 * ks + 6], s[8 * ks + 7]);
                T[t].o0 = MFMA32(vf[ks][0], pf, T[t].o0); T[t].o1 = MFMA32(vf[ks][1], pf, T[t].o1);
            }
            __builtin_amdgcn_sched_barrier(0);
        }
    };
    bf16x8 kA[4], kB[4]; v4u vA[4], vB[4];
    load_blk(0, kA, vA); load_blk(1, kB, vB);
    for (int blk = 0; blk < nblk; blk += 2) { step(blk, kA, vA); if (blk + 1 < nblk) step(blk + 1, kB, vB); }
#pragma unroll
    for (int t = 0; t < 2; ++t) {
        float lt = T[t].lsum + __shfl_xor(T[t].lsum, 32);
        if (MODE == 1 || MODE == 3) lt += fexp2(sink[hq] * LOG2E - T[t].m);
        const float inv = frcp(lt);
        bf16_t* op = MIX + (size_t)(qrow0 + 32 * t + ql) * 1024 + ocol + 4 * hi;
#pragma unroll
        for (int g = 0; g < 4; ++g) {
            v2u w0, w1; w0.x = pk2(T[t].o0[4 * g] * inv, T[t].o0[4 * g + 1] * inv); w0.y = pk2(T[t].o0[4 * g + 2] * inv, T[t].o0[4 * g + 3] * inv);
            w1.x = pk2(T[t].o1[4 * g] * inv, T[t].o1[4 * g + 1] * inv); w1.y = pk2(T[t].o1[4 * g + 2] * inv, T[t].o1[4 * g + 3] * inv);
            *(v2u*)(op + 8 * g) = w0; *(v2u*)(op + 32 + 8 * g) = w1;
        }
    }
}
constexpr int GP = 144;
constexpr int G_V = 0, G_A = 64 * GP, G_B = 64 * GP + 32 * GP;
static_assert(G_B + 32 * GP <= WAVE_LDS, "gla LDS");

struct GlaCum { float cum[2][16]; float tot; };
__device__ __forceinline__ void gla_cum(const bf16_t* P, int row0, int hh, int dir, const float* __restrict__ a_up, const float* __restrict__ a_bias, int lane, GlaCum& C) {
    const int kk = lane & 31, hi = lane >> 5;
    const float* up = a_up + (size_t)dir * 16 * 128 + (size_t)(8 * hi) * 128 + hh * 32 + kk;
    const bf16x8 ub = pack8(up[0], up[128], up[256], up[384], up[512], up[640], up[768], up[896]);
    const float bias = a_bias[dir * 128 + hh * 32 + kk];
    float gs[2][4];
#pragma unroll
    for (int tt = 0; tt < 2; ++tt) {
        const bf16x8 al = *(const bf16x8*)(P + (size_t)(row0 + 32 * tt + kk) * PP + C_GAF + 16 * dir + 8 * hi);
        f32x16 z;
#pragma unroll
        for (int i = 0; i < 16; ++i) z[i] = 0.f;
        z = MFMA32(al, ub, z);
#pragma unroll
        for (int g = 0; g < 4; ++g) { float run = 0.f;
#pragma unroll
            for (int e = 0; e < 4; ++e) { const float zz = z[4 * g + e] + bias; const float ls = fminf(zz, 0.f) - flog(1.f + fexp(-fabsf(zz)));
                const float l = ls * (1.f / 16.f);
                if (dir == 0) { run += l; C.cum[tt][4 * g + e] = run; } else { C.cum[tt][4 * g + e] = run; run += l; } }
            gs[tt][g] = run; }
    }
    float off = 0.f;
#pragma unroll
    for (int tt = 0; tt < 2; ++tt)
#pragma unroll
        for (int g = 0; g < 4; ++g) { const float other = __shfl_xor(gs[tt][g], 32); const float mine = off + (hi ? other : 0.f);
#pragma unroll
            for (int e = 0; e < 4; ++e) C.cum[tt][4 * g + e] += mine;
            off += gs[tt][g] + other; }
    C.tot = off;
    if (dir == 1) {
#pragma unroll
        for (int tt = 0; tt < 2; ++tt)
#pragma unroll
            for (int r = 0; r < 16; ++r) C.cum[tt][r] = off - C.cum[tt][r];
    }
}
__device__ __forceinline__ void gla_ld_tc(const bf16_t* P, int row0, int col, int lane, float (&x)[2][16]) {
    const int kk = lane & 31, hi = lane >> 5;
#pragma unroll
    for (int tt = 0; tt < 2; ++tt)
#pragma unroll
        for (int r = 0; r < 16; ++r) x[tt][r] = bf1(P[(size_t)(row0 + 32 * tt + crow(r, hi)) * PP + col + kk]);
}
__device__ __forceinline__ void gla_st_img(LAS unsigned char* img, int lane, const float (&x)[2][16]) {
    const int kk = lane & 31, hi = lane >> 5;
#pragma unroll
    for (int tt = 0; tt < 2; ++tt)
#pragma unroll
        for (int g = 0; g < 4; ++g) { v2u w; w.x = pk2(x[tt][4 * g], x[tt][4 * g + 1]); w.y = pk2(x[tt][4 * g + 2], x[tt][4 * g + 3]);
            *(LAS v2u*)(img + kk * GP + (32 * tt + 8 * g + 4 * hi) * 2) = w; }
}
__device__ __forceinline__ void gla_stage_v(const bf16_t* P, int row0, int hh, LAS unsigned char* wl, int lane) {
#pragma unroll
    for (int i = 0; i < 8; ++i) { const int c = lane + 64 * i; const v4u v = *(const v4u*)(P + (size_t)(row0 + (c >> 3)) * PP + C_GV + hh * 64 + (c & 7) * 8);
        *(LAS v4u*)(wl + G_V + (c >> 3) * GP + (c & 7) * 16) = v; }
}
__device__ __forceinline__ int gla_row0(int b, int nc) { return nc < 4 ? (ML + b * CTXL + 64 * nc) : (b * SEQ + 64 * (nc - 4)); }

__device__ __forceinline__ void gla_local_item(const bf16_t* P, float* UST, float* DEC, int item, LAS unsigned char* wl, int lane,
                                               const float* __restrict__ a_up, const float* __restrict__ a_bias) {
    asm volatile("" : "+v"(lane));
    const int nc = item % 36, hh = (item / 36) & 3, b = item / 144;
    const int row0 = gla_row0(b, nc), kk = lane & 31, hi = lane >> 5;
    gla_stage_v(P, row0, hh, wl, lane);
    float kv[2][16]; gla_ld_tc(P, row0, C_GK + hh * 32, lane, kv);
#pragma unroll
    for (int dir = 0; dir < 2; ++dir) {
        GlaCum C; gla_cum(P, row0, hh, dir, a_up, a_bias, lane, C);
        float kd[2][16];
#pragma unroll
        for (int tt = 0; tt < 2; ++tt)
#pragma unroll
            for (int r = 0; r < 16; ++r) kd[tt][r] = kv[tt][r] * fexp(C.tot - C.cum[tt][r]);
        gla_st_img(wl + (dir == 0 ? G_A : G_B), lane, kd);
        if (hi == 0) DEC[((size_t)((b * 4 + hh) * 2 + dir) * 36 + nc) * 32 + kk] = fexp(C.tot);
    }
    const int trv = ((lane & 15) >> 2) * GP + (16 * ((lane >> 4) & 1) + 4 * (lane & 3)) * 2;
#pragma unroll
    for (int dir = 0; dir < 2; ++dir) {
        f32x16 u0, u1;
#pragma unroll
        for (int i = 0; i < 16; ++i) { u0[i] = 0.f; u1[i] = 0.f; }
        LAS const unsigned char* img = wl + (dir == 0 ? G_A : G_B);
#pragma unroll
        for (int s = 0; s < 4; ++s) {
            const bf16x8 kb = *(LAS const bf16x8*)(img + kk * GP + (16 * s + 8 * hi) * 2);
            LAS const unsigned char* vb = wl + G_V + trv + (16 * s + 8 * hi) * GP;
            const bf16x8 v0 = cat4(tr_read(vb), tr_read(vb + 4 * GP));
            const bf16x8 v1 = cat4(tr_read(vb + 64), tr_read(vb + 4 * GP + 64));
            u0 = MFMA32(v0, kb, u0); u1 = MFMA32(v1, kb, u1);
        }
        float* up = UST + ((size_t)((b * 4 + hh) * 2 + dir) * 36 + nc) * 2048 + kk;
#pragma unroll
        for (int i = 0; i < 16; ++i) { up[(size_t)crow(i, hi) * 32] = u0[i]; up[(size_t)(32 + crow(i, hi)) * 32] = u1[i]; }
    }
}

__device__ __forceinline__ void gla_prefix(float* UST, const float* DEC, int gid, bool dry) {
    const int bhd = gid >> 11, e = gid & 2047, k = e & 31, dir = bhd & 1;
    float* base = UST + (size_t)bhd * 36 * 2048 + e; const float* dec = DEC + (size_t)bhd * 36 * 32 + k;
    float s = 0.f;
#pragma unroll 4
    for (int ci = 0; ci < 36; ++ci) {
        const int sl = dir == 0 ? ci : (ci < 4 ? 3 - ci : 39 - ci);
        const float u = base[(size_t)sl * 2048], d = dec[sl * 32];
        if (!dry) base[(size_t)sl * 2048] = s;
        s = d * s + u;
    }
}

__device__ __forceinline__ void gla_out_item(const bf16_t* P, const float* UST, bf16_t* MIX, int item, LAS unsigned char* wl, int lane,
                                             const float* __restrict__ a_up, const float* __restrict__ a_bias, const float* __restrict__ gnorm) {
    const int nc = item % 36, hh = (item / 36) & 3, b = item / 144;
    const int row0 = gla_row0(b, nc), kk = lane & 31, hi = lane >> 5;
    gla_stage_v(P, row0, hh, wl, lane);
    f32x16 o[2][2];
#pragma unroll
    for (int a = 0; a < 2; ++a)
#pragma unroll
        for (int c = 0; c < 2; ++c)
#pragma unroll
            for (int i = 0; i < 16; ++i) o[a][c][i] = 0.f;
    const int g16 = (lane >> 4) & 1, qq = (lane & 15) >> 2, pp = lane & 3;
    const int tri = (8 * hi + qq) * GP + (16 * g16 + 4 * pp) * 2;
    const int trv = (4 * hi + qq) * GP + (16 * g16 + 4 * pp) * 2;
#pragma unroll
    for (int dir = 0; dir < 2; ++dir) {
        GlaCum C; gla_cum(P, row0, hh, dir, a_up, a_bias, lane, C);
#pragma unroll
        for (int tt = 0; tt < 2; ++tt) {
            float cum[16];
#pragma unroll
            for (int r = 0; r < 16; ++r) cum[r] = C.cum[tt][r];
#pragma unroll
            for (int g = 0; g < 4; ++g) {
                float xq[4], xk[4];
#pragma unroll
                for (int e = 0; e < 4; ++e) { const size_t ro = (size_t)(row0 + 32 * tt + 8 * g + 4 * hi + e) * PP + hh * 32 + kk;
                    xq[e] = bf1(P[ro + C_GQ]) * 0.17677669529663687f * fexp(cum[4 * g + e]); xk[e] = bf1(P[ro + C_GK]) * fexp(-cum[4 * g + e]); }
                v2u wq, wk; wq.x = pk2(xq[0], xq[1]); wq.y = pk2(xq[2], xq[3]); wk.x = pk2(xk[0], xk[1]); wk.y = pk2(xk[2], xk[3]);
                const int off = kk * GP + (32 * tt + 8 * g + 4 * hi) * 2;
                *(LAS v2u*)(wl + G_A + off) = wq; *(LAS v2u*)(wl + G_B + off) = wk;
                if (g & 1) asm volatile("" ::: "memory");
            }
        }
        const float* sp = UST + ((size_t)((b * 4 + hh) * 2 + dir) * 36 + nc) * 2048;
        bf16x8 sf[2][2];
#pragma unroll
        for (int vb = 0; vb < 2; ++vb)
#pragma unroll
            for (int s = 0; s < 2; ++s) { const float* p = sp + (size_t)(32 * vb + kk) * 32 + 16 * s + 8 * hi; const f32x4 a = *(const f32x4*)p, c = *(const f32x4*)(p + 4);
                sf[vb][s] = pack8(a.x, a.y, a.z, a.w, c.x, c.y, c.z, c.w); }
#pragma unroll
        for (int it = 0; it < 2; ++it) {
            bf16x8 qf[2];
#pragma unroll
            for (int s = 0; s < 2; ++s) { LAS const unsigned char* p = wl + G_A + tri + 16 * s * GP + 64 * it; qf[s] = cat4(tr_read(p), tr_read(p + 4 * GP)); }
#pragma unroll
            for (int vb = 0; vb < 2; ++vb)
#pragma unroll
                for (int s = 0; s < 2; ++s) o[vb][it] = MFMA32(sf[vb][s], qf[s], o[vb][it]);
#pragma unroll
            for (int jt = 0; jt < 2; ++jt) {
                if (dir == 0 ? (jt > it) : (jt < it)) continue;
                f32x16 sc;
#pragma unroll
                for (int i = 0; i < 16; ++i) sc[i] = 0.f;
#pragma unroll
                for (int s = 0; s < 2; ++s) { LAS const unsigned char* p = wl + G_B + tri + 16 * s * GP + 64 * jt; const bf16x8 kf = cat4(tr_read(p), tr_read(p + 4 * GP)); sc = MFMA32(kf, qf[s], sc); }
                if (jt == it) {
#pragma unroll
                    for (int i = 0; i < 16; ++i) { const int j = crow(i, hi); const bool ok = dir == 0 ? (j <= kk) : (j >= kk); sc[i] = ok ? sc[i] : 0.f; }
                }
#pragma unroll
                for (int s2 = 0; s2 < 2; ++s2) {
                    const bf16x8 pf = pack8(sc[8 * s2 + 0], sc[8 * s2 + 1], sc[8 * s2 + 2], sc[8 * s2 + 3], sc[8 * s2 + 4], sc[8 * s2 + 5], sc[8 * s2 + 6], sc[8 * s2 + 7]);
                    LAS const unsigned char* vp = wl + G_V + trv + (32 * jt + 16 * s2) * GP;
                    const bf16x8 v0 = cat4(tr_read(vp), tr_read(vp + 8 * GP));
                    const bf16x8 v1 = cat4(tr_read(vp + 64), tr_read(vp + 8 * GP + 64));
                    o[0][it] = MFMA32(v0, pf, o[0][it]); o[1][it] = MFMA32(v1, pf, o[1][it]);
                }
                __builtin_amdgcn_sched_barrier(0);
            }
            __builtin_amdgcn_sched_barrier(0);
        }
    }
#pragma unroll
    for (int it = 0; it < 2; ++it) {
        float ss = 0.f;
#pragma unroll
        for (int vb = 0; vb < 2; ++vb)
#pragma unroll
            for (int i = 0; i < 16; ++i) ss += o[vb][it][i] * o[vb][it][i];
        ss += __shfl_xor(ss, 32);
        const float rstd = __builtin_amdgcn_rsqf(ss * (1.f / 64.f) + NEPS);
        const size_t row = (size_t)(row0 + 32 * it + kk);
#pragma unroll
        for (int vb = 0; vb < 2; ++vb)
#pragma unroll
            for (int g = 0; g < 4; ++g) { const int v = 32 * vb + 8 * g + 4 * hi;
                const f32x4 gn = *(const f32x4*)(gnorm + v); const v2u gw = *(const v2u*)(P + row * PP + C_GG + hh * 64 + v);
                const float g0 = bflo(gw.x), g1 = bfhi(gw.x), g2 = bflo(gw.y), g3 = bfhi(gw.y);
                v2u w; w.x = pk2(o[vb][it][4 * g] * rstd * gn.x * silu_f(g0), o[vb][it][4 * g + 1] * rstd * gn.y * silu_f(g1));
                w.y = pk2(o[vb][it][4 * g + 2] * rstd * gn.z * silu_f(g2), o[vb][it][4 * g + 3] * rstd * gn.w * silu_f(g3));
                *(v2u*)(MIX + row * 1024 + hh * 64 + v) = w; }
    }
}
__device__ __forceinline__ void phase_r1(const float* const* in, float* xout, unsigned char* ws, LAS unsigned char* lds, int l, bool upd, int G, int tid, int wave, int lane, bool dry) {
    const float* x0 = in[0]; const float* ctx0 = in[2]; const float* gains = in[6] + (size_t)l * 4096; const float* wr = in[14] + (size_t)l * 1024 * 16;
    const float* mod = (const float*)(ws + WS_MOD) + (size_t)l * 9 * 6144;
    const bf16_t* Y = (const bf16_t*)(ws + WS_R2 + (size_t)MT * 2048); bf16_t* H = (bf16_t*)(ws + WS_H); float* XC = (float*)(ws + WS_XC);
    float* AFF = (float*)(ws + WS_AFF); float* AFFC = (float*)(ws + WS_AFFC);
    LAS float* V = (LAS float*)lds;
    LAS float* RT = V + 6144;
    __syncthreads();
    for (int i = tid; i < 16384; i += 512) { const int d = i >> 4, e = i & 15; RT[e * 1024 + d] = wr[i]; }
    for (int t = blockIdx.x; t < 256; t += G) {
        const int b = t >> 5;
        __syncthreads();
        for (int n = tid; n < 1024; n += 512) { const float gpa = gains[1024 + n], gpf = gains[2048 + n];
            V[n] = gpa * mod[b * 6144 + 2048 + n]; V[1024 + n] = gpf * (1.f + mod[b * 6144 + 4096 + n]); V[2048 + n] = mod[b * 6144 + 3072 + n];
            V[3072 + n] = gpa * mod[8 * 6144 + 2048 + n]; V[4096 + n] = gpf * (1.f + mod[8 * 6144 + 4096 + n]); V[5120 + n] = mod[8 * 6144 + 3072 + n]; }
        __syncthreads();
        const int nrows = upd ? 9 : 8;
#pragma unroll 1
        for (int i0 = 0; i0 < 9; i0 += 3) {
            f32x4 yv[3][4], xq[3][4];
#pragma unroll
            for (int k = 0; k < 3; ++k) { const int i = i0 + k; if (i < nrows) {
                const bool isc = (i == 8); const int row = isc ? (ML + 8 * t + wave) : (64 * t + 8 * wave + i);
                const float* xs = isc ? ((l == 0 ? ctx0 : XC) + (size_t)(8 * t + wave) * 1024) : ((l == 0 ? x0 : xout) + (size_t)row * 1024);
                ld_row_bf16(Y + (size_t)row * 1024, lane, yv[k]); ld_row_f32(xs, lane, xq[k]); } }
#pragma unroll
            for (int k = 0; k < 3; ++k) { const int i = i0 + k; if (i < nrows) {
            const bool isc = (i == 8);
            const int row = isc ? (ML + 8 * t + wave) : (64 * t + 8 * wave + i);
            float* xd = isc ? (XC + (size_t)(8 * t + wave) * 1024) : (xout + (size_t)row * 1024);
            if (dry) xd = (float*)(ws + WS_R1) + (size_t)(row & (ML - 1)) * 1024;
            LAS const float* vv = V + (isc ? 3072 : 0);
            f32x4 (&y)[4] = yv[k]; f32x4 (&xv)[4] = xq[k]; f32x4 a[4];
            const float rsy = __builtin_amdgcn_rsqf(wave_sum(sumsq16(y)) * (1.f / 1024.f) + NEPS);
            ld_vec_lds(vv, lane, a);
#pragma unroll
            for (int j = 0; j < 4; ++j) xv[j] = xv[j] + a[j] * (y[j] * rsy);
            st_row_f32(xd, lane, xv);
            const float rs1 = __builtin_amdgcn_rsqf(wave_sum(sumsq16(xv)) * (1.f / 1024.f) + NEPS);
            f32x4 s[4]; ld_vec_lds(vv + 1024, lane, a); ld_vec_lds(vv + 2048, lane, s);
#pragma unroll
            for (int j = 0; j < 4; ++j) xv[j] = xv[j] * rs1 * a[j] + s[j];
            st_row_bf16((dry ? (bf16_t*)(ws + WS_R2) : H) + (size_t)row * 1024, lane, xv);
            float lg[16];
#pragma unroll
            for (int e = 0; e < 16; ++e) { float p = 0.f;
#pragma unroll
                for (int j = 0; j < 4; ++j) { const f32x4 w = *(LAS const f32x4*)(RT + e * 1024 + 256 * j + 4 * lane); p += (xv[j].x * w.x + xv[j].y * w.y) + (xv[j].z * w.z + xv[j].w * w.w); }
                lg[e] = p;
                if ((e & 3) == 3) asm volatile("" ::: "memory"); }
#pragma unroll
            for (int i2 = 0; i2 < 8; ++i2) { const bool up = (lane & 32) != 0; const float keep = up ? lg[i2 + 8] : lg[i2], send = up ? lg[i2] : lg[i2 + 8]; lg[i2] = keep + __shfl_xor(send, 32); }
#pragma unroll
            for (int i2 = 0; i2 < 4; ++i2) { const bool up = (lane & 16) != 0; const float keep = up ? lg[i2 + 4] : lg[i2], send = up ? lg[i2] : lg[i2 + 4]; lg[i2] = keep + __shfl_xor(send, 16); }
#pragma unroll
            for (int i2 = 0; i2 < 2; ++i2) { const bool up = (lane & 8) != 0; const float keep = up ? lg[i2 + 2] : lg[i2], send = up ? lg[i2] : lg[i2 + 2]; lg[i2] = keep + __shfl_xor(send, 8); }
            { const bool up = (lane & 4) != 0; const float keep = up ? lg[1] : lg[0], send = up ? lg[0] : lg[1]; lg[0] = keep + __shfl_xor(send, 4); }
            float lgt = lg[0]; lgt += __shfl_xor(lgt, 1); lgt += __shfl_xor(lgt, 2);
            const int ex = ((lane >> 5) & 1) * 8 + ((lane >> 4) & 1) * 4 + ((lane >> 3) & 1) * 2 + ((lane >> 2) & 1);
            float mx = lgt;
            mx = fmaxf(mx, __shfl_xor(mx, 4)); mx = fmaxf(mx, __shfl_xor(mx, 8)); mx = fmaxf(mx, __shfl_xor(mx, 16)); mx = fmaxf(mx, __shfl_xor(mx, 32));
            const float pe = fexp(lgt - mx);
            float den = pe; den += __shfl_xor(den, 4); den += __shfl_xor(den, 8); den += __shfl_xor(den, 16); den += __shfl_xor(den, 32);
            const float mine = pe / den;
            if ((lane & 3) == 0) {
                if (isc) { const int cr = 8 * t + wave; AFFC[((size_t)(cr >> 8) * 16 + ex) * 256 + (cr & 255)] = mine; }
                else AFF[((size_t)(row >> 11) * 16 + ex) * 2048 + (row & 2047)] = mine;
            }
            } }
        }
    }
}

template <bool CTX>
__device__ __forceinline__ void topk_wg(unsigned char* ws, int item, int wave, LAS unsigned char* wl, int lane) {
    constexpr int NT = CTX ? 256 : 2048, CAP = CTX ? 32 : 256, PER = NT / 64, RPW = CAP / 16;
    const int hf = item & 1, e = (item >> 1) & 15, b = item >> 5;
    const float* arow = (const float*)(ws + (CTX ? WS_AFFC : WS_AFF)) + (size_t)(b * 16 + e) * NT;
    float* gate = (float*)(ws + (CTX ? WS_GATEC : WS_GATE)) + (size_t)(b * 16 + e) * CAP;
    short* INV = (short*)(ws + WS_INV);
    const bf16_t* H = (const bf16_t*)(ws + WS_H); bf16_t* XS = (bf16_t*)(ws + WS_R1);
    LAS int* list = (LAS int*)wl; LAS float* vals = (LAS float*)(wl + 1024);
    unsigned v[PER];
#pragma unroll
    for (int i = 0; i < PER / 4; ++i) { const v4u q = *(const v4u*)(arow + lane * PER + 4 * i); v[4 * i] = q.x; v[4 * i + 1] = q.y; v[4 * i + 2] = q.z; v[4 * i + 3] = q.w; }
    unsigned T = 0;
    for (int bit = 29; bit >= 0; --bit) {
        const unsigned cand = T | (1u << bit); int c = 0;
#pragma unroll
        for (int i = 0; i < PER; ++i) c += __popcll(__ballot(v[i] >= cand));
        if (c >= CAP) T = cand;
    }
    int ngt = 0, cg = 0, ce = 0;
#pragma unroll
    for (int i = 0; i < PER; ++i) { ngt += __popcll(__ballot(v[i] > T)); cg += (v[i] > T) ? 1 : 0; ce += (v[i] == T) ? 1 : 0; }
    const int need = CAP - ngt;
    int pg = cg, pe = ce;
#pragma unroll
    for (int d = 1; d < 64; d <<= 1) { const int tg = __shfl_up(pg, d), te = __shfl_up(pe, d); if (lane >= d) { pg += tg; pe += te; } }
    pg -= cg; pe -= ce;
    const int myp = hf * 8 + wave;
#pragma unroll
    for (int i = 0; i < PER; ++i) {
        const bool gt = v[i] > T, eq = v[i] == T;
        const bool sel = gt || (eq && pe < need);
        const int slot = pg + (pe < need ? pe : need);
        const int tok = lane * PER + i;
        if (sel) { list[slot] = tok; vals[slot] = __uint_as_float(v[i]); }
        const bool mine = CTX ? ((lane >> 2) == myp) : ((i >> 1) == myp);
        if (mine) INV[(size_t)(CTX ? (ML + b * CTXL + tok) : (b * SEQ + tok)) * 16 + e] = sel ? (short)slot : (short)-1;
        pg += gt ? 1 : 0; pe += eq ? 1 : 0;
    }
    const int s0 = hf * (CAP / 2) + wave * RPW;
    if (lane < RPW) gate[s0 + lane] = vals[s0 + lane];
    constexpr int BT = RPW < 8 ? RPW : 8;
#pragma unroll 1
    for (int bt = 0; bt < RPW / BT; ++bt) {
        v4u r0[BT], r1[BT];
#pragma unroll
        for (int j = 0; j < BT; ++j) { const int tok = list[s0 + bt * BT + j]; const v4u* sp = (const v4u*)(H + (size_t)(CTX ? (ML + b * CTXL + tok) : (b * SEQ + tok)) * 1024);
            r0[j] = sp[lane]; r1[j] = sp[64 + lane]; }
#pragma unroll
        for (int j = 0; j < BT; ++j) { const int slot = s0 + bt * BT + j; const size_t drow = CTX ? ((size_t)(128 + e) * 256 + b * 32 + slot) : ((size_t)(b * 16 + e) * 256 + slot);
            v4u* dp = (v4u*)(XS + drow * 1024); dp[lane] = r0[j]; dp[64 + lane] = r1[j]; }
    }
}

__device__ __forceinline__ void phase_r5(const float* const* in, float* xout, unsigned char* ws, LAS unsigned char* lds, int l, bool upd, int G, int tid, int wave, int lane, bool dry) {
    const float* gains = in[6];
    const float* mod = (const float*)(ws + WS_MOD);
    const bf16_t* YE = (const bf16_t*)(ws + WS_R1); bf16_t* H = (bf16_t*)(ws + WS_H); float* XC = (float*)(ws + WS_XC);
    const float* GATE = (const float*)(ws + WS_GATE); const float* GATEC = (const float*)(ws + WS_GATEC); const short* INV = (const short*)(ws + WS_INV);
    LAS float* V = (LAS float*)lds;
    LAS int* CL = (LAS int*)(lds + 24576);
    for (int t = blockIdx.x; t < 256; t += G) {
        const int b = t >> 5;
        __syncthreads();
        for (int n = tid; n < 1024; n += 512) { const float gpf = gains[(size_t)l * 4096 + 3072 + n];
            V[n] = gpf * mod[((size_t)l * 9 + b) * 6144 + 5120 + n]; V[3072 + n] = gpf * mod[((size_t)l * 9 + 8) * 6144 + 5120 + n];
            if (l == 0) { const float gna = gains[4096 + n];
                V[1024 + n] = gna * (1.f + mod[((size_t)9 + b) * 6144 + 1024 + n]); V[2048 + n] = mod[((size_t)9 + b) * 6144 + n];
                V[4096 + n] = gna * (1.f + mod[((size_t)9 + 8) * 6144 + 1024 + n]); V[5120 + n] = mod[((size_t)9 + 8) * 6144 + n]; } }
        if (tid < (upd ? 72 : 64)) {
            const bool isc = tid >= 64; const int cr = 8 * t + (tid - 64);
            const int row = isc ? (ML + cr) : (64 * t + tid); const int bb = isc ? (cr >> 8) : b;
            const v4u i0 = *(const v4u*)(INV + (size_t)row * 16), i1 = *(const v4u*)(INV + (size_t)row * 16 + 8);
            const unsigned iw[8] = {i0.x, i0.y, i0.z, i0.w, i1.x, i1.y, i1.z, i1.w};
            float gv[16]; int sl[16];
#pragma unroll
            for (int e = 0; e < 16; ++e) { sl[e] = (int)(short)((iw[e >> 1] >> (16 * (e & 1))) & 0xffffu); const int s0 = sl[e] < 0 ? 0 : sl[e];
                gv[e] = isc ? GATEC[(size_t)(bb * 16 + e) * 32 + s0] : GATE[(size_t)(bb * 16 + e) * 256 + s0]; }
            int cnt = 0; LAS int* cl = CL + tid * 33;
#pragma unroll
            for (int e = 0; e < 16; ++e) if (sl[e] >= 0) { cl[1 + 2 * cnt] = isc ? ((128 + e) * 256 + bb * 32 + sl[e]) : ((bb * 16 + e) * 256 + sl[e]); cl[2 + 2 * cnt] = (int)__float_as_uint(gv[e]); ++cnt; }
            cl[0] = cnt;
        }
        __syncthreads();
        const int nrows = upd ? 9 : 8;
#pragma unroll 1
        for (int i0 = 0; i0 < 9; i0 += 3) {
            f32x4 xq[3][4];
#pragma unroll
            for (int k = 0; k < 3; ++k) { const int i = i0 + k; if (i < nrows) { const bool isc = (i == 8);
                const float* xs = isc ? (XC + (size_t)(8 * t + wave) * 1024) : (xout + (size_t)(64 * t + 8 * wave + i) * 1024); ld_row_f32(xs, lane, xq[k]); } }
#pragma unroll
            for (int k = 0; k < 3; ++k) { const int i = i0 + k; if (i < nrows) {
            const bool isc = (i == 8);
            const int row = isc ? (ML + 8 * t + wave) : (64 * t + 8 * wave + i);
            float* xd = isc ? (XC + (size_t)(8 * t + wave) * 1024) : (xout + (size_t)row * 1024);
            if (dry) xd = (float*)(ws + WS_R2) + (size_t)(row & (ML - 1)) * 1024;
            LAS const float* vv = V + (isc ? 3072 : 0);
            LAS const int* cl = CL + (isc ? (64 + wave) : (8 * wave + i)) * 33;
            const int n = __builtin_amdgcn_readfirstlane(cl[0]);
            f32x4 acc[4];
#pragma unroll
            for (int j = 0; j < 4; ++j) acc[j] = (f32x4){0.f, 0.f, 0.f, 0.f};
            for (int j0 = 0; j0 < n; j0 += 4) {
                v2u raw[4][4]; float g[4];
#pragma unroll
                for (int q = 0; q < 4; ++q) {
                    if (j0 + q < n) { const int yr = __builtin_amdgcn_readfirstlane(cl[1 + 2 * (j0 + q)]); g[q] = __uint_as_float((unsigned)__builtin_amdgcn_readfirstlane(cl[2 + 2 * (j0 + q)]));
                        const bf16_t* yp = YE + (size_t)yr * 1024;
#pragma unroll
                        for (int j = 0; j < 4; ++j) raw[q][j] = *(const v2u*)(yp + 256 * j + 4 * lane); }
                    else { g[q] = 0.f;
#pragma unroll
                        for (int j = 0; j < 4; ++j) raw[q][j] = (v2u){0u, 0u}; }
                }
#pragma unroll
                for (int q = 0; q < 4; ++q)
#pragma unroll
                    for (int j = 0; j < 4; ++j) acc[j] += (f32x4){bflo(raw[q][j].x), bfhi(raw[q][j].x), bflo(raw[q][j].y), bfhi(raw[q][j].y)} * g[q];
            }
            const float rsm = __builtin_amdgcn_rsqf(wave_sum(sumsq16(acc)) * (1.f / 1024.f) + NEPS);
            f32x4 (&xv)[4] = xq[k]; f32x4 a[4]; ld_vec_lds(vv, lane, a);
#pragma unroll
            for (int j = 0; j < 4; ++j) xv[j] = xv[j] + a[j] * (acc[j] * rsm);
            st_row_f32(xd, lane, xv);
            if (l == 0 && !dry) {
                const float rs2 = __builtin_amdgcn_rsqf(wave_sum(sumsq16(xv)) * (1.f / 1024.f) + NEPS);
                f32x4 s[4]; ld_vec_lds(vv + 1024, lane, a); ld_vec_lds(vv + 2048, lane, s);
#pragma unroll
                for (int j = 0; j < 4; ++j) xv[j] = xv[j] * rs2 * a[j] + s[j];
                st_row_bf16(H + (size_t)row * 1024, lane, xv);
            }
            } }
        }
    }
}
#ifndef MK_PER_PHASE
#define MK_PER_PHASE 0
#endif
constexpr int N_PHASES = 22;
struct Args { const float* in[18]; float* out; unsigned char* ws; int ph_lo, ph_hi; };
__device__ __forceinline__ const Args* kargs_opaque() {
    auto p = __builtin_amdgcn_kernarg_segment_ptr(); asm volatile("" : "+s"(p)); return (const Args*)p; }
#define PHASE_REGS() int tid = threadIdx.x; asm volatile("" : "+v"(tid)); const int lane = tid & 63, wave = __builtin_amdgcn_readfirstlane(tid >> 6); \
    const Args* A = kargs_opaque(); unsigned char* ws = A->ws; const int G = gridDim.x, bx = blockIdx.x; \
    const int vcu = (G % 8 == 0) ? (bx % 8) * (G / 8) + bx / 8 : bx; const int gw = vcu * NWAVES + wave, NGW = G * NWAVES; \
    LAS unsigned char* wl = lds + wave * WAVE_LDS; (void)gw; (void)NGW; (void)wl; (void)lane; (void)ws
#ifndef PH_MASK
#define PH_MASK 0xFFFFFFFFu
#endif
#define EN(j) (((PH_MASK) >> (j)) & 1u)
#ifndef REP_MASK
#define REP_MASK 0u
#endif
#define REPS(j) ((((REP_MASK) >> (j)) & 1u) ? 2 : 1)
__global__ void __launch_bounds__(NWAVES * 64, 2) fwd_kernel(Args args) {
    extern __shared__ __attribute__((aligned(16))) unsigned char lds_raw[];
    LAS unsigned char* lds = (LAS unsigned char*)lds_raw;
    volatile LAS unsigned* MISC = (volatile LAS unsigned*)(lds + MISC_OFF);
    for (int u = threadIdx.x; u < (LDS_BYTES - LDSCTL_OFF) / 4; u += NWAVES * 64) ((LAS unsigned*)(lds + LDSCTL_OFF))[u] = 0u;
    __syncthreads();
    const int lo = args.ph_lo, hi = args.ph_hi;
    XcdBarrier bar; bar.bar = (unsigned*)(args.ws + WS_CTL) + CW_BAR; bar.x = 0; bar.st = nullptr;
    if (hi - lo > 1) bar = xcd_barrier_post((unsigned*)(args.ws + WS_CTL) + CW_BAR, MISC + 8);
#define IN(k) (lo <= (k) && (k) < hi)
#define SEAM(k) do { if (IN((k) + 1)) { xcd_barrier(bar); if (REPS(12) == 2) xcd_barrier(bar); } } while (0)
    if (EN(0) && IN(0)) { for (int rep = 0; rep < REPS(0); ++rep) { PHASE_REGS(); phase_p0(A->in, ws, wl, gw, NGW, lane); } SEAM(0); }
    if (EN(1) && IN(1)) { for (int rep = 0; rep < REPS(1); ++rep) { PHASE_REGS(); phase_a0(A->in, ws, lds, G, tid, wave, lane); } SEAM(1); }
    for (int l = 0; l < 2; ++l) {
        const int base = 2 + 10 * l; const bool upd = (l == 0);
        if (EN(2) && IN(base + 0)) { for (int rep = 0; rep < REPS(2); ++rep) {
            PHASE_REGS();
            pg8::Gemm g{(const bf16_t*)(ws + WS_H), (const bf16_t*)(ws + WS_WIN) + (size_t)l * PP * 1024, MT, PP, 1024}; pg8::StaticOrder S; S.init(MT, PP, G, bx);
            pg8::EpiProj E{(bf16_t*)(ws + WS_R1), PP, (const pg8::f32x2*)(ws + WS_TAB), ML};
            pg8::gemm_phase<pg8::EpiProj, pg8::StaticOrder, true, true>(lds, g, S, E);
            }
            SEAM(base + 0);
        }
        if (EN(3) && IN(base + 1)) { for (int rep = 0; rep < REPS(3); ++rep) {
            PHASE_REGS();
            const bf16_t* PROJ = (const bf16_t*)(ws + WS_R1); bf16_t* MIX = (bf16_t*)(ws + WS_R2);
            const float* a_up = A->in[9] + (size_t)l * 2 * 16 * 128; const float* a_bias = A->in[10] + (size_t)l * 2 * 128;
            const float* rpb = A->in[12] + (size_t)l * 4 * 465; const float* sink = A->in[13] + (size_t)l * 8;
            const int n_cn = upd ? 128 : 0, n_cs = upd ? 256 : 0;
            const bool xmap = (G == 256);
            const int xcd = bx & 7, cu = bx >> 3;
            const int n_att = xmap ? 12 : 0;
            const int tail_total = (xmap ? 0 : 1024 + 2048) + 1152 + n_cn + n_cs;
            volatile LAS unsigned* qctr = (volatile LAS unsigned*)(lds + MISC_OFF) + 16 + l * 2 + rep;
            for (;;) {
                int j = 0; if (lane == 0) j = (int)__hip_atomic_fetch_add((LAS unsigned*)qctr, 1u, __ATOMIC_RELAXED, __HIP_MEMORY_SCOPE_WORKGROUP);
                j = __builtin_amdgcn_readfirstlane(j);
                int mode, item;
                if (j < n_att) {
                    if (j < 4) { mode = 0; item = (xcd * 4 + j) * 32 + cu; }
                    else { const int jj = j - 4, group = xcd * 2 + (jj >> 2), i = cu * 4 + (jj & 3); const int bb = group >> 1, hq = (group & 1) * 4 + (i >> 5); mode = 1; item = (i & 31) + 32 * hq + 256 * bb; }
                } else {
                    int r = (j - n_att) * G + bx;
                    if (r >= tail_total) break;
                    mode = -1; item = 0;
                    if (!xmap) { if (r < 1024) { mode = 0; item = r; } else if (r < 3072) { mode = 1; item = r - 1024; } r -= 3072; }
                    if (mode < 0) {
                        if (r < 1152) { if (rep + 1 < REPS(3)) continue; gla_local_item(PROJ, (float*)(ws + WS_UST), (float*)(ws + WS_DEC), r, wl, lane, a_up, a_bias); continue; } r -= 1152;
                        if (r < n_cs) { mode = 3; item = r; } else { mode = 2; item = r - n_cs; }
                    }
                }
                attn_item(mode, PROJ, MIX, item, wl, lane, rpb, sink, rep + 1 < REPS(3));
            }
            }
            SEAM(base + 1);
        }
        if (EN(4) && IN(base + 2)) { for (int rep = 0; rep < REPS(4); ++rep) {
            PHASE_REGS();
            for (int gid = bx * (NWAVES * 64) + tid; gid < 64 * 2048; gid += G * NWAVES * 64) gla_prefix((float*)(ws + WS_UST), (const float*)(ws + WS_DEC), gid, rep + 1 < REPS(4));
            }
            SEAM(base + 2);
        }
        if (EN(5) && IN(base + 3)) { for (int rep = 0; rep < REPS(5); ++rep) {
            PHASE_REGS();
            const float* a_up = A->in[9] + (size_t)l * 2 * 16 * 128; const float* a_bias = A->in[10] + (size_t)l * 2 * 128; const float* gnorm = A->in[11] + (size_t)l * 64;
            for (int it = gw; it < 1152; it += NGW) { if (!upd && (it % 36) < 4) continue;
                gla_out_item((const bf16_t*)(ws + WS_R1), (const float*)(ws + WS_UST), (bf16_t*)(ws + WS_R2), it, wl, lane, a_up, a_bias, gnorm); }
            }
            SEAM(base + 3);
        }
        if (EN(6) && IN(base + 4)) { for (int rep = 0; rep < REPS(6); ++rep) {
            PHASE_REGS();
            const int M2 = upd ? MT : ML;
            pg8::Gemm g{(const bf16_t*)(ws + WS_R2), (const bf16_t*)(ws + WS_WOUT) + (size_t)l * 1024 * 1024, M2, 1024, 1024}; pg8::StaticOrder S; S.init(M2, 1024, G, bx);
            pg8::EpiStore E{(bf16_t*)(ws + WS_R2 + (size_t)MT * 2048), 1024};
            pg8::gemm_phase<pg8::EpiStore, pg8::StaticOrder, true, true>(lds, g, S, E);
            }
            SEAM(base + 4);
        }
        if (EN(7) && IN(base + 5)) { for (int rep = 0; rep < REPS(7); ++rep) { PHASE_REGS(); phase_r1(A->in, A->out, ws, lds, l, upd, G, tid, wave, lane, rep + 1 < REPS(7)); } SEAM(base + 5); }
        if (EN(8) && IN(base + 6)) { for (int rep = 0; rep < REPS(8); ++rep) {
            PHASE_REGS();
            for (int it = bx; it < 256; it += G) { topk_wg<false>(ws, it, wave, wl, lane); if (upd) topk_wg<true>(ws, it, wave, wl, lane); }
            }
            SEAM(base + 6);
        }
        if (EN(9) && IN(base + 7)) { for (int rep = 0; rep < REPS(9); ++rep) {
            PHASE_REGS();
            pg8::Gemm g{(const bf16_t*)(ws + WS_R1), (const bf16_t*)(ws + WS_WGU) + (size_t)l * 16 * 2048 * 1024, 0, 0, 1024}; pg8::MoeOrder S; S.init(upd ? 9 : 8, 8, G, bx);
            pg8::EpiSwiGLU E{(bf16_t*)(ws + WS_R2), 1024};
            pg8::gemm_phase<pg8::EpiSwiGLU, pg8::MoeOrder, true, true>(lds, g, S, E);
            }
            SEAM(base + 7);
        }
        if (EN(10) && IN(base + 8)) { for (int rep = 0; rep < REPS(10); ++rep) {
            PHASE_REGS();
            pg8::Gemm g{(const bf16_t*)(ws + WS_R2), (const bf16_t*)(ws + WS_WD) + (size_t)l * 16 * 1024 * 1024, 0, 0, 1024}; pg8::MoeOrder S; S.init(upd ? 9 : 8, 4, G, bx);
            pg8::EpiStore E{(bf16_t*)(ws + WS_R1), 1024};
            pg8::gemm_phase<pg8::EpiStore, pg8::MoeOrder, true, true>(lds, g, S, E);
            }
            SEAM(base + 8);
        }
        if (EN(11) && IN(base + 9)) { for (int rep = 0; rep < REPS(11); ++rep) { PHASE_REGS(); phase_r5(A->in, A->out, ws, lds, l, upd, G, tid, wave, lane, rep + 1 < REPS(11)); } SEAM(base + 9); }
    }
#undef IN
#undef SEAM
}

extern "C" void kernel_launch(void* const* d_in, const int* in_sizes, int n_in, void* d_out, int out_size, void* d_ws, size_t ws_size, hipStream_t stream) {
    static int grid = 0;
    if (grid == 0) {
        if (n_in != 18 || out_size != ML * DM || ws_size < WS_END) { fprintf(stderr, "kernel_launch: unexpected sizes: n_in %d out %d ws %zu (need %zu)\n", n_in, out_size, ws_size, (size_t)WS_END); grid = -1; return; }
        int dev = 0, cus = 0, per_cu = 0;
        if (hipGetDevice(&dev) != hipSuccess || hipDeviceGetAttribute(&cus, hipDeviceAttributeMultiprocessorCount, dev) != hipSuccess) { grid = -1; return; }
        if (hipFuncSetAttribute((const void*)fwd_kernel, hipFuncAttributeMaxDynamicSharedMemorySize, LDS_BYTES) != hipSuccess) { fprintf(stderr, "kernel_launch: hipFuncSetAttribute failed\n"); grid = -1; return; }
        if (hipOccupancyMaxActiveBlocksPerMultiprocessor(&per_cu, (const void*)fwd_kernel, NWAVES * 64, LDS_BYTES) != hipSuccess || per_cu < 1) { fprintf(stderr, "kernel_launch: occupancy query says %d blocks per CU\n", per_cu); (void)hipGetLastError(); grid = -1; return; }
        grid = cus;
    }
    if (grid < 0) return;
    (void)hipMemsetAsync((char*)d_ws + WS_CTL, 0, CTL_ZERO_BYTES, stream);
    Args a{};
    for (int i = 0; i < 18; ++i) a.in[i] = (const float*)d_in[i];
    a.out = (float*)d_out; a.ws = (unsigned char*)d_ws;
#if MK_PER_PHASE
    for (int p = 0; p < N_PHASES; ++p) { a.ph_lo = p; a.ph_hi = p + 1; hipLaunchKernelGGL(fwd_kernel, dim3(grid), dim3(NWAVES * 64), LDS_BYTES, stream, a); }
#else
    a.ph_lo = 0; a.ph_hi = N_PHASES;
    void* kargs[] = {&a};
    hipError_t e = hipLaunchCooperativeKernel((const void*)fwd_kernel, dim3(grid), dim3(NWAVES * 64), kargs, LDS_BYTES, stream);
    if (e != hipSuccess) fprintf(stderr, "kernel_launch: cooperative launch failed: %s (grid %d)\n", hipGetErrorString(e), grid);
#endif
}
```

```cpp
#include <hip/hip_runtime.h>
#include <cstdio>
#include <cstdint>
#include <cmath>

namespace pg8 {
#define PG8_LAS __attribute__((address_space(3)))
typedef unsigned short bf16_t;
typedef short bf16x8 __attribute__((ext_vector_type(8)));
typedef float f32x4 __attribute__((ext_vector_type(4)));
typedef unsigned u32x4 __attribute__((ext_vector_type(4)));
constexpr int BM = 256, BK = 64, HALF = 128, HTB = HALF * BK * 2  , STAGE_BYTES = 8 * HTB, NXCD = 8, WGM = 8;

__host__ __device__ __forceinline__ int lds_byte(int r, int c) { const int st = (r >> 4) * 2 + (c >> 5), rr = r & 15, cc = c & 31, ob = rr * 64 + cc * 2; return st * 1024 + (ob ^ (((ob >> 9) & 1) << 5)); }
__host__ __device__ __forceinline__ void stage_rc(int b, int& R, int& C) { const int st = b / 1024, sb = b % 1024, swz = sb ^ (((sb >> 9) & 1) << 5); R = (st >> 1) * 16 + swz / 64; C = (st & 1) * 32 + (swz % 64) / 2; }
__host__ __device__ __forceinline__ int perm32(int rho) { const int n = rho >> 4, i = rho & 15; return 8 * (i >> 2) + 4 * n + (i & 3); }

struct Unit { int pm, pn, pb; };
struct Gemm { const bf16_t* A; const bf16_t* Bt; int M, N, K; };

struct StaticOrder {
    int nM, nN, nwg, G, c;
    __host__ __device__ void init(int M, int N, int G_, int c_) { nM = M / BM; nN = N / BM; nwg = nM * nN; G = G_; c = c_; }
    __host__ __device__ bool next(int i, Unit& u) const {
        const long L = (long)i * G + c; if (L >= nwg) return false;
        int wgid = (int)L; { const int q = nwg / NXCD, r = nwg % NXCD, xcd = wgid % NXCD, off = wgid / NXCD; wgid = (xcd < r ? xcd * (q + 1) : r * (q + 1) + (xcd - r) * q) + off; }
        const int nig = WGM * nN, gid = wgid / nig, fm = gid * WGM, gsz = (nM - fm) < WGM ? (nM - fm) : WGM;
        u.pm = fm + ((wgid % nig) % gsz); u.pn = (wgid % nig) / gsz; u.pb = u.pn; return true;
    }
    __device__ __forceinline__ void a_ready(const Unit&) const {}
    __device__ __forceinline__ void done(const Unit&) const {}
};

__device__ __forceinline__ unsigned cvt_pk_bf16(float lo, float hi) { unsigned r; asm volatile("v_cvt_pk_bf16_f32 %0, %1, %2" : "=v"(r) : "v"(lo), "v"(hi)); return r; }
typedef float f32x2 __attribute__((ext_vector_type(2)));
struct EpiStore {
    static constexpr bool PERM = true, AFTER_DRAIN = false;
    bf16_t* O; int ldc;
    __device__ __forceinline__ void operator()(const f32x4 (&acc)[2][2][4][2], const Unit& u, int wr, int wc, int fr, int fq) const {
        const int row0 = u.pm * BM + wr * 64 + fr, col0 = u.pn * BM + wc * 32 + 8 * fq;
#pragma unroll
        for (int ai = 0; ai < 2; ++ai)
#pragma unroll
            for (int m = 0; m < 4; ++m) { bf16_t* rowp = O + (size_t)(row0 + ai * HALF + m * 16) * ldc + col0;
#pragma unroll
                for (int bj = 0; bj < 2; ++bj) { const f32x4 v0 = acc[ai][bj][m][0], v1 = acc[ai][bj][m][1];
                    u32x4 w; w.x = cvt_pk_bf16(v0[0], v0[1]); w.y = cvt_pk_bf16(v0[2], v0[3]); w.z = cvt_pk_bf16(v1[0], v1[1]); w.w = cvt_pk_bf16(v1[2], v1[3]);
                    *(u32x4*)(rowp + bj * HALF) = w; } }
    }
};
struct EpiProj {
    static constexpr bool PERM = true, AFTER_DRAIN = false;
    bf16_t* O; int ldc; const f32x2* tab; int ml;
    __device__ __forceinline__ void operator()(const f32x4 (&acc)[2][2][4][2], const Unit& u, int wr, int wc, int fr, int fq) const {
        const int row0 = u.pm * BM + wr * 64 + fr;
        const bool latent = (u.pm * BM) < ml;
#pragma unroll
        for (int bj = 0; bj < 2; ++bj) {
            const int c0 = u.pn * BM + bj * HALF + wc * 32;
            const bool rope = latent && ((c0 >= 928 && c0 < 1056) || (c0 >= 1824 && c0 < 2336));
            const bool rowhalf = (((c0 - 32) & 63) == 0);
            const bool qscale = (c0 >= 1568 && c0 < 2336);
#pragma unroll
            for (int ai = 0; ai < 2; ++ai)
#pragma unroll
                for (int m = 0; m < 4; ++m) {
                    const int row = row0 + ai * HALF + m * 16;
                    f32x4 v0 = acc[ai][bj][m][0], v1 = acc[ai][bj][m][1];
                    if (rope) {
                        const int t = row & 2047, pos = rowhalf ? (t >> 6) : (t & 63);
                        const f32x2* tp = tab + pos * 16 + 8 * (fq & 1);
                        const float sg = (fq < 2) ? -1.f : 1.f;
#pragma unroll
                        for (int e = 0; e < 4; ++e) {
                            const float x0 = v0[e], x1 = v1[e];
                            const float p0 = __shfl_xor(x0, 32), p1 = __shfl_xor(x1, 32);
                            const f32x2 c0s = tp[e], c1s = tp[4 + e];
                            v0[e] = x0 * c0s.x + sg * p0 * c0s.y; v1[e] = x1 * c1s.x + sg * p1 * c1s.y;
                        }
                    }
                    if (qscale) { v0 = v0 * 0.18033688011112042f; v1 = v1 * 0.18033688011112042f; }
                    u32x4 w; w.x = cvt_pk_bf16(v0[0], v0[1]); w.y = cvt_pk_bf16(v0[2], v0[3]); w.z = cvt_pk_bf16(v1[0], v1[1]); w.w = cvt_pk_bf16(v1[2], v1[3]);
                    *(u32x4*)(O + (size_t)row * ldc + c0 + 8 * fq) = w;
                }
        }
    }
};
struct EpiSwiGLU {
    static constexpr bool PERM = true, AFTER_DRAIN = false;
    bf16_t* O; int ldc;
    __device__ __forceinline__ void operator()(const f32x4 (&acc)[2][2][4][2], const Unit& u, int wr, int wc, int fr, int fq) const {
        const int row0 = u.pm * BM + wr * 64 + fr, col0 = u.pn * HALF + wc * 32 + 8 * fq;
#pragma unroll
        for (int ai = 0; ai < 2; ++ai)
#pragma unroll
            for (int m = 0; m < 4; ++m) {
                float h[8];
#pragma unroll
                for (int n = 0; n < 2; ++n)
#pragma unroll
                    for (int e = 0; e < 4; ++e) { const float g = acc[ai][0][m][n][e], up = acc[ai][1][m][n][e];
                        h[n * 4 + e] = g * __builtin_amdgcn_rcpf(1.f + __builtin_amdgcn_exp2f(-1.4426950408889634f * g)) * up; }
                u32x4 w; w.x = cvt_pk_bf16(h[0], h[1]); w.y = cvt_pk_bf16(h[2], h[3]); w.z = cvt_pk_bf16(h[4], h[5]); w.w = cvt_pk_bf16(h[6], h[7]);
                *(u32x4*)(O + (size_t)(row0 + ai * HALF + m * 16) * ldc + col0) = w;
            }
    }
};
struct MoeOrder {
    int npe, nN, nwg, G, c;
    __host__ __device__ void init(int npe_, int nN_, int G_, int c_) { npe = npe_; nN = nN_; nwg = 16 * npe * nN; G = G_; c = c_; }
    __host__ __device__ bool next(int i, Unit& u) const {
        const long L = (long)i * G + c; if (L >= nwg) return false;
        int wgid = (int)L; { const int q = nwg / NXCD, r = nwg % NXCD, xcd = wgid % NXCD, off = wgid / NXCD; wgid = (xcd < r ? xcd * (q + 1) : r * (q + 1) + (xcd - r) * q) + off; }
        const int per = npe * nN, e = wgid / per, rem = wgid % per, j = rem / nN, pn = rem % nN;
        u.pm = (j < 8) ? (j * 16 + e) : (128 + e); u.pn = pn; u.pb = e * nN + pn; return true;
    }
    __device__ __forceinline__ void a_ready(const Unit&) const {}
    __device__ __forceinline__ void done(const Unit&) const {}
};

template <class Epi, class Sched, bool ALIGN_EPI = false, bool SP2 = false>
__device__ __forceinline__ void gemm_phase(PG8_LAS unsigned char* lds, const Gemm g, const Sched& S, const Epi& E) {
    int tid_ = threadIdx.x; asm volatile("" : "+v"(tid_));
    const int tid = tid_, wid = __builtin_amdgcn_readfirstlane(tid >> 6), lane = tid & 63, wr = wid >> 2, wc = wid & 3, fr = lane & 15, fq = lane >> 4;
    const int K = g.K, nt = K / BK;
    unsigned voffA[2], voffB[2];
#pragma unroll
    for (int i = 0; i < 2; ++i) { int R, C; stage_rc(tid * 16 + i * 8192, R, C); const int Rb = Epi::PERM ? ((R & ~31) + perm32(R & 31)) : R;
        voffA[i] = (unsigned)(R * K + C) * 2u; voffB[i] = (unsigned)(Rb * K + C) * 2u; }
    const size_t kstep = (size_t)(BK * 2);
    const size_t hstep = (size_t)HALF * K * 2;
    const size_t tstep = 2 * hstep;
    const unsigned ldsw = (unsigned)wid * 1024u;
    const int aoff = lds_byte(wr * 64 + fr, fq * 8), boff = lds_byte(wc * 32 + fr, fq * 8);
#define PG8_SA(b, h) (((b) * 2 + (h)) * HTB)
#define PG8_SB(b, h) ((4 + (b) * 2 + (h)) * HTB)
#define PG8_STAGE(bufoff, gbase, voff) do { _Pragma("unroll") for (int _i = 0; _i < 2; ++_i) \
        __builtin_amdgcn_global_load_lds((const unsigned*)((const char*)(gbase) + (voff)[_i]), (PG8_LAS unsigned*)(lds + (bufoff) + ldsw + _i * 8192), 16, 0, 0); } while (0)
#define PG8_LDA(dst, b, h) do { _Pragma("unroll") for (int m = 0; m < 4; ++m) _Pragma("unroll") for (int k = 0; k < 2; ++k) dst[m][k] = *(const PG8_LAS bf16x8*)(lds + PG8_SA(b, h) + aoff + m * 2048 + k * 1024); } while (0)
#define PG8_LDB(dst, b, h) do { _Pragma("unroll") for (int n = 0; n < 2; ++n) _Pragma("unroll") for (int k = 0; k < 2; ++k) dst[n][k] = *(const PG8_LAS bf16x8*)(lds + PG8_SB(b, h) + boff + n * 2048 + k * 1024); } while (0)
#define PG8_MMA(ai, bj, At, Bt) do { __builtin_amdgcn_s_setprio(1); _Pragma("unroll") for (int m = 0; m < 4; ++m) _Pragma("unroll") for (int n = 0; n < 2; ++n) _Pragma("unroll") for (int k = 0; k < 2; ++k) \
        acc[ai][bj][m][n] = __builtin_amdgcn_mfma_f32_16x16x32_bf16(Bt[n][k], At[m][k], acc[ai][bj][m][n], 0, 0, 0); __builtin_amdgcn_s_setprio(0); } while (0)
#define PG8_WAIT_V(n) asm volatile("s_waitcnt vmcnt(" #n ")" ::: "memory")
#define PG8_WAIT_L(n) asm volatile("s_waitcnt lgkmcnt(" #n ")" ::: "memory")
#define PG8_BAR __builtin_amdgcn_s_barrier()
#define PG8_SCHED __builtin_amdgcn_sched_barrier(0)
    Unit cur, nxt; int ui = 0;
    if (!S.next(0, cur)) return;
    f32x4 acc[2][2][4][2];
#pragma unroll
    for (int a = 0; a < 2; ++a)
#pragma unroll
        for (int b = 0; b < 2; ++b)
#pragma unroll
            for (int m = 0; m < 4; ++m)
#pragma unroll
                for (int n = 0; n < 2; ++n) acc[a][b][m][n] = (f32x4){0.f, 0.f, 0.f, 0.f};
    bf16x8 At[4][2], B0[2][2], B1[2][2];
    const char* cA = (const char*)g.A + (size_t)cur.pm * tstep; const char* cB = (const char*)g.Bt + (size_t)cur.pb * tstep;
    S.a_ready(cur);
    if constexpr (SP2) {
        PG8_STAGE(PG8_SB(0, 0), cB, voffB); PG8_STAGE(PG8_SB(0, 1), cB + hstep, voffB); PG8_STAGE(PG8_SA(0, 0), cA, voffA); PG8_STAGE(PG8_SA(0, 1), cA + hstep, voffA);
        if (wr == 1) PG8_BAR;
        PG8_WAIT_V(2); PG8_BAR;
        PG8_STAGE(PG8_SB(1, 0), cB + kstep, voffB); PG8_STAGE(PG8_SA(1, 0), cA + kstep, voffA); PG8_STAGE(PG8_SB(1, 1), cB + hstep + kstep, voffB);
        PG8_WAIT_V(6); PG8_BAR;
    } else {
        PG8_STAGE(PG8_SB(0, 0), cB, voffB); PG8_STAGE(PG8_SA(0, 0), cA, voffA); PG8_STAGE(PG8_SB(0, 1), cB + hstep, voffB); PG8_STAGE(PG8_SA(0, 1), cA + hstep, voffA);
        if (wr == 1) PG8_BAR;
        PG8_WAIT_V(4); PG8_BAR;
        PG8_STAGE(PG8_SB(1, 0), cB + kstep, voffB); PG8_STAGE(PG8_SA(1, 0), cA + kstep, voffA); PG8_STAGE(PG8_SB(1, 1), cB + hstep + kstep, voffB);
        PG8_WAIT_V(6); PG8_BAR;
    }
    for (;;) {
        const bool has_next = S.next(ui + 1, nxt);
        const char* nA = has_next ? (const char*)g.A + (size_t)nxt.pm * tstep : cA; const char* nB = has_next ? (const char*)g.Bt + (size_t)nxt.pb * tstep : cB;
        for (int t = 0; t < nt; t += 2) {
            const bool last = (t == nt - 2);
            const char* a1 = cA + (size_t)(t + 1) * kstep;
            const char* a2 = last ? nA : cA + (size_t)(t + 2) * kstep; const char* b2 = last ? nB : cB + (size_t)(t + 2) * kstep;
            const char* a3 = a2 + kstep; const char* b3 = b2 + kstep;
            if (last && has_next) S.a_ready(nxt);
            if constexpr (SP2) {
            PG8_LDB(B0, 0, 0); PG8_LDB(B1, 0, 1); PG8_SCHED; PG8_LDA(At, 0, 0); PG8_STAGE(PG8_SA(1, 1), a1 + hstep, voffA);
            PG8_WAIT_V(8); PG8_WAIT_L(0); PG8_BAR; PG8_MMA(0, 0, At, B0); PG8_MMA(0, 1, At, B1); PG8_BAR; PG8_SCHED;
            PG8_LDA(At, 0, 1); PG8_STAGE(PG8_SB(0, 0), b2, voffB); PG8_STAGE(PG8_SB(0, 1), b2 + hstep, voffB); PG8_STAGE(PG8_SA(0, 0), a2, voffA);
            PG8_WAIT_V(8); PG8_WAIT_L(0); PG8_BAR; PG8_MMA(1, 0, At, B0); PG8_MMA(1, 1, At, B1); PG8_BAR; PG8_SCHED;
            PG8_LDB(B0, 1, 0); PG8_LDB(B1, 1, 1); PG8_SCHED; PG8_LDA(At, 1, 0); PG8_STAGE(PG8_SA(0, 1), a2 + hstep, voffA);
            PG8_WAIT_V(8); PG8_WAIT_L(0); PG8_BAR; PG8_MMA(0, 0, At, B0); PG8_MMA(0, 1, At, B1); PG8_BAR; PG8_SCHED;
            PG8_LDA(At, 1, 1); PG8_STAGE(PG8_SB(1, 0), b3, voffB); PG8_STAGE(PG8_SB(1, 1), b3 + hstep, voffB); PG8_STAGE(PG8_SA(1, 0), a3, voffA);
            PG8_WAIT_V(8); PG8_WAIT_L(0); PG8_BAR; PG8_MMA(1, 0, At, B0); PG8_MMA(1, 1, At, B1); PG8_BAR; PG8_SCHED;
            } else {
            PG8_LDB(B0, 0, 0); PG8_SCHED; PG8_LDA(At, 0, 0); PG8_STAGE(PG8_SA(1, 1), a1 + hstep, voffA);
            PG8_WAIT_L(8); PG8_BAR; PG8_WAIT_L(0); PG8_MMA(0, 0, At, B0); PG8_BAR; PG8_SCHED;
            PG8_LDB(B1, 0, 1); PG8_STAGE(PG8_SB(0, 0), b2, voffB);
            PG8_BAR; PG8_WAIT_L(0); PG8_MMA(0, 1, At, B1); PG8_BAR;
            PG8_LDA(At, 0, 1); PG8_STAGE(PG8_SA(0, 0), a2, voffA);
            PG8_BAR; PG8_WAIT_L(0); PG8_MMA(1, 0, At, B0); PG8_BAR; PG8_SCHED;
            PG8_STAGE(PG8_SB(0, 1), b2 + hstep, voffB);
            PG8_WAIT_V(6); PG8_BAR; PG8_MMA(1, 1, At, B1); PG8_BAR;
            PG8_LDB(B0, 1, 0); PG8_SCHED; PG8_LDA(At, 1, 0); PG8_STAGE(PG8_SA(0, 1), a2 + hstep, voffA);
            PG8_WAIT_L(8); PG8_BAR; PG8_WAIT_L(0); PG8_MMA(0, 0, At, B0); PG8_BAR; PG8_SCHED;
            PG8_LDB(B1, 1, 1); PG8_STAGE(PG8_SB(1, 0), b3, voffB);
            PG8_BAR; PG8_WAIT_L(0); PG8_MMA(0, 1, At, B1); PG8_BAR;
            PG8_LDA(At, 1, 1); PG8_STAGE(PG8_SA(1, 0), a3, voffA);
            PG8_BAR; PG8_WAIT_L(0); PG8_MMA(1, 0, At, B0); PG8_BAR; PG8_SCHED;
            PG8_STAGE(PG8_SB(1, 1), b3 + hstep, voffB);
            PG8_WAIT_V(6); PG8_BAR; PG8_MMA(1, 1, At, B1); PG8_BAR;
            }
        }
        if constexpr (ALIGN_EPI) { if (wr == 0) PG8_BAR; }
        if constexpr (!Epi::AFTER_DRAIN) { E(acc, cur, wr, wc, fr, fq); S.done(cur); }
        if (!has_next) break;
#pragma unroll
        for (int a = 0; a < 2; ++a)
#pragma unroll
            for (int b = 0; b < 2; ++b)
#pragma unroll
                for (int m = 0; m < 4; ++m)
#pragma unroll
                    for (int n = 0; n < 2; ++n) acc[a][b][m][n] = (f32x4){0.f, 0.f, 0.f, 0.f};
        cur = nxt; cA = nA; cB = nB; ++ui;
        if constexpr (ALIGN_EPI) { if (wr == 1) PG8_BAR; }
    }
    PG8_WAIT_V(0);
    if constexpr (!ALIGN_EPI) { if (wr == 0) PG8_BAR; }
    PG8_BAR;
    if constexpr (Epi::AFTER_DRAIN) { E.fused(acc, cur, wr, wc, fr, fq, lds, wid, lane); S.done(cur); }
#undef PG8_SA
#undef PG8_SB
#undef PG8_STAGE
#undef PG8_LDA
#undef PG8_LDB
#undef PG8_MMA
#undef PG8_WAIT_V
#undef PG8_WAIT_L
#undef PG8_BAR
#undef PG8_SCHED
}
}
constexpr int NB = 8, SEQ = 2048, DM = 1024, CTXL = 256, ML = NB * SEQ, MC = NB * CTXL, MT = ML + MC;
constexpr int PP = 2560;
constexpr int INW = 2336;
constexpr int C_GK = 0, C_GV = 128, C_GAF = 384, C_GAB = 400, C_NK = 416, C_NV = 672, C_SK = 928, C_SV = 1056, C_GQ = 1184, C_GG = 1312, C_NQ = 1568, C_SQ = 1824;
constexpr int NWAVES = 8;
constexpr float NEPS = 1e-6f;
constexpr float LOG2E = 1.4426950408889634f;

constexpr size_t MiB = 1u << 20;
constexpr size_t WS_CTL = 0, CTL_ZERO_BYTES = 1 * MiB;
constexpr size_t WS_TAB = 1 * MiB;
constexpr size_t WS_MOD = 1 * MiB + 65536;
constexpr size_t WS_MODP = 2 * MiB;
constexpr size_t WS_WIN = 6 * MiB;
constexpr size_t WS_WOUT = 16 * MiB;
constexpr size_t WS_WGU = 20 * MiB;
constexpr size_t WS_WD = 148 * MiB;
constexpr size_t WS_H = 212 * MiB;
constexpr size_t WS_R1 = 248 * MiB;
constexpr size_t WS_R2 = 338 * MiB;
constexpr size_t WS_XB = 410 * MiB;
constexpr size_t WS_UST = 446 * MiB;
constexpr size_t WS_MISC = 464 * MiB;
constexpr size_t WS_DEC = WS_MISC;
constexpr size_t WS_AFF = WS_MISC + 1 * MiB;
constexpr size_t WS_AFFC = WS_MISC + 2 * MiB;
constexpr size_t WS_GATE = WS_MISC + 2 * MiB + 262144;
constexpr size_t WS_GATEC = WS_MISC + 2 * MiB + 524288;
constexpr size_t WS_INV = WS_MISC + 3 * MiB;
constexpr size_t WS_END = 468 * MiB;
constexpr int CW_BAR = 4096;
constexpr int CW_QUEUE = 1024;

constexpr int WAVE_LDS = 19456;
constexpr int RING_BYTES = NWAVES * WAVE_LDS;
constexpr int LDSCTL_OFF = RING_BYTES, MISC_OFF = LDSCTL_OFF + 320;
constexpr int LDS_BYTES = RING_BYTES + 1024;
static_assert(RING_BYTES >= pg8::STAGE_BYTES && LDS_BYTES <= 163840, "LDS map");

#define GAS __attribute__((address_space(1)))
#define LAS __attribute__((address_space(3)))
typedef unsigned short bf16_t;
typedef unsigned v4u __attribute__((ext_vector_type(4)));
typedef unsigned v2u __attribute__((ext_vector_type(2)));
typedef float f32x4 __attribute__((ext_vector_type(4)));
typedef float f32x2 __attribute__((ext_vector_type(2)));
typedef float f32x16 __attribute__((ext_vector_type(16)));
typedef short bf16x8 __attribute__((ext_vector_type(8)));
typedef short s16x4 __attribute__((ext_vector_type(4)));
typedef GAS unsigned gu32;
#define RLX_AGENT __ATOMIC_RELAXED, __HIP_MEMORY_SCOPE_AGENT
typedef __bf16 bf16x2_t __attribute__((ext_vector_type(2)));
__device__ __forceinline__ unsigned pk2(float lo, float hi) { f32x2 v = {lo, hi}; bf16x2_t b = __builtin_convertvector(v, bf16x2_t); return __builtin_bit_cast(unsigned, b); }
__device__ __forceinline__ float bflo(unsigned w) { return __uint_as_float(w << 16); }
__device__ __forceinline__ float bfhi(unsigned w) { return __uint_as_float(w & 0xffff0000u); }
__device__ __forceinline__ float bf1(bf16_t w) { return __uint_as_float((unsigned)w << 16); }
__device__ __forceinline__ float wave_sum(float v) {
#pragma unroll
    for (int o = 1; o < 64; o <<= 1) v += __shfl_xor(v, o);
    return v;
}
__device__ __forceinline__ float fexp2(float x) { return __builtin_amdgcn_exp2f(x); }
__device__ __forceinline__ float fexp(float x) { return __builtin_amdgcn_exp2f(x * LOG2E); }
__device__ __forceinline__ float flog(float x) { return __builtin_amdgcn_logf(x) * 0.6931471805599453f; }
__device__ __forceinline__ float frcp(float x) { return __builtin_amdgcn_rcpf(x); }
__device__ __forceinline__ float silu_f(float x) { return x * frcp(1.f + fexp(-x)); }
__device__ __forceinline__ int crow(int r, int hi) { return (r & 3) + 8 * (r >> 2) + 4 * hi; }
__device__ __forceinline__ s16x4 tr_read(LAS const unsigned char* p) { return __builtin_bit_cast(s16x4, __builtin_amdgcn_ds_read_tr16_b64_v4i16((LAS s16x4*)p)); }
__device__ __forceinline__ bf16x8 cat4(s16x4 a, s16x4 b) { return (bf16x8){a[0], a[1], a[2], a[3], b[0], b[1], b[2], b[3]}; }
__device__ __forceinline__ bf16x8 pack8(float a0, float a1, float a2, float a3, float a4, float a5, float a6, float a7) {
    v4u w; w.x = pk2(a0, a1); w.y = pk2(a2, a3); w.z = pk2(a4, a5); w.w = pk2(a6, a7); return __builtin_bit_cast(bf16x8, w); }
#define MFMA32(a, b, c) __builtin_amdgcn_mfma_f32_32x32x16_bf16((a), (b), (c), 0, 0, 0)

#define XB_TMO      128
#define XB_XCNT(j)  (256  + 64 * (j))
#define XB_XSUB(j)  (1280 + 64 * (j))
#define XB_XGEN(j)  (2304 + 64 * (j))
#define XB_TOP      3328
#define XB_TOPGEN   3392
#define XCD_BAR_WORDS 3456
#define XB_SPIN_CAP (1u << 18)

__device__ __forceinline__ unsigned xb_ld(unsigned* p)              { return __hip_atomic_load(p, __ATOMIC_RELAXED, __HIP_MEMORY_SCOPE_AGENT); }
__device__ __forceinline__ unsigned xb_add(unsigned* p, unsigned v) { return __hip_atomic_fetch_add(p, v, __ATOMIC_RELAXED, __HIP_MEMORY_SCOPE_AGENT); }
__device__ __forceinline__ unsigned xb_xcc_id() { return (unsigned)__builtin_amdgcn_s_getreg((3 << 11) | 20) & 0xFu; }
#define XB_SPIN(cond, bar) do { unsigned _sp = 0; while (cond) { __builtin_amdgcn_s_sleep(1); \
    if ((++_sp & 255u) == 0u) { if (xb_ld(&(bar)[XB_TMO])) break; if (_sp > XB_SPIN_CAP) { atomicAdd(&(bar)[XB_TMO], 1u); break; } } } } while (0)

struct XcdBarrier {
    unsigned* bar; unsigned x;
    volatile LAS unsigned* st;
};

__device__ __forceinline__ XcdBarrier xcd_barrier_post(unsigned* bar, volatile LAS unsigned* st) {
    XcdBarrier b; b.bar = bar; b.x = xb_xcc_id(); b.st = st;
    if (threadIdx.x == 0) (void)xb_add(&bar[XB_XCNT(b.x)], 1u);
    return b;
}
__device__ __forceinline__ void xcd_barrier_complete(unsigned* bar, unsigned x, unsigned& nloc, unsigned& nx) {
    const unsigned G = gridDim.x * gridDim.y * gridDim.z;
    unsigned sum, cnt, mine, sp = 0u;
    for (;;) {
        sum = 0u; cnt = 0u; mine = 0u;
#pragma unroll
        for (unsigned j = 0; j < 16; ++j) { const unsigned c = xb_ld(&bar[XB_XCNT(j)]); sum += c; cnt += (c > 0u) ? 1u : 0u; mine = (j == x) ? c : mine; }
        if (sum == G) break;
        __builtin_amdgcn_s_sleep(1);
        if ((++sp & 255u) == 0u) { if (xb_ld(&bar[XB_TMO])) break; if (sp > XB_SPIN_CAP) { atomicAdd(&bar[XB_TMO], 1u); break; } }
    }
    nloc = mine > 0u ? mine : 1u; nx = cnt > 0u ? cnt : 1u;
}

__device__ __forceinline__ void xcd_barrier(const XcdBarrier& b) {
    asm volatile("s_waitcnt vmcnt(0)" ::: "memory");
    __syncthreads();
    if (threadIdx.x == 0) {
        unsigned* bar = b.bar;
        __builtin_amdgcn_s_waitcnt(0);
        unsigned nloc = b.st[0], nx = b.st[1];
        if (nloc == 0u) { xcd_barrier_complete(bar, b.x, nloc, nx); b.st[0] = nloc; b.st[1] = nx; }
        const unsigned old = xb_add(&bar[XB_XSUB(b.x)], 1u);
        const unsigned gen = old / nloc;
        if (old + 1u == (gen + 1u) * nloc) {
            __builtin_amdgcn_fence(__ATOMIC_RELEASE, "agent");
            asm volatile("s_waitcnt vmcnt(0)" ::: "memory");
            const unsigned og = xb_add(&bar[XB_TOP], 1u);
            const unsigned tg = og / nx;
            if (og + 1u == (tg + 1u) * nx) xb_add(&bar[XB_TOPGEN], 1u);
            else XB_SPIN(xb_ld(&bar[XB_TOPGEN]) == tg, bar);
            __builtin_amdgcn_fence(__ATOMIC_ACQUIRE, "agent");
            xb_add(&bar[XB_XGEN(b.x)], 1u);
            asm volatile("s_waitcnt vmcnt(0)" ::: "memory");
        } else {
            XB_SPIN(xb_ld(&bar[XB_XGEN(b.x)]) == gen, bar);
            __builtin_amdgcn_fence(__ATOMIC_ACQUIRE, "agent");
            asm volatile("s_waitcnt vmcnt(0)" ::: "memory");
        }
    }
    __syncthreads();
}
__device__ __forceinline__ void ld_row_f32(const float* p, int lane, f32x4 (&v)[4]) {
#pragma unroll
    for (int j = 0; j < 4; ++j) v[j] = *(const f32x4*)(p + 256 * j + 4 * lane);
}
__device__ __forceinline__ void st_row_f32(float* p, int lane, const f32x4 (&v)[4]) {
#pragma unroll
    for (int j = 0; j < 4; ++j) *(f32x4*)(p + 256 * j + 4 * lane) = v[j];
}
__device__ __forceinline__ void ld_row_bf16(const bf16_t* p, int lane, f32x4 (&v)[4]) {
#pragma unroll
    for (int j = 0; j < 4; ++j) { const v2u w = *(const v2u*)(p + 256 * j + 4 * lane); v[j] = (f32x4){bflo(w.x), bfhi(w.x), bflo(w.y), bfhi(w.y)}; }
}
__device__ __forceinline__ void st_row_bf16(bf16_t* p, int lane, const f32x4 (&v)[4]) {
#pragma unroll
    for (int j = 0; j < 4; ++j) { v2u w; w.x = pk2(v[j].x, v[j].y); w.y = pk2(v[j].z, v[j].w); *(v2u*)(p + 256 * j + 4 * lane) = w; }
}
__device__ __forceinline__ void ld_vec_lds(LAS const float* p, int lane, f32x4 (&v)[4]) {
#pragma unroll
    for (int j = 0; j < 4; ++j) v[j] = *(LAS const f32x4*)(p + 256 * j + 4 * lane);
}
__device__ __forceinline__ float sumsq16(const f32x4 (&v)[4]) {
    float s = 0.f;
#pragma unroll
    for (int j = 0; j < 4; ++j) s += (v[j].x * v[j].x + v[j].y * v[j].y) + (v[j].z * v[j].z + v[j].w * v[j].w);
    return s;
}
__device__ __forceinline__ float modfin(const float* modp, const float* bmod, int l, int r, int n) {
    float s = bmod[l * 6144 + n];
#pragma unroll
    for (int kc = 0; kc < 8; ++kc) s += modp[((size_t)(l * 8 + kc) * 9 + r) * 6144 + n];
    return s;
}

__device__ __forceinline__ void tr_item64(const float* W, int N, int Nvalid, bf16_t* WT, int Kd, int k0, int n0, int dst_row0, LAS float* scr, int lane) {
    const int q = lane & 15, kr = lane >> 4;
    f32x4 t[16];
#pragma unroll
    for (int i = 0; i < 16; ++i) { const int kk = 4 * i + kr; const int n = n0 + 4 * q;
        t[i] = (n < Nvalid) ? *(const f32x4*)(W + (size_t)(k0 + kk) * N + n) : (f32x4){0.f, 0.f, 0.f, 0.f}; }
#pragma unroll
    for (int i = 0; i < 16; ++i) { const int kk = 4 * i + kr; LAS float* d = scr + kk * 65 + 4 * q; d[0] = t[i].x; d[1] = t[i].y; d[2] = t[i].z; d[3] = t[i].w; }
    const int c = lane & 7, nl = lane >> 3;
#pragma unroll
    for (int j = 0; j < 8; ++j) { const int n = nl + 8 * j; LAS const float* s = scr + (8 * c) * 65 + n;
        v4u o; o.x = pk2(s[0 * 65], s[1 * 65]); o.y = pk2(s[2 * 65], s[3 * 65]); o.z = pk2(s[4 * 65], s[5 * 65]); o.w = pk2(s[6 * 65], s[7 * 65]);
        *(v4u*)(WT + (size_t)(dst_row0 + n) * Kd + k0 + 8 * c) = o; }
}
__device__ __forceinline__ void phase_p0(const float* const* in, unsigned char* ws, LAS unsigned char* wl, int gw, int NGW, int lane) {
    const float* cvec = in[1]; const float* cctx = in[3]; const float* wmod = in[4];
    const float* w_in = in[7]; const float* w_out = in[8]; const float* w_gate = in[15]; const float* w_up = in[16]; const float* w_down = in[17];
    float* modp = (float*)(ws + WS_MODP);
    constexpr int NI_MOD = 2 * 8 * 24, NI_ROPE = 16;
    constexpr int NI_IN = 16 * 40, NI_OUT = 16 * 16, NI_E = 16 * 16 * 16;
    constexpr int NI_L = NI_IN + NI_OUT + 3 * NI_E;
    constexpr int NITEMS = NI_MOD + NI_ROPE + 2 * NI_L;
    LAS float* scr = (LAS float*)wl;
    for (int it = gw; it < NITEMS; it += NGW) {
        int r = it;
        if (r < NI_MOD) {
            const int cb = r % 24, kc = (r / 24) & 7, l = r / 192;
            for (int idx = lane; idx < 128 * 9; idx += 64) { const int rr = idx / 128, k = idx % 128; const float cv = (rr < 8) ? cvec[rr * 1024 + kc * 128 + k] : cctx[kc * 128 + k]; scr[k * 12 + rr] = silu_f(cv); }
            f32x4 acc[9];
#pragma unroll
            for (int rr = 0; rr < 9; ++rr) acc[rr] = (f32x4){0.f, 0.f, 0.f, 0.f};
            const float* wp = wmod + ((size_t)l * 1024 + kc * 128) * 6144 + cb * 256 + 4 * lane;
#pragma unroll 4
            for (int k = 0; k < 128; ++k) { const f32x4 w = *(const f32x4*)(wp + (size_t)k * 6144);
                const f32x4 s0 = *(LAS const f32x4*)(scr + k * 12), s1 = *(LAS const f32x4*)(scr + k * 12 + 4); const float s8 = scr[k * 12 + 8];
                acc[0] += w * s0.x; acc[1] += w * s0.y; acc[2] += w * s0.z; acc[3] += w * s0.w; acc[4] += w * s1.x; acc[5] += w * s1.y; acc[6] += w * s1.z; acc[7] += w * s1.w; acc[8] += w * s8; }
#pragma unroll
            for (int rr = 0; rr < 9; ++rr) *(f32x4*)(modp + ((size_t)(l * 8 + kc) * 9 + rr) * 6144 + cb * 256 + 4 * lane) = acc[rr];
            continue;
        }
        r -= NI_MOD;
        if (r < NI_ROPE) {
            const int id = r * 64 + lane, pos = id >> 4, i = id & 15;
            const float fr = fexp2(-(float)i * (13.287712379549449f / 16.f));
            float rev = (float)pos * fr * 0.15915494309189535f; rev -= floorf(rev);
            f32x2 cs; cs.x = __builtin_amdgcn_cosf(rev); cs.y = __builtin_amdgcn_sinf(rev);
            ((f32x2*)(ws + WS_TAB))[id] = cs;
            continue;
        }
        r -= NI_ROPE;
        const int l = r / NI_L; r -= l * NI_L;
        if (r < NI_IN) { const int kb = r / 40, nb = r % 40;
            tr_item64(w_in + (size_t)l * 1024 * INW, INW, INW, (bf16_t*)(ws + WS_WIN) + (size_t)l * PP * 1024, 1024, 64 * kb, 64 * nb, 64 * nb, scr, lane); continue; }
        r -= NI_IN;
        if (r < NI_OUT) { const int kb = r / 16, nb = r % 16;
            tr_item64(w_out + (size_t)l * 1024 * 1024, 1024, 1024, (bf16_t*)(ws + WS_WOUT) + (size_t)l * 1024 * 1024, 1024, 64 * kb, 64 * nb, 64 * nb, scr, lane); continue; }
        r -= NI_OUT;
        const int which = r / NI_E; r -= which * NI_E;
        const int e = r / 256, kb = (r % 256) / 16, nb = r % 16, n0 = 64 * nb;
        const size_t eoff = (size_t)(l * 16 + e) * 1024 * 1024;
        if (which == 0) tr_item64(w_gate + eoff, 1024, 1024, (bf16_t*)(ws + WS_WGU) + 2 * eoff, 1024, 64 * kb, n0, (n0 >> 7) * 256 + (n0 & 127), scr, lane);
        else if (which == 1) tr_item64(w_up + eoff, 1024, 1024, (bf16_t*)(ws + WS_WGU) + 2 * eoff, 1024, 64 * kb, n0, (n0 >> 7) * 256 + 128 + (n0 & 127), scr, lane);
        else tr_item64(w_down + eoff, 1024, 1024, (bf16_t*)(ws + WS_WD) + eoff, 1024, 64 * kb, n0, n0, scr, lane);
    }
}

__device__ __forceinline__ void phase_a0(const float* const* in, unsigned char* ws, LAS unsigned char* lds, int G, int tid, int wave, int lane) {
    const float* x = in[0]; const float* ctx = in[2]; const float* bmod = in[5]; const float* gains = in[6];
    const float* modp = (const float*)(ws + WS_MODP); float* mod = (float*)(ws + WS_MOD); bf16_t* H = (bf16_t*)(ws + WS_H);
    LAS float* V = (LAS float*)lds;
    for (int row = blockIdx.x; row < 18; row += G) { const int l = row / 9, r = row % 9;
        for (int n = tid; n < 6144; n += 512) mod[(size_t)row * 6144 + n] = modfin(modp, bmod, l, r, n); }
    for (int t = blockIdx.x; t < 256; t += G) {
        const int b = t >> 5;
        __syncthreads();
        for (int n = tid; n < 1024; n += 512) { const float g = gains[n];
            V[n] = g * (1.f + modfin(modp, bmod, 0, b, 1024 + n)); V[1024 + n] = modfin(modp, bmod, 0, b, n);
            V[2048 + n] = g * (1.f + modfin(modp, bmod, 0, 8, 1024 + n)); V[3072 + n] = modfin(modp, bmod, 0, 8, n); }
        __syncthreads();
#pragma unroll 1
        for (int i0 = 0; i0 < 9; i0 += 3) {
            f32x4 xq[3][4];
#pragma unroll
            for (int k = 0; k < 3; ++k) { const int i = i0 + k; const bool isc = (i == 8);
                const float* src = isc ? (ctx + (size_t)(8 * t + wave) * 1024) : (x + (size_t)(64 * t + 8 * wave + i) * 1024); ld_row_f32(src, lane, xq[k]); }
#pragma unroll
            for (int k = 0; k < 3; ++k) { const int i = i0 + k; const bool isc = (i == 8);
                const int row = isc ? (ML + 8 * t + wave) : (64 * t + 8 * wave + i);
                f32x4 (&v)[4] = xq[k]; f32x4 a[4], s[4];
                const float rstd = __builtin_amdgcn_rsqf(wave_sum(sumsq16(v)) * (1.f / 1024.f) + NEPS);
                ld_vec_lds(V + (isc ? 2048 : 0), lane, a); ld_vec_lds(V + (isc ? 3072 : 1024), lane, s);
#pragma unroll
                for (int j = 0; j < 4; ++j) v[j] = v[j] * rstd * a[j] + s[j];
                st_row_bf16(H + (size_t)row * 1024, lane, v);
            }
        }
    }
}
constexpr int VP = 192;
struct AttnTile { f32x16 o0, o1; float m, lsum; };
__device__ __forceinline__ void attn_softmax(f32x16& s, AttnTile& T) {
    float bm = fmaxf(fmaxf(s[0], s[1]), fmaxf(s[2], s[3]));
#pragma unroll
    for (int i = 4; i < 16; i += 4) bm = fmaxf(bm, fmaxf(fmaxf(s[i], s[i + 1]), fmaxf(s[i + 2], s[i + 3])));
    bm = fmaxf(bm, __shfl_xor(bm, 32));
    const float mo = T.m, mn = fmaxf(mo, bm);
    T.m = mn;
    float ps = 0.f;
#pragma unroll
    for (int i = 0; i < 16; ++i) { s[i] = fexp2(s[i] - mn); ps += s[i]; }
    if (__any(mn != mo)) {
        const float alpha = fexp2(mo - mn);
        T.lsum *= alpha;
#pragma unroll
        for (int i = 0; i < 16; ++i) { T.o0[i] *= alpha; T.o1[i] *= alpha; }
    }
    T.lsum += ps;
}
__device__ __forceinline__ void attn_item(const int MODE, const bf16_t* P, bf16_t* MIX, int item, LAS unsigned char* wl, int lane,
                                          const float* __restrict__ rpb, const float* __restrict__ sink, const bool dry = false) {
    asm volatile("" : "+v"(lane));
    const int ql = lane & 31, hi = lane >> 5;
    int b, hq, qcol, kcol, vcol, ocol, qrow0, r = 0, rs = 0, q64 = 0, nloc, kb_lo = 0;
    if (MODE == 0) { r = item & 31; hq = (item >> 5) & 3; b = item >> 7;
        qcol = C_NQ + hq * 64; kcol = C_NK + hq * 64; vcol = C_NV + hq * 64; ocol = 256 + hq * 64; qrow0 = b * SEQ + r * 64;
        rs = r - 4; rs = rs < 0 ? 0 : (rs > 24 ? 24 : rs); nloc = 16; }
    else if (MODE == 1) { q64 = item & 31; hq = (item >> 5) & 7; b = item >> 8;
        qcol = C_SQ + hq * 64; kcol = C_SK + (hq >> 2) * 64; vcol = C_SV + (hq >> 2) * 64; ocol = 512 + hq * 64; qrow0 = b * SEQ + q64 * 64;
        kb_lo = 2 * q64 - 4; if (kb_lo < 0) kb_lo = 0; int kb_hi = 2 * q64 + 5; if (kb_hi > 63) kb_hi = 63; nloc = kb_hi - kb_lo + 1; }
    else if (MODE == 2) { q64 = item & 3; hq = (item >> 2) & 3; b = item >> 4;
        qcol = C_NQ + hq * 64; kcol = C_NK + hq * 64; vcol = C_NV + hq * 64; ocol = 256 + hq * 64; qrow0 = ML + b * CTXL + q64 * 64; nloc = 0; }
    else { q64 = item & 3; hq = (item >> 2) & 7; b = item >> 5;
        qcol = C_SQ + hq * 64; kcol = C_SK + (hq >> 2) * 64; vcol = C_SV + (hq >> 2) * 64; ocol = 512 + hq * 64; qrow0 = ML + b * CTXL + q64 * 64; nloc = 0; }
    const int nblk = 8 + nloc;
    LAS unsigned char* vl = wl;
    LAS float* rl = (LAS float*)(wl + 32 * VP);
    if (MODE == 0) { for (int i = lane; i < 465; i += 64) rl[i] = rpb[hq * 465 + i] * LOG2E; }
    LAS unsigned char* qimg = wl + 32 * VP + 1920;
    constexpr int QP = 144;
#pragma unroll
    for (int i = 0; i < 8; ++i) { const int c = lane + 64 * i; const v4u v = *(const v4u*)(P + (size_t)(qrow0 + (c >> 3)) * PP + qcol + (c & 7) * 8); *(LAS v4u*)(qimg + (c >> 3) * QP + (c & 7) * 16) = v; }
    LAS const unsigned char* qrd = qimg + ql * QP + 16 * hi;
    auto blk_row0 = [&](int blk) -> int {
        if (blk < 8) return ML + b * CTXL + blk * 32;
        const int lb = blk - 8;
        if (MODE == 0) return b * SEQ + (rs + (lb >> 1)) * 64 + (lb & 1) * 32;
        return b * SEQ + 32 * (kb_lo + lb);
    };
    auto load_blk = [&](int blk, bf16x8 (&kn)[4], v4u (&vn)[4]) {
        const int r0 = blk_row0(blk);
        const bf16_t* kp = P + (size_t)(r0 + ql) * PP + kcol + 8 * hi;
#pragma unroll
        for (int ds = 0; ds < 4; ++ds) kn[ds] = *(const bf16x8*)(kp + 16 * ds);
#pragma unroll
        for (int i = 0; i < 4; ++i) { const int c = lane + 64 * i; vn[i] = *(const v4u*)(P + (size_t)(r0 + (c >> 3)) * PP + vcol + (c & 7) * 8); }
    };
    AttnTile T[2];
#pragma unroll
    for (int t = 0; t < 2; ++t) { T[t].m = -INFINITY; T[t].lsum = 0.f;
#pragma unroll
        for (int i = 0; i < 16; ++i) { T[t].o0[i] = 0.f; T[t].o1[i] = 0.f; } }
    const int tr_off = (4 * hi + ((lane & 15) >> 2)) * VP + (16 * ((lane >> 4) & 1) + 4 * (lane & 3)) * 2;
    auto step = [&](int blk, bf16x8 (&kf)[4], v4u (&vr)[4]) {
#pragma unroll
        for (int i = 0; i < 4; ++i) { const int c = lane + 64 * i; *(LAS v4u*)(vl + (c >> 3) * VP + (c & 7) * 16) = vr[i]; }
        f32x16 sc[2];
#pragma unroll
        for (int t = 0; t < 2; ++t) {
#pragma unroll
            for (int i = 0; i < 16; ++i) sc[t][i] = 0.f;
#pragma unroll
            for (int ds = 0; ds < 4; ++ds) sc[t] = MFMA32(kf[ds], *(LAS const bf16x8*)(qrd + 32 * t * QP + 32 * ds), sc[t]);
        }
        if (blk + 2 < nblk) load_blk(blk + 2, kf, vr);
        bf16x8 vf[2][2];
#pragma unroll
        for (int ks = 0; ks < 2; ++ks) { LAS const unsigned char* vb = vl + tr_off + 16 * ks * VP;
            vf[ks][0] = cat4(tr_read(vb), tr_read(vb + 8 * VP)); vf[ks][1] = cat4(tr_read(vb + 64), tr_read(vb + 8 * VP + 64)); }
#pragma unroll
        for (int t = 0; t < 2; ++t) {
            f32x16& s = sc[t];
            if (MODE == 0 && blk >= 8) {
                const int lb = blk - 8, j = lb >> 1, ch = lb & 1, c = t * 32 + ql;
                int cs = c - 8; cs = cs < 0 ? 0 : (cs > 48 ? 48 : cs);
                LAS const float* rrow = rl + (rs + j - r + 7) * 31 + (15 - c);
#pragma unroll
                for (int i = 0; i < 16; ++i) { const int kc = ch * 32 + crow(i, hi); const bool ok = (kc >= cs) && (kc < cs + 16);
                    const float bias = rrow[ok ? kc : c];
                    s[i] = ok ? (s[i] + bias) : -INFINITY; }
            } else if (MODE == 1 && blk >= 8) {
                const int rel = (kb_lo + blk - 8) - (2 * q64 + t);
                if (rel <= -4 || rel >= 4) {
#pragma unroll
                    for (int i = 0; i < 16; ++i) { const int kk = crow(i, hi); const bool ok = (rel == -4) ? (kk >= ql) : ((rel == 4) ? (kk <= ql) : false);
                        s[i] = ok ? s[i] : -INFINITY; }
                }
            }
            attn_softmax(s, T[t]);
#pragma unroll
            for (int ks = 0; ks < 2; ++ks) {
                const bf16x8 pf = pack8(s[8 * ks + 0], s[8 * ks + 1], s[8 * ks + 2], s[8 * ks + 3], s[8 * ks + 4], s[8 * ks + 5], s[8 * ks + 6], s[8 * ks + 7]);
                T[t].o0 = MFMA32(vf[ks][0], pf, T[t].o0); T[t].o1 = MFMA32(vf[ks][1], pf, T[t].o1);
            }
            __builtin_amdgcn_sched_barrier(0);
        }
    };
    bf16x8 kA[4], kB[4]; v4u vA[4], vB[4];
    load_blk(0, kA, vA); load_blk(1, kB, vB);
    for (int blk = 0; blk < nblk; blk += 2) { step(blk, kA, vA); if (blk + 1 < nblk) step(blk + 1, kB, vB); }
#pragma unroll
    for (int t = 0; t < 2; ++t) {
        float lt = T[t].lsum + __shfl_xor(T[t].lsum, 32);
        if (MODE == 1 || MODE == 3) lt += fexp2(sink[hq] * LOG2E - T[t].m);
        const float inv = frcp(lt);
        bf16_t* op = MIX + (size_t)(qrow0 + 32 * t + ql) * 1024 + ocol + 4 * hi;
#pragma unroll
        for (int g = 0; g < 4; ++g) {
            v2u w0, w1; w0.x = pk2(T[t].o0[4 * g] * inv, T[t].o0[4 * g + 1] * inv); w0.y = pk2(T[t].o0[4 * g + 2] * inv, T[t].o0[4 * g + 3] * inv);
            w1.x = pk2(T[t].o1[4 * g] * inv, T[t].o1[4 * g + 1] * inv); w1.y = pk2(T[t].o1[4 * g + 2] * inv, T[t].o1[4 * g + 3] * inv);
            *(v2u*)(op + 8 * g) = w0; *(v2u*)(op + 32 + 8 * g) = w1;
        }
    }
}
constexpr int GP = 144;
constexpr int G_V = 0, G_A = 64 * GP, G_B = 64 * GP + 32 * GP;
static_assert(G_B + 32 * GP <= WAVE_LDS, "gla LDS");

struct GlaCum { float cum[2][16]; float tot; };
__device__ __forceinline__ void gla_cum(const bf16_t* P, int row0, int hh, int dir, const float* __restrict__ a_up, const float* __restrict__ a_bias, int lane, GlaCum& C) {
    const int kk = lane & 31, hi = lane >> 5;
    const float* up = a_up + (size_t)dir * 16 * 128 + (size_t)(8 * hi) * 128 + hh * 32 + kk;
    const bf16x8 ub = pack8(up[0], up[128], up[256], up[384], up[512], up[640], up[768], up[896]);
    const float bias = a_bias[dir * 128 + hh * 32 + kk];
    float gs[2][4];
#pragma unroll
    for (int tt = 0; tt < 2; ++tt) {
        const bf16x8 al = *(const bf16x8*)(P + (size_t)(row0 + 32 * tt + kk) * PP + C_GAF + 16 * dir + 8 * hi);
        f32x16 z;
#pragma unroll
        for (int i = 0; i < 16; ++i) z[i] = 0.f;
        z = MFMA32(al, ub, z);
#pragma unroll
        for (int g = 0; g < 4; ++g) { float run = 0.f;
#pragma unroll
            for (int e = 0; e < 4; ++e) { const float zz = z[4 * g + e] + bias; const float ls = fminf(zz, 0.f) - flog(1.f + fexp(-fabsf(zz)));
                const float l = ls * (1.f / 16.f);
                if (dir == 0) { run += l; C.cum[tt][4 * g + e] = run; } else { C.cum[tt][4 * g + e] = run; run += l; } }
            gs[tt][g] = run; }
    }
    float off = 0.f;
#pragma unroll
    for (int tt = 0; tt < 2; ++tt)
#pragma unroll
        for (int g = 0; g < 4; ++g) { const float other = __shfl_xor(gs[tt][g], 32); const float mine = off + (hi ? other : 0.f);
#pragma unroll
            for (int e = 0; e < 4; ++e) C.cum[tt][4 * g + e] += mine;
            off += gs[tt][g] + other; }
    C.tot = off;
    if (dir == 1) {
#pragma unroll
        for (int tt = 0; tt < 2; ++tt)
#pragma unroll
            for (int r = 0; r < 16; ++r) C.cum[tt][r] = off - C.cum[tt][r];
    }
}
__device__ __forceinline__ void gla_ld_tc(const bf16_t* P, int row0, int col, int lane, float (&x)[2][16]) {
    const int kk = lane & 31, hi = lane >> 5;
#pragma unroll
    for (int tt = 0; tt < 2; ++tt)
#pragma unroll
        for (int r = 0; r < 16; ++r) x[tt][r] = bf1(P[(size_t)(row0 + 32 * tt + crow(r, hi)) * PP + col + kk]);
}
__device__ __forceinline__ void gla_st_img(LAS unsigned char* img, int lane, const float (&x)[2][16]) {
    const int kk = lane & 31, hi = lane >> 5;
#pragma unroll
    for (int tt = 0; tt < 2; ++tt)
#pragma unroll
        for (int g = 0; g < 4; ++g) { v2u w; w.x = pk2(x[tt][4 * g], x[tt][4 * g + 1]); w.y = pk2(x[tt][4 * g + 2], x[tt][4 * g + 3]);
            *(LAS v2u*)(img + kk * GP + (32 * tt + 8 * g + 4 * hi) * 2) = w; }
}
__device__ __forceinline__ void gla_stage_v(const bf16_t* P, int row0, int hh, LAS unsigned char* wl, int lane) {
#pragma unroll
    for (int i = 0; i < 8; ++i) { const int c = lane + 64 * i; const v4u v = *(const v4u*)(P + (size_t)(row0 + (c >> 3)) * PP + C_GV + hh * 64 + (c & 7) * 8);
        *(LAS v4u*)(wl + G_V + (c >> 3) * GP + (c & 7) * 16) = v; }
}
__device__ __forceinline__ int gla_row0(int b, int nc) { return nc < 4 ? (ML + b * CTXL + 64 * nc) : (b * SEQ + 64 * (nc - 4)); }

__device__ __forceinline__ void gla_local_item(const bf16_t* P, float* UST, float* DEC, int item, LAS unsigned char* wl, int lane,
                                               const float* __restrict__ a_up, const float* __restrict__ a_bias) {
    asm volatile("" : "+v"(lane));
    const int nc = item % 36, hh = (item / 36) & 3, b = item / 144;
    const int row0 = gla_row0(b, nc), kk = lane & 31, hi = lane >> 5;
    gla_stage_v(P, row0, hh, wl, lane);
    float kv[2][16]; gla_ld_tc(P, row0, C_GK + hh * 32, lane, kv);
#pragma unroll
    for (int dir = 0; dir < 2; ++dir) {
        GlaCum C; gla_cum(P, row0, hh, dir, a_up, a_bias, lane, C);
        float kd[2][16];
#pragma unroll
        for (int tt = 0; tt < 2; ++tt)
#pragma unroll
            for (int r = 0; r < 16; ++r) kd[tt][r] = kv[tt][r] * fexp(C.tot - C.cum[tt][r]);
        gla_st_img(wl + (dir == 0 ? G_A : G_B), lane, kd);
        if (hi == 0) DEC[((size_t)((b * 4 + hh) * 2 + dir) * 36 + nc) * 32 + kk] = fexp(C.tot);
    }
    const int trv = ((lane & 15) >> 2) * GP + (16 * ((lane >> 4) & 1) + 4 * (lane & 3)) * 2;
#pragma unroll
    for (int dir = 0; dir < 2; ++dir) {
        f32x16 u0, u1;
#pragma unroll
        for (int i = 0; i < 16; ++i) { u0[i] = 0.f; u1[i] = 0.f; }
        LAS const unsigned char* img = wl + (dir == 0 ? G_A : G_B);
#pragma unroll
        for (int s = 0; s < 4; ++s) {
            const bf16x8 kb = *(LAS const bf16x8*)(img + kk * GP + (16 * s + 8 * hi) * 2);
            LAS const unsigned char* vb = wl + G_V + trv + (16 * s + 8 * hi) * GP;
            const bf16x8 v0 = cat4(tr_read(vb), tr_read(vb + 4 * GP));
            const bf16x8 v1 = cat4(tr_read(vb + 64), tr_read(vb + 4 * GP + 64));
            u0 = MFMA32(v0, kb, u0); u1 = MFMA32(v1, kb, u1);
        }
        float* up = UST + ((size_t)((b * 4 + hh) * 2 + dir) * 36 + nc) * 2048 + kk;
#pragma unroll
        for (int i = 0; i < 16; ++i) { up[(size_t)crow(i, hi) * 32] = u0[i]; up[(size_t)(32 + crow(i, hi)) * 32] = u1[i]; }
    }
}

__device__ __forceinline__ void gla_prefix(float* UST, const float* DEC, int gid, bool dry) {
    const int bhd = gid >> 11, e = gid & 2047, k = e & 31, dir = bhd & 1;
    float* base = UST + (size_t)bhd * 36 * 2048 + e; const float* dec = DEC + (size_t)bhd * 36 * 32 + k;
    float s = 0.f;
#pragma unroll 4
    for (int ci = 0; ci < 36; ++ci) {
        const int sl = dir == 0 ? ci : (ci < 4 ? 3 - ci : 39 - ci);
        const float u = base[(size_t)sl * 2048], d = dec[sl * 32];
        if (!dry) base[(size_t)sl * 2048] = s;
        s = d * s + u;
    }
}

__device__ __forceinline__ void gla_out_item(const bf16_t* P, const float* UST, bf16_t* MIX, int item, LAS unsigned char* wl, int lane,
                                             const float* __restrict__ a_up, const float* __restrict__ a_bias, const float* __restrict__ gnorm) {
    const int nc = item % 36, hh = (item / 36) & 3, b = item / 144;
    const int row0 = gla_row0(b, nc), kk = lane & 31, hi = lane >> 5;
    gla_stage_v(P, row0, hh, wl, lane);
    f32x16 o[2][2];
#pragma unroll
    for (int a = 0; a < 2; ++a)
#pragma unroll
        for (int c = 0; c < 2; ++c)
#pragma unroll
            for (int i = 0; i < 16; ++i) o[a][c][i] = 0.f;
    const int g16 = (lane >> 4) & 1, qq = (lane & 15) >> 2, pp = lane & 3;
    const int tri = (8 * hi + qq) * GP + (16 * g16 + 4 * pp) * 2;
    const int trv = (4 * hi + qq) * GP + (16 * g16 + 4 * pp) * 2;
#pragma unroll
    for (int dir = 0; dir < 2; ++dir) {
        GlaCum C; gla_cum(P, row0, hh, dir, a_up, a_bias, lane, C);
#pragma unroll
        for (int tt = 0; tt < 2; ++tt) {
            float cum[16];
#pragma unroll
            for (int r = 0; r < 16; ++r) cum[r] = C.cum[tt][r];
#pragma unroll
            for (int g = 0; g < 4; ++g) {
                float xq[4], xk[4];
#pragma unroll
                for (int e = 0; e < 4; ++e) { const size_t ro = (size_t)(row0 + 32 * tt + 8 * g + 4 * hi + e) * PP + hh * 32 + kk;
                    xq[e] = bf1(P[ro + C_GQ]) * 0.17677669529663687f * fexp(cum[4 * g + e]); xk[e] = bf1(P[ro + C_GK]) * fexp(-cum[4 * g + e]); }
                v2u wq, wk; wq.x = pk2(xq[0], xq[1]); wq.y = pk2(xq[2], xq[3]); wk.x = pk2(xk[0], xk[1]); wk.y = pk2(xk[2], xk[3]);
                const int off = kk * GP + (32 * tt + 8 * g + 4 * hi) * 2;
                *(LAS v2u*)(wl + G_A + off) = wq; *(LAS v2u*)(wl + G_B + off) = wk;
                if (g & 1) asm volatile("" ::: "memory");
            }
        }
        const float* sp = UST + ((size_t)((b * 4 + hh) * 2 + dir) * 36 + nc) * 2048;
        bf16x8 sf[2][2];
#pragma unroll
        for (int vb = 0; vb < 2; ++vb)
#pragma unroll
            for (int s = 0; s < 2; ++s) { const float* p = sp + (size_t)(32 * vb + kk) * 32 + 16 * s + 8 * hi; const f32x4 a = *(const f32x4*)p, c = *(const f32x4*)(p + 4);
                sf[vb][s] = pack8(a.x, a.y, a.z, a.w, c.x, c.y, c.z, c.w); }
#pragma unroll
        for (int it = 0; it < 2; ++it) {
            bf16x8 qf[2];
#pragma unroll
            for (int s = 0; s < 2; ++s) { LAS const unsigned char* p = wl + G_A + tri + 16 * s * GP + 64 * it; qf[s] = cat4(tr_read(p), tr_read(p + 4 * GP)); }
#pragma unroll
            for (int vb = 0; vb < 2; ++vb)
#pragma unroll
                for (int s = 0; s < 2; ++s) o[vb][it] = MFMA32(sf[vb][s], qf[s], o[vb][it]);
#pragma unroll
            for (int jt = 0; jt < 2; ++jt) {
                if (dir == 0 ? (jt > it) : (jt < it)) continue;
                f32x16 sc;
#pragma unroll
                for (int i = 0; i < 16; ++i) sc[i] = 0.f;
#pragma unroll
                for (int s = 0; s < 2; ++s) { LAS const unsigned char* p = wl + G_B + tri + 16 * s * GP + 64 * jt; const bf16x8 kf = cat4(tr_read(p), tr_read(p + 4 * GP)); sc = MFMA32(kf, qf[s], sc); }
                if (jt == it) {
#pragma unroll
                    for (int i = 0; i < 16; ++i) { const int j = crow(i, hi); const bool ok = dir == 0 ? (j <= kk) : (j >= kk); sc[i] = ok ? sc[i] : 0.f; }
                }
#pragma unroll
                for (int s2 = 0; s2 < 2; ++s2) {
                    const bf16x8 pf = pack8(sc[8 * s2 + 0], sc[8 * s2 + 1], sc[8 * s2 + 2], sc[8 * s2 + 3], sc[8 * s2 + 4], sc[8 * s2 + 5], sc[8 * s2 + 6], sc[8 * s2 + 7]);
                    LAS const unsigned char* vp = wl + G_V + trv + (32 * jt + 16 * s2) * GP;
                    const bf16x8 v0 = cat4(tr_read(vp), tr_read(vp + 8 * GP));
                    const bf16x8 v1 = cat4(tr_read(vp + 64), tr_read(vp + 8 * GP + 64));
                    o[0][it] = MFMA32(v0, pf, o[0][it]); o[1][it] = MFMA32(v1, pf, o[1][it]);
                }
                __builtin_amdgcn_sched_barrier(0);
            }
            __builtin_amdgcn_sched_barrier(0);
        }
    }
#pragma unroll
    for (int it = 0; it < 2; ++it) {
        float ss = 0.f;
#pragma unroll
        for (int vb = 0; vb < 2; ++vb)
#pragma unroll
            for (int i = 0; i < 16; ++i) ss += o[vb][it][i] * o[vb][it][i];
        ss += __shfl_xor(ss, 32);
        const float rstd = __builtin_amdgcn_rsqf(ss * (1.f / 64.f) + NEPS);
        const size_t row = (size_t)(row0 + 32 * it + kk);
#pragma unroll
        for (int vb = 0; vb < 2; ++vb)
#pragma unroll
            for (int g = 0; g < 4; ++g) { const int v = 32 * vb + 8 * g + 4 * hi;
                const f32x4 gn = *(const f32x4*)(gnorm + v); const v2u gw = *(const v2u*)(P + row * PP + C_GG + hh * 64 + v);
                const float g0 = bflo(gw.x), g1 = bfhi(gw.x), g2 = bflo(gw.y), g3 = bfhi(gw.y);
                v2u w; w.x = pk2(o[vb][it][4 * g] * rstd * gn.x * silu_f(g0), o[vb][it][4 * g + 1] * rstd * gn.y * silu_f(g1));
                w.y = pk2(o[vb][it][4 * g + 2] * rstd * gn.z * silu_f(g2), o[vb][it][4 * g + 3] * rstd * gn.w * silu_f(g3));
                *(v2u*)(MIX + row * 1024 + hh * 64 + v) = w; }
    }
}
__device__ __forceinline__ void phase_r1(const float* const* in, float* xout, unsigned char* ws, LAS unsigned char* lds, int l, bool upd, int G, int tid, int wave, int lane, bool dry) {
    const float* x0 = in[0]; const float* ctx0 = in[2]; const float* gains = in[6] + (size_t)l * 4096; const float* wr = in[14] + (size_t)l * 1024 * 16;
    const float* mod = (const float*)(ws + WS_MOD) + (size_t)l * 9 * 6144;
    const bf16_t* Y = (const bf16_t*)(ws + WS_R2 + (size_t)MT * 2048); bf16_t* H = (bf16_t*)(ws + WS_H); bf16_t* XB = (bf16_t*)(ws + WS_XB);
    float* AFF = (float*)(ws + WS_AFF); float* AFFC = (float*)(ws + WS_AFFC);
    LAS float* V = (LAS float*)lds;
    LAS float* RT = V + 6144;
    __syncthreads();
    for (int i = tid; i < 16384; i += 512) { const int d = i >> 4, e = i & 15; RT[e * 1024 + d] = wr[i]; }
    for (int t = blockIdx.x; t < 256; t += G) {
        const int b = t >> 5;
        __syncthreads();
        for (int n = tid; n < 1024; n += 512) { const float gpa = gains[1024 + n], gpf = gains[2048 + n];
            V[n] = gpa * mod[b * 6144 + 2048 + n]; V[1024 + n] = gpf * (1.f + mod[b * 6144 + 4096 + n]); V[2048 + n] = mod[b * 6144 + 3072 + n];
            V[3072 + n] = gpa * mod[8 * 6144 + 2048 + n]; V[4096 + n] = gpf * (1.f + mod[8 * 6144 + 4096 + n]); V[5120 + n] = mod[8 * 6144 + 3072 + n]; }
        __syncthreads();
        const int nrows = upd ? 9 : 8;
#pragma unroll 1
        for (int i0 = 0; i0 < 9; i0 += 3) {
            f32x4 yv[3][4], xq[3][4];
#pragma unroll
            for (int k = 0; k < 3; ++k) { const int i = i0 + k; if (i < nrows) {
                const bool isc = (i == 8); const int row = isc ? (ML + 8 * t + wave) : (64 * t + 8 * wave + i);
                ld_row_bf16(Y + (size_t)row * 1024, lane, yv[k]);
                if (l == 0) ld_row_f32(isc ? (ctx0 + (size_t)(8 * t + wave) * 1024) : (x0 + (size_t)row * 1024), lane, xq[k]); else ld_row_bf16(XB + (size_t)row * 1024, lane, xq[k]); } }
#pragma unroll
            for (int k = 0; k < 3; ++k) { const int i = i0 + k; if (i < nrows) {
            const bool isc = (i == 8);
            const int row = isc ? (ML + 8 * t + wave) : (64 * t + 8 * wave + i);
            bf16_t* xd = (dry ? (bf16_t*)(ws + WS_R1) : XB) + (size_t)row * 1024;
            LAS const float* vv = V + (isc ? 3072 : 0);
            f32x4 (&y)[4] = yv[k]; f32x4 (&xv)[4] = xq[k]; f32x4 a[4];
            const float rsy = __builtin_amdgcn_rsqf(wave_sum(sumsq16(y)) * (1.f / 1024.f) + NEPS);
            ld_vec_lds(vv, lane, a);
#pragma unroll
            for (int j = 0; j < 4; ++j) xv[j] = xv[j] + a[j] * (y[j] * rsy);
            st_row_bf16(xd, lane, xv);
            const float rs1 = __builtin_amdgcn_rsqf(wave_sum(sumsq16(xv)) * (1.f / 1024.f) + NEPS);
            f32x4 s[4]; ld_vec_lds(vv + 1024, lane, a); ld_vec_lds(vv + 2048, lane, s);
#pragma unroll
            for (int j = 0; j < 4; ++j) xv[j] = xv[j] * rs1 * a[j] + s[j];
            st_row_bf16((dry ? (bf16_t*)(ws + WS_R2) : H) + (size_t)row * 1024, lane, xv);
            float lg[16];
#pragma unroll
            for (int e = 0; e < 16; ++e) { float p = 0.f;
#pragma unroll
                for (int j = 0; j < 4; ++j) { const f32x4 w = *(LAS const f32x4*)(RT + e * 1024 + 256 * j + 4 * lane); p += (xv[j].x * w.x + xv[j].y * w.y) + (xv[j].z * w.z + xv[j].w * w.w); }
                lg[e] = p;
                if ((e & 3) == 3) asm volatile("" ::: "memory"); }
#pragma unroll
            for (int i2 = 0; i2 < 8; ++i2) { const bool up = (lane & 32) != 0; const float keep = up ? lg[i2 + 8] : lg[i2], send = up ? lg[i2] : lg[i2 + 8]; lg[i2] = keep + __shfl_xor(send, 32); }
#pragma unroll
            for (int i2 = 0; i2 < 4; ++i2) { const bool up = (lane & 16) != 0; const float keep = up ? lg[i2 + 4] : lg[i2], send = up ? lg[i2] : lg[i2 + 4]; lg[i2] = keep + __shfl_xor(send, 16); }
#pragma unroll
            for (int i2 = 0; i2 < 2; ++i2) { const bool up = (lane & 8) != 0; const float keep = up ? lg[i2 + 2] : lg[i2], send = up ? lg[i2] : lg[i2 + 2]; lg[i2] = keep + __shfl_xor(send, 8); }
            { const bool up = (lane & 4) != 0; const float keep = up ? lg[1] : lg[0], send = up ? lg[0] : lg[1]; lg[0] = keep + __shfl_xor(send, 4); }
            float lgt = lg[0]; lgt += __shfl_xor(lgt, 1); lgt += __shfl_xor(lgt, 2);
            const int ex = ((lane >> 5) & 1) * 8 + ((lane >> 4) & 1) * 4 + ((lane >> 3) & 1) * 2 + ((lane >> 2) & 1);
            float mx = lgt;
            mx = fmaxf(mx, __shfl_xor(mx, 4)); mx = fmaxf(mx, __shfl_xor(mx, 8)); mx = fmaxf(mx, __shfl_xor(mx, 16)); mx = fmaxf(mx, __shfl_xor(mx, 32));
            const float pe = fexp(lgt - mx);
            float den = pe; den += __shfl_xor(den, 4); den += __shfl_xor(den, 8); den += __shfl_xor(den, 16); den += __shfl_xor(den, 32);
            const float mine = pe / den;
            if ((lane & 3) == 0) {
                if (isc) { const int cr = 8 * t + wave; AFFC[((size_t)(cr >> 8) * 16 + ex) * 256 + (cr & 255)] = mine; }
                else AFF[((size_t)(row >> 11) * 16 + ex) * 2048 + (row & 2047)] = mine;
            }
            } }
        }
    }
}

template <bool CTX>
__device__ __forceinline__ void topk_wg(unsigned char* ws, int item, int wave, LAS unsigned char* wl, int lane) {
    constexpr int NT = CTX ? 256 : 2048, CAP = CTX ? 32 : 256, PER = NT / 64, RPW = CAP / 16;
    const int hf = item & 1, e = (item >> 1) & 15, b = item >> 5;
    const float* arow = (const float*)(ws + (CTX ? WS_AFFC : WS_AFF)) + (size_t)(b * 16 + e) * NT;
    float* gate = (float*)(ws + (CTX ? WS_GATEC : WS_GATE)) + (size_t)(b * 16 + e) * CAP;
    short* INV = (short*)(ws + WS_INV);
    const bf16_t* H = (const bf16_t*)(ws + WS_H); bf16_t* XS = (bf16_t*)(ws + WS_R1);
    LAS int* list = (LAS int*)wl; LAS float* vals = (LAS float*)(wl + 1024);
    unsigned v[PER];
#pragma unroll
    for (int i = 0; i < PER / 4; ++i) { const v4u q = *(const v4u*)(arow + lane * PER + 4 * i); v[4 * i] = q.x; v[4 * i + 1] = q.y; v[4 * i + 2] = q.z; v[4 * i + 3] = q.w; }
    unsigned T = 0;
    for (int bit = 29; bit >= 0; --bit) {
        const unsigned cand = T | (1u << bit); int c = 0;
#pragma unroll
        for (int i = 0; i < PER; ++i) c += __popcll(__ballot(v[i] >= cand));
        if (c >= CAP) T = cand;
    }
    int ngt = 0, cg = 0, ce = 0;
#pragma unroll
    for (int i = 0; i < PER; ++i) { ngt += __popcll(__ballot(v[i] > T)); cg += (v[i] > T) ? 1 : 0; ce += (v[i] == T) ? 1 : 0; }
    const int need = CAP - ngt;
    int pg = cg, pe = ce;
#pragma unroll
    for (int d = 1; d < 64; d <<= 1) { const int tg = __shfl_up(pg, d), te = __shfl_up(pe, d); if (lane >= d) { pg += tg; pe += te; } }
    pg -= cg; pe -= ce;
    const int myp = hf * 8 + wave;
#pragma unroll
    for (int i = 0; i < PER; ++i) {
        const bool gt = v[i] > T, eq = v[i] == T;
        const bool sel = gt || (eq && pe < need);
        const int slot = pg + (pe < need ? pe : need);
        const int tok = lane * PER + i;
        if (sel) { list[slot] = tok; vals[slot] = __uint_as_float(v[i]); }
        const bool mine = CTX ? ((lane >> 2) == myp) : ((i >> 1) == myp);
        if (mine) INV[(size_t)(CTX ? (ML + b * CTXL + tok) : (b * SEQ + tok)) * 16 + e] = sel ? (short)slot : (short)-1;
        pg += gt ? 1 : 0; pe += eq ? 1 : 0;
    }
    const int s0 = hf * (CAP / 2) + wave * RPW;
    if (lane < RPW) gate[s0 + lane] = vals[s0 + lane];
    constexpr int BT = RPW < 8 ? RPW : 8;
#pragma unroll 1
    for (int bt = 0; bt < RPW / BT; ++bt) {
        v4u r0[BT], r1[BT];
#pragma unroll
        for (int j = 0; j < BT; ++j) { const int tok = list[s0 + bt * BT + j]; const v4u* sp = (const v4u*)(H + (size_t)(CTX ? (ML + b * CTXL + tok) : (b * SEQ + tok)) * 1024);
            r0[j] = sp[lane]; r1[j] = sp[64 + lane]; }
#pragma unroll
        for (int j = 0; j < BT; ++j) { const int slot = s0 + bt * BT + j; const size_t drow = CTX ? ((size_t)(128 + e) * 256 + b * 32 + slot) : ((size_t)(b * 16 + e) * 256 + slot);
            v4u* dp = (v4u*)(XS + drow * 1024); dp[lane] = r0[j]; dp[64 + lane] = r1[j]; }
    }
}

__device__ __forceinline__ void phase_r5(const float* const* in, float* xout, unsigned char* ws, LAS unsigned char* lds, int l, bool upd, int G, int tid, int wave, int lane, bool dry) {
    const float* gains = in[6];
    const float* mod = (const float*)(ws + WS_MOD);
    const bf16_t* YE = (const bf16_t*)(ws + WS_R1); bf16_t* H = (bf16_t*)(ws + WS_H); bf16_t* XB = (bf16_t*)(ws + WS_XB);
    const float* GATE = (const float*)(ws + WS_GATE); const float* GATEC = (const float*)(ws + WS_GATEC); const short* INV = (const short*)(ws + WS_INV);
    LAS float* V = (LAS float*)lds;
    LAS int* CL = (LAS int*)(lds + 24576);
    for (int t = blockIdx.x; t < 256; t += G) {
        const int b = t >> 5;
        __syncthreads();
        for (int n = tid; n < 1024; n += 512) { const float gpf = gains[(size_t)l * 4096 + 3072 + n];
            V[n] = gpf * mod[((size_t)l * 9 + b) * 6144 + 5120 + n]; V[3072 + n] = gpf * mod[((size_t)l * 9 + 8) * 6144 + 5120 + n];
            if (l == 0) { const float gna = gains[4096 + n];
                V[1024 + n] = gna * (1.f + mod[((size_t)9 + b) * 6144 + 1024 + n]); V[2048 + n] = mod[((size_t)9 + b) * 6144 + n];
                V[4096 + n] = gna * (1.f + mod[((size_t)9 + 8) * 6144 + 1024 + n]); V[5120 + n] = mod[((size_t)9 + 8) * 6144 + n]; } }
        if (tid < (upd ? 72 : 64)) {
            const bool isc = tid >= 64; const int cr = 8 * t + (tid - 64);
            const int row = isc ? (ML + cr) : (64 * t + tid); const int bb = isc ? (cr >> 8) : b;
            const v4u i0 = *(const v4u*)(INV + (size_t)row * 16), i1 = *(const v4u*)(INV + (size_t)row * 16 + 8);
            const unsigned iw[8] = {i0.x, i0.y, i0.z, i0.w, i1.x, i1.y, i1.z, i1.w};
            float gv[16]; int sl[16];
#pragma unroll
            for (int e = 0; e < 16; ++e) { sl[e] = (int)(short)((iw[e >> 1] >> (16 * (e & 1))) & 0xffffu); const int s0 = sl[e] < 0 ? 0 : sl[e];
                gv[e] = isc ? GATEC[(size_t)(bb * 16 + e) * 32 + s0] : GATE[(size_t)(bb * 16 + e) * 256 + s0]; }
            int cnt = 0; LAS int* cl = CL + tid * 33;
#pragma unroll
            for (int e = 0; e < 16; ++e) if (sl[e] >= 0) { cl[1 + 2 * cnt] = isc ? ((128 + e) * 256 + bb * 32 + sl[e]) : ((bb * 16 + e) * 256 + sl[e]); cl[2 + 2 * cnt] = (int)__float_as_uint(gv[e]); ++cnt; }
            cl[0] = cnt;
        }
        __syncthreads();
        const int nrows = upd ? 9 : 8;
#pragma unroll 1
        for (int i0 = 0; i0 < 9; i0 += 3) {
            f32x4 xq[3][4];
#pragma unroll
            for (int k = 0; k < 3; ++k) { const int i = i0 + k; if (i < nrows) { const bool isc = (i == 8);
                ld_row_bf16(XB + (size_t)(isc ? (ML + 8 * t + wave) : (64 * t + 8 * wave + i)) * 1024, lane, xq[k]); } }
#pragma unroll
            for (int k = 0; k < 3; ++k) { const int i = i0 + k; if (i < nrows) {
            const bool isc = (i == 8);
            const int row = isc ? (ML + 8 * t + wave) : (64 * t + 8 * wave + i);
            LAS const float* vv = V + (isc ? 3072 : 0);
            LAS const int* cl = CL + (isc ? (64 + wave) : (8 * wave + i)) * 33;
            const int n = __builtin_amdgcn_readfirstlane(cl[0]);
            f32x4 acc[4];
#pragma unroll
            for (int j = 0; j < 4; ++j) acc[j] = (f32x4){0.f, 0.f, 0.f, 0.f};
            for (int j0 = 0; j0 < n; j0 += 4) {
                v2u raw[4][4]; float g[4];
#pragma unroll
                for (int q = 0; q < 4; ++q) {
                    if (j0 + q < n) { const int yr = __builtin_amdgcn_readfirstlane(cl[1 + 2 * (j0 + q)]); g[q] = __uint_as_float((unsigned)__builtin_amdgcn_readfirstlane(cl[2 + 2 * (j0 + q)]));
                        const bf16_t* yp = YE + (size_t)yr * 1024;
#pragma unroll
                        for (int j = 0; j < 4; ++j) raw[q][j] = *(const v2u*)(yp + 256 * j + 4 * lane); }
                    else { g[q] = 0.f;
#pragma unroll
                        for (int j = 0; j < 4; ++j) raw[q][j] = (v2u){0u, 0u}; }
                }
#pragma unroll
                for (int q = 0; q < 4; ++q)
#pragma unroll
                    for (int j = 0; j < 4; ++j) acc[j] += (f32x4){bflo(raw[q][j].x), bfhi(raw[q][j].x), bflo(raw[q][j].y), bfhi(raw[q][j].y)} * g[q];
            }
            const float rsm = __builtin_amdgcn_rsqf(wave_sum(sumsq16(acc)) * (1.f / 1024.f) + NEPS);
            f32x4 (&xv)[4] = xq[k]; f32x4 a[4]; ld_vec_lds(vv, lane, a);
#pragma unroll
            for (int j = 0; j < 4; ++j) xv[j] = xv[j] + a[j] * (acc[j] * rsm);
            if (l == 0) st_row_bf16((dry ? (bf16_t*)(ws + WS_R2) : XB) + (size_t)row * 1024, lane, xv);
            else st_row_f32((dry ? (float*)(ws + WS_R2) : xout) + (size_t)row * 1024, lane, xv);
            if (l == 0 && !dry) {
                const float rs2 = __builtin_amdgcn_rsqf(wave_sum(sumsq16(xv)) * (1.f / 1024.f) + NEPS);
                f32x4 s[4]; ld_vec_lds(vv + 1024, lane, a); ld_vec_lds(vv + 2048, lane, s);
#pragma unroll
                for (int j = 0; j < 4; ++j) xv[j] = xv[j] * rs2 * a[j] + s[j];
                st_row_bf16(H + (size_t)row * 1024, lane, xv);
            }
            } }
        }
    }
}
#ifndef MK_PER_PHASE
#define MK_PER_PHASE 0
#endif
constexpr int N_PHASES = 22;
struct Args { const float* in[18]; float* out; unsigned char* ws; int ph_lo, ph_hi; };
__device__ __forceinline__ const Args* kargs_opaque() {
    auto p = __builtin_amdgcn_kernarg_segment_ptr(); asm volatile("" : "+s"(p)); return (const Args*)p; }
#define PHASE_REGS() int tid = threadIdx.x; asm volatile("" : "+v"(tid)); const int lane = tid & 63, wave = __builtin_amdgcn_readfirstlane(tid >> 6); \
    const Args* A = kargs_opaque(); unsigned char* ws = A->ws; const int G = gridDim.x, bx = blockIdx.x; \
    const int vcu = (G % 8 == 0) ? (bx % 8) * (G / 8) + bx / 8 : bx; const int gw = vcu * NWAVES + wave, NGW = G * NWAVES; \
    LAS unsigned char* wl = lds + wave * WAVE_LDS; (void)gw; (void)NGW; (void)wl; (void)lane; (void)ws
#ifndef PH_MASK
#define PH_MASK 0xFFFFFFFFu
#endif
#define EN(j) (((PH_MASK) >> (j)) & 1u)
#ifndef REP_MASK
#define REP_MASK 0u
#endif
#define REPS(j) ((((REP_MASK) >> (j)) & 1u) ? 2 : 1)
__global__ void __launch_bounds__(NWAVES * 64, 2) fwd_kernel(Args args) {
    extern __shared__ __attribute__((aligned(16))) unsigned char lds_raw[];
    LAS unsigned char* lds = (LAS unsigned char*)lds_raw;
    volatile LAS unsigned* MISC = (volatile LAS unsigned*)(lds + MISC_OFF);
    for (int u = threadIdx.x; u < (LDS_BYTES - LDSCTL_OFF) / 4; u += NWAVES * 64) ((LAS unsigned*)(lds + LDSCTL_OFF))[u] = 0u;
    __syncthreads();
    const int lo = args.ph_lo, hi = args.ph_hi;
    XcdBarrier bar; bar.bar = (unsigned*)(args.ws + WS_CTL) + CW_BAR; bar.x = 0; bar.st = nullptr;
    if (hi - lo > 1) bar = xcd_barrier_post((unsigned*)(args.ws + WS_CTL) + CW_BAR, MISC + 8);
#define IN(k) (lo <= (k) && (k) < hi)
#define SEAM(k) do { if (IN((k) + 1)) { xcd_barrier(bar); if (REPS(12) == 2) xcd_barrier(bar); } } while (0)
    if (EN(0) && IN(0)) { for (int rep = 0; rep < REPS(0); ++rep) { PHASE_REGS(); phase_p0(A->in, ws, wl, gw, NGW, lane); } SEAM(0); }
    if (EN(1) && IN(1)) { for (int rep = 0; rep < REPS(1); ++rep) { PHASE_REGS(); phase_a0(A->in, ws, lds, G, tid, wave, lane); } SEAM(1); }
    for (int l = 0; l < 2; ++l) {
        const int base = 2 + 10 * l; const bool upd = (l == 0);
        if (EN(2) && IN(base + 0)) { for (int rep = 0; rep < REPS(2); ++rep) {
            PHASE_REGS();
            pg8::Gemm g{(const bf16_t*)(ws + WS_H), (const bf16_t*)(ws + WS_WIN) + (size_t)l * PP * 1024, MT, PP, 1024}; pg8::StaticOrder S; S.init(MT, PP, G, bx);
            pg8::EpiProj E{(bf16_t*)(ws + WS_R1), PP, (const pg8::f32x2*)(ws + WS_TAB), ML};
            pg8::gemm_phase<pg8::EpiProj, pg8::StaticOrder, true, true>(lds, g, S, E);
            }
            SEAM(base + 0);
        }
        if (EN(3) && IN(base + 1)) { for (int rep = 0; rep < REPS(3); ++rep) {
            PHASE_REGS();
            const bf16_t* PROJ = (const bf16_t*)(ws + WS_R1); bf16_t* MIX = (bf16_t*)(ws + WS_R2);
            const float* a_up = A->in[9] + (size_t)l * 2 * 16 * 128; const float* a_bias = A->in[10] + (size_t)l * 2 * 128;
            const float* rpb = A->in[12] + (size_t)l * 4 * 465; const float* sink = A->in[13] + (size_t)l * 8;
            const int n_cn = upd ? 128 : 0, n_cs = upd ? 256 : 0;
            const bool xmap = (G == 256);
            const int xcd = bx & 7, cu = bx >> 3;
            const int n_att = xmap ? 12 : 0;
            const int tail_total = (xmap ? 0 : 1024 + 2048) + 1152 + n_cn + n_cs;
            volatile LAS unsigned* qctr = (volatile LAS unsigned*)(lds + MISC_OFF) + 16 + l * 2 + rep;
            for (;;) {
                int j = 0; if (lane == 0) j = (int)__hip_atomic_fetch_add((LAS unsigned*)qctr, 1u, __ATOMIC_RELAXED, __HIP_MEMORY_SCOPE_WORKGROUP);
                j = __builtin_amdgcn_readfirstlane(j);
                int mode, item;
                if (j < n_att) {
                    if (j < 4) { mode = 0; item = (xcd * 4 + j) * 32 + cu; }
                    else { const int jj = j - 4, group = xcd * 2 + (jj >> 2), i = cu * 4 + (jj & 3); const int bb = group >> 1, hq = (group & 1) * 4 + (i >> 5); mode = 1; item = (i & 31) + 32 * hq + 256 * bb; }
                } else {
                    int r = (j - n_att) * G + bx;
                    if (r >= tail_total) break;
                    mode = -1; item = 0;
                    if (!xmap) { if (r < 1024) { mode = 0; item = r; } else if (r < 3072) { mode = 1; item = r - 1024; } r -= 3072; }
                    if (mode < 0) {
                        if (r < 1152) { if (rep + 1 < REPS(3)) continue; gla_local_item(PROJ, (float*)(ws + WS_UST), (float*)(ws + WS_DEC), r, wl, lane, a_up, a_bias); continue; } r -= 1152;
                        if (r < n_cs) { mode = 3; item = r; } else { mode = 2; item = r - n_cs; }
                    }
                }
                attn_item(mode, PROJ, MIX, item, wl, lane, rpb, sink, rep + 1 < REPS(3));
            }
            }
            SEAM(base + 1);
        }
        if (EN(4) && IN(base + 2)) { for (int rep = 0; rep < REPS(4); ++rep) {
            PHASE_REGS();
            for (int gid = bx * (NWAVES * 64) + tid; gid < 64 * 2048; gid += G * NWAVES * 64) gla_prefix((float*)(ws + WS_UST), (const float*)(ws + WS_DEC), gid, rep + 1 < REPS(4));
            }
            SEAM(base + 2);
        }
        if (EN(5) && IN(base + 3)) { for (int rep = 0; rep < REPS(5); ++rep) {
            PHASE_REGS();
            const float* a_up = A->in[9] + (size_t)l * 2 * 16 * 128; const float* a_bias = A->in[10] + (size_t)l * 2 * 128; const float* gnorm = A->in[11] + (size_t)l * 64;
            for (int it = gw; it < 1152; it += NGW) { if (!upd && (it % 36) < 4) continue;
                gla_out_item((const bf16_t*)(ws + WS_R1), (const float*)(ws + WS_UST), (bf16_t*)(ws + WS_R2), it, wl, lane, a_up, a_bias, gnorm); }
            }
            SEAM(base + 3);
        }
        if (EN(6) && IN(base + 4)) { for (int rep = 0; rep < REPS(6); ++rep) {
            PHASE_REGS();
            const int M2 = upd ? MT : ML;
            pg8::Gemm g{(const bf16_t*)(ws + WS_R2), (const bf16_t*)(ws + WS_WOUT) + (size_t)l * 1024 * 1024, M2, 1024, 1024}; pg8::StaticOrder S; S.init(M2, 1024, G, bx);
            pg8::EpiStore E{(bf16_t*)(ws + WS_R2 + (size_t)MT * 2048), 1024};
            pg8::gemm_phase<pg8::EpiStore, pg8::StaticOrder, true, true>(lds, g, S, E);
            }
            SEAM(base + 4);
        }
        if (EN(7) && IN(base + 5)) { for (int rep = 0; rep < REPS(7); ++rep) { PHASE_REGS(); phase_r1(A->in, A->out, ws, lds, l, upd, G, tid, wave, lane, rep + 1 < REPS(7)); } SEAM(base + 5); }
        if (EN(8) && IN(base + 6)) { for (int rep = 0; rep < REPS(8); ++rep) {
            PHASE_REGS();
            for (int it = bx; it < 256; it += G) { topk_wg<false>(ws, it, wave, wl, lane); if (upd) topk_wg<true>(ws, it, wave, wl, lane); }
            }
            SEAM(base + 6);
        }
        if (EN(9) && IN(base + 7)) { for (int rep = 0; rep < REPS(9); ++rep) {
            PHASE_REGS();
            pg8::Gemm g{(const bf16_t*)(ws + WS_R1), (const bf16_t*)(ws + WS_WGU) + (size_t)l * 16 * 2048 * 1024, 0, 0, 1024}; pg8::MoeOrder S; S.init(upd ? 9 : 8, 8, G, bx);
            pg8::EpiSwiGLU E{(bf16_t*)(ws + WS_R2), 1024};
            pg8::gemm_phase<pg8::EpiSwiGLU, pg8::MoeOrder, true, true>(lds, g, S, E);
            }
            SEAM(base + 7);
        }
        if (EN(10) && IN(base + 8)) { for (int rep = 0; rep < REPS(10); ++rep) {
            PHASE_REGS();
            pg8::Gemm g{(const bf16_t*)(ws + WS_R2), (const bf16_t*)(ws + WS_WD) + (size_t)l * 16 * 1024 * 1024, 0, 0, 1024}; pg8::MoeOrder S; S.init(upd ? 9 : 8, 4, G, bx);
            pg8::EpiStore E{(bf16_t*)(ws + WS_R1), 1024};
            pg8::gemm_phase<pg8::EpiStore, pg8::MoeOrder, true, true>(lds, g, S, E);
            }
            SEAM(base + 8);
        }
        if (EN(11) && IN(base + 9)) { for (int rep = 0; rep < REPS(11); ++rep) { PHASE_REGS(); phase_r5(A->in, A->out, ws, lds, l, upd, G, tid, wave, lane, rep + 1 < REPS(11)); } SEAM(base + 9); }
    }
#undef IN
#undef SEAM
}

extern "C" void kernel_launch(void* const* d_in, const int* in_sizes, int n_in, void* d_out, int out_size, void* d_ws, size_t ws_size, hipStream_t stream) {
    static int grid = 0;
    if (grid == 0) {
        if (n_in != 18 || out_size != ML * DM || ws_size < WS_END) { fprintf(stderr, "kernel_launch: unexpected sizes: n_in %d out %d ws %zu (need %zu)\n", n_in, out_size, ws_size, (size_t)WS_END); grid = -1; return; }
        int dev = 0, cus = 0, per_cu = 0;
        if (hipGetDevice(&dev) != hipSuccess || hipDeviceGetAttribute(&cus, hipDeviceAttributeMultiprocessorCount, dev) != hipSuccess) { grid = -1; return; }
        if (hipFuncSetAttribute((const void*)fwd_kernel, hipFuncAttributeMaxDynamicSharedMemorySize, LDS_BYTES) != hipSuccess) { fprintf(stderr, "kernel_launch: hipFuncSetAttribute failed\n"); grid = -1; return; }
        if (hipOccupancyMaxActiveBlocksPerMultiprocessor(&per_cu, (const void*)fwd_kernel, NWAVES * 64, LDS_BYTES) != hipSuccess || per_cu < 1) { fprintf(stderr, "kernel_launch: occupancy query says %d blocks per CU\n", per_cu); (void)hipGetLastError(); grid = -1; return; }
        grid = cus;
    }
    if (grid < 0) return;
    (void)hipMemsetAsync((char*)d_ws + WS_CTL, 0, CTL_ZERO_BYTES, stream);
    Args a{};
    for (int i = 0; i < 18; ++i) a.in[i] = (const float*)d_in[i];
    a.out = (float*)d_out; a.ws = (unsigned char*)d_ws;
#if MK_PER_PHASE
    for (int p = 0; p < N_PHASES; ++p) { a.ph_lo = p; a.ph_hi = p + 1; hipLaunchKernelGGL(fwd_kernel, dim3(grid), dim3(NWAVES * 64), LDS_BYTES, stream, a); }
#else
    a.ph_lo = 0; a.ph_hi = N_PHASES;
    void* kargs[] = {&a};
    hipError_t e = hipLaunchCooperativeKernel((const void*)fwd_kernel, dim3(grid), dim3(NWAVES * 64), kargs, LDS_BYTES, stream);
    if (e != hipSuccess) fprintf(stderr, "kernel_launch: cooperative launch failed: %s (grid %d)\n", hipGetErrorString(e), grid);
#endif
}
```

```cpp
#include <hip/hip_runtime.h>
#include <cstdio>
#include <cstdint>
#include <cmath>

namespace pg8 {
#define PG8_LAS __attribute__((address_space(3)))
typedef unsigned short bf16_t;
typedef short bf16x8 __attribute__((ext_vector_type(8)));
typedef float f32x4 __attribute__((ext_vector_type(4)));
typedef unsigned u32x4 __attribute__((ext_vector_type(4)));
constexpr int BM = 256, BK = 64, HALF = 128, HTB = HALF * BK * 2  , STAGE_BYTES = 8 * HTB, NXCD = 8, WGM = 8;

__host__ __device__ __forceinline__ int lds_byte(int r, int c) { const int st = (r >> 4) * 2 + (c >> 5), rr = r & 15, cc = c & 31, ob = rr * 64 + cc * 2; return st * 1024 + (ob ^ (((ob >> 9) & 1) << 5)); }
__host__ __device__ __forceinline__ void stage_rc(int b, int& R, int& C) { const int st = b / 1024, sb = b % 1024, swz = sb ^ (((sb >> 9) & 1) << 5); R = (st >> 1) * 16 + swz / 64; C = (st & 1) * 32 + (swz % 64) / 2; }
__host__ __device__ __forceinline__ int perm32(int rho) { const int n = rho >> 4, i = rho & 15; return 8 * (i >> 2) + 4 * n + (i & 3); }

struct Unit { int pm, pn, pb; };
struct Gemm { const bf16_t* A; const bf16_t* Bt; int M, N, K; const int* rowidx; };

struct StaticOrder {
    int nM, nN, nwg, G, c;
    __host__ __device__ void init(int M, int N, int G_, int c_) { nM = M / BM; nN = N / BM; nwg = nM * nN; G = G_; c = c_; }
    __host__ __device__ bool next(int i, Unit& u) const {
        const long L = (long)i * G + c; if (L >= nwg) return false;
        int wgid = (int)L; { const int q = nwg / NXCD, r = nwg % NXCD, xcd = wgid % NXCD, off = wgid / NXCD; wgid = (xcd < r ? xcd * (q + 1) : r * (q + 1) + (xcd - r) * q) + off; }
        const int nig = WGM * nN, gid = wgid / nig, fm = gid * WGM, gsz = (nM - fm) < WGM ? (nM - fm) : WGM;
        u.pm = fm + ((wgid % nig) % gsz); u.pn = (wgid % nig) / gsz; u.pb = u.pn; return true;
    }
    __device__ __forceinline__ void a_ready(const Unit&) const {}
    __device__ __forceinline__ void done(const Unit&) const {}
};

__device__ __forceinline__ unsigned cvt_pk_bf16(float lo, float hi) { unsigned r; asm volatile("v_cvt_pk_bf16_f32 %0, %1, %2" : "=v"(r) : "v"(lo), "v"(hi)); return r; }
typedef float f32x2 __attribute__((ext_vector_type(2)));
struct EpiStore {
    static constexpr bool PERM = true, AFTER_DRAIN = false;
    bf16_t* O; int ldc;
    __device__ __forceinline__ void operator()(const f32x4 (&acc)[2][2][4][2], const Unit& u, int wr, int wc, int fr, int fq) const {
        const int row0 = u.pm * BM + wr * 64 + fr, col0 = u.pn * BM + wc * 32 + 8 * fq;
#pragma unroll
        for (int ai = 0; ai < 2; ++ai)
#pragma unroll
            for (int m = 0; m < 4; ++m) { bf16_t* rowp = O + (size_t)(row0 + ai * HALF + m * 16) * ldc + col0;
#pragma unroll
                for (int bj = 0; bj < 2; ++bj) { const f32x4 v0 = acc[ai][bj][m][0], v1 = acc[ai][bj][m][1];
                    u32x4 w; w.x = cvt_pk_bf16(v0[0], v0[1]); w.y = cvt_pk_bf16(v0[2], v0[3]); w.z = cvt_pk_bf16(v1[0], v1[1]); w.w = cvt_pk_bf16(v1[2], v1[3]);
                    *(u32x4*)(rowp + bj * HALF) = w; } }
    }
};
struct EpiProj {
    static constexpr bool PERM = true, AFTER_DRAIN = false;
    bf16_t* O; int ldc; const f32x2* tab; int ml;
    __device__ __forceinline__ void operator()(const f32x4 (&acc)[2][2][4][2], const Unit& u, int wr, int wc, int fr, int fq) const {
        const int row0 = u.pm * BM + wr * 64 + fr;
        const bool latent = (u.pm * BM) < ml;
#pragma unroll
        for (int bj = 0; bj < 2; ++bj) {
            const int c0 = u.pn * BM + bj * HALF + wc * 32;
            const bool rope = latent && ((c0 >= 928 && c0 < 1056) || (c0 >= 1824 && c0 < 2336));
            const bool rowhalf = (((c0 - 32) & 63) == 0);
            const bool qscale = (c0 >= 1568 && c0 < 2336);
#pragma unroll
            for (int ai = 0; ai < 2; ++ai)
#pragma unroll
                for (int m = 0; m < 4; ++m) {
                    const int row = row0 + ai * HALF + m * 16;
                    f32x4 v0 = acc[ai][bj][m][0], v1 = acc[ai][bj][m][1];
                    if (rope) {
                        const int t = row & 2047, pos = rowhalf ? (t >> 6) : (t & 63);
                        const f32x2* tp = tab + pos * 16 + 8 * (fq & 1);
                        const float sg = (fq < 2) ? -1.f : 1.f;
#pragma unroll
                        for (int e = 0; e < 4; ++e) {
                            const float x0 = v0[e], x1 = v1[e];
                            const float p0 = __shfl_xor(x0, 32), p1 = __shfl_xor(x1, 32);
                            const f32x2 c0s = tp[e], c1s = tp[4 + e];
                            v0[e] = x0 * c0s.x + sg * p0 * c0s.y; v1[e] = x1 * c1s.x + sg * p1 * c1s.y;
                        }
                    }
                    if (qscale) { v0 = v0 * 0.18033688011112042f; v1 = v1 * 0.18033688011112042f; }
                    u32x4 w; w.x = cvt_pk_bf16(v0[0], v0[1]); w.y = cvt_pk_bf16(v0[2], v0[3]); w.z = cvt_pk_bf16(v1[0], v1[1]); w.w = cvt_pk_bf16(v1[2], v1[3]);
                    *(u32x4*)(O + (size_t)row * ldc + c0 + 8 * fq) = w;
                }
        }
    }
};
struct EpiSwiGLU {
    static constexpr bool PERM = true, AFTER_DRAIN = false;
    bf16_t* O; int ldc;
    __device__ __forceinline__ void operator()(const f32x4 (&acc)[2][2][4][2], const Unit& u, int wr, int wc, int fr, int fq) const {
        const int row0 = u.pm * BM + wr * 64 + fr, col0 = u.pn * HALF + wc * 32 + 8 * fq;
#pragma unroll
        for (int ai = 0; ai < 2; ++ai)
#pragma unroll
            for (int m = 0; m < 4; ++m) {
                float h[8];
#pragma unroll
                for (int n = 0; n < 2; ++n)
#pragma unroll
                    for (int e = 0; e < 4; ++e) { const float g = acc[ai][0][m][n][e], up = acc[ai][1][m][n][e];
                        h[n * 4 + e] = g * __builtin_amdgcn_rcpf(1.f + __builtin_amdgcn_exp2f(-1.4426950408889634f * g)) * up; }
                u32x4 w; w.x = cvt_pk_bf16(h[0], h[1]); w.y = cvt_pk_bf16(h[2], h[3]); w.z = cvt_pk_bf16(h[4], h[5]); w.w = cvt_pk_bf16(h[6], h[7]);
                *(u32x4*)(O + (size_t)(row0 + ai * HALF + m * 16) * ldc + col0) = w;
            }
    }
};
struct MoeOrder {
    int npe, nN, nwg, G, c;
    __host__ __device__ void init(int npe_, int nN_, int G_, int c_) { npe = npe_; nN = nN_; nwg = 16 * npe * nN; G = G_; c = c_; }
    __host__ __device__ bool next(int i, Unit& u) const {
        const long L = (long)i * G + c; if (L >= nwg) return false;
        int wgid = (int)L; { const int q = nwg / NXCD, r = nwg % NXCD, xcd = wgid % NXCD, off = wgid / NXCD; wgid = (xcd < r ? xcd * (q + 1) : r * (q + 1) + (xcd - r) * q) + off; }
        const int per = npe * nN, e = wgid / per, rem = wgid % per, j = rem / nN, pn = rem % nN;
        u.pm = (j < 8) ? (j * 16 + e) : (128 + e); u.pn = pn; u.pb = e * nN + pn; return true;
    }
    __device__ __forceinline__ void a_ready(const Unit&) const {}
    __device__ __forceinline__ void done(const Unit&) const {}
};

template <class Epi, class Sched, bool ALIGN_EPI = false, bool SP2 = false, bool GATHER = false>
__device__ __forceinline__ void gemm_phase(PG8_LAS unsigned char* lds, const Gemm g, const Sched& S, const Epi& E) {
    int tid_ = threadIdx.x; asm volatile("" : "+v"(tid_));
    const int tid = tid_, wid = __builtin_amdgcn_readfirstlane(tid >> 6), lane = tid & 63, wr = wid >> 2, wc = wid & 3, fr = lane & 15, fq = lane >> 4;
    const int K = g.K, nt = K / BK;
    static_assert(!GATHER || SP2, "GATHER is wired into the SP2 loop only");
    unsigned voffA[2], voffB[2]; int RA[2], CA[2]; unsigned vAc[2][2], vAn[2][2];
#pragma unroll
    for (int i = 0; i < 2; ++i) { int R, C; stage_rc(tid * 16 + i * 8192, R, C); const int Rb = Epi::PERM ? ((R & ~31) + perm32(R & 31)) : R; RA[i] = R; CA[i] = C;
        voffA[i] = (unsigned)(R * K + C) * 2u; voffB[i] = (unsigned)(Rb * K + C) * 2u; vAc[0][i] = vAc[1][i] = vAn[0][i] = vAn[1][i] = 0u; }
    auto load_idx = [&](int pm, unsigned (&v)[2][2]) {
#pragma unroll
        for (int h = 0; h < 2; ++h)
#pragma unroll
            for (int i = 0; i < 2; ++i) v[h][i] = (unsigned)(g.rowidx[pm * BM + h * HALF + RA[i]] * K + CA[i]) * 2u;
    };
    const size_t kstep = (size_t)(BK * 2);
    const size_t hstep = (size_t)HALF * K * 2;
    const size_t tstep = 2 * hstep;
    const unsigned ldsw = (unsigned)wid * 1024u;
    const int aoff = lds_byte(wr * 64 + fr, fq * 8), boff = lds_byte(wc * 32 + fr, fq * 8);
#define PG8_SA(b, h) (((b) * 2 + (h)) * HTB)
#define PG8_SB(b, h) ((4 + (b) * 2 + (h)) * HTB)
#define PG8_STAGE(bufoff, gbase, voff) do { _Pragma("unroll") for (int _i = 0; _i < 2; ++_i) \
        __builtin_amdgcn_global_load_lds((const unsigned*)((const char*)(gbase) + (voff)[_i]), (PG8_LAS unsigned*)(lds + (bufoff) + ldsw + _i * 8192), 16, 0, 0); } while (0)
#define PG8_STAGE_A(bufoff, gbase, h, nx) do { if constexpr (GATHER) { const unsigned v_[2] = { (nx) ? vAn[h][0] : vAc[h][0], (nx) ? vAn[h][1] : vAc[h][1] }; PG8_STAGE(bufoff, gbase, v_); } \
        else { PG8_STAGE(bufoff, (gbase) + (h) * hstep, voffA); } } while (0)
#define PG8_LDA(dst, b, h) do { _Pragma("unroll") for (int m = 0; m < 4; ++m) _Pragma("unroll") for (int k = 0; k < 2; ++k) dst[m][k] = *(const PG8_LAS bf16x8*)(lds + PG8_SA(b, h) + aoff + m * 2048 + k * 1024); } while (0)
#define PG8_LDB(dst, b, h) do { _Pragma("unroll") for (int n = 0; n < 2; ++n) _Pragma("unroll") for (int k = 0; k < 2; ++k) dst[n][k] = *(const PG8_LAS bf16x8*)(lds + PG8_SB(b, h) + boff + n * 2048 + k * 1024); } while (0)
#define PG8_MMA(ai, bj, At, Bt) do { __builtin_amdgcn_s_setprio(1); _Pragma("unroll") for (int m = 0; m < 4; ++m) _Pragma("unroll") for (int n = 0; n < 2; ++n) _Pragma("unroll") for (int k = 0; k < 2; ++k) \
        acc[ai][bj][m][n] = __builtin_amdgcn_mfma_f32_16x16x32_bf16(Bt[n][k], At[m][k], acc[ai][bj][m][n], 0, 0, 0); __builtin_amdgcn_s_setprio(0); } while (0)
#define PG8_WAIT_V(n) asm volatile("s_waitcnt vmcnt(" #n ")" ::: "memory")
#define PG8_WAIT_L(n) asm volatile("s_waitcnt lgkmcnt(" #n ")" ::: "memory")
#define PG8_BAR __builtin_amdgcn_s_barrier()
#define PG8_SCHED __builtin_amdgcn_sched_barrier(0)
    Unit cur, nxt; int ui = 0;
    if (!S.next(0, cur)) return;
    f32x4 acc[2][2][4][2];
#pragma unroll
    for (int a = 0; a < 2; ++a)
#pragma unroll
        for (int b = 0; b < 2; ++b)
#pragma unroll
            for (int m = 0; m < 4; ++m)
#pragma unroll
                for (int n = 0; n < 2; ++n) acc[a][b][m][n] = (f32x4){0.f, 0.f, 0.f, 0.f};
    bf16x8 At[4][2], B0[2][2], B1[2][2];
    const char* cA = (const char*)g.A + (GATHER ? (size_t)0 : (size_t)cur.pm * tstep); const char* cB = (const char*)g.Bt + (size_t)cur.pb * tstep;
    if constexpr (GATHER) load_idx(cur.pm, vAc);
    S.a_ready(cur);
    if constexpr (SP2) {
        PG8_STAGE(PG8_SB(0, 0), cB, voffB); PG8_STAGE(PG8_SB(0, 1), cB + hstep, voffB); PG8_STAGE_A(PG8_SA(0, 0), cA, 0, false); PG8_STAGE_A(PG8_SA(0, 1), cA, 1, false);
        if (wr == 1) PG8_BAR;
        PG8_WAIT_V(2); PG8_BAR;
        PG8_STAGE(PG8_SB(1, 0), cB + kstep, voffB); PG8_STAGE_A(PG8_SA(1, 0), cA + kstep, 0, false); PG8_STAGE(PG8_SB(1, 1), cB + hstep + kstep, voffB);
        PG8_WAIT_V(6); PG8_BAR;
    } else {
        PG8_STAGE(PG8_SB(0, 0), cB, voffB); PG8_STAGE(PG8_SA(0, 0), cA, voffA); PG8_STAGE(PG8_SB(0, 1), cB + hstep, voffB); PG8_STAGE(PG8_SA(0, 1), cA + hstep, voffA);
        if (wr == 1) PG8_BAR;
        PG8_WAIT_V(4); PG8_BAR;
        PG8_STAGE(PG8_SB(1, 0), cB + kstep, voffB); PG8_STAGE(PG8_SA(1, 0), cA + kstep, voffA); PG8_STAGE(PG8_SB(1, 1), cB + hstep + kstep, voffB);
        PG8_WAIT_V(6); PG8_BAR;
    }
    for (;;) {
        const bool has_next = S.next(ui + 1, nxt);
        if constexpr (GATHER) { if (has_next) {
#pragma unroll
            for (int h = 0; h < 2; ++h)
#pragma unroll
                for (int i = 0; i < 2; ++i) __builtin_amdgcn_global_load_lds((const unsigned*)(g.rowidx + nxt.pm * BM + h * HALF + RA[i]), (PG8_LAS unsigned*)(lds + STAGE_BYTES + (h * 2 + i) * 2048 + wid * 256), 4, 0, 0); } }
        const char* nA = (has_next && !GATHER) ? (const char*)g.A + (size_t)nxt.pm * tstep : cA; const char* nB = has_next ? (const char*)g.Bt + (size_t)nxt.pb * tstep : cB;
        for (int t = 0; t < nt; t += 2) {
            const bool last = (t == nt - 2); const bool nxu = last && has_next; (void)nxu;
            if constexpr (GATHER) { if (nxu) {
#pragma unroll
                for (int h = 0; h < 2; ++h)
#pragma unroll
                    for (int i = 0; i < 2; ++i) { const int ix = *(const PG8_LAS int*)(lds + STAGE_BYTES + (h * 2 + i) * 2048 + tid * 4); vAn[h][i] = (unsigned)(ix * K + CA[i]) * 2u; } } }
            const char* a1 = cA + (size_t)(t + 1) * kstep;
            const char* a2 = last ? nA : cA + (size_t)(t + 2) * kstep; const char* b2 = last ? nB : cB + (size_t)(t + 2) * kstep;
            const char* a3 = a2 + kstep; const char* b3 = b2 + kstep;
            if (last && has_next) S.a_ready(nxt);
            if constexpr (SP2) {
            PG8_LDB(B0, 0, 0); PG8_LDB(B1, 0, 1); PG8_SCHED; PG8_LDA(At, 0, 0); PG8_STAGE_A(PG8_SA(1, 1), a1, 1, false);
            PG8_WAIT_V(8); PG8_WAIT_L(0); PG8_BAR; PG8_MMA(0, 0, At, B0); PG8_MMA(0, 1, At, B1); PG8_BAR; PG8_SCHED;
            PG8_LDA(At, 0, 1); PG8_STAGE(PG8_SB(0, 0), b2, voffB); PG8_STAGE(PG8_SB(0, 1), b2 + hstep, voffB); PG8_STAGE_A(PG8_SA(0, 0), a2, 0, nxu);
            PG8_WAIT_V(8); PG8_WAIT_L(0); PG8_BAR; PG8_MMA(1, 0, At, B0); PG8_MMA(1, 1, At, B1); PG8_BAR; PG8_SCHED;
            PG8_LDB(B0, 1, 0); PG8_LDB(B1, 1, 1); PG8_SCHED; PG8_LDA(At, 1, 0); PG8_STAGE_A(PG8_SA(0, 1), a2, 1, nxu);
            PG8_WAIT_V(8); PG8_WAIT_L(0); PG8_BAR; PG8_MMA(0, 0, At, B0); PG8_MMA(0, 1, At, B1); PG8_BAR; PG8_SCHED;
            PG8_LDA(At, 1, 1); PG8_STAGE(PG8_SB(1, 0), b3, voffB); PG8_STAGE(PG8_SB(1, 1), b3 + hstep, voffB); PG8_STAGE_A(PG8_SA(1, 0), a3, 0, nxu);
            PG8_WAIT_V(8); PG8_WAIT_L(0); PG8_BAR; PG8_MMA(1, 0, At, B0); PG8_MMA(1, 1, At, B1); PG8_BAR; PG8_SCHED;
            } else {
            PG8_LDB(B0, 0, 0); PG8_SCHED; PG8_LDA(At, 0, 0); PG8_STAGE(PG8_SA(1, 1), a1 + hstep, voffA);
            PG8_WAIT_L(8); PG8_BAR; PG8_WAIT_L(0); PG8_MMA(0, 0, At, B0); PG8_BAR; PG8_SCHED;
            PG8_LDB(B1, 0, 1); PG8_STAGE(PG8_SB(0, 0), b2, voffB);
            PG8_BAR; PG8_WAIT_L(0); PG8_MMA(0, 1, At, B1); PG8_BAR;
            PG8_LDA(At, 0, 1); PG8_STAGE(PG8_SA(0, 0), a2, voffA);
            PG8_BAR; PG8_WAIT_L(0); PG8_MMA(1, 0, At, B0); PG8_BAR; PG8_SCHED;
            PG8_STAGE(PG8_SB(0, 1), b2 + hstep, voffB);
            PG8_WAIT_V(6); PG8_BAR; PG8_MMA(1, 1, At, B1); PG8_BAR;
            PG8_LDB(B0, 1, 0); PG8_SCHED; PG8_LDA(At, 1, 0); PG8_STAGE(PG8_SA(0, 1), a2 + hstep, voffA);
            PG8_WAIT_L(8); PG8_BAR; PG8_WAIT_L(0); PG8_MMA(0, 0, At, B0); PG8_BAR; PG8_SCHED;
            PG8_LDB(B1, 1, 1); PG8_STAGE(PG8_SB(1, 0), b3, voffB);
            PG8_BAR; PG8_WAIT_L(0); PG8_MMA(0, 1, At, B1); PG8_BAR;
            PG8_LDA(At, 1, 1); PG8_STAGE(PG8_SA(1, 0), a3, voffA);
            PG8_BAR; PG8_WAIT_L(0); PG8_MMA(1, 0, At, B0); PG8_BAR; PG8_SCHED;
            PG8_STAGE(PG8_SB(1, 1), b3 + hstep, voffB);
            PG8_WAIT_V(6); PG8_BAR; PG8_MMA(1, 1, At, B1); PG8_BAR;
            }
        }
        if constexpr (ALIGN_EPI) { if (wr == 0) PG8_BAR; }
        if constexpr (!Epi::AFTER_DRAIN) { E(acc, cur, wr, wc, fr, fq); S.done(cur); }
        if (!has_next) break;
#pragma unroll
        for (int a = 0; a < 2; ++a)
#pragma unroll
            for (int b = 0; b < 2; ++b)
#pragma unroll
                for (int m = 0; m < 4; ++m)
#pragma unroll
                    for (int n = 0; n < 2; ++n) acc[a][b][m][n] = (f32x4){0.f, 0.f, 0.f, 0.f};
        cur = nxt; cA = nA; cB = nB; ++ui;
        if constexpr (GATHER) {
#pragma unroll
            for (int h = 0; h < 2; ++h) { vAc[h][0] = vAn[h][0]; vAc[h][1] = vAn[h][1]; } }
        if constexpr (ALIGN_EPI) { if (wr == 1) PG8_BAR; }
    }
    PG8_WAIT_V(0);
    if constexpr (!ALIGN_EPI) { if (wr == 0) PG8_BAR; }
    PG8_BAR;
    if constexpr (Epi::AFTER_DRAIN) { E.fused(acc, cur, wr, wc, fr, fq, lds, wid, lane); S.done(cur); }
#undef PG8_SA
#undef PG8_SB
#undef PG8_STAGE
#undef PG8_STAGE_A
#undef PG8_LDA
#undef PG8_LDB
#undef PG8_MMA
#undef PG8_WAIT_V
#undef PG8_WAIT_L
#undef PG8_BAR
#undef PG8_SCHED
}
}
constexpr int NB = 8, SEQ = 2048, DM = 1024, CTXL = 256, ML = NB * SEQ, MC = NB * CTXL, MT = ML + MC;
constexpr int PP = 2560;
constexpr int INW = 2336;
constexpr int C_GK = 0, C_GV = 128, C_GAF = 384, C_GAB = 400, C_NK = 416, C_NV = 672, C_SK = 928, C_SV = 1056, C_GQ = 1184, C_GG = 1312, C_NQ = 1568, C_SQ = 1824;
constexpr int NWAVES = 8;
constexpr float NEPS = 1e-6f;
constexpr float LOG2E = 1.4426950408889634f;

constexpr size_t MiB = 1u << 20;
constexpr size_t WS_CTL = 0, CTL_ZERO_BYTES = 1 * MiB;
constexpr size_t WS_TAB = 1 * MiB;
constexpr size_t WS_MOD = 1 * MiB + 65536;
constexpr size_t WS_MODP = 2 * MiB;
constexpr size_t WS_WIN = 6 * MiB;
constexpr size_t WS_WOUT = 16 * MiB;
constexpr size_t WS_WGU = 20 * MiB;
constexpr size_t WS_WD = 148 * MiB;
constexpr size_t WS_H = 212 * MiB;
constexpr size_t WS_R1 = 248 * MiB;
constexpr size_t WS_R2 = 338 * MiB;
constexpr size_t WS_XB = 410 * MiB;
constexpr size_t WS_UST = 446 * MiB;
constexpr size_t WS_MISC = 464 * MiB;
constexpr size_t WS_DEC = WS_MISC;
constexpr size_t WS_AFF = WS_MISC + 1 * MiB;
constexpr size_t WS_AFFC = WS_MISC + 2 * MiB;
constexpr size_t WS_GATE = WS_MISC + 2 * MiB + 262144;
constexpr size_t WS_GATEC = WS_MISC + 2 * MiB + 524288;
constexpr size_t WS_INV = WS_MISC + 3 * MiB;
constexpr size_t WS_ROWIDX = WS_MISC + 3 * MiB + 786432;
constexpr size_t WS_END = 468 * MiB;
constexpr int CW_BAR = 4096;
constexpr int CW_QUEUE = 1024;
constexpr int CW_CONV = 2048;

constexpr int WAVE_LDS = 19456;
constexpr int RING_BYTES = NWAVES * WAVE_LDS;
constexpr int LDSCTL_OFF = RING_BYTES, MISC_OFF = LDSCTL_OFF + 320;
constexpr int LDS_BYTES = RING_BYTES + 1024;
static_assert(RING_BYTES >= pg8::STAGE_BYTES && LDS_BYTES <= 163840, "LDS map");

#define GAS __attribute__((address_space(1)))
#define LAS __attribute__((address_space(3)))
typedef unsigned short bf16_t;
typedef unsigned v4u __attribute__((ext_vector_type(4)));
typedef unsigned v2u __attribute__((ext_vector_type(2)));
typedef float f32x4 __attribute__((ext_vector_type(4)));
typedef float f32x2 __attribute__((ext_vector_type(2)));
typedef float f32x16 __attribute__((ext_vector_type(16)));
typedef short bf16x8 __attribute__((ext_vector_type(8)));
typedef short s16x4 __attribute__((ext_vector_type(4)));
typedef GAS unsigned gu32;
#define RLX_AGENT __ATOMIC_RELAXED, __HIP_MEMORY_SCOPE_AGENT
typedef __bf16 bf16x2_t __attribute__((ext_vector_type(2)));
__device__ __forceinline__ unsigned pk2(float lo, float hi) { f32x2 v = {lo, hi}; bf16x2_t b = __builtin_convertvector(v, bf16x2_t); return __builtin_bit_cast(unsigned, b); }
__device__ __forceinline__ float bflo(unsigned w) { return __uint_as_float(w << 16); }
__device__ __forceinline__ float bfhi(unsigned w) { return __uint_as_float(w & 0xffff0000u); }
__device__ __forceinline__ float bf1(bf16_t w) { return __uint_as_float((unsigned)w << 16); }
__device__ __forceinline__ float wave_sum(float v) {
#pragma unroll
    for (int o = 1; o < 64; o <<= 1) v += __shfl_xor(v, o);
    return v;
}
__device__ __forceinline__ float fexp2(float x) { return __builtin_amdgcn_exp2f(x); }
__device__ __forceinline__ float fexp(float x) { return __builtin_amdgcn_exp2f(x * LOG2E); }
__device__ __forceinline__ float flog(float x) { return __builtin_amdgcn_logf(x) * 0.6931471805599453f; }
__device__ __forceinline__ float frcp(float x) { return __builtin_amdgcn_rcpf(x); }
__device__ __forceinline__ float silu_f(float x) { return x * frcp(1.f + fexp(-x)); }
__device__ __forceinline__ int crow(int r, int hi) { return (r & 3) + 8 * (r >> 2) + 4 * hi; }
__device__ __forceinline__ s16x4 tr_read(LAS const unsigned char* p) { return __builtin_bit_cast(s16x4, __builtin_amdgcn_ds_read_tr16_b64_v4i16((LAS s16x4*)p)); }
__device__ __forceinline__ bf16x8 cat4(s16x4 a, s16x4 b) { return (bf16x8){a[0], a[1], a[2], a[3], b[0], b[1], b[2], b[3]}; }
__device__ __forceinline__ bf16x8 pack8(float a0, float a1, float a2, float a3, float a4, float a5, float a6, float a7) {
    v4u w; w.x = pk2(a0, a1); w.y = pk2(a2, a3); w.z = pk2(a4, a5); w.w = pk2(a6, a7); return __builtin_bit_cast(bf16x8, w); }
#define MFMA32(a, b, c) __builtin_amdgcn_mfma_f32_32x32x16_bf16((a), (b), (c), 0, 0, 0)

#define XB_TMO      128
#define XB_XCNT(j)  (256  + 64 * (j))
#define XB_XSUB(j)  (1280 + 64 * (j))
#define XB_XGEN(j)  (2304 + 64 * (j))
#define XB_TOP      3328
#define XB_TOPGEN   3392
#define XCD_BAR_WORDS 3456
#define XB_SPIN_CAP (1u << 18)

__device__ __forceinline__ unsigned xb_ld(unsigned* p)              { return __hip_atomic_load(p, __ATOMIC_RELAXED, __HIP_MEMORY_SCOPE_AGENT); }
__device__ __forceinline__ unsigned xb_add(unsigned* p, unsigned v) { return __hip_atomic_fetch_add(p, v, __ATOMIC_RELAXED, __HIP_MEMORY_SCOPE_AGENT); }
__device__ __forceinline__ unsigned xb_xcc_id() { return (unsigned)__builtin_amdgcn_s_getreg((3 << 11) | 20) & 0xFu; }
#define XB_SPIN(cond, bar) do { unsigned _sp = 0; while (cond) { __builtin_amdgcn_s_sleep(1); \
    if ((++_sp & 255u) == 0u) { if (xb_ld(&(bar)[XB_TMO])) break; if (_sp > XB_SPIN_CAP) { atomicAdd(&(bar)[XB_TMO], 1u); break; } } } } while (0)

struct XcdBarrier {
    unsigned* bar; unsigned x;
    volatile LAS unsigned* st;
};

__device__ __forceinline__ XcdBarrier xcd_barrier_post(unsigned* bar, volatile LAS unsigned* st) {
    XcdBarrier b; b.bar = bar; b.x = xb_xcc_id(); b.st = st;
    if (threadIdx.x == 0) (void)xb_add(&bar[XB_XCNT(b.x)], 1u);
    return b;
}
__device__ __forceinline__ void xcd_barrier_complete(unsigned* bar, unsigned x, unsigned& nloc, unsigned& nx) {
    const unsigned G = gridDim.x * gridDim.y * gridDim.z;
    unsigned sum, cnt, mine, sp = 0u;
    for (;;) {
        sum = 0u; cnt = 0u; mine = 0u;
#pragma unroll
        for (unsigned j = 0; j < 16; ++j) { const unsigned c = xb_ld(&bar[XB_XCNT(j)]); sum += c; cnt += (c > 0u) ? 1u : 0u; mine = (j == x) ? c : mine; }
        if (sum == G) break;
        __builtin_amdgcn_s_sleep(1);
        if ((++sp & 255u) == 0u) { if (xb_ld(&bar[XB_TMO])) break; if (sp > XB_SPIN_CAP) { atomicAdd(&bar[XB_TMO], 1u); break; } }
    }
    nloc = mine > 0u ? mine : 1u; nx = cnt > 0u ? cnt : 1u;
}

__device__ __forceinline__ void xcd_barrier(const XcdBarrier& b) {
    asm volatile("s_waitcnt vmcnt(0)" ::: "memory");
    __syncthreads();
    if (threadIdx.x == 0) {
        unsigned* bar = b.bar;
        __builtin_amdgcn_s_waitcnt(0);
        unsigned nloc = b.st[0], nx = b.st[1];
        if (nloc == 0u) { xcd_barrier_complete(bar, b.x, nloc, nx); b.st[0] = nloc; b.st[1] = nx; }
        const unsigned old = xb_add(&bar[XB_XSUB(b.x)], 1u);
        const unsigned gen = old / nloc;
        if (old + 1u == (gen + 1u) * nloc) {
            __builtin_amdgcn_fence(__ATOMIC_RELEASE, "agent");
            asm volatile("s_waitcnt vmcnt(0)" ::: "memory");
            const unsigned og = xb_add(&bar[XB_TOP], 1u);
            const unsigned tg = og / nx;
            if (og + 1u == (tg + 1u) * nx) xb_add(&bar[XB_TOPGEN], 1u);
            else XB_SPIN(xb_ld(&bar[XB_TOPGEN]) == tg, bar);
            __builtin_amdgcn_fence(__ATOMIC_ACQUIRE, "agent");
            xb_add(&bar[XB_XGEN(b.x)], 1u);
            asm volatile("s_waitcnt vmcnt(0)" ::: "memory");
        } else {
            XB_SPIN(xb_ld(&bar[XB_XGEN(b.x)]) == gen, bar);
            __builtin_amdgcn_fence(__ATOMIC_ACQUIRE, "agent");
            asm volatile("s_waitcnt vmcnt(0)" ::: "memory");
        }
    }
    __syncthreads();
}
__device__ __forceinline__ void ld_row_f32(const float* p, int lane, f32x4 (&v)[4]) {
#pragma unroll
    for (int j = 0; j < 4; ++j) v[j] = *(const f32x4*)(p + 256 * j + 4 * lane);
}
__device__ __forceinline__ void st_row_f32(float* p, int lane, const f32x4 (&v)[4]) {
#pragma unroll
    for (int j = 0; j < 4; ++j) *(f32x4*)(p + 256 * j + 4 * lane) = v[j];
}
__device__ __forceinline__ void ld_row_bf16(const bf16_t* p, int lane, f32x4 (&v)[4]) {
#pragma unroll
    for (int j = 0; j < 4; ++j) { const v2u w = *(const v2u*)(p + 256 * j + 4 * lane); v[j] = (f32x4){bflo(w.x), bfhi(w.x), bflo(w.y), bfhi(w.y)}; }
}
__device__ __forceinline__ void st_row_bf16(bf16_t* p, int lane, const f32x4 (&v)[4]) {
#pragma unroll
    for (int j = 0; j < 4; ++j) { v2u w; w.x = pk2(v[j].x, v[j].y); w.y = pk2(v[j].z, v[j].w); *(v2u*)(p + 256 * j + 4 * lane) = w; }
}
__device__ __forceinline__ void ld_vec_lds(LAS const float* p, int lane, f32x4 (&v)[4]) {
#pragma unroll
    for (int j = 0; j < 4; ++j) v[j] = *(LAS const f32x4*)(p + 256 * j + 4 * lane);
}
__device__ __forceinline__ float sumsq16(const f32x4 (&v)[4]) {
    float s = 0.f;
#pragma unroll
    for (int j = 0; j < 4; ++j) s += (v[j].x * v[j].x + v[j].y * v[j].y) + (v[j].z * v[j].z + v[j].w * v[j].w);
    return s;
}
__device__ __forceinline__ float modfin(const float* modp, const float* bmod, int l, int r, int n) {
    float s = bmod[l * 6144 + n];
#pragma unroll
    for (int kc = 0; kc < 8; ++kc) s += modp[((size_t)(l * 8 + kc) * 9 + r) * 6144 + n];
    return s;
}

#ifndef CONV_IN_P0
#define CONV_IN_P0 1
#endif
__device__ __forceinline__ void tr_item64(const float* W, int N, int Nvalid, bf16_t* WT, int Kd, int k0, int n0, int dst_row0, LAS float* scr, int lane) {
    const int q = lane & 15, kr = lane >> 4;
    f32x4 t[16];
#pragma unroll
    for (int i = 0; i < 16; ++i) { const int kk = 4 * i + kr; const int n = n0 + 4 * q;
        t[i] = (n < Nvalid) ? *(const f32x4*)(W + (size_t)(k0 + kk) * N + n) : (f32x4){0.f, 0.f, 0.f, 0.f}; }
#pragma unroll
    for (int i = 0; i < 16; ++i) { const int kk = 4 * i + kr; LAS float* d = scr + kk * 65 + 4 * q; d[0] = t[i].x; d[1] = t[i].y; d[2] = t[i].z; d[3] = t[i].w; }
    const int c = lane & 7, nl = lane >> 3;
#pragma unroll
    for (int j = 0; j < 8; ++j) { const int n = nl + 8 * j; LAS const float* s = scr + (8 * c) * 65 + n;
        v4u o; o.x = pk2(s[0 * 65], s[1 * 65]); o.y = pk2(s[2 * 65], s[3 * 65]); o.z = pk2(s[4 * 65], s[5 * 65]); o.w = pk2(s[6 * 65], s[7 * 65]);
        *(v4u*)(WT + (size_t)(dst_row0 + n) * Kd + k0 + 8 * c) = o; }
}
__device__ __forceinline__ void expert_conv_item(const float* const* in, unsigned char* ws, int l, int r, LAS float* scr, int lane) {
    const float* w_gate = in[15]; const float* w_up = in[16]; const float* w_down = in[17];
    const int which = r >> 12; r &= 4095;
    const int e = r >> 8, kb = (r & 255) >> 4, nb = r & 15, n0 = 64 * nb;
    const size_t eoff = (size_t)(l * 16 + e) * 1024 * 1024;
    if (which == 0) tr_item64(w_gate + eoff, 1024, 1024, (bf16_t*)(ws + WS_WGU) + 2 * eoff, 1024, 64 * kb, n0, (n0 >> 7) * 256 + (n0 & 127), scr, lane);
    else if (which == 1) tr_item64(w_up + eoff, 1024, 1024, (bf16_t*)(ws + WS_WGU) + 2 * eoff, 1024, 64 * kb, n0, (n0 >> 7) * 256 + 128 + (n0 & 127), scr, lane);
    else tr_item64(w_down + eoff, 1024, 1024, (bf16_t*)(ws + WS_WD) + eoff, 1024, 64 * kb, n0, n0, scr, lane);
}
__device__ __forceinline__ void conv_pull(const float* const* in, unsigned char* ws, int l_lo, int l_hi, int budget, LAS float* scr, int lane) {
    for (int l = l_lo; l <= l_hi && l < 2; ++l) {
        unsigned* ctr = (unsigned*)(ws + WS_CTL) + CW_CONV + 64 * l;
        while (budget > 0) {
            const int c = budget < 8 ? budget : 8;
            unsigned r = 0; if (lane == 0) r = __hip_atomic_fetch_add(ctr, (unsigned)c, __ATOMIC_RELAXED, __HIP_MEMORY_SCOPE_AGENT);
            r = (unsigned)__builtin_amdgcn_readfirstlane((int)r);
            if (r >= 12288u) break;
            for (int k = 0; k < c && (int)r + k < 12288; ++k) expert_conv_item(in, ws, l, (int)r + k, scr, lane);
            budget -= c;
        }
    }
}
__device__ __forceinline__ void phase_p0(const float* const* in, unsigned char* ws, LAS unsigned char* wl, int gw, int NGW, int lane) {
    const float* cvec = in[1]; const float* cctx = in[3]; const float* wmod = in[4];
    const float* w_in = in[7]; const float* w_out = in[8];
    float* modp = (float*)(ws + WS_MODP);
    constexpr int NI_MOD = 2 * 8 * 24, NI_ROPE = 16;
    constexpr int NI_IN = 16 * 40, NI_OUT = 16 * 16, NI_E = 16 * 16 * 16;
    constexpr int NI_L = NI_IN + NI_OUT + (CONV_IN_P0 ? 3 * NI_E : 0);
    constexpr int NITEMS = NI_MOD + NI_ROPE + 2 * NI_L;
    LAS float* scr = (LAS float*)wl;
    for (int it = gw; it < NITEMS; it += NGW) {
        int r = it;
        if (r < NI_MOD) {
            const int cb = r % 24, kc = (r / 24) & 7, l = r / 192;
            for (int idx = lane; idx < 128 * 9; idx += 64) { const int rr = idx / 128, k = idx % 128; const float cv = (rr < 8) ? cvec[rr * 1024 + kc * 128 + k] : cctx[kc * 128 + k]; scr[k * 12 + rr] = silu_f(cv); }
            f32x4 acc[9];
#pragma unroll
            for (int rr = 0; rr < 9; ++rr) acc[rr] = (f32x4){0.f, 0.f, 0.f, 0.f};
            const float* wp = wmod + ((size_t)l * 1024 + kc * 128) * 6144 + cb * 256 + 4 * lane;
#pragma unroll 4
            for (int k = 0; k < 128; ++k) { const f32x4 w = *(const f32x4*)(wp + (size_t)k * 6144);
                const f32x4 s0 = *(LAS const f32x4*)(scr + k * 12), s1 = *(LAS const f32x4*)(scr + k * 12 + 4); const float s8 = scr[k * 12 + 8];
                acc[0] += w * s0.x; acc[1] += w * s0.y; acc[2] += w * s0.z; acc[3] += w * s0.w; acc[4] += w * s1.x; acc[5] += w * s1.y; acc[6] += w * s1.z; acc[7] += w * s1.w; acc[8] += w * s8; }
#pragma unroll
            for (int rr = 0; rr < 9; ++rr) *(f32x4*)(modp + ((size_t)(l * 8 + kc) * 9 + rr) * 6144 + cb * 256 + 4 * lane) = acc[rr];
            continue;
        }
        r -= NI_MOD;
        if (r < NI_ROPE) {
            const int id = r * 64 + lane, pos = id >> 4, i = id & 15;
            const float fr = fexp2(-(float)i * (13.287712379549449f / 16.f));
            float rev = (float)pos * fr * 0.15915494309189535f; rev -= floorf(rev);
            f32x2 cs; cs.x = __builtin_amdgcn_cosf(rev); cs.y = __builtin_amdgcn_sinf(rev);
            ((f32x2*)(ws + WS_TAB))[id] = cs;
            continue;
        }
        r -= NI_ROPE;
        const int l = r / NI_L; r -= l * NI_L;
        if (r < NI_IN) { const int kb = r / 40, nb = r % 40;
            tr_item64(w_in + (size_t)l * 1024 * INW, INW, INW, (bf16_t*)(ws + WS_WIN) + (size_t)l * PP * 1024, 1024, 64 * kb, 64 * nb, 64 * nb, scr, lane); continue; }
        r -= NI_IN;
        if (r < NI_OUT) { const int kb = r / 16, nb = r % 16;
            tr_item64(w_out + (size_t)l * 1024 * 1024, 1024, 1024, (bf16_t*)(ws + WS_WOUT) + (size_t)l * 1024 * 1024, 1024, 64 * kb, 64 * nb, 64 * nb, scr, lane); continue; }
        r -= NI_OUT;
        expert_conv_item(in, ws, l, r, scr, lane);
    }
}

__device__ __forceinline__ void phase_a0(const float* const* in, unsigned char* ws, LAS unsigned char* lds, int G, int tid, int wave, int lane) {
    const float* x = in[0]; const float* ctx = in[2]; const float* bmod = in[5]; const float* gains = in[6];
    const float* modp = (const float*)(ws + WS_MODP); float* mod = (float*)(ws + WS_MOD); bf16_t* H = (bf16_t*)(ws + WS_H);
    LAS float* V = (LAS float*)lds;
    for (int row = blockIdx.x; row < 18; row += G) { const int l = row / 9, r = row % 9;
        for (int n = tid; n < 6144; n += 512) mod[(size_t)row * 6144 + n] = modfin(modp, bmod, l, r, n); }
    for (int t = blockIdx.x; t < 256; t += G) {
        const int b = t >> 5;
        __syncthreads();
        for (int n = tid; n < 1024; n += 512) { const float g = gains[n];
            V[n] = g * (1.f + modfin(modp, bmod, 0, b, 1024 + n)); V[1024 + n] = modfin(modp, bmod, 0, b, n);
            V[2048 + n] = g * (1.f + modfin(modp, bmod, 0, 8, 1024 + n)); V[3072 + n] = modfin(modp, bmod, 0, 8, n); }
        __syncthreads();
#pragma unroll 1
        for (int i0 = 0; i0 < 9; i0 += 3) {
            f32x4 xq[3][4];
#pragma unroll
            for (int k = 0; k < 3; ++k) { const int i = i0 + k; const bool isc = (i == 8);
                const float* src = isc ? (ctx + (size_t)(8 * t + wave) * 1024) : (x + (size_t)(64 * t + 8 * wave + i) * 1024); ld_row_f32(src, lane, xq[k]); }
#pragma unroll
            for (int k = 0; k < 3; ++k) { const int i = i0 + k; const bool isc = (i == 8);
                const int row = isc ? (ML + 8 * t + wave) : (64 * t + 8 * wave + i);
                f32x4 (&v)[4] = xq[k]; f32x4 a[4], s[4];
                const float rstd = __builtin_amdgcn_rsqf(wave_sum(sumsq16(v)) * (1.f / 1024.f) + NEPS);
                ld_vec_lds(V + (isc ? 2048 : 0), lane, a); ld_vec_lds(V + (isc ? 3072 : 1024), lane, s);
#pragma unroll
                for (int j = 0; j < 4; ++j) v[j] = v[j] * rstd * a[j] + s[j];
                st_row_bf16(H + (size_t)row * 1024, lane, v);
            }
        }
    }
}
constexpr int VP = 192;
struct AttnTile { f32x16 o0, o1; float m, lsum; };
__device__ __forceinline__ void attn_softmax(f32x16& s, AttnTile& T) {
    float bm = fmaxf(fmaxf(s[0], s[1]), fmaxf(s[2], s[3]));
#pragma unroll
    for (int i = 4; i < 16; i += 4) bm = fmaxf(bm, fmaxf(fmaxf(s[i], s[i + 1]), fmaxf(s[i + 2], s[i + 3])));
    bm = fmaxf(bm, __shfl_xor(bm, 32));
    const float mo = T.m, mn = fmaxf(mo, bm);
    T.m = mn;
    float ps = 0.f;
#pragma unroll
    for (int i = 0; i < 16; ++i) { s[i] = fexp2(s[i] - mn); ps += s[i]; }
    if (__any(mn != mo)) {
        const float alpha = fexp2(mo - mn);
        T.lsum *= alpha;
#pragma unroll
        for (int i = 0; i < 16; ++i) { T.o0[i] *= alpha; T.o1[i] *= alpha; }
    }
    T.lsum += ps;
}
__device__ __forceinline__ void attn_item(const int MODE, const bf16_t* P, bf16_t* MIX, int item, LAS unsigned char* wl, int lane,
                                          const float* __restrict__ rpb, const float* __restrict__ sink, const bool dry = false) {
    asm volatile("" : "+v"(lane));
    const int ql = lane & 31, hi = lane >> 5;
    int b, hq, qcol, kcol, vcol, ocol, qrow0, r = 0, rs = 0, q64 = 0, nloc, kb_lo = 0;
    if (MODE == 0) { r = item & 31; hq = (item >> 5) & 3; b = item >> 7;
        qcol = C_NQ + hq * 64; kcol = C_NK + hq * 64; vcol = C_NV + hq * 64; ocol = 256 + hq * 64; qrow0 = b * SEQ + r * 64;
        rs = r - 4; rs = rs < 0 ? 0 : (rs > 24 ? 24 : rs); nloc = 16; }
    else if (MODE == 1) { q64 = item & 31; hq = (item >> 5) & 7; b = item >> 8;
        qcol = C_SQ + hq * 64; kcol = C_SK + (hq >> 2) * 64; vcol = C_SV + (hq >> 2) * 64; ocol = 512 + hq * 64; qrow0 = b * SEQ + q64 * 64;
        kb_lo = 2 * q64 - 4; if (kb_lo < 0) kb_lo = 0; int kb_hi = 2 * q64 + 5; if (kb_hi > 63) kb_hi = 63; nloc = kb_hi - kb_lo + 1; }
    else if (MODE == 2) { q64 = item & 3; hq = (item >> 2) & 3; b = item >> 4;
        qcol = C_NQ + hq * 64; kcol = C_NK + hq * 64; vcol = C_NV + hq * 64; ocol = 256 + hq * 64; qrow0 = ML + b * CTXL + q64 * 64; nloc = 0; }
    else { q64 = item & 3; hq = (item >> 2) & 7; b = item >> 5;
        qcol = C_SQ + hq * 64; kcol = C_SK + (hq >> 2) * 64; vcol = C_SV + (hq >> 2) * 64; ocol = 512 + hq * 64; qrow0 = ML + b * CTXL + q64 * 64; nloc = 0; }
    const int nblk = 8 + nloc;
    LAS unsigned char* vl = wl;
    LAS float* rl = (LAS float*)(wl + 32 * VP);
    if (MODE == 0) { for (int i = lane; i < 465; i += 64) rl[i] = rpb[hq * 465 + i] * LOG2E; }
    LAS unsigned char* qimg = wl + 32 * VP + 1920;
    constexpr int QP = 144;
#pragma unroll
    for (int i = 0; i < 8; ++i) { const int c = lane + 64 * i; const v4u v = *(const v4u*)(P + (size_t)(qrow0 + (c >> 3)) * PP + qcol + (c & 7) * 8); *(LAS v4u*)(qimg + (c >> 3) * QP + (c & 7) * 16) = v; }
    LAS const unsigned char* qrd = qimg + ql * QP + 16 * hi;
    auto blk_row0 = [&](int blk) -> int {
        if (blk < 8) return ML + b * CTXL + blk * 32;
        const int lb = blk - 8;
        if (MODE == 0) return b * SEQ + (rs + (lb >> 1)) * 64 + (lb & 1) * 32;
        return b * SEQ + 32 * (kb_lo + lb);
    };
    auto load_blk = [&](int blk, bf16x8 (&kn)[4], v4u (&vn)[4]) {
        const int r0 = blk_row0(blk);
        const bf16_t* kp = P + (size_t)(r0 + ql) * PP + kcol + 8 * hi;
#pragma unroll
        for (int ds = 0; ds < 4; ++ds) kn[ds] = *(const bf16x8*)(kp + 16 * ds);
#pragma unroll
        for (int i = 0; i < 4; ++i) { const int c = lane + 64 * i; vn[i] = *(const v4u*)(P + (size_t)(r0 + (c >> 3)) * PP + vcol + (c & 7) * 8); }
    };
    AttnTile T[2];
#pragma unroll
    for (int t = 0; t < 2; ++t) { T[t].m = -INFINITY; T[t].lsum = 0.f;
#pragma unroll
        for (int i = 0; i < 16; ++i) { T[t].o0[i] = 0.f; T[t].o1[i] = 0.f; } }
    const int tr_off = (4 * hi + ((lane & 15) >> 2)) * VP + (16 * ((lane >> 4) & 1) + 4 * (lane & 3)) * 2;
    auto step = [&](int blk, bf16x8 (&kf)[4], v4u (&vr)[4]) {
#pragma unroll
        for (int i = 0; i < 4; ++i) { const int c = lane + 64 * i; *(LAS v4u*)(vl + (c >> 3) * VP + (c & 7) * 16) = vr[i]; }
        f32x16 sc[2];
#pragma unroll
        for (int t = 0; t < 2; ++t) {
#pragma unroll
            for (int i = 0; i < 16; ++i) sc[t][i] = 0.f;
#pragma unroll
            for (int ds = 0; ds < 4; ++ds) sc[t] = MFMA32(kf[ds], *(LAS const bf16x8*)(qrd + 32 * t * QP + 32 * ds), sc[t]);
        }
        if (blk + 2 < nblk) load_blk(blk + 2, kf, vr);
        bf16x8 vf[2][2];
#pragma unroll
        for (int ks = 0; ks < 2; ++ks) { LAS const unsigned char* vb = vl + tr_off + 16 * ks * VP;
            vf[ks][0] = cat4(tr_read(vb), tr_read(vb + 8 * VP)); vf[ks][1] = cat4(tr_read(vb + 64), tr_read(vb + 8 * VP + 64)); }
#pragma unroll
        for (int t = 0; t < 2; ++t) {
            f32x16& s = sc[t];
            if (MODE == 0 && blk >= 8) {
                const int lb = blk - 8, j = lb >> 1, ch = lb & 1, c = t * 32 + ql;
                int cs = c - 8; cs = cs < 0 ? 0 : (cs > 48 ? 48 : cs);
                LAS const float* rrow = rl + (rs + j - r + 7) * 31 + (15 - c);
#pragma unroll
                for (int i = 0; i < 16; ++i) { const int kc = ch * 32 + crow(i, hi); const bool ok = (kc >= cs) && (kc < cs + 16);
                    const float bias = rrow[ok ? kc : c];
                    s[i] = ok ? (s[i] + bias) : -INFINITY; }
            } else if (MODE == 1 && blk >= 8) {
                const int rel = (kb_lo + blk - 8) - (2 * q64 + t);
                if (rel <= -4 || rel >= 4) {
#pragma unroll
                    for (int i = 0; i < 16; ++i) { const int kk = crow(i, hi); const bool ok = (rel == -4) ? (kk >= ql) : ((rel == 4) ? (kk <= ql) : false);
                        s[i] = ok ? s[i] : -INFINITY; }
                }
            }
            attn_softmax(s, T[t]);
#pragma unroll
            for (int ks = 0; ks < 2; ++ks) {
                const bf16x8 pf = pack8(s[8 * ks + 0], s[8 * ks + 1], s[8 * ks + 2], s[8 * ks + 3], s[8 * ks + 4], s[8 * ks + 5], s[8 * ks + 6], s[8 * ks + 7]);
                T[t].o0 = MFMA32(vf[ks][0], pf, T[t].o0); T[t].o1 = MFMA32(vf[ks][1], pf, T[t].o1);
            }
            __builtin_amdgcn_sched_barrier(0);
        }
    };
    bf16x8 kA[4], kB[4]; v4u vA[4], vB[4];
    load_blk(0, kA, vA); load_blk(1, kB, vB);
    for (int blk = 0; blk < nblk; blk += 2) { step(blk, kA, vA); if (blk + 1 < nblk) step(blk + 1, kB, vB); }
#pragma unroll
    for (int t = 0; t < 2; ++t) {
        float lt = T[t].lsum + __shfl_xor(T[t].lsum, 32);
        if (MODE == 1 || MODE == 3) lt += fexp2(sink[hq] * LOG2E - T[t].m);
        const float inv = frcp(lt);
        bf16_t* op = MIX + (size_t)(qrow0 + 32 * t + ql) * 1024 + ocol + 4 * hi;
#pragma unroll
        for (int g = 0; g < 4; ++g) {
            v2u w0, w1; w0.x = pk2(T[t].o0[4 * g] * inv, T[t].o0[4 * g + 1] * inv); w0.y = pk2(T[t].o0[4 * g + 2] * inv, T[t].o0[4 * g + 3] * inv);
            w1.x = pk2(T[t].o1[4 * g] * inv, T[t].o1[4 * g + 1] * inv); w1.y = pk2(T[t].o1[4 * g + 2] * inv, T[t].o1[4 * g + 3] * inv);
            *(v2u*)(op + 8 * g) = w0; *(v2u*)(op + 32 + 8 * g) = w1;
        }
    }
}
constexpr int GP = 144;
constexpr int G_V = 0, G_A = 64 * GP, G_B = 64 * GP + 32 * GP;
static_assert(G_B + 32 * GP <= WAVE_LDS, "gla LDS");

struct GlaCum { float cum[2][16]; float tot; };
__device__ __forceinline__ void gla_cum(const bf16_t* P, int row0, int hh, int dir, const float* __restrict__ a_up, const float* __restrict__ a_bias, int lane, GlaCum& C) {
    const int kk = lane & 31, hi = lane >> 5;
    const float* up = a_up + (size_t)dir * 16 * 128 + (size_t)(8 * hi) * 128 + hh * 32 + kk;
    const bf16x8 ub = pack8(up[0], up[128], up[256], up[384], up[512], up[640], up[768], up[896]);
    const float bias = a_bias[dir * 128 + hh * 32 + kk];
    float gs[2][4];
#pragma unroll
    for (int tt = 0; tt < 2; ++tt) {
        const bf16x8 al = *(const bf16x8*)(P + (size_t)(row0 + 32 * tt + kk) * PP + C_GAF + 16 * dir + 8 * hi);
        f32x16 z;
#pragma unroll
        for (int i = 0; i < 16; ++i) z[i] = 0.f;
        z = MFMA32(al, ub, z);
#pragma unroll
        for (int g = 0; g < 4; ++g) { float run = 0.f;
#pragma unroll
            for (int e = 0; e < 4; ++e) { const float zz = z[4 * g + e] + bias; const float ls = fminf(zz, 0.f) - flog(1.f + fexp(-fabsf(zz)));
                const float l = ls * (1.f / 16.f);
                if (dir == 0) { run += l; C.cum[tt][4 * g + e] = run; } else { C.cum[tt][4 * g + e] = run; run += l; } }
            gs[tt][g] = run; }
    }
    float off = 0.f;
#pragma unroll
    for (int tt = 0; tt < 2; ++tt)
#pragma unroll
        for (int g = 0; g < 4; ++g) { const float other = __shfl_xor(gs[tt][g], 32); const float mine = off + (hi ? other : 0.f);
#pragma unroll
            for (int e = 0; e < 4; ++e) C.cum[tt][4 * g + e] += mine;
            off += gs[tt][g] + other; }
    C.tot = off;
    if (dir == 1) {
#pragma unroll
        for (int tt = 0; tt < 2; ++tt)
#pragma unroll
            for (int r = 0; r < 16; ++r) C.cum[tt][r] = off - C.cum[tt][r];
    }
}
__device__ __forceinline__ void gla_ld_tc(const bf16_t* P, int row0, int col, int lane, float (&x)[2][16]) {
    const int kk = lane & 31, hi = lane >> 5;
#pragma unroll
    for (int tt = 0; tt < 2; ++tt)
#pragma unroll
        for (int r = 0; r < 16; ++r) x[tt][r] = bf1(P[(size_t)(row0 + 32 * tt + crow(r, hi)) * PP + col + kk]);
}
__device__ __forceinline__ void gla_st_img(LAS unsigned char* img, int lane, const float (&x)[2][16]) {
    const int kk = lane & 31, hi = lane >> 5;
#pragma unroll
    for (int tt = 0; tt < 2; ++tt)
#pragma unroll
        for (int g = 0; g < 4; ++g) { v2u w; w.x = pk2(x[tt][4 * g], x[tt][4 * g + 1]); w.y = pk2(x[tt][4 * g + 2], x[tt][4 * g + 3]);
            *(LAS v2u*)(img + kk * GP + (32 * tt + 8 * g + 4 * hi) * 2) = w; }
}
__device__ __forceinline__ void gla_stage_v(const bf16_t* P, int row0, int hh, LAS unsigned char* wl, int lane) {
#pragma unroll
    for (int i = 0; i < 8; ++i) { const int c = lane + 64 * i; const v4u v = *(const v4u*)(P + (size_t)(row0 + (c >> 3)) * PP + C_GV + hh * 64 + (c & 7) * 8);
        *(LAS v4u*)(wl + G_V + (c >> 3) * GP + (c & 7) * 16) = v; }
}
__device__ __forceinline__ int gla_row0(int b, int nc) { return nc < 4 ? (ML + b * CTXL + 64 * nc) : (b * SEQ + 64 * (nc - 4)); }

__device__ __forceinline__ void gla_local_item(const bf16_t* P, float* UST, float* DEC, int item, LAS unsigned char* wl, int lane,
                                               const float* __restrict__ a_up, const float* __restrict__ a_bias) {
    asm volatile("" : "+v"(lane));
    const int nc = item % 36, hh = (item / 36) & 3, b = item / 144;
    const int row0 = gla_row0(b, nc), kk = lane & 31, hi = lane >> 5;
    gla_stage_v(P, row0, hh, wl, lane);
    float kv[2][16]; gla_ld_tc(P, row0, C_GK + hh * 32, lane, kv);
#pragma unroll
    for (int dir = 0; dir < 2; ++dir) {
        GlaCum C; gla_cum(P, row0, hh, dir, a_up, a_bias, lane, C);
        float kd[2][16];
#pragma unroll
        for (int tt = 0; tt < 2; ++tt)
#pragma unroll
            for (int r = 0; r < 16; ++r) kd[tt][r] = kv[tt][r] * fexp(C.tot - C.cum[tt][r]);
        gla_st_img(wl + (dir == 0 ? G_A : G_B), lane, kd);
        if (hi == 0) DEC[((size_t)((b * 4 + hh) * 2 + dir) * 36 + nc) * 32 + kk] = fexp(C.tot);
    }
    const int trv = ((lane & 15) >> 2) * GP + (16 * ((lane >> 4) & 1) + 4 * (lane & 3)) * 2;
#pragma unroll
    for (int dir = 0; dir < 2; ++dir) {
        f32x16 u0, u1;
#pragma unroll
        for (int i = 0; i < 16; ++i) { u0[i] = 0.f; u1[i] = 0.f; }
        LAS const unsigned char* img = wl + (dir == 0 ? G_A : G_B);
#pragma unroll
        for (int s = 0; s < 4; ++s) {
            const bf16x8 kb = *(LAS const bf16x8*)(img + kk * GP + (16 * s + 8 * hi) * 2);
            LAS const unsigned char* vb = wl + G_V + trv + (16 * s + 8 * hi) * GP;
            const bf16x8 v0 = cat4(tr_read(vb), tr_read(vb + 4 * GP));
            const bf16x8 v1 = cat4(tr_read(vb + 64), tr_read(vb + 4 * GP + 64));
            u0 = MFMA32(v0, kb, u0); u1 = MFMA32(v1, kb, u1);
        }
        float* up = UST + ((size_t)((b * 4 + hh) * 2 + dir) * 36 + nc) * 2048 + kk;
#pragma unroll
        for (int i = 0; i < 16; ++i) { up[(size_t)crow(i, hi) * 32] = u0[i]; up[(size_t)(32 + crow(i, hi)) * 32] = u1[i]; }
    }
}

__device__ __forceinline__ void gla_prefix(float* UST, const float* DEC, int gid, bool dry) {
    const int bhd = gid >> 11, e = gid & 2047, k = e & 31, dir = bhd & 1;
    float* base = UST + (size_t)bhd * 36 * 2048 + e; const float* dec = DEC + (size_t)bhd * 36 * 32 + k;
    float s = 0.f;
#pragma unroll 4
    for (int ci = 0; ci < 36; ++ci) {
        const int sl = dir == 0 ? ci : (ci < 4 ? 3 - ci : 39 - ci);
        const float u = base[(size_t)sl * 2048], d = dec[sl * 32];
        if (!dry) base[(size_t)sl * 2048] = s;
        s = d * s + u;
    }
}

__device__ __forceinline__ void gla_out_item(const bf16_t* P, const float* UST, bf16_t* MIX, int item, LAS unsigned char* wl, int lane,
                                             const float* __restrict__ a_up, const float* __restrict__ a_bias, const float* __restrict__ gnorm) {
    const int nc = item % 36, hh = (item / 36) & 3, b = item / 144;
    const int row0 = gla_row0(b, nc), kk = lane & 31, hi = lane >> 5;
    gla_stage_v(P, row0, hh, wl, lane);
    f32x16 o[2][2];
#pragma unroll
    for (int a = 0; a < 2; ++a)
#pragma unroll
        for (int c = 0; c < 2; ++c)
#pragma unroll
            for (int i = 0; i < 16; ++i) o[a][c][i] = 0.f;
    const int g16 = (lane >> 4) & 1, qq = (lane & 15) >> 2, pp = lane & 3;
    const int tri = (8 * hi + qq) * GP + (16 * g16 + 4 * pp) * 2;
    const int trv = (4 * hi + qq) * GP + (16 * g16 + 4 * pp) * 2;
#pragma unroll
    for (int dir = 0; dir < 2; ++dir) {
        GlaCum C; gla_cum(P, row0, hh, dir, a_up, a_bias, lane, C);
#pragma unroll
        for (int tt = 0; tt < 2; ++tt) {
            float cum[16];
#pragma unroll
            for (int r = 0; r < 16; ++r) cum[r] = C.cum[tt][r];
#pragma unroll
            for (int g = 0; g < 4; ++g) {
                float xq[4], xk[4];
#pragma unroll
                for (int e = 0; e < 4; ++e) { const size_t ro = (size_t)(row0 + 32 * tt + 8 * g + 4 * hi + e) * PP + hh * 32 + kk;
                    xq[e] = bf1(P[ro + C_GQ]) * 0.17677669529663687f * fexp(cum[4 * g + e]); xk[e] = bf1(P[ro + C_GK]) * fexp(-cum[4 * g + e]); }
                v2u wq, wk; wq.x = pk2(xq[0], xq[1]); wq.y = pk2(xq[2], xq[3]); wk.x = pk2(xk[0], xk[1]); wk.y = pk2(xk[2], xk[3]);
                const int off = kk * GP + (32 * tt + 8 * g + 4 * hi) * 2;
                *(LAS v2u*)(wl + G_A + off) = wq; *(LAS v2u*)(wl + G_B + off) = wk;
                if (g & 1) asm volatile("" ::: "memory");
            }
        }
        const float* sp = UST + ((size_t)((b * 4 + hh) * 2 + dir) * 36 + nc) * 2048;
        bf16x8 sf[2][2];
#pragma unroll
        for (int vb = 0; vb < 2; ++vb)
#pragma unroll
            for (int s = 0; s < 2; ++s) { const float* p = sp + (size_t)(32 * vb + kk) * 32 + 16 * s + 8 * hi; const f32x4 a = *(const f32x4*)p, c = *(const f32x4*)(p + 4);
                sf[vb][s] = pack8(a.x, a.y, a.z, a.w, c.x, c.y, c.z, c.w); }
#pragma unroll
        for (int it = 0; it < 2; ++it) {
            bf16x8 qf[2];
#pragma unroll
            for (int s = 0; s < 2; ++s) { LAS const unsigned char* p = wl + G_A + tri + 16 * s * GP + 64 * it; qf[s] = cat4(tr_read(p), tr_read(p + 4 * GP)); }
#pragma unroll
            for (int vb = 0; vb < 2; ++vb)
#pragma unroll
                for (int s = 0; s < 2; ++s) o[vb][it] = MFMA32(sf[vb][s], qf[s], o[vb][it]);
#pragma unroll
            for (int jt = 0; jt < 2; ++jt) {
                if (dir == 0 ? (jt > it) : (jt < it)) continue;
                f32x16 sc;
#pragma unroll
                for (int i = 0; i < 16; ++i) sc[i] = 0.f;
#pragma unroll
                for (int s = 0; s < 2; ++s) { LAS const unsigned char* p = wl + G_B + tri + 16 * s * GP + 64 * jt; const bf16x8 kf = cat4(tr_read(p), tr_read(p + 4 * GP)); sc = MFMA32(kf, qf[s], sc); }
                if (jt == it) {
#pragma unroll
                    for (int i = 0; i < 16; ++i) { const int j = crow(i, hi); const bool ok = dir == 0 ? (j <= kk) : (j >= kk); sc[i] = ok ? sc[i] : 0.f; }
                }
#pragma unroll
                for (int s2 = 0; s2 < 2; ++s2) {
                    const bf16x8 pf = pack8(sc[8 * s2 + 0], sc[8 * s2 + 1], sc[8 * s2 + 2], sc[8 * s2 + 3], sc[8 * s2 + 4], sc[8 * s2 + 5], sc[8 * s2 + 6], sc[8 * s2 + 7]);
                    LAS const unsigned char* vp = wl + G_V + trv + (32 * jt + 16 * s2) * GP;
                    const bf16x8 v0 = cat4(tr_read(vp), tr_read(vp + 8 * GP));
                    const bf16x8 v1 = cat4(tr_read(vp + 64), tr_read(vp + 8 * GP + 64));
                    o[0][it] = MFMA32(v0, pf, o[0][it]); o[1][it] = MFMA32(v1, pf, o[1][it]);
                }
                __builtin_amdgcn_sched_barrier(0);
            }
            __builtin_amdgcn_sched_barrier(0);
        }
    }
#pragma unroll
    for (int it = 0; it < 2; ++it) {
        float ss = 0.f;
#pragma unroll
        for (int vb = 0; vb < 2; ++vb)
#pragma unroll
            for (int i = 0; i < 16; ++i) ss += o[vb][it][i] * o[vb][it][i];
        ss += __shfl_xor(ss, 32);
        const float rstd = __builtin_amdgcn_rsqf(ss * (1.f / 64.f) + NEPS);
        const size_t row = (size_t)(row0 + 32 * it + kk);
#pragma unroll
        for (int vb = 0; vb < 2; ++vb)
#pragma unroll
            for (int g = 0; g < 4; ++g) { const int v = 32 * vb + 8 * g + 4 * hi;
                const f32x4 gn = *(const f32x4*)(gnorm + v); const v2u gw = *(const v2u*)(P + row * PP + C_GG + hh * 64 + v);
                const float g0 = bflo(gw.x), g1 = bfhi(gw.x), g2 = bflo(gw.y), g3 = bfhi(gw.y);
                v2u w; w.x = pk2(o[vb][it][4 * g] * rstd * gn.x * silu_f(g0), o[vb][it][4 * g + 1] * rstd * gn.y * silu_f(g1));
                w.y = pk2(o[vb][it][4 * g + 2] * rstd * gn.z * silu_f(g2), o[vb][it][4 * g + 3] * rstd * gn.w * silu_f(g3));
                *(v2u*)(MIX + row * 1024 + hh * 64 + v) = w; }
    }
}
__device__ __forceinline__ void phase_r1(const float* const* in, float* xout, unsigned char* ws, LAS unsigned char* lds, int l, bool upd, int G, int tid, int wave, int lane, bool dry) {
    const float* x0 = in[0]; const float* ctx0 = in[2]; const float* gains = in[6] + (size_t)l * 4096; const float* wr = in[14] + (size_t)l * 1024 * 16;
    const float* mod = (const float*)(ws + WS_MOD) + (size_t)l * 9 * 6144;
    const bf16_t* Y = (const bf16_t*)(ws + WS_R2 + (size_t)MT * 2048); bf16_t* H = (bf16_t*)(ws + WS_H); bf16_t* XB = (bf16_t*)(ws + WS_XB);
    float* AFF = (float*)(ws + WS_AFF); float* AFFC = (float*)(ws + WS_AFFC);
    LAS float* V = (LAS float*)lds;
    LAS float* RT = V + 6144;
    __syncthreads();
    for (int i = tid; i < 16384; i += 512) { const int d = i >> 4, e = i & 15; RT[e * 1024 + d] = wr[i]; }
    for (int t = blockIdx.x; t < 256; t += G) {
        const int b = t >> 5;
        __syncthreads();
        for (int n = tid; n < 1024; n += 512) { const float gpa = gains[1024 + n], gpf = gains[2048 + n];
            V[n] = gpa * mod[b * 6144 + 2048 + n]; V[1024 + n] = gpf * (1.f + mod[b * 6144 + 4096 + n]); V[2048 + n] = mod[b * 6144 + 3072 + n];
            V[3072 + n] = gpa * mod[8 * 6144 + 2048 + n]; V[4096 + n] = gpf * (1.f + mod[8 * 6144 + 4096 + n]); V[5120 + n] = mod[8 * 6144 + 3072 + n]; }
        __syncthreads();
        const int nrows = upd ? 9 : 8;
#pragma unroll 1
        for (int i0 = 0; i0 < 9; i0 += 3) {
            f32x4 yv[3][4], xq[3][4];
#pragma unroll
            for (int k = 0; k < 3; ++k) { const int i = i0 + k; if (i < nrows) {
                const bool isc = (i == 8); const int row = isc ? (ML + 8 * t + wave) : (64 * t + 8 * wave + i);
                ld_row_bf16(Y + (size_t)row * 1024, lane, yv[k]);
                if (l == 0) ld_row_f32(isc ? (ctx0 + (size_t)(8 * t + wave) * 1024) : (x0 + (size_t)row * 1024), lane, xq[k]); else ld_row_bf16(XB + (size_t)row * 1024, lane, xq[k]); } }
#pragma unroll
            for (int k = 0; k < 3; ++k) { const int i = i0 + k; if (i < nrows) {
            const bool isc = (i == 8);
            const int row = isc ? (ML + 8 * t + wave) : (64 * t + 8 * wave + i);
            bf16_t* xd = (dry ? (bf16_t*)(ws + WS_R1) : XB) + (size_t)row * 1024;
            LAS const float* vv = V + (isc ? 3072 : 0);
            f32x4 (&y)[4] = yv[k]; f32x4 (&xv)[4] = xq[k]; f32x4 a[4];
            const float rsy = __builtin_amdgcn_rsqf(wave_sum(sumsq16(y)) * (1.f / 1024.f) + NEPS);
            ld_vec_lds(vv, lane, a);
#pragma unroll
            for (int j = 0; j < 4; ++j) xv[j] = xv[j] + a[j] * (y[j] * rsy);
            st_row_bf16(xd, lane, xv);
            const float rs1 = __builtin_amdgcn_rsqf(wave_sum(sumsq16(xv)) * (1.f / 1024.f) + NEPS);
            f32x4 s[4]; ld_vec_lds(vv + 1024, lane, a); ld_vec_lds(vv + 2048, lane, s);
#pragma unroll
            for (int j = 0; j < 4; ++j) xv[j] = xv[j] * rs1 * a[j] + s[j];
            st_row_bf16((dry ? (bf16_t*)(ws + WS_R2) : H) + (size_t)row * 1024, lane, xv);
            float lg[16];
#pragma unroll
            for (int e = 0; e < 16; ++e) { float p = 0.f;
#pragma unroll
                for (int j = 0; j < 4; ++j) { const f32x4 w = *(LAS const f32x4*)(RT + e * 1024 + 256 * j + 4 * lane); p += (xv[j].x * w.x + xv[j].y * w.y) + (xv[j].z * w.z + xv[j].w * w.w); }
                lg[e] = p;
                if ((e & 3) == 3) asm volatile("" ::: "memory"); }
#pragma unroll
            for (int i2 = 0; i2 < 8; ++i2) { const bool up = (lane & 32) != 0; const float keep = up ? lg[i2 + 8] : lg[i2], send = up ? lg[i2] : lg[i2 + 8]; lg[i2] = keep + __shfl_xor(send, 32); }
#pragma unroll
            for (int i2 = 0; i2 < 4; ++i2) { const bool up = (lane & 16) != 0; const float keep = up ? lg[i2 + 4] : lg[i2], send = up ? lg[i2] : lg[i2 + 4]; lg[i2] = keep + __shfl_xor(send, 16); }
#pragma unroll
            for (int i2 = 0; i2 < 2; ++i2) { const bool up = (lane & 8) != 0; const float keep = up ? lg[i2 + 2] : lg[i2], send = up ? lg[i2] : lg[i2 + 2]; lg[i2] = keep + __shfl_xor(send, 8); }
            { const bool up = (lane & 4) != 0; const float keep = up ? lg[1] : lg[0], send = up ? lg[0] : lg[1]; lg[0] = keep + __shfl_xor(send, 4); }
            float lgt = lg[0]; lgt += __shfl_xor(lgt, 1); lgt += __shfl_xor(lgt, 2);
            const int ex = ((lane >> 5) & 1) * 8 + ((lane >> 4) & 1) * 4 + ((lane >> 3) & 1) * 2 + ((lane >> 2) & 1);
            float mx = lgt;
            mx = fmaxf(mx, __shfl_xor(mx, 4)); mx = fmaxf(mx, __shfl_xor(mx, 8)); mx = fmaxf(mx, __shfl_xor(mx, 16)); mx = fmaxf(mx, __shfl_xor(mx, 32));
            const float pe = fexp(lgt - mx);
            float den = pe; den += __shfl_xor(den, 4); den += __shfl_xor(den, 8); den += __shfl_xor(den, 16); den += __shfl_xor(den, 32);
            const float mine = pe / den;
            if ((lane & 3) == 0) {
                if (isc) { const int cr = 8 * t + wave; AFFC[((size_t)(cr >> 8) * 16 + ex) * 256 + (cr & 255)] = mine; }
                else AFF[((size_t)(row >> 11) * 16 + ex) * 2048 + (row & 2047)] = mine;
            }
            } }
        }
    }
}

template <bool CTX>
__device__ __forceinline__ void topk_wave(unsigned char* ws, int item, int lane) {
    constexpr int NT = CTX ? 256 : 2048, CAP = CTX ? 32 : 256, PER = NT / 64;
    const int e = item & 15, b = item >> 4;
    const float* arow = (const float*)(ws + (CTX ? WS_AFFC : WS_AFF)) + (size_t)(b * 16 + e) * NT;
    float* gate = (float*)(ws + (CTX ? WS_GATEC : WS_GATE)) + (size_t)(b * 16 + e) * CAP;
    short* INV = (short*)(ws + WS_INV);
    int* rowidx = (int*)(ws + WS_ROWIDX) + (CTX ? ((128 + e) * 256 + b * 32) : ((b * 16 + e) * 256));
    unsigned v[PER];
#pragma unroll
    for (int i = 0; i < PER / 4; ++i) { const v4u q = *(const v4u*)(arow + lane * PER + 4 * i); v[4 * i] = q.x; v[4 * i + 1] = q.y; v[4 * i + 2] = q.z; v[4 * i + 3] = q.w; }
    unsigned T = 0;
    for (int bit = 29; bit >= 0; --bit) {
        const unsigned cand = T | (1u << bit); int c = 0;
#pragma unroll
        for (int i = 0; i < PER; ++i) c += __popcll(__ballot(v[i] >= cand));
        if (c >= CAP) T = cand;
    }
    int ngt = 0, cg = 0, ce = 0;
#pragma unroll
    for (int i = 0; i < PER; ++i) { ngt += __popcll(__ballot(v[i] > T)); cg += (v[i] > T) ? 1 : 0; ce += (v[i] == T) ? 1 : 0; }
    const int need = CAP - ngt;
    int pg = cg, pe = ce;
#pragma unroll
    for (int d = 1; d < 64; d <<= 1) { const int tg = __shfl_up(pg, d), te = __shfl_up(pe, d); if (lane >= d) { pg += tg; pe += te; } }
    pg -= cg; pe -= ce;
#pragma unroll
    for (int i = 0; i < PER; ++i) {
        const bool gt = v[i] > T, eq = v[i] == T;
        const bool sel = gt || (eq && pe < need);
        const int slot = pg + (pe < need ? pe : need);
        const int tok = lane * PER + i, grow = CTX ? (ML + b * CTXL + tok) : (b * SEQ + tok);
        if (sel) { rowidx[slot] = grow; gate[slot] = __uint_as_float(v[i]); }
        INV[(size_t)grow * 16 + e] = sel ? (short)slot : (short)-1;
        pg += gt ? 1 : 0; pe += eq ? 1 : 0;
    }
}

__device__ __forceinline__ void phase_r5(const float* const* in, float* xout, unsigned char* ws, LAS unsigned char* lds, int l, bool upd, int G, int tid, int wave, int lane, bool dry) {
    const float* gains = in[6];
    const float* mod = (const float*)(ws + WS_MOD);
    const bf16_t* YE = (const bf16_t*)(ws + WS_R1); bf16_t* H = (bf16_t*)(ws + WS_H); bf16_t* XB = (bf16_t*)(ws + WS_XB);
    const float* GATE = (const float*)(ws + WS_GATE); const float* GATEC = (const float*)(ws + WS_GATEC); const short* INV = (const short*)(ws + WS_INV);
    LAS float* V = (LAS float*)lds;
    LAS int* CL = (LAS int*)(lds + 24576);
    for (int t = blockIdx.x; t < 256; t += G) {
        const int b = t >> 5;
        __syncthreads();
        for (int n = tid; n < 1024; n += 512) { const float gpf = gains[(size_t)l * 4096 + 3072 + n];
            V[n] = gpf * mod[((size_t)l * 9 + b) * 6144 + 5120 + n]; V[3072 + n] = gpf * mod[((size_t)l * 9 + 8) * 6144 + 5120 + n];
            if (l == 0) { const float gna = gains[4096 + n];
                V[1024 + n] = gna * (1.f + mod[((size_t)9 + b) * 6144 + 1024 + n]); V[2048 + n] = mod[((size_t)9 + b) * 6144 + n];
                V[4096 + n] = gna * (1.f + mod[((size_t)9 + 8) * 6144 + 1024 + n]); V[5120 + n] = mod[((size_t)9 + 8) * 6144 + n]; } }
        if (tid < (upd ? 72 : 64)) {
            const bool isc = tid >= 64; const int cr = 8 * t + (tid - 64);
            const int row = isc ? (ML + cr) : (64 * t + tid); const int bb = isc ? (cr >> 8) : b;
            const v4u i0 = *(const v4u*)(INV + (size_t)row * 16), i1 = *(const v4u*)(INV + (size_t)row * 16 + 8);
            const unsigned iw[8] = {i0.x, i0.y, i0.z, i0.w, i1.x, i1.y, i1.z, i1.w};
            float gv[16]; int sl[16];
#pragma unroll
            for (int e = 0; e < 16; ++e) { sl[e] = (int)(short)((iw[e >> 1] >> (16 * (e & 1))) & 0xffffu); const int s0 = sl[e] < 0 ? 0 : sl[e];
                gv[e] = isc ? GATEC[(size_t)(bb * 16 + e) * 32 + s0] : GATE[(size_t)(bb * 16 + e) * 256 + s0]; }
            int cnt = 0; LAS int* cl = CL + tid * 33;
#pragma unroll
            for (int e = 0; e < 16; ++e) if (sl[e] >= 0) { cl[1 + 2 * cnt] = isc ? ((128 + e) * 256 + bb * 32 + sl[e]) : ((bb * 16 + e) * 256 + sl[e]); cl[2 + 2 * cnt] = (int)__float_as_uint(gv[e]); ++cnt; }
            cl[0] = cnt;
        }
        __syncthreads();
        const int nrows = upd ? 9 : 8;
#pragma unroll 1
        for (int i0 = 0; i0 < 9; i0 += 3) {
            f32x4 xq[3][4];
#pragma unroll
            for (int k = 0; k < 3; ++k) { const int i = i0 + k; if (i < nrows) { const bool isc = (i == 8);
                ld_row_bf16(XB + (size_t)(isc ? (ML + 8 * t + wave) : (64 * t + 8 * wave + i)) * 1024, lane, xq[k]); } }
#pragma unroll
            for (int k = 0; k < 3; ++k) { const int i = i0 + k; if (i < nrows) {
            const bool isc = (i == 8);
            const int row = isc ? (ML + 8 * t + wave) : (64 * t + 8 * wave + i);
            LAS const float* vv = V + (isc ? 3072 : 0);
            LAS const int* cl = CL + (isc ? (64 + wave) : (8 * wave + i)) * 33;
            const int n = __builtin_amdgcn_readfirstlane(cl[0]);
            f32x4 acc[4];
#pragma unroll
            for (int j = 0; j < 4; ++j) acc[j] = (f32x4){0.f, 0.f, 0.f, 0.f};
            for (int j0 = 0; j0 < n; j0 += 4) {
                v2u raw[4][4]; float g[4];
#pragma unroll
                for (int q = 0; q < 4; ++q) {
                    if (j0 + q < n) { const int yr = __builtin_amdgcn_readfirstlane(cl[1 + 2 * (j0 + q)]); g[q] = __uint_as_float((unsigned)__builtin_amdgcn_readfirstlane(cl[2 + 2 * (j0 + q)]));
                        const bf16_t* yp = YE + (size_t)yr * 1024;
#pragma unroll
                        for (int j = 0; j < 4; ++j) raw[q][j] = *(const v2u*)(yp + 256 * j + 4 * lane); }
                    else { g[q] = 0.f;
#pragma unroll
                        for (int j = 0; j < 4; ++j) raw[q][j] = (v2u){0u, 0u}; }
                }
#pragma unroll
                for (int q = 0; q < 4; ++q)
#pragma unroll
                    for (int j = 0; j < 4; ++j) acc[j] += (f32x4){bflo(raw[q][j].x), bfhi(raw[q][j].x), bflo(raw[q][j].y), bfhi(raw[q][j].y)} * g[q];
            }
            const float rsm = __builtin_amdgcn_rsqf(wave_sum(sumsq16(acc)) * (1.f / 1024.f) + NEPS);
            f32x4 (&xv)[4] = xq[k]; f32x4 a[4]; ld_vec_lds(vv, lane, a);
#pragma unroll
            for (int j = 0; j < 4; ++j) xv[j] = xv[j] + a[j] * (acc[j] * rsm);
            if (l == 0) st_row_bf16((dry ? (bf16_t*)(ws + WS_R2) : XB) + (size_t)row * 1024, lane, xv);
            else st_row_f32((dry ? (float*)(ws + WS_R2) : xout) + (size_t)row * 1024, lane, xv);
            if (l == 0 && !dry) {
                const float rs2 = __builtin_amdgcn_rsqf(wave_sum(sumsq16(xv)) * (1.f / 1024.f) + NEPS);
                f32x4 s[4]; ld_vec_lds(vv + 1024, lane, a); ld_vec_lds(vv + 2048, lane, s);
#pragma unroll
                for (int j = 0; j < 4; ++j) xv[j] = xv[j] * rs2 * a[j] + s[j];
                st_row_bf16(H + (size_t)row * 1024, lane, xv);
            }
            } }
        }
    }
}
#ifndef MK_PER_PHASE
#define MK_PER_PHASE 0
#endif
constexpr int N_PHASES = 22;
struct Args { const float* in[18]; float* out; unsigned char* ws; int ph_lo, ph_hi; };
__device__ __forceinline__ const Args* kargs_opaque() {
    auto p = __builtin_amdgcn_kernarg_segment_ptr(); asm volatile("" : "+s"(p)); return (const Args*)p; }
#define PHASE_REGS() int tid = threadIdx.x; asm volatile("" : "+v"(tid)); const int lane = tid & 63, wave = __builtin_amdgcn_readfirstlane(tid >> 6); \
    const Args* A = kargs_opaque(); unsigned char* ws = A->ws; const int G = gridDim.x, bx = blockIdx.x; \
    const int vcu = (G % 8 == 0) ? (bx % 8) * (G / 8) + bx / 8 : bx; const int gw = vcu * NWAVES + wave, NGW = G * NWAVES; \
    LAS unsigned char* wl = lds + wave * WAVE_LDS; (void)gw; (void)NGW; (void)wl; (void)lane; (void)ws
#ifndef CONV_BUDGET
#define CONV_BUDGET 1
#endif
#ifndef PH_MASK
#define PH_MASK 0xFFFFFFFFu
#endif
#define EN(j) (((PH_MASK) >> (j)) & 1u)
#ifndef REP_MASK
#define REP_MASK 0u
#endif
#define REPS(j) ((((REP_MASK) >> (j)) & 1u) ? 2 : 1)
__global__ void __launch_bounds__(NWAVES * 64, 2) fwd_kernel(Args args) {
    extern __shared__ __attribute__((aligned(16))) unsigned char lds_raw[];
    LAS unsigned char* lds = (LAS unsigned char*)lds_raw;
    volatile LAS unsigned* MISC = (volatile LAS unsigned*)(lds + MISC_OFF);
    for (int u = threadIdx.x; u < (LDS_BYTES - LDSCTL_OFF) / 4; u += NWAVES * 64) ((LAS unsigned*)(lds + LDSCTL_OFF))[u] = 0u;
    __syncthreads();
    const int lo = args.ph_lo, hi = args.ph_hi;
    XcdBarrier bar; bar.bar = (unsigned*)(args.ws + WS_CTL) + CW_BAR; bar.x = 0; bar.st = nullptr;
    if (hi - lo > 1) bar = xcd_barrier_post((unsigned*)(args.ws + WS_CTL) + CW_BAR, MISC + 8);
#define IN(k) (lo <= (k) && (k) < hi)
#define SEAM(k) do { if (IN((k) + 1)) { xcd_barrier(bar); if (REPS(12) == 2) xcd_barrier(bar); } } while (0)
    if (EN(0) && IN(0)) { for (int rep = 0; rep < REPS(0); ++rep) { PHASE_REGS(); phase_p0(A->in, ws, wl, gw, NGW, lane); } SEAM(0); }
    if (EN(1) && IN(1)) { for (int rep = 0; rep < REPS(1); ++rep) { PHASE_REGS(); phase_a0(A->in, ws, lds, G, tid, wave, lane); } SEAM(1); }
    for (int l = 0; l < 2; ++l) {
        const int base = 2 + 10 * l; const bool upd = (l == 0);
        if (EN(2) && IN(base + 0)) { for (int rep = 0; rep < REPS(2); ++rep) {
            PHASE_REGS();
            pg8::Gemm g{(const bf16_t*)(ws + WS_H), (const bf16_t*)(ws + WS_WIN) + (size_t)l * PP * 1024, MT, PP, 1024}; pg8::StaticOrder S; S.init(MT, PP, G, bx);
            pg8::EpiProj E{(bf16_t*)(ws + WS_R1), PP, (const pg8::f32x2*)(ws + WS_TAB), ML};
            pg8::gemm_phase<pg8::EpiProj, pg8::StaticOrder, true, true>(lds, g, S, E);
            if (!CONV_IN_P0) { const int nwg_ = (MT / 256) * (PP / 256); if ((nwg_ - bx + G - 1) / G < (nwg_ + G - 1) / G) conv_pull(A->in, ws, l, 1, 12 * CONV_BUDGET, (LAS float*)wl, lane); }
            }
            SEAM(base + 0);
        }
        if (EN(3) && IN(base + 1)) { for (int rep = 0; rep < REPS(3); ++rep) {
            PHASE_REGS();
            const bf16_t* PROJ = (const bf16_t*)(ws + WS_R1); bf16_t* MIX = (bf16_t*)(ws + WS_R2);
            const float* a_up = A->in[9] + (size_t)l * 2 * 16 * 128; const float* a_bias = A->in[10] + (size_t)l * 2 * 128;
            const float* rpb = A->in[12] + (size_t)l * 4 * 465; const float* sink = A->in[13] + (size_t)l * 8;
            const int n_cn = upd ? 128 : 0, n_cs = upd ? 256 : 0;
            const bool xmap = (G == 256);
            const int xcd = bx & 7, cu = bx >> 3;
            const int n_att = xmap ? 12 : 0;
            const int tail_total = (xmap ? 0 : 1024 + 2048) + 1152 + n_cn + n_cs;
            volatile LAS unsigned* qctr = (volatile LAS unsigned*)(lds + MISC_OFF) + 16 + l * 2 + rep;
            const int n_conv = 0, n_mix = (n_conv + 2) / 3 * 4;
            for (;;) {
                int j = 0; if (lane == 0) j = (int)__hip_atomic_fetch_add((LAS unsigned*)qctr, 1u, __ATOMIC_RELAXED, __HIP_MEMORY_SCOPE_WORKGROUP);
                j = __builtin_amdgcn_readfirstlane(j);
                if (j < n_mix) {
                    if ((j & 3) != 3) { const int ci = (j >> 2) * 3 + (j & 3), r = ci * G + bx; if (ci < n_conv && r < 12288 && !(rep + 1 < REPS(3))) expert_conv_item(A->in, ws, l, r, (LAS float*)wl, lane); continue; }
                    j = j >> 2;
                } else j = j - n_mix + n_mix / 4;
                int mode, item;
                if (j < n_att) {
                    if (j < 4) { mode = 0; item = (xcd * 4 + j) * 32 + cu; }
                    else { const int jj = j - 4, group = xcd * 2 + (jj >> 2), i = cu * 4 + (jj & 3); const int bb = group >> 1, hq = (group & 1) * 4 + (i >> 5); mode = 1; item = (i & 31) + 32 * hq + 256 * bb; }
                } else {
                    int r = (j - n_att) * G + bx;
                    if (r >= tail_total) break;
                    mode = -1; item = 0;
                    if (!xmap) { if (r < 1024) { mode = 0; item = r; } else if (r < 3072) { mode = 1; item = r - 1024; } r -= 3072; }
                    if (mode < 0) {
                        if (r < 1152) { if (rep + 1 < REPS(3)) continue; gla_local_item(PROJ, (float*)(ws + WS_UST), (float*)(ws + WS_DEC), r, wl, lane, a_up, a_bias); continue; } r -= 1152;
                        if (r < n_cs) { mode = 3; item = r; } else { mode = 2; item = r - n_cs; }
                    }
                }
                attn_item(mode, PROJ, MIX, item, wl, lane, rpb, sink, rep + 1 < REPS(3));
            }
            }
            SEAM(base + 1);
        }
        if (EN(4) && IN(base + 2)) { for (int rep = 0; rep < REPS(4); ++rep) {
            PHASE_REGS();
            for (int gid = bx * (NWAVES * 64) + tid; gid < 64 * 2048; gid += G * NWAVES * 64) gla_prefix((float*)(ws + WS_UST), (const float*)(ws + WS_DEC), gid, rep + 1 < REPS(4));
            }
            SEAM(base + 2);
        }
        if (EN(5) && IN(base + 3)) { for (int rep = 0; rep < REPS(5); ++rep) {
            PHASE_REGS();
            const float* a_up = A->in[9] + (size_t)l * 2 * 16 * 128; const float* a_bias = A->in[10] + (size_t)l * 2 * 128; const float* gnorm = A->in[11] + (size_t)l * 64;
            for (int it = gw; it < 1152; it += NGW) { if (!upd && (it % 36) < 4) continue;
                gla_out_item((const bf16_t*)(ws + WS_R1), (const float*)(ws + WS_UST), (bf16_t*)(ws + WS_R2), it, wl, lane, a_up, a_bias, gnorm); }
            }
            SEAM(base + 3);
        }
        if (EN(6) && IN(base + 4)) { for (int rep = 0; rep < REPS(6); ++rep) {
            PHASE_REGS();
            const int M2 = upd ? MT : ML;
            pg8::Gemm g{(const bf16_t*)(ws + WS_R2), (const bf16_t*)(ws + WS_WOUT) + (size_t)l * 1024 * 1024, M2, 1024, 1024}; pg8::StaticOrder S; S.init(M2, 1024, G, bx);
            pg8::EpiStore E{(bf16_t*)(ws + WS_R2 + (size_t)MT * 2048), 1024};
            pg8::gemm_phase<pg8::EpiStore, pg8::StaticOrder, true, true>(lds, g, S, E);
            if (!CONV_IN_P0) { const int nwg_ = (M2 / 256) * 4; if ((nwg_ - bx + G - 1) / G < (nwg_ + G - 1) / G) conv_pull(A->in, ws, l, 1, 3 * CONV_BUDGET, (LAS float*)wl, lane); }
            }
            SEAM(base + 4);
        }
        if (EN(7) && IN(base + 5)) { for (int rep = 0; rep < REPS(7); ++rep) { PHASE_REGS(); phase_r1(A->in, A->out, ws, lds, l, upd, G, tid, wave, lane, rep + 1 < REPS(7)); } SEAM(base + 5); }
        if (EN(8) && IN(base + 6)) { for (int rep = 0; rep < REPS(8); ++rep) {
            PHASE_REGS();
            if (!CONV_IN_P0) conv_pull(A->in, ws, l, l, 1 << 30, (LAS float*)wl, lane);
            for (int it = gw; it < (upd ? 256 : 128); it += NGW) { if (it < 128) topk_wave<false>(ws, it, lane); else topk_wave<true>(ws, it - 128, lane); }
            }
            SEAM(base + 6);
        }
        if (EN(9) && IN(base + 7)) { for (int rep = 0; rep < REPS(9); ++rep) {
            PHASE_REGS();
            pg8::Gemm g{(const bf16_t*)(ws + WS_H), (const bf16_t*)(ws + WS_WGU) + (size_t)l * 16 * 2048 * 1024, 0, 0, 1024, (const int*)(ws + WS_ROWIDX)}; pg8::MoeOrder S; S.init(upd ? 9 : 8, 8, G, bx);
            pg8::EpiSwiGLU E{(bf16_t*)(ws + WS_R2), 1024};
            pg8::gemm_phase<pg8::EpiSwiGLU, pg8::MoeOrder, true, true, true>(lds, g, S, E);
            if (!CONV_IN_P0) { const int nwg_ = 16 * (upd ? 9 : 8) * 8; if ((nwg_ - bx + G - 1) / G < (nwg_ + G - 1) / G) conv_pull(A->in, ws, l + 1, 1, 4 * CONV_BUDGET, (LAS float*)wl, lane); }
            }
            SEAM(base + 7);
        }
        if (EN(10) && IN(base + 8)) { for (int rep = 0; rep < REPS(10); ++rep) {
            PHASE_REGS();
            pg8::Gemm g{(const bf16_t*)(ws + WS_R2), (const bf16_t*)(ws + WS_WD) + (size_t)l * 16 * 1024 * 1024, 0, 0, 1024}; pg8::MoeOrder S; S.init(upd ? 9 : 8, 4, G, bx);
            pg8::EpiStore E{(bf16_t*)(ws + WS_R1), 1024};
            pg8::gemm_phase<pg8::EpiStore, pg8::MoeOrder, true, true>(lds, g, S, E);
            if (!CONV_IN_P0) { const int nwg_ = 16 * (upd ? 9 : 8) * 4; if ((nwg_ - bx + G - 1) / G < (nwg_ + G - 1) / G) conv_pull(A->in, ws, l + 1, 1, 3 * CONV_BUDGET, (LAS float*)wl, lane); }
            }
            SEAM(base + 8);
        }
        if (EN(11) && IN(base + 9)) { for (int rep = 0; rep < REPS(11); ++rep) { PHASE_REGS(); phase_r5(A->in, A->out, ws, lds, l, upd, G, tid, wave, lane, rep + 1 < REPS(11)); } SEAM(base + 9); }
    }
#undef IN
#undef SEAM
}

extern "C" void kernel_launch(void* const* d_in, const int* in_sizes, int n_in, void* d_out, int out_size, void* d_ws, size_t ws_size, hipStream_t stream) {
    static int grid = 0;
    if (grid == 0) {
        if (n_in != 18 || out_size != ML * DM || ws_size < WS_END) { fprintf(stderr, "kernel_launch: unexpected sizes: n_in %d out %d ws %zu (need %zu)\n", n_in, out_size, ws_size, (size_t)WS_END); grid = -1; return; }
        int dev = 0, cus = 0, per_cu = 0;
        if (hipGetDevice(&dev) != hipSuccess || hipDeviceGetAttribute(&cus, hipDeviceAttributeMultiprocessorCount, dev) != hipSuccess) { grid = -1; return; }
        if (hipFuncSetAttribute((const void*)fwd_kernel, hipFuncAttributeMaxDynamicSharedMemorySize, LDS_BYTES) != hipSuccess) { fprintf(stderr, "kernel_launch: hipFuncSetAttribute failed\n"); grid = -1; return; }
        if (hipOccupancyMaxActiveBlocksPerMultiprocessor(&per_cu, (const void*)fwd_kernel, NWAVES * 64, LDS_BYTES) != hipSuccess || per_cu < 1) { fprintf(stderr, "kernel_launch: occupancy query says %d blocks per CU\n", per_cu); (void)hipGetLastError(); grid = -1; return; }
        grid = cus;
    }
    if (grid < 0) return;
    (void)hipMemsetAsync((char*)d_ws + WS_CTL, 0, CTL_ZERO_BYTES, stream);
    Args a{};
    for (int i = 0; i < 18; ++i) a.in[i] = (const float*)d_in[i];
    a.out = (float*)d_out; a.ws = (unsigned char*)d_ws;
#if MK_PER_PHASE
    for (int p = 0; p < N_PHASES; ++p) { a.ph_lo = p; a.ph_hi = p + 1; hipLaunchKernelGGL(fwd_kernel, dim3(grid), dim3(NWAVES * 64), LDS_BYTES, stream, a); }
#else
    a.ph_lo = 0; a.ph_hi = N_PHASES;
    void* kargs[] = {&a};
    hipError_t e = hipLaunchCooperativeKernel((const void*)fwd_kernel, dim3(grid), dim3(NWAVES * 64), kargs, LDS_BYTES, stream);
    if (e != hipSuccess) fprintf(stderr, "kernel_launch: cooperative launch failed: %s (grid %d)\n", hipGetErrorString(e), grid);
#endif
}
```

```cpp
#include <hip/hip_runtime.h>
#include <cstdio>
#include <cstdint>
#include <cmath>

namespace pg8 {
#define PG8_LAS __attribute__((address_space(3)))
typedef unsigned short bf16_t;
typedef short bf16x8 __attribute__((ext_vector_type(8)));
typedef float f32x4 __attribute__((ext_vector_type(4)));
typedef unsigned u32x4 __attribute__((ext_vector_type(4)));
constexpr int BM = 256, BK = 64, HALF = 128, HTB = HALF * BK * 2  , STAGE_BYTES = 8 * HTB, NXCD = 8, WGM = 8;

__host__ __device__ __forceinline__ int lds_byte(int r, int c) { const int st = (r >> 4) * 2 + (c >> 5), rr = r & 15, cc = c & 31, ob = rr * 64 + cc * 2; return st * 1024 + (ob ^ (((ob >> 9) & 1) << 5)); }
__host__ __device__ __forceinline__ void stage_rc(int b, int& R, int& C) { const int st = b / 1024, sb = b % 1024, swz = sb ^ (((sb >> 9) & 1) << 5); R = (st >> 1) * 16 + swz / 64; C = (st & 1) * 32 + (swz % 64) / 2; }
__host__ __device__ __forceinline__ int perm32(int rho) { const int n = rho >> 4, i = rho & 15; return 8 * (i >> 2) + 4 * n + (i & 3); }

struct Unit { int pm, pn, pb; };
struct Gemm { const bf16_t* A; const bf16_t* Bt; int M, N, K; const int* rowidx; };

struct StaticOrder {
    int nM, nN, nwg, G, c;
    __host__ __device__ void init(int M, int N, int G_, int c_) { nM = M / BM; nN = N / BM; nwg = nM * nN; G = G_; c = c_; }
    __host__ __device__ bool next(int i, Unit& u) const {
        const long L = (long)i * G + c; if (L >= nwg) return false;
        int wgid = (int)L; { const int q = nwg / NXCD, r = nwg % NXCD, xcd = wgid % NXCD, off = wgid / NXCD; wgid = (xcd < r ? xcd * (q + 1) : r * (q + 1) + (xcd - r) * q) + off; }
        const int nig = WGM * nN, gid = wgid / nig, fm = gid * WGM, gsz = (nM - fm) < WGM ? (nM - fm) : WGM;
        u.pm = fm + ((wgid % nig) % gsz); u.pn = (wgid % nig) / gsz; u.pb = u.pn; return true;
    }
    __device__ __forceinline__ void a_ready(const Unit&) const {}
    __device__ __forceinline__ void done(const Unit&) const {}
};

__device__ __forceinline__ unsigned cvt_pk_bf16(float lo, float hi) { unsigned r; asm volatile("v_cvt_pk_bf16_f32 %0, %1, %2" : "=v"(r) : "v"(lo), "v"(hi)); return r; }
typedef float f32x2 __attribute__((ext_vector_type(2)));
#ifndef EPI_WT
#define EPI_WT 0
#endif
__device__ __forceinline__ void st16(bf16_t* base, size_t elem_off, u32x4 w) {
#if EPI_WT
    const __amdgpu_buffer_rsrc_t r = __builtin_amdgcn_make_buffer_rsrc((void*)base, 0, 0x7fffffff, 0x00020000);
    __builtin_amdgcn_raw_buffer_store_b128(w, r, (unsigned)(elem_off * 2), 0, 16);
#else
    *(u32x4*)(base + elem_off) = w;
#endif
}
struct EpiStore {
    static constexpr bool PERM = true, AFTER_DRAIN = false;
    bf16_t* O; int ldc;
    __device__ __forceinline__ void operator()(const f32x4 (&acc)[2][2][4][2], const Unit& u, int wr, int wc, int fr, int fq) const {
        const int row0 = u.pm * BM + wr * 64 + fr, col0 = u.pn * BM + wc * 32 + 8 * fq;
#pragma unroll
        for (int ai = 0; ai < 2; ++ai)
#pragma unroll
            for (int m = 0; m < 4; ++m) { bf16_t* rowp = O + (size_t)(row0 + ai * HALF + m * 16) * ldc + col0;
#pragma unroll
                for (int bj = 0; bj < 2; ++bj) { const f32x4 v0 = acc[ai][bj][m][0], v1 = acc[ai][bj][m][1];
                    u32x4 w; w.x = cvt_pk_bf16(v0[0], v0[1]); w.y = cvt_pk_bf16(v0[2], v0[3]); w.z = cvt_pk_bf16(v1[0], v1[1]); w.w = cvt_pk_bf16(v1[2], v1[3]);
                    st16(O, (size_t)(rowp - O) + bj * HALF, w); } }
    }
};
struct EpiProj {
    static constexpr bool PERM = true, AFTER_DRAIN = false;
    bf16_t* O; int ldc; const f32x2* tab; int ml;
    __device__ __forceinline__ void operator()(const f32x4 (&acc)[2][2][4][2], const Unit& u, int wr, int wc, int fr, int fq) const {
        const int row0 = u.pm * BM + wr * 64 + fr;
        const bool latent = (u.pm * BM) < ml;
#pragma unroll
        for (int bj = 0; bj < 2; ++bj) {
            const int c0 = u.pn * BM + bj * HALF + wc * 32;
            const bool rope = latent && ((c0 >= 928 && c0 < 1056) || (c0 >= 1824 && c0 < 2336));
            const bool rowhalf = (((c0 - 32) & 63) == 0);
            const bool qscale = (c0 >= 1568 && c0 < 2336);
#pragma unroll
            for (int ai = 0; ai < 2; ++ai)
#pragma unroll
                for (int m = 0; m < 4; ++m) {
                    const int row = row0 + ai * HALF + m * 16;
                    f32x4 v0 = acc[ai][bj][m][0], v1 = acc[ai][bj][m][1];
                    if (rope) {
                        const int t = row & 2047, pos = rowhalf ? (t >> 6) : (t & 63);
                        const f32x2* tp = tab + pos * 16 + 8 * (fq & 1);
                        const float sg = (fq < 2) ? -1.f : 1.f;
#pragma unroll
                        for (int e = 0; e < 4; ++e) {
                            const float x0 = v0[e], x1 = v1[e];
                            const float p0 = __shfl_xor(x0, 32), p1 = __shfl_xor(x1, 32);
                            const f32x2 c0s = tp[e], c1s = tp[4 + e];
                            v0[e] = x0 * c0s.x + sg * p0 * c0s.y; v1[e] = x1 * c1s.x + sg * p1 * c1s.y;
                        }
                    }
                    if (qscale) { v0 = v0 * 0.18033688011112042f; v1 = v1 * 0.18033688011112042f; }
                    u32x4 w; w.x = cvt_pk_bf16(v0[0], v0[1]); w.y = cvt_pk_bf16(v0[2], v0[3]); w.z = cvt_pk_bf16(v1[0], v1[1]); w.w = cvt_pk_bf16(v1[2], v1[3]);
                    st16(O, (size_t)row * ldc + c0 + 8 * fq, w);
                }
        }
    }
};
struct EpiSwiGLU {
    static constexpr bool PERM = true, AFTER_DRAIN = false;
    bf16_t* O; int ldc;
    __device__ __forceinline__ void operator()(const f32x4 (&acc)[2][2][4][2], const Unit& u, int wr, int wc, int fr, int fq) const {
        const int row0 = u.pm * BM + wr * 64 + fr, col0 = u.pn * HALF + wc * 32 + 8 * fq;
#pragma unroll
        for (int ai = 0; ai < 2; ++ai)
#pragma unroll
            for (int m = 0; m < 4; ++m) {
                float h[8];
#pragma unroll
                for (int n = 0; n < 2; ++n)
#pragma unroll
                    for (int e = 0; e < 4; ++e) { const float g = acc[ai][0][m][n][e], up = acc[ai][1][m][n][e];
                        h[n * 4 + e] = g * __builtin_amdgcn_rcpf(1.f + __builtin_amdgcn_exp2f(-1.4426950408889634f * g)) * up; }
                u32x4 w; w.x = cvt_pk_bf16(h[0], h[1]); w.y = cvt_pk_bf16(h[2], h[3]); w.z = cvt_pk_bf16(h[4], h[5]); w.w = cvt_pk_bf16(h[6], h[7]);
                st16(O, (size_t)(row0 + ai * HALF + m * 16) * ldc + col0, w);
            }
    }
};
struct MoeOrder {
    int npe, nN, nwg, G, c;
    __host__ __device__ void init(int npe_, int nN_, int G_, int c_) { npe = npe_; nN = nN_; nwg = 16 * npe * nN; G = G_; c = c_; }
    __host__ __device__ bool next(int i, Unit& u) const {
        const long L = (long)i * G + c; if (L >= nwg) return false;
        int wgid = (int)L; { const int q = nwg / NXCD, r = nwg % NXCD, xcd = wgid % NXCD, off = wgid / NXCD; wgid = (xcd < r ? xcd * (q + 1) : r * (q + 1) + (xcd - r) * q) + off; }
        const int per = npe * nN, e = wgid / per, rem = wgid % per, j = rem / nN, pn = rem % nN;
        u.pm = (j < 8) ? (j * 16 + e) : (128 + e); u.pn = pn; u.pb = e * nN + pn; return true;
    }
    __device__ __forceinline__ void a_ready(const Unit&) const {}
    __device__ __forceinline__ void done(const Unit&) const {}
};

template <class Epi, class Sched, bool ALIGN_EPI = false, bool SP2 = false, bool GATHER = false>
__device__ __forceinline__ void gemm_phase(PG8_LAS unsigned char* lds, const Gemm g, const Sched& S, const Epi& E) {
    int tid_ = threadIdx.x; asm volatile("" : "+v"(tid_));
    const int tid = tid_, wid = __builtin_amdgcn_readfirstlane(tid >> 6), lane = tid & 63, wr = wid >> 2, wc = wid & 3, fr = lane & 15, fq = lane >> 4;
    const int K = g.K, nt = K / BK;
    static_assert(!GATHER || SP2, "GATHER is wired into the SP2 loop only");
    unsigned voffA[2], voffB[2]; int RA[2], CA[2]; unsigned vAc[2][2], vAn[2][2];
#pragma unroll
    for (int i = 0; i < 2; ++i) { int R, C; stage_rc(tid * 16 + i * 8192, R, C); const int Rb = Epi::PERM ? ((R & ~31) + perm32(R & 31)) : R; RA[i] = R; CA[i] = C;
        voffA[i] = (unsigned)(R * K + C) * 2u; voffB[i] = (unsigned)(Rb * K + C) * 2u; vAc[0][i] = vAc[1][i] = vAn[0][i] = vAn[1][i] = 0u; }
    auto load_idx = [&](int pm, unsigned (&v)[2][2]) {
#pragma unroll
        for (int h = 0; h < 2; ++h)
#pragma unroll
            for (int i = 0; i < 2; ++i) v[h][i] = (unsigned)(g.rowidx[pm * BM + h * HALF + RA[i]] * K + CA[i]) * 2u;
    };
    const size_t kstep = (size_t)(BK * 2);
    const size_t hstep = (size_t)HALF * K * 2;
    const size_t tstep = 2 * hstep;
    const unsigned ldsw = (unsigned)wid * 1024u;
    const int aoff = lds_byte(wr * 64 + fr, fq * 8), boff = lds_byte(wc * 32 + fr, fq * 8);
#define PG8_SA(b, h) (((b) * 2 + (h)) * HTB)
#define PG8_SB(b, h) ((4 + (b) * 2 + (h)) * HTB)
#define PG8_STAGE(bufoff, gbase, voff) do { _Pragma("unroll") for (int _i = 0; _i < 2; ++_i) \
        __builtin_amdgcn_global_load_lds((const unsigned*)((const char*)(gbase) + (voff)[_i]), (PG8_LAS unsigned*)(lds + (bufoff) + ldsw + _i * 8192), 16, 0, 0); } while (0)
#define PG8_STAGE_A(bufoff, gbase, h, nx) do { if constexpr (GATHER) { const unsigned v_[2] = { (nx) ? vAn[h][0] : vAc[h][0], (nx) ? vAn[h][1] : vAc[h][1] }; PG8_STAGE(bufoff, gbase, v_); } \
        else { PG8_STAGE(bufoff, (gbase) + (h) * hstep, voffA); } } while (0)
#define PG8_LDA(dst, b, h) do { _Pragma("unroll") for (int m = 0; m < 4; ++m) _Pragma("unroll") for (int k = 0; k < 2; ++k) dst[m][k] = *(const PG8_LAS bf16x8*)(lds + PG8_SA(b, h) + aoff + m * 2048 + k * 1024); } while (0)
#define PG8_LDB(dst, b, h) do { _Pragma("unroll") for (int n = 0; n < 2; ++n) _Pragma("unroll") for (int k = 0; k < 2; ++k) dst[n][k] = *(const PG8_LAS bf16x8*)(lds + PG8_SB(b, h) + boff + n * 2048 + k * 1024); } while (0)
#define PG8_MMA(ai, bj, At, Bt) do { __builtin_amdgcn_s_setprio(1); _Pragma("unroll") for (int m = 0; m < 4; ++m) _Pragma("unroll") for (int n = 0; n < 2; ++n) _Pragma("unroll") for (int k = 0; k < 2; ++k) \
        acc[ai][bj][m][n] = __builtin_amdgcn_mfma_f32_16x16x32_bf16(Bt[n][k], At[m][k], acc[ai][bj][m][n], 0, 0, 0); __builtin_amdgcn_s_setprio(0); } while (0)
#define PG8_WAIT_V(n) asm volatile("s_waitcnt vmcnt(" #n ")" ::: "memory")
#define PG8_WAIT_L(n) asm volatile("s_waitcnt lgkmcnt(" #n ")" ::: "memory")
#define PG8_BAR __builtin_amdgcn_s_barrier()
#define PG8_SCHED __builtin_amdgcn_sched_barrier(0)
    Unit cur, nxt; int ui = 0;
    if (!S.next(0, cur)) return;
    f32x4 acc[2][2][4][2];
#pragma unroll
    for (int a = 0; a < 2; ++a)
#pragma unroll
        for (int b = 0; b < 2; ++b)
#pragma unroll
            for (int m = 0; m < 4; ++m)
#pragma unroll
                for (int n = 0; n < 2; ++n) acc[a][b][m][n] = (f32x4){0.f, 0.f, 0.f, 0.f};
    bf16x8 At[4][2], B0[2][2], B1[2][2];
    const char* cA = (const char*)g.A + (GATHER ? (size_t)0 : (size_t)cur.pm * tstep); const char* cB = (const char*)g.Bt + (size_t)cur.pb * tstep;
    if constexpr (GATHER) load_idx(cur.pm, vAc);
    S.a_ready(cur);
    if constexpr (SP2) {
        PG8_STAGE(PG8_SB(0, 0), cB, voffB); PG8_STAGE(PG8_SB(0, 1), cB + hstep, voffB); PG8_STAGE_A(PG8_SA(0, 0), cA, 0, false); PG8_STAGE_A(PG8_SA(0, 1), cA, 1, false);
        if (wr == 1) PG8_BAR;
        PG8_WAIT_V(2); PG8_BAR;
        PG8_STAGE(PG8_SB(1, 0), cB + kstep, voffB); PG8_STAGE_A(PG8_SA(1, 0), cA + kstep, 0, false); PG8_STAGE(PG8_SB(1, 1), cB + hstep + kstep, voffB);
        PG8_WAIT_V(6); PG8_BAR;
    } else {
        PG8_STAGE(PG8_SB(0, 0), cB, voffB); PG8_STAGE(PG8_SA(0, 0), cA, voffA); PG8_STAGE(PG8_SB(0, 1), cB + hstep, voffB); PG8_STAGE(PG8_SA(0, 1), cA + hstep, voffA);
        if (wr == 1) PG8_BAR;
        PG8_WAIT_V(4); PG8_BAR;
        PG8_STAGE(PG8_SB(1, 0), cB + kstep, voffB); PG8_STAGE(PG8_SA(1, 0), cA + kstep, voffA); PG8_STAGE(PG8_SB(1, 1), cB + hstep + kstep, voffB);
        PG8_WAIT_V(6); PG8_BAR;
    }
    for (;;) {
        const bool has_next = S.next(ui + 1, nxt);
        if constexpr (GATHER) { if (has_next) {
#pragma unroll
            for (int h = 0; h < 2; ++h)
#pragma unroll
                for (int i = 0; i < 2; ++i) __builtin_amdgcn_global_load_lds((const unsigned*)(g.rowidx + nxt.pm * BM + h * HALF + RA[i]), (PG8_LAS unsigned*)(lds + STAGE_BYTES + (h * 2 + i) * 2048 + wid * 256), 4, 0, 0); } }
        const char* nA = (has_next && !GATHER) ? (const char*)g.A + (size_t)nxt.pm * tstep : cA; const char* nB = has_next ? (const char*)g.Bt + (size_t)nxt.pb * tstep : cB;
        for (int t = 0; t < nt; t += 2) {
            const bool last = (t == nt - 2); const bool nxu = last && has_next; (void)nxu;
            if constexpr (GATHER) { if (nxu) {
#pragma unroll
                for (int h = 0; h < 2; ++h)
#pragma unroll
                    for (int i = 0; i < 2; ++i) { const int ix = *(const PG8_LAS int*)(lds + STAGE_BYTES + (h * 2 + i) * 2048 + tid * 4); vAn[h][i] = (unsigned)(ix * K + CA[i]) * 2u; } } }
            const char* a1 = cA + (size_t)(t + 1) * kstep;
            const char* a2 = last ? nA : cA + (size_t)(t + 2) * kstep; const char* b2 = last ? nB : cB + (size_t)(t + 2) * kstep;
            const char* a3 = a2 + kstep; const char* b3 = b2 + kstep;
            if (last && has_next) S.a_ready(nxt);
            if constexpr (SP2) {
            PG8_LDB(B0, 0, 0); PG8_LDB(B1, 0, 1); PG8_SCHED; PG8_LDA(At, 0, 0); PG8_STAGE_A(PG8_SA(1, 1), a1, 1, false);
            PG8_WAIT_V(8); PG8_WAIT_L(0); PG8_BAR; PG8_MMA(0, 0, At, B0); PG8_MMA(0, 1, At, B1); PG8_BAR; PG8_SCHED;
            PG8_LDA(At, 0, 1); PG8_STAGE(PG8_SB(0, 0), b2, voffB); PG8_STAGE(PG8_SB(0, 1), b2 + hstep, voffB); PG8_STAGE_A(PG8_SA(0, 0), a2, 0, nxu);
            PG8_WAIT_V(8); PG8_WAIT_L(0); PG8_BAR; PG8_MMA(1, 0, At, B0); PG8_MMA(1, 1, At, B1); PG8_BAR; PG8_SCHED;
            PG8_LDB(B0, 1, 0); PG8_LDB(B1, 1, 1); PG8_SCHED; PG8_LDA(At, 1, 0); PG8_STAGE_A(PG8_SA(0, 1), a2, 1, nxu);
            PG8_WAIT_V(8); PG8_WAIT_L(0); PG8_BAR; PG8_MMA(0, 0, At, B0); PG8_MMA(0, 1, At, B1); PG8_BAR; PG8_SCHED;
            PG8_LDA(At, 1, 1); PG8_STAGE(PG8_SB(1, 0), b3, voffB); PG8_STAGE(PG8_SB(1, 1), b3 + hstep, voffB); PG8_STAGE_A(PG8_SA(1, 0), a3, 0, nxu);
            PG8_WAIT_V(8); PG8_WAIT_L(0); PG8_BAR; PG8_MMA(1, 0, At, B0); PG8_MMA(1, 1, At, B1); PG8_BAR; PG8_SCHED;
            } else {
            PG8_LDB(B0, 0, 0); PG8_SCHED; PG8_LDA(At, 0, 0); PG8_STAGE(PG8_SA(1, 1), a1 + hstep, voffA);
            PG8_WAIT_L(8); PG8_BAR; PG8_WAIT_L(0); PG8_MMA(0, 0, At, B0); PG8_BAR; PG8_SCHED;
            PG8_LDB(B1, 0, 1); PG8_STAGE(PG8_SB(0, 0), b2, voffB);
            PG8_BAR; PG8_WAIT_L(0); PG8_MMA(0, 1, At, B1); PG8_BAR;
            PG8_LDA(At, 0, 1); PG8_STAGE(PG8_SA(0, 0), a2, voffA);
            PG8_BAR; PG8_WAIT_L(0); PG8_MMA(1, 0, At, B0); PG8_BAR; PG8_SCHED;
            PG8_STAGE(PG8_SB(0, 1), b2 + hstep, voffB);
            PG8_WAIT_V(6); PG8_BAR; PG8_MMA(1, 1, At, B1); PG8_BAR;
            PG8_LDB(B0, 1, 0); PG8_SCHED; PG8_LDA(At, 1, 0); PG8_STAGE(PG8_SA(0, 1), a2 + hstep, voffA);
            PG8_WAIT_L(8); PG8_BAR; PG8_WAIT_L(0); PG8_MMA(0, 0, At, B0); PG8_BAR; PG8_SCHED;
            PG8_LDB(B1, 1, 1); PG8_STAGE(PG8_SB(1, 0), b3, voffB);
            PG8_BAR; PG8_WAIT_L(0); PG8_MMA(0, 1, At, B1); PG8_BAR;
            PG8_LDA(At, 1, 1); PG8_STAGE(PG8_SA(1, 0), a3, voffA);
            PG8_BAR; PG8_WAIT_L(0); PG8_MMA(1, 0, At, B0); PG8_BAR; PG8_SCHED;
            PG8_STAGE(PG8_SB(1, 1), b3 + hstep, voffB);
            PG8_WAIT_V(6); PG8_BAR; PG8_MMA(1, 1, At, B1); PG8_BAR;
            }
        }
        if constexpr (ALIGN_EPI) { if (wr == 0) PG8_BAR; }
        if constexpr (!Epi::AFTER_DRAIN) { E(acc, cur, wr, wc, fr, fq); S.done(cur); }
        if (!has_next) break;
#pragma unroll
        for (int a = 0; a < 2; ++a)
#pragma unroll
            for (int b = 0; b < 2; ++b)
#pragma unroll
                for (int m = 0; m < 4; ++m)
#pragma unroll
                    for (int n = 0; n < 2; ++n) acc[a][b][m][n] = (f32x4){0.f, 0.f, 0.f, 0.f};
        cur = nxt; cA = nA; cB = nB; ++ui;
        if constexpr (GATHER) {
#pragma unroll
            for (int h = 0; h < 2; ++h) { vAc[h][0] = vAn[h][0]; vAc[h][1] = vAn[h][1]; } }
        if constexpr (ALIGN_EPI) { if (wr == 1) PG8_BAR; }
    }
    PG8_WAIT_V(0);
    if constexpr (!ALIGN_EPI) { if (wr == 0) PG8_BAR; }
    PG8_BAR;
    if constexpr (Epi::AFTER_DRAIN) { E.fused(acc, cur, wr, wc, fr, fq, lds, wid, lane); S.done(cur); }
#undef PG8_SA
#undef PG8_SB
#undef PG8_STAGE
#undef PG8_STAGE_A
#undef PG8_LDA
#undef PG8_LDB
#undef PG8_MMA
#undef PG8_WAIT_V
#undef PG8_WAIT_L
#undef PG8_BAR
#undef PG8_SCHED
}
}
constexpr int NB = 8, SEQ = 2048, DM = 1024, CTXL = 256, ML = NB * SEQ, MC = NB * CTXL, MT = ML + MC;
constexpr int PP = 2560;
constexpr int INW = 2336;
constexpr int C_GK = 0, C_GV = 128, C_GAF = 384, C_GAB = 400, C_NK = 416, C_NV = 672, C_SK = 928, C_SV = 1056, C_GQ = 1184, C_GG = 1312, C_NQ = 1568, C_SQ = 1824;
constexpr int NWAVES = 8;
constexpr float NEPS = 1e-6f;
constexpr float LOG2E = 1.4426950408889634f;

constexpr size_t MiB = 1u << 20;
constexpr size_t WS_CTL = 0, CTL_ZERO_BYTES = 1 * MiB;
constexpr size_t WS_TAB = 1 * MiB;
constexpr size_t WS_MOD = 1 * MiB + 65536;
constexpr size_t WS_MODP = 2 * MiB;
constexpr size_t WS_WIN = 6 * MiB;
constexpr size_t WS_WOUT = 16 * MiB;
constexpr size_t WS_WGU = 20 * MiB;
constexpr size_t WS_WD = 148 * MiB;
constexpr size_t WS_H = 212 * MiB;
constexpr size_t WS_R1 = 248 * MiB;
constexpr size_t WS_R2 = 338 * MiB;
constexpr size_t WS_XB = 410 * MiB;
constexpr size_t WS_UST = 446 * MiB;
constexpr size_t WS_MISC = 464 * MiB;
constexpr size_t WS_DEC = WS_MISC;
constexpr size_t WS_AFF = WS_MISC + 1 * MiB;
constexpr size_t WS_AFFC = WS_MISC + 2 * MiB;
constexpr size_t WS_GATE = WS_MISC + 2 * MiB + 262144;
constexpr size_t WS_GATEC = WS_MISC + 2 * MiB + 524288;
constexpr size_t WS_INV = WS_MISC + 3 * MiB;
constexpr size_t WS_ROWIDX = WS_MISC + 3 * MiB + 786432;
constexpr size_t WS_END = 468 * MiB;
constexpr int CW_BAR = 4096;
constexpr int CW_QUEUE = 1024;
constexpr int CW_CONV = 2048;

constexpr int WAVE_LDS = 19456;
constexpr int RING_BYTES = NWAVES * WAVE_LDS;
constexpr int LDSCTL_OFF = RING_BYTES, MISC_OFF = LDSCTL_OFF + 320;
constexpr int LDS_BYTES = RING_BYTES + 1024;
static_assert(RING_BYTES >= pg8::STAGE_BYTES && LDS_BYTES <= 163840, "LDS map");

#define GAS __attribute__((address_space(1)))
#define LAS __attribute__((address_space(3)))
typedef unsigned short bf16_t;
typedef unsigned v4u __attribute__((ext_vector_type(4)));
typedef unsigned v2u __attribute__((ext_vector_type(2)));
typedef float f32x4 __attribute__((ext_vector_type(4)));
typedef float f32x2 __attribute__((ext_vector_type(2)));
typedef float f32x16 __attribute__((ext_vector_type(16)));
typedef short bf16x8 __attribute__((ext_vector_type(8)));
typedef short s16x4 __attribute__((ext_vector_type(4)));
typedef GAS unsigned gu32;
#define RLX_AGENT __ATOMIC_RELAXED, __HIP_MEMORY_SCOPE_AGENT
typedef __bf16 bf16x2_t __attribute__((ext_vector_type(2)));
__device__ __forceinline__ unsigned pk2(float lo, float hi) { f32x2 v = {lo, hi}; bf16x2_t b = __builtin_convertvector(v, bf16x2_t); return __builtin_bit_cast(unsigned, b); }
__device__ __forceinline__ float bflo(unsigned w) { return __uint_as_float(w << 16); }
__device__ __forceinline__ float bfhi(unsigned w) { return __uint_as_float(w & 0xffff0000u); }
__device__ __forceinline__ float bf1(bf16_t w) { return __uint_as_float((unsigned)w << 16); }
__device__ __forceinline__ float wave_sum(float v) {
#pragma unroll
    for (int o = 1; o < 64; o <<= 1) v += __shfl_xor(v, o);
    return v;
}
__device__ __forceinline__ float fexp2(float x) { return __builtin_amdgcn_exp2f(x); }
__device__ __forceinline__ float fexp(float x) { return __builtin_amdgcn_exp2f(x * LOG2E); }
__device__ __forceinline__ float flog(float x) { return __builtin_amdgcn_logf(x) * 0.6931471805599453f; }
__device__ __forceinline__ float frcp(float x) { return __builtin_amdgcn_rcpf(x); }
__device__ __forceinline__ float silu_f(float x) { return x * frcp(1.f + fexp(-x)); }
__device__ __forceinline__ int crow(int r, int hi) { return (r & 3) + 8 * (r >> 2) + 4 * hi; }
__device__ __forceinline__ s16x4 tr_read(LAS const unsigned char* p) { return __builtin_bit_cast(s16x4, __builtin_amdgcn_ds_read_tr16_b64_v4i16((LAS s16x4*)p)); }
__device__ __forceinline__ bf16x8 cat4(s16x4 a, s16x4 b) { return (bf16x8){a[0], a[1], a[2], a[3], b[0], b[1], b[2], b[3]}; }
__device__ __forceinline__ bf16x8 pack8(float a0, float a1, float a2, float a3, float a4, float a5, float a6, float a7) {
    v4u w; w.x = pk2(a0, a1); w.y = pk2(a2, a3); w.z = pk2(a4, a5); w.w = pk2(a6, a7); return __builtin_bit_cast(bf16x8, w); }
#define MFMA32(a, b, c) __builtin_amdgcn_mfma_f32_32x32x16_bf16((a), (b), (c), 0, 0, 0)

#define XB_TMO      128
#define XB_XCNT(j)  (256  + 64 * (j))
#define XB_XSUB(j)  (1280 + 64 * (j))
#define XB_XGEN(j)  (2304 + 64 * (j))
#define XB_TOP      3328
#define XB_TOPGEN   3392
#define XCD_BAR_WORDS 3456
#define XB_SPIN_CAP (1u << 18)

__device__ __forceinline__ unsigned xb_ld(unsigned* p)              { return __hip_atomic_load(p, __ATOMIC_RELAXED, __HIP_MEMORY_SCOPE_AGENT); }
__device__ __forceinline__ unsigned xb_add(unsigned* p, unsigned v) { return __hip_atomic_fetch_add(p, v, __ATOMIC_RELAXED, __HIP_MEMORY_SCOPE_AGENT); }
__device__ __forceinline__ unsigned xb_xcc_id() { return (unsigned)__builtin_amdgcn_s_getreg((3 << 11) | 20) & 0xFu; }
#define XB_SPIN(cond, bar) do { unsigned _sp = 0; while (cond) { __builtin_amdgcn_s_sleep(1); \
    if ((++_sp & 255u) == 0u) { if (xb_ld(&(bar)[XB_TMO])) break; if (_sp > XB_SPIN_CAP) { atomicAdd(&(bar)[XB_TMO], 1u); break; } } } } while (0)

struct XcdBarrier {
    unsigned* bar; unsigned x;
    volatile LAS unsigned* st;
};

__device__ __forceinline__ XcdBarrier xcd_barrier_post(unsigned* bar, volatile LAS unsigned* st) {
    XcdBarrier b; b.bar = bar; b.x = xb_xcc_id(); b.st = st;
    if (threadIdx.x == 0) (void)xb_add(&bar[XB_XCNT(b.x)], 1u);
    return b;
}
__device__ __forceinline__ void xcd_barrier_complete(unsigned* bar, unsigned x, unsigned& nloc, unsigned& nx) {
    const unsigned G = gridDim.x * gridDim.y * gridDim.z;
    unsigned sum, cnt, mine, sp = 0u;
    for (;;) {
        sum = 0u; cnt = 0u; mine = 0u;
#pragma unroll
        for (unsigned j = 0; j < 16; ++j) { const unsigned c = xb_ld(&bar[XB_XCNT(j)]); sum += c; cnt += (c > 0u) ? 1u : 0u; mine = (j == x) ? c : mine; }
        if (sum == G) break;
        __builtin_amdgcn_s_sleep(1);
        if ((++sp & 255u) == 0u) { if (xb_ld(&bar[XB_TMO])) break; if (sp > XB_SPIN_CAP) { atomicAdd(&bar[XB_TMO], 1u); break; } }
    }
    nloc = mine > 0u ? mine : 1u; nx = cnt > 0u ? cnt : 1u;
}

__device__ __forceinline__ void xcd_barrier(const XcdBarrier& b) {
    asm volatile("s_waitcnt vmcnt(0)" ::: "memory");
    __syncthreads();
    if (threadIdx.x == 0) {
        unsigned* bar = b.bar;
        __builtin_amdgcn_s_waitcnt(0);
        unsigned nloc = b.st[0], nx = b.st[1];
        if (nloc == 0u) { xcd_barrier_complete(bar, b.x, nloc, nx); b.st[0] = nloc; b.st[1] = nx; }
        const unsigned old = xb_add(&bar[XB_XSUB(b.x)], 1u);
        const unsigned gen = old / nloc;
        if (old + 1u == (gen + 1u) * nloc) {
            __builtin_amdgcn_fence(__ATOMIC_RELEASE, "agent");
            asm volatile("s_waitcnt vmcnt(0)" ::: "memory");
            const unsigned og = xb_add(&bar[XB_TOP], 1u);
            const unsigned tg = og / nx;
            if (og + 1u == (tg + 1u) * nx) xb_add(&bar[XB_TOPGEN], 1u);
            else XB_SPIN(xb_ld(&bar[XB_TOPGEN]) == tg, bar);
            __builtin_amdgcn_fence(__ATOMIC_ACQUIRE, "agent");
            xb_add(&bar[XB_XGEN(b.x)], 1u);
            asm volatile("s_waitcnt vmcnt(0)" ::: "memory");
        } else {
            XB_SPIN(xb_ld(&bar[XB_XGEN(b.x)]) == gen, bar);
            __builtin_amdgcn_fence(__ATOMIC_ACQUIRE, "agent");
            asm volatile("s_waitcnt vmcnt(0)" ::: "memory");
        }
    }
    __syncthreads();
}
__device__ __forceinline__ void ld_row_f32(const float* p, int lane, f32x4 (&v)[4]) {
#pragma unroll
    for (int j = 0; j < 4; ++j) v[j] = *(const f32x4*)(p + 256 * j + 4 * lane);
}
__device__ __forceinline__ void st_row_f32(float* p, int lane, const f32x4 (&v)[4]) {
#pragma unroll
    for (int j = 0; j < 4; ++j) *(f32x4*)(p + 256 * j + 4 * lane) = v[j];
}
__device__ __forceinline__ void ld_row_bf16(const bf16_t* p, int lane, f32x4 (&v)[4]) {
#pragma unroll
    for (int j = 0; j < 4; ++j) { const v2u w = *(const v2u*)(p + 256 * j + 4 * lane); v[j] = (f32x4){bflo(w.x), bfhi(w.x), bflo(w.y), bfhi(w.y)}; }
}
__device__ __forceinline__ void st_row_bf16(bf16_t* p, int lane, const f32x4 (&v)[4]) {
#pragma unroll
    for (int j = 0; j < 4; ++j) { v2u w; w.x = pk2(v[j].x, v[j].y); w.y = pk2(v[j].z, v[j].w); *(v2u*)(p + 256 * j + 4 * lane) = w; }
}
__device__ __forceinline__ void ld_vec_lds(LAS const float* p, int lane, f32x4 (&v)[4]) {
#pragma unroll
    for (int j = 0; j < 4; ++j) v[j] = *(LAS const f32x4*)(p + 256 * j + 4 * lane);
}
__device__ __forceinline__ float sumsq16(const f32x4 (&v)[4]) {
    float s = 0.f;
#pragma unroll
    for (int j = 0; j < 4; ++j) s += (v[j].x * v[j].x + v[j].y * v[j].y) + (v[j].z * v[j].z + v[j].w * v[j].w);
    return s;
}
__device__ __forceinline__ float modfin(const float* modp, const float* bmod, int l, int r, int n) {
    float s = bmod[l * 6144 + n];
#pragma unroll
    for (int kc = 0; kc < 8; ++kc) s += modp[((size_t)(l * 8 + kc) * 9 + r) * 6144 + n];
    return s;
}

#ifndef CONV_IN_P0
#define CONV_IN_P0 1
#endif
__device__ __forceinline__ void tr_item64(const float* W, int N, int Nvalid, bf16_t* WT, int Kd, int k0, int n0, int dst_row0, LAS float* scr, int lane) {
    const int q = lane & 15, kr = lane >> 4;
    f32x4 t[16];
#pragma unroll
    for (int i = 0; i < 16; ++i) { const int kk = 4 * i + kr; const int n = n0 + 4 * q;
        t[i] = (n < Nvalid) ? *(const f32x4*)(W + (size_t)(k0 + kk) * N + n) : (f32x4){0.f, 0.f, 0.f, 0.f}; }
#pragma unroll
    for (int i = 0; i < 16; ++i) { const int kk = 4 * i + kr; LAS float* d = scr + kk * 65 + 4 * q; d[0] = t[i].x; d[1] = t[i].y; d[2] = t[i].z; d[3] = t[i].w; }
    const int c = lane & 7, nl = lane >> 3;
#pragma unroll
    for (int j = 0; j < 8; ++j) { const int n = nl + 8 * j; LAS const float* s = scr + (8 * c) * 65 + n;
        v4u o; o.x = pk2(s[0 * 65], s[1 * 65]); o.y = pk2(s[2 * 65], s[3 * 65]); o.z = pk2(s[4 * 65], s[5 * 65]); o.w = pk2(s[6 * 65], s[7 * 65]);
        *(v4u*)(WT + (size_t)(dst_row0 + n) * Kd + k0 + 8 * c) = o; }
}
__device__ __forceinline__ void expert_conv_item(const float* const* in, unsigned char* ws, int l, int r, LAS float* scr, int lane) {
    const float* w_gate = in[15]; const float* w_up = in[16]; const float* w_down = in[17];
    const int which = r >> 12; r &= 4095;
    const int e = r >> 8, kb = (r & 255) >> 4, nb = r & 15, n0 = 64 * nb;
    const size_t eoff = (size_t)(l * 16 + e) * 1024 * 1024;
    if (which == 0) tr_item64(w_gate + eoff, 1024, 1024, (bf16_t*)(ws + WS_WGU) + 2 * eoff, 1024, 64 * kb, n0, (n0 >> 7) * 256 + (n0 & 127), scr, lane);
    else if (which == 1) tr_item64(w_up + eoff, 1024, 1024, (bf16_t*)(ws + WS_WGU) + 2 * eoff, 1024, 64 * kb, n0, (n0 >> 7) * 256 + 128 + (n0 & 127), scr, lane);
    else tr_item64(w_down + eoff, 1024, 1024, (bf16_t*)(ws + WS_WD) + eoff, 1024, 64 * kb, n0, n0, scr, lane);
}
__device__ __forceinline__ void conv_pull(const float* const* in, unsigned char* ws, int l_lo, int l_hi, int budget, LAS float* scr, int lane) {
    for (int l = l_lo; l <= l_hi && l < 2; ++l) {
        unsigned* ctr = (unsigned*)(ws + WS_CTL) + CW_CONV + 64 * l;
        while (budget > 0) {
            const int c = budget < 8 ? budget : 8;
            unsigned r = 0; if (lane == 0) r = __hip_atomic_fetch_add(ctr, (unsigned)c, __ATOMIC_RELAXED, __HIP_MEMORY_SCOPE_AGENT);
            r = (unsigned)__builtin_amdgcn_readfirstlane((int)r);
            if (r >= 12288u) break;
            for (int k = 0; k < c && (int)r + k < 12288; ++k) expert_conv_item(in, ws, l, (int)r + k, scr, lane);
            budget -= c;
        }
    }
}
__device__ __forceinline__ void phase_p0(const float* const* in, unsigned char* ws, LAS unsigned char* wl, int gw, int NGW, int lane) {
    const float* cvec = in[1]; const float* cctx = in[3]; const float* wmod = in[4];
    const float* w_in = in[7]; const float* w_out = in[8];
    float* modp = (float*)(ws + WS_MODP);
    constexpr int NI_MOD = 2 * 8 * 24, NI_ROPE = 16;
    constexpr int NI_IN = 16 * 40, NI_OUT = 16 * 16, NI_E = 16 * 16 * 16;
    constexpr int NI_L = NI_IN + NI_OUT + (CONV_IN_P0 ? 3 * NI_E : 0);
    constexpr int NITEMS = NI_MOD + NI_ROPE + 2 * NI_L;
    LAS float* scr = (LAS float*)wl;
    for (int it = gw; it < NITEMS; it += NGW) {
        int r = it;
        if (r < NI_MOD) {
            const int cb = r % 24, kc = (r / 24) & 7, l = r / 192;
            for (int idx = lane; idx < 128 * 9; idx += 64) { const int rr = idx / 128, k = idx % 128; const float cv = (rr < 8) ? cvec[rr * 1024 + kc * 128 + k] : cctx[kc * 128 + k]; scr[k * 12 + rr] = silu_f(cv); }
            f32x4 acc[9];
#pragma unroll
            for (int rr = 0; rr < 9; ++rr) acc[rr] = (f32x4){0.f, 0.f, 0.f, 0.f};
            const float* wp = wmod + ((size_t)l * 1024 + kc * 128) * 6144 + cb * 256 + 4 * lane;
#pragma unroll 4
            for (int k = 0; k < 128; ++k) { const f32x4 w = *(const f32x4*)(wp + (size_t)k * 6144);
                const f32x4 s0 = *(LAS const f32x4*)(scr + k * 12), s1 = *(LAS const f32x4*)(scr + k * 12 + 4); const float s8 = scr[k * 12 + 8];
                acc[0] += w * s0.x; acc[1] += w * s0.y; acc[2] += w * s0.z; acc[3] += w * s0.w; acc[4] += w * s1.x; acc[5] += w * s1.y; acc[6] += w * s1.z; acc[7] += w * s1.w; acc[8] += w * s8; }
#pragma unroll
            for (int rr = 0; rr < 9; ++rr) *(f32x4*)(modp + ((size_t)(l * 8 + kc) * 9 + rr) * 6144 + cb * 256 + 4 * lane) = acc[rr];
            continue;
        }
        r -= NI_MOD;
        if (r < NI_ROPE) {
            const int id = r * 64 + lane, pos = id >> 4, i = id & 15;
            const float fr = fexp2(-(float)i * (13.287712379549449f / 16.f));
            float rev = (float)pos * fr * 0.15915494309189535f; rev -= floorf(rev);
            f32x2 cs; cs.x = __builtin_amdgcn_cosf(rev); cs.y = __builtin_amdgcn_sinf(rev);
            ((f32x2*)(ws + WS_TAB))[id] = cs;
            continue;
        }
        r -= NI_ROPE;
        const int l = r / NI_L; r -= l * NI_L;
        if (r < NI_IN) { const int kb = r / 40, nb = r % 40;
            tr_item64(w_in + (size_t)l * 1024 * INW, INW, INW, (bf16_t*)(ws + WS_WIN) + (size_t)l * PP * 1024, 1024, 64 * kb, 64 * nb, 64 * nb, scr, lane); continue; }
        r -= NI_IN;
        if (r < NI_OUT) { const int kb = r / 16, nb = r % 16;
            tr_item64(w_out + (size_t)l * 1024 * 1024, 1024, 1024, (bf16_t*)(ws + WS_WOUT) + (size_t)l * 1024 * 1024, 1024, 64 * kb, 64 * nb, 64 * nb, scr, lane); continue; }
        r -= NI_OUT;
        expert_conv_item(in, ws, l, r, scr, lane);
    }
}

__device__ __forceinline__ void phase_a0(const float* const* in, unsigned char* ws, LAS unsigned char* lds, int G, int tid, int wave, int lane) {
    const float* x = in[0]; const float* ctx = in[2]; const float* bmod = in[5]; const float* gains = in[6];
    const float* modp = (const float*)(ws + WS_MODP); float* mod = (float*)(ws + WS_MOD); bf16_t* H = (bf16_t*)(ws + WS_H);
    LAS float* V = (LAS float*)lds;
    for (int row = blockIdx.x; row < 18; row += G) { const int l = row / 9, r = row % 9;
        for (int n = tid; n < 6144; n += 512) mod[(size_t)row * 6144 + n] = modfin(modp, bmod, l, r, n); }
    for (int t = blockIdx.x; t < 256; t += G) {
        const int b = t >> 5;
        __syncthreads();
        for (int n = tid; n < 1024; n += 512) { const float g = gains[n];
            V[n] = g * (1.f + modfin(modp, bmod, 0, b, 1024 + n)); V[1024 + n] = modfin(modp, bmod, 0, b, n);
            V[2048 + n] = g * (1.f + modfin(modp, bmod, 0, 8, 1024 + n)); V[3072 + n] = modfin(modp, bmod, 0, 8, n); }
        __syncthreads();
#pragma unroll 1
        for (int i0 = 0; i0 < 9; i0 += 3) {
            f32x4 xq[3][4];
#pragma unroll
            for (int k = 0; k < 3; ++k) { const int i = i0 + k; const bool isc = (i == 8);
                const float* src = isc ? (ctx + (size_t)(8 * t + wave) * 1024) : (x + (size_t)(64 * t + 8 * wave + i) * 1024); ld_row_f32(src, lane, xq[k]); }
#pragma unroll
            for (int k = 0; k < 3; ++k) { const int i = i0 + k; const bool isc = (i == 8);
                const int row = isc ? (ML + 8 * t + wave) : (64 * t + 8 * wave + i);
                f32x4 (&v)[4] = xq[k]; f32x4 a[4], s[4];
                const float rstd = __builtin_amdgcn_rsqf(wave_sum(sumsq16(v)) * (1.f / 1024.f) + NEPS);
                ld_vec_lds(V + (isc ? 2048 : 0), lane, a); ld_vec_lds(V + (isc ? 3072 : 1024), lane, s);
#pragma unroll
                for (int j = 0; j < 4; ++j) v[j] = v[j] * rstd * a[j] + s[j];
                st_row_bf16(H + (size_t)row * 1024, lane, v);
            }
        }
    }
}
constexpr int VP = 192;
struct AttnTile { f32x16 o0, o1; float m, lsum; };
__device__ __forceinline__ void attn_softmax(f32x16& s, AttnTile& T) {
    float bm = fmaxf(fmaxf(s[0], s[1]), fmaxf(s[2], s[3]));
#pragma unroll
    for (int i = 4; i < 16; i += 4) bm = fmaxf(bm, fmaxf(fmaxf(s[i], s[i + 1]), fmaxf(s[i + 2], s[i + 3])));
    bm = fmaxf(bm, __shfl_xor(bm, 32));
    const float mo = T.m, mn = fmaxf(mo, bm);
    T.m = mn;
    float ps = 0.f;
#pragma unroll
    for (int i = 0; i < 16; ++i) { s[i] = fexp2(s[i] - mn); ps += s[i]; }
    if (__any(mn != mo)) {
        const float alpha = fexp2(mo - mn);
        T.lsum *= alpha;
#pragma unroll
        for (int i = 0; i < 16; ++i) { T.o0[i] *= alpha; T.o1[i] *= alpha; }
    }
    T.lsum += ps;
}
__device__ __forceinline__ void attn_item(const int MODE, const bf16_t* P, bf16_t* MIX, int item, LAS unsigned char* wl, int lane,
                                          const float* __restrict__ rpb, const float* __restrict__ sink, const bool dry = false) {
    asm volatile("" : "+v"(lane));
    const int ql = lane & 31, hi = lane >> 5;
    int b, hq, qcol, kcol, vcol, ocol, qrow0, r = 0, rs = 0, q64 = 0, nloc, kb_lo = 0;
    if (MODE == 0) { r = item & 31; hq = (item >> 5) & 3; b = item >> 7;
        qcol = C_NQ + hq * 64; kcol = C_NK + hq * 64; vcol = C_NV + hq * 64; ocol = 256 + hq * 64; qrow0 = b * SEQ + r * 64;
        rs = r - 4; rs = rs < 0 ? 0 : (rs > 24 ? 24 : rs); nloc = 16; }
    else if (MODE == 1) { q64 = item & 31; hq = (item >> 5) & 7; b = item >> 8;
        qcol = C_SQ + hq * 64; kcol = C_SK + (hq >> 2) * 64; vcol = C_SV + (hq >> 2) * 64; ocol = 512 + hq * 64; qrow0 = b * SEQ + q64 * 64;
        kb_lo = 2 * q64 - 4; if (kb_lo < 0) kb_lo = 0; int kb_hi = 2 * q64 + 5; if (kb_hi > 63) kb_hi = 63; nloc = kb_hi - kb_lo + 1; }
    else if (MODE == 2) { q64 = item & 3; hq = (item >> 2) & 3; b = item >> 4;
        qcol = C_NQ + hq * 64; kcol = C_NK + hq * 64; vcol = C_NV + hq * 64; ocol = 256 + hq * 64; qrow0 = ML + b * CTXL + q64 * 64; nloc = 0; }
    else { q64 = item & 3; hq = (item >> 2) & 7; b = item >> 5;
        qcol = C_SQ + hq * 64; kcol = C_SK + (hq >> 2) * 64; vcol = C_SV + (hq >> 2) * 64; ocol = 512 + hq * 64; qrow0 = ML + b * CTXL + q64 * 64; nloc = 0; }
    const int nblk = 8 + nloc;
    LAS unsigned char* vl = wl;
    LAS float* rl = (LAS float*)(wl + 32 * VP);
    if (MODE == 0) { for (int i = lane; i < 465; i += 64) rl[i] = rpb[hq * 465 + i] * LOG2E; }
    LAS unsigned char* qimg = wl + 32 * VP + 1920;
    constexpr int QP = 144;
#pragma unroll
    for (int i = 0; i < 8; ++i) { const int c = lane + 64 * i; const v4u v = *(const v4u*)(P + (size_t)(qrow0 + (c >> 3)) * PP + qcol + (c & 7) * 8); *(LAS v4u*)(qimg + (c >> 3) * QP + (c & 7) * 16) = v; }
    LAS const unsigned char* qrd = qimg + ql * QP + 16 * hi;
    auto blk_row0 = [&](int blk) -> int {
        if (blk < 8) return ML + b * CTXL + blk * 32;
        const int lb = blk - 8;
        if (MODE == 0) return b * SEQ + (rs + (lb >> 1)) * 64 + (lb & 1) * 32;
        return b * SEQ + 32 * (kb_lo + lb);
    };
    auto load_blk = [&](int blk, bf16x8 (&kn)[4], v4u (&vn)[4]) {
        const int r0 = blk_row0(blk);
        const bf16_t* kp = P + (size_t)(r0 + ql) * PP + kcol + 8 * hi;
#pragma unroll
        for (int ds = 0; ds < 4; ++ds) kn[ds] = *(const bf16x8*)(kp + 16 * ds);
#pragma unroll
        for (int i = 0; i < 4; ++i) { const int c = lane + 64 * i; vn[i] = *(const v4u*)(P + (size_t)(r0 + (c >> 3)) * PP + vcol + (c & 7) * 8); }
    };
    AttnTile T[2];
#pragma unroll
    for (int t = 0; t < 2; ++t) { T[t].m = -INFINITY; T[t].lsum = 0.f;
#pragma unroll
        for (int i = 0; i < 16; ++i) { T[t].o0[i] = 0.f; T[t].o1[i] = 0.f; } }
    const int tr_off = (4 * hi + ((lane & 15) >> 2)) * VP + (16 * ((lane >> 4) & 1) + 4 * (lane & 3)) * 2;
    auto step = [&](int blk, bf16x8 (&kf)[4], v4u (&vr)[4]) {
#pragma unroll
        for (int i = 0; i < 4; ++i) { const int c = lane + 64 * i; *(LAS v4u*)(vl + (c >> 3) * VP + (c & 7) * 16) = vr[i]; }
        f32x16 sc[2];
#pragma unroll
        for (int t = 0; t < 2; ++t) {
#pragma unroll
            for (int i = 0; i < 16; ++i) sc[t][i] = 0.f;
#pragma unroll
            for (int ds = 0; ds < 4; ++ds) sc[t] = MFMA32(kf[ds], *(LAS const bf16x8*)(qrd + 32 * t * QP + 32 * ds), sc[t]);
        }
        if (blk + 2 < nblk) load_blk(blk + 2, kf, vr);
        bf16x8 vf[2][2];
#pragma unroll
        for (int ks = 0; ks < 2; ++ks) { LAS const unsigned char* vb = vl + tr_off + 16 * ks * VP;
            vf[ks][0] = cat4(tr_read(vb), tr_read(vb + 8 * VP)); vf[ks][1] = cat4(tr_read(vb + 64), tr_read(vb + 8 * VP + 64)); }
#pragma unroll
        for (int t = 0; t < 2; ++t) {
            f32x16& s = sc[t];
            if (MODE == 0 && blk >= 8) {
                const int lb = blk - 8, j = lb >> 1, ch = lb & 1, c = t * 32 + ql;
                int cs = c - 8; cs = cs < 0 ? 0 : (cs > 48 ? 48 : cs);
                LAS const float* rrow = rl + (rs + j - r + 7) * 31 + (15 - c);
#pragma unroll
                for (int i = 0; i < 16; ++i) { const int kc = ch * 32 + crow(i, hi); const bool ok = (kc >= cs) && (kc < cs + 16);
                    const float bias = rrow[ok ? kc : c];
                    s[i] = ok ? (s[i] + bias) : -INFINITY; }
            } else if (MODE == 1 && blk >= 8) {
                const int rel = (kb_lo + blk - 8) - (2 * q64 + t);
                if (rel <= -4 || rel >= 4) {
#pragma unroll
                    for (int i = 0; i < 16; ++i) { const int kk = crow(i, hi); const bool ok = (rel == -4) ? (kk >= ql) : ((rel == 4) ? (kk <= ql) : false);
                        s[i] = ok ? s[i] : -INFINITY; }
                }
            }
            attn_softmax(s, T[t]);
#pragma unroll
            for (int ks = 0; ks < 2; ++ks) {
                const bf16x8 pf = pack8(s[8 * ks + 0], s[8 * ks + 1], s[8 * ks + 2], s[8 * ks + 3], s[8 * ks + 4], s[8 * ks + 5], s[8 * ks + 6], s[8 * ks + 7]);
                T[t].o0 = MFMA32(vf[ks][0], pf, T[t].o0); T[t].o1 = MFMA32(vf[ks][1], pf, T[t].o1);
            }
            __builtin_amdgcn_sched_barrier(0);
        }
    };
    bf16x8 kA[4], kB[4]; v4u vA[4], vB[4];
    load_blk(0, kA, vA); load_blk(1, kB, vB);
    for (int blk = 0; blk < nblk; blk += 2) { step(blk, kA, vA); if (blk + 1 < nblk) step(blk + 1, kB, vB); }
#pragma unroll
    for (int t = 0; t < 2; ++t) {
        float lt = T[t].lsum + __shfl_xor(T[t].lsum, 32);
        if (MODE == 1 || MODE == 3) lt += fexp2(sink[hq] * LOG2E - T[t].m);
        const float inv = frcp(lt);
        bf16_t* op = MIX + (size_t)(qrow0 + 32 * t + ql) * 1024 + ocol + 4 * hi;
#pragma unroll
        for (int g = 0; g < 4; ++g) {
            v2u w0, w1; w0.x = pk2(T[t].o0[4 * g] * inv, T[t].o0[4 * g + 1] * inv); w0.y = pk2(T[t].o0[4 * g + 2] * inv, T[t].o0[4 * g + 3] * inv);
            w1.x = pk2(T[t].o1[4 * g] * inv, T[t].o1[4 * g + 1] * inv); w1.y = pk2(T[t].o1[4 * g + 2] * inv, T[t].o1[4 * g + 3] * inv);
            *(v2u*)(op + 8 * g) = w0; *(v2u*)(op + 32 + 8 * g) = w1;
        }
    }
}
constexpr int GP = 144;
constexpr int G_V = 0, G_A = 64 * GP, G_B = 64 * GP + 32 * GP;
static_assert(G_B + 32 * GP <= WAVE_LDS, "gla LDS");

struct GlaCum { float cum[2][16]; float tot; };
__device__ __forceinline__ void gla_cum(const bf16_t* P, int row0, int hh, int dir, const float* __restrict__ a_up, const float* __restrict__ a_bias, int lane, GlaCum& C) {
    const int kk = lane & 31, hi = lane >> 5;
    const float* up = a_up + (size_t)dir * 16 * 128 + (size_t)(8 * hi) * 128 + hh * 32 + kk;
    const bf16x8 ub = pack8(up[0], up[128], up[256], up[384], up[512], up[640], up[768], up[896]);
    const float bias = a_bias[dir * 128 + hh * 32 + kk];
    float gs[2][4];
#pragma unroll
    for (int tt = 0; tt < 2; ++tt) {
        const bf16x8 al = *(const bf16x8*)(P + (size_t)(row0 + 32 * tt + kk) * PP + C_GAF + 16 * dir + 8 * hi);
        f32x16 z;
#pragma unroll
        for (int i = 0; i < 16; ++i) z[i] = 0.f;
        z = MFMA32(al, ub, z);
#pragma unroll
        for (int g = 0; g < 4; ++g) { float run = 0.f;
#pragma unroll
            for (int e = 0; e < 4; ++e) { const float zz = z[4 * g + e] + bias; const float ls = fminf(zz, 0.f) - flog(1.f + fexp(-fabsf(zz)));
                const float l = ls * (1.f / 16.f);
                if (dir == 0) { run += l; C.cum[tt][4 * g + e] = run; } else { C.cum[tt][4 * g + e] = run; run += l; } }
            gs[tt][g] = run; }
    }
    float off = 0.f;
#pragma unroll
    for (int tt = 0; tt < 2; ++tt)
#pragma unroll
        for (int g = 0; g < 4; ++g) { const float other = __shfl_xor(gs[tt][g], 32); const float mine = off + (hi ? other : 0.f);
#pragma unroll
            for (int e = 0; e < 4; ++e) C.cum[tt][4 * g + e] += mine;
            off += gs[tt][g] + other; }
    C.tot = off;
    if (dir == 1) {
#pragma unroll
        for (int tt = 0; tt < 2; ++tt)
#pragma unroll
            for (int r = 0; r < 16; ++r) C.cum[tt][r] = off - C.cum[tt][r];
    }
}
__device__ __forceinline__ void gla_ld_tc(const bf16_t* P, int row0, int col, int lane, float (&x)[2][16]) {
    const int kk = lane & 31, hi = lane >> 5;
#pragma unroll
    for (int tt = 0; tt < 2; ++tt)
#pragma unroll
        for (int r = 0; r < 16; ++r) x[tt][r] = bf1(P[(size_t)(row0 + 32 * tt + crow(r, hi)) * PP + col + kk]);
}
__device__ __forceinline__ void gla_st_img(LAS unsigned char* img, int lane, const float (&x)[2][16]) {
    const int kk = lane & 31, hi = lane >> 5;
#pragma unroll
    for (int tt = 0; tt < 2; ++tt)
#pragma unroll
        for (int g = 0; g < 4; ++g) { v2u w; w.x = pk2(x[tt][4 * g], x[tt][4 * g + 1]); w.y = pk2(x[tt][4 * g + 2], x[tt][4 * g + 3]);
            *(LAS v2u*)(img + kk * GP + (32 * tt + 8 * g + 4 * hi) * 2) = w; }
}
__device__ __forceinline__ void gla_stage_v(const bf16_t* P, int row0, int hh, LAS unsigned char* wl, int lane) {
#pragma unroll
    for (int i = 0; i < 8; ++i) { const int c = lane + 64 * i; const v4u v = *(const v4u*)(P + (size_t)(row0 + (c >> 3)) * PP + C_GV + hh * 64 + (c & 7) * 8);
        *(LAS v4u*)(wl + G_V + (c >> 3) * GP + (c & 7) * 16) = v; }
}
__device__ __forceinline__ int gla_row0(int b, int nc) { return nc < 4 ? (ML + b * CTXL + 64 * nc) : (b * SEQ + 64 * (nc - 4)); }

__device__ __forceinline__ void gla_local_item(const bf16_t* P, float* UST, float* DEC, int item, LAS unsigned char* wl, int lane,
                                               const float* __restrict__ a_up, const float* __restrict__ a_bias) {
    asm volatile("" : "+v"(lane));
    const int nc = item % 36, hh = (item / 36) & 3, b = item / 144;
    const int row0 = gla_row0(b, nc), kk = lane & 31, hi = lane >> 5;
    gla_stage_v(P, row0, hh, wl, lane);
    float kv[2][16]; gla_ld_tc(P, row0, C_GK + hh * 32, lane, kv);
#pragma unroll
    for (int dir = 0; dir < 2; ++dir) {
        GlaCum C; gla_cum(P, row0, hh, dir, a_up, a_bias, lane, C);
        float kd[2][16];
#pragma unroll
        for (int tt = 0; tt < 2; ++tt)
#pragma unroll
            for (int r = 0; r < 16; ++r) kd[tt][r] = kv[tt][r] * fexp(C.tot - C.cum[tt][r]);
        gla_st_img(wl + (dir == 0 ? G_A : G_B), lane, kd);
        if (hi == 0) DEC[((size_t)((b * 4 + hh) * 2 + dir) * 36 + nc) * 32 + kk] = fexp(C.tot);
    }
    const int trv = ((lane & 15) >> 2) * GP + (16 * ((lane >> 4) & 1) + 4 * (lane & 3)) * 2;
#pragma unroll
    for (int dir = 0; dir < 2; ++dir) {
        f32x16 u0, u1;
#pragma unroll
        for (int i = 0; i < 16; ++i) { u0[i] = 0.f; u1[i] = 0.f; }
        LAS const unsigned char* img = wl + (dir == 0 ? G_A : G_B);
#pragma unroll
        for (int s = 0; s < 4; ++s) {
            const bf16x8 kb = *(LAS const bf16x8*)(img + kk * GP + (16 * s + 8 * hi) * 2);
            LAS const unsigned char* vb = wl + G_V + trv + (16 * s + 8 * hi) * GP;
            const bf16x8 v0 = cat4(tr_read(vb), tr_read(vb + 4 * GP));
            const bf16x8 v1 = cat4(tr_read(vb + 64), tr_read(vb + 4 * GP + 64));
            u0 = MFMA32(v0, kb, u0); u1 = MFMA32(v1, kb, u1);
        }
        float* up = UST + ((size_t)((b * 4 + hh) * 2 + dir) * 36 + nc) * 2048 + kk;
#pragma unroll
        for (int i = 0; i < 16; ++i) { up[(size_t)crow(i, hi) * 32] = u0[i]; up[(size_t)(32 + crow(i, hi)) * 32] = u1[i]; }
    }
}

__device__ __forceinline__ void gla_prefix(float* UST, const float* DEC, int gid, bool dry) {
    const int bhd = gid >> 11, e = gid & 2047, k = e & 31, dir = bhd & 1;
    float* base = UST + (size_t)bhd * 36 * 2048 + e; const float* dec = DEC + (size_t)bhd * 36 * 32 + k;
    float s = 0.f;
#pragma unroll 4
    for (int ci = 0; ci < 36; ++ci) {
        const int sl = dir == 0 ? ci : (ci < 4 ? 3 - ci : 39 - ci);
        const float u = base[(size_t)sl * 2048], d = dec[sl * 32];
        if (!dry) base[(size_t)sl * 2048] = s;
        s = d * s + u;
    }
}

__device__ __forceinline__ void gla_out_item(const bf16_t* P, const float* UST, bf16_t* MIX, int item, LAS unsigned char* wl, int lane,
                                             const float* __restrict__ a_up, const float* __restrict__ a_bias, const float* __restrict__ gnorm) {
    const int nc = item % 36, hh = (item / 36) & 3, b = item / 144;
    const int row0 = gla_row0(b, nc), kk = lane & 31, hi = lane >> 5;
    gla_stage_v(P, row0, hh, wl, lane);
    f32x16 o[2][2];
#pragma unroll
    for (int a = 0; a < 2; ++a)
#pragma unroll
        for (int c = 0; c < 2; ++c)
#pragma unroll
            for (int i = 0; i < 16; ++i) o[a][c][i] = 0.f;
    const int g16 = (lane >> 4) & 1, qq = (lane & 15) >> 2, pp = lane & 3;
    const int tri = (8 * hi + qq) * GP + (16 * g16 + 4 * pp) * 2;
    const int trv = (4 * hi + qq) * GP + (16 * g16 + 4 * pp) * 2;
#pragma unroll
    for (int dir = 0; dir < 2; ++dir) {
        GlaCum C; gla_cum(P, row0, hh, dir, a_up, a_bias, lane, C);
#pragma unroll
        for (int tt = 0; tt < 2; ++tt) {
            float cum[16];
#pragma unroll
            for (int r = 0; r < 16; ++r) cum[r] = C.cum[tt][r];
#pragma unroll
            for (int g = 0; g < 4; ++g) {
                float xq[4], xk[4];
#pragma unroll
                for (int e = 0; e < 4; ++e) { const size_t ro = (size_t)(row0 + 32 * tt + 8 * g + 4 * hi + e) * PP + hh * 32 + kk;
                    xq[e] = bf1(P[ro + C_GQ]) * 0.17677669529663687f * fexp(cum[4 * g + e]); xk[e] = bf1(P[ro + C_GK]) * fexp(-cum[4 * g + e]); }
                v2u wq, wk; wq.x = pk2(xq[0], xq[1]); wq.y = pk2(xq[2], xq[3]); wk.x = pk2(xk[0], xk[1]); wk.y = pk2(xk[2], xk[3]);
                const int off = kk * GP + (32 * tt + 8 * g + 4 * hi) * 2;
                *(LAS v2u*)(wl + G_A + off) = wq; *(LAS v2u*)(wl + G_B + off) = wk;
                if (g & 1) asm volatile("" ::: "memory");
            }
        }
        const float* sp = UST + ((size_t)((b * 4 + hh) * 2 + dir) * 36 + nc) * 2048;
        bf16x8 sf[2][2];
#pragma unroll
        for (int vb = 0; vb < 2; ++vb)
#pragma unroll
            for (int s = 0; s < 2; ++s) { const float* p = sp + (size_t)(32 * vb + kk) * 32 + 16 * s + 8 * hi; const f32x4 a = *(const f32x4*)p, c = *(const f32x4*)(p + 4);
                sf[vb][s] = pack8(a.x, a.y, a.z, a.w, c.x, c.y, c.z, c.w); }
#pragma unroll
        for (int it = 0; it < 2; ++it) {
            bf16x8 qf[2];
#pragma unroll
            for (int s = 0; s < 2; ++s) { LAS const unsigned char* p = wl + G_A + tri + 16 * s * GP + 64 * it; qf[s] = cat4(tr_read(p), tr_read(p + 4 * GP)); }
#pragma unroll
            for (int vb = 0; vb < 2; ++vb)
#pragma unroll
                for (int s = 0; s < 2; ++s) o[vb][it] = MFMA32(sf[vb][s], qf[s], o[vb][it]);
#pragma unroll
            for (int jt = 0; jt < 2; ++jt) {
                if (dir == 0 ? (jt > it) : (jt < it)) continue;
                f32x16 sc;
#pragma unroll
                for (int i = 0; i < 16; ++i) sc[i] = 0.f;
#pragma unroll
                for (int s = 0; s < 2; ++s) { LAS const unsigned char* p = wl + G_B + tri + 16 * s * GP + 64 * jt; const bf16x8 kf = cat4(tr_read(p), tr_read(p + 4 * GP)); sc = MFMA32(kf, qf[s], sc); }
                if (jt == it) {
#pragma unroll
                    for (int i = 0; i < 16; ++i) { const int j = crow(i, hi); const bool ok = dir == 0 ? (j <= kk) : (j >= kk); sc[i] = ok ? sc[i] : 0.f; }
                }
#pragma unroll
                for (int s2 = 0; s2 < 2; ++s2) {
                    const bf16x8 pf = pack8(sc[8 * s2 + 0], sc[8 * s2 + 1], sc[8 * s2 + 2], sc[8 * s2 + 3], sc[8 * s2 + 4], sc[8 * s2 + 5], sc[8 * s2 + 6], sc[8 * s2 + 7]);
                    LAS const unsigned char* vp = wl + G_V + trv + (32 * jt + 16 * s2) * GP;
                    const bf16x8 v0 = cat4(tr_read(vp), tr_read(vp + 8 * GP));
                    const bf16x8 v1 = cat4(tr_read(vp + 64), tr_read(vp + 8 * GP + 64));
                    o[0][it] = MFMA32(v0, pf, o[0][it]); o[1][it] = MFMA32(v1, pf, o[1][it]);
                }
                __builtin_amdgcn_sched_barrier(0);
            }
            __builtin_amdgcn_sched_barrier(0);
        }
    }
#pragma unroll
    for (int it = 0; it < 2; ++it) {
        float ss = 0.f;
#pragma unroll
        for (int vb = 0; vb < 2; ++vb)
#pragma unroll
            for (int i = 0; i < 16; ++i) ss += o[vb][it][i] * o[vb][it][i];
        ss += __shfl_xor(ss, 32);
        const float rstd = __builtin_amdgcn_rsqf(ss * (1.f / 64.f) + NEPS);
        const size_t row = (size_t)(row0 + 32 * it + kk);
#pragma unroll
        for (int vb = 0; vb < 2; ++vb)
#pragma unroll
            for (int g = 0; g < 4; ++g) { const int v = 32 * vb + 8 * g + 4 * hi;
                const f32x4 gn = *(const f32x4*)(gnorm + v); const v2u gw = *(const v2u*)(P + row * PP + C_GG + hh * 64 + v);
                const float g0 = bflo(gw.x), g1 = bfhi(gw.x), g2 = bflo(gw.y), g3 = bfhi(gw.y);
                v2u w; w.x = pk2(o[vb][it][4 * g] * rstd * gn.x * silu_f(g0), o[vb][it][4 * g + 1] * rstd * gn.y * silu_f(g1));
                w.y = pk2(o[vb][it][4 * g + 2] * rstd * gn.z * silu_f(g2), o[vb][it][4 * g + 3] * rstd * gn.w * silu_f(g3));
                *(v2u*)(MIX + row * 1024 + hh * 64 + v) = w; }
    }
}
__device__ __forceinline__ void phase_r1(const float* const* in, float* xout, unsigned char* ws, LAS unsigned char* lds, int l, bool upd, int G, int tid, int wave, int lane, bool dry) {
    const float* x0 = in[0]; const float* ctx0 = in[2]; const float* gains = in[6] + (size_t)l * 4096; const float* wr = in[14] + (size_t)l * 1024 * 16;
    const float* mod = (const float*)(ws + WS_MOD) + (size_t)l * 9 * 6144;
    const bf16_t* Y = (const bf16_t*)(ws + WS_R2 + (size_t)MT * 2048); bf16_t* H = (bf16_t*)(ws + WS_H); bf16_t* XB = (bf16_t*)(ws + WS_XB);
    float* AFF = (float*)(ws + WS_AFF); float* AFFC = (float*)(ws + WS_AFFC);
    LAS float* V = (LAS float*)lds;
    LAS float* RT = V + 6144;
    __syncthreads();
    for (int i = tid; i < 16384; i += 512) { const int d = i >> 4, e = i & 15; RT[e * 1024 + d] = wr[i]; }
    for (int t = blockIdx.x; t < 256; t += G) {
        const int b = t >> 5;
        __syncthreads();
        for (int n = tid; n < 1024; n += 512) { const float gpa = gains[1024 + n], gpf = gains[2048 + n];
            V[n] = gpa * mod[b * 6144 + 2048 + n]; V[1024 + n] = gpf * (1.f + mod[b * 6144 + 4096 + n]); V[2048 + n] = mod[b * 6144 + 3072 + n];
            V[3072 + n] = gpa * mod[8 * 6144 + 2048 + n]; V[4096 + n] = gpf * (1.f + mod[8 * 6144 + 4096 + n]); V[5120 + n] = mod[8 * 6144 + 3072 + n]; }
        __syncthreads();
        const int nrows = upd ? 9 : 8;
#pragma unroll 1
        for (int i0 = 0; i0 < 9; i0 += 3) {
            f32x4 yv[3][4], xq[3][4];
#pragma unroll
            for (int k = 0; k < 3; ++k) { const int i = i0 + k; if (i < nrows) {
                const bool isc = (i == 8); const int row = isc ? (ML + 8 * t + wave) : (64 * t + 8 * wave + i);
                ld_row_bf16(Y + (size_t)row * 1024, lane, yv[k]);
                if (l == 0) ld_row_f32(isc ? (ctx0 + (size_t)(8 * t + wave) * 1024) : (x0 + (size_t)row * 1024), lane, xq[k]); else ld_row_bf16(XB + (size_t)row * 1024, lane, xq[k]); } }
#pragma unroll
            for (int k = 0; k < 3; ++k) { const int i = i0 + k; if (i < nrows) {
            const bool isc = (i == 8);
            const int row = isc ? (ML + 8 * t + wave) : (64 * t + 8 * wave + i);
            bf16_t* xd = (dry ? (bf16_t*)(ws + WS_R1) : XB) + (size_t)row * 1024;
            LAS const float* vv = V + (isc ? 3072 : 0);
            f32x4 (&y)[4] = yv[k]; f32x4 (&xv)[4] = xq[k]; f32x4 a[4];
            const float rsy = __builtin_amdgcn_rsqf(wave_sum(sumsq16(y)) * (1.f / 1024.f) + NEPS);
            ld_vec_lds(vv, lane, a);
#pragma unroll
            for (int j = 0; j < 4; ++j) xv[j] = xv[j] + a[j] * (y[j] * rsy);
            st_row_bf16(xd, lane, xv);
            const float rs1 = __builtin_amdgcn_rsqf(wave_sum(sumsq16(xv)) * (1.f / 1024.f) + NEPS);
            f32x4 s[4]; ld_vec_lds(vv + 1024, lane, a); ld_vec_lds(vv + 2048, lane, s);
#pragma unroll
            for (int j = 0; j < 4; ++j) xv[j] = xv[j] * rs1 * a[j] + s[j];
            st_row_bf16((dry ? (bf16_t*)(ws + WS_R2) : H) + (size_t)row * 1024, lane, xv);
            float lg[16];
#pragma unroll
            for (int e = 0; e < 16; ++e) { float p = 0.f;
#pragma unroll
                for (int j = 0; j < 4; ++j) { const f32x4 w = *(LAS const f32x4*)(RT + e * 1024 + 256 * j + 4 * lane); p += (xv[j].x * w.x + xv[j].y * w.y) + (xv[j].z * w.z + xv[j].w * w.w); }
                lg[e] = p;
                if ((e & 3) == 3) asm volatile("" ::: "memory"); }
#pragma unroll
            for (int i2 = 0; i2 < 8; ++i2) { const bool up = (lane & 32) != 0; const float keep = up ? lg[i2 + 8] : lg[i2], send = up ? lg[i2] : lg[i2 + 8]; lg[i2] = keep + __shfl_xor(send, 32); }
#pragma unroll
            for (int i2 = 0; i2 < 4; ++i2) { const bool up = (lane & 16) != 0; const float keep = up ? lg[i2 + 4] : lg[i2], send = up ? lg[i2] : lg[i2 + 4]; lg[i2] = keep + __shfl_xor(send, 16); }
#pragma unroll
            for (int i2 = 0; i2 < 2; ++i2) { const bool up = (lane & 8) != 0; const float keep = up ? lg[i2 + 2] : lg[i2], send = up ? lg[i2] : lg[i2 + 2]; lg[i2] = keep + __shfl_xor(send, 8); }
            { const bool up = (lane & 4) != 0; const float keep = up ? lg[1] : lg[0], send = up ? lg[0] : lg[1]; lg[0] = keep + __shfl_xor(send, 4); }
            float lgt = lg[0]; lgt += __shfl_xor(lgt, 1); lgt += __shfl_xor(lgt, 2);
            const int ex = ((lane >> 5) & 1) * 8 + ((lane >> 4) & 1) * 4 + ((lane >> 3) & 1) * 2 + ((lane >> 2) & 1);
            float mx = lgt;
            mx = fmaxf(mx, __shfl_xor(mx, 4)); mx = fmaxf(mx, __shfl_xor(mx, 8)); mx = fmaxf(mx, __shfl_xor(mx, 16)); mx = fmaxf(mx, __shfl_xor(mx, 32));
            const float pe = fexp(lgt - mx);
            float den = pe; den += __shfl_xor(den, 4); den += __shfl_xor(den, 8); den += __shfl_xor(den, 16); den += __shfl_xor(den, 32);
            const float mine = pe / den;
            if ((lane & 3) == 0) {
                if (isc) { const int cr = 8 * t + wave; AFFC[((size_t)(cr >> 8) * 16 + ex) * 256 + (cr & 255)] = mine; }
                else AFF[((size_t)(row >> 11) * 16 + ex) * 2048 + (row & 2047)] = mine;
            }
            } }
        }
    }
}

template <bool CTX>
__device__ __forceinline__ void topk_wave(unsigned char* ws, int item, int lane) {
    constexpr int NT = CTX ? 256 : 2048, CAP = CTX ? 32 : 256, PER = NT / 64;
    const int e = item & 15, b = item >> 4;
    const float* arow = (const float*)(ws + (CTX ? WS_AFFC : WS_AFF)) + (size_t)(b * 16 + e) * NT;
    float* gate = (float*)(ws + (CTX ? WS_GATEC : WS_GATE)) + (size_t)(b * 16 + e) * CAP;
    short* INV = (short*)(ws + WS_INV);
    int* rowidx = (int*)(ws + WS_ROWIDX) + (CTX ? ((128 + e) * 256 + b * 32) : ((b * 16 + e) * 256));
    unsigned v[PER];
#pragma unroll
    for (int i = 0; i < PER / 4; ++i) { const v4u q = *(const v4u*)(arow + lane * PER + 4 * i); v[4 * i] = q.x; v[4 * i + 1] = q.y; v[4 * i + 2] = q.z; v[4 * i + 3] = q.w; }
    unsigned T = 0;
    for (int bit = 29; bit >= 0; --bit) {
        const unsigned cand = T | (1u << bit); int c = 0;
#pragma unroll
        for (int i = 0; i < PER; ++i) c += __popcll(__ballot(v[i] >= cand));
        if (c >= CAP) T = cand;
    }
    int ngt = 0, cg = 0, ce = 0;
#pragma unroll
    for (int i = 0; i < PER; ++i) { ngt += __popcll(__ballot(v[i] > T)); cg += (v[i] > T) ? 1 : 0; ce += (v[i] == T) ? 1 : 0; }
    const int need = CAP - ngt;
    int pg = cg, pe = ce;
#pragma unroll
    for (int d = 1; d < 64; d <<= 1) { const int tg = __shfl_up(pg, d), te = __shfl_up(pe, d); if (lane >= d) { pg += tg; pe += te; } }
    pg -= cg; pe -= ce;
#pragma unroll
    for (int i = 0; i < PER; ++i) {
        const bool gt = v[i] > T, eq = v[i] == T;
        const bool sel = gt || (eq && pe < need);
        const int slot = pg + (pe < need ? pe : need);
        const int tok = lane * PER + i, grow = CTX ? (ML + b * CTXL + tok) : (b * SEQ + tok);
        if (sel) { rowidx[slot] = grow; gate[slot] = __uint_as_float(v[i]); }
        INV[(size_t)grow * 16 + e] = sel ? (short)slot : (short)-1;
        pg += gt ? 1 : 0; pe += eq ? 1 : 0;
    }
}

__device__ __forceinline__ void topk_wg2(unsigned char* ws, int item, LAS unsigned char* lds, int tid, int wave, int lane) {
    constexpr int CAP = 256;
    const int e = item & 15, b = item >> 4;
    const float* arow = (const float*)(ws + WS_AFF) + (size_t)(b * 16 + e) * 2048;
    float* gate = (float*)(ws + WS_GATE) + (size_t)(b * 16 + e) * CAP;
    short* INV = (short*)(ws + WS_INV);
    int* rowidx = (int*)(ws + WS_ROWIDX) + (b * 16 + e) * 256;
    LAS int* cnt = (LAS int*)lds;
    const v4u q = *(const v4u*)(arow + 4 * tid);
    const unsigned v[4] = {q.x, q.y, q.z, q.w};
    unsigned T = 0;
    __syncthreads();
    for (int bit = 29; bit >= 0; --bit) {
        const unsigned cand = T | (1u << bit); int c = 0;
#pragma unroll
        for (int i = 0; i < 4; ++i) c += __popcll(__ballot(v[i] >= cand));
        LAS int* cb = cnt + (bit & 1) * 8;
        if (lane == 0) cb[wave] = c;
        __syncthreads();
        int tot = 0;
#pragma unroll
        for (int w = 0; w < 8; ++w) tot += cb[w];
        if (tot >= CAP) T = cand;
    }
    int cg = 0, ce = 0, wg_ = 0, we_ = 0;
#pragma unroll
    for (int i = 0; i < 4; ++i) { wg_ += __popcll(__ballot(v[i] > T)); we_ += __popcll(__ballot(v[i] == T)); cg += (v[i] > T) ? 1 : 0; ce += (v[i] == T) ? 1 : 0; }
    if (lane == 0) { cnt[16 + wave] = wg_; cnt[24 + wave] = we_; }
    int pg = cg, pe = ce;
#pragma unroll
    for (int d = 1; d < 64; d <<= 1) { const int tg = __shfl_up(pg, d), te = __shfl_up(pe, d); if (lane >= d) { pg += tg; pe += te; } }
    pg -= cg; pe -= ce;
    __syncthreads();
    int ngt = 0;
#pragma unroll
    for (int w = 0; w < 8; ++w) { const int g_ = cnt[16 + w], e_ = cnt[24 + w]; ngt += g_; if (w < wave) { pg += g_; pe += e_; } }
    const int need = CAP - ngt;
#pragma unroll
    for (int i = 0; i < 4; ++i) {
        const bool gt = v[i] > T, eq = v[i] == T;
        const bool sel = gt || (eq && pe < need);
        const int slot = pg + (pe < need ? pe : need);
        const int grow = b * SEQ + 4 * tid + i;
        if (sel) { rowidx[slot] = grow; gate[slot] = __uint_as_float(v[i]); }
        INV[(size_t)grow * 16 + e] = sel ? (short)slot : (short)-1;
        pg += gt ? 1 : 0; pe += eq ? 1 : 0;
    }
}

__device__ __forceinline__ void phase_r5(const float* const* in, float* xout, unsigned char* ws, LAS unsigned char* lds, int l, bool upd, int G, int tid, int wave, int lane, bool dry) {
    const float* gains = in[6];
    const float* mod = (const float*)(ws + WS_MOD);
    const bf16_t* YE = (const bf16_t*)(ws + WS_R1); bf16_t* H = (bf16_t*)(ws + WS_H); bf16_t* XB = (bf16_t*)(ws + WS_XB);
    const float* GATE = (const float*)(ws + WS_GATE); const float* GATEC = (const float*)(ws + WS_GATEC); const short* INV = (const short*)(ws + WS_INV);
    LAS float* V = (LAS float*)lds;
    LAS int* CL = (LAS int*)(lds + 24576);
    for (int t = blockIdx.x; t < 256; t += G) {
        const int b = t >> 5;
        __syncthreads();
        for (int n = tid; n < 1024; n += 512) { const float gpf = gains[(size_t)l * 4096 + 3072 + n];
            V[n] = gpf * mod[((size_t)l * 9 + b) * 6144 + 5120 + n]; V[3072 + n] = gpf * mod[((size_t)l * 9 + 8) * 6144 + 5120 + n];
            if (l == 0) { const float gna = gains[4096 + n];
                V[1024 + n] = gna * (1.f + mod[((size_t)9 + b) * 6144 + 1024 + n]); V[2048 + n] = mod[((size_t)9 + b) * 6144 + n];
                V[4096 + n] = gna * (1.f + mod[((size_t)9 + 8) * 6144 + 1024 + n]); V[5120 + n] = mod[((size_t)9 + 8) * 6144 + n]; } }
        if (tid < (upd ? 72 : 64)) {
            const bool isc = tid >= 64; const int cr = 8 * t + (tid - 64);
            const int row = isc ? (ML + cr) : (64 * t + tid); const int bb = isc ? (cr >> 8) : b;
            const v4u i0 = *(const v4u*)(INV + (size_t)row * 16), i1 = *(const v4u*)(INV + (size_t)row * 16 + 8);
            const unsigned iw[8] = {i0.x, i0.y, i0.z, i0.w, i1.x, i1.y, i1.z, i1.w};
            float gv[16]; int sl[16];
#pragma unroll
            for (int e = 0; e < 16; ++e) { sl[e] = (int)(short)((iw[e >> 1] >> (16 * (e & 1))) & 0xffffu); const int s0 = sl[e] < 0 ? 0 : sl[e];
                gv[e] = isc ? GATEC[(size_t)(bb * 16 + e) * 32 + s0] : GATE[(size_t)(bb * 16 + e) * 256 + s0]; }
            int cnt = 0; LAS int* cl = CL + tid * 33;
#pragma unroll
            for (int e = 0; e < 16; ++e) if (sl[e] >= 0) { cl[1 + 2 * cnt] = isc ? ((128 + e) * 256 + bb * 32 + sl[e]) : ((bb * 16 + e) * 256 + sl[e]); cl[2 + 2 * cnt] = (int)__float_as_uint(gv[e]); ++cnt; }
            cl[0] = cnt;
        }
        __syncthreads();
        const int nrows = upd ? 9 : 8;
#pragma unroll 1
        for (int i0 = 0; i0 < 9; i0 += 3) {
            f32x4 xq[3][4];
#pragma unroll
            for (int k = 0; k < 3; ++k) { const int i = i0 + k; if (i < nrows) { const bool isc = (i == 8);
                ld_row_bf16(XB + (size_t)(isc ? (ML + 8 * t + wave) : (64 * t + 8 * wave + i)) * 1024, lane, xq[k]); } }
#pragma unroll
            for (int k = 0; k < 3; ++k) { const int i = i0 + k; if (i < nrows) {
            const bool isc = (i == 8);
            const int row = isc ? (ML + 8 * t + wave) : (64 * t + 8 * wave + i);
            LAS const float* vv = V + (isc ? 3072 : 0);
            LAS const int* cl = CL + (isc ? (64 + wave) : (8 * wave + i)) * 33;
            const int n = __builtin_amdgcn_readfirstlane(cl[0]);
            f32x4 acc[4];
#pragma unroll
            for (int j = 0; j < 4; ++j) acc[j] = (f32x4){0.f, 0.f, 0.f, 0.f};
            for (int j0 = 0; j0 < n; j0 += 4) {
                v2u raw[4][4]; float g[4];
#pragma unroll
                for (int q = 0; q < 4; ++q) {
                    if (j0 + q < n) { const int yr = __builtin_amdgcn_readfirstlane(cl[1 + 2 * (j0 + q)]); g[q] = __uint_as_float((unsigned)__builtin_amdgcn_readfirstlane(cl[2 + 2 * (j0 + q)]));
                        const bf16_t* yp = YE + (size_t)yr * 1024;
#pragma unroll
                        for (int j = 0; j < 4; ++j) raw[q][j] = *(const v2u*)(yp + 256 * j + 4 * lane); }
                    else { g[q] = 0.f;
#pragma unroll
                        for (int j = 0; j < 4; ++j) raw[q][j] = (v2u){0u, 0u}; }
                }
#pragma unroll
                for (int q = 0; q < 4; ++q)
#pragma unroll
                    for (int j = 0; j < 4; ++j) acc[j] += (f32x4){bflo(raw[q][j].x), bfhi(raw[q][j].x), bflo(raw[q][j].y), bfhi(raw[q][j].y)} * g[q];
            }
            const float rsm = __builtin_amdgcn_rsqf(wave_sum(sumsq16(acc)) * (1.f / 1024.f) + NEPS);
            f32x4 (&xv)[4] = xq[k]; f32x4 a[4]; ld_vec_lds(vv, lane, a);
#pragma unroll
            for (int j = 0; j < 4; ++j) xv[j] = xv[j] + a[j] * (acc[j] * rsm);
            if (l == 0) st_row_bf16((dry ? (bf16_t*)(ws + WS_R2) : XB) + (size_t)row * 1024, lane, xv);
            else st_row_f32((dry ? (float*)(ws + WS_R2) : xout) + (size_t)row * 1024, lane, xv);
            if (l == 0 && !dry) {
                const float rs2 = __builtin_amdgcn_rsqf(wave_sum(sumsq16(xv)) * (1.f / 1024.f) + NEPS);
                f32x4 s[4]; ld_vec_lds(vv + 1024, lane, a); ld_vec_lds(vv + 2048, lane, s);
#pragma unroll
                for (int j = 0; j < 4; ++j) xv[j] = xv[j] * rs2 * a[j] + s[j];
                st_row_bf16(H + (size_t)row * 1024, lane, xv);
            }
            } }
        }
    }
}
#ifndef MK_PER_PHASE
#define MK_PER_PHASE 0
#endif
constexpr int N_PHASES = 22;
struct Args { const float* in[18]; float* out; unsigned char* ws; int ph_lo, ph_hi; };
__device__ __forceinline__ const Args* kargs_opaque() {
    auto p = __builtin_amdgcn_kernarg_segment_ptr(); asm volatile("" : "+s"(p)); return (const Args*)p; }
#define PHASE_REGS() int tid = threadIdx.x; asm volatile("" : "+v"(tid)); const int lane = tid & 63, wave = __builtin_amdgcn_readfirstlane(tid >> 6); \
    const Args* A = kargs_opaque(); unsigned char* ws = A->ws; const int G = gridDim.x, bx = blockIdx.x; \
    const int vcu = (G % 8 == 0) ? (bx % 8) * (G / 8) + bx / 8 : bx; const int gw = vcu * NWAVES + wave, NGW = G * NWAVES; \
    LAS unsigned char* wl = lds + wave * WAVE_LDS; (void)gw; (void)NGW; (void)wl; (void)lane; (void)ws
#ifndef CONV_BUDGET
#define CONV_BUDGET 1
#endif
#ifndef PH_MASK
#define PH_MASK 0xFFFFFFFFu
#endif
#define EN(j) (((PH_MASK) >> (j)) & 1u)
#ifndef REP_MASK
#define REP_MASK 0u
#endif
#define REPS(j) ((((REP_MASK) >> (j)) & 1u) ? 2 : 1)
__global__ void __launch_bounds__(NWAVES * 64, 2) fwd_kernel(Args args) {
    extern __shared__ __attribute__((aligned(16))) unsigned char lds_raw[];
    LAS unsigned char* lds = (LAS unsigned char*)lds_raw;
    volatile LAS unsigned* MISC = (volatile LAS unsigned*)(lds + MISC_OFF);
    for (int u = threadIdx.x; u < (LDS_BYTES - LDSCTL_OFF) / 4; u += NWAVES * 64) ((LAS unsigned*)(lds + LDSCTL_OFF))[u] = 0u;
    __syncthreads();
    const int lo = args.ph_lo, hi = args.ph_hi;
    XcdBarrier bar; bar.bar = (unsigned*)(args.ws + WS_CTL) + CW_BAR; bar.x = 0; bar.st = nullptr;
    if (hi - lo > 1) bar = xcd_barrier_post((unsigned*)(args.ws + WS_CTL) + CW_BAR, MISC + 8);
#define IN(k) (lo <= (k) && (k) < hi)
#ifdef STAMP_A
#define STAMP(k) do { if (blockIdx.x == 0 && threadIdx.x == 0) ((unsigned long long*)(args.ws + WS_CTL))[1536 + (k)] = __builtin_amdgcn_s_memrealtime(); } while (0)
#else
#define STAMP(k) do { } while (0)
#endif
#define SEAM(k) do { if (IN((k) + 1)) { xcd_barrier(bar); if (REPS(12) == 2) xcd_barrier(bar); } STAMP((k) + 1); } while (0)
    STAMP(0);
    if (EN(0) && IN(0)) { for (int rep = 0; rep < REPS(0); ++rep) { PHASE_REGS(); phase_p0(A->in, ws, wl, gw, NGW, lane); } SEAM(0); }
    if (EN(1) && IN(1)) { for (int rep = 0; rep < REPS(1); ++rep) { PHASE_REGS(); phase_a0(A->in, ws, lds, G, tid, wave, lane); } SEAM(1); }
    for (int l = 0; l < 2; ++l) {
        const int base = 2 + 10 * l; const bool upd = (l == 0);
        if (EN(2) && IN(base + 0)) { for (int rep = 0; rep < REPS(2); ++rep) {
            PHASE_REGS();
            pg8::Gemm g{(const bf16_t*)(ws + WS_H), (const bf16_t*)(ws + WS_WIN) + (size_t)l * PP * 1024, MT, PP, 1024}; pg8::StaticOrder S; S.init(MT, PP, G, bx);
            pg8::EpiProj E{(bf16_t*)(ws + WS_R1), PP, (const pg8::f32x2*)(ws + WS_TAB), ML};
            pg8::gemm_phase<pg8::EpiProj, pg8::StaticOrder, true, true>(lds, g, S, E);
            if (!CONV_IN_P0) { const int nwg_ = (MT / 256) * (PP / 256); if ((nwg_ - bx + G - 1) / G < (nwg_ + G - 1) / G) conv_pull(A->in, ws, l, 1, 12 * CONV_BUDGET, (LAS float*)wl, lane); }
            }
            SEAM(base + 0);
        }
        if (EN(3) && IN(base + 1)) { for (int rep = 0; rep < REPS(3); ++rep) {
            PHASE_REGS();
            const bf16_t* PROJ = (const bf16_t*)(ws + WS_R1); bf16_t* MIX = (bf16_t*)(ws + WS_R2);
            const float* a_up = A->in[9] + (size_t)l * 2 * 16 * 128; const float* a_bias = A->in[10] + (size_t)l * 2 * 128;
            const float* rpb = A->in[12] + (size_t)l * 4 * 465; const float* sink = A->in[13] + (size_t)l * 8;
            const int n_cn = upd ? 128 : 0, n_cs = upd ? 256 : 0;
            const bool xmap = (G == 256);
            const int xcd = bx & 7, cu = bx >> 3;
            const int n_att = xmap ? 12 : 0;
            const int tail_total = (xmap ? 0 : 1024 + 2048) + 1152 + n_cn + n_cs;
            volatile LAS unsigned* qctr = (volatile LAS unsigned*)(lds + MISC_OFF) + 16 + l * 2 + rep;
            const int n_conv = 0, n_mix = (n_conv + 2) / 3 * 4;
            for (;;) {
                int j = 0; if (lane == 0) j = (int)__hip_atomic_fetch_add((LAS unsigned*)qctr, 1u, __ATOMIC_RELAXED, __HIP_MEMORY_SCOPE_WORKGROUP);
                j = __builtin_amdgcn_readfirstlane(j);
                if (j < n_mix) {
                    if ((j & 3) != 3) { const int ci = (j >> 2) * 3 + (j & 3), r = ci * G + bx; if (ci < n_conv && r < 12288 && !(rep + 1 < REPS(3))) expert_conv_item(A->in, ws, l, r, (LAS float*)wl, lane); continue; }
                    j = j >> 2;
                } else j = j - n_mix + n_mix / 4;
                int mode, item;
                if (j < n_att) {
                    if (j < 4) { mode = 0; item = (xcd * 4 + j) * 32 + cu; }
                    else { const int jj = j - 4, group = xcd * 2 + (jj >> 2), i = cu * 4 + (jj & 3); const int bb = group >> 1, hq = (group & 1) * 4 + (i >> 5); mode = 1; item = (i & 31) + 32 * hq + 256 * bb; }
                } else {
                    int r = (j - n_att) * G + bx;
                    if (r >= tail_total) break;
                    mode = -1; item = 0;
                    if (!xmap) { if (r < 1024) { mode = 0; item = r; } else if (r < 3072) { mode = 1; item = r - 1024; } r -= 3072; }
                    if (mode < 0) {
                        if (r < 1152) { if (rep + 1 < REPS(3)) continue; gla_local_item(PROJ, (float*)(ws + WS_UST), (float*)(ws + WS_DEC), r, wl, lane, a_up, a_bias); continue; } r -= 1152;
                        if (r < n_cs) { mode = 3; item = r; } else { mode = 2; item = r - n_cs; }
                    }
                }
                attn_item(mode, PROJ, MIX, item, wl, lane, rpb, sink, rep + 1 < REPS(3));
            }
            }
            SEAM(base + 1);
        }
        if (EN(4) && IN(base + 2)) { for (int rep = 0; rep < REPS(4); ++rep) {
            PHASE_REGS();
            for (int gid = bx * (NWAVES * 64) + tid; gid < 64 * 2048; gid += G * NWAVES * 64) gla_prefix((float*)(ws + WS_UST), (const float*)(ws + WS_DEC), gid, rep + 1 < REPS(4));
            }
            SEAM(base + 2);
        }
        if (EN(5) && IN(base + 3)) { for (int rep = 0; rep < REPS(5); ++rep) {
            PHASE_REGS();
            const float* a_up = A->in[9] + (size_t)l * 2 * 16 * 128; const float* a_bias = A->in[10] + (size_t)l * 2 * 128; const float* gnorm = A->in[11] + (size_t)l * 64;
            for (int it = gw; it < 1152; it += NGW) { if (!upd && (it % 36) < 4) continue;
                gla_out_item((const bf16_t*)(ws + WS_R1), (const float*)(ws + WS_UST), (bf16_t*)(ws + WS_R2), it, wl, lane, a_up, a_bias, gnorm); }
            }
            SEAM(base + 3);
        }
        if (EN(6) && IN(base + 4)) { for (int rep = 0; rep < REPS(6); ++rep) {
            PHASE_REGS();
            const int M2 = upd ? MT : ML;
            pg8::Gemm g{(const bf16_t*)(ws + WS_R2), (const bf16_t*)(ws + WS_WOUT) + (size_t)l * 1024 * 1024, M2, 1024, 1024}; pg8::StaticOrder S; S.init(M2, 1024, G, bx);
            pg8::EpiStore E{(bf16_t*)(ws + WS_R2 + (size_t)MT * 2048), 1024};
            pg8::gemm_phase<pg8::EpiStore, pg8::StaticOrder, true, true>(lds, g, S, E);
            if (!CONV_IN_P0) { const int nwg_ = (M2 / 256) * 4; if ((nwg_ - bx + G - 1) / G < (nwg_ + G - 1) / G) conv_pull(A->in, ws, l, 1, 3 * CONV_BUDGET, (LAS float*)wl, lane); }
            }
            SEAM(base + 4);
        }
        if (EN(7) && IN(base + 5)) { for (int rep = 0; rep < REPS(7); ++rep) { PHASE_REGS(); phase_r1(A->in, A->out, ws, lds, l, upd, G, tid, wave, lane, rep + 1 < REPS(7)); } SEAM(base + 5); }
        if (EN(8) && IN(base + 6)) { for (int rep = 0; rep < REPS(8); ++rep) {
            PHASE_REGS();
            if (!CONV_IN_P0) conv_pull(A->in, ws, l, l, 1 << 30, (LAS float*)wl, lane);
            for (int it = bx; it < 128; it += G) topk_wg2(ws, it, lds, tid, wave, lane);
            if (upd) { const int w2 = (bx >= 128 ? bx - 128 : bx + G - 128) * NWAVES + wave; for (int it = w2; it < 128; it += NGW) topk_wave<true>(ws, it, lane); }
            }
            SEAM(base + 6);
        }
        if (EN(9) && IN(base + 7)) { for (int rep = 0; rep < REPS(9); ++rep) {
            PHASE_REGS();
            pg8::Gemm g{(const bf16_t*)(ws + WS_H), (const bf16_t*)(ws + WS_WGU) + (size_t)l * 16 * 2048 * 1024, 0, 0, 1024, (const int*)(ws + WS_ROWIDX)}; pg8::MoeOrder S; S.init(upd ? 9 : 8, 8, G, bx);
            pg8::EpiSwiGLU E{(bf16_t*)(ws + WS_R2), 1024};
            pg8::gemm_phase<pg8::EpiSwiGLU, pg8::MoeOrder, true, true, true>(lds, g, S, E);
            if (!CONV_IN_P0) { const int nwg_ = 16 * (upd ? 9 : 8) * 8; if ((nwg_ - bx + G - 1) / G < (nwg_ + G - 1) / G) conv_pull(A->in, ws, l + 1, 1, 4 * CONV_BUDGET, (LAS float*)wl, lane); }
            }
            SEAM(base + 7);
        }
        if (EN(10) && IN(base + 8)) { for (int rep = 0; rep < REPS(10); ++rep) {
            PHASE_REGS();
            pg8::Gemm g{(const bf16_t*)(ws + WS_R2), (const bf16_t*)(ws + WS_WD) + (size_t)l * 16 * 1024 * 1024, 0, 0, 1024}; pg8::MoeOrder S; S.init(upd ? 9 : 8, 4, G, bx);
            pg8::EpiStore E{(bf16_t*)(ws + WS_R1), 1024};
            pg8::gemm_phase<pg8::EpiStore, pg8::MoeOrder, true, true>(lds, g, S, E);
            if (!CONV_IN_P0) { const int nwg_ = 16 * (upd ? 9 : 8) * 4; if ((nwg_ - bx + G - 1) / G < (nwg_ + G - 1) / G) conv_pull(A->in, ws, l + 1, 1, 3 * CONV_BUDGET, (LAS float*)wl, lane); }
            }
            SEAM(base + 8);
        }
        if (EN(11) && IN(base + 9)) { for (int rep = 0; rep < REPS(11); ++rep) { PHASE_REGS(); phase_r5(A->in, A->out, ws, lds, l, upd, G, tid, wave, lane, rep + 1 < REPS(11)); } SEAM(base + 9); }
    }
#ifdef STAMP_A
    if (blockIdx.x == 0 && threadIdx.x == 0) { const unsigned long long* st_ = (const unsigned long long*)(args.ws + WS_CTL) + 1536; const float d_ = (float)(st_[STAMP_B] - st_[STAMP_A]); args.out[0] = 200.f * floorf(d_ / 200.f + 0.5f); }
#endif
#undef IN
#undef SEAM
}

extern "C" void kernel_launch(void* const* d_in, const int* in_sizes, int n_in, void* d_out, int out_size, void* d_ws, size_t ws_size, hipStream_t stream) {
    static int grid = 0;
    if (grid == 0) {
        if (n_in != 18 || out_size != ML * DM || ws_size < WS_END) { fprintf(stderr, "kernel_launch: unexpected sizes: n_in %d out %d ws %zu (need %zu)\n", n_in, out_size, ws_size, (size_t)WS_END); grid = -1; return; }
        int dev = 0, cus = 0, per_cu = 0;
        if (hipGetDevice(&dev) != hipSuccess || hipDeviceGetAttribute(&cus, hipDeviceAttributeMultiprocessorCount, dev) != hipSuccess) { grid = -1; return; }
        if (hipFuncSetAttribute((const void*)fwd_kernel, hipFuncAttributeMaxDynamicSharedMemorySize, LDS_BYTES) != hipSuccess) { fprintf(stderr, "kernel_launch: hipFuncSetAttribute failed\n"); grid = -1; return; }
        if (hipOccupancyMaxActiveBlocksPerMultiprocessor(&per_cu, (const void*)fwd_kernel, NWAVES * 64, LDS_BYTES) != hipSuccess || per_cu < 1) { fprintf(stderr, "kernel_launch: occupancy query says %d blocks per CU\n", per_cu); (void)hipGetLastError(); grid = -1; return; }
        grid = cus;
    }
    if (grid < 0) return;
    (void)hipMemsetAsync((char*)d_ws + WS_CTL, 0, CTL_ZERO_BYTES, stream);
    Args a{};
    for (int i = 0; i < 18; ++i) a.in[i] = (const float*)d_in[i];
    a.out = (float*)d_out; a.ws = (unsigned char*)d_ws;
#if MK_PER_PHASE
    for (int p = 0; p < N_PHASES; ++p) { a.ph_lo = p; a.ph_hi = p + 1; hipLaunchKernelGGL(fwd_kernel, dim3(grid), dim3(NWAVES * 64), LDS_BYTES, stream, a); }
#else
    a.ph_lo = 0; a.ph_hi = N_PHASES;
    void* kargs[] = {&a};
    hipError_t e = hipLaunchCooperativeKernel((const void*)fwd_kernel, dim3(grid), dim3(NWAVES * 64), kargs, LDS_BYTES, stream);
    if (e != hipSuccess) fprintf(stderr, "kernel_launch: cooperative launch failed: %s (grid %d)\n", hipGetErrorString(e), grid);
#endif
}
```

```cpp
#include <hip/hip_runtime.h>
#include <cstdio>
#include <cstdint>
#include <cmath>

namespace pg8 {
#define PG8_LAS __attribute__((address_space(3)))
typedef unsigned short bf16_t;
typedef short bf16x8 __attribute__((ext_vector_type(8)));
typedef float f32x4 __attribute__((ext_vector_type(4)));
typedef unsigned u32x4 __attribute__((ext_vector_type(4)));
constexpr int BM = 256, BK = 64, HALF = 128, HTB = HALF * BK * 2  , STAGE_BYTES = 8 * HTB, NXCD = 8, WGM = 8;

__host__ __device__ __forceinline__ int lds_byte(int r, int c) { const int st = (r >> 4) * 2 + (c >> 5), rr = r & 15, cc = c & 31, ob = rr * 64 + cc * 2; return st * 1024 + (ob ^ (((ob >> 9) & 1) << 5)); }
__host__ __device__ __forceinline__ void stage_rc(int b, int& R, int& C) { const int st = b / 1024, sb = b % 1024, swz = sb ^ (((sb >> 9) & 1) << 5); R = (st >> 1) * 16 + swz / 64; C = (st & 1) * 32 + (swz % 64) / 2; }
__host__ __device__ __forceinline__ int perm32(int rho) { const int n = rho >> 4, i = rho & 15; return 8 * (i >> 2) + 4 * n + (i & 3); }

struct Unit { int pm, pn, pb; };
struct Gemm { const bf16_t* A; const bf16_t* Bt; int M, N, K; const int* rowidx; };

struct StaticOrder {
    int nM, nN, nwg, G, c;
    __host__ __device__ void init(int M, int N, int G_, int c_) { nM = M / BM; nN = N / BM; nwg = nM * nN; G = G_; c = c_; }
    __host__ __device__ bool next(int i, Unit& u) const {
        const long L = (long)i * G + c; if (L >= nwg) return false;
        int wgid = (int)L; { const int q = nwg / NXCD, r = nwg % NXCD, xcd = wgid % NXCD, off = wgid / NXCD; wgid = (xcd < r ? xcd * (q + 1) : r * (q + 1) + (xcd - r) * q) + off; }
        const int nig = WGM * nN, gid = wgid / nig, fm = gid * WGM, gsz = (nM - fm) < WGM ? (nM - fm) : WGM;
        u.pm = fm + ((wgid % nig) % gsz); u.pn = (wgid % nig) / gsz; u.pb = u.pn; return true;
    }
    __device__ __forceinline__ void a_ready(const Unit&) const {}
    __device__ __forceinline__ void done(const Unit&) const {}
};

__device__ __forceinline__ unsigned cvt_pk_bf16(float lo, float hi) { unsigned r; asm volatile("v_cvt_pk_bf16_f32 %0, %1, %2" : "=v"(r) : "v"(lo), "v"(hi)); return r; }
typedef float f32x2 __attribute__((ext_vector_type(2)));
#ifndef EPI_WT
#define EPI_WT 0
#endif
__device__ __forceinline__ void st16(bf16_t* base, size_t elem_off, u32x4 w) {
#if EPI_WT
    const __amdgpu_buffer_rsrc_t r = __builtin_amdgcn_make_buffer_rsrc((void*)base, 0, 0x7fffffff, 0x00020000);
    __builtin_amdgcn_raw_buffer_store_b128(w, r, (unsigned)(elem_off * 2), 0, 16);
#else
    *(u32x4*)(base + elem_off) = w;
#endif
}
struct EpiStore {
    static constexpr bool PERM = true, AFTER_DRAIN = false;
    bf16_t* O; int ldc;
    __device__ __forceinline__ void operator()(const f32x4 (&acc)[2][2][4][2], const Unit& u, int wr, int wc, int fr, int fq) const {
        const int row0 = u.pm * BM + wr * 64 + fr, col0 = u.pn * BM + wc * 32 + 8 * fq;
#pragma unroll
        for (int ai = 0; ai < 2; ++ai)
#pragma unroll
            for (int m = 0; m < 4; ++m) { bf16_t* rowp = O + (size_t)(row0 + ai * HALF + m * 16) * ldc + col0;
#pragma unroll
                for (int bj = 0; bj < 2; ++bj) { const f32x4 v0 = acc[ai][bj][m][0], v1 = acc[ai][bj][m][1];
                    u32x4 w; w.x = cvt_pk_bf16(v0[0], v0[1]); w.y = cvt_pk_bf16(v0[2], v0[3]); w.z = cvt_pk_bf16(v1[0], v1[1]); w.w = cvt_pk_bf16(v1[2], v1[3]);
                    st16(O, (size_t)(rowp - O) + bj * HALF, w); } }
    }
};
struct EpiProj {
    static constexpr bool PERM = true, AFTER_DRAIN = false;
    bf16_t* O; int ldc; const f32x2* tab; int ml;
    __device__ __forceinline__ void operator()(const f32x4 (&acc)[2][2][4][2], const Unit& u, int wr, int wc, int fr, int fq) const {
        const int row0 = u.pm * BM + wr * 64 + fr;
        const bool latent = (u.pm * BM) < ml;
#pragma unroll
        for (int bj = 0; bj < 2; ++bj) {
            const int c0 = u.pn * BM + bj * HALF + wc * 32;
            const bool rope = latent && ((c0 >= 928 && c0 < 1056) || (c0 >= 1824 && c0 < 2336));
            const bool rowhalf = (((c0 - 32) & 63) == 0);
            const bool qscale = (c0 >= 1568 && c0 < 2336);
#pragma unroll
            for (int ai = 0; ai < 2; ++ai)
#pragma unroll
                for (int m = 0; m < 4; ++m) {
                    const int row = row0 + ai * HALF + m * 16;
                    f32x4 v0 = acc[ai][bj][m][0], v1 = acc[ai][bj][m][1];
                    if (rope) {
                        const int t = row & 2047, pos = rowhalf ? (t >> 6) : (t & 63);
                        const f32x2* tp = tab + pos * 16 + 8 * (fq & 1);
                        const float sg = (fq < 2) ? -1.f : 1.f;
#pragma unroll
                        for (int e = 0; e < 4; ++e) {
                            const float x0 = v0[e], x1 = v1[e];
                            const float p0 = __shfl_xor(x0, 32), p1 = __shfl_xor(x1, 32);
                            const f32x2 c0s = tp[e], c1s = tp[4 + e];
                            v0[e] = x0 * c0s.x + sg * p0 * c0s.y; v1[e] = x1 * c1s.x + sg * p1 * c1s.y;
                        }
                    }
                    if (qscale) { v0 = v0 * 0.18033688011112042f; v1 = v1 * 0.18033688011112042f; }
                    u32x4 w; w.x = cvt_pk_bf16(v0[0], v0[1]); w.y = cvt_pk_bf16(v0[2], v0[3]); w.z = cvt_pk_bf16(v1[0], v1[1]); w.w = cvt_pk_bf16(v1[2], v1[3]);
                    st16(O, (size_t)row * ldc + c0 + 8 * fq, w);
                }
        }
    }
};
struct EpiSwiGLU {
    static constexpr bool PERM = true, AFTER_DRAIN = false;
    bf16_t* O; int ldc;
    __device__ __forceinline__ void operator()(const f32x4 (&acc)[2][2][4][2], const Unit& u, int wr, int wc, int fr, int fq) const {
        const int row0 = u.pm * BM + wr * 64 + fr, col0 = u.pn * HALF + wc * 32 + 8 * fq;
#pragma unroll
        for (int ai = 0; ai < 2; ++ai)
#pragma unroll
            for (int m = 0; m < 4; ++m) {
                float h[8];
#pragma unroll
                for (int n = 0; n < 2; ++n)
#pragma unroll
                    for (int e = 0; e < 4; ++e) { const float g = acc[ai][0][m][n][e], up = acc[ai][1][m][n][e];
                        h[n * 4 + e] = g * __builtin_amdgcn_rcpf(1.f + __builtin_amdgcn_exp2f(-1.4426950408889634f * g)) * up; }
                u32x4 w; w.x = cvt_pk_bf16(h[0], h[1]); w.y = cvt_pk_bf16(h[2], h[3]); w.z = cvt_pk_bf16(h[4], h[5]); w.w = cvt_pk_bf16(h[6], h[7]);
                st16(O, (size_t)(row0 + ai * HALF + m * 16) * ldc + col0, w);
            }
    }
};
struct MoeOrder {
    int npe, nN, nwg, G, c;
    __host__ __device__ void init(int npe_, int nN_, int G_, int c_) { npe = npe_; nN = nN_; nwg = 16 * npe * nN; G = G_; c = c_; }
    __host__ __device__ bool next(int i, Unit& u) const {
        const long L = (long)i * G + c; if (L >= nwg) return false;
        int wgid = (int)L; { const int q = nwg / NXCD, r = nwg % NXCD, xcd = wgid % NXCD, off = wgid / NXCD; wgid = (xcd < r ? xcd * (q + 1) : r * (q + 1) + (xcd - r) * q) + off; }
        const int per = npe * nN, e = wgid / per, rem = wgid % per, j = rem / nN, pn = rem % nN;
        u.pm = (j < 8) ? (j * 16 + e) : (128 + e); u.pn = pn; u.pb = e * nN + pn; return true;
    }
    __device__ __forceinline__ void a_ready(const Unit&) const {}
    __device__ __forceinline__ void done(const Unit&) const {}
};

template <class Epi, class Sched, bool ALIGN_EPI = false, bool SP2 = false, bool GATHER = false>
__device__ __forceinline__ void gemm_phase(PG8_LAS unsigned char* lds, const Gemm g, const Sched& S, const Epi& E) {
    int tid_ = threadIdx.x; asm volatile("" : "+v"(tid_));
    const int tid = tid_, wid = __builtin_amdgcn_readfirstlane(tid >> 6), lane = tid & 63, wr = wid >> 2, wc = wid & 3, fr = lane & 15, fq = lane >> 4;
    const int K = g.K, nt = K / BK;
    static_assert(!GATHER || SP2, "GATHER is wired into the SP2 loop only");
    unsigned voffA[2], voffB[2]; int RA[2], CA[2]; unsigned vAc[2][2], vAn[2][2];
#pragma unroll
    for (int i = 0; i < 2; ++i) { int R, C; stage_rc(tid * 16 + i * 8192, R, C); const int Rb = Epi::PERM ? ((R & ~31) + perm32(R & 31)) : R; RA[i] = R; CA[i] = C;
        voffA[i] = (unsigned)(R * K + C) * 2u; voffB[i] = (unsigned)(Rb * K + C) * 2u; vAc[0][i] = vAc[1][i] = vAn[0][i] = vAn[1][i] = 0u; }
    auto load_idx = [&](int pm, unsigned (&v)[2][2]) {
#pragma unroll
        for (int h = 0; h < 2; ++h)
#pragma unroll
            for (int i = 0; i < 2; ++i) v[h][i] = (unsigned)(g.rowidx[pm * BM + h * HALF + RA[i]] * K + CA[i]) * 2u;
    };
    const size_t kstep = (size_t)(BK * 2);
    const size_t hstep = (size_t)HALF * K * 2;
    const size_t tstep = 2 * hstep;
    const unsigned ldsw = (unsigned)wid * 1024u;
    const int aoff = lds_byte(wr * 64 + fr, fq * 8), boff = lds_byte(wc * 32 + fr, fq * 8);
#define PG8_SA(b, h) (((b) * 2 + (h)) * HTB)
#define PG8_SB(b, h) ((4 + (b) * 2 + (h)) * HTB)
#define PG8_STAGE(bufoff, gbase, voff) do { _Pragma("unroll") for (int _i = 0; _i < 2; ++_i) \
        __builtin_amdgcn_global_load_lds((const unsigned*)((const char*)(gbase) + (voff)[_i]), (PG8_LAS unsigned*)(lds + (bufoff) + ldsw + _i * 8192), 16, 0, 0); } while (0)
#define PG8_STAGE_A(bufoff, gbase, h, nx) do { if constexpr (GATHER) { const unsigned v_[2] = { (nx) ? vAn[h][0] : vAc[h][0], (nx) ? vAn[h][1] : vAc[h][1] }; PG8_STAGE(bufoff, gbase, v_); } \
        else { PG8_STAGE(bufoff, (gbase) + (h) * hstep, voffA); } } while (0)
#define PG8_LDA(dst, b, h) do { _Pragma("unroll") for (int m = 0; m < 4; ++m) _Pragma("unroll") for (int k = 0; k < 2; ++k) dst[m][k] = *(const PG8_LAS bf16x8*)(lds + PG8_SA(b, h) + aoff + m * 2048 + k * 1024); } while (0)
#define PG8_LDB(dst, b, h) do { _Pragma("unroll") for (int n = 0; n < 2; ++n) _Pragma("unroll") for (int k = 0; k < 2; ++k) dst[n][k] = *(const PG8_LAS bf16x8*)(lds + PG8_SB(b, h) + boff + n * 2048 + k * 1024); } while (0)
#define PG8_MMA(ai, bj, At, Bt) do { __builtin_amdgcn_s_setprio(1); _Pragma("unroll") for (int m = 0; m < 4; ++m) _Pragma("unroll") for (int n = 0; n < 2; ++n) _Pragma("unroll") for (int k = 0; k < 2; ++k) \
        acc[ai][bj][m][n] = __builtin_amdgcn_mfma_f32_16x16x32_bf16(Bt[n][k], At[m][k], acc[ai][bj][m][n], 0, 0, 0); __builtin_amdgcn_s_setprio(0); } while (0)
#define PG8_WAIT_V(n) asm volatile("s_waitcnt vmcnt(" #n ")" ::: "memory")
#define PG8_WAIT_L(n) asm volatile("s_waitcnt lgkmcnt(" #n ")" ::: "memory")
#define PG8_BAR __builtin_amdgcn_s_barrier()
#define PG8_SCHED __builtin_amdgcn_sched_barrier(0)
    Unit cur, nxt; int ui = 0;
    if (!S.next(0, cur)) return;
    f32x4 acc[2][2][4][2];
#pragma unroll
    for (int a = 0; a < 2; ++a)
#pragma unroll
        for (int b = 0; b < 2; ++b)
#pragma unroll
            for (int m = 0; m < 4; ++m)
#pragma unroll
                for (int n = 0; n < 2; ++n) acc[a][b][m][n] = (f32x4){0.f, 0.f, 0.f, 0.f};
    bf16x8 At[4][2], B0[2][2], B1[2][2];
    const char* cA = (const char*)g.A + (GATHER ? (size_t)0 : (size_t)cur.pm * tstep); const char* cB = (const char*)g.Bt + (size_t)cur.pb * tstep;
    if constexpr (GATHER) load_idx(cur.pm, vAc);
    S.a_ready(cur);
    if constexpr (SP2) {
        PG8_STAGE(PG8_SB(0, 0), cB, voffB); PG8_STAGE(PG8_SB(0, 1), cB + hstep, voffB); PG8_STAGE_A(PG8_SA(0, 0), cA, 0, false); PG8_STAGE_A(PG8_SA(0, 1), cA, 1, false);
        if (wr == 1) PG8_BAR;
        PG8_WAIT_V(2); PG8_BAR;
        PG8_STAGE(PG8_SB(1, 0), cB + kstep, voffB); PG8_STAGE_A(PG8_SA(1, 0), cA + kstep, 0, false); PG8_STAGE(PG8_SB(1, 1), cB + hstep + kstep, voffB);
        PG8_WAIT_V(6); PG8_BAR;
    } else {
        PG8_STAGE(PG8_SB(0, 0), cB, voffB); PG8_STAGE(PG8_SA(0, 0), cA, voffA); PG8_STAGE(PG8_SB(0, 1), cB + hstep, voffB); PG8_STAGE(PG8_SA(0, 1), cA + hstep, voffA);
        if (wr == 1) PG8_BAR;
        PG8_WAIT_V(4); PG8_BAR;
        PG8_STAGE(PG8_SB(1, 0), cB + kstep, voffB); PG8_STAGE(PG8_SA(1, 0), cA + kstep, voffA); PG8_STAGE(PG8_SB(1, 1), cB + hstep + kstep, voffB);
        PG8_WAIT_V(6); PG8_BAR;
    }
    for (;;) {
        const bool has_next = S.next(ui + 1, nxt);
        if constexpr (GATHER) { if (has_next) {
#pragma unroll
            for (int h = 0; h < 2; ++h)
#pragma unroll
                for (int i = 0; i < 2; ++i) __builtin_amdgcn_global_load_lds((const unsigned*)(g.rowidx + nxt.pm * BM + h * HALF + RA[i]), (PG8_LAS unsigned*)(lds + STAGE_BYTES + (h * 2 + i) * 2048 + wid * 256), 4, 0, 0); } }
        const char* nA = (has_next && !GATHER) ? (const char*)g.A + (size_t)nxt.pm * tstep : cA; const char* nB = has_next ? (const char*)g.Bt + (size_t)nxt.pb * tstep : cB;
        for (int t = 0; t < nt; t += 2) {
            const bool last = (t == nt - 2); const bool nxu = last && has_next; (void)nxu;
            if constexpr (GATHER) { if (nxu) {
#pragma unroll
                for (int h = 0; h < 2; ++h)
#pragma unroll
                    for (int i = 0; i < 2; ++i) { const int ix = *(const PG8_LAS int*)(lds + STAGE_BYTES + (h * 2 + i) * 2048 + tid * 4); vAn[h][i] = (unsigned)(ix * K + CA[i]) * 2u; } } }
            const char* a1 = cA + (size_t)(t + 1) * kstep;
            const char* a2 = last ? nA : cA + (size_t)(t + 2) * kstep; const char* b2 = last ? nB : cB + (size_t)(t + 2) * kstep;
            const char* a3 = a2 + kstep; const char* b3 = b2 + kstep;
            if (last && has_next) S.a_ready(nxt);
            if constexpr (SP2) {
            PG8_LDB(B0, 0, 0); PG8_LDB(B1, 0, 1); PG8_SCHED; PG8_LDA(At, 0, 0); PG8_STAGE_A(PG8_SA(1, 1), a1, 1, false);
            PG8_WAIT_V(8); PG8_WAIT_L(0); PG8_BAR; PG8_MMA(0, 0, At, B0); PG8_MMA(0, 1, At, B1); PG8_BAR; PG8_SCHED;
            PG8_LDA(At, 0, 1); PG8_STAGE(PG8_SB(0, 0), b2, voffB); PG8_STAGE(PG8_SB(0, 1), b2 + hstep, voffB); PG8_STAGE_A(PG8_SA(0, 0), a2, 0, nxu);
            PG8_WAIT_V(8); PG8_WAIT_L(0); PG8_BAR; PG8_MMA(1, 0, At, B0); PG8_MMA(1, 1, At, B1); PG8_BAR; PG8_SCHED;
            PG8_LDB(B0, 1, 0); PG8_LDB(B1, 1, 1); PG8_SCHED; PG8_LDA(At, 1, 0); PG8_STAGE_A(PG8_SA(0, 1), a2, 1, nxu);
            PG8_WAIT_V(8); PG8_WAIT_L(0); PG8_BAR; PG8_MMA(0, 0, At, B0); PG8_MMA(0, 1, At, B1); PG8_BAR; PG8_SCHED;
            PG8_LDA(At, 1, 1); PG8_STAGE(PG8_SB(1, 0), b3, voffB); PG8_STAGE(PG8_SB(1, 1), b3 + hstep, voffB); PG8_STAGE_A(PG8_SA(1, 0), a3, 0, nxu);
            PG8_WAIT_V(8); PG8_WAIT_L(0); PG8_BAR; PG8_MMA(1, 0, At, B0); PG8_MMA(1, 1, At, B1); PG8_BAR; PG8_SCHED;
            } else {
            PG8_LDB(B0, 0, 0); PG8_SCHED; PG8_LDA(At, 0, 0); PG8_STAGE(PG8_SA(1, 1), a1 + hstep, voffA);
            PG8_WAIT_L(8); PG8_BAR; PG8_WAIT_L(0); PG8_MMA(0, 0, At, B0); PG8_BAR; PG8_SCHED;
            PG8_LDB(B1, 0, 1); PG8_STAGE(PG8_SB(0, 0), b2, voffB);
            PG8_BAR; PG8_WAIT_L(0); PG8_MMA(0, 1, At, B1); PG8_BAR;
            PG8_LDA(At, 0, 1); PG8_STAGE(PG8_SA(0, 0), a2, voffA);
            PG8_BAR; PG8_WAIT_L(0); PG8_MMA(1, 0, At, B0); PG8_BAR; PG8_SCHED;
            PG8_STAGE(PG8_SB(0, 1), b2 + hstep, voffB);
            PG8_WAIT_V(6); PG8_BAR; PG8_MMA(1, 1, At, B1); PG8_BAR;
            PG8_LDB(B0, 1, 0); PG8_SCHED; PG8_LDA(At, 1, 0); PG8_STAGE(PG8_SA(0, 1), a2 + hstep, voffA);
            PG8_WAIT_L(8); PG8_BAR; PG8_WAIT_L(0); PG8_MMA(0, 0, At, B0); PG8_BAR; PG8_SCHED;
            PG8_LDB(B1, 1, 1); PG8_STAGE(PG8_SB(1, 0), b3, voffB);
            PG8_BAR; PG8_WAIT_L(0); PG8_MMA(0, 1, At, B1); PG8_BAR;
            PG8_LDA(At, 1, 1); PG8_STAGE(PG8_SA(1, 0), a3, voffA);
            PG8_BAR; PG8_WAIT_L(0); PG8_MMA(1, 0, At, B0); PG8_BAR; PG8_SCHED;
            PG8_STAGE(PG8_SB(1, 1), b3 + hstep, voffB);
            PG8_WAIT_V(6); PG8_BAR; PG8_MMA(1, 1, At, B1); PG8_BAR;
            }
        }
        if constexpr (ALIGN_EPI) { if (wr == 0) PG8_BAR; }
        if constexpr (!Epi::AFTER_DRAIN) { E(acc, cur, wr, wc, fr, fq); S.done(cur); }
        if (!has_next) break;
#pragma unroll
        for (int a = 0; a < 2; ++a)
#pragma unroll
            for (int b = 0; b < 2; ++b)
#pragma unroll
                for (int m = 0; m < 4; ++m)
#pragma unroll
                    for (int n = 0; n < 2; ++n) acc[a][b][m][n] = (f32x4){0.f, 0.f, 0.f, 0.f};
        cur = nxt; cA = nA; cB = nB; ++ui;
        if constexpr (GATHER) {
#pragma unroll
            for (int h = 0; h < 2; ++h) { vAc[h][0] = vAn[h][0]; vAc[h][1] = vAn[h][1]; } }
        if constexpr (ALIGN_EPI) { if (wr == 1) PG8_BAR; }
    }
    PG8_WAIT_V(0);
    if constexpr (!ALIGN_EPI) { if (wr == 0) PG8_BAR; }
    PG8_BAR;
    if constexpr (Epi::AFTER_DRAIN) { E.fused(acc, cur, wr, wc, fr, fq, lds, wid, lane); S.done(cur); }
#undef PG8_SA
#undef PG8_SB
#undef PG8_STAGE
#undef PG8_STAGE_A
#undef PG8_LDA
#undef PG8_LDB
#undef PG8_MMA
#undef PG8_WAIT_V
#undef PG8_WAIT_L
#undef PG8_BAR
#undef PG8_SCHED
}
}
constexpr int NB = 8, SEQ = 2048, DM = 1024, CTXL = 256, ML = NB * SEQ, MC = NB * CTXL, MT = ML + MC;
constexpr int PP = 2560;
constexpr int INW = 2336;
constexpr int C_GK = 0, C_GV = 128, C_GAF = 384, C_GAB = 400, C_NK = 416, C_NV = 672, C_SK = 928, C_SV = 1056, C_GQ = 1184, C_GG = 1312, C_NQ = 1568, C_SQ = 1824;
constexpr int NWAVES = 8;
constexpr float NEPS = 1e-6f;
constexpr float LOG2E = 1.4426950408889634f;

constexpr size_t MiB = 1u << 20;
constexpr size_t WS_CTL = 0, CTL_ZERO_BYTES = 65536;
constexpr size_t WS_TAB = 1 * MiB;
constexpr size_t WS_MOD = 1 * MiB + 65536;
constexpr size_t WS_MODP = 2 * MiB;
constexpr size_t WS_WIN = 6 * MiB;
constexpr size_t WS_WOUT = 16 * MiB;
constexpr size_t WS_WGU = 20 * MiB;
constexpr size_t WS_WD = 148 * MiB;
constexpr size_t WS_H = 212 * MiB;
constexpr size_t WS_R1 = 248 * MiB;
constexpr size_t WS_R2 = 338 * MiB;
constexpr size_t WS_XB = 410 * MiB;
constexpr size_t WS_UST = 446 * MiB;
constexpr size_t WS_MISC = 464 * MiB;
constexpr size_t WS_DEC = WS_MISC;
constexpr size_t WS_AFF = WS_MISC + 1 * MiB;
constexpr size_t WS_AFFC = WS_MISC + 2 * MiB;
constexpr size_t WS_GATE = WS_MISC + 2 * MiB + 262144;
constexpr size_t WS_GATEC = WS_MISC + 2 * MiB + 524288;
constexpr size_t WS_INV = WS_MISC + 3 * MiB;
constexpr size_t WS_ROWIDX = WS_MISC + 3 * MiB + 786432;
constexpr size_t WS_END = 468 * MiB;
constexpr int CW_BAR = 4096;
constexpr int CW_QUEUE = 1024;
constexpr int CW_CONV = 2048;

constexpr int WAVE_LDS = 19456;
constexpr int RING_BYTES = NWAVES * WAVE_LDS;
constexpr int LDSCTL_OFF = RING_BYTES, MISC_OFF = LDSCTL_OFF + 320;
constexpr int LDS_BYTES = RING_BYTES + 1024;
static_assert(RING_BYTES >= pg8::STAGE_BYTES && LDS_BYTES <= 163840, "LDS map");

#define GAS __attribute__((address_space(1)))
#define LAS __attribute__((address_space(3)))
typedef unsigned short bf16_t;
typedef unsigned v4u __attribute__((ext_vector_type(4)));
typedef unsigned v2u __attribute__((ext_vector_type(2)));
typedef float f32x4 __attribute__((ext_vector_type(4)));
typedef float f32x2 __attribute__((ext_vector_type(2)));
typedef float f32x16 __attribute__((ext_vector_type(16)));
typedef short bf16x8 __attribute__((ext_vector_type(8)));
typedef short s16x4 __attribute__((ext_vector_type(4)));
typedef GAS unsigned gu32;
#define RLX_AGENT __ATOMIC_RELAXED, __HIP_MEMORY_SCOPE_AGENT
typedef __bf16 bf16x2_t __attribute__((ext_vector_type(2)));
__device__ __forceinline__ unsigned pk2(float lo, float hi) { f32x2 v = {lo, hi}; bf16x2_t b = __builtin_convertvector(v, bf16x2_t); return __builtin_bit_cast(unsigned, b); }
__device__ __forceinline__ float bflo(unsigned w) { return __uint_as_float(w << 16); }
__device__ __forceinline__ float bfhi(unsigned w) { return __uint_as_float(w & 0xffff0000u); }
__device__ __forceinline__ float bf1(bf16_t w) { return __uint_as_float((unsigned)w << 16); }
__device__ __forceinline__ float wave_sum(float v) {
#pragma unroll
    for (int o = 1; o < 64; o <<= 1) v += __shfl_xor(v, o);
    return v;
}
__device__ __forceinline__ float fexp2(float x) { return __builtin_amdgcn_exp2f(x); }
__device__ __forceinline__ float fexp(float x) { return __builtin_amdgcn_exp2f(x * LOG2E); }
__device__ __forceinline__ float flog(float x) { return __builtin_amdgcn_logf(x) * 0.6931471805599453f; }
__device__ __forceinline__ float frcp(float x) { return __builtin_amdgcn_rcpf(x); }
__device__ __forceinline__ float silu_f(float x) { return x * frcp(1.f + fexp(-x)); }
__device__ __forceinline__ int crow(int r, int hi) { return (r & 3) + 8 * (r >> 2) + 4 * hi; }
__device__ __forceinline__ s16x4 tr_read(LAS const unsigned char* p) { return __builtin_bit_cast(s16x4, __builtin_amdgcn_ds_read_tr16_b64_v4i16((LAS s16x4*)p)); }
__device__ __forceinline__ bf16x8 cat4(s16x4 a, s16x4 b) { return (bf16x8){a[0], a[1], a[2], a[3], b[0], b[1], b[2], b[3]}; }
__device__ __forceinline__ bf16x8 pack8(float a0, float a1, float a2, float a3, float a4, float a5, float a6, float a7) {
    v4u w; w.x = pk2(a0, a1); w.y = pk2(a2, a3); w.z = pk2(a4, a5); w.w = pk2(a6, a7); return __builtin_bit_cast(bf16x8, w); }
#define MFMA32(a, b, c) __builtin_amdgcn_mfma_f32_32x32x16_bf16((a), (b), (c), 0, 0, 0)

#ifndef EARLY_WB
#define EARLY_WB 0
#endif
#define XB_TMO      128
#define XB_XCNT(j)  (256  + 64 * (j))
#define XB_XSUB(j)  (1280 + 64 * (j))
#define XB_XGEN(j)  (2304 + 64 * (j))
#define XB_TOP      3328
#define XB_TOPGEN   3392
#define XCD_BAR_WORDS 3456
#define XB_SPIN_CAP (1u << 18)

__device__ __forceinline__ unsigned xb_ld(unsigned* p)              { return __hip_atomic_load(p, __ATOMIC_RELAXED, __HIP_MEMORY_SCOPE_AGENT); }
__device__ __forceinline__ unsigned xb_add(unsigned* p, unsigned v) { return __hip_atomic_fetch_add(p, v, __ATOMIC_RELAXED, __HIP_MEMORY_SCOPE_AGENT); }
__device__ __forceinline__ unsigned xb_xcc_id() { return (unsigned)__builtin_amdgcn_s_getreg((3 << 11) | 20) & 0xFu; }
#define XB_SPIN(cond, bar) do { unsigned _sp = 0; while (cond) { __builtin_amdgcn_s_sleep(1); \
    if ((++_sp & 255u) == 0u) { if (xb_ld(&(bar)[XB_TMO])) break; if (_sp > XB_SPIN_CAP) { atomicAdd(&(bar)[XB_TMO], 1u); break; } } } } while (0)

struct XcdBarrier {
    unsigned* bar; unsigned x;
    volatile LAS unsigned* st;
};

__device__ __forceinline__ XcdBarrier xcd_barrier_post(unsigned* bar, volatile LAS unsigned* st) {
    XcdBarrier b; b.bar = bar; b.x = xb_xcc_id(); b.st = st;
    if (threadIdx.x == 0) (void)xb_add(&bar[XB_XCNT(b.x)], 1u);
    return b;
}
__device__ __forceinline__ void xcd_barrier_complete(unsigned* bar, unsigned x, unsigned& nloc, unsigned& nx) {
    const unsigned G = gridDim.x * gridDim.y * gridDim.z;
    unsigned sum, cnt, mine, sp = 0u;
    for (;;) {
        sum = 0u; cnt = 0u; mine = 0u;
#pragma unroll
        for (unsigned j = 0; j < 16; ++j) { const unsigned c = xb_ld(&bar[XB_XCNT(j)]); sum += c; cnt += (c > 0u) ? 1u : 0u; mine = (j == x) ? c : mine; }
        if (sum == G) break;
        __builtin_amdgcn_s_sleep(1);
        if ((++sp & 255u) == 0u) { if (xb_ld(&bar[XB_TMO])) break; if (sp > XB_SPIN_CAP) { atomicAdd(&bar[XB_TMO], 1u); break; } }
    }
    nloc = mine > 0u ? mine : 1u; nx = cnt > 0u ? cnt : 1u;
}

__device__ __forceinline__ void xcd_barrier(const XcdBarrier& b) {
    asm volatile("s_waitcnt vmcnt(0)" ::: "memory");
    __syncthreads();
    if (threadIdx.x == 0) {
        unsigned* bar = b.bar;
        __builtin_amdgcn_s_waitcnt(0);
        unsigned nloc = b.st[0], nx = b.st[1];
        if (nloc == 0u) { xcd_barrier_complete(bar, b.x, nloc, nx); b.st[0] = nloc; b.st[1] = nx; }
#if EARLY_WB
        __builtin_amdgcn_fence(__ATOMIC_RELEASE, "agent");
        asm volatile("s_waitcnt vmcnt(0)" ::: "memory");
#endif
        const unsigned old = xb_add(&bar[XB_XSUB(b.x)], 1u);
        const unsigned gen = old / nloc;
        if (old + 1u == (gen + 1u) * nloc) {
            __builtin_amdgcn_fence(__ATOMIC_RELEASE, "agent");
            asm volatile("s_waitcnt vmcnt(0)" ::: "memory");
            const unsigned og = xb_add(&bar[XB_TOP], 1u);
            const unsigned tg = og / nx;
            if (og + 1u == (tg + 1u) * nx) xb_add(&bar[XB_TOPGEN], 1u);
            else XB_SPIN(xb_ld(&bar[XB_TOPGEN]) == tg, bar);
            __builtin_amdgcn_fence(__ATOMIC_ACQUIRE, "agent");
            xb_add(&bar[XB_XGEN(b.x)], 1u);
            asm volatile("s_waitcnt vmcnt(0)" ::: "memory");
        } else {
            XB_SPIN(xb_ld(&bar[XB_XGEN(b.x)]) == gen, bar);
            __builtin_amdgcn_fence(__ATOMIC_ACQUIRE, "agent");
            asm volatile("s_waitcnt vmcnt(0)" ::: "memory");
        }
    }
    __syncthreads();
}
__device__ __forceinline__ void ld_row_f32(const float* p, int lane, f32x4 (&v)[4]) {
#pragma unroll
    for (int j = 0; j < 4; ++j) v[j] = *(const f32x4*)(p + 256 * j + 4 * lane);
}
__device__ __forceinline__ void st_row_f32(float* p, int lane, const f32x4 (&v)[4]) {
#pragma unroll
    for (int j = 0; j < 4; ++j) *(f32x4*)(p + 256 * j + 4 * lane) = v[j];
}
__device__ __forceinline__ void ld_row_bf16(const bf16_t* p, int lane, f32x4 (&v)[4]) {
#pragma unroll
    for (int j = 0; j < 4; ++j) { const v2u w = *(const v2u*)(p + 256 * j + 4 * lane); v[j] = (f32x4){bflo(w.x), bfhi(w.x), bflo(w.y), bfhi(w.y)}; }
}
__device__ __forceinline__ void st_row_bf16(bf16_t* p, int lane, const f32x4 (&v)[4]) {
#pragma unroll
    for (int j = 0; j < 4; ++j) { v2u w; w.x = pk2(v[j].x, v[j].y); w.y = pk2(v[j].z, v[j].w); *(v2u*)(p + 256 * j + 4 * lane) = w; }
}
__device__ __forceinline__ void ld_vec_lds(LAS const float* p, int lane, f32x4 (&v)[4]) {
#pragma unroll
    for (int j = 0; j < 4; ++j) v[j] = *(LAS const f32x4*)(p + 256 * j + 4 * lane);
}
__device__ __forceinline__ float sumsq16(const f32x4 (&v)[4]) {
    float s = 0.f;
#pragma unroll
    for (int j = 0; j < 4; ++j) s += (v[j].x * v[j].x + v[j].y * v[j].y) + (v[j].z * v[j].z + v[j].w * v[j].w);
    return s;
}
__device__ __forceinline__ float modfin(const float* modp, const float* bmod, int l, int r, int n) {
    float s = bmod[l * 6144 + n];
#pragma unroll
    for (int kc = 0; kc < 8; ++kc) s += modp[((size_t)(l * 8 + kc) * 9 + r) * 6144 + n];
    return s;
}

#ifndef CONV_IN_P0
#define CONV_IN_P0 1
#endif
__device__ __forceinline__ void tr_item64(const float* W, int N, int Nvalid, bf16_t* WT, int Kd, int k0, int n0, int dst_row0, LAS float* scr, int lane) {
    const int q = lane & 15, kr = lane >> 4;
    f32x4 t[16];
#pragma unroll
    for (int i = 0; i < 16; ++i) { const int kk = 4 * i + kr; const int n = n0 + 4 * q;
        t[i] = (n < Nvalid) ? *(const f32x4*)(W + (size_t)(k0 + kk) * N + n) : (f32x4){0.f, 0.f, 0.f, 0.f}; }
#pragma unroll
    for (int i = 0; i < 16; ++i) { const int kk = 4 * i + kr; LAS float* d = scr + kk * 65 + 4 * q; d[0] = t[i].x; d[1] = t[i].y; d[2] = t[i].z; d[3] = t[i].w; }
    const int c = lane & 7, nl = lane >> 3;
#pragma unroll
    for (int j = 0; j < 8; ++j) { const int n = nl + 8 * j; LAS const float* s = scr + (8 * c) * 65 + n;
        v4u o; o.x = pk2(s[0 * 65], s[1 * 65]); o.y = pk2(s[2 * 65], s[3 * 65]); o.z = pk2(s[4 * 65], s[5 * 65]); o.w = pk2(s[6 * 65], s[7 * 65]);
        *(v4u*)(WT + (size_t)(dst_row0 + n) * Kd + k0 + 8 * c) = o; }
}
__device__ __forceinline__ void expert_conv_item(const float* const* in, unsigned char* ws, int l, int r, LAS float* scr, int lane) {
    const float* w_gate = in[15]; const float* w_up = in[16]; const float* w_down = in[17];
    const int which = r >> 12; r &= 4095;
    const int e = r >> 8, kb = (r & 255) >> 4, nb = r & 15, n0 = 64 * nb;
    const size_t eoff = (size_t)(l * 16 + e) * 1024 * 1024;
    if (which == 0) tr_item64(w_gate + eoff, 1024, 1024, (bf16_t*)(ws + WS_WGU) + 2 * eoff, 1024, 64 * kb, n0, (n0 >> 7) * 256 + (n0 & 127), scr, lane);
    else if (which == 1) tr_item64(w_up + eoff, 1024, 1024, (bf16_t*)(ws + WS_WGU) + 2 * eoff, 1024, 64 * kb, n0, (n0 >> 7) * 256 + 128 + (n0 & 127), scr, lane);
    else tr_item64(w_down + eoff, 1024, 1024, (bf16_t*)(ws + WS_WD) + eoff, 1024, 64 * kb, n0, n0, scr, lane);
}
__device__ __forceinline__ void conv_pull(const float* const* in, unsigned char* ws, int l_lo, int l_hi, int budget, LAS float* scr, int lane) {
    for (int l = l_lo; l <= l_hi && l < 2; ++l) {
        unsigned* ctr = (unsigned*)(ws + WS_CTL) + CW_CONV + 64 * l;
        while (budget > 0) {
            const int c = budget < 8 ? budget : 8;
            unsigned r = 0; if (lane == 0) r = __hip_atomic_fetch_add(ctr, (unsigned)c, __ATOMIC_RELAXED, __HIP_MEMORY_SCOPE_AGENT);
            r = (unsigned)__builtin_amdgcn_readfirstlane((int)r);
            if (r >= 12288u) break;
            for (int k = 0; k < c && (int)r + k < 12288; ++k) expert_conv_item(in, ws, l, (int)r + k, scr, lane);
            budget -= c;
        }
    }
}
__device__ __forceinline__ void phase_p0(const float* const* in, unsigned char* ws, LAS unsigned char* wl, int gw, int NGW, int lane) {
    const float* cvec = in[1]; const float* cctx = in[3]; const float* wmod = in[4];
    const float* w_in = in[7]; const float* w_out = in[8];
    float* modp = (float*)(ws + WS_MODP);
    constexpr int NI_MOD = 2 * 8 * 24, NI_ROPE = 16;
    constexpr int NI_IN = 16 * 40, NI_OUT = 16 * 16, NI_E = 16 * 16 * 16;
    constexpr int NI_L = NI_IN + NI_OUT + (CONV_IN_P0 ? 3 * NI_E : 0);
    constexpr int NITEMS = NI_MOD + NI_ROPE + 2 * NI_L;
    LAS float* scr = (LAS float*)wl;
    for (int it = gw; it < NITEMS; it += NGW) {
        int r = it;
        if (r < NI_MOD) {
            const int cb = r % 24, kc = (r / 24) & 7, l = r / 192;
            for (int idx = lane; idx < 128 * 9; idx += 64) { const int rr = idx / 128, k = idx % 128; const float cv = (rr < 8) ? cvec[rr * 1024 + kc * 128 + k] : cctx[kc * 128 + k]; scr[k * 12 + rr] = silu_f(cv); }
            f32x4 acc[9];
#pragma unroll
            for (int rr = 0; rr < 9; ++rr) acc[rr] = (f32x4){0.f, 0.f, 0.f, 0.f};
            const float* wp = wmod + ((size_t)l * 1024 + kc * 128) * 6144 + cb * 256 + 4 * lane;
#pragma unroll 4
            for (int k = 0; k < 128; ++k) { const f32x4 w = *(const f32x4*)(wp + (size_t)k * 6144);
                const f32x4 s0 = *(LAS const f32x4*)(scr + k * 12), s1 = *(LAS const f32x4*)(scr + k * 12 + 4); const float s8 = scr[k * 12 + 8];
                acc[0] += w * s0.x; acc[1] += w * s0.y; acc[2] += w * s0.z; acc[3] += w * s0.w; acc[4] += w * s1.x; acc[5] += w * s1.y; acc[6] += w * s1.z; acc[7] += w * s1.w; acc[8] += w * s8; }
#pragma unroll
            for (int rr = 0; rr < 9; ++rr) *(f32x4*)(modp + ((size_t)(l * 8 + kc) * 9 + rr) * 6144 + cb * 256 + 4 * lane) = acc[rr];
            continue;
        }
        r -= NI_MOD;
        if (r < NI_ROPE) {
            const int id = r * 64 + lane, pos = id >> 4, i = id & 15;
            const float fr = fexp2(-(float)i * (13.287712379549449f / 16.f));
            float rev = (float)pos * fr * 0.15915494309189535f; rev -= floorf(rev);
            f32x2 cs; cs.x = __builtin_amdgcn_cosf(rev); cs.y = __builtin_amdgcn_sinf(rev);
            ((f32x2*)(ws + WS_TAB))[id] = cs;
            continue;
        }
        r -= NI_ROPE;
        const int l = r / NI_L; r -= l * NI_L;
        if (r < NI_IN) { const int kb = r / 40, nb = r % 40;
            tr_item64(w_in + (size_t)l * 1024 * INW, INW, INW, (bf16_t*)(ws + WS_WIN) + (size_t)l * PP * 1024, 1024, 64 * kb, 64 * nb, 64 * nb, scr, lane); continue; }
        r -= NI_IN;
        if (r < NI_OUT) { const int kb = r / 16, nb = r % 16;
            tr_item64(w_out + (size_t)l * 1024 * 1024, 1024, 1024, (bf16_t*)(ws + WS_WOUT) + (size_t)l * 1024 * 1024, 1024, 64 * kb, 64 * nb, 64 * nb, scr, lane); continue; }
        r -= NI_OUT;
        expert_conv_item(in, ws, l, r, scr, lane);
    }
}

__device__ __forceinline__ void phase_a0(const float* const* in, unsigned char* ws, LAS unsigned char* lds, int G, int tid, int wave, int lane) {
    const float* x = in[0]; const float* ctx = in[2]; const float* bmod = in[5]; const float* gains = in[6];
    const float* modp = (const float*)(ws + WS_MODP); float* mod = (float*)(ws + WS_MOD); bf16_t* H = (bf16_t*)(ws + WS_H);
    LAS float* V = (LAS float*)lds;
    for (int row = blockIdx.x; row < 18; row += G) { const int l = row / 9, r = row % 9;
        for (int n = tid; n < 6144; n += 512) mod[(size_t)row * 6144 + n] = modfin(modp, bmod, l, r, n); }
    for (int t = blockIdx.x; t < 256; t += G) {
        const int b = t >> 5;
        __syncthreads();
        for (int n = tid; n < 1024; n += 512) { const float g = gains[n];
            V[n] = g * (1.f + modfin(modp, bmod, 0, b, 1024 + n)); V[1024 + n] = modfin(modp, bmod, 0, b, n);
            V[2048 + n] = g * (1.f + modfin(modp, bmod, 0, 8, 1024 + n)); V[3072 + n] = modfin(modp, bmod, 0, 8, n); }
        __syncthreads();
#pragma unroll 1
        for (int i0 = 0; i0 < 9; i0 += 3) {
            f32x4 xq[3][4];
#pragma unroll
            for (int k = 0; k < 3; ++k) { const int i = i0 + k; const bool isc = (i == 8);
                const float* src = isc ? (ctx + (size_t)(8 * t + wave) * 1024) : (x + (size_t)(64 * t + 8 * wave + i) * 1024); ld_row_f32(src, lane, xq[k]); }
#pragma unroll
            for (int k = 0; k < 3; ++k) { const int i = i0 + k; const bool isc = (i == 8);
                const int row = isc ? (ML + 8 * t + wave) : (64 * t + 8 * wave + i);
                f32x4 (&v)[4] = xq[k]; f32x4 a[4], s[4];
                const float rstd = __builtin_amdgcn_rsqf(wave_sum(sumsq16(v)) * (1.f / 1024.f) + NEPS);
                ld_vec_lds(V + (isc ? 2048 : 0), lane, a); ld_vec_lds(V + (isc ? 3072 : 1024), lane, s);
#pragma unroll
                for (int j = 0; j < 4; ++j) v[j] = v[j] * rstd * a[j] + s[j];
                st_row_bf16(H + (size_t)row * 1024, lane, v);
            }
        }
    }
}
constexpr int VP = 192;
struct AttnTile { f32x16 o0, o1; float m, lsum; };
__device__ __forceinline__ void attn_softmax(f32x16& s, AttnTile& T) {
    float bm = fmaxf(fmaxf(s[0], s[1]), fmaxf(s[2], s[3]));
#pragma unroll
    for (int i = 4; i < 16; i += 4) bm = fmaxf(bm, fmaxf(fmaxf(s[i], s[i + 1]), fmaxf(s[i + 2], s[i + 3])));
    bm = fmaxf(bm, __shfl_xor(bm, 32));
    const float mo = T.m, mn = fmaxf(mo, bm);
    T.m = mn;
    float ps = 0.f;
#pragma unroll
    for (int i = 0; i < 16; ++i) { s[i] = fexp2(s[i] - mn); ps += s[i]; }
    if (__any(mn != mo)) {
        const float alpha = fexp2(mo - mn);
        T.lsum *= alpha;
#pragma unroll
        for (int i = 0; i < 16; ++i) { T.o0[i] *= alpha; T.o1[i] *= alpha; }
    }
    T.lsum += ps;
}
__device__ __forceinline__ void attn_item(const int MODE, const bf16_t* P, bf16_t* MIX, int item, LAS unsigned char* wl, int lane,
                                          const float* __restrict__ rpb, const float* __restrict__ sink, const bool dry = false) {
    asm volatile("" : "+v"(lane));
    const int ql = lane & 31, hi = lane >> 5;
    int b, hq, qcol, kcol, vcol, ocol, qrow0, r = 0, rs = 0, q64 = 0, nloc, kb_lo = 0;
    if (MODE == 0) { r = item & 31; hq = (item >> 5) & 3; b = item >> 7;
        qcol = C_NQ + hq * 64; kcol = C_NK + hq * 64; vcol = C_NV + hq * 64; ocol = 256 + hq * 64; qrow0 = b * SEQ + r * 64;
        rs = r - 4; rs = rs < 0 ? 0 : (rs > 24 ? 24 : rs); nloc = 16; }
    else if (MODE == 1) { q64 = item & 31; hq = (item >> 5) & 7; b = item >> 8;
        qcol = C_SQ + hq * 64; kcol = C_SK + (hq >> 2) * 64; vcol = C_SV + (hq >> 2) * 64; ocol = 512 + hq * 64; qrow0 = b * SEQ + q64 * 64;
        kb_lo = 2 * q64 - 4; if (kb_lo < 0) kb_lo = 0; int kb_hi = 2 * q64 + 5; if (kb_hi > 63) kb_hi = 63; nloc = kb_hi - kb_lo + 1; }
    else if (MODE == 2) { q64 = item & 3; hq = (item >> 2) & 3; b = item >> 4;
        qcol = C_NQ + hq * 64; kcol = C_NK + hq * 64; vcol = C_NV + hq * 64; ocol = 256 + hq * 64; qrow0 = ML + b * CTXL + q64 * 64; nloc = 0; }
    else { q64 = item & 3; hq = (item >> 2) & 7; b = item >> 5;
        qcol = C_SQ + hq * 64; kcol = C_SK + (hq >> 2) * 64; vcol = C_SV + (hq >> 2) * 64; ocol = 512 + hq * 64; qrow0 = ML + b * CTXL + q64 * 64; nloc = 0; }
    const int nblk = 8 + nloc;
    LAS unsigned char* vl = wl;
    LAS float* rl = (LAS float*)(wl + 32 * VP);
    if (MODE == 0) { for (int i = lane; i < 465; i += 64) rl[i] = rpb[hq * 465 + i] * LOG2E; }
    LAS unsigned char* qimg = wl + 32 * VP + 1920;
    constexpr int QP = 144;
#pragma unroll
    for (int i = 0; i < 8; ++i) { const int c = lane + 64 * i; const v4u v = *(const v4u*)(P + (size_t)(qrow0 + (c >> 3)) * PP + qcol + (c & 7) * 8); *(LAS v4u*)(qimg + (c >> 3) * QP + (c & 7) * 16) = v; }
    LAS const unsigned char* qrd = qimg + ql * QP + 16 * hi;
    auto blk_row0 = [&](int blk) -> int {
        if (blk < 8) return ML + b * CTXL + blk * 32;
        const int lb = blk - 8;
        if (MODE == 0) return b * SEQ + (rs + (lb >> 1)) * 64 + (lb & 1) * 32;
        return b * SEQ + 32 * (kb_lo + lb);
    };
    auto load_blk = [&](int blk, bf16x8 (&kn)[4], v4u (&vn)[4]) {
        const int r0 = blk_row0(blk);
        const bf16_t* kp = P + (size_t)(r0 + ql) * PP + kcol + 8 * hi;
#pragma unroll
        for (int ds = 0; ds < 4; ++ds) kn[ds] = *(const bf16x8*)(kp + 16 * ds);
#pragma unroll
        for (int i = 0; i < 4; ++i) { const int c = lane + 64 * i; vn[i] = *(const v4u*)(P + (size_t)(r0 + (c >> 3)) * PP + vcol + (c & 7) * 8); }
    };
    AttnTile T[2];
#pragma unroll
    for (int t = 0; t < 2; ++t) { T[t].m = -INFINITY; T[t].lsum = 0.f;
#pragma unroll
        for (int i = 0; i < 16; ++i) { T[t].o0[i] = 0.f; T[t].o1[i] = 0.f; } }
    const int tr_off = (4 * hi + ((lane & 15) >> 2)) * VP + (16 * ((lane >> 4) & 1) + 4 * (lane & 3)) * 2;
    auto step = [&](int blk, bf16x8 (&kf)[4], v4u (&vr)[4]) {
#pragma unroll
        for (int i = 0; i < 4; ++i) { const int c = lane + 64 * i; *(LAS v4u*)(vl + (c >> 3) * VP + (c & 7) * 16) = vr[i]; }
        f32x16 sc[2];
#pragma unroll
        for (int t = 0; t < 2; ++t) {
#pragma unroll
            for (int i = 0; i < 16; ++i) sc[t][i] = 0.f;
#pragma unroll
            for (int ds = 0; ds < 4; ++ds) sc[t] = MFMA32(kf[ds], *(LAS const bf16x8*)(qrd + 32 * t * QP + 32 * ds), sc[t]);
        }
        if (blk + 2 < nblk) load_blk(blk + 2, kf, vr);
        bf16x8 vf[2][2];
#pragma unroll
        for (int ks = 0; ks < 2; ++ks) { LAS const unsigned char* vb = vl + tr_off + 16 * ks * VP;
            vf[ks][0] = cat4(tr_read(vb), tr_read(vb + 8 * VP)); vf[ks][1] = cat4(tr_read(vb + 64), tr_read(vb + 8 * VP + 64)); }
#pragma unroll
        for (int t = 0; t < 2; ++t) {
            f32x16& s = sc[t];
            if (MODE == 0 && blk >= 8) {
                const int lb = blk - 8, j = lb >> 1, ch = lb & 1, c = t * 32 + ql;
                int cs = c - 8; cs = cs < 0 ? 0 : (cs > 48 ? 48 : cs);
                LAS const float* rrow = rl + (rs + j - r + 7) * 31 + (15 - c);
#pragma unroll
                for (int i = 0; i < 16; ++i) { const int kc = ch * 32 + crow(i, hi); const bool ok = (kc >= cs) && (kc < cs + 16);
                    const float bias = rrow[ok ? kc : c];
                    s[i] = ok ? (s[i] + bias) : -INFINITY; }
            } else if (MODE == 1 && blk >= 8) {
                const int rel = (kb_lo + blk - 8) - (2 * q64 + t);
                if (rel <= -4 || rel >= 4) {
#pragma unroll
                    for (int i = 0; i < 16; ++i) { const int kk = crow(i, hi); const bool ok = (rel == -4) ? (kk >= ql) : ((rel == 4) ? (kk <= ql) : false);
                        s[i] = ok ? s[i] : -INFINITY; }
                }
            }
            attn_softmax(s, T[t]);
#pragma unroll
            for (int ks = 0; ks < 2; ++ks) {
                const bf16x8 pf = pack8(s[8 * ks + 0], s[8 * ks + 1], s[8 * ks + 2], s[8 * ks + 3], s[8 * ks + 4], s[8 * ks + 5], s[8 * ks + 6], s[8 * ks + 7]);
                T[t].o0 = MFMA32(vf[ks][0], pf, T[t].o0); T[t].o1 = MFMA32(vf[ks][1], pf, T[t].o1);
            }
            __builtin_amdgcn_sched_barrier(0);
        }
    };
    bf16x8 kA[4], kB[4]; v4u vA[4], vB[4];
    load_blk(0, kA, vA); load_blk(1, kB, vB);
    for (int blk = 0; blk < nblk; blk += 2) { step(blk, kA, vA); if (blk + 1 < nblk) step(blk + 1, kB, vB); }
#pragma unroll
    for (int t = 0; t < 2; ++t) {
        float lt = T[t].lsum + __shfl_xor(T[t].lsum, 32);
        if (MODE == 1 || MODE == 3) lt += fexp2(sink[hq] * LOG2E - T[t].m);
        const float inv = frcp(lt);
        bf16_t* op = MIX + (size_t)(qrow0 + 32 * t + ql) * 1024 + ocol + 4 * hi;
#pragma unroll
        for (int g = 0; g < 4; ++g) {
            v2u w0, w1; w0.x = pk2(T[t].o0[4 * g] * inv, T[t].o0[4 * g + 1] * inv); w0.y = pk2(T[t].o0[4 * g + 2] * inv, T[t].o0[4 * g + 3] * inv);
            w1.x = pk2(T[t].o1[4 * g] * inv, T[t].o1[4 * g + 1] * inv); w1.y = pk2(T[t].o1[4 * g + 2] * inv, T[t].o1[4 * g + 3] * inv);
            *(v2u*)(op + 8 * g) = w0; *(v2u*)(op + 32 + 8 * g) = w1;
        }
    }
}
constexpr int GP = 144;
constexpr int G_V = 0, G_A = 64 * GP, G_B = 64 * GP + 32 * GP;
static_assert(G_B + 32 * GP <= WAVE_LDS, "gla LDS");

struct GlaCum { float cum[2][16]; float tot; };
__device__ __forceinline__ void gla_cum(const bf16_t* P, int row0, int hh, int dir, const float* __restrict__ a_up, const float* __restrict__ a_bias, int lane, GlaCum& C) {
    const int kk = lane & 31, hi = lane >> 5;
    const float* up = a_up + (size_t)dir * 16 * 128 + (size_t)(8 * hi) * 128 + hh * 32 + kk;
    const bf16x8 ub = pack8(up[0], up[128], up[256], up[384], up[512], up[640], up[768], up[896]);
    const float bias = a_bias[dir * 128 + hh * 32 + kk];
    float gs[2][4];
#pragma unroll
    for (int tt = 0; tt < 2; ++tt) {
        const bf16x8 al = *(const bf16x8*)(P + (size_t)(row0 + 32 * tt + kk) * PP + C_GAF + 16 * dir + 8 * hi);
        f32x16 z;
#pragma unroll
        for (int i = 0; i < 16; ++i) z[i] = 0.f;
        z = MFMA32(al, ub, z);
#pragma unroll
        for (int g = 0; g < 4; ++g) { float run = 0.f;
#pragma unroll
            for (int e = 0; e < 4; ++e) { const float zz = z[4 * g + e] + bias; const float ls = fminf(zz, 0.f) - flog(1.f + fexp(-fabsf(zz)));
                const float l = ls * (1.f / 16.f);
                if (dir == 0) { run += l; C.cum[tt][4 * g + e] = run; } else { C.cum[tt][4 * g + e] = run; run += l; } }
            gs[tt][g] = run; }
    }
    float off = 0.f;
#pragma unroll
    for (int tt = 0; tt < 2; ++tt)
#pragma unroll
        for (int g = 0; g < 4; ++g) { const float other = __shfl_xor(gs[tt][g], 32); const float mine = off + (hi ? other : 0.f);
#pragma unroll
            for (int e = 0; e < 4; ++e) C.cum[tt][4 * g + e] += mine;
            off += gs[tt][g] + other; }
    C.tot = off;
    if (dir == 1) {
#pragma unroll
        for (int tt = 0; tt < 2; ++tt)
#pragma unroll
            for (int r = 0; r < 16; ++r) C.cum[tt][r] = off - C.cum[tt][r];
    }
}
__device__ __forceinline__ void gla_ld_tc(const bf16_t* P, int row0, int col, int lane, float (&x)[2][16]) {
    const int kk = lane & 31, hi = lane >> 5;
#pragma unroll
    for (int tt = 0; tt < 2; ++tt)
#pragma unroll
        for (int r = 0; r < 16; ++r) x[tt][r] = bf1(P[(size_t)(row0 + 32 * tt + crow(r, hi)) * PP + col + kk]);
}
__device__ __forceinline__ void gla_st_img(LAS unsigned char* img, int lane, const float (&x)[2][16]) {
    const int kk = lane & 31, hi = lane >> 5;
#pragma unroll
    for (int tt = 0; tt < 2; ++tt)
#pragma unroll
        for (int g = 0; g < 4; ++g) { v2u w; w.x = pk2(x[tt][4 * g], x[tt][4 * g + 1]); w.y = pk2(x[tt][4 * g + 2], x[tt][4 * g + 3]);
            *(LAS v2u*)(img + kk * GP + (32 * tt + 8 * g + 4 * hi) * 2) = w; }
}
__device__ __forceinline__ void gla_stage_v(const bf16_t* P, int row0, int hh, LAS unsigned char* wl, int lane) {
#pragma unroll
    for (int i = 0; i < 8; ++i) { const int c = lane + 64 * i; const v4u v = *(const v4u*)(P + (size_t)(row0 + (c >> 3)) * PP + C_GV + hh * 64 + (c & 7) * 8);
        *(LAS v4u*)(wl + G_V + (c >> 3) * GP + (c & 7) * 16) = v; }
}
__device__ __forceinline__ int gla_row0(int b, int nc) { return nc < 4 ? (ML + b * CTXL + 64 * nc) : (b * SEQ + 64 * (nc - 4)); }

__device__ __forceinline__ void gla_local_item(const bf16_t* P, float* UST, float* DEC, int item, LAS unsigned char* wl, int lane,
                                               const float* __restrict__ a_up, const float* __restrict__ a_bias) {
    asm volatile("" : "+v"(lane));
    const int nc = item % 36, hh = (item / 36) & 3, b = item / 144;
    const int row0 = gla_row0(b, nc), kk = lane & 31, hi = lane >> 5;
    gla_stage_v(P, row0, hh, wl, lane);
    float kv[2][16]; gla_ld_tc(P, row0, C_GK + hh * 32, lane, kv);
#pragma unroll
    for (int dir = 0; dir < 2; ++dir) {
        GlaCum C; gla_cum(P, row0, hh, dir, a_up, a_bias, lane, C);
        float kd[2][16];
#pragma unroll
        for (int tt = 0; tt < 2; ++tt)
#pragma unroll
            for (int r = 0; r < 16; ++r) kd[tt][r] = kv[tt][r] * fexp(C.tot - C.cum[tt][r]);
        gla_st_img(wl + (dir == 0 ? G_A : G_B), lane, kd);
        if (hi == 0) DEC[((size_t)((b * 4 + hh) * 2 + dir) * 36 + nc) * 32 + kk] = fexp(C.tot);
    }
    const int trv = ((lane & 15) >> 2) * GP + (16 * ((lane >> 4) & 1) + 4 * (lane & 3)) * 2;
#pragma unroll
    for (int dir = 0; dir < 2; ++dir) {
        f32x16 u0, u1;
#pragma unroll
        for (int i = 0; i < 16; ++i) { u0[i] = 0.f; u1[i] = 0.f; }
        LAS const unsigned char* img = wl + (dir == 0 ? G_A : G_B);
#pragma unroll
        for (int s = 0; s < 4; ++s) {
            const bf16x8 kb = *(LAS const bf16x8*)(img + kk * GP + (16 * s + 8 * hi) * 2);
            LAS const unsigned char* vb = wl + G_V + trv + (16 * s + 8 * hi) * GP;
            const bf16x8 v0 = cat4(tr_read(vb), tr_read(vb + 4 * GP));
            const bf16x8 v1 = cat4(tr_read(vb + 64), tr_read(vb + 4 * GP + 64));
            u0 = MFMA32(v0, kb, u0); u1 = MFMA32(v1, kb, u1);
        }
        float* up = UST + ((size_t)((b * 4 + hh) * 2 + dir) * 36 + nc) * 2048 + kk;
#pragma unroll
        for (int i = 0; i < 16; ++i) { up[(size_t)crow(i, hi) * 32] = u0[i]; up[(size_t)(32 + crow(i, hi)) * 32] = u1[i]; }
    }
}

__device__ __forceinline__ void gla_prefix(float* UST, const float* DEC, int gid, bool dry) {
    const int bhd = gid >> 11, e = gid & 2047, k = e & 31, dir = bhd & 1;
    float* base = UST + (size_t)bhd * 36 * 2048 + e; const float* dec = DEC + (size_t)bhd * 36 * 32 + k;
    float s = 0.f;
#pragma unroll 4
    for (int ci = 0; ci < 36; ++ci) {
        const int sl = dir == 0 ? ci : (ci < 4 ? 3 - ci : 39 - ci);
        const float u = base[(size_t)sl * 2048], d = dec[sl * 32];
        if (!dry) base[(size_t)sl * 2048] = s;
        s = d * s + u;
    }
}

__device__ __forceinline__ void gla_out_item(const bf16_t* P, const float* UST, bf16_t* MIX, int item, LAS unsigned char* wl, int lane,
                                             const float* __restrict__ a_up, const float* __restrict__ a_bias, const float* __restrict__ gnorm) {
    const int nc = item % 36, hh = (item / 36) & 3, b = item / 144;
    const int row0 = gla_row0(b, nc), kk = lane & 31, hi = lane >> 5;
    gla_stage_v(P, row0, hh, wl, lane);
    f32x16 o[2][2];
#pragma unroll
    for (int a = 0; a < 2; ++a)
#pragma unroll
        for (int c = 0; c < 2; ++c)
#pragma unroll
            for (int i = 0; i < 16; ++i) o[a][c][i] = 0.f;
    const int g16 = (lane >> 4) & 1, qq = (lane & 15) >> 2, pp = lane & 3;
    const int tri = (8 * hi + qq) * GP + (16 * g16 + 4 * pp) * 2;
    const int trv = (4 * hi + qq) * GP + (16 * g16 + 4 * pp) * 2;
#pragma unroll
    for (int dir = 0; dir < 2; ++dir) {
        GlaCum C; gla_cum(P, row0, hh, dir, a_up, a_bias, lane, C);
#pragma unroll
        for (int tt = 0; tt < 2; ++tt) {
            float cum[16];
#pragma unroll
            for (int r = 0; r < 16; ++r) cum[r] = C.cum[tt][r];
#pragma unroll
            for (int g = 0; g < 4; ++g) {
                float xq[4], xk[4];
#pragma unroll
                for (int e = 0; e < 4; ++e) { const size_t ro = (size_t)(row0 + 32 * tt + 8 * g + 4 * hi + e) * PP + hh * 32 + kk;
                    xq[e] = bf1(P[ro + C_GQ]) * 0.17677669529663687f * fexp(cum[4 * g + e]); xk[e] = bf1(P[ro + C_GK]) * fexp(-cum[4 * g + e]); }
                v2u wq, wk; wq.x = pk2(xq[0], xq[1]); wq.y = pk2(xq[2], xq[3]); wk.x = pk2(xk[0], xk[1]); wk.y = pk2(xk[2], xk[3]);
                const int off = kk * GP + (32 * tt + 8 * g + 4 * hi) * 2;
                *(LAS v2u*)(wl + G_A + off) = wq; *(LAS v2u*)(wl + G_B + off) = wk;
                if (g & 1) asm volatile("" ::: "memory");
            }
        }
        const float* sp = UST + ((size_t)((b * 4 + hh) * 2 + dir) * 36 + nc) * 2048;
        bf16x8 sf[2][2];
#pragma unroll
        for (int vb = 0; vb < 2; ++vb)
#pragma unroll
            for (int s = 0; s < 2; ++s) { const float* p = sp + (size_t)(32 * vb + kk) * 32 + 16 * s + 8 * hi; const f32x4 a = *(const f32x4*)p, c = *(const f32x4*)(p + 4);
                sf[vb][s] = pack8(a.x, a.y, a.z, a.w, c.x, c.y, c.z, c.w); }
#pragma unroll
        for (int it = 0; it < 2; ++it) {
            bf16x8 qf[2];
#pragma unroll
            for (int s = 0; s < 2; ++s) { LAS const unsigned char* p = wl + G_A + tri + 16 * s * GP + 64 * it; qf[s] = cat4(tr_read(p), tr_read(p + 4 * GP)); }
#pragma unroll
            for (int vb = 0; vb < 2; ++vb)
#pragma unroll
                for (int s = 0; s < 2; ++s) o[vb][it] = MFMA32(sf[vb][s], qf[s], o[vb][it]);
#pragma unroll
            for (int jt = 0; jt < 2; ++jt) {
                if (dir == 0 ? (jt > it) : (jt < it)) continue;
                f32x16 sc;
#pragma unroll
                for (int i = 0; i < 16; ++i) sc[i] = 0.f;
#pragma unroll
                for (int s = 0; s < 2; ++s) { LAS const unsigned char* p = wl + G_B + tri + 16 * s * GP + 64 * jt; const bf16x8 kf = cat4(tr_read(p), tr_read(p + 4 * GP)); sc = MFMA32(kf, qf[s], sc); }
                if (jt == it) {
#pragma unroll
                    for (int i = 0; i < 16; ++i) { const int j = crow(i, hi); const bool ok = dir == 0 ? (j <= kk) : (j >= kk); sc[i] = ok ? sc[i] : 0.f; }
                }
#pragma unroll
                for (int s2 = 0; s2 < 2; ++s2) {
                    const bf16x8 pf = pack8(sc[8 * s2 + 0], sc[8 * s2 + 1], sc[8 * s2 + 2], sc[8 * s2 + 3], sc[8 * s2 + 4], sc[8 * s2 + 5], sc[8 * s2 + 6], sc[8 * s2 + 7]);
                    LAS const unsigned char* vp = wl + G_V + trv + (32 * jt + 16 * s2) * GP;
                    const bf16x8 v0 = cat4(tr_read(vp), tr_read(vp + 8 * GP));
                    const bf16x8 v1 = cat4(tr_read(vp + 64), tr_read(vp + 8 * GP + 64));
                    o[0][it] = MFMA32(v0, pf, o[0][it]); o[1][it] = MFMA32(v1, pf, o[1][it]);
                }
                __builtin_amdgcn_sched_barrier(0);
            }
            __builtin_amdgcn_sched_barrier(0);
        }
    }
#pragma unroll
    for (int it = 0; it < 2; ++it) {
        float ss = 0.f;
#pragma unroll
        for (int vb = 0; vb < 2; ++vb)
#pragma unroll
            for (int i = 0; i < 16; ++i) ss += o[vb][it][i] * o[vb][it][i];
        ss += __shfl_xor(ss, 32);
        const float rstd = __builtin_amdgcn_rsqf(ss * (1.f / 64.f) + NEPS);
        const size_t row = (size_t)(row0 + 32 * it + kk);
#pragma unroll
        for (int vb = 0; vb < 2; ++vb)
#pragma unroll
            for (int g = 0; g < 4; ++g) { const int v = 32 * vb + 8 * g + 4 * hi;
                const f32x4 gn = *(const f32x4*)(gnorm + v); const v2u gw = *(const v2u*)(P + row * PP + C_GG + hh * 64 + v);
                const float g0 = bflo(gw.x), g1 = bfhi(gw.x), g2 = bflo(gw.y), g3 = bfhi(gw.y);
                v2u w; w.x = pk2(o[vb][it][4 * g] * rstd * gn.x * silu_f(g0), o[vb][it][4 * g + 1] * rstd * gn.y * silu_f(g1));
                w.y = pk2(o[vb][it][4 * g + 2] * rstd * gn.z * silu_f(g2), o[vb][it][4 * g + 3] * rstd * gn.w * silu_f(g3));
                *(v2u*)(MIX + row * 1024 + hh * 64 + v) = w; }
    }
}
__device__ __forceinline__ void phase_r1(const float* const* in, float* xout, unsigned char* ws, LAS unsigned char* lds, int l, bool upd, int G, int tid, int wave, int lane, bool dry) {
    const float* x0 = in[0]; const float* ctx0 = in[2]; const float* gains = in[6] + (size_t)l * 4096; const float* wr = in[14] + (size_t)l * 1024 * 16;
    const float* mod = (const float*)(ws + WS_MOD) + (size_t)l * 9 * 6144;
    const bf16_t* Y = (const bf16_t*)(ws + WS_R2 + (size_t)MT * 2048); bf16_t* H = (bf16_t*)(ws + WS_H); bf16_t* XB = (bf16_t*)(ws + WS_XB);
    float* AFF = (float*)(ws + WS_AFF); float* AFFC = (float*)(ws + WS_AFFC);
    LAS float* V = (LAS float*)lds;
    LAS float* RT = V + 6144;
    __syncthreads();
    for (int i = tid; i < 16384; i += 512) { const int d = i >> 4, e = i & 15; RT[e * 1024 + d] = wr[i]; }
    for (int t = blockIdx.x; t < 256; t += G) {
        const int b = t >> 5;
        __syncthreads();
        for (int n = tid; n < 1024; n += 512) { const float gpa = gains[1024 + n], gpf = gains[2048 + n];
            V[n] = gpa * mod[b * 6144 + 2048 + n]; V[1024 + n] = gpf * (1.f + mod[b * 6144 + 4096 + n]); V[2048 + n] = mod[b * 6144 + 3072 + n];
            V[3072 + n] = gpa * mod[8 * 6144 + 2048 + n]; V[4096 + n] = gpf * (1.f + mod[8 * 6144 + 4096 + n]); V[5120 + n] = mod[8 * 6144 + 3072 + n]; }
        __syncthreads();
        const int nrows = upd ? 9 : 8;
#pragma unroll 1
        for (int i0 = 0; i0 < 9; i0 += 3) {
            f32x4 yv[3][4], xq[3][4];
#pragma unroll
            for (int k = 0; k < 3; ++k) { const int i = i0 + k; if (i < nrows) {
                const bool isc = (i == 8); const int row = isc ? (ML + 8 * t + wave) : (64 * t + 8 * wave + i);
                ld_row_bf16(Y + (size_t)row * 1024, lane, yv[k]);
                if (l == 0) ld_row_f32(isc ? (ctx0 + (size_t)(8 * t + wave) * 1024) : (x0 + (size_t)row * 1024), lane, xq[k]); else ld_row_bf16(XB + (size_t)row * 1024, lane, xq[k]); } }
#pragma unroll
            for (int k = 0; k < 3; ++k) { const int i = i0 + k; if (i < nrows) {
            const bool isc = (i == 8);
            const int row = isc ? (ML + 8 * t + wave) : (64 * t + 8 * wave + i);
            bf16_t* xd = (dry ? (bf16_t*)(ws + WS_R1) : XB) + (size_t)row * 1024;
            LAS const float* vv = V + (isc ? 3072 : 0);
            f32x4 (&y)[4] = yv[k]; f32x4 (&xv)[4] = xq[k]; f32x4 a[4];
            const float rsy = __builtin_amdgcn_rsqf(wave_sum(sumsq16(y)) * (1.f / 1024.f) + NEPS);
            ld_vec_lds(vv, lane, a);
#pragma unroll
            for (int j = 0; j < 4; ++j) xv[j] = xv[j] + a[j] * (y[j] * rsy);
            st_row_bf16(xd, lane, xv);
            const float rs1 = __builtin_amdgcn_rsqf(wave_sum(sumsq16(xv)) * (1.f / 1024.f) + NEPS);
            f32x4 s[4]; ld_vec_lds(vv + 1024, lane, a); ld_vec_lds(vv + 2048, lane, s);
#pragma unroll
            for (int j = 0; j < 4; ++j) xv[j] = xv[j] * rs1 * a[j] + s[j];
            st_row_bf16((dry ? (bf16_t*)(ws + WS_R2) : H) + (size_t)row * 1024, lane, xv);
            float lg[16];
#pragma unroll
            for (int e = 0; e < 16; ++e) { float p = 0.f;
#pragma unroll
                for (int j = 0; j < 4; ++j) { const f32x4 w = *(LAS const f32x4*)(RT + e * 1024 + 256 * j + 4 * lane); p += (xv[j].x * w.x + xv[j].y * w.y) + (xv[j].z * w.z + xv[j].w * w.w); }
                lg[e] = p;
                if ((e & 3) == 3) asm volatile("" ::: "memory"); }
#pragma unroll
            for (int i2 = 0; i2 < 8; ++i2) { const bool up = (lane & 32) != 0; const float keep = up ? lg[i2 + 8] : lg[i2], send = up ? lg[i2] : lg[i2 + 8]; lg[i2] = keep + __shfl_xor(send, 32); }
#pragma unroll
            for (int i2 = 0; i2 < 4; ++i2) { const bool up = (lane & 16) != 0; const float keep = up ? lg[i2 + 4] : lg[i2], send = up ? lg[i2] : lg[i2 + 4]; lg[i2] = keep + __shfl_xor(send, 16); }
#pragma unroll
            for (int i2 = 0; i2 < 2; ++i2) { const bool up = (lane & 8) != 0; const float keep = up ? lg[i2 + 2] : lg[i2], send = up ? lg[i2] : lg[i2 + 2]; lg[i2] = keep + __shfl_xor(send, 8); }
            { const bool up = (lane & 4) != 0; const float keep = up ? lg[1] : lg[0], send = up ? lg[0] : lg[1]; lg[0] = keep + __shfl_xor(send, 4); }
            float lgt = lg[0]; lgt += __shfl_xor(lgt, 1); lgt += __shfl_xor(lgt, 2);
            const int ex = ((lane >> 5) & 1) * 8 + ((lane >> 4) & 1) * 4 + ((lane >> 3) & 1) * 2 + ((lane >> 2) & 1);
            float mx = lgt;
            mx = fmaxf(mx, __shfl_xor(mx, 4)); mx = fmaxf(mx, __shfl_xor(mx, 8)); mx = fmaxf(mx, __shfl_xor(mx, 16)); mx = fmaxf(mx, __shfl_xor(mx, 32));
            const float pe = fexp(lgt - mx);
            float den = pe; den += __shfl_xor(den, 4); den += __shfl_xor(den, 8); den += __shfl_xor(den, 16); den += __shfl_xor(den, 32);
            const float mine = pe / den;
            if ((lane & 3) == 0) {
                if (isc) { const int cr = 8 * t + wave; AFFC[((size_t)(cr >> 8) * 16 + ex) * 256 + (cr & 255)] = mine; }
                else AFF[((size_t)(row >> 11) * 16 + ex) * 2048 + (row & 2047)] = mine;
            }
            } }
        }
    }
}

template <bool CTX>
__device__ __forceinline__ void topk_wave(unsigned char* ws, int item, int lane) {
    constexpr int NT = CTX ? 256 : 2048, CAP = CTX ? 32 : 256, PER = NT / 64;
    const int e = item & 15, b = item >> 4;
    const float* arow = (const float*)(ws + (CTX ? WS_AFFC : WS_AFF)) + (size_t)(b * 16 + e) * NT;
    float* gate = (float*)(ws + (CTX ? WS_GATEC : WS_GATE)) + (size_t)(b * 16 + e) * CAP;
    short* INV = (short*)(ws + WS_INV);
    int* rowidx = (int*)(ws + WS_ROWIDX) + (CTX ? ((128 + e) * 256 + b * 32) : ((b * 16 + e) * 256));
    unsigned v[PER];
#pragma unroll
    for (int i = 0; i < PER / 4; ++i) { const v4u q = *(const v4u*)(arow + lane * PER + 4 * i); v[4 * i] = q.x; v[4 * i + 1] = q.y; v[4 * i + 2] = q.z; v[4 * i + 3] = q.w; }
    unsigned T = 0;
    for (int bit = 29; bit >= 0; --bit) {
        const unsigned cand = T | (1u << bit); int c = 0;
#pragma unroll
        for (int i = 0; i < PER; ++i) c += __popcll(__ballot(v[i] >= cand));
        if (c >= CAP) T = cand;
    }
    int ngt = 0, cg = 0, ce = 0;
#pragma unroll
    for (int i = 0; i < PER; ++i) { ngt += __popcll(__ballot(v[i] > T)); cg += (v[i] > T) ? 1 : 0; ce += (v[i] == T) ? 1 : 0; }
    const int need = CAP - ngt;
    int pg = cg, pe = ce;
#pragma unroll
    for (int d = 1; d < 64; d <<= 1) { const int tg = __shfl_up(pg, d), te = __shfl_up(pe, d); if (lane >= d) { pg += tg; pe += te; } }
    pg -= cg; pe -= ce;
#pragma unroll
    for (int i = 0; i < PER; ++i) {
        const bool gt = v[i] > T, eq = v[i] == T;
        const bool sel = gt || (eq && pe < need);
        const int slot = pg + (pe < need ? pe : need);
        const int tok = lane * PER + i, grow = CTX ? (ML + b * CTXL + tok) : (b * SEQ + tok);
        if (sel) { rowidx[slot] = grow; gate[slot] = __uint_as_float(v[i]); }
        INV[(size_t)grow * 16 + e] = sel ? (short)slot : (short)-1;
        pg += gt ? 1 : 0; pe += eq ? 1 : 0;
    }
}

__device__ __forceinline__ void topk_wg2(unsigned char* ws, int item, LAS unsigned char* lds, int tid, int wave, int lane) {
    constexpr int CAP = 256;
    const int e = item & 15, b = item >> 4;
    const float* arow = (const float*)(ws + WS_AFF) + (size_t)(b * 16 + e) * 2048;
    float* gate = (float*)(ws + WS_GATE) + (size_t)(b * 16 + e) * CAP;
    short* INV = (short*)(ws + WS_INV);
    int* rowidx = (int*)(ws + WS_ROWIDX) + (b * 16 + e) * 256;
    LAS int* cnt = (LAS int*)lds;
    const v4u q = *(const v4u*)(arow + 4 * tid);
    const unsigned v[4] = {q.x, q.y, q.z, q.w};
    unsigned T = 0;
    __syncthreads();
    for (int bit = 29; bit >= 0; --bit) {
        const unsigned cand = T | (1u << bit); int c = 0;
#pragma unroll
        for (int i = 0; i < 4; ++i) c += __popcll(__ballot(v[i] >= cand));
        LAS int* cb = cnt + (bit & 1) * 8;
        if (lane == 0) cb[wave] = c;
        __syncthreads();
        int tot = 0;
#pragma unroll
        for (int w = 0; w < 8; ++w) tot += cb[w];
        if (tot >= CAP) T = cand;
    }
    int cg = 0, ce = 0, wg_ = 0, we_ = 0;
#pragma unroll
    for (int i = 0; i < 4; ++i) { wg_ += __popcll(__ballot(v[i] > T)); we_ += __popcll(__ballot(v[i] == T)); cg += (v[i] > T) ? 1 : 0; ce += (v[i] == T) ? 1 : 0; }
    if (lane == 0) { cnt[16 + wave] = wg_; cnt[24 + wave] = we_; }
    int pg = cg, pe = ce;
#pragma unroll
    for (int d = 1; d < 64; d <<= 1) { const int tg = __shfl_up(pg, d), te = __shfl_up(pe, d); if (lane >= d) { pg += tg; pe += te; } }
    pg -= cg; pe -= ce;
    __syncthreads();
    int ngt = 0;
#pragma unroll
    for (int w = 0; w < 8; ++w) { const int g_ = cnt[16 + w], e_ = cnt[24 + w]; ngt += g_; if (w < wave) { pg += g_; pe += e_; } }
    const int need = CAP - ngt;
#pragma unroll
    for (int i = 0; i < 4; ++i) {
        const bool gt = v[i] > T, eq = v[i] == T;
        const bool sel = gt || (eq && pe < need);
        const int slot = pg + (pe < need ? pe : need);
        const int grow = b * SEQ + 4 * tid + i;
        if (sel) { rowidx[slot] = grow; gate[slot] = __uint_as_float(v[i]); }
        INV[(size_t)grow * 16 + e] = sel ? (short)slot : (short)-1;
        pg += gt ? 1 : 0; pe += eq ? 1 : 0;
    }
}

__device__ __forceinline__ void phase_r5(const float* const* in, float* xout, unsigned char* ws, LAS unsigned char* lds, int l, bool upd, int G, int tid, int wave, int lane, bool dry) {
    const float* gains = in[6];
    const float* mod = (const float*)(ws + WS_MOD);
    const bf16_t* YE = (const bf16_t*)(ws + WS_R1); bf16_t* H = (bf16_t*)(ws + WS_H); bf16_t* XB = (bf16_t*)(ws + WS_XB);
    const float* GATE = (const float*)(ws + WS_GATE); const float* GATEC = (const float*)(ws + WS_GATEC); const short* INV = (const short*)(ws + WS_INV);
    LAS float* V = (LAS float*)lds;
    LAS int* CL = (LAS int*)(lds + 24576);
    for (int t = blockIdx.x; t < 256; t += G) {
        const int b = t >> 5;
        __syncthreads();
        for (int n = tid; n < 1024; n += 512) { const float gpf = gains[(size_t)l * 4096 + 3072 + n];
            V[n] = gpf * mod[((size_t)l * 9 + b) * 6144 + 5120 + n]; V[3072 + n] = gpf * mod[((size_t)l * 9 + 8) * 6144 + 5120 + n];
            if (l == 0) { const float gna = gains[4096 + n];
                V[1024 + n] = gna * (1.f + mod[((size_t)9 + b) * 6144 + 1024 + n]); V[2048 + n] = mod[((size_t)9 + b) * 6144 + n];
                V[4096 + n] = gna * (1.f + mod[((size_t)9 + 8) * 6144 + 1024 + n]); V[5120 + n] = mod[((size_t)9 + 8) * 6144 + n]; } }
        if (tid < (upd ? 72 : 64)) {
            const bool isc = tid >= 64; const int cr = 8 * t + (tid - 64);
            const int row = isc ? (ML + cr) : (64 * t + tid); const int bb = isc ? (cr >> 8) : b;
            const v4u i0 = *(const v4u*)(INV + (size_t)row * 16), i1 = *(const v4u*)(INV + (size_t)row * 16 + 8);
            const unsigned iw[8] = {i0.x, i0.y, i0.z, i0.w, i1.x, i1.y, i1.z, i1.w};
            float gv[16]; int sl[16];
#pragma unroll
            for (int e = 0; e < 16; ++e) { sl[e] = (int)(short)((iw[e >> 1] >> (16 * (e & 1))) & 0xffffu); const int s0 = sl[e] < 0 ? 0 : sl[e];
                gv[e] = isc ? GATEC[(size_t)(bb * 16 + e) * 32 + s0] : GATE[(size_t)(bb * 16 + e) * 256 + s0]; }
            int cnt = 0; LAS int* cl = CL + tid * 33;
#pragma unroll
            for (int e = 0; e < 16; ++e) if (sl[e] >= 0) { cl[1 + 2 * cnt] = isc ? ((128 + e) * 256 + bb * 32 + sl[e]) : ((bb * 16 + e) * 256 + sl[e]); cl[2 + 2 * cnt] = (int)__float_as_uint(gv[e]); ++cnt; }
            cl[0] = cnt;
        }
        __syncthreads();
        const int nrows = upd ? 9 : 8;
#pragma unroll 1
        for (int i0 = 0; i0 < 9; i0 += 3) {
            f32x4 xq[3][4];
#pragma unroll
            for (int k = 0; k < 3; ++k) { const int i = i0 + k; if (i < nrows) { const bool isc = (i == 8);
                ld_row_bf16(XB + (size_t)(isc ? (ML + 8 * t + wave) : (64 * t + 8 * wave + i)) * 1024, lane, xq[k]); } }
#pragma unroll
            for (int k = 0; k < 3; ++k) { const int i = i0 + k; if (i < nrows) {
            const bool isc = (i == 8);
            const int row = isc ? (ML + 8 * t + wave) : (64 * t + 8 * wave + i);
            LAS const float* vv = V + (isc ? 3072 : 0);
            LAS const int* cl = CL + (isc ? (64 + wave) : (8 * wave + i)) * 33;
            const int n = __builtin_amdgcn_readfirstlane(cl[0]);
            f32x4 acc[4];
#pragma unroll
            for (int j = 0; j < 4; ++j) acc[j] = (f32x4){0.f, 0.f, 0.f, 0.f};
            for (int j0 = 0; j0 < n; j0 += 4) {
                v2u raw[4][4]; float g[4];
#pragma unroll
                for (int q = 0; q < 4; ++q) {
                    if (j0 + q < n) { const int yr = __builtin_amdgcn_readfirstlane(cl[1 + 2 * (j0 + q)]); g[q] = __uint_as_float((unsigned)__builtin_amdgcn_readfirstlane(cl[2 + 2 * (j0 + q)]));
                        const bf16_t* yp = YE + (size_t)yr * 1024;
#pragma unroll
                        for (int j = 0; j < 4; ++j) raw[q][j] = *(const v2u*)(yp + 256 * j + 4 * lane); }
                    else { g[q] = 0.f;
#pragma unroll
                        for (int j = 0; j < 4; ++j) raw[q][j] = (v2u){0u, 0u}; }
                }
#pragma unroll
                for (int q = 0; q < 4; ++q)
#pragma unroll
                    for (int j = 0; j < 4; ++j) acc[j] += (f32x4){bflo(raw[q][j].x), bfhi(raw[q][j].x), bflo(raw[q][j].y), bfhi(raw[q][j].y)} * g[q];
            }
            const float rsm = __builtin_amdgcn_rsqf(wave_sum(sumsq16(acc)) * (1.f / 1024.f) + NEPS);
            f32x4 (&xv)[4] = xq[k]; f32x4 a[4]; ld_vec_lds(vv, lane, a);
#pragma unroll
            for (int j = 0; j < 4; ++j) xv[j] = xv[j] + a[j] * (acc[j] * rsm);
            if (l == 0) st_row_bf16((dry ? (bf16_t*)(ws + WS_R2) : XB) + (size_t)row * 1024, lane, xv);
            else st_row_f32((dry ? (float*)(ws + WS_R2) : xout) + (size_t)row * 1024, lane, xv);
            if (l == 0 && !dry) {
                const float rs2 = __builtin_amdgcn_rsqf(wave_sum(sumsq16(xv)) * (1.f / 1024.f) + NEPS);
                f32x4 s[4]; ld_vec_lds(vv + 1024, lane, a); ld_vec_lds(vv + 2048, lane, s);
#pragma unroll
                for (int j = 0; j < 4; ++j) xv[j] = xv[j] * rs2 * a[j] + s[j];
                st_row_bf16(H + (size_t)row * 1024, lane, xv);
            }
            } }
        }
    }
}
#ifndef MK_PER_PHASE
#define MK_PER_PHASE 0
#endif
constexpr int N_PHASES = 22;
struct Args { const float* in[18]; float* out; unsigned char* ws; int ph_lo, ph_hi; };
__device__ __forceinline__ const Args* kargs_opaque() {
    auto p = __builtin_amdgcn_kernarg_segment_ptr(); asm volatile("" : "+s"(p)); return (const Args*)p; }
#define PHASE_REGS() int tid = threadIdx.x; asm volatile("" : "+v"(tid)); const int lane = tid & 63, wave = __builtin_amdgcn_readfirstlane(tid >> 6); \
    const Args* A = kargs_opaque(); unsigned char* ws = A->ws; const int G = gridDim.x, bx = blockIdx.x; \
    const int vcu = (G % 8 == 0) ? (bx % 8) * (G / 8) + bx / 8 : bx; const int gw = vcu * NWAVES + wave, NGW = G * NWAVES; \
    LAS unsigned char* wl = lds + wave * WAVE_LDS; (void)gw; (void)NGW; (void)wl; (void)lane; (void)ws
#ifndef CONV_BUDGET
#define CONV_BUDGET 1
#endif
#ifndef PH_MASK
#define PH_MASK 0xFFFFFFFFu
#endif
#define EN(j) (((PH_MASK) >> (j)) & 1u)
#ifndef REP_MASK
#define REP_MASK 0u
#endif
#define REPS(j) ((((REP_MASK) >> (j)) & 1u) ? 2 : 1)
__global__ void __launch_bounds__(NWAVES * 64, 2) fwd_kernel(Args args) {
    extern __shared__ __attribute__((aligned(16))) unsigned char lds_raw[];
    LAS unsigned char* lds = (LAS unsigned char*)lds_raw;
    volatile LAS unsigned* MISC = (volatile LAS unsigned*)(lds + MISC_OFF);
    for (int u = threadIdx.x; u < (LDS_BYTES - LDSCTL_OFF) / 4; u += NWAVES * 64) ((LAS unsigned*)(lds + LDSCTL_OFF))[u] = 0u;
    __syncthreads();
    const int lo = args.ph_lo, hi = args.ph_hi;
    XcdBarrier bar; bar.bar = (unsigned*)(args.ws + WS_CTL) + CW_BAR; bar.x = 0; bar.st = nullptr;
    if (hi - lo > 1) bar = xcd_barrier_post((unsigned*)(args.ws + WS_CTL) + CW_BAR, MISC + 8);
#define IN(k) (lo <= (k) && (k) < hi)
#ifdef STAMP_A
#define STAMP(k) do { if (blockIdx.x == 0 && threadIdx.x == 0) ((unsigned long long*)(args.ws + WS_CTL))[1536 + (k)] = __builtin_amdgcn_s_memrealtime(); } while (0)
#else
#define STAMP(k) do { } while (0)
#endif
#define SEAM(k) do { if (IN((k) + 1)) { xcd_barrier(bar); if (REPS(12) == 2) xcd_barrier(bar); } STAMP((k) + 1); } while (0)
    STAMP(0);
    if (EN(0) && IN(0)) { for (int rep = 0; rep < REPS(0); ++rep) { PHASE_REGS(); phase_p0(A->in, ws, wl, gw, NGW, lane); } SEAM(0); }
    if (EN(1) && IN(1)) { for (int rep = 0; rep < REPS(1); ++rep) { PHASE_REGS(); phase_a0(A->in, ws, lds, G, tid, wave, lane); } SEAM(1); }
    for (int l = 0; l < 2; ++l) {
        const int base = 2 + 10 * l; const bool upd = (l == 0);
        if (EN(2) && IN(base + 0)) { for (int rep = 0; rep < REPS(2); ++rep) {
            PHASE_REGS();
            pg8::Gemm g{(const bf16_t*)(ws + WS_H), (const bf16_t*)(ws + WS_WIN) + (size_t)l * PP * 1024, MT, PP, 1024}; pg8::StaticOrder S; S.init(MT, PP, G, bx);
            pg8::EpiProj E{(bf16_t*)(ws + WS_R1), PP, (const pg8::f32x2*)(ws + WS_TAB), ML};
            pg8::gemm_phase<pg8::EpiProj, pg8::StaticOrder, true, true>(lds, g, S, E);
            if (!CONV_IN_P0) { const int nwg_ = (MT / 256) * (PP / 256); if ((nwg_ - bx + G - 1) / G < (nwg_ + G - 1) / G) conv_pull(A->in, ws, l, 1, 12 * CONV_BUDGET, (LAS float*)wl, lane); }
            }
            SEAM(base + 0);
        }
        if (EN(3) && IN(base + 1)) { for (int rep = 0; rep < REPS(3); ++rep) {
            PHASE_REGS();
            const bf16_t* PROJ = (const bf16_t*)(ws + WS_R1); bf16_t* MIX = (bf16_t*)(ws + WS_R2);
            const float* a_up = A->in[9] + (size_t)l * 2 * 16 * 128; const float* a_bias = A->in[10] + (size_t)l * 2 * 128;
            const float* rpb = A->in[12] + (size_t)l * 4 * 465; const float* sink = A->in[13] + (size_t)l * 8;
            const int n_cn = upd ? 128 : 0, n_cs = upd ? 256 : 0;
            const bool xmap = (G == 256);
            const int xcd = bx & 7, cu = bx >> 3;
            const int n_att = xmap ? 12 : 0;
            const int tail_total = (xmap ? 0 : 1024 + 2048) + 1152 + n_cn + n_cs;
            volatile LAS unsigned* qctr = (volatile LAS unsigned*)(lds + MISC_OFF) + 16 + l * 2 + rep;
            const int n_conv = 0, n_mix = (n_conv + 2) / 3 * 4;
            for (;;) {
                int j = 0; if (lane == 0) j = (int)__hip_atomic_fetch_add((LAS unsigned*)qctr, 1u, __ATOMIC_RELAXED, __HIP_MEMORY_SCOPE_WORKGROUP);
                j = __builtin_amdgcn_readfirstlane(j);
                if (j < n_mix) {
                    if ((j & 3) != 3) { const int ci = (j >> 2) * 3 + (j & 3), r = ci * G + bx; if (ci < n_conv && r < 12288 && !(rep + 1 < REPS(3))) expert_conv_item(A->in, ws, l, r, (LAS float*)wl, lane); continue; }
                    j = j >> 2;
                } else j = j - n_mix + n_mix / 4;
                int mode, item;
                if (j < n_att) {
                    if (j < 4) { mode = 0; item = (xcd * 4 + j) * 32 + cu; }
                    else { const int jj = j - 4, group = xcd * 2 + (jj >> 2), i = cu * 4 + (jj & 3); const int bb = group >> 1, hq = (group & 1) * 4 + (i >> 5); mode = 1; item = (i & 31) + 32 * hq + 256 * bb; }
                } else {
                    int r = (j - n_att) * G + bx;
                    if (r >= tail_total) break;
                    mode = -1; item = 0;
                    if (!xmap) { if (r < 1024) { mode = 0; item = r; } else if (r < 3072) { mode = 1; item = r - 1024; } r -= 3072; }
                    if (mode < 0) {
                        if (r < 1152) { if (rep + 1 < REPS(3)) continue; gla_local_item(PROJ, (float*)(ws + WS_UST), (float*)(ws + WS_DEC), r, wl, lane, a_up, a_bias); continue; } r -= 1152;
                        if (r < n_cs) { mode = 3; item = r; } else { mode = 2; item = r - n_cs; }
                    }
                }
                attn_item(mode, PROJ, MIX, item, wl, lane, rpb, sink, rep + 1 < REPS(3));
            }
            }
            SEAM(base + 1);
        }
        if (EN(4) && IN(base + 2)) { for (int rep = 0; rep < REPS(4); ++rep) {
            PHASE_REGS();
            for (int gid = bx * (NWAVES * 64) + tid; gid < 64 * 2048; gid += G * NWAVES * 64) gla_prefix((float*)(ws + WS_UST), (const float*)(ws + WS_DEC), gid, rep + 1 < REPS(4));
            }
            SEAM(base + 2);
        }
        if (EN(5) && IN(base + 3)) { for (int rep = 0; rep < REPS(5); ++rep) {
            PHASE_REGS();
            const float* a_up = A->in[9] + (size_t)l * 2 * 16 * 128; const float* a_bias = A->in[10] + (size_t)l * 2 * 128; const float* gnorm = A->in[11] + (size_t)l * 64;
            for (int it = gw; it < 1152; it += NGW) { if (!upd && (it % 36) < 4) continue;
                gla_out_item((const bf16_t*)(ws + WS_R1), (const float*)(ws + WS_UST), (bf16_t*)(ws + WS_R2), it, wl, lane, a_up, a_bias, gnorm); }
            }
            SEAM(base + 3);
        }
        if (EN(6) && IN(base + 4)) { for (int rep = 0; rep < REPS(6); ++rep) {
            PHASE_REGS();
            const int M2 = upd ? MT : ML;
            pg8::Gemm g{(const bf16_t*)(ws + WS_R2), (const bf16_t*)(ws + WS_WOUT) + (size_t)l * 1024 * 1024, M2, 1024, 1024}; pg8::StaticOrder S; S.init(M2, 1024, G, bx);
            pg8::EpiStore E{(bf16_t*)(ws + WS_R2 + (size_t)MT * 2048), 1024};
            pg8::gemm_phase<pg8::EpiStore, pg8::StaticOrder, true, true>(lds, g, S, E);
            if (!CONV_IN_P0) { const int nwg_ = (M2 / 256) * 4; if ((nwg_ - bx + G - 1) / G < (nwg_ + G - 1) / G) conv_pull(A->in, ws, l, 1, 3 * CONV_BUDGET, (LAS float*)wl, lane); }
            }
            SEAM(base + 4);
        }
        if (EN(7) && IN(base + 5)) { for (int rep = 0; rep < REPS(7); ++rep) { PHASE_REGS(); phase_r1(A->in, A->out, ws, lds, l, upd, G, tid, wave, lane, rep + 1 < REPS(7)); } SEAM(base + 5); }
        if (EN(8) && IN(base + 6)) { for (int rep = 0; rep < REPS(8); ++rep) {
            PHASE_REGS();
            if (!CONV_IN_P0) conv_pull(A->in, ws, l, l, 1 << 30, (LAS float*)wl, lane);
            for (int it = bx; it < 128; it += G) topk_wg2(ws, it, lds, tid, wave, lane);
            if (upd) { const int w2 = (bx >= 128 ? bx - 128 : bx + G - 128) * NWAVES + wave; for (int it = w2; it < 128; it += NGW) topk_wave<true>(ws, it, lane); }
            }
            SEAM(base + 6);
        }
        if (EN(9) && IN(base + 7)) { for (int rep = 0; rep < REPS(9); ++rep) {
            PHASE_REGS();
            pg8::Gemm g{(const bf16_t*)(ws + WS_H), (const bf16_t*)(ws + WS_WGU) + (size_t)l * 16 * 2048 * 1024, 0, 0, 1024, (const int*)(ws + WS_ROWIDX)}; pg8::MoeOrder S; S.init(upd ? 9 : 8, 8, G, bx);
            pg8::EpiSwiGLU E{(bf16_t*)(ws + WS_R2), 1024};
            pg8::gemm_phase<pg8::EpiSwiGLU, pg8::MoeOrder, true, true, true>(lds, g, S, E);
            if (!CONV_IN_P0) { const int nwg_ = 16 * (upd ? 9 : 8) * 8; if ((nwg_ - bx + G - 1) / G < (nwg_ + G - 1) / G) conv_pull(A->in, ws, l + 1, 1, 4 * CONV_BUDGET, (LAS float*)wl, lane); }
            }
            SEAM(base + 7);
        }
        if (EN(10) && IN(base + 8)) { for (int rep = 0; rep < REPS(10); ++rep) {
            PHASE_REGS();
            pg8::Gemm g{(const bf16_t*)(ws + WS_R2), (const bf16_t*)(ws + WS_WD) + (size_t)l * 16 * 1024 * 1024, 0, 0, 1024}; pg8::MoeOrder S; S.init(upd ? 9 : 8, 4, G, bx);
            pg8::EpiStore E{(bf16_t*)(ws + WS_R1), 1024};
            pg8::gemm_phase<pg8::EpiStore, pg8::MoeOrder, true, true>(lds, g, S, E);
            if (!CONV_IN_P0) { const int nwg_ = 16 * (upd ? 9 : 8) * 4; if ((nwg_ - bx + G - 1) / G < (nwg_ + G - 1) / G) conv_pull(A->in, ws, l + 1, 1, 3 * CONV_BUDGET, (LAS float*)wl, lane); }
            }
            SEAM(base + 8);
        }
        if (EN(11) && IN(base + 9)) { for (int rep = 0; rep < REPS(11); ++rep) { PHASE_REGS(); phase_r5(A->in, A->out, ws, lds, l, upd, G, tid, wave, lane, rep + 1 < REPS(11)); } SEAM(base + 9); }
    }
#ifdef STAMP_A
    if (blockIdx.x == 0 && threadIdx.x == 0) { const unsigned long long* st_ = (const unsigned long long*)(args.ws + WS_CTL) + 1536; const float d_ = (float)(st_[STAMP_B] - st_[STAMP_A]); args.out[0] = 200.f * floorf(d_ / 200.f + 0.5f); }
#endif
#undef IN
#undef SEAM
}

extern "C" void kernel_launch(void* const* d_in, const int* in_sizes, int n_in, void* d_out, int out_size, void* d_ws, size_t ws_size, hipStream_t stream) {
    static int grid = 0;
    if (grid == 0) {
        if (n_in != 18 || out_size != ML * DM || ws_size < WS_END) { fprintf(stderr, "kernel_launch: unexpected sizes: n_in %d out %d ws %zu (need %zu)\n", n_in, out_size, ws_size, (size_t)WS_END); grid = -1; return; }
        int dev = 0, cus = 0, per_cu = 0;
        if (hipGetDevice(&dev) != hipSuccess || hipDeviceGetAttribute(&cus, hipDeviceAttributeMultiprocessorCount, dev) != hipSuccess) { grid = -1; return; }
        if (hipFuncSetAttribute((const void*)fwd_kernel, hipFuncAttributeMaxDynamicSharedMemorySize, LDS_BYTES) != hipSuccess) { fprintf(stderr, "kernel_launch: hipFuncSetAttribute failed\n"); grid = -1; return; }
        if (hipOccupancyMaxActiveBlocksPerMultiprocessor(&per_cu, (const void*)fwd_kernel, NWAVES * 64, LDS_BYTES) != hipSuccess || per_cu < 1) { fprintf(stderr, "kernel_launch: occupancy query says %d blocks per CU\n", per_cu); (void)hipGetLastError(); grid = -1; return; }
        grid = cus;
    }
    if (grid < 0) return;
    (void)hipMemsetAsync((char*)d_ws + WS_CTL, 0, CTL_ZERO_BYTES, stream);
    Args a{};
    for (int i = 0; i < 18; ++i) a.in[i] = (const float*)d_in[i];
    a.out = (float*)d_out; a.ws = (unsigned char*)d_ws;
#if MK_PER_PHASE
    for (int p = 0; p < N_PHASES; ++p) { a.ph_lo = p; a.ph_hi = p + 1; hipLaunchKernelGGL(fwd_kernel, dim3(grid), dim3(NWAVES * 64), LDS_BYTES, stream, a); }
#else
    a.ph_lo = 0; a.ph_hi = N_PHASES;
    void* kargs[] = {&a};
    hipError_t e = hipLaunchCooperativeKernel((const void*)fwd_kernel, dim3(grid), dim3(NWAVES * 64), kargs, LDS_BYTES, stream);
    if (e != hipSuccess) fprintf(stderr, "kernel_launch: cooperative launch failed: %s (grid %d)\n", hipGetErrorString(e), grid);
#endif
}
```

```cpp
#include <hip/hip_runtime.h>
#include <cstdio>
#include <cstdint>
#include <cmath>

namespace pg8 {
#define PG8_LAS __attribute__((address_space(3)))
typedef unsigned short bf16_t;
typedef short bf16x8 __attribute__((ext_vector_type(8)));
typedef float f32x4 __attribute__((ext_vector_type(4)));
typedef unsigned u32x4 __attribute__((ext_vector_type(4)));
constexpr int BM = 256, BK = 64, HALF = 128, HTB = HALF * BK * 2  , STAGE_BYTES = 8 * HTB, NXCD = 8, WGM = 8;

__host__ __device__ __forceinline__ int lds_byte(int r, int c) { const int st = (r >> 4) * 2 + (c >> 5), rr = r & 15, cc = c & 31, ob = rr * 64 + cc * 2; return st * 1024 + (ob ^ (((ob >> 9) & 1) << 5)); }
__host__ __device__ __forceinline__ void stage_rc(int b, int& R, int& C) { const int st = b / 1024, sb = b % 1024, swz = sb ^ (((sb >> 9) & 1) << 5); R = (st >> 1) * 16 + swz / 64; C = (st & 1) * 32 + (swz % 64) / 2; }
__host__ __device__ __forceinline__ int perm32(int rho) { const int n = rho >> 4, i = rho & 15; return 8 * (i >> 2) + 4 * n + (i & 3); }

struct Unit { int pm, pn, pb; };
struct Gemm { const bf16_t* A; const bf16_t* Bt; int M, N, K; const int* rowidx; };

struct StaticOrder {
    int nM, nN, nwg, G, c;
    __host__ __device__ void init(int M, int N, int G_, int c_) { nM = M / BM; nN = N / BM; nwg = nM * nN; G = G_; c = c_; }
    __host__ __device__ bool next(int i, Unit& u) const {
        const long L = (long)i * G + c; if (L >= nwg) return false;
        int wgid = (int)L; { const int q = nwg / NXCD, r = nwg % NXCD, xcd = wgid % NXCD, off = wgid / NXCD; wgid = (xcd < r ? xcd * (q + 1) : r * (q + 1) + (xcd - r) * q) + off; }
        const int nig = WGM * nN, gid = wgid / nig, fm = gid * WGM, gsz = (nM - fm) < WGM ? (nM - fm) : WGM;
        u.pm = fm + ((wgid % nig) % gsz); u.pn = (wgid % nig) / gsz; u.pb = u.pn; return true;
    }
    __device__ __forceinline__ void a_ready(const Unit&) const {}
    __device__ __forceinline__ void done(const Unit&) const {}
};

__device__ __forceinline__ unsigned cvt_pk_bf16(float lo, float hi) { unsigned r; asm volatile("v_cvt_pk_bf16_f32 %0, %1, %2" : "=v"(r) : "v"(lo), "v"(hi)); return r; }
typedef float f32x2 __attribute__((ext_vector_type(2)));
#ifndef EPI_WT
#define EPI_WT 0
#endif
__device__ __forceinline__ void st16(bf16_t* base, size_t elem_off, u32x4 w) {
#if EPI_WT
    const __amdgpu_buffer_rsrc_t r = __builtin_amdgcn_make_buffer_rsrc((void*)base, 0, 0x7fffffff, 0x00020000);
    __builtin_amdgcn_raw_buffer_store_b128(w, r, (unsigned)(elem_off * 2), 0, 16);
#else
    *(u32x4*)(base + elem_off) = w;
#endif
}
struct EpiStore {
    static constexpr bool PERM = true, AFTER_DRAIN = false;
    bf16_t* O; int ldc;
    __device__ __forceinline__ void operator()(const f32x4 (&acc)[2][2][4][2], const Unit& u, int wr, int wc, int fr, int fq) const {
        const int row0 = u.pm * BM + wr * 64 + fr, col0 = u.pn * BM + wc * 32 + 8 * fq;
#pragma unroll
        for (int ai = 0; ai < 2; ++ai)
#pragma unroll
            for (int m = 0; m < 4; ++m) { bf16_t* rowp = O + (size_t)(row0 + ai * HALF + m * 16) * ldc + col0;
#pragma unroll
                for (int bj = 0; bj < 2; ++bj) { const f32x4 v0 = acc[ai][bj][m][0], v1 = acc[ai][bj][m][1];
                    u32x4 w; w.x = cvt_pk_bf16(v0[0], v0[1]); w.y = cvt_pk_bf16(v0[2], v0[3]); w.z = cvt_pk_bf16(v1[0], v1[1]); w.w = cvt_pk_bf16(v1[2], v1[3]);
                    st16(O, (size_t)(rowp - O) + bj * HALF, w); } }
    }
};
struct EpiProj {
    static constexpr bool PERM = true, AFTER_DRAIN = false;
    bf16_t* O; int ldc; const f32x2* tab; int ml;
    __device__ __forceinline__ void operator()(const f32x4 (&acc)[2][2][4][2], const Unit& u, int wr, int wc, int fr, int fq) const {
        const int row0 = u.pm * BM + wr * 64 + fr;
        const bool latent = (u.pm * BM) < ml;
#pragma unroll
        for (int bj = 0; bj < 2; ++bj) {
            const int c0 = u.pn * BM + bj * HALF + wc * 32;
            const bool rope = latent && ((c0 >= 928 && c0 < 1056) || (c0 >= 1824 && c0 < 2336));
            const bool rowhalf = (((c0 - 32) & 63) == 0);
            const bool qscale = (c0 >= 1568 && c0 < 2336);
#pragma unroll
            for (int ai = 0; ai < 2; ++ai)
#pragma unroll
                for (int m = 0; m < 4; ++m) {
                    const int row = row0 + ai * HALF + m * 16;
                    f32x4 v0 = acc[ai][bj][m][0], v1 = acc[ai][bj][m][1];
                    if (rope) {
                        const int t = row & 2047, pos = rowhalf ? (t >> 6) : (t & 63);
                        const f32x2* tp = tab + pos * 16 + 8 * (fq & 1);
                        const float sg = (fq < 2) ? -1.f : 1.f;
#pragma unroll
                        for (int e = 0; e < 4; ++e) {
                            const float x0 = v0[e], x1 = v1[e];
                            const float p0 = __shfl_xor(x0, 32), p1 = __shfl_xor(x1, 32);
                            const f32x2 c0s = tp[e], c1s = tp[4 + e];
                            v0[e] = x0 * c0s.x + sg * p0 * c0s.y; v1[e] = x1 * c1s.x + sg * p1 * c1s.y;
                        }
                    }
                    if (qscale) { v0 = v0 * 0.18033688011112042f; v1 = v1 * 0.18033688011112042f; }
                    u32x4 w; w.x = cvt_pk_bf16(v0[0], v0[1]); w.y = cvt_pk_bf16(v0[2], v0[3]); w.z = cvt_pk_bf16(v1[0], v1[1]); w.w = cvt_pk_bf16(v1[2], v1[3]);
                    st16(O, (size_t)row * ldc + c0 + 8 * fq, w);
                }
        }
    }
};
struct EpiSwiGLU {
    static constexpr bool PERM = true, AFTER_DRAIN = false;
    bf16_t* O; int ldc;
    __device__ __forceinline__ void operator()(const f32x4 (&acc)[2][2][4][2], const Unit& u, int wr, int wc, int fr, int fq) const {
        const int row0 = u.pm * BM + wr * 64 + fr, col0 = u.pn * HALF + wc * 32 + 8 * fq;
#pragma unroll
        for (int ai = 0; ai < 2; ++ai)
#pragma unroll
            for (int m = 0; m < 4; ++m) {
                float h[8];
#pragma unroll
                for (int n = 0; n < 2; ++n)
#pragma unroll
                    for (int e = 0; e < 4; ++e) { const float g = acc[ai][0][m][n][e], up = acc[ai][1][m][n][e];
                        h[n * 4 + e] = g * __builtin_amdgcn_rcpf(1.f + __builtin_amdgcn_exp2f(-1.4426950408889634f * g)) * up; }
                u32x4 w; w.x = cvt_pk_bf16(h[0], h[1]); w.y = cvt_pk_bf16(h[2], h[3]); w.z = cvt_pk_bf16(h[4], h[5]); w.w = cvt_pk_bf16(h[6], h[7]);
                st16(O, (size_t)(row0 + ai * HALF + m * 16) * ldc + col0, w);
            }
    }
};
struct MoeOrder {
    int npe, nN, nwg, G, c;
    __host__ __device__ void init(int npe_, int nN_, int G_, int c_) { npe = npe_; nN = nN_; nwg = 16 * npe * nN; G = G_; c = c_; }
    __host__ __device__ bool next(int i, Unit& u) const {
        const long L = (long)i * G + c; if (L >= nwg) return false;
        int wgid = (int)L; { const int q = nwg / NXCD, r = nwg % NXCD, xcd = wgid % NXCD, off = wgid / NXCD; wgid = (xcd < r ? xcd * (q + 1) : r * (q + 1) + (xcd - r) * q) + off; }
        const int per = npe * nN, e = wgid / per, rem = wgid % per, j = rem / nN, pn = rem % nN;
        u.pm = (j < 8) ? (j * 16 + e) : (128 + e); u.pn = pn; u.pb = e * nN + pn; return true;
    }
    __device__ __forceinline__ void a_ready(const Unit&) const {}
    __device__ __forceinline__ void done(const Unit&) const {}
};

template <class Epi, class Sched, bool ALIGN_EPI = false, bool SP2 = false, bool GATHER = false>
__device__ __forceinline__ void gemm_phase(PG8_LAS unsigned char* lds, const Gemm g, const Sched& S, const Epi& E) {
    int tid_ = threadIdx.x; asm volatile("" : "+v"(tid_));
    const int tid = tid_, wid = __builtin_amdgcn_readfirstlane(tid >> 6), lane = tid & 63, wr = wid >> 2, wc = wid & 3, fr = lane & 15, fq = lane >> 4;
    const int K = g.K, nt = K / BK;
    static_assert(!GATHER || SP2, "GATHER is wired into the SP2 loop only");
    unsigned voffA[2], voffB[2]; int RA[2], CA[2]; unsigned vAc[2][2], vAn[2][2];
#pragma unroll
    for (int i = 0; i < 2; ++i) { int R, C; stage_rc(tid * 16 + i * 8192, R, C); const int Rb = Epi::PERM ? ((R & ~31) + perm32(R & 31)) : R; RA[i] = R; CA[i] = C;
        voffA[i] = (unsigned)(R * K + C) * 2u; voffB[i] = (unsigned)(Rb * K + C) * 2u; vAc[0][i] = vAc[1][i] = vAn[0][i] = vAn[1][i] = 0u; }
    auto load_idx = [&](int pm, unsigned (&v)[2][2]) {
#pragma unroll
        for (int h = 0; h < 2; ++h)
#pragma unroll
            for (int i = 0; i < 2; ++i) v[h][i] = (unsigned)(g.rowidx[pm * BM + h * HALF + RA[i]] * K + CA[i]) * 2u;
    };
    const size_t kstep = (size_t)(BK * 2);
    const size_t hstep = (size_t)HALF * K * 2;
    const size_t tstep = 2 * hstep;
    const unsigned ldsw = (unsigned)wid * 1024u;
    const int aoff = lds_byte(wr * 64 + fr, fq * 8), boff = lds_byte(wc * 32 + fr, fq * 8);
#define PG8_SA(b, h) (((b) * 2 + (h)) * HTB)
#define PG8_SB(b, h) ((4 + (b) * 2 + (h)) * HTB)
#define PG8_STAGE(bufoff, gbase, voff) do { _Pragma("unroll") for (int _i = 0; _i < 2; ++_i) \
        __builtin_amdgcn_global_load_lds((const unsigned*)((const char*)(gbase) + (voff)[_i]), (PG8_LAS unsigned*)(lds + (bufoff) + ldsw + _i * 8192), 16, 0, 0); } while (0)
#define PG8_STAGE_A(bufoff, gbase, h, nx) do { if constexpr (GATHER) { const unsigned v_[2] = { (nx) ? vAn[h][0] : vAc[h][0], (nx) ? vAn[h][1] : vAc[h][1] }; PG8_STAGE(bufoff, gbase, v_); } \
        else { PG8_STAGE(bufoff, (gbase) + (h) * hstep, voffA); } } while (0)
#define PG8_LDA(dst, b, h) do { _Pragma("unroll") for (int m = 0; m < 4; ++m) _Pragma("unroll") for (int k = 0; k < 2; ++k) dst[m][k] = *(const PG8_LAS bf16x8*)(lds + PG8_SA(b, h) + aoff + m * 2048 + k * 1024); } while (0)
#define PG8_LDB(dst, b, h) do { _Pragma("unroll") for (int n = 0; n < 2; ++n) _Pragma("unroll") for (int k = 0; k < 2; ++k) dst[n][k] = *(const PG8_LAS bf16x8*)(lds + PG8_SB(b, h) + boff + n * 2048 + k * 1024); } while (0)
#define PG8_MMA(ai, bj, At, Bt) do { __builtin_amdgcn_s_setprio(1); _Pragma("unroll") for (int m = 0; m < 4; ++m) _Pragma("unroll") for (int n = 0; n < 2; ++n) _Pragma("unroll") for (int k = 0; k < 2; ++k) \
        acc[ai][bj][m][n] = __builtin_amdgcn_mfma_f32_16x16x32_bf16(Bt[n][k], At[m][k], acc[ai][bj][m][n], 0, 0, 0); __builtin_amdgcn_s_setprio(0); } while (0)
#define PG8_WAIT_V(n) asm volatile("s_waitcnt vmcnt(" #n ")" ::: "memory")
#define PG8_WAIT_L(n) asm volatile("s_waitcnt lgkmcnt(" #n ")" ::: "memory")
#define PG8_BAR __builtin_amdgcn_s_barrier()
#define PG8_SCHED __builtin_amdgcn_sched_barrier(0)
    Unit cur, nxt; int ui = 0;
    if (!S.next(0, cur)) return;
    f32x4 acc[2][2][4][2];
#pragma unroll
    for (int a = 0; a < 2; ++a)
#pragma unroll
        for (int b = 0; b < 2; ++b)
#pragma unroll
            for (int m = 0; m < 4; ++m)
#pragma unroll
                for (int n = 0; n < 2; ++n) acc[a][b][m][n] = (f32x4){0.f, 0.f, 0.f, 0.f};
    bf16x8 At[4][2], B0[2][2], B1[2][2];
    const char* cA = (const char*)g.A + (GATHER ? (size_t)0 : (size_t)cur.pm * tstep); const char* cB = (const char*)g.Bt + (size_t)cur.pb * tstep;
    if constexpr (GATHER) load_idx(cur.pm, vAc);
    S.a_ready(cur);
    if constexpr (SP2) {
        PG8_STAGE(PG8_SB(0, 0), cB, voffB); PG8_STAGE(PG8_SB(0, 1), cB + hstep, voffB); PG8_STAGE_A(PG8_SA(0, 0), cA, 0, false); PG8_STAGE_A(PG8_SA(0, 1), cA, 1, false);
        if (wr == 1) PG8_BAR;
        PG8_WAIT_V(2); PG8_BAR;
        PG8_STAGE(PG8_SB(1, 0), cB + kstep, voffB); PG8_STAGE_A(PG8_SA(1, 0), cA + kstep, 0, false); PG8_STAGE(PG8_SB(1, 1), cB + hstep + kstep, voffB);
        PG8_WAIT_V(6); PG8_BAR;
    } else {
        PG8_STAGE(PG8_SB(0, 0), cB, voffB); PG8_STAGE(PG8_SA(0, 0), cA, voffA); PG8_STAGE(PG8_SB(0, 1), cB + hstep, voffB); PG8_STAGE(PG8_SA(0, 1), cA + hstep, voffA);
        if (wr == 1) PG8_BAR;
        PG8_WAIT_V(4); PG8_BAR;
        PG8_STAGE(PG8_SB(1, 0), cB + kstep, voffB); PG8_STAGE(PG8_SA(1, 0), cA + kstep, voffA); PG8_STAGE(PG8_SB(1, 1), cB + hstep + kstep, voffB);
        PG8_WAIT_V(6); PG8_BAR;
    }
    for (;;) {
        const bool has_next = S.next(ui + 1, nxt);
        if constexpr (GATHER) { if (has_next) {
#pragma unroll
            for (int h = 0; h < 2; ++h)
#pragma unroll
                for (int i = 0; i < 2; ++i) __builtin_amdgcn_global_load_lds((const unsigned*)(g.rowidx + nxt.pm * BM + h * HALF + RA[i]), (PG8_LAS unsigned*)(lds + STAGE_BYTES + (h * 2 + i) * 2048 + wid * 256), 4, 0, 0); } }
        const char* nA = (has_next && !GATHER) ? (const char*)g.A + (size_t)nxt.pm * tstep : cA; const char* nB = has_next ? (const char*)g.Bt + (size_t)nxt.pb * tstep : cB;
        for (int t = 0; t < nt; t += 2) {
            const bool last = (t == nt - 2); const bool nxu = last && has_next; (void)nxu;
            if constexpr (GATHER) { if (nxu) {
#pragma unroll
                for (int h = 0; h < 2; ++h)
#pragma unroll
                    for (int i = 0; i < 2; ++i) { const int ix = *(const PG8_LAS int*)(lds + STAGE_BYTES + (h * 2 + i) * 2048 + tid * 4); vAn[h][i] = (unsigned)(ix * K + CA[i]) * 2u; } } }
            const char* a1 = cA + (size_t)(t + 1) * kstep;
            const char* a2 = last ? nA : cA + (size_t)(t + 2) * kstep; const char* b2 = last ? nB : cB + (size_t)(t + 2) * kstep;
            const char* a3 = a2 + kstep; const char* b3 = b2 + kstep;
            if (last && has_next) S.a_ready(nxt);
            if constexpr (SP2) {
            PG8_LDB(B0, 0, 0); PG8_LDB(B1, 0, 1); PG8_SCHED; PG8_LDA(At, 0, 0); PG8_STAGE_A(PG8_SA(1, 1), a1, 1, false);
            PG8_WAIT_V(8); PG8_WAIT_L(0); PG8_BAR; PG8_MMA(0, 0, At, B0); PG8_MMA(0, 1, At, B1); PG8_BAR; PG8_SCHED;
            PG8_LDA(At, 0, 1); PG8_STAGE(PG8_SB(0, 0), b2, voffB); PG8_STAGE(PG8_SB(0, 1), b2 + hstep, voffB); PG8_STAGE_A(PG8_SA(0, 0), a2, 0, nxu);
            PG8_WAIT_V(8); PG8_WAIT_L(0); PG8_BAR; PG8_MMA(1, 0, At, B0); PG8_MMA(1, 1, At, B1); PG8_BAR; PG8_SCHED;
            PG8_LDB(B0, 1, 0); PG8_LDB(B1, 1, 1); PG8_SCHED; PG8_LDA(At, 1, 0); PG8_STAGE_A(PG8_SA(0, 1), a2, 1, nxu);
            PG8_WAIT_V(8); PG8_WAIT_L(0); PG8_BAR; PG8_MMA(0, 0, At, B0); PG8_MMA(0, 1, At, B1); PG8_BAR; PG8_SCHED;
            PG8_LDA(At, 1, 1); PG8_STAGE(PG8_SB(1, 0), b3, voffB); PG8_STAGE(PG8_SB(1, 1), b3 + hstep, voffB); PG8_STAGE_A(PG8_SA(1, 0), a3, 0, nxu);
            PG8_WAIT_V(8); PG8_WAIT_L(0); PG8_BAR; PG8_MMA(1, 0, At, B0); PG8_MMA(1, 1, At, B1); PG8_BAR; PG8_SCHED;
            } else {
            PG8_LDB(B0, 0, 0); PG8_SCHED; PG8_LDA(At, 0, 0); PG8_STAGE(PG8_SA(1, 1), a1 + hstep, voffA);
            PG8_WAIT_L(8); PG8_BAR; PG8_WAIT_L(0); PG8_MMA(0, 0, At, B0); PG8_BAR; PG8_SCHED;
            PG8_LDB(B1, 0, 1); PG8_STAGE(PG8_SB(0, 0), b2, voffB);
            PG8_BAR; PG8_WAIT_L(0); PG8_MMA(0, 1, At, B1); PG8_BAR;
            PG8_LDA(At, 0, 1); PG8_STAGE(PG8_SA(0, 0), a2, voffA);
            PG8_BAR; PG8_WAIT_L(0); PG8_MMA(1, 0, At, B0); PG8_BAR; PG8_SCHED;
            PG8_STAGE(PG8_SB(0, 1), b2 + hstep, voffB);
            PG8_WAIT_V(6); PG8_BAR; PG8_MMA(1, 1, At, B1); PG8_BAR;
            PG8_LDB(B0, 1, 0); PG8_SCHED; PG8_LDA(At, 1, 0); PG8_STAGE(PG8_SA(0, 1), a2 + hstep, voffA);
            PG8_WAIT_L(8); PG8_BAR; PG8_WAIT_L(0); PG8_MMA(0, 0, At, B0); PG8_BAR; PG8_SCHED;
            PG8_LDB(B1, 1, 1); PG8_STAGE(PG8_SB(1, 0), b3, voffB);
            PG8_BAR; PG8_WAIT_L(0); PG8_MMA(0, 1, At, B1); PG8_BAR;
            PG8_LDA(At, 1, 1); PG8_STAGE(PG8_SA(1, 0), a3, voffA);
            PG8_BAR; PG8_WAIT_L(0); PG8_MMA(1, 0, At, B0); PG8_BAR; PG8_SCHED;
            PG8_STAGE(PG8_SB(1, 1), b3 + hstep, voffB);
            PG8_WAIT_V(6); PG8_BAR; PG8_MMA(1, 1, At, B1); PG8_BAR;
            }
        }
        if constexpr (ALIGN_EPI) { if (wr == 0) PG8_BAR; }
        if constexpr (!Epi::AFTER_DRAIN) { E(acc, cur, wr, wc, fr, fq); S.done(cur); }
        if (!has_next) break;
#pragma unroll
        for (int a = 0; a < 2; ++a)
#pragma unroll
            for (int b = 0; b < 2; ++b)
#pragma unroll
                for (int m = 0; m < 4; ++m)
#pragma unroll
                    for (int n = 0; n < 2; ++n) acc[a][b][m][n] = (f32x4){0.f, 0.f, 0.f, 0.f};
        cur = nxt; cA = nA; cB = nB; ++ui;
        if constexpr (GATHER) {
#pragma unroll
            for (int h = 0; h < 2; ++h) { vAc[h][0] = vAn[h][0]; vAc[h][1] = vAn[h][1]; } }
        if constexpr (ALIGN_EPI) { if (wr == 1) PG8_BAR; }
    }
    PG8_WAIT_V(0);
    if constexpr (!ALIGN_EPI) { if (wr == 0) PG8_BAR; }
    PG8_BAR;
    if constexpr (Epi::AFTER_DRAIN) { E.fused(acc, cur, wr, wc, fr, fq, lds, wid, lane); S.done(cur); }
#undef PG8_SA
#undef PG8_SB
#undef PG8_STAGE
#undef PG8_STAGE_A
#undef PG8_LDA
#undef PG8_LDB
#undef PG8_MMA
#undef PG8_WAIT_V
#undef PG8_WAIT_L
#undef PG8_BAR
#undef PG8_SCHED
}
}
constexpr int NB = 8, SEQ = 2048, DM = 1024, CTXL = 256, ML = NB * SEQ, MC = NB * CTXL, MT = ML + MC;
constexpr int PP = 2560;
constexpr int INW = 2336;
constexpr int C_GK = 0, C_GV = 128, C_GAF = 384, C_GAB = 400, C_NK = 416, C_NV = 672, C_SK = 928, C_SV = 1056, C_GQ = 1184, C_GG = 1312, C_NQ = 1568, C_SQ = 1824;
constexpr int NWAVES = 8;
constexpr float NEPS = 1e-6f;
constexpr float LOG2E = 1.4426950408889634f;

constexpr size_t MiB = 1u << 20;
constexpr size_t WS_CTL = 0, CTL_ZERO_BYTES = 65536;
constexpr size_t WS_TAB = 1 * MiB;
constexpr size_t WS_MOD = 1 * MiB + 65536;
constexpr size_t WS_MODP = 2 * MiB;
constexpr size_t WS_WIN = 6 * MiB;
constexpr size_t WS_WOUT = 16 * MiB;
constexpr size_t WS_WGU = 20 * MiB;
constexpr size_t WS_WD = 148 * MiB;
constexpr size_t WS_H = 212 * MiB;
constexpr size_t WS_R1 = 248 * MiB;
constexpr size_t WS_R2 = 338 * MiB;
constexpr size_t WS_XB = 410 * MiB;
constexpr size_t WS_UST = 446 * MiB;
constexpr size_t WS_MISC = 464 * MiB;
constexpr size_t WS_DEC = WS_MISC;
constexpr size_t WS_AFF = WS_MISC + 1 * MiB;
constexpr size_t WS_AFFC = WS_MISC + 2 * MiB;
constexpr size_t WS_GATE = WS_MISC + 2 * MiB + 262144;
constexpr size_t WS_GATEC = WS_MISC + 2 * MiB + 524288;
constexpr size_t WS_INV = WS_MISC + 3 * MiB;
constexpr size_t WS_ROWIDX = WS_MISC + 3 * MiB + 786432;
constexpr size_t WS_END = 468 * MiB;
constexpr int CW_BAR = 4096;
constexpr int CW_QUEUE = 1024;
constexpr int CW_CONV = 2048;

constexpr int WAVE_LDS = 19456;
constexpr int RING_BYTES = NWAVES * WAVE_LDS;
constexpr int LDSCTL_OFF = RING_BYTES, MISC_OFF = LDSCTL_OFF + 320;
constexpr int LDS_BYTES = RING_BYTES + 1024;
static_assert(RING_BYTES >= pg8::STAGE_BYTES && LDS_BYTES <= 163840, "LDS map");

#define GAS __attribute__((address_space(1)))
#define LAS __attribute__((address_space(3)))
typedef unsigned short bf16_t;
typedef unsigned v4u __attribute__((ext_vector_type(4)));
typedef unsigned v2u __attribute__((ext_vector_type(2)));
typedef float f32x4 __attribute__((ext_vector_type(4)));
typedef float f32x2 __attribute__((ext_vector_type(2)));
typedef float f32x16 __attribute__((ext_vector_type(16)));
typedef short bf16x8 __attribute__((ext_vector_type(8)));
typedef short s16x4 __attribute__((ext_vector_type(4)));
typedef GAS unsigned gu32;
#define RLX_AGENT __ATOMIC_RELAXED, __HIP_MEMORY_SCOPE_AGENT
typedef __bf16 bf16x2_t __attribute__((ext_vector_type(2)));
__device__ __forceinline__ unsigned pk2(float lo, float hi) { f32x2 v = {lo, hi}; bf16x2_t b = __builtin_convertvector(v, bf16x2_t); return __builtin_bit_cast(unsigned, b); }
__device__ __forceinline__ float bflo(unsigned w) { return __uint_as_float(w << 16); }
__device__ __forceinline__ float bfhi(unsigned w) { return __uint_as_float(w & 0xffff0000u); }
__device__ __forceinline__ float bf1(bf16_t w) { return __uint_as_float((unsigned)w << 16); }
__device__ __forceinline__ float wave_sum(float v) {
#pragma unroll
    for (int o = 1; o < 64; o <<= 1) v += __shfl_xor(v, o);
    return v;
}
__device__ __forceinline__ float fexp2(float x) { return __builtin_amdgcn_exp2f(x); }
__device__ __forceinline__ float fexp(float x) { return __builtin_amdgcn_exp2f(x * LOG2E); }
__device__ __forceinline__ float flog(float x) { return __builtin_amdgcn_logf(x) * 0.6931471805599453f; }
__device__ __forceinline__ float frcp(float x) { return __builtin_amdgcn_rcpf(x); }
__device__ __forceinline__ float silu_f(float x) { return x * frcp(1.f + fexp(-x)); }
__device__ __forceinline__ int crow(int r, int hi) { return (r & 3) + 8 * (r >> 2) + 4 * hi; }
__device__ __forceinline__ s16x4 tr_read(LAS const unsigned char* p) { return __builtin_bit_cast(s16x4, __builtin_amdgcn_ds_read_tr16_b64_v4i16((LAS s16x4*)p)); }
__device__ __forceinline__ bf16x8 cat4(s16x4 a, s16x4 b) { return (bf16x8){a[0], a[1], a[2], a[3], b[0], b[1], b[2], b[3]}; }
__device__ __forceinline__ bf16x8 pack8(float a0, float a1, float a2, float a3, float a4, float a5, float a6, float a7) {
    v4u w; w.x = pk2(a0, a1); w.y = pk2(a2, a3); w.z = pk2(a4, a5); w.w = pk2(a6, a7); return __builtin_bit_cast(bf16x8, w); }
#define MFMA32(a, b, c) __builtin_amdgcn_mfma_f32_32x32x16_bf16((a), (b), (c), 0, 0, 0)

#ifndef EARLY_WB
#define EARLY_WB 0
#endif
#define XB_TMO      128
#define XB_XCNT(j)  (256  + 64 * (j))
#define XB_XSUB(j)  (1280 + 64 * (j))
#define XB_XGEN(j)  (2304 + 64 * (j))
#define XB_TOP      3328
#define XB_TOPGEN   3392
#define XCD_BAR_WORDS 3456
#define XB_SPIN_CAP (1u << 18)

__device__ __forceinline__ unsigned xb_ld(unsigned* p)              { return __hip_atomic_load(p, __ATOMIC_RELAXED, __HIP_MEMORY_SCOPE_AGENT); }
__device__ __forceinline__ unsigned xb_add(unsigned* p, unsigned v) { return __hip_atomic_fetch_add(p, v, __ATOMIC_RELAXED, __HIP_MEMORY_SCOPE_AGENT); }
__device__ __forceinline__ unsigned xb_xcc_id() { return (unsigned)__builtin_amdgcn_s_getreg((3 << 11) | 20) & 0xFu; }
#define XB_SPIN(cond, bar) do { unsigned _sp = 0; while (cond) { __builtin_amdgcn_s_sleep(1); \
    if ((++_sp & 255u) == 0u) { if (xb_ld(&(bar)[XB_TMO])) break; if (_sp > XB_SPIN_CAP) { atomicAdd(&(bar)[XB_TMO], 1u); break; } } } } while (0)

struct XcdBarrier {
    unsigned* bar; unsigned x;
    volatile LAS unsigned* st;
};

__device__ __forceinline__ XcdBarrier xcd_barrier_post(unsigned* bar, volatile LAS unsigned* st) {
    XcdBarrier b; b.bar = bar; b.x = xb_xcc_id(); b.st = st;
    if (threadIdx.x == 0) (void)xb_add(&bar[XB_XCNT(b.x)], 1u);
    return b;
}
__device__ __forceinline__ void xcd_barrier_complete(unsigned* bar, unsigned x, unsigned& nloc, unsigned& nx) {
    const unsigned G = gridDim.x * gridDim.y * gridDim.z;
    unsigned sum, cnt, mine, sp = 0u;
    for (;;) {
        sum = 0u; cnt = 0u; mine = 0u;
#pragma unroll
        for (unsigned j = 0; j < 16; ++j) { const unsigned c = xb_ld(&bar[XB_XCNT(j)]); sum += c; cnt += (c > 0u) ? 1u : 0u; mine = (j == x) ? c : mine; }
        if (sum == G) break;
        __builtin_amdgcn_s_sleep(1);
        if ((++sp & 255u) == 0u) { if (xb_ld(&bar[XB_TMO])) break; if (sp > XB_SPIN_CAP) { atomicAdd(&bar[XB_TMO], 1u); break; } }
    }
    nloc = mine > 0u ? mine : 1u; nx = cnt > 0u ? cnt : 1u;
}

__device__ __forceinline__ void xcd_barrier(const XcdBarrier& b) {
    asm volatile("s_waitcnt vmcnt(0)" ::: "memory");
    __syncthreads();
    if (threadIdx.x == 0) {
        unsigned* bar = b.bar;
        __builtin_amdgcn_s_waitcnt(0);
        unsigned nloc = b.st[0], nx = b.st[1];
        if (nloc == 0u) { xcd_barrier_complete(bar, b.x, nloc, nx); b.st[0] = nloc; b.st[1] = nx; }
#if EARLY_WB
        __builtin_amdgcn_fence(__ATOMIC_RELEASE, "agent");
        asm volatile("s_waitcnt vmcnt(0)" ::: "memory");
#endif
        const unsigned old = xb_add(&bar[XB_XSUB(b.x)], 1u);
        const unsigned gen = old / nloc;
        if (old + 1u == (gen + 1u) * nloc) {
            __builtin_amdgcn_fence(__ATOMIC_RELEASE, "agent");
            asm volatile("s_waitcnt vmcnt(0)" ::: "memory");
            const unsigned og = xb_add(&bar[XB_TOP], 1u);
            const unsigned tg = og / nx;
            if (og + 1u == (tg + 1u) * nx) xb_add(&bar[XB_TOPGEN], 1u);
            else XB_SPIN(xb_ld(&bar[XB_TOPGEN]) == tg, bar);
            __builtin_amdgcn_fence(__ATOMIC_ACQUIRE, "agent");
            xb_add(&bar[XB_XGEN(b.x)], 1u);
            asm volatile("s_waitcnt vmcnt(0)" ::: "memory");
        } else {
            XB_SPIN(xb_ld(&bar[XB_XGEN(b.x)]) == gen, bar);
            __builtin_amdgcn_fence(__ATOMIC_ACQUIRE, "agent");
            asm volatile("s_waitcnt vmcnt(0)" ::: "memory");
        }
    }
    __syncthreads();
}
__device__ __forceinline__ void ld_row_f32(const float* p, int lane, f32x4 (&v)[4]) {
#pragma unroll
    for (int j = 0; j < 4; ++j) v[j] = *(const f32x4*)(p + 256 * j + 4 * lane);
}
__device__ __forceinline__ void st_row_f32(float* p, int lane, const f32x4 (&v)[4]) {
#pragma unroll
    for (int j = 0; j < 4; ++j) *(f32x4*)(p + 256 * j + 4 * lane) = v[j];
}
__device__ __forceinline__ void ld_row_bf16(const bf16_t* p, int lane, f32x4 (&v)[4]) {
#pragma unroll
    for (int j = 0; j < 4; ++j) { const v2u w = *(const v2u*)(p + 256 * j + 4 * lane); v[j] = (f32x4){bflo(w.x), bfhi(w.x), bflo(w.y), bfhi(w.y)}; }
}
__device__ __forceinline__ void st_row_bf16(bf16_t* p, int lane, const f32x4 (&v)[4]) {
#pragma unroll
    for (int j = 0; j < 4; ++j) { v2u w; w.x = pk2(v[j].x, v[j].y); w.y = pk2(v[j].z, v[j].w); *(v2u*)(p + 256 * j + 4 * lane) = w; }
}
__device__ __forceinline__ void ld_vec_lds(LAS const float* p, int lane, f32x4 (&v)[4]) {
#pragma unroll
    for (int j = 0; j < 4; ++j) v[j] = *(LAS const f32x4*)(p + 256 * j + 4 * lane);
}
__device__ __forceinline__ float sumsq16(const f32x4 (&v)[4]) {
    float s = 0.f;
#pragma unroll
    for (int j = 0; j < 4; ++j) s += (v[j].x * v[j].x + v[j].y * v[j].y) + (v[j].z * v[j].z + v[j].w * v[j].w);
    return s;
}
__device__ __forceinline__ float modfin(const float* modp, const float* bmod, int l, int r, int n) {
    float s = bmod[l * 6144 + n];
#pragma unroll
    for (int kc = 0; kc < 8; ++kc) s += modp[((size_t)(l * 8 + kc) * 9 + r) * 6144 + n];
    return s;
}

#ifndef CV_G1
#define CV_G1 4
#endif
#ifndef CV_G2
#define CV_G2 6
#endif
#ifndef CV_G3
#define CV_G3 5
#endif
#ifndef CV_G4
#define CV_G4 1
#endif
#ifndef CONV_M3
#define CONV_M3 5376
#endif
#ifndef CONV_IN_P0
#define CONV_IN_P0 1
#endif
__device__ __forceinline__ void tr_item64(const float* W, int N, int Nvalid, bf16_t* WT, int Kd, int k0, int n0, int dst_row0, LAS float* scr, int lane) {
    const int q = lane & 15, kr = lane >> 4;
    f32x4 t[16];
#pragma unroll
    for (int i = 0; i < 16; ++i) { const int kk = 4 * i + kr; const int n = n0 + 4 * q;
        t[i] = (n < Nvalid) ? *(const f32x4*)(W + (size_t)(k0 + kk) * N + n) : (f32x4){0.f, 0.f, 0.f, 0.f}; }
#pragma unroll
    for (int i = 0; i < 16; ++i) { const int kk = 4 * i + kr; LAS float* d = scr + kk * 65 + 4 * q; d[0] = t[i].x; d[1] = t[i].y; d[2] = t[i].z; d[3] = t[i].w; }
    const int c = lane & 7, nl = lane >> 3;
#pragma unroll
    for (int j = 0; j < 8; ++j) { const int n = nl + 8 * j; LAS const float* s = scr + (8 * c) * 65 + n;
        v4u o; o.x = pk2(s[0 * 65], s[1 * 65]); o.y = pk2(s[2 * 65], s[3 * 65]); o.z = pk2(s[4 * 65], s[5 * 65]); o.w = pk2(s[6 * 65], s[7 * 65]);
        *(v4u*)(WT + (size_t)(dst_row0 + n) * Kd + k0 + 8 * c) = o; }
}
__device__ __forceinline__ void expert_conv_item(const float* const* in, unsigned char* ws, int l, int r, LAS float* scr, int lane) {
    const float* w_gate = in[15]; const float* w_up = in[16]; const float* w_down = in[17];
    const int which = r >> 12; r &= 4095;
    const int e = r >> 8, kb = (r & 255) >> 4, nb = r & 15, n0 = 64 * nb;
    const size_t eoff = (size_t)(l * 16 + e) * 1024 * 1024;
    if (which == 0) tr_item64(w_gate + eoff, 1024, 1024, (bf16_t*)(ws + WS_WGU) + 2 * eoff, 1024, 64 * kb, n0, (n0 >> 7) * 256 + (n0 & 127), scr, lane);
    else if (which == 1) tr_item64(w_up + eoff, 1024, 1024, (bf16_t*)(ws + WS_WGU) + 2 * eoff, 1024, 64 * kb, n0, (n0 >> 7) * 256 + 128 + (n0 & 127), scr, lane);
    else tr_item64(w_down + eoff, 1024, 1024, (bf16_t*)(ws + WS_WD) + eoff, 1024, 64 * kb, n0, n0, scr, lane);
}
__device__ __forceinline__ void conv_pull(const float* const* in, unsigned char* ws, int l_lo, int l_hi, int budget, LAS float* scr, int lane) {
    for (int l = l_lo; l <= l_hi && l < 2; ++l) {
        unsigned* ctr = (unsigned*)(ws + WS_CTL) + CW_CONV + 64 * l;
        while (budget > 0) {
            const int c = budget < 8 ? budget : 8;
            unsigned r = 0; if (lane == 0) r = __hip_atomic_fetch_add(ctr, (unsigned)c, __ATOMIC_RELAXED, __HIP_MEMORY_SCOPE_AGENT);
            r = (unsigned)__builtin_amdgcn_readfirstlane((int)r);
            if (r >= 12288u) break;
            for (int k = 0; k < c && (int)r + k < 12288; ++k) expert_conv_item(in, ws, l, (int)r + k, scr, lane);
            budget -= c;
        }
    }
}
struct TrDesc { const float* src; bf16_t* dst; int N, Nvalid, k0, n0, drow; };
constexpr int TR_IN = 16 * 40, TR_OUT = 16 * 16, TR_E = 16 * 16 * 16, TR_L = TR_IN + TR_OUT + 3 * TR_E, TR_ALL = 2 * TR_L;
constexpr int CV_N1 = CV_G1 * 384, CV_N2 = CV_G2 * 1792, CV_N3 = CV_G3 * 1024, CV_N4 = CV_G4 * 1536;
constexpr int P0_A = TR_L - CV_N1 - CV_N2;
constexpr int P0_B = TR_ALL - CONV_M3 - CV_N3 - CV_N4;
static_assert(P0_A >= 896 && P0_B >= TR_L + 896, "tail conversion budgets exceed the expert tiles");
__device__ __forceinline__ void tr_desc(const float* const* in, unsigned char* ws, int r, TrDesc& d) {
    const int l = r / TR_L; r -= l * TR_L;
    if (r < TR_IN) { const int kb = r / 40, nb = r % 40; d.src = in[7] + (size_t)l * 1024 * INW; d.dst = (bf16_t*)(ws + WS_WIN) + (size_t)l * PP * 1024; d.N = INW; d.Nvalid = INW; d.k0 = 64 * kb; d.n0 = 64 * nb; d.drow = 64 * nb; return; }
    r -= TR_IN;
    if (r < TR_OUT) { const int kb = r / 16, nb = r % 16; d.src = in[8] + (size_t)l * 1024 * 1024; d.dst = (bf16_t*)(ws + WS_WOUT) + (size_t)l * 1024 * 1024; d.N = 1024; d.Nvalid = 1024; d.k0 = 64 * kb; d.n0 = 64 * nb; d.drow = 64 * nb; return; }
    r -= TR_OUT;
    const int which = r >> 12; r &= 4095;
    const int e = r >> 8, kb = (r & 255) >> 4, nb = r & 15, n0 = 64 * nb;
    const size_t eoff = (size_t)(l * 16 + e) * 1024 * 1024;
    d.N = 1024; d.Nvalid = 1024; d.k0 = 64 * kb; d.n0 = n0;
    if (which == 0) { d.src = in[15] + eoff; d.dst = (bf16_t*)(ws + WS_WGU) + 2 * eoff; d.drow = (n0 >> 7) * 256 + (n0 & 127); }
    else if (which == 1) { d.src = in[16] + eoff; d.dst = (bf16_t*)(ws + WS_WGU) + 2 * eoff; d.drow = (n0 >> 7) * 256 + 128 + (n0 & 127); }
    else { d.src = in[17] + eoff; d.dst = (bf16_t*)(ws + WS_WD) + eoff; d.drow = n0; }
}
__device__ __forceinline__ void tr_load(const TrDesc& d, int lane, f32x4 (&t)[16]) {
    const int q = lane & 15, kr = lane >> 4, n = d.n0 + 4 * q;
    const float* p = d.src + (size_t)(d.k0 + kr) * d.N + (n < d.Nvalid ? n : 0);
#pragma unroll
    for (int i = 0; i < 16; ++i) t[i] = *(const f32x4*)(p + (size_t)(4 * i) * d.N);
}
__device__ __forceinline__ void tr_finish(const TrDesc& d, f32x4 (&t)[16], LAS float* scr, int lane) {
    const int q = lane & 15, kr = lane >> 4; const bool valid = (d.n0 + 4 * q) < d.Nvalid;
#pragma unroll
    for (int i = 0; i < 16; ++i) { const int kk = 4 * i + kr; LAS float* s = scr + kk * 65 + 4 * q; const f32x4 v = valid ? t[i] : (f32x4){0.f, 0.f, 0.f, 0.f}; s[0] = v.x; s[1] = v.y; s[2] = v.z; s[3] = v.w; }
    const int c = lane & 7, nl = lane >> 3;
#pragma unroll
    for (int j = 0; j < 8; ++j) { const int n = nl + 8 * j; LAS const float* s = scr + (8 * c) * 65 + n;
        v4u o; o.x = pk2(s[0 * 65], s[1 * 65]); o.y = pk2(s[2 * 65], s[3 * 65]); o.z = pk2(s[4 * 65], s[5 * 65]); o.w = pk2(s[6 * 65], s[7 * 65]);
        *(v4u*)(d.dst + (size_t)(d.drow + n) * 1024 + d.k0 + 8 * c) = o; }
}
__device__ __forceinline__ void tr_stream(const float* const* in, unsigned char* ws, int first, int stride, int hi, LAS float* scr, int lane, int cut = 1 << 30, int jump = 0) {
#define TR_ID(x) ((x) < cut ? (x) : (x) + jump)
    if (first >= hi) return;
    const int n_my = (hi - first + stride - 1) / stride;
    TrDesc dA, dB; f32x4 tA[16], tB[16];
    tr_desc(in, ws, TR_ID(first), dA); tr_load(dA, lane, tA);
    for (int i = 0; i < n_my; i += 2) {
        { const int nx = i + 1 < n_my ? i + 1 : n_my - 1; tr_desc(in, ws, TR_ID(first + nx * stride), dB); tr_load(dB, lane, tB); }
        tr_finish(dA, tA, scr, lane);
        if (i + 1 >= n_my) break;
        { const int nx = i + 2 < n_my ? i + 2 : n_my - 1; tr_desc(in, ws, TR_ID(first + nx * stride), dA); tr_load(dA, lane, tA); }
        tr_finish(dB, tB, scr, lane);
    }
#undef TR_ID
}
__device__ __forceinline__ void phase_p0(const float* const* in, unsigned char* ws, LAS unsigned char* wl, int gw, int NGW, int lane) {
    const float* cvec = in[1]; const float* cctx = in[3]; const float* wmod = in[4];
    const float* w_in = in[7]; const float* w_out = in[8];
    float* modp = (float*)(ws + WS_MODP);
    constexpr int NI_MOD = 2 * 8 * 24, NI_ROPE = 16;
    constexpr int NI_IN = 16 * 40, NI_OUT = 16 * 16, NI_E = 16 * 16 * 16;
    constexpr int NI_L = NI_IN + NI_OUT + (CONV_IN_P0 ? 3 * NI_E : 0);
    constexpr int NITEMS = NI_MOD + NI_ROPE + 2 * NI_L;
    LAS float* scr = (LAS float*)wl;
    for (int it = gw; it < NI_MOD + NI_ROPE; it += NGW) {
        int r = it;
        if (r < NI_MOD) {
            const int cb = r % 24, kc = (r / 24) & 7, l = r / 192;
            for (int idx = lane; idx < 128 * 9; idx += 64) { const int rr = idx / 128, k = idx % 128; const float cv = (rr < 8) ? cvec[rr * 1024 + kc * 128 + k] : cctx[kc * 128 + k]; scr[k * 12 + rr] = silu_f(cv); }
            f32x4 acc[9];
#pragma unroll
            for (int rr = 0; rr < 9; ++rr) acc[rr] = (f32x4){0.f, 0.f, 0.f, 0.f};
            const float* wp = wmod + ((size_t)l * 1024 + kc * 128) * 6144 + cb * 256 + 4 * lane;
#pragma unroll 4
            for (int k = 0; k < 128; ++k) { const f32x4 w = *(const f32x4*)(wp + (size_t)k * 6144);
                const f32x4 s0 = *(LAS const f32x4*)(scr + k * 12), s1 = *(LAS const f32x4*)(scr + k * 12 + 4); const float s8 = scr[k * 12 + 8];
                acc[0] += w * s0.x; acc[1] += w * s0.y; acc[2] += w * s0.z; acc[3] += w * s0.w; acc[4] += w * s1.x; acc[5] += w * s1.y; acc[6] += w * s1.z; acc[7] += w * s1.w; acc[8] += w * s8; }
#pragma unroll
            for (int rr = 0; rr < 9; ++rr) *(f32x4*)(modp + ((size_t)(l * 8 + kc) * 9 + rr) * 6144 + cb * 256 + 4 * lane) = acc[rr];
            continue;
        }
        r -= NI_MOD;
        if (r < NI_ROPE) {
            const int id = r * 64 + lane, pos = id >> 4, i = id & 15;
            const float fr = fexp2(-(float)i * (13.287712379549449f / 16.f));
            float rev = (float)pos * fr * 0.15915494309189535f; rev -= floorf(rev);
            f32x2 cs; cs.x = __builtin_amdgcn_cosf(rev); cs.y = __builtin_amdgcn_sinf(rev);
            ((f32x2*)(ws + WS_TAB))[id] = cs;
            continue;
        }
        break;
    }
    if (NGW == 2048) tr_stream(in, ws, (gw + NGW - (NI_MOD + NI_ROPE)) % NGW, NGW, P0_A + (P0_B - TR_L), scr, lane, P0_A, TR_L - P0_A);
    else tr_stream(in, ws, gw, NGW, TR_ALL, scr, lane);
}

__device__ __forceinline__ void phase_a0(const float* const* in, unsigned char* ws, LAS unsigned char* lds, int G, int tid, int wave, int lane) {
    const float* x = in[0]; const float* ctx = in[2]; const float* bmod = in[5]; const float* gains = in[6];
    const float* modp = (const float*)(ws + WS_MODP); float* mod = (float*)(ws + WS_MOD); bf16_t* H = (bf16_t*)(ws + WS_H);
    LAS float* V = (LAS float*)lds;
    for (int row = blockIdx.x; row < 18; row += G) { const int l = row / 9, r = row % 9;
        for (int n = tid; n < 6144; n += 512) mod[(size_t)row * 6144 + n] = modfin(modp, bmod, l, r, n); }
    for (int t = blockIdx.x; t < 256; t += G) {
        const int b = t >> 5;
        __syncthreads();
        for (int n = tid; n < 1024; n += 512) { const float g = gains[n];
            V[n] = g * (1.f + modfin(modp, bmod, 0, b, 1024 + n)); V[1024 + n] = modfin(modp, bmod, 0, b, n);
            V[2048 + n] = g * (1.f + modfin(modp, bmod, 0, 8, 1024 + n)); V[3072 + n] = modfin(modp, bmod, 0, 8, n); }
        __syncthreads();
#pragma unroll 1
        for (int i0 = 0; i0 < 9; i0 += 3) {
            f32x4 xq[3][4];
#pragma unroll
            for (int k = 0; k < 3; ++k) { const int i = i0 + k; const bool isc = (i == 8);
                const float* src = isc ? (ctx + (size_t)(8 * t + wave) * 1024) : (x + (size_t)(64 * t + 8 * wave + i) * 1024); ld_row_f32(src, lane, xq[k]); }
#pragma unroll
            for (int k = 0; k < 3; ++k) { const int i = i0 + k; const bool isc = (i == 8);
                const int row = isc ? (ML + 8 * t + wave) : (64 * t + 8 * wave + i);
                f32x4 (&v)[4] = xq[k]; f32x4 a[4], s[4];
                const float rstd = __builtin_amdgcn_rsqf(wave_sum(sumsq16(v)) * (1.f / 1024.f) + NEPS);
                ld_vec_lds(V + (isc ? 2048 : 0), lane, a); ld_vec_lds(V + (isc ? 3072 : 1024), lane, s);
#pragma unroll
                for (int j = 0; j < 4; ++j) v[j] = v[j] * rstd * a[j] + s[j];
                st_row_bf16(H + (size_t)row * 1024, lane, v);
            }
        }
    }
}
constexpr int VP = 192;
struct AttnTile { f32x16 o0, o1; float m, lsum; };
__device__ __forceinline__ void attn_softmax(f32x16& s, AttnTile& T) {
    float bm = fmaxf(fmaxf(s[0], s[1]), fmaxf(s[2], s[3]));
#pragma unroll
    for (int i = 4; i < 16; i += 4) bm = fmaxf(bm, fmaxf(fmaxf(s[i], s[i + 1]), fmaxf(s[i + 2], s[i + 3])));
    bm = fmaxf(bm, __shfl_xor(bm, 32));
    const float mo = T.m, mn = fmaxf(mo, bm);
    T.m = mn;
    float ps = 0.f;
#pragma unroll
    for (int i = 0; i < 16; ++i) { s[i] = fexp2(s[i] - mn); ps += s[i]; }
    if (__any(mn != mo)) {
        const float alpha = fexp2(mo - mn);
        T.lsum *= alpha;
#pragma unroll
        for (int i = 0; i < 16; ++i) { T.o0[i] *= alpha; T.o1[i] *= alpha; }
    }
    T.lsum += ps;
}
__device__ __forceinline__ void attn_item(const int MODE, const bf16_t* P, bf16_t* MIX, int item, LAS unsigned char* wl, int lane,
                                          const float* __restrict__ rpb, const float* __restrict__ sink, const bool dry = false) {
    asm volatile("" : "+v"(lane));
    const int ql = lane & 31, hi = lane >> 5;
    int b, hq, qcol, kcol, vcol, ocol, qrow0, r = 0, rs = 0, q64 = 0, nloc, kb_lo = 0;
    if (MODE == 0) { r = item & 31; hq = (item >> 5) & 3; b = item >> 7;
        qcol = C_NQ + hq * 64; kcol = C_NK + hq * 64; vcol = C_NV + hq * 64; ocol = 256 + hq * 64; qrow0 = b * SEQ + r * 64;
        rs = r - 4; rs = rs < 0 ? 0 : (rs > 24 ? 24 : rs); nloc = 16; }
    else if (MODE == 1) { q64 = item & 31; hq = (item >> 5) & 7; b = item >> 8;
        qcol = C_SQ + hq * 64; kcol = C_SK + (hq >> 2) * 64; vcol = C_SV + (hq >> 2) * 64; ocol = 512 + hq * 64; qrow0 = b * SEQ + q64 * 64;
        kb_lo = 2 * q64 - 4; if (kb_lo < 0) kb_lo = 0; int kb_hi = 2 * q64 + 5; if (kb_hi > 63) kb_hi = 63; nloc = kb_hi - kb_lo + 1; }
    else if (MODE == 2) { q64 = item & 3; hq = (item >> 2) & 3; b = item >> 4;
        qcol = C_NQ + hq * 64; kcol = C_NK + hq * 64; vcol = C_NV + hq * 64; ocol = 256 + hq * 64; qrow0 = ML + b * CTXL + q64 * 64; nloc = 0; }
    else { q64 = item & 3; hq = (item >> 2) & 7; b = item >> 5;
        qcol = C_SQ + hq * 64; kcol = C_SK + (hq >> 2) * 64; vcol = C_SV + (hq >> 2) * 64; ocol = 512 + hq * 64; qrow0 = ML + b * CTXL + q64 * 64; nloc = 0; }
    const int nblk = 8 + nloc;
    LAS unsigned char* vl = wl;
    LAS float* rl = (LAS float*)(wl + 32 * VP);
    if (MODE == 0) { for (int i = lane; i < 465; i += 64) rl[i] = rpb[hq * 465 + i] * LOG2E; }
    LAS unsigned char* qimg = wl + 32 * VP + 1920;
    constexpr int QP = 144;
#pragma unroll
    for (int i = 0; i < 8; ++i) { const int c = lane + 64 * i; const v4u v = *(const v4u*)(P + (size_t)(qrow0 + (c >> 3)) * PP + qcol + (c & 7) * 8); *(LAS v4u*)(qimg + (c >> 3) * QP + (c & 7) * 16) = v; }
    LAS const unsigned char* qrd = qimg + ql * QP + 16 * hi;
    auto blk_row0 = [&](int blk) -> int {
        if (blk < 8) return ML + b * CTXL + blk * 32;
        const int lb = blk - 8;
        if (MODE == 0) return b * SEQ + (rs + (lb >> 1)) * 64 + (lb & 1) * 32;
        return b * SEQ + 32 * (kb_lo + lb);
    };
    auto load_blk = [&](int blk, bf16x8 (&kn)[4], v4u (&vn)[4]) {
        const int r0 = blk_row0(blk);
        const bf16_t* kp = P + (size_t)(r0 + ql) * PP + kcol + 8 * hi;
#pragma unroll
        for (int ds = 0; ds < 4; ++ds) kn[ds] = *(const bf16x8*)(kp + 16 * ds);
#pragma unroll
        for (int i = 0; i < 4; ++i) { const int c = lane + 64 * i; vn[i] = *(const v4u*)(P + (size_t)(r0 + (c >> 3)) * PP + vcol + (c & 7) * 8); }
    };
    AttnTile T[2];
#pragma unroll
    for (int t = 0; t < 2; ++t) { T[t].m = -INFINITY; T[t].lsum = 0.f;
#pragma unroll
        for (int i = 0; i < 16; ++i) { T[t].o0[i] = 0.f; T[t].o1[i] = 0.f; } }
    const int tr_off = (4 * hi + ((lane & 15) >> 2)) * VP + (16 * ((lane >> 4) & 1) + 4 * (lane & 3)) * 2;
    auto step = [&](int blk, bf16x8 (&kf)[4], v4u (&vr)[4]) {
#pragma unroll
        for (int i = 0; i < 4; ++i) { const int c = lane + 64 * i; *(LAS v4u*)(vl + (c >> 3) * VP + (c & 7) * 16) = vr[i]; }
        f32x16 sc[2];
#pragma unroll
        for (int t = 0; t < 2; ++t) {
#pragma unroll
            for (int i = 0; i < 16; ++i) sc[t][i] = 0.f;
#pragma unroll
            for (int ds = 0; ds < 4; ++ds) sc[t] = MFMA32(kf[ds], *(LAS const bf16x8*)(qrd + 32 * t * QP + 32 * ds), sc[t]);
        }
        if (blk + 2 < nblk) load_blk(blk + 2, kf, vr);
        bf16x8 vf[2][2];
#pragma unroll
        for (int ks = 0; ks < 2; ++ks) { LAS const unsigned char* vb = vl + tr_off + 16 * ks * VP;
            vf[ks][0] = cat4(tr_read(vb), tr_read(vb + 8 * VP)); vf[ks][1] = cat4(tr_read(vb + 64), tr_read(vb + 8 * VP + 64)); }
#pragma unroll
        for (int t = 0; t < 2; ++t) {
            f32x16& s = sc[t];
            if (MODE == 0 && blk >= 8) {
                const int lb = blk - 8, j = lb >> 1, ch = lb & 1, c = t * 32 + ql;
                int cs = c - 8; cs = cs < 0 ? 0 : (cs > 48 ? 48 : cs);
                LAS const float* rrow = rl + (rs + j - r + 7) * 31 + (15 - c);
#pragma unroll
                for (int i = 0; i < 16; ++i) { const int kc = ch * 32 + crow(i, hi); const bool ok = (kc >= cs) && (kc < cs + 16);
                    const float bias = rrow[ok ? kc : c];
                    s[i] = ok ? (s[i] + bias) : -INFINITY; }
            } else if (MODE == 1 && blk >= 8) {
                const int rel = (kb_lo + blk - 8) - (2 * q64 + t);
                if (rel <= -4 || rel >= 4) {
#pragma unroll
                    for (int i = 0; i < 16; ++i) { const int kk = crow(i, hi); const bool ok = (rel == -4) ? (kk >= ql) : ((rel == 4) ? (kk <= ql) : false);
                        s[i] = ok ? s[i] : -INFINITY; }
                }
            }
            attn_softmax(s, T[t]);
#pragma unroll
            for (int ks = 0; ks < 2; ++ks) {
                const bf16x8 pf = pack8(s[8 * ks + 0], s[8 * ks + 1], s[8 * ks + 2], s[8 * ks + 3], s[8 * ks + 4], s[8 * ks + 5], s[8 * ks + 6], s[8 * ks + 7]);
                T[t].o0 = MFMA32(vf[ks][0], pf, T[t].o0); T[t].o1 = MFMA32(vf[ks][1], pf, T[t].o1);
            }
            __builtin_amdgcn_sched_barrier(0);
        }
    };
    bf16x8 kA[4], kB[4]; v4u vA[4], vB[4];
    load_blk(0, kA, vA); load_blk(1, kB, vB);
    for (int blk = 0; blk < nblk; blk += 2) { step(blk, kA, vA); if (blk + 1 < nblk) step(blk + 1, kB, vB); }
#pragma unroll
    for (int t = 0; t < 2; ++t) {
        float lt = T[t].lsum + __shfl_xor(T[t].lsum, 32);
        if (MODE == 1 || MODE == 3) lt += fexp2(sink[hq] * LOG2E - T[t].m);
        const float inv = frcp(lt);
        bf16_t* op = MIX + (size_t)(qrow0 + 32 * t + ql) * 1024 + ocol + 4 * hi;
#pragma unroll
        for (int g = 0; g < 4; ++g) {
            v2u w0, w1; w0.x = pk2(T[t].o0[4 * g] * inv, T[t].o0[4 * g + 1] * inv); w0.y = pk2(T[t].o0[4 * g + 2] * inv, T[t].o0[4 * g + 3] * inv);
            w1.x = pk2(T[t].o1[4 * g] * inv, T[t].o1[4 * g + 1] * inv); w1.y = pk2(T[t].o1[4 * g + 2] * inv, T[t].o1[4 * g + 3] * inv);
            *(v2u*)(op + 8 * g) = w0; *(v2u*)(op + 32 + 8 * g) = w1;
        }
    }
}
constexpr int GP = 144;
constexpr int G_V = 0, G_A = 64 * GP, G_B = 64 * GP + 32 * GP;
static_assert(G_B + 32 * GP <= WAVE_LDS, "gla LDS");

struct GlaCum { float cum[2][16]; float tot; };
__device__ __forceinline__ void gla_cum(const bf16_t* P, int row0, int hh, int dir, const float* __restrict__ a_up, const float* __restrict__ a_bias, int lane, GlaCum& C) {
    const int kk = lane & 31, hi = lane >> 5;
    const float* up = a_up + (size_t)dir * 16 * 128 + (size_t)(8 * hi) * 128 + hh * 32 + kk;
    const bf16x8 ub = pack8(up[0], up[128], up[256], up[384], up[512], up[640], up[768], up[896]);
    const float bias = a_bias[dir * 128 + hh * 32 + kk];
    float gs[2][4];
#pragma unroll
    for (int tt = 0; tt < 2; ++tt) {
        const bf16x8 al = *(const bf16x8*)(P + (size_t)(row0 + 32 * tt + kk) * PP + C_GAF + 16 * dir + 8 * hi);
        f32x16 z;
#pragma unroll
        for (int i = 0; i < 16; ++i) z[i] = 0.f;
        z = MFMA32(al, ub, z);
#pragma unroll
        for (int g = 0; g < 4; ++g) { float run = 0.f;
#pragma unroll
            for (int e = 0; e < 4; ++e) { const float zz = z[4 * g + e] + bias; const float ls = fminf(zz, 0.f) - flog(1.f + fexp(-fabsf(zz)));
                const float l = ls * (1.f / 16.f);
                if (dir == 0) { run += l; C.cum[tt][4 * g + e] = run; } else { C.cum[tt][4 * g + e] = run; run += l; } }
            gs[tt][g] = run; }
    }
    float off = 0.f;
#pragma unroll
    for (int tt = 0; tt < 2; ++tt)
#pragma unroll
        for (int g = 0; g < 4; ++g) { const float other = __shfl_xor(gs[tt][g], 32); const float mine = off + (hi ? other : 0.f);
#pragma unroll
            for (int e = 0; e < 4; ++e) C.cum[tt][4 * g + e] += mine;
            off += gs[tt][g] + other; }
    C.tot = off;
    if (dir == 1) {
#pragma unroll
        for (int tt = 0; tt < 2; ++tt)
#pragma unroll
            for (int r = 0; r < 16; ++r) C.cum[tt][r] = off - C.cum[tt][r];
    }
}
__device__ __forceinline__ void gla_ld_tc(const bf16_t* P, int row0, int col, int lane, float (&x)[2][16]) {
    const int kk = lane & 31, hi = lane >> 5;
#pragma unroll
    for (int tt = 0; tt < 2; ++tt)
#pragma unroll
        for (int r = 0; r < 16; ++r) x[tt][r] = bf1(P[(size_t)(row0 + 32 * tt + crow(r, hi)) * PP + col + kk]);
}
__device__ __forceinline__ void gla_st_img(LAS unsigned char* img, int lane, const float (&x)[2][16]) {
    const int kk = lane & 31, hi = lane >> 5;
#pragma unroll
    for (int tt = 0; tt < 2; ++tt)
#pragma unroll
        for (int g = 0; g < 4; ++g) { v2u w; w.x = pk2(x[tt][4 * g], x[tt][4 * g + 1]); w.y = pk2(x[tt][4 * g + 2], x[tt][4 * g + 3]);
            *(LAS v2u*)(img + kk * GP + (32 * tt + 8 * g + 4 * hi) * 2) = w; }
}
__device__ __forceinline__ void gla_stage_v(const bf16_t* P, int row0, int hh, LAS unsigned char* wl, int lane) {
#pragma unroll
    for (int i = 0; i < 8; ++i) { const int c = lane + 64 * i; const v4u v = *(const v4u*)(P + (size_t)(row0 + (c >> 3)) * PP + C_GV + hh * 64 + (c & 7) * 8);
        *(LAS v4u*)(wl + G_V + (c >> 3) * GP + (c & 7) * 16) = v; }
}
__device__ __forceinline__ int gla_row0(int b, int nc) { return nc < 4 ? (ML + b * CTXL + 64 * nc) : (b * SEQ + 64 * (nc - 4)); }

__device__ __forceinline__ void gla_local_item(const bf16_t* P, float* UST, float* DEC, int item, LAS unsigned char* wl, int lane,
                                               const float* __restrict__ a_up, const float* __restrict__ a_bias) {
    asm volatile("" : "+v"(lane));
    const int nc = item % 36, hh = (item / 36) & 3, b = item / 144;
    const int row0 = gla_row0(b, nc), kk = lane & 31, hi = lane >> 5;
    gla_stage_v(P, row0, hh, wl, lane);
    float kv[2][16]; gla_ld_tc(P, row0, C_GK + hh * 32, lane, kv);
#pragma unroll
    for (int dir = 0; dir < 2; ++dir) {
        GlaCum C; gla_cum(P, row0, hh, dir, a_up, a_bias, lane, C);
        float kd[2][16];
#pragma unroll
        for (int tt = 0; tt < 2; ++tt)
#pragma unroll
            for (int r = 0; r < 16; ++r) kd[tt][r] = kv[tt][r] * fexp(C.tot - C.cum[tt][r]);
        gla_st_img(wl + (dir == 0 ? G_A : G_B), lane, kd);
        if (hi == 0) DEC[((size_t)((b * 4 + hh) * 2 + dir) * 36 + nc) * 32 + kk] = fexp(C.tot);
    }
    const int trv = ((lane & 15) >> 2) * GP + (16 * ((lane >> 4) & 1) + 4 * (lane & 3)) * 2;
#pragma unroll
    for (int dir = 0; dir < 2; ++dir) {
        f32x16 u0, u1;
#pragma unroll
        for (int i = 0; i < 16; ++i) { u0[i] = 0.f; u1[i] = 0.f; }
        LAS const unsigned char* img = wl + (dir == 0 ? G_A : G_B);
#pragma unroll
        for (int s = 0; s < 4; ++s) {
            const bf16x8 kb = *(LAS const bf16x8*)(img + kk * GP + (16 * s + 8 * hi) * 2);
            LAS const unsigned char* vb = wl + G_V + trv + (16 * s + 8 * hi) * GP;
            const bf16x8 v0 = cat4(tr_read(vb), tr_read(vb + 4 * GP));
            const bf16x8 v1 = cat4(tr_read(vb + 64), tr_read(vb + 4 * GP + 64));
            u0 = MFMA32(v0, kb, u0); u1 = MFMA32(v1, kb, u1);
        }
        float* up = UST + ((size_t)((b * 4 + hh) * 2 + dir) * 36 + nc) * 2048 + kk;
#pragma unroll
        for (int i = 0; i < 16; ++i) { up[(size_t)crow(i, hi) * 32] = u0[i]; up[(size_t)(32 + crow(i, hi)) * 32] = u1[i]; }
    }
}

__device__ __forceinline__ void gla_prefix(float* UST, const float* DEC, int gid, bool dry) {
    const int bhd = gid >> 11, e = gid & 2047, k = e & 31, dir = bhd & 1;
    float* base = UST + (size_t)bhd * 36 * 2048 + e; const float* dec = DEC + (size_t)bhd * 36 * 32 + k;
    float s = 0.f;
#pragma unroll 4
    for (int ci = 0; ci < 36; ++ci) {
        const int sl = dir == 0 ? ci : (ci < 4 ? 3 - ci : 39 - ci);
        const float u = base[(size_t)sl * 2048], d = dec[sl * 32];
        if (!dry) base[(size_t)sl * 2048] = s;
        s = d * s + u;
    }
}

__device__ __forceinline__ void gla_out_item(const bf16_t* P, const float* UST, bf16_t* MIX, int item, LAS unsigned char* wl, int lane,
                                             const float* __restrict__ a_up, const float* __restrict__ a_bias, const float* __restrict__ gnorm) {
    const int nc = item % 36, hh = (item / 36) & 3, b = item / 144;
    const int row0 = gla_row0(b, nc), kk = lane & 31, hi = lane >> 5;
    gla_stage_v(P, row0, hh, wl, lane);
    f32x16 o[2][2];
#pragma unroll
    for (int a = 0; a < 2; ++a)
#pragma unroll
        for (int c = 0; c < 2; ++c)
#pragma unroll
            for (int i = 0; i < 16; ++i) o[a][c][i] = 0.f;
    const int g16 = (lane >> 4) & 1, qq = (lane & 15) >> 2, pp = lane & 3;
    const int tri = (8 * hi + qq) * GP + (16 * g16 + 4 * pp) * 2;
    const int trv = (4 * hi + qq) * GP + (16 * g16 + 4 * pp) * 2;
#pragma unroll
    for (int dir = 0; dir < 2; ++dir) {
        GlaCum C; gla_cum(P, row0, hh, dir, a_up, a_bias, lane, C);
#pragma unroll
        for (int tt = 0; tt < 2; ++tt) {
            float cum[16];
#pragma unroll
            for (int r = 0; r < 16; ++r) cum[r] = C.cum[tt][r];
#pragma unroll
            for (int g = 0; g < 4; ++g) {
                float xq[4], xk[4];
#pragma unroll
                for (int e = 0; e < 4; ++e) { const size_t ro = (size_t)(row0 + 32 * tt + 8 * g + 4 * hi + e) * PP + hh * 32 + kk;
                    xq[e] = bf1(P[ro + C_GQ]) * 0.17677669529663687f * fexp(cum[4 * g + e]); xk[e] = bf1(P[ro + C_GK]) * fexp(-cum[4 * g + e]); }
                v2u wq, wk; wq.x = pk2(xq[0], xq[1]); wq.y = pk2(xq[2], xq[3]); wk.x = pk2(xk[0], xk[1]); wk.y = pk2(xk[2], xk[3]);
                const int off = kk * GP + (32 * tt + 8 * g + 4 * hi) * 2;
                *(LAS v2u*)(wl + G_A + off) = wq; *(LAS v2u*)(wl + G_B + off) = wk;
                if (g & 1) asm volatile("" ::: "memory");
            }
        }
        const float* sp = UST + ((size_t)((b * 4 + hh) * 2 + dir) * 36 + nc) * 2048;
        bf16x8 sf[2][2];
#pragma unroll
        for (int vb = 0; vb < 2; ++vb)
#pragma unroll
            for (int s = 0; s < 2; ++s) { const float* p = sp + (size_t)(32 * vb + kk) * 32 + 16 * s + 8 * hi; const f32x4 a = *(const f32x4*)p, c = *(const f32x4*)(p + 4);
                sf[vb][s] = pack8(a.x, a.y, a.z, a.w, c.x, c.y, c.z, c.w); }
#pragma unroll
        for (int it = 0; it < 2; ++it) {
            bf16x8 qf[2];
#pragma unroll
            for (int s = 0; s < 2; ++s) { LAS const unsigned char* p = wl + G_A + tri + 16 * s * GP + 64 * it; qf[s] = cat4(tr_read(p), tr_read(p + 4 * GP)); }
#pragma unroll
            for (int vb = 0; vb < 2; ++vb)
#pragma unroll
                for (int s = 0; s < 2; ++s) o[vb][it] = MFMA32(sf[vb][s], qf[s], o[vb][it]);
#pragma unroll
            for (int jt = 0; jt < 2; ++jt) {
                if (dir == 0 ? (jt > it) : (jt < it)) continue;
                f32x16 sc;
#pragma unroll
                for (int i = 0; i < 16; ++i) sc[i] = 0.f;
#pragma unroll
                for (int s = 0; s < 2; ++s) { LAS const unsigned char* p = wl + G_B + tri + 16 * s * GP + 64 * jt; const bf16x8 kf = cat4(tr_read(p), tr_read(p + 4 * GP)); sc = MFMA32(kf, qf[s], sc); }
                if (jt == it) {
#pragma unroll
                    for (int i = 0; i < 16; ++i) { const int j = crow(i, hi); const bool ok = dir == 0 ? (j <= kk) : (j >= kk); sc[i] = ok ? sc[i] : 0.f; }
                }
#pragma unroll
                for (int s2 = 0; s2 < 2; ++s2) {
                    const bf16x8 pf = pack8(sc[8 * s2 + 0], sc[8 * s2 + 1], sc[8 * s2 + 2], sc[8 * s2 + 3], sc[8 * s2 + 4], sc[8 * s2 + 5], sc[8 * s2 + 6], sc[8 * s2 + 7]);
                    LAS const unsigned char* vp = wl + G_V + trv + (32 * jt + 16 * s2) * GP;
                    const bf16x8 v0 = cat4(tr_read(vp), tr_read(vp + 8 * GP));
                    const bf16x8 v1 = cat4(tr_read(vp + 64), tr_read(vp + 8 * GP + 64));
                    o[0][it] = MFMA32(v0, pf, o[0][it]); o[1][it] = MFMA32(v1, pf, o[1][it]);
                }
                __builtin_amdgcn_sched_barrier(0);
            }
            __builtin_amdgcn_sched_barrier(0);
        }
    }
#pragma unroll
    for (int it = 0; it < 2; ++it) {
        float ss = 0.f;
#pragma unroll
        for (int vb = 0; vb < 2; ++vb)
#pragma unroll
            for (int i = 0; i < 16; ++i) ss += o[vb][it][i] * o[vb][it][i];
        ss += __shfl_xor(ss, 32);
        const float rstd = __builtin_amdgcn_rsqf(ss * (1.f / 64.f) + NEPS);
        const size_t row = (size_t)(row0 + 32 * it + kk);
#pragma unroll
        for (int vb = 0; vb < 2; ++vb)
#pragma unroll
            for (int g = 0; g < 4; ++g) { const int v = 32 * vb + 8 * g + 4 * hi;
                const f32x4 gn = *(const f32x4*)(gnorm + v); const v2u gw = *(const v2u*)(P + row * PP + C_GG + hh * 64 + v);
                const float g0 = bflo(gw.x), g1 = bfhi(gw.x), g2 = bflo(gw.y), g3 = bfhi(gw.y);
                v2u w; w.x = pk2(o[vb][it][4 * g] * rstd * gn.x * silu_f(g0), o[vb][it][4 * g + 1] * rstd * gn.y * silu_f(g1));
                w.y = pk2(o[vb][it][4 * g + 2] * rstd * gn.z * silu_f(g2), o[vb][it][4 * g + 3] * rstd * gn.w * silu_f(g3));
                *(v2u*)(MIX + row * 1024 + hh * 64 + v) = w; }
    }
}
__device__ __forceinline__ void phase_r1(const float* const* in, float* xout, unsigned char* ws, LAS unsigned char* lds, int l, bool upd, int G, int tid, int wave, int lane, bool dry) {
    const float* x0 = in[0]; const float* ctx0 = in[2]; const float* gains = in[6] + (size_t)l * 4096; const float* wr = in[14] + (size_t)l * 1024 * 16;
    const float* mod = (const float*)(ws + WS_MOD) + (size_t)l * 9 * 6144;
    const bf16_t* Y = (const bf16_t*)(ws + WS_R2 + (size_t)MT * 2048); bf16_t* H = (bf16_t*)(ws + WS_H); bf16_t* XB = (bf16_t*)(ws + WS_XB);
    float* AFF = (float*)(ws + WS_AFF); float* AFFC = (float*)(ws + WS_AFFC);
    LAS float* V = (LAS float*)lds;
    LAS float* RT = V + 6144;
    __syncthreads();
    for (int i = tid; i < 16384; i += 512) { const int d = i >> 4, e = i & 15; RT[e * 1024 + d] = wr[i]; }
    for (int t = blockIdx.x; t < 256; t += G) {
        const int b = t >> 5;
        __syncthreads();
        for (int n = tid; n < 1024; n += 512) { const float gpa = gains[1024 + n], gpf = gains[2048 + n];
            V[n] = gpa * mod[b * 6144 + 2048 + n]; V[1024 + n] = gpf * (1.f + mod[b * 6144 + 4096 + n]); V[2048 + n] = mod[b * 6144 + 3072 + n];
            V[3072 + n] = gpa * mod[8 * 6144 + 2048 + n]; V[4096 + n] = gpf * (1.f + mod[8 * 6144 + 4096 + n]); V[5120 + n] = mod[8 * 6144 + 3072 + n]; }
        __syncthreads();
        const int nrows = upd ? 9 : 8;
#pragma unroll 1
        for (int i0 = 0; i0 < 9; i0 += 3) {
            f32x4 yv[3][4], xq[3][4];
#pragma unroll
            for (int k = 0; k < 3; ++k) { const int i = i0 + k; if (i < nrows) {
                const bool isc = (i == 8); const int row = isc ? (ML + 8 * t + wave) : (64 * t + 8 * wave + i);
                ld_row_bf16(Y + (size_t)row * 1024, lane, yv[k]);
                if (l == 0) ld_row_f32(isc ? (ctx0 + (size_t)(8 * t + wave) * 1024) : (x0 + (size_t)row * 1024), lane, xq[k]); else ld_row_bf16(XB + (size_t)row * 1024, lane, xq[k]); } }
#pragma unroll
            for (int k = 0; k < 3; ++k) { const int i = i0 + k; if (i < nrows) {
            const bool isc = (i == 8);
            const int row = isc ? (ML + 8 * t + wave) : (64 * t + 8 * wave + i);
            bf16_t* xd = (dry ? (bf16_t*)(ws + WS_R1) : XB) + (size_t)row * 1024;
            LAS const float* vv = V + (isc ? 3072 : 0);
            f32x4 (&y)[4] = yv[k]; f32x4 (&xv)[4] = xq[k]; f32x4 a[4];
            const float rsy = __builtin_amdgcn_rsqf(wave_sum(sumsq16(y)) * (1.f / 1024.f) + NEPS);
            ld_vec_lds(vv, lane, a);
#pragma unroll
            for (int j = 0; j < 4; ++j) xv[j] = xv[j] + a[j] * (y[j] * rsy);
            st_row_bf16(xd, lane, xv);
            const float rs1 = __builtin_amdgcn_rsqf(wave_sum(sumsq16(xv)) * (1.f / 1024.f) + NEPS);
            f32x4 s[4]; ld_vec_lds(vv + 1024, lane, a); ld_vec_lds(vv + 2048, lane, s);
#pragma unroll
            for (int j = 0; j < 4; ++j) xv[j] = xv[j] * rs1 * a[j] + s[j];
            st_row_bf16((dry ? (bf16_t*)(ws + WS_R2) : H) + (size_t)row * 1024, lane, xv);
            float lg[16];
#pragma unroll
            for (int e = 0; e < 16; ++e) { float p = 0.f;
#pragma unroll
                for (int j = 0; j < 4; ++j) { const f32x4 w = *(LAS const f32x4*)(RT + e * 1024 + 256 * j + 4 * lane); p += (xv[j].x * w.x + xv[j].y * w.y) + (xv[j].z * w.z + xv[j].w * w.w); }
                lg[e] = p;
                if ((e & 3) == 3) asm volatile("" ::: "memory"); }
#pragma unroll
            for (int i2 = 0; i2 < 8; ++i2) { const bool up = (lane & 32) != 0; const float keep = up ? lg[i2 + 8] : lg[i2], send = up ? lg[i2] : lg[i2 + 8]; lg[i2] = keep + __shfl_xor(send, 32); }
#pragma unroll
            for (int i2 = 0; i2 < 4; ++i2) { const bool up = (lane & 16) != 0; const float keep = up ? lg[i2 + 4] : lg[i2], send = up ? lg[i2] : lg[i2 + 4]; lg[i2] = keep + __shfl_xor(send, 16); }
#pragma unroll
            for (int i2 = 0; i2 < 2; ++i2) { const bool up = (lane & 8) != 0; const float keep = up ? lg[i2 + 2] : lg[i2], send = up ? lg[i2] : lg[i2 + 2]; lg[i2] = keep + __shfl_xor(send, 8); }
            { const bool up = (lane & 4) != 0; const float keep = up ? lg[1] : lg[0], send = up ? lg[0] : lg[1]; lg[0] = keep + __shfl_xor(send, 4); }
            float lgt = lg[0]; lgt += __shfl_xor(lgt, 1); lgt += __shfl_xor(lgt, 2);
            const int ex = ((lane >> 5) & 1) * 8 + ((lane >> 4) & 1) * 4 + ((lane >> 3) & 1) * 2 + ((lane >> 2) & 1);
            float mx = lgt;
            mx = fmaxf(mx, __shfl_xor(mx, 4)); mx = fmaxf(mx, __shfl_xor(mx, 8)); mx = fmaxf(mx, __shfl_xor(mx, 16)); mx = fmaxf(mx, __shfl_xor(mx, 32));
            const float pe = fexp(lgt - mx);
            float den = pe; den += __shfl_xor(den, 4); den += __shfl_xor(den, 8); den += __shfl_xor(den, 16); den += __shfl_xor(den, 32);
            const float mine = pe / den;
            if ((lane & 3) == 0) {
                if (isc) { const int cr = 8 * t + wave; AFFC[((size_t)(cr >> 8) * 16 + ex) * 256 + (cr & 255)] = mine; }
                else AFF[((size_t)(row >> 11) * 16 + ex) * 2048 + (row & 2047)] = mine;
            }
            } }
        }
    }
}

template <bool CTX>
__device__ __forceinline__ void topk_wave(unsigned char* ws, int item, int lane) {
    constexpr int NT = CTX ? 256 : 2048, CAP = CTX ? 32 : 256, PER = NT / 64;
    const int e = item & 15, b = item >> 4;
    const float* arow = (const float*)(ws + (CTX ? WS_AFFC : WS_AFF)) + (size_t)(b * 16 + e) * NT;
    float* gate = (float*)(ws + (CTX ? WS_GATEC : WS_GATE)) + (size_t)(b * 16 + e) * CAP;
    short* INV = (short*)(ws + WS_INV);
    int* rowidx = (int*)(ws + WS_ROWIDX) + (CTX ? ((128 + e) * 256 + b * 32) : ((b * 16 + e) * 256));
    unsigned v[PER];
#pragma unroll
    for (int i = 0; i < PER / 4; ++i) { const v4u q = *(const v4u*)(arow + lane * PER + 4 * i); v[4 * i] = q.x; v[4 * i + 1] = q.y; v[4 * i + 2] = q.z; v[4 * i + 3] = q.w; }
    unsigned T = 0;
    for (int bit = 29; bit >= 0; --bit) {
        const unsigned cand = T | (1u << bit); int c = 0;
#pragma unroll
        for (int i = 0; i < PER; ++i) c += __popcll(__ballot(v[i] >= cand));
        if (c >= CAP) T = cand;
    }
    int ngt = 0, cg = 0, ce = 0;
#pragma unroll
    for (int i = 0; i < PER; ++i) { ngt += __popcll(__ballot(v[i] > T)); cg += (v[i] > T) ? 1 : 0; ce += (v[i] == T) ? 1 : 0; }
    const int need = CAP - ngt;
    int pg = cg, pe = ce;
#pragma unroll
    for (int d = 1; d < 64; d <<= 1) { const int tg = __shfl_up(pg, d), te = __shfl_up(pe, d); if (lane >= d) { pg += tg; pe += te; } }
    pg -= cg; pe -= ce;
#pragma unroll
    for (int i = 0; i < PER; ++i) {
        const bool gt = v[i] > T, eq = v[i] == T;
        const bool sel = gt || (eq && pe < need);
        const int slot = pg + (pe < need ? pe : need);
        const int tok = lane * PER + i, grow = CTX ? (ML + b * CTXL + tok) : (b * SEQ + tok);
        if (sel) { rowidx[slot] = grow; gate[slot] = __uint_as_float(v[i]); }
        INV[(size_t)grow * 16 + e] = sel ? (short)slot : (short)-1;
        pg += gt ? 1 : 0; pe += eq ? 1 : 0;
    }
}

__device__ __forceinline__ void topk_wg2(unsigned char* ws, int item, LAS unsigned char* lds, int tid, int wave, int lane) {
    constexpr int CAP = 256;
    const int e = item & 15, b = item >> 4;
    const float* arow = (const float*)(ws + WS_AFF) + (size_t)(b * 16 + e) * 2048;
    float* gate = (float*)(ws + WS_GATE) + (size_t)(b * 16 + e) * CAP;
    short* INV = (short*)(ws + WS_INV);
    int* rowidx = (int*)(ws + WS_ROWIDX) + (b * 16 + e) * 256;
    LAS int* cnt = (LAS int*)lds;
    const v4u q = *(const v4u*)(arow + 4 * tid);
    const unsigned v[4] = {q.x, q.y, q.z, q.w};
    unsigned T = 0;
    __syncthreads();
    for (int bit = 29; bit >= 0; --bit) {
        const unsigned cand = T | (1u << bit); int c = 0;
#pragma unroll
        for (int i = 0; i < 4; ++i) c += __popcll(__ballot(v[i] >= cand));
        LAS int* cb = cnt + (bit & 1) * 8;
        if (lane == 0) cb[wave] = c;
        __syncthreads();
        int tot = 0;
#pragma unroll
        for (int w = 0; w < 8; ++w) tot += cb[w];
        if (tot >= CAP) T = cand;
    }
    int cg = 0, ce = 0, wg_ = 0, we_ = 0;
#pragma unroll
    for (int i = 0; i < 4; ++i) { wg_ += __popcll(__ballot(v[i] > T)); we_ += __popcll(__ballot(v[i] == T)); cg += (v[i] > T) ? 1 : 0; ce += (v[i] == T) ? 1 : 0; }
    if (lane == 0) { cnt[16 + wave] = wg_; cnt[24 + wave] = we_; }
    int pg = cg, pe = ce;
#pragma unroll
    for (int d = 1; d < 64; d <<= 1) { const int tg = __shfl_up(pg, d), te = __shfl_up(pe, d); if (lane >= d) { pg += tg; pe += te; } }
    pg -= cg; pe -= ce;
    __syncthreads();
    int ngt = 0;
#pragma unroll
    for (int w = 0; w < 8; ++w) { const int g_ = cnt[16 + w], e_ = cnt[24 + w]; ngt += g_; if (w < wave) { pg += g_; pe += e_; } }
    const int need = CAP - ngt;
#pragma unroll
    for (int i = 0; i < 4; ++i) {
        const bool gt = v[i] > T, eq = v[i] == T;
        const bool sel = gt || (eq && pe < need);
        const int slot = pg + (pe < need ? pe : need);
        const int grow = b * SEQ + 4 * tid + i;
        if (sel) { rowidx[slot] = grow; gate[slot] = __uint_as_float(v[i]); }
        INV[(size_t)grow * 16 + e] = sel ? (short)slot : (short)-1;
        pg += gt ? 1 : 0; pe += eq ? 1 : 0;
    }
}

__device__ __forceinline__ void phase_r5(const float* const* in, float* xout, unsigned char* ws, LAS unsigned char* lds, int l, bool upd, int G, int tid, int wave, int lane, bool dry) {
    const float* gains = in[6];
    const float* mod = (const float*)(ws + WS_MOD);
    const bf16_t* YE = (const bf16_t*)(ws + WS_R1); bf16_t* H = (bf16_t*)(ws + WS_H); bf16_t* XB = (bf16_t*)(ws + WS_XB);
    const float* GATE = (const float*)(ws + WS_GATE); const float* GATEC = (const float*)(ws + WS_GATEC); const short* INV = (const short*)(ws + WS_INV);
    LAS float* V = (LAS float*)lds;
    LAS int* CL = (LAS int*)(lds + 24576);
    for (int t = blockIdx.x; t < 256; t += G) {
        const int b = t >> 5;
        __syncthreads();
        for (int n = tid; n < 1024; n += 512) { const float gpf = gains[(size_t)l * 4096 + 3072 + n];
            V[n] = gpf * mod[((size_t)l * 9 + b) * 6144 + 5120 + n]; V[3072 + n] = gpf * mod[((size_t)l * 9 + 8) * 6144 + 5120 + n];
            if (l == 0) { const float gna = gains[4096 + n];
                V[1024 + n] = gna * (1.f + mod[((size_t)9 + b) * 6144 + 1024 + n]); V[2048 + n] = mod[((size_t)9 + b) * 6144 + n];
                V[4096 + n] = gna * (1.f + mod[((size_t)9 + 8) * 6144 + 1024 + n]); V[5120 + n] = mod[((size_t)9 + 8) * 6144 + n]; } }
        if (tid < (upd ? 72 : 64)) {
            const bool isc = tid >= 64; const int cr = 8 * t + (tid - 64);
            const int row = isc ? (ML + cr) : (64 * t + tid); const int bb = isc ? (cr >> 8) : b;
            const v4u i0 = *(const v4u*)(INV + (size_t)row * 16), i1 = *(const v4u*)(INV + (size_t)row * 16 + 8);
            const unsigned iw[8] = {i0.x, i0.y, i0.z, i0.w, i1.x, i1.y, i1.z, i1.w};
            float gv[16]; int sl[16];
#pragma unroll
            for (int e = 0; e < 16; ++e) { sl[e] = (int)(short)((iw[e >> 1] >> (16 * (e & 1))) & 0xffffu); const int s0 = sl[e] < 0 ? 0 : sl[e];
                gv[e] = isc ? GATEC[(size_t)(bb * 16 + e) * 32 + s0] : GATE[(size_t)(bb * 16 + e) * 256 + s0]; }
            int cnt = 0; LAS int* cl = CL + tid * 33;
#pragma unroll
            for (int e = 0; e < 16; ++e) if (sl[e] >= 0) { cl[1 + 2 * cnt] = isc ? ((128 + e) * 256 + bb * 32 + sl[e]) : ((bb * 16 + e) * 256 + sl[e]); cl[2 + 2 * cnt] = (int)__float_as_uint(gv[e]); ++cnt; }
            cl[0] = cnt;
        }
        __syncthreads();
        const int nrows = upd ? 9 : 8;
#pragma unroll 1
        for (int i0 = 0; i0 < 9; i0 += 3) {
            f32x4 xq[3][4];
#pragma unroll
            for (int k = 0; k < 3; ++k) { const int i = i0 + k; if (i < nrows) { const bool isc = (i == 8);
                ld_row_bf16(XB + (size_t)(isc ? (ML + 8 * t + wave) : (64 * t + 8 * wave + i)) * 1024, lane, xq[k]); } }
#pragma unroll
            for (int k = 0; k < 3; ++k) { const int i = i0 + k; if (i < nrows) {
            const bool isc = (i == 8);
            const int row = isc ? (ML + 8 * t + wave) : (64 * t + 8 * wave + i);
            LAS const float* vv = V + (isc ? 3072 : 0);
            LAS const int* cl = CL + (isc ? (64 + wave) : (8 * wave + i)) * 33;
            const int n = __builtin_amdgcn_readfirstlane(cl[0]);
            f32x4 acc[4];
#pragma unroll
            for (int j = 0; j < 4; ++j) acc[j] = (f32x4){0.f, 0.f, 0.f, 0.f};
            for (int j0 = 0; j0 < n; j0 += 4) {
                v2u raw[4][4]; float g[4];
#pragma unroll
                for (int q = 0; q < 4; ++q) {
                    if (j0 + q < n) { const int yr = __builtin_amdgcn_readfirstlane(cl[1 + 2 * (j0 + q)]); g[q] = __uint_as_float((unsigned)__builtin_amdgcn_readfirstlane(cl[2 + 2 * (j0 + q)]));
                        const bf16_t* yp = YE + (size_t)yr * 1024;
#pragma unroll
                        for (int j = 0; j < 4; ++j) raw[q][j] = *(const v2u*)(yp + 256 * j + 4 * lane); }
                    else { g[q] = 0.f;
#pragma unroll
                        for (int j = 0; j < 4; ++j) raw[q][j] = (v2u){0u, 0u}; }
                }
#pragma unroll
                for (int q = 0; q < 4; ++q)
#pragma unroll
                    for (int j = 0; j < 4; ++j) acc[j] += (f32x4){bflo(raw[q][j].x), bfhi(raw[q][j].x), bflo(raw[q][j].y), bfhi(raw[q][j].y)} * g[q];
            }
            const float rsm = __builtin_amdgcn_rsqf(wave_sum(sumsq16(acc)) * (1.f / 1024.f) + NEPS);
            f32x4 (&xv)[4] = xq[k]; f32x4 a[4]; ld_vec_lds(vv, lane, a);
#pragma unroll
            for (int j = 0; j < 4; ++j) xv[j] = xv[j] + a[j] * (acc[j] * rsm);
            if (l == 0) st_row_bf16((dry ? (bf16_t*)(ws + WS_R2) : XB) + (size_t)row * 1024, lane, xv);
            else st_row_f32((dry ? (float*)(ws + WS_R2) : xout) + (size_t)row * 1024, lane, xv);
            if (l == 0 && !dry) {
                const float rs2 = __builtin_amdgcn_rsqf(wave_sum(sumsq16(xv)) * (1.f / 1024.f) + NEPS);
                f32x4 s[4]; ld_vec_lds(vv + 1024, lane, a); ld_vec_lds(vv + 2048, lane, s);
#pragma unroll
                for (int j = 0; j < 4; ++j) xv[j] = xv[j] * rs2 * a[j] + s[j];
                st_row_bf16(H + (size_t)row * 1024, lane, xv);
            }
            } }
        }
    }
}
#ifndef MK_PER_PHASE
#define MK_PER_PHASE 0
#endif
constexpr int N_PHASES = 22;
struct Args { const float* in[18]; float* out; unsigned char* ws; int ph_lo, ph_hi; };
__device__ __forceinline__ const Args* kargs_opaque() {
    auto p = __builtin_amdgcn_kernarg_segment_ptr(); asm volatile("" : "+s"(p)); return (const Args*)p; }
#define PHASE_REGS() int tid = threadIdx.x; asm volatile("" : "+v"(tid)); const int lane = tid & 63, wave = __builtin_amdgcn_readfirstlane(tid >> 6); \
    const Args* A = kargs_opaque(); unsigned char* ws = A->ws; const int G = gridDim.x, bx = blockIdx.x; \
    const int vcu = (G % 8 == 0) ? (bx % 8) * (G / 8) + bx / 8 : bx; const int gw = vcu * NWAVES + wave, NGW = G * NWAVES; \
    LAS unsigned char* wl = lds + wave * WAVE_LDS; (void)gw; (void)NGW; (void)wl; (void)lane; (void)ws
#ifndef CONV_BUDGET
#define CONV_BUDGET 1
#endif
#ifndef PH_MASK
#define PH_MASK 0xFFFFFFFFu
#endif
#define EN(j) (((PH_MASK) >> (j)) & 1u)
#ifndef REP_MASK
#define REP_MASK 0u
#endif
#define REPS(j) ((((REP_MASK) >> (j)) & 1u) ? 2 : 1)
__global__ void __launch_bounds__(NWAVES * 64, 2) fwd_kernel(Args args) {
    extern __shared__ __attribute__((aligned(16))) unsigned char lds_raw[];
    LAS unsigned char* lds = (LAS unsigned char*)lds_raw;
    volatile LAS unsigned* MISC = (volatile LAS unsigned*)(lds + MISC_OFF);
    for (int u = threadIdx.x; u < (LDS_BYTES - LDSCTL_OFF) / 4; u += NWAVES * 64) ((LAS unsigned*)(lds + LDSCTL_OFF))[u] = 0u;
    __syncthreads();
    const int lo = args.ph_lo, hi = args.ph_hi;
    XcdBarrier bar; bar.bar = (unsigned*)(args.ws + WS_CTL) + CW_BAR; bar.x = 0; bar.st = nullptr;
    if (hi - lo > 1) bar = xcd_barrier_post((unsigned*)(args.ws + WS_CTL) + CW_BAR, MISC + 8);
#define IN(k) (lo <= (k) && (k) < hi)
#ifdef STAMP_A
#define STAMP(k) do { if (blockIdx.x == 0 && threadIdx.x == 0) ((unsigned long long*)(args.ws + WS_CTL))[1536 + (k)] = __builtin_amdgcn_s_memrealtime(); } while (0)
#else
#define STAMP(k) do { } while (0)
#endif
#define SEAM(k) do { if (IN((k) + 1)) { xcd_barrier(bar); if (REPS(12) == 2) xcd_barrier(bar); } STAMP((k) + 1); } while (0)
    STAMP(0);
    if (EN(0) && IN(0)) { for (int rep = 0; rep < REPS(0); ++rep) { PHASE_REGS(); phase_p0(A->in, ws, wl, gw, NGW, lane); } SEAM(0); }
    if (EN(1) && IN(1)) { for (int rep = 0; rep < REPS(1); ++rep) { PHASE_REGS(); phase_a0(A->in, ws, lds, G, tid, wave, lane); } SEAM(1); }
    for (int l = 0; l < 2; ++l) {
        const int base = 2 + 10 * l; const bool upd = (l == 0);
        if (EN(2) && IN(base + 0)) { for (int rep = 0; rep < REPS(2); ++rep) {
            PHASE_REGS();
            pg8::Gemm g{(const bf16_t*)(ws + WS_H), (const bf16_t*)(ws + WS_WIN) + (size_t)l * PP * 1024, MT, PP, 1024}; pg8::StaticOrder S; S.init(MT, PP, G, bx);
            pg8::EpiProj E{(bf16_t*)(ws + WS_R1), PP, (const pg8::f32x2*)(ws + WS_TAB), ML};
            pg8::gemm_phase<pg8::EpiProj, pg8::StaticOrder, true, true>(lds, g, S, E);
            if (upd && CV_G1 > 0 && G == 256 && bx >= 208 && !(rep + 1 < REPS(2))) tr_stream(A->in, ws, P0_A + (bx - 208) * NWAVES + wave, 384, P0_A + CV_N1, (LAS float*)wl, lane);
            if (!CONV_IN_P0) { const int nwg_ = (MT / 256) * (PP / 256); if ((nwg_ - bx + G - 1) / G < (nwg_ + G - 1) / G) conv_pull(A->in, ws, l, 1, 12 * CONV_BUDGET, (LAS float*)wl, lane); }
            }
            SEAM(base + 0);
        }
        if (EN(3) && IN(base + 1)) { for (int rep = 0; rep < REPS(3); ++rep) {
            PHASE_REGS();
            const bf16_t* PROJ = (const bf16_t*)(ws + WS_R1); bf16_t* MIX = (bf16_t*)(ws + WS_R2);
            const float* a_up = A->in[9] + (size_t)l * 2 * 16 * 128; const float* a_bias = A->in[10] + (size_t)l * 2 * 128;
            const float* rpb = A->in[12] + (size_t)l * 4 * 465; const float* sink = A->in[13] + (size_t)l * 8;
            const int n_cn = upd ? 128 : 0, n_cs = upd ? 256 : 0;
            const bool xmap = (G == 256);
            const int xcd = bx & 7, cu = bx >> 3;
            const int n_att = xmap ? 12 : 0;
            const int tail_total = (xmap ? 0 : 1024 + 2048) + 1152 + n_cn + n_cs;
            volatile LAS unsigned* qctr = (volatile LAS unsigned*)(lds + MISC_OFF) + 16 + l * 2 + rep;
            const int n_conv = 0, n_mix = (n_conv + 2) / 3 * 4;
            for (;;) {
                int j = 0; if (lane == 0) j = (int)__hip_atomic_fetch_add((LAS unsigned*)qctr, 1u, __ATOMIC_RELAXED, __HIP_MEMORY_SCOPE_WORKGROUP);
                j = __builtin_amdgcn_readfirstlane(j);
                if (j < n_mix) {
                    if ((j & 3) != 3) { const int ci = (j >> 2) * 3 + (j & 3), r = ci * G + bx; if (ci < n_conv && r < 12288 && !(rep + 1 < REPS(3))) expert_conv_item(A->in, ws, l, r, (LAS float*)wl, lane); continue; }
                    j = j >> 2;
                } else j = j - n_mix + n_mix / 4;
                int mode, item;
                if (j < n_att) {
                    if (j < 4) { mode = 0; item = (xcd * 4 + j) * 32 + cu; }
                    else { const int jj = j - 4, group = xcd * 2 + (jj >> 2), i = cu * 4 + (jj & 3); const int bb = group >> 1, hq = (group & 1) * 4 + (i >> 5); mode = 1; item = (i & 31) + 32 * hq + 256 * bb; }
                } else {
                    int r = (j - n_att) * G + bx;
                    if (r >= tail_total) break;
                    mode = -1; item = 0;
                    if (!xmap) { if (r < 1024) { mode = 0; item = r; } else if (r < 3072) { mode = 1; item = r - 1024; } r -= 3072; }
                    if (mode < 0) {
                        if (r < 1152) { if (rep + 1 < REPS(3)) continue; gla_local_item(PROJ, (float*)(ws + WS_UST), (float*)(ws + WS_DEC), r, wl, lane, a_up, a_bias); continue; } r -= 1152;
                        if (r < n_cs) { mode = 3; item = r; } else { mode = 2; item = r - n_cs; }
                    }
                }
                attn_item(mode, PROJ, MIX, item, wl, lane, rpb, sink, rep + 1 < REPS(3));
            }
            }
            SEAM(base + 1);
        }
        if (EN(4) && IN(base + 2)) { for (int rep = 0; rep < REPS(4); ++rep) {
            PHASE_REGS();
            for (int gid = bx * (NWAVES * 64) + tid; gid < 64 * 2048; gid += G * NWAVES * 64) gla_prefix((float*)(ws + WS_UST), (const float*)(ws + WS_DEC), gid, rep + 1 < REPS(4));
            }
            SEAM(base + 2);
        }
        if (EN(5) && IN(base + 3)) { for (int rep = 0; rep < REPS(5); ++rep) {
            PHASE_REGS();
            const float* a_up = A->in[9] + (size_t)l * 2 * 16 * 128; const float* a_bias = A->in[10] + (size_t)l * 2 * 128; const float* gnorm = A->in[11] + (size_t)l * 64;
            for (int it = gw; it < 1152; it += NGW) { if (!upd && (it % 36) < 4) continue;
                gla_out_item((const bf16_t*)(ws + WS_R1), (const float*)(ws + WS_UST), (bf16_t*)(ws + WS_R2), it, wl, lane, a_up, a_bias, gnorm); }
            if (upd && G == 256 && gw >= 1152 && !(rep + 1 < REPS(5))) tr_stream(A->in, ws, TR_ALL - CONV_M3 + (gw - 1152), NGW - 1152, TR_ALL, (LAS float*)wl, lane);
            }
            SEAM(base + 3);
        }
        if (EN(6) && IN(base + 4)) { for (int rep = 0; rep < REPS(6); ++rep) {
            PHASE_REGS();
            const int M2 = upd ? MT : ML;
            pg8::Gemm g{(const bf16_t*)(ws + WS_R2), (const bf16_t*)(ws + WS_WOUT) + (size_t)l * 1024 * 1024, M2, 1024, 1024}; pg8::StaticOrder S; S.init(M2, 1024, G, bx);
            pg8::EpiStore E{(bf16_t*)(ws + WS_R2 + (size_t)MT * 2048), 1024};
            pg8::gemm_phase<pg8::EpiStore, pg8::StaticOrder, true, true>(lds, g, S, E);
            if (upd && CV_G2 > 0 && G == 256 && bx >= 32 && !(rep + 1 < REPS(6))) tr_stream(A->in, ws, P0_A + CV_N1 + (bx - 32) * NWAVES + wave, 1792, TR_L, (LAS float*)wl, lane);
            if (!CONV_IN_P0) { const int nwg_ = (M2 / 256) * 4; if ((nwg_ - bx + G - 1) / G < (nwg_ + G - 1) / G) conv_pull(A->in, ws, l, 1, 3 * CONV_BUDGET, (LAS float*)wl, lane); }
            }
            SEAM(base + 4);
        }
        if (EN(7) && IN(base + 5)) { for (int rep = 0; rep < REPS(7); ++rep) { PHASE_REGS(); phase_r1(A->in, A->out, ws, lds, l, upd, G, tid, wave, lane, rep + 1 < REPS(7)); } SEAM(base + 5); }
        if (EN(8) && IN(base + 6)) { for (int rep = 0; rep < REPS(8); ++rep) {
            PHASE_REGS();
            if (!CONV_IN_P0) conv_pull(A->in, ws, l, l, 1 << 30, (LAS float*)wl, lane);
            for (int it = bx; it < 128; it += G) topk_wg2(ws, it, lds, tid, wave, lane);
            if (upd) { const int w2 = (bx >= 128 ? bx - 128 : bx + G - 128) * NWAVES + wave; for (int it = w2; it < 128; it += NGW) topk_wave<true>(ws, it, lane); }
            }
            SEAM(base + 6);
        }
        if (EN(9) && IN(base + 7)) { for (int rep = 0; rep < REPS(9); ++rep) {
            PHASE_REGS();
            pg8::Gemm g{(const bf16_t*)(ws + WS_H), (const bf16_t*)(ws + WS_WGU) + (size_t)l * 16 * 2048 * 1024, 0, 0, 1024, (const int*)(ws + WS_ROWIDX)}; pg8::MoeOrder S; S.init(upd ? 9 : 8, 8, G, bx);
            pg8::EpiSwiGLU E{(bf16_t*)(ws + WS_R2), 1024};
            pg8::gemm_phase<pg8::EpiSwiGLU, pg8::MoeOrder, true, true, true>(lds, g, S, E);
            if (upd && CV_G3 > 0 && G == 256 && bx >= 128 && !(rep + 1 < REPS(9))) tr_stream(A->in, ws, P0_B + (bx - 128) * NWAVES + wave, 1024, P0_B + CV_N3, (LAS float*)wl, lane);
            if (!CONV_IN_P0) { const int nwg_ = 16 * (upd ? 9 : 8) * 8; if ((nwg_ - bx + G - 1) / G < (nwg_ + G - 1) / G) conv_pull(A->in, ws, l + 1, 1, 4 * CONV_BUDGET, (LAS float*)wl, lane); }
            }
            SEAM(base + 7);
        }
        if (EN(10) && IN(base + 8)) { for (int rep = 0; rep < REPS(10); ++rep) {
            PHASE_REGS();
            pg8::Gemm g{(const bf16_t*)(ws + WS_R2), (const bf16_t*)(ws + WS_WD) + (size_t)l * 16 * 1024 * 1024, 0, 0, 1024}; pg8::MoeOrder S; S.init(upd ? 9 : 8, 4, G, bx);
            pg8::EpiStore E{(bf16_t*)(ws + WS_R1), 1024};
            pg8::gemm_phase<pg8::EpiStore, pg8::MoeOrder, true, true>(lds, g, S, E);
            if (upd && CV_G4 > 0 && G == 256 && bx >= 64 && !(rep + 1 < REPS(10))) tr_stream(A->in, ws, P0_B + CV_N3 + (bx - 64) * NWAVES + wave, 1536, P0_B + CV_N3 + CV_N4, (LAS float*)wl, lane);
            if (!CONV_IN_P0) { const int nwg_ = 16 * (upd ? 9 : 8) * 4; if ((nwg_ - bx + G - 1) / G < (nwg_ + G - 1) / G) conv_pull(A->in, ws, l + 1, 1, 3 * CONV_BUDGET, (LAS float*)wl, lane); }
            }
            SEAM(base + 8);
        }
        if (EN(11) && IN(base + 9)) { for (int rep = 0; rep < REPS(11); ++rep) { PHASE_REGS(); phase_r5(A->in, A->out, ws, lds, l, upd, G, tid, wave, lane, rep + 1 < REPS(11)); } SEAM(base + 9); }
    }
#ifdef STAMP_A
    if (blockIdx.x == 0 && threadIdx.x == 0) { const unsigned long long* st_ = (const unsigned long long*)(args.ws + WS_CTL) + 1536; const float d_ = (float)(st_[STAMP_B] - st_[STAMP_A]); args.out[0] = 200.f * floorf(d_ / 200.f + 0.5f); }
#endif
#undef IN
#undef SEAM
}

extern "C" void kernel_launch(void* const* d_in, const int* in_sizes, int n_in, void* d_out, int out_size, void* d_ws, size_t ws_size, hipStream_t stream) {
    static int grid = 0;
    if (grid == 0) {
        if (n_in != 18 || out_size != ML * DM || ws_size < WS_END) { fprintf(stderr, "kernel_launch: unexpected sizes: n_in %d out %d ws %zu (need %zu)\n", n_in, out_size, ws_size, (size_t)WS_END); grid = -1; return; }
        int dev = 0, cus = 0, per_cu = 0;
        if (hipGetDevice(&dev) != hipSuccess || hipDeviceGetAttribute(&cus, hipDeviceAttributeMultiprocessorCount, dev) != hipSuccess) { grid = -1; return; }
        if (hipFuncSetAttribute((const void*)fwd_kernel, hipFuncAttributeMaxDynamicSharedMemorySize, LDS_BYTES) != hipSuccess) { fprintf(stderr, "kernel_launch: hipFuncSetAttribute failed\n"); grid = -1; return; }
        if (hipOccupancyMaxActiveBlocksPerMultiprocessor(&per_cu, (const void*)fwd_kernel, NWAVES * 64, LDS_BYTES) != hipSuccess || per_cu < 1) { fprintf(stderr, "kernel_launch: occupancy query says %d blocks per CU\n", per_cu); (void)hipGetLastError(); grid = -1; return; }
        grid = cus;
    }
    if (grid < 0) return;
    (void)hipMemsetAsync((char*)d_ws + WS_CTL, 0, CTL_ZERO_BYTES, stream);
    Args a{};
    for (int i = 0; i < 18; ++i) a.in[i] = (const float*)d_in[i];
    a.out = (float*)d_out; a.ws = (unsigned char*)d_ws;
#if MK_PER_PHASE
    for (int p = 0; p < N_PHASES; ++p) { a.ph_lo = p; a.ph_hi = p + 1; hipLaunchKernelGGL(fwd_kernel, dim3(grid), dim3(NWAVES * 64), LDS_BYTES, stream, a); }
#else
    a.ph_lo = 0; a.ph_hi = N_PHASES;
    void* kargs[] = {&a};
    hipError_t e = hipLaunchCooperativeKernel((const void*)fwd_kernel, dim3(grid), dim3(NWAVES * 64), kargs, LDS_BYTES, stream);
    if (e != hipSuccess) fprintf(stderr, "kernel_launch: cooperative launch failed: %s (grid %d)\n", hipGetErrorString(e), grid);
#endif
}
```

```cpp
#include <hip/hip_runtime.h>
#include <cstdio>
#include <cstdint>
#include <cmath>

namespace pg8 {
#define PG8_LAS __attribute__((address_space(3)))
typedef unsigned short bf16_t;
typedef short bf16x8 __attribute__((ext_vector_type(8)));
typedef float f32x4 __attribute__((ext_vector_type(4)));
typedef unsigned u32x4 __attribute__((ext_vector_type(4)));
constexpr int BM = 256, BK = 64, HALF = 128, HTB = HALF * BK * 2  , STAGE_BYTES = 8 * HTB, NXCD = 8, WGM = 8;

__host__ __device__ __forceinline__ int lds_byte(int r, int c) { const int st = (r >> 4) * 2 + (c >> 5), rr = r & 15, cc = c & 31, ob = rr * 64 + cc * 2; return st * 1024 + (ob ^ (((ob >> 9) & 1) << 5)); }
__host__ __device__ __forceinline__ void stage_rc(int b, int& R, int& C) { const int st = b / 1024, sb = b % 1024, swz = sb ^ (((sb >> 9) & 1) << 5); R = (st >> 1) * 16 + swz / 64; C = (st & 1) * 32 + (swz % 64) / 2; }
__host__ __device__ __forceinline__ int perm32(int rho) { const int n = rho >> 4, i = rho & 15; return 8 * (i >> 2) + 4 * n + (i & 3); }

struct Unit { int pm, pn, pb; };
struct Gemm { const bf16_t* A; const bf16_t* Bt; int M, N, K; const int* rowidx; };

struct StaticOrder {
    int nM, nN, nwg, G, c;
    __host__ __device__ void init(int M, int N, int G_, int c_) { nM = M / BM; nN = N / BM; nwg = nM * nN; G = G_; c = c_; }
    __host__ __device__ bool next(int i, Unit& u) const {
        const long L = (long)i * G + c; if (L >= nwg) return false;
        int wgid = (int)L; { const int q = nwg / NXCD, r = nwg % NXCD, xcd = wgid % NXCD, off = wgid / NXCD; wgid = (xcd < r ? xcd * (q + 1) : r * (q + 1) + (xcd - r) * q) + off; }
        const int nig = WGM * nN, gid = wgid / nig, fm = gid * WGM, gsz = (nM - fm) < WGM ? (nM - fm) : WGM;
        u.pm = fm + ((wgid % nig) % gsz); u.pn = (wgid % nig) / gsz; u.pb = u.pn; return true;
    }
    __device__ __forceinline__ void a_ready(const Unit&) const {}
    __device__ __forceinline__ void done(const Unit&) const {}
};

__device__ __forceinline__ unsigned cvt_pk_bf16(float lo, float hi) { unsigned r; asm volatile("v_cvt_pk_bf16_f32 %0, %1, %2" : "=v"(r) : "v"(lo), "v"(hi)); return r; }
typedef float f32x2 __attribute__((ext_vector_type(2)));
#ifndef EPI_WT
#define EPI_WT 0
#endif
__device__ __forceinline__ void st16(bf16_t* base, size_t elem_off, u32x4 w) {
#if EPI_WT
    const __amdgpu_buffer_rsrc_t r = __builtin_amdgcn_make_buffer_rsrc((void*)base, 0, 0x7fffffff, 0x00020000);
    __builtin_amdgcn_raw_buffer_store_b128(w, r, (unsigned)(elem_off * 2), 0, 16);
#else
    *(u32x4*)(base + elem_off) = w;
#endif
}
struct EpiStore {
    static constexpr bool PERM = true, AFTER_DRAIN = false;
    bf16_t* O; int ldc;
    __device__ __forceinline__ void operator()(const f32x4 (&acc)[2][2][4][2], const Unit& u, int wr, int wc, int fr, int fq) const {
        const int row0 = u.pm * BM + wr * 64 + fr, col0 = u.pn * BM + wc * 32 + 8 * fq;
#pragma unroll
        for (int ai = 0; ai < 2; ++ai)
#pragma unroll
            for (int m = 0; m < 4; ++m) { bf16_t* rowp = O + (size_t)(row0 + ai * HALF + m * 16) * ldc + col0;
#pragma unroll
                for (int bj = 0; bj < 2; ++bj) { const f32x4 v0 = acc[ai][bj][m][0], v1 = acc[ai][bj][m][1];
                    u32x4 w; w.x = cvt_pk_bf16(v0[0], v0[1]); w.y = cvt_pk_bf16(v0[2], v0[3]); w.z = cvt_pk_bf16(v1[0], v1[1]); w.w = cvt_pk_bf16(v1[2], v1[3]);
                    st16(O, (size_t)(rowp - O) + bj * HALF, w); } }
    }
};
struct EpiProj {
    static constexpr bool PERM = true, AFTER_DRAIN = false;
    bf16_t* O; int ldc; const f32x2* tab; int ml;
    __device__ __forceinline__ void operator()(const f32x4 (&acc)[2][2][4][2], const Unit& u, int wr, int wc, int fr, int fq) const {
        const int row0 = u.pm * BM + wr * 64 + fr;
        const bool latent = (u.pm * BM) < ml;
#pragma unroll
        for (int bj = 0; bj < 2; ++bj) {
            const int c0 = u.pn * BM + bj * HALF + wc * 32;
            const bool rope = latent && ((c0 >= 928 && c0 < 1056) || (c0 >= 1824 && c0 < 2336));
            const bool rowhalf = (((c0 - 32) & 63) == 0);
            const bool qscale = (c0 >= 1568 && c0 < 2336);
#pragma unroll
            for (int ai = 0; ai < 2; ++ai)
#pragma unroll
                for (int m = 0; m < 4; ++m) {
                    const int row = row0 + ai * HALF + m * 16;
                    f32x4 v0 = acc[ai][bj][m][0], v1 = acc[ai][bj][m][1];
                    if (rope) {
                        const int t = row & 2047, pos = rowhalf ? (t >> 6) : (t & 63);
                        const f32x2* tp = tab + pos * 16 + 8 * (fq & 1);
                        const float sg = (fq < 2) ? -1.f : 1.f;
#pragma unroll
                        for (int e = 0; e < 4; ++e) {
                            const float x0 = v0[e], x1 = v1[e];
                            const float p0 = __shfl_xor(x0, 32), p1 = __shfl_xor(x1, 32);
                            const f32x2 c0s = tp[e], c1s = tp[4 + e];
                            v0[e] = x0 * c0s.x + sg * p0 * c0s.y; v1[e] = x1 * c1s.x + sg * p1 * c1s.y;
                        }
                    }
                    if (qscale) { v0 = v0 * 0.18033688011112042f; v1 = v1 * 0.18033688011112042f; }
                    u32x4 w; w.x = cvt_pk_bf16(v0[0], v0[1]); w.y = cvt_pk_bf16(v0[2], v0[3]); w.z = cvt_pk_bf16(v1[0], v1[1]); w.w = cvt_pk_bf16(v1[2], v1[3]);
                    st16(O, (size_t)row * ldc + c0 + 8 * fq, w);
                }
        }
    }
};
struct EpiSwiGLU {
    static constexpr bool PERM = true, AFTER_DRAIN = false;
    bf16_t* O; int ldc;
    __device__ __forceinline__ void operator()(const f32x4 (&acc)[2][2][4][2], const Unit& u, int wr, int wc, int fr, int fq) const {
        const int row0 = u.pm * BM + wr * 64 + fr, col0 = u.pn * HALF + wc * 32 + 8 * fq;
#pragma unroll
        for (int ai = 0; ai < 2; ++ai)
#pragma unroll
            for (int m = 0; m < 4; ++m) {
                float h[8];
#pragma unroll
                for (int n = 0; n < 2; ++n)
#pragma unroll
                    for (int e = 0; e < 4; ++e) { const float g = acc[ai][0][m][n][e], up = acc[ai][1][m][n][e];
                        h[n * 4 + e] = g * __builtin_amdgcn_rcpf(1.f + __builtin_amdgcn_exp2f(-1.4426950408889634f * g)) * up; }
                u32x4 w; w.x = cvt_pk_bf16(h[0], h[1]); w.y = cvt_pk_bf16(h[2], h[3]); w.z = cvt_pk_bf16(h[4], h[5]); w.w = cvt_pk_bf16(h[6], h[7]);
                st16(O, (size_t)(row0 + ai * HALF + m * 16) * ldc + col0, w);
            }
    }
};
struct MoeOrder {
    int npe, nN, nwg, G, c;
    __host__ __device__ void init(int npe_, int nN_, int G_, int c_) { npe = npe_; nN = nN_; nwg = 16 * npe * nN; G = G_; c = c_; }
    __host__ __device__ bool next(int i, Unit& u) const {
        const long L = (long)i * G + c; if (L >= nwg) return false;
        int wgid = (int)L; { const int q = nwg / NXCD, r = nwg % NXCD, xcd = wgid % NXCD, off = wgid / NXCD; wgid = (xcd < r ? xcd * (q + 1) : r * (q + 1) + (xcd - r) * q) + off; }
        const int per = npe * nN, e = wgid / per, rem = wgid % per, j = rem / nN, pn = rem % nN;
        u.pm = (j < 8) ? (j * 16 + e) : (128 + e); u.pn = pn; u.pb = e * nN + pn; return true;
    }
    __device__ __forceinline__ void a_ready(const Unit&) const {}
    __device__ __forceinline__ void done(const Unit&) const {}
};

template <class Epi, class Sched, bool ALIGN_EPI = false, bool SP2 = false, bool GATHER = false>
__device__ __forceinline__ void gemm_phase(PG8_LAS unsigned char* lds, const Gemm g, const Sched& S, const Epi& E) {
    int tid_ = threadIdx.x; asm volatile("" : "+v"(tid_));
    const int tid = tid_, wid = __builtin_amdgcn_readfirstlane(tid >> 6), lane = tid & 63, wr = wid >> 2, wc = wid & 3, fr = lane & 15, fq = lane >> 4;
    const int K = g.K, nt = K / BK;
    static_assert(!GATHER || SP2, "GATHER is wired into the SP2 loop only");
    unsigned voffA[2], voffB[2]; int RA[2], CA[2]; unsigned vAc[2][2], vAn[2][2];
#pragma unroll
    for (int i = 0; i < 2; ++i) { int R, C; stage_rc(tid * 16 + i * 8192, R, C); const int Rb = Epi::PERM ? ((R & ~31) + perm32(R & 31)) : R; RA[i] = R; CA[i] = C;
        voffA[i] = (unsigned)(R * K + C) * 2u; voffB[i] = (unsigned)(Rb * K + C) * 2u; vAc[0][i] = vAc[1][i] = vAn[0][i] = vAn[1][i] = 0u; }
    auto load_idx = [&](int pm, unsigned (&v)[2][2]) {
#pragma unroll
        for (int h = 0; h < 2; ++h)
#pragma unroll
            for (int i = 0; i < 2; ++i) v[h][i] = (unsigned)(g.rowidx[pm * BM + h * HALF + RA[i]] * K + CA[i]) * 2u;
    };
    const size_t kstep = (size_t)(BK * 2);
    const size_t hstep = (size_t)HALF * K * 2;
    const size_t tstep = 2 * hstep;
    const unsigned ldsw = (unsigned)wid * 1024u;
    const int aoff = lds_byte(wr * 64 + fr, fq * 8), boff = lds_byte(wc * 32 + fr, fq * 8);
#define PG8_SA(b, h) (((b) * 2 + (h)) * HTB)
#define PG8_SB(b, h) ((4 + (b) * 2 + (h)) * HTB)
#define PG8_STAGE(bufoff, gbase, voff) do { _Pragma("unroll") for (int _i = 0; _i < 2; ++_i) \
        __builtin_amdgcn_global_load_lds((const unsigned*)((const char*)(gbase) + (voff)[_i]), (PG8_LAS unsigned*)(lds + (bufoff) + ldsw + _i * 8192), 16, 0, 0); } while (0)
#define PG8_STAGE_A(bufoff, gbase, h, nx) do { if constexpr (GATHER) { const unsigned v_[2] = { (nx) ? vAn[h][0] : vAc[h][0], (nx) ? vAn[h][1] : vAc[h][1] }; PG8_STAGE(bufoff, gbase, v_); } \
        else { PG8_STAGE(bufoff, (gbase) + (h) * hstep, voffA); } } while (0)
#define PG8_LDA(dst, b, h) do { _Pragma("unroll") for (int m = 0; m < 4; ++m) _Pragma("unroll") for (int k = 0; k < 2; ++k) dst[m][k] = *(const PG8_LAS bf16x8*)(lds + PG8_SA(b, h) + aoff + m * 2048 + k * 1024); } while (0)
#define PG8_LDB(dst, b, h) do { _Pragma("unroll") for (int n = 0; n < 2; ++n) _Pragma("unroll") for (int k = 0; k < 2; ++k) dst[n][k] = *(const PG8_LAS bf16x8*)(lds + PG8_SB(b, h) + boff + n * 2048 + k * 1024); } while (0)
#define PG8_MMA(ai, bj, At, Bt) do { __builtin_amdgcn_s_setprio(1); _Pragma("unroll") for (int m = 0; m < 4; ++m) _Pragma("unroll") for (int n = 0; n < 2; ++n) _Pragma("unroll") for (int k = 0; k < 2; ++k) \
        acc[ai][bj][m][n] = __builtin_amdgcn_mfma_f32_16x16x32_bf16(Bt[n][k], At[m][k], acc[ai][bj][m][n], 0, 0, 0); __builtin_amdgcn_s_setprio(0); } while (0)
#define PG8_WAIT_V(n) asm volatile("s_waitcnt vmcnt(" #n ")" ::: "memory")
#define PG8_WAIT_L(n) asm volatile("s_waitcnt lgkmcnt(" #n ")" ::: "memory")
#define PG8_BAR __builtin_amdgcn_s_barrier()
#define PG8_SCHED __builtin_amdgcn_sched_barrier(0)
    Unit cur, nxt; int ui = 0;
    if (!S.next(0, cur)) return;
    f32x4 acc[2][2][4][2];
#pragma unroll
    for (int a = 0; a < 2; ++a)
#pragma unroll
        for (int b = 0; b < 2; ++b)
#pragma unroll
            for (int m = 0; m < 4; ++m)
#pragma unroll
                for (int n = 0; n < 2; ++n) acc[a][b][m][n] = (f32x4){0.f, 0.f, 0.f, 0.f};
    bf16x8 At[4][2], B0[2][2], B1[2][2];
    const char* cA = (const char*)g.A + (GATHER ? (size_t)0 : (size_t)cur.pm * tstep); const char* cB = (const char*)g.Bt + (size_t)cur.pb * tstep;
    if constexpr (GATHER) load_idx(cur.pm, vAc);
    S.a_ready(cur);
    if constexpr (SP2) {
        PG8_STAGE(PG8_SB(0, 0), cB, voffB); PG8_STAGE(PG8_SB(0, 1), cB + hstep, voffB); PG8_STAGE_A(PG8_SA(0, 0), cA, 0, false); PG8_STAGE_A(PG8_SA(0, 1), cA, 1, false);
        if (wr == 1) PG8_BAR;
        PG8_WAIT_V(2); PG8_BAR;
        PG8_STAGE(PG8_SB(1, 0), cB + kstep, voffB); PG8_STAGE_A(PG8_SA(1, 0), cA + kstep, 0, false); PG8_STAGE(PG8_SB(1, 1), cB + hstep + kstep, voffB);
        PG8_WAIT_V(6); PG8_BAR;
    } else {
        PG8_STAGE(PG8_SB(0, 0), cB, voffB); PG8_STAGE(PG8_SA(0, 0), cA, voffA); PG8_STAGE(PG8_SB(0, 1), cB + hstep, voffB); PG8_STAGE(PG8_SA(0, 1), cA + hstep, voffA);
        if (wr == 1) PG8_BAR;
        PG8_WAIT_V(4); PG8_BAR;
        PG8_STAGE(PG8_SB(1, 0), cB + kstep, voffB); PG8_STAGE(PG8_SA(1, 0), cA + kstep, voffA); PG8_STAGE(PG8_SB(1, 1), cB + hstep + kstep, voffB);
        PG8_WAIT_V(6); PG8_BAR;
    }
    for (;;) {
        const bool has_next = S.next(ui + 1, nxt);
        if constexpr (GATHER) { if (has_next) {
#pragma unroll
            for (int h = 0; h < 2; ++h)
#pragma unroll
                for (int i = 0; i < 2; ++i) __builtin_amdgcn_global_load_lds((const unsigned*)(g.rowidx + nxt.pm * BM + h * HALF + RA[i]), (PG8_LAS unsigned*)(lds + STAGE_BYTES + (h * 2 + i) * 2048 + wid * 256), 4, 0, 0); } }
        const char* nA = (has_next && !GATHER) ? (const char*)g.A + (size_t)nxt.pm * tstep : cA; const char* nB = has_next ? (const char*)g.Bt + (size_t)nxt.pb * tstep : cB;
        for (int t = 0; t < nt; t += 2) {
            const bool last = (t == nt - 2); const bool nxu = last && has_next; (void)nxu;
            if constexpr (GATHER) { if (nxu) {
#pragma unroll
                for (int h = 0; h < 2; ++h)
#pragma unroll
                    for (int i = 0; i < 2; ++i) { const int ix = *(const PG8_LAS int*)(lds + STAGE_BYTES + (h * 2 + i) * 2048 + tid * 4); vAn[h][i] = (unsigned)(ix * K + CA[i]) * 2u; } } }
            const char* a1 = cA + (size_t)(t + 1) * kstep;
            const char* a2 = last ? nA : cA + (size_t)(t + 2) * kstep; const char* b2 = last ? nB : cB + (size_t)(t + 2) * kstep;
            const char* a3 = a2 + kstep; const char* b3 = b2 + kstep;
            if (last && has_next) S.a_ready(nxt);
            if constexpr (SP2) {
            PG8_LDB(B0, 0, 0); PG8_LDB(B1, 0, 1); PG8_SCHED; PG8_LDA(At, 0, 0); PG8_STAGE_A(PG8_SA(1, 1), a1, 1, false);
            PG8_WAIT_V(8); PG8_WAIT_L(0); PG8_BAR; PG8_MMA(0, 0, At, B0); PG8_MMA(0, 1, At, B1); PG8_BAR; PG8_SCHED;
            PG8_LDA(At, 0, 1); PG8_STAGE(PG8_SB(0, 0), b2, voffB); PG8_STAGE(PG8_SB(0, 1), b2 + hstep, voffB); PG8_STAGE_A(PG8_SA(0, 0), a2, 0, nxu);
            PG8_WAIT_V(8); PG8_WAIT_L(0); PG8_BAR; PG8_MMA(1, 0, At, B0); PG8_MMA(1, 1, At, B1); PG8_BAR; PG8_SCHED;
            PG8_LDB(B0, 1, 0); PG8_LDB(B1, 1, 1); PG8_SCHED; PG8_LDA(At, 1, 0); PG8_STAGE_A(PG8_SA(0, 1), a2, 1, nxu);
            PG8_WAIT_V(8); PG8_WAIT_L(0); PG8_BAR; PG8_MMA(0, 0, At, B0); PG8_MMA(0, 1, At, B1); PG8_BAR; PG8_SCHED;
            PG8_LDA(At, 1, 1); PG8_STAGE(PG8_SB(1, 0), b3, voffB); PG8_STAGE(PG8_SB(1, 1), b3 + hstep, voffB); PG8_STAGE_A(PG8_SA(1, 0), a3, 0, nxu);
            PG8_WAIT_V(8); PG8_WAIT_L(0); PG8_BAR; PG8_MMA(1, 0, At, B0); PG8_MMA(1, 1, At, B1); PG8_BAR; PG8_SCHED;
            } else {
            PG8_LDB(B0, 0, 0); PG8_SCHED; PG8_LDA(At, 0, 0); PG8_STAGE(PG8_SA(1, 1), a1 + hstep, voffA);
            PG8_WAIT_L(8); PG8_BAR; PG8_WAIT_L(0); PG8_MMA(0, 0, At, B0); PG8_BAR; PG8_SCHED;
            PG8_LDB(B1, 0, 1); PG8_STAGE(PG8_SB(0, 0), b2, voffB);
            PG8_BAR; PG8_WAIT_L(0); PG8_MMA(0, 1, At, B1); PG8_BAR;
            PG8_LDA(At, 0, 1); PG8_STAGE(PG8_SA(0, 0), a2, voffA);
            PG8_BAR; PG8_WAIT_L(0); PG8_MMA(1, 0, At, B0); PG8_BAR; PG8_SCHED;
            PG8_STAGE(PG8_SB(0, 1), b2 + hstep, voffB);
            PG8_WAIT_V(6); PG8_BAR; PG8_MMA(1, 1, At, B1); PG8_BAR;
            PG8_LDB(B0, 1, 0); PG8_SCHED; PG8_LDA(At, 1, 0); PG8_STAGE(PG8_SA(0, 1), a2 + hstep, voffA);
            PG8_WAIT_L(8); PG8_BAR; PG8_WAIT_L(0); PG8_MMA(0, 0, At, B0); PG8_BAR; PG8_SCHED;
            PG8_LDB(B1, 1, 1); PG8_STAGE(PG8_SB(1, 0), b3, voffB);
            PG8_BAR; PG8_WAIT_L(0); PG8_MMA(0, 1, At, B1); PG8_BAR;
            PG8_LDA(At, 1, 1); PG8_STAGE(PG8_SA(1, 0), a3, voffA);
            PG8_BAR; PG8_WAIT_L(0); PG8_MMA(1, 0, At, B0); PG8_BAR; PG8_SCHED;
            PG8_STAGE(PG8_SB(1, 1), b3 + hstep, voffB);
            PG8_WAIT_V(6); PG8_BAR; PG8_MMA(1, 1, At, B1); PG8_BAR;
            }
        }
        if constexpr (ALIGN_EPI) { if (wr == 0) PG8_BAR; }
        if constexpr (!Epi::AFTER_DRAIN) { E(acc, cur, wr, wc, fr, fq); S.done(cur); }
        if (!has_next) break;
#pragma unroll
        for (int a = 0; a < 2; ++a)
#pragma unroll
            for (int b = 0; b < 2; ++b)
#pragma unroll
                for (int m = 0; m < 4; ++m)
#pragma unroll
                    for (int n = 0; n < 2; ++n) acc[a][b][m][n] = (f32x4){0.f, 0.f, 0.f, 0.f};
        cur = nxt; cA = nA; cB = nB; ++ui;
        if constexpr (GATHER) {
#pragma unroll
            for (int h = 0; h < 2; ++h) { vAc[h][0] = vAn[h][0]; vAc[h][1] = vAn[h][1]; } }
        if constexpr (ALIGN_EPI) { if (wr == 1) PG8_BAR; }
    }
    PG8_WAIT_V(0);
    if constexpr (!ALIGN_EPI) { if (wr == 0) PG8_BAR; }
    PG8_BAR;
    if constexpr (Epi::AFTER_DRAIN) { E.fused(acc, cur, wr, wc, fr, fq, lds, wid, lane); S.done(cur); }
#undef PG8_SA
#undef PG8_SB
#undef PG8_STAGE
#undef PG8_STAGE_A
#undef PG8_LDA
#undef PG8_LDB
#undef PG8_MMA
#undef PG8_WAIT_V
#undef PG8_WAIT_L
#undef PG8_BAR
#undef PG8_SCHED
}
}
constexpr int NB = 8, SEQ = 2048, DM = 1024, CTXL = 256, ML = NB * SEQ, MC = NB * CTXL, MT = ML + MC;
constexpr int PP = 2560;
constexpr int INW = 2336;
constexpr int C_GK = 0, C_GV = 128, C_GAF = 384, C_GAB = 400, C_NK = 416, C_NV = 672, C_SK = 928, C_SV = 1056, C_GQ = 1184, C_GG = 1312, C_NQ = 1568, C_SQ = 1824;
constexpr int NWAVES = 8;
constexpr float NEPS = 1e-6f;
constexpr float LOG2E = 1.4426950408889634f;

constexpr size_t MiB = 1u << 20;
constexpr size_t WS_CTL = 0, CTL_ZERO_BYTES = 65536;
constexpr size_t WS_TAB = 1 * MiB;
constexpr size_t WS_MOD = 1 * MiB + 65536;
constexpr size_t WS_MODP = 2 * MiB;
constexpr size_t WS_WIN = 6 * MiB;
constexpr size_t WS_WOUT = 16 * MiB;
constexpr size_t WS_WGU = 20 * MiB;
constexpr size_t WS_WD = 148 * MiB;
constexpr size_t WS_H = 212 * MiB;
constexpr size_t WS_R1 = 248 * MiB;
constexpr size_t WS_R2 = 338 * MiB;
constexpr size_t WS_XB = 410 * MiB;
constexpr size_t WS_UST = 446 * MiB;
constexpr size_t WS_MISC = 464 * MiB;
constexpr size_t WS_DEC = WS_MISC;
constexpr size_t WS_AFF = WS_MISC + 1 * MiB;
constexpr size_t WS_AFFC = WS_MISC + 2 * MiB;
constexpr size_t WS_GATE = WS_MISC + 2 * MiB + 262144;
constexpr size_t WS_GATEC = WS_MISC + 2 * MiB + 524288;
constexpr size_t WS_INV = WS_MISC + 3 * MiB;
constexpr size_t WS_ROWIDX = WS_MISC + 3 * MiB + 786432;
constexpr size_t WS_END = 468 * MiB;
constexpr int CW_BAR = 4096;
constexpr int CW_QUEUE = 1024;
constexpr int CW_CONV = 2048;

constexpr int WAVE_LDS = 19456;
constexpr int RING_BYTES = NWAVES * WAVE_LDS;
constexpr int LDSCTL_OFF = RING_BYTES, MISC_OFF = LDSCTL_OFF + 320;
constexpr int LDS_BYTES = RING_BYTES + 1024;
static_assert(RING_BYTES >= pg8::STAGE_BYTES && LDS_BYTES <= 163840, "LDS map");

#define GAS __attribute__((address_space(1)))
#define LAS __attribute__((address_space(3)))
typedef unsigned short bf16_t;
typedef unsigned v4u __attribute__((ext_vector_type(4)));
typedef unsigned v2u __attribute__((ext_vector_type(2)));
typedef float f32x4 __attribute__((ext_vector_type(4)));
typedef float f32x2 __attribute__((ext_vector_type(2)));
typedef float f32x16 __attribute__((ext_vector_type(16)));
typedef short bf16x8 __attribute__((ext_vector_type(8)));
typedef short s16x4 __attribute__((ext_vector_type(4)));
typedef GAS unsigned gu32;
#define RLX_AGENT __ATOMIC_RELAXED, __HIP_MEMORY_SCOPE_AGENT
typedef __bf16 bf16x2_t __attribute__((ext_vector_type(2)));
__device__ __forceinline__ unsigned pk2(float lo, float hi) { f32x2 v = {lo, hi}; bf16x2_t b = __builtin_convertvector(v, bf16x2_t); return __builtin_bit_cast(unsigned, b); }
__device__ __forceinline__ float bflo(unsigned w) { return __uint_as_float(w << 16); }
__device__ __forceinline__ float bfhi(unsigned w) { return __uint_as_float(w & 0xffff0000u); }
__device__ __forceinline__ float bf1(bf16_t w) { return __uint_as_float((unsigned)w << 16); }
__device__ __forceinline__ float wave_sum(float v) {
#pragma unroll
    for (int o = 1; o < 64; o <<= 1) v += __shfl_xor(v, o);
    return v;
}
__device__ __forceinline__ float fexp2(float x) { return __builtin_amdgcn_exp2f(x); }
__device__ __forceinline__ float fexp(float x) { return __builtin_amdgcn_exp2f(x * LOG2E); }
__device__ __forceinline__ float flog(float x) { return __builtin_amdgcn_logf(x) * 0.6931471805599453f; }
__device__ __forceinline__ float frcp(float x) { return __builtin_amdgcn_rcpf(x); }
__device__ __forceinline__ float silu_f(float x) { return x * frcp(1.f + fexp(-x)); }
__device__ __forceinline__ int crow(int r, int hi) { return (r & 3) + 8 * (r >> 2) + 4 * hi; }
__device__ __forceinline__ s16x4 tr_read(LAS const unsigned char* p) { return __builtin_bit_cast(s16x4, __builtin_amdgcn_ds_read_tr16_b64_v4i16((LAS s16x4*)p)); }
__device__ __forceinline__ bf16x8 cat4(s16x4 a, s16x4 b) { return (bf16x8){a[0], a[1], a[2], a[3], b[0], b[1], b[2], b[3]}; }
__device__ __forceinline__ bf16x8 pack8(float a0, float a1, float a2, float a3, float a4, float a5, float a6, float a7) {
    v4u w; w.x = pk2(a0, a1); w.y = pk2(a2, a3); w.z = pk2(a4, a5); w.w = pk2(a6, a7); return __builtin_bit_cast(bf16x8, w); }
#define MFMA32(a, b, c) __builtin_amdgcn_mfma_f32_32x32x16_bf16((a), (b), (c), 0, 0, 0)

#ifndef EARLY_WB
#define EARLY_WB 0
#endif
#define XB_TMO      128
#define XB_XCNT(j)  (256  + 64 * (j))
#define XB_XSUB(j)  (1280 + 64 * (j))
#define XB_XGEN(j)  (2304 + 64 * (j))
#define XB_TOP      3328
#define XB_TOPGEN   3392
#define XCD_BAR_WORDS 3456
#define XB_SPIN_CAP (1u << 18)

__device__ __forceinline__ unsigned xb_ld(unsigned* p)              { return __hip_atomic_load(p, __ATOMIC_RELAXED, __HIP_MEMORY_SCOPE_AGENT); }
__device__ __forceinline__ unsigned xb_add(unsigned* p, unsigned v) { return __hip_atomic_fetch_add(p, v, __ATOMIC_RELAXED, __HIP_MEMORY_SCOPE_AGENT); }
__device__ __forceinline__ unsigned xb_xcc_id() { return (unsigned)__builtin_amdgcn_s_getreg((3 << 11) | 20) & 0xFu; }
#define XB_SPIN(cond, bar) do { unsigned _sp = 0; while (cond) { __builtin_amdgcn_s_sleep(1); \
    if ((++_sp & 255u) == 0u) { if (xb_ld(&(bar)[XB_TMO])) break; if (_sp > XB_SPIN_CAP) { atomicAdd(&(bar)[XB_TMO], 1u); break; } } } } while (0)

struct XcdBarrier {
    unsigned* bar; unsigned x;
    volatile LAS unsigned* st;
};

__device__ __forceinline__ XcdBarrier xcd_barrier_post(unsigned* bar, volatile LAS unsigned* st) {
    XcdBarrier b; b.bar = bar; b.x = xb_xcc_id(); b.st = st;
    if (threadIdx.x == 0) (void)xb_add(&bar[XB_XCNT(b.x)], 1u);
    return b;
}
__device__ __forceinline__ void xcd_barrier_complete(unsigned* bar, unsigned x, unsigned& nloc, unsigned& nx) {
    const unsigned G = gridDim.x * gridDim.y * gridDim.z;
    unsigned sum, cnt, mine, sp = 0u;
    for (;;) {
        sum = 0u; cnt = 0u; mine = 0u;
#pragma unroll
        for (unsigned j = 0; j < 16; ++j) { const unsigned c = xb_ld(&bar[XB_XCNT(j)]); sum += c; cnt += (c > 0u) ? 1u : 0u; mine = (j == x) ? c : mine; }
        if (sum == G) break;
        __builtin_amdgcn_s_sleep(1);
        if ((++sp & 255u) == 0u) { if (xb_ld(&bar[XB_TMO])) break; if (sp > XB_SPIN_CAP) { atomicAdd(&bar[XB_TMO], 1u); break; } }
    }
    nloc = mine > 0u ? mine : 1u; nx = cnt > 0u ? cnt : 1u;
}

__device__ __forceinline__ void xcd_barrier(const XcdBarrier& b) {
    asm volatile("s_waitcnt vmcnt(0)" ::: "memory");
    __syncthreads();
    if (threadIdx.x == 0) {
        unsigned* bar = b.bar;
        __builtin_amdgcn_s_waitcnt(0);
        unsigned nloc = b.st[0], nx = b.st[1];
        if (nloc == 0u) { xcd_barrier_complete(bar, b.x, nloc, nx); b.st[0] = nloc; b.st[1] = nx; }
#if EARLY_WB
        __builtin_amdgcn_fence(__ATOMIC_RELEASE, "agent");
        asm volatile("s_waitcnt vmcnt(0)" ::: "memory");
#endif
        const unsigned old = xb_add(&bar[XB_XSUB(b.x)], 1u);
        const unsigned gen = old / nloc;
        if (old + 1u == (gen + 1u) * nloc) {
            __builtin_amdgcn_fence(__ATOMIC_RELEASE, "agent");
            asm volatile("s_waitcnt vmcnt(0)" ::: "memory");
            const unsigned og = xb_add(&bar[XB_TOP], 1u);
            const unsigned tg = og / nx;
            if (og + 1u == (tg + 1u) * nx) xb_add(&bar[XB_TOPGEN], 1u);
            else XB_SPIN(xb_ld(&bar[XB_TOPGEN]) == tg, bar);
            __builtin_amdgcn_fence(__ATOMIC_ACQUIRE, "agent");
            xb_add(&bar[XB_XGEN(b.x)], 1u);
            asm volatile("s_waitcnt vmcnt(0)" ::: "memory");
        } else {
            XB_SPIN(xb_ld(&bar[XB_XGEN(b.x)]) == gen, bar);
            __builtin_amdgcn_fence(__ATOMIC_ACQUIRE, "agent");
            asm volatile("s_waitcnt vmcnt(0)" ::: "memory");
        }
    }
    __syncthreads();
}
__device__ __forceinline__ void ld_row_f32(const float* p, int lane, f32x4 (&v)[4]) {
#pragma unroll
    for (int j = 0; j < 4; ++j) v[j] = *(const f32x4*)(p + 256 * j + 4 * lane);
}
__device__ __forceinline__ void st_row_f32(float* p, int lane, const f32x4 (&v)[4]) {
#pragma unroll
    for (int j = 0; j < 4; ++j) *(f32x4*)(p + 256 * j + 4 * lane) = v[j];
}
__device__ __forceinline__ void ld_row_bf16(const bf16_t* p, int lane, f32x4 (&v)[4]) {
#pragma unroll
    for (int j = 0; j < 4; ++j) { const v2u w = *(const v2u*)(p + 256 * j + 4 * lane); v[j] = (f32x4){bflo(w.x), bfhi(w.x), bflo(w.y), bfhi(w.y)}; }
}
__device__ __forceinline__ void st_row_bf16(bf16_t* p, int lane, const f32x4 (&v)[4]) {
#pragma unroll
    for (int j = 0; j < 4; ++j) { v2u w; w.x = pk2(v[j].x, v[j].y); w.y = pk2(v[j].z, v[j].w); *(v2u*)(p + 256 * j + 4 * lane) = w; }
}
__device__ __forceinline__ void ld_vec_lds(LAS const float* p, int lane, f32x4 (&v)[4]) {
#pragma unroll
    for (int j = 0; j < 4; ++j) v[j] = *(LAS const f32x4*)(p + 256 * j + 4 * lane);
}
__device__ __forceinline__ float sumsq16(const f32x4 (&v)[4]) {
    float s = 0.f;
#pragma unroll
    for (int j = 0; j < 4; ++j) s += (v[j].x * v[j].x + v[j].y * v[j].y) + (v[j].z * v[j].z + v[j].w * v[j].w);
    return s;
}
__device__ __forceinline__ float modfin(const float* modp, const float* bmod, int l, int r, int n) {
    float s = bmod[l * 6144 + n];
#pragma unroll
    for (int kc = 0; kc < 8; ++kc) s += modp[((size_t)(l * 8 + kc) * 9 + r) * 6144 + n];
    return s;
}

#ifndef CV_G1
#define CV_G1 4
#endif
#ifndef CV_G2
#define CV_G2 6
#endif
#ifndef CV_G3
#define CV_G3 5
#endif
#ifndef CV_G4
#define CV_G4 1
#endif
#ifndef CONV_M3
#define CONV_M3 5376
#endif
#ifndef CONV_IN_P0
#define CONV_IN_P0 1
#endif
__device__ __forceinline__ void tr_item64(const float* W, int N, int Nvalid, bf16_t* WT, int Kd, int k0, int n0, int dst_row0, LAS float* scr, int lane) {
    const int q = lane & 15, kr = lane >> 4;
    f32x4 t[16];
#pragma unroll
    for (int i = 0; i < 16; ++i) { const int kk = 4 * i + kr; const int n = n0 + 4 * q;
        t[i] = (n < Nvalid) ? *(const f32x4*)(W + (size_t)(k0 + kk) * N + n) : (f32x4){0.f, 0.f, 0.f, 0.f}; }
#pragma unroll
    for (int i = 0; i < 16; ++i) { const int kk = 4 * i + kr; LAS float* d = scr + kk * 65 + 4 * q; d[0] = t[i].x; d[1] = t[i].y; d[2] = t[i].z; d[3] = t[i].w; }
    const int c = lane & 7, nl = lane >> 3;
#pragma unroll
    for (int j = 0; j < 8; ++j) { const int n = nl + 8 * j; LAS const float* s = scr + (8 * c) * 65 + n;
        v4u o; o.x = pk2(s[0 * 65], s[1 * 65]); o.y = pk2(s[2 * 65], s[3 * 65]); o.z = pk2(s[4 * 65], s[5 * 65]); o.w = pk2(s[6 * 65], s[7 * 65]);
        *(v4u*)(WT + (size_t)(dst_row0 + n) * Kd + k0 + 8 * c) = o; }
}
__device__ __forceinline__ void expert_conv_item(const float* const* in, unsigned char* ws, int l, int r, LAS float* scr, int lane) {
    const float* w_gate = in[15]; const float* w_up = in[16]; const float* w_down = in[17];
    const int which = r >> 12; r &= 4095;
    const int e = r >> 8, kb = (r & 255) >> 4, nb = r & 15, n0 = 64 * nb;
    const size_t eoff = (size_t)(l * 16 + e) * 1024 * 1024;
    if (which == 0) tr_item64(w_gate + eoff, 1024, 1024, (bf16_t*)(ws + WS_WGU) + 2 * eoff, 1024, 64 * kb, n0, (n0 >> 7) * 256 + (n0 & 127), scr, lane);
    else if (which == 1) tr_item64(w_up + eoff, 1024, 1024, (bf16_t*)(ws + WS_WGU) + 2 * eoff, 1024, 64 * kb, n0, (n0 >> 7) * 256 + 128 + (n0 & 127), scr, lane);
    else tr_item64(w_down + eoff, 1024, 1024, (bf16_t*)(ws + WS_WD) + eoff, 1024, 64 * kb, n0, n0, scr, lane);
}
__device__ __forceinline__ void conv_pull(const float* const* in, unsigned char* ws, int l_lo, int l_hi, int budget, LAS float* scr, int lane) {
    for (int l = l_lo; l <= l_hi && l < 2; ++l) {
        unsigned* ctr = (unsigned*)(ws + WS_CTL) + CW_CONV + 64 * l;
        while (budget > 0) {
            const int c = budget < 8 ? budget : 8;
            unsigned r = 0; if (lane == 0) r = __hip_atomic_fetch_add(ctr, (unsigned)c, __ATOMIC_RELAXED, __HIP_MEMORY_SCOPE_AGENT);
            r = (unsigned)__builtin_amdgcn_readfirstlane((int)r);
            if (r >= 12288u) break;
            for (int k = 0; k < c && (int)r + k < 12288; ++k) expert_conv_item(in, ws, l, (int)r + k, scr, lane);
            budget -= c;
        }
    }
}
struct TrDesc { const float* src; bf16_t* dst; int N, Nvalid, k0, n0, drow; };
constexpr int TR_IN = 16 * 40, TR_OUT = 16 * 16, TR_E = 16 * 16 * 16, TR_L = TR_IN + TR_OUT + 3 * TR_E, TR_ALL = 2 * TR_L;
constexpr int CV_N1 = CV_G1 * 384, CV_N2 = CV_G2 * 1792, CV_N3 = CV_G3 * 1024, CV_N4 = CV_G4 * 1536;
constexpr int P0_A = TR_L - CV_N1 - CV_N2;
constexpr int P0_B = TR_ALL - CONV_M3 - CV_N3 - CV_N4;
static_assert(P0_A >= 896 && P0_B >= TR_L + 896, "tail conversion budgets exceed the expert tiles");
__device__ __forceinline__ void tr_desc(const float* const* in, unsigned char* ws, int r, TrDesc& d) {
    const int l = r / TR_L; r -= l * TR_L;
    if (r < TR_IN) { const int kb = r / 40, nb = r % 40; d.src = in[7] + (size_t)l * 1024 * INW; d.dst = (bf16_t*)(ws + WS_WIN) + (size_t)l * PP * 1024; d.N = INW; d.Nvalid = INW; d.k0 = 64 * kb; d.n0 = 64 * nb; d.drow = 64 * nb; return; }
    r -= TR_IN;
    if (r < TR_OUT) { const int kb = r / 16, nb = r % 16; d.src = in[8] + (size_t)l * 1024 * 1024; d.dst = (bf16_t*)(ws + WS_WOUT) + (size_t)l * 1024 * 1024; d.N = 1024; d.Nvalid = 1024; d.k0 = 64 * kb; d.n0 = 64 * nb; d.drow = 64 * nb; return; }
    r -= TR_OUT;
    const int which = r >> 12; r &= 4095;
    const int e = r >> 8, kb = (r & 255) >> 4, nb = r & 15, n0 = 64 * nb;
    const size_t eoff = (size_t)(l * 16 + e) * 1024 * 1024;
    d.N = 1024; d.Nvalid = 1024; d.k0 = 64 * kb; d.n0 = n0;
    if (which == 0) { d.src = in[15] + eoff; d.dst = (bf16_t*)(ws + WS_WGU) + 2 * eoff; d.drow = (n0 >> 7) * 256 + (n0 & 127); }
    else if (which == 1) { d.src = in[16] + eoff; d.dst = (bf16_t*)(ws + WS_WGU) + 2 * eoff; d.drow = (n0 >> 7) * 256 + 128 + (n0 & 127); }
    else { d.src = in[17] + eoff; d.dst = (bf16_t*)(ws + WS_WD) + eoff; d.drow = n0; }
}
__device__ __forceinline__ void tr_load(const TrDesc& d, int lane, f32x4 (&t)[16]) {
    const int q = lane & 15, kr = lane >> 4, n = d.n0 + 4 * q;
    const float* p = d.src + (size_t)(d.k0 + kr) * d.N + (n < d.Nvalid ? n : 0);
#pragma unroll
    for (int i = 0; i < 16; ++i) t[i] = *(const f32x4*)(p + (size_t)(4 * i) * d.N);
}
__device__ __forceinline__ void tr_finish(const TrDesc& d, f32x4 (&t)[16], LAS float* scr, int lane) {
    const int q = lane & 15, kr = lane >> 4; const bool valid = (d.n0 + 4 * q) < d.Nvalid;
#pragma unroll
    for (int i = 0; i < 16; ++i) { const int kk = 4 * i + kr; LAS float* s = scr + kk * 65 + 4 * q; const f32x4 v = valid ? t[i] : (f32x4){0.f, 0.f, 0.f, 0.f}; s[0] = v.x; s[1] = v.y; s[2] = v.z; s[3] = v.w; }
    const int c = lane & 7, nl = lane >> 3;
#pragma unroll
    for (int j = 0; j < 8; ++j) { const int n = nl + 8 * j; LAS const float* s = scr + (8 * c) * 65 + n;
        v4u o; o.x = pk2(s[0 * 65], s[1 * 65]); o.y = pk2(s[2 * 65], s[3 * 65]); o.z = pk2(s[4 * 65], s[5 * 65]); o.w = pk2(s[6 * 65], s[7 * 65]);
        *(v4u*)(d.dst + (size_t)(d.drow + n) * 1024 + d.k0 + 8 * c) = o; }
}
__device__ __forceinline__ void tr_stream(const float* const* in, unsigned char* ws, int first, int stride, int hi, LAS float* scr, int lane, int cut = 1 << 30, int jump = 0) {
#define TR_ID(x) ((x) < cut ? (x) : (x) + jump)
    if (first >= hi) return;
    const int n_my = (hi - first + stride - 1) / stride;
    TrDesc dA, dB; f32x4 tA[16], tB[16];
    tr_desc(in, ws, TR_ID(first), dA); tr_load(dA, lane, tA);
    for (int i = 0; i < n_my; i += 2) {
        { const int nx = i + 1 < n_my ? i + 1 : n_my - 1; tr_desc(in, ws, TR_ID(first + nx * stride), dB); tr_load(dB, lane, tB); }
        tr_finish(dA, tA, scr, lane);
        if (i + 1 >= n_my) break;
        { const int nx = i + 2 < n_my ? i + 2 : n_my - 1; tr_desc(in, ws, TR_ID(first + nx * stride), dA); tr_load(dA, lane, tA); }
        tr_finish(dB, tB, scr, lane);
    }
#undef TR_ID
}
__device__ __forceinline__ void phase_p0(const float* const* in, unsigned char* ws, LAS unsigned char* wl, int gw, int NGW, int lane) {
    const float* cvec = in[1]; const float* cctx = in[3]; const float* wmod = in[4];
    const float* w_in = in[7]; const float* w_out = in[8];
    float* modp = (float*)(ws + WS_MODP);
    constexpr int NI_MOD = 2 * 8 * 24, NI_ROPE = 16;
    constexpr int NI_IN = 16 * 40, NI_OUT = 16 * 16, NI_E = 16 * 16 * 16;
    constexpr int NI_L = NI_IN + NI_OUT + (CONV_IN_P0 ? 3 * NI_E : 0);
    constexpr int NITEMS = NI_MOD + NI_ROPE + 2 * NI_L;
    LAS float* scr = (LAS float*)wl;
    for (int it = gw; it < NI_MOD + NI_ROPE; it += NGW) {
        int r = it;
        if (r < NI_MOD) {
            const int cb = r % 24, kc = (r / 24) & 7, l = r / 192;
            for (int idx = lane; idx < 128 * 9; idx += 64) { const int rr = idx / 128, k = idx % 128; const float cv = (rr < 8) ? cvec[rr * 1024 + kc * 128 + k] : cctx[kc * 128 + k]; scr[k * 12 + rr] = silu_f(cv); }
            f32x4 acc[9];
#pragma unroll
            for (int rr = 0; rr < 9; ++rr) acc[rr] = (f32x4){0.f, 0.f, 0.f, 0.f};
            const float* wp = wmod + ((size_t)l * 1024 + kc * 128) * 6144 + cb * 256 + 4 * lane;
#pragma unroll 4
            for (int k = 0; k < 128; ++k) { const f32x4 w = *(const f32x4*)(wp + (size_t)k * 6144);
                const f32x4 s0 = *(LAS const f32x4*)(scr + k * 12), s1 = *(LAS const f32x4*)(scr + k * 12 + 4); const float s8 = scr[k * 12 + 8];
                acc[0] += w * s0.x; acc[1] += w * s0.y; acc[2] += w * s0.z; acc[3] += w * s0.w; acc[4] += w * s1.x; acc[5] += w * s1.y; acc[6] += w * s1.z; acc[7] += w * s1.w; acc[8] += w * s8; }
#pragma unroll
            for (int rr = 0; rr < 9; ++rr) *(f32x4*)(modp + ((size_t)(l * 8 + kc) * 9 + rr) * 6144 + cb * 256 + 4 * lane) = acc[rr];
            continue;
        }
        r -= NI_MOD;
        if (r < NI_ROPE) {
            const int id = r * 64 + lane, pos = id >> 4, i = id & 15;
            const float fr = fexp2(-(float)i * (13.287712379549449f / 16.f));
            float rev = (float)pos * fr * 0.15915494309189535f; rev -= floorf(rev);
            f32x2 cs; cs.x = __builtin_amdgcn_cosf(rev); cs.y = __builtin_amdgcn_sinf(rev);
            ((f32x2*)(ws + WS_TAB))[id] = cs;
            continue;
        }
        break;
    }
    if (NGW == 2048) tr_stream(in, ws, (gw + NGW - (NI_MOD + NI_ROPE)) % NGW, NGW, P0_A + (P0_B - TR_L), scr, lane, P0_A, TR_L - P0_A);
    else tr_stream(in, ws, gw, NGW, TR_ALL, scr, lane);
}

__device__ __forceinline__ void phase_a0(const float* const* in, unsigned char* ws, LAS unsigned char* lds, int G, int tid, int wave, int lane) {
    const float* x = in[0]; const float* ctx = in[2]; const float* bmod = in[5]; const float* gains = in[6];
    const float* modp = (const float*)(ws + WS_MODP); float* mod = (float*)(ws + WS_MOD); bf16_t* H = (bf16_t*)(ws + WS_H);
    LAS float* V = (LAS float*)lds;
    for (int row = blockIdx.x; row < 18; row += G) { const int l = row / 9, r = row % 9;
        for (int n = tid; n < 6144; n += 512) mod[(size_t)row * 6144 + n] = modfin(modp, bmod, l, r, n); }
    for (int t = blockIdx.x; t < 256; t += G) {
        const int b = t >> 5;
        __syncthreads();
        for (int n = tid; n < 1024; n += 512) { const float g = gains[n];
            V[n] = g * (1.f + modfin(modp, bmod, 0, b, 1024 + n)); V[1024 + n] = modfin(modp, bmod, 0, b, n);
            V[2048 + n] = g * (1.f + modfin(modp, bmod, 0, 8, 1024 + n)); V[3072 + n] = modfin(modp, bmod, 0, 8, n); }
        __syncthreads();
#pragma unroll 1
        for (int i0 = 0; i0 < 9; i0 += 3) {
            f32x4 xq[3][4];
#pragma unroll
            for (int k = 0; k < 3; ++k) { const int i = i0 + k; const bool isc = (i == 8);
                const float* src = isc ? (ctx + (size_t)(8 * t + wave) * 1024) : (x + (size_t)(64 * t + 8 * wave + i) * 1024); ld_row_f32(src, lane, xq[k]); }
#pragma unroll
            for (int k = 0; k < 3; ++k) { const int i = i0 + k; const bool isc = (i == 8);
                const int row = isc ? (ML + 8 * t + wave) : (64 * t + 8 * wave + i);
                f32x4 (&v)[4] = xq[k]; f32x4 a[4], s[4];
                const float rstd = __builtin_amdgcn_rsqf(wave_sum(sumsq16(v)) * (1.f / 1024.f) + NEPS);
                ld_vec_lds(V + (isc ? 2048 : 0), lane, a); ld_vec_lds(V + (isc ? 3072 : 1024), lane, s);
#pragma unroll
                for (int j = 0; j < 4; ++j) v[j] = v[j] * rstd * a[j] + s[j];
                st_row_bf16(H + (size_t)row * 1024, lane, v);
            }
        }
    }
}
constexpr int VP = 192;
struct AttnTile { f32x16 o0, o1; float m, lsum; };
__device__ __forceinline__ void attn_softmax(f32x16& s, AttnTile& T) {
    float bm = fmaxf(fmaxf(s[0], s[1]), fmaxf(s[2], s[3]));
#pragma unroll
    for (int i = 4; i < 16; i += 4) bm = fmaxf(bm, fmaxf(fmaxf(s[i], s[i + 1]), fmaxf(s[i + 2], s[i + 3])));
    bm = fmaxf(bm, __shfl_xor(bm, 32));
    const float mo = T.m, mn = fmaxf(mo, bm);
    T.m = mn;
    float ps = 0.f;
#pragma unroll
    for (int i = 0; i < 16; ++i) { s[i] = fexp2(s[i] - mn); ps += s[i]; }
    if (__any(mn != mo)) {
        const float alpha = fexp2(mo - mn);
        T.lsum *= alpha;
#pragma unroll
        for (int i = 0; i < 16; ++i) { T.o0[i] *= alpha; T.o1[i] *= alpha; }
    }
    T.lsum += ps;
}
__device__ __forceinline__ void attn_item(const int MODE, const bf16_t* P, bf16_t* MIX, int item, LAS unsigned char* wl, int lane,
                                          const float* __restrict__ rpb, const float* __restrict__ sink, const bool dry = false) {
    asm volatile("" : "+v"(lane));
    const int ql = lane & 31, hi = lane >> 5;
    int b, hq, qcol, kcol, vcol, ocol, qrow0, r = 0, rs = 0, q64 = 0, nloc, kb_lo = 0;
    if (MODE == 0) { r = item & 31; hq = (item >> 5) & 3; b = item >> 7;
        qcol = C_NQ + hq * 64; kcol = C_NK + hq * 64; vcol = C_NV + hq * 64; ocol = 256 + hq * 64; qrow0 = b * SEQ + r * 64;
        rs = r - 4; rs = rs < 0 ? 0 : (rs > 24 ? 24 : rs); nloc = 16; }
    else if (MODE == 1) { q64 = item & 31; hq = (item >> 5) & 7; b = item >> 8;
        qcol = C_SQ + hq * 64; kcol = C_SK + (hq >> 2) * 64; vcol = C_SV + (hq >> 2) * 64; ocol = 512 + hq * 64; qrow0 = b * SEQ + q64 * 64;
        kb_lo = 2 * q64 - 4; if (kb_lo < 0) kb_lo = 0; int kb_hi = 2 * q64 + 5; if (kb_hi > 63) kb_hi = 63; nloc = kb_hi - kb_lo + 1; }
    else if (MODE == 2) { q64 = item & 3; hq = (item >> 2) & 3; b = item >> 4;
        qcol = C_NQ + hq * 64; kcol = C_NK + hq * 64; vcol = C_NV + hq * 64; ocol = 256 + hq * 64; qrow0 = ML + b * CTXL + q64 * 64; nloc = 0; }
    else { q64 = item & 3; hq = (item >> 2) & 7; b = item >> 5;
        qcol = C_SQ + hq * 64; kcol = C_SK + (hq >> 2) * 64; vcol = C_SV + (hq >> 2) * 64; ocol = 512 + hq * 64; qrow0 = ML + b * CTXL + q64 * 64; nloc = 0; }
    const int nblk = 8 + nloc;
    LAS unsigned char* vl = wl;
    LAS float* rl = (LAS float*)(wl + 32 * VP);
    if (MODE == 0) { for (int i = lane; i < 465; i += 64) rl[i] = rpb[hq * 465 + i] * LOG2E; }
    LAS unsigned char* qimg = wl + 32 * VP + 1920;
    constexpr int QP = 144;
#pragma unroll
    for (int i = 0; i < 8; ++i) { const int c = lane + 64 * i; const v4u v = *(const v4u*)(P + (size_t)(qrow0 + (c >> 3)) * PP + qcol + (c & 7) * 8); *(LAS v4u*)(qimg + (c >> 3) * QP + (c & 7) * 16) = v; }
    LAS const unsigned char* qrd = qimg + ql * QP + 16 * hi;
    auto blk_row0 = [&](int blk) -> int {
        if (blk < 8) return ML + b * CTXL + blk * 32;
        const int lb = blk - 8;
        if (MODE == 0) return b * SEQ + (rs + (lb >> 1)) * 64 + (lb & 1) * 32;
        return b * SEQ + 32 * (kb_lo + lb);
    };
    auto load_blk = [&](int blk, bf16x8 (&kn)[4], v4u (&vn)[4]) {
        const int r0 = blk_row0(blk);
        const bf16_t* kp = P + (size_t)(r0 + ql) * PP + kcol + 8 * hi;
#pragma unroll
        for (int ds = 0; ds < 4; ++ds) kn[ds] = *(const bf16x8*)(kp + 16 * ds);
#pragma unroll
        for (int i = 0; i < 4; ++i) { const int c = lane + 64 * i; vn[i] = *(const v4u*)(P + (size_t)(r0 + (c >> 3)) * PP + vcol + (c & 7) * 8); }
    };
    AttnTile T[2];
#pragma unroll
    for (int t = 0; t < 2; ++t) { T[t].m = -INFINITY; T[t].lsum = 0.f;
#pragma unroll
        for (int i = 0; i < 16; ++i) { T[t].o0[i] = 0.f; T[t].o1[i] = 0.f; } }
    const int tr_off = (4 * hi + ((lane & 15) >> 2)) * VP + (16 * ((lane >> 4) & 1) + 4 * (lane & 3)) * 2;
    auto step = [&](int blk, bf16x8 (&kf)[4], v4u (&vr)[4]) {
#pragma unroll
        for (int i = 0; i < 4; ++i) { const int c = lane + 64 * i; *(LAS v4u*)(vl + (c >> 3) * VP + (c & 7) * 16) = vr[i]; }
        f32x16 sc[2];
#pragma unroll
        for (int t = 0; t < 2; ++t) {
#pragma unroll
            for (int i = 0; i < 16; ++i) sc[t][i] = 0.f;
#pragma unroll
            for (int ds = 0; ds < 4; ++ds) sc[t] = MFMA32(kf[ds], *(LAS const bf16x8*)(qrd + 32 * t * QP + 32 * ds), sc[t]);
        }
        if (blk + 2 < nblk) load_blk(blk + 2, kf, vr);
        bf16x8 vf[2][2];
#pragma unroll
        for (int ks = 0; ks < 2; ++ks) { LAS const unsigned char* vb = vl + tr_off + 16 * ks * VP;
            vf[ks][0] = cat4(tr_read(vb), tr_read(vb + 8 * VP)); vf[ks][1] = cat4(tr_read(vb + 64), tr_read(vb + 8 * VP + 64)); }
#pragma unroll
        for (int t = 0; t < 2; ++t) {
            f32x16& s = sc[t];
            if (MODE == 0 && blk >= 8) {
                const int lb = blk - 8, j = lb >> 1, ch = lb & 1, c = t * 32 + ql;
                int cs = c - 8; cs = cs < 0 ? 0 : (cs > 48 ? 48 : cs);
                LAS const float* rrow = rl + (rs + j - r + 7) * 31 + (15 - c);
#pragma unroll
                for (int i = 0; i < 16; ++i) { const int kc = ch * 32 + crow(i, hi); const bool ok = (kc >= cs) && (kc < cs + 16);
                    const float bias = rrow[ok ? kc : c];
                    s[i] = ok ? (s[i] + bias) : -INFINITY; }
            } else if (MODE == 1 && blk >= 8) {
                const int rel = (kb_lo + blk - 8) - (2 * q64 + t);
                if (rel <= -4 || rel >= 4) {
#pragma unroll
                    for (int i = 0; i < 16; ++i) { const int kk = crow(i, hi); const bool ok = (rel == -4) ? (kk >= ql) : ((rel == 4) ? (kk <= ql) : false);
                        s[i] = ok ? s[i] : -INFINITY; }
                }
            }
            attn_softmax(s, T[t]);
#pragma unroll
            for (int ks = 0; ks < 2; ++ks) {
                const bf16x8 pf = pack8(s[8 * ks + 0], s[8 * ks + 1], s[8 * ks + 2], s[8 * ks + 3], s[8 * ks + 4], s[8 * ks + 5], s[8 * ks + 6], s[8 * ks + 7]);
                T[t].o0 = MFMA32(vf[ks][0], pf, T[t].o0); T[t].o1 = MFMA32(vf[ks][1], pf, T[t].o1);
            }
            __builtin_amdgcn_sched_barrier(0);
        }
    };
    bf16x8 kA[4], kB[4]; v4u vA[4], vB[4];
    load_blk(0, kA, vA); load_blk(1, kB, vB);
    for (int blk = 0; blk < nblk; blk += 2) { step(blk, kA, vA); if (blk + 1 < nblk) step(blk + 1, kB, vB); }
#pragma unroll
    for (int t = 0; t < 2; ++t) {
        float lt = T[t].lsum + __shfl_xor(T[t].lsum, 32);
        if (MODE == 1 || MODE == 3) lt += fexp2(sink[hq] * LOG2E - T[t].m);
        const float inv = frcp(lt);
        bf16_t* op = MIX + (size_t)(qrow0 + 32 * t + ql) * 1024 + ocol + 4 * hi;
#pragma unroll
        for (int g = 0; g < 4; ++g) {
            v2u w0, w1; w0.x = pk2(T[t].o0[4 * g] * inv, T[t].o0[4 * g + 1] * inv); w0.y = pk2(T[t].o0[4 * g + 2] * inv, T[t].o0[4 * g + 3] * inv);
            w1.x = pk2(T[t].o1[4 * g] * inv, T[t].o1[4 * g + 1] * inv); w1.y = pk2(T[t].o1[4 * g + 2] * inv, T[t].o1[4 * g + 3] * inv);
            *(v2u*)(op + 8 * g) = w0; *(v2u*)(op + 32 + 8 * g) = w1;
        }
    }
}
constexpr int GP = 144;
constexpr int G_V = 0, G_A = 64 * GP, G_B = 64 * GP + 32 * GP;
static_assert(G_B + 32 * GP <= WAVE_LDS, "gla LDS");

struct GlaCum { float cum[2][16]; float tot; };
__device__ __forceinline__ void gla_cum(const bf16_t* P, int row0, int hh, int dir, const float* __restrict__ a_up, const float* __restrict__ a_bias, int lane, GlaCum& C) {
    const int kk = lane & 31, hi = lane >> 5;
    const float* up = a_up + (size_t)dir * 16 * 128 + (size_t)(8 * hi) * 128 + hh * 32 + kk;
    const bf16x8 ub = pack8(up[0], up[128], up[256], up[384], up[512], up[640], up[768], up[896]);
    const float bias = a_bias[dir * 128 + hh * 32 + kk];
    float gs[2][4];
#pragma unroll
    for (int tt = 0; tt < 2; ++tt) {
        const bf16x8 al = *(const bf16x8*)(P + (size_t)(row0 + 32 * tt + kk) * PP + C_GAF + 16 * dir + 8 * hi);
        f32x16 z;
#pragma unroll
        for (int i = 0; i < 16; ++i) z[i] = 0.f;
        z = MFMA32(al, ub, z);
#pragma unroll
        for (int g = 0; g < 4; ++g) { float run = 0.f;
#pragma unroll
            for (int e = 0; e < 4; ++e) { const float zz = z[4 * g + e] + bias; const float ls = fminf(zz, 0.f) - flog(1.f + fexp(-fabsf(zz)));
                const float l = ls * (1.f / 16.f);
                if (dir == 0) { run += l; C.cum[tt][4 * g + e] = run; } else { C.cum[tt][4 * g + e] = run; run += l; } }
            gs[tt][g] = run; }
    }
    float off = 0.f;
#pragma unroll
    for (int tt = 0; tt < 2; ++tt)
#pragma unroll
        for (int g = 0; g < 4; ++g) { const float other = __shfl_xor(gs[tt][g], 32); const float mine = off + (hi ? other : 0.f);
#pragma unroll
            for (int e = 0; e < 4; ++e) C.cum[tt][4 * g + e] += mine;
            off += gs[tt][g] + other; }
    C.tot = off;
    if (dir == 1) {
#pragma unroll
        for (int tt = 0; tt < 2; ++tt)
#pragma unroll
            for (int r = 0; r < 16; ++r) C.cum[tt][r] = off - C.cum[tt][r];
    }
}
__device__ __forceinline__ void gla_ld_tc(const bf16_t* P, int row0, int col, int lane, float (&x)[2][16]) {
    const int kk = lane & 31, hi = lane >> 5;
#pragma unroll
    for (int tt = 0; tt < 2; ++tt)
#pragma unroll
        for (int r = 0; r < 16; ++r) x[tt][r] = bf1(P[(size_t)(row0 + 32 * tt + crow(r, hi)) * PP + col + kk]);
}
__device__ __forceinline__ void gla_st_img(LAS unsigned char* img, int lane, const float (&x)[2][16]) {
    const int kk = lane & 31, hi = lane >> 5;
#pragma unroll
    for (int tt = 0; tt < 2; ++tt)
#pragma unroll
        for (int g = 0; g < 4; ++g) { v2u w; w.x = pk2(x[tt][4 * g], x[tt][4 * g + 1]); w.y = pk2(x[tt][4 * g + 2], x[tt][4 * g + 3]);
            *(LAS v2u*)(img + kk * GP + (32 * tt + 8 * g + 4 * hi) * 2) = w; }
}
__device__ __forceinline__ void gla_stage_v(const bf16_t* P, int row0, int hh, LAS unsigned char* wl, int lane) {
#pragma unroll
    for (int i = 0; i < 8; ++i) { const int c = lane + 64 * i; const v4u v = *(const v4u*)(P + (size_t)(row0 + (c >> 3)) * PP + C_GV + hh * 64 + (c & 7) * 8);
        *(LAS v4u*)(wl + G_V + (c >> 3) * GP + (c & 7) * 16) = v; }
}
__device__ __forceinline__ int gla_row0(int b, int nc) { return nc < 4 ? (ML + b * CTXL + 64 * nc) : (b * SEQ + 64 * (nc - 4)); }

__device__ __forceinline__ void gla_local_item(const bf16_t* P, float* UST, float* DEC, int item, LAS unsigned char* wl, int lane,
                                               const float* __restrict__ a_up, const float* __restrict__ a_bias) {
    asm volatile("" : "+v"(lane));
    const int nc = item % 36, hh = (item / 36) & 3, b = item / 144;
    const int row0 = gla_row0(b, nc), kk = lane & 31, hi = lane >> 5;
    gla_stage_v(P, row0, hh, wl, lane);
    float kv[2][16]; gla_ld_tc(P, row0, C_GK + hh * 32, lane, kv);
#pragma unroll
    for (int dir = 0; dir < 2; ++dir) {
        GlaCum C; gla_cum(P, row0, hh, dir, a_up, a_bias, lane, C);
        float kd[2][16];
#pragma unroll
        for (int tt = 0; tt < 2; ++tt)
#pragma unroll
            for (int r = 0; r < 16; ++r) kd[tt][r] = kv[tt][r] * fexp(C.tot - C.cum[tt][r]);
        gla_st_img(wl + (dir == 0 ? G_A : G_B), lane, kd);
        if (hi == 0) DEC[((size_t)((b * 4 + hh) * 2 + dir) * 36 + nc) * 32 + kk] = fexp(C.tot);
    }
    const int trv = ((lane & 15) >> 2) * GP + (16 * ((lane >> 4) & 1) + 4 * (lane & 3)) * 2;
#pragma unroll
    for (int dir = 0; dir < 2; ++dir) {
        f32x16 u0, u1;
#pragma unroll
        for (int i = 0; i < 16; ++i) { u0[i] = 0.f; u1[i] = 0.f; }
        LAS const unsigned char* img = wl + (dir == 0 ? G_A : G_B);
#pragma unroll
        for (int s = 0; s < 4; ++s) {
            const bf16x8 kb = *(LAS const bf16x8*)(img + kk * GP + (16 * s + 8 * hi) * 2);
            LAS const unsigned char* vb = wl + G_V + trv + (16 * s + 8 * hi) * GP;
            const bf16x8 v0 = cat4(tr_read(vb), tr_read(vb + 4 * GP));
            const bf16x8 v1 = cat4(tr_read(vb + 64), tr_read(vb + 4 * GP + 64));
            u0 = MFMA32(v0, kb, u0); u1 = MFMA32(v1, kb, u1);
        }
        float* up = UST + ((size_t)((b * 4 + hh) * 2 + dir) * 36 + nc) * 2048 + kk;
#pragma unroll
        for (int i = 0; i < 16; ++i) { up[(size_t)crow(i, hi) * 32] = u0[i]; up[(size_t)(32 + crow(i, hi)) * 32] = u1[i]; }
    }
}

__device__ __forceinline__ void gla_prefix(float* UST, const float* DEC, int gid, bool dry) {
    const int bhd = gid >> 11, e = gid & 2047, k = e & 31, dir = bhd & 1;
    float* base = UST + (size_t)bhd * 36 * 2048 + e; const float* dec = DEC + (size_t)bhd * 36 * 32 + k;
    float s = 0.f;
#pragma unroll 4
    for (int ci = 0; ci < 36; ++ci) {
        const int sl = dir == 0 ? ci : (ci < 4 ? 3 - ci : 39 - ci);
        const float u = base[(size_t)sl * 2048], d = dec[sl * 32];
        if (!dry) base[(size_t)sl * 2048] = s;
        s = d * s + u;
    }
}

__device__ __forceinline__ void gla_out_item(const bf16_t* P, const float* UST, bf16_t* MIX, int item, LAS unsigned char* wl, int lane,
                                             const float* __restrict__ a_up, const float* __restrict__ a_bias, const float* __restrict__ gnorm) {
    const int nc = item % 36, hh = (item / 36) & 3, b = item / 144;
    const int row0 = gla_row0(b, nc), kk = lane & 31, hi = lane >> 5;
    gla_stage_v(P, row0, hh, wl, lane);
    f32x16 o[2][2];
#pragma unroll
    for (int a = 0; a < 2; ++a)
#pragma unroll
        for (int c = 0; c < 2; ++c)
#pragma unroll
            for (int i = 0; i < 16; ++i) o[a][c][i] = 0.f;
    unsigned qp[2][8], kp[2][8];
#pragma unroll
    for (int tt = 0; tt < 2; ++tt) {
#pragma unroll
        for (int g = 0; g < 4; ++g)
#pragma unroll
            for (int e2 = 0; e2 < 2; ++e2) { const size_t ro = (size_t)(row0 + 32 * tt + 8 * g + 4 * hi + 2 * e2) * PP + hh * 32 + kk;
                qp[tt][2 * g + e2] = (unsigned)P[ro + C_GQ] | ((unsigned)P[ro + PP + C_GQ] << 16); kp[tt][2 * g + e2] = (unsigned)P[ro + C_GK] | ((unsigned)P[ro + PP + C_GK] << 16); }
        asm volatile("" ::: "memory");
    }
    const int g16 = (lane >> 4) & 1, qq = (lane & 15) >> 2, pp = lane & 3;
    const int tri = (8 * hi + qq) * GP + (16 * g16 + 4 * pp) * 2;
    const int trv = (4 * hi + qq) * GP + (16 * g16 + 4 * pp) * 2;
#pragma unroll
    for (int dir = 0; dir < 2; ++dir) {
        GlaCum C; gla_cum(P, row0, hh, dir, a_up, a_bias, lane, C);
#pragma unroll
        for (int tt = 0; tt < 2; ++tt) {
            float cum[16];
#pragma unroll
            for (int r = 0; r < 16; ++r) cum[r] = C.cum[tt][r];
#pragma unroll
            for (int g = 0; g < 4; ++g) {
                float xq[4], xk[4];
#pragma unroll
                for (int e = 0; e < 4; ++e) { const unsigned qw = qp[tt][2 * g + (e >> 1)], kw = kp[tt][2 * g + (e >> 1)];
                    xq[e] = ((e & 1) ? bfhi(qw) : bflo(qw)) * 0.17677669529663687f * fexp(cum[4 * g + e]); xk[e] = ((e & 1) ? bfhi(kw) : bflo(kw)) * fexp(-cum[4 * g + e]); }
                v2u wq, wk; wq.x = pk2(xq[0], xq[1]); wq.y = pk2(xq[2], xq[3]); wk.x = pk2(xk[0], xk[1]); wk.y = pk2(xk[2], xk[3]);
                const int off = kk * GP + (32 * tt + 8 * g + 4 * hi) * 2;
                *(LAS v2u*)(wl + G_A + off) = wq; *(LAS v2u*)(wl + G_B + off) = wk;
            }
        }
        const float* sp = UST + ((size_t)((b * 4 + hh) * 2 + dir) * 36 + nc) * 2048;
        bf16x8 sf[2][2];
#pragma unroll
        for (int vb = 0; vb < 2; ++vb)
#pragma unroll
            for (int s = 0; s < 2; ++s) { const float* p = sp + (size_t)(32 * vb + kk) * 32 + 16 * s + 8 * hi; const f32x4 a = *(const f32x4*)p, c = *(const f32x4*)(p + 4);
                sf[vb][s] = pack8(a.x, a.y, a.z, a.w, c.x, c.y, c.z, c.w); }
#pragma unroll
        for (int it = 0; it < 2; ++it) {
            bf16x8 qf[2];
#pragma unroll
            for (int s = 0; s < 2; ++s) { LAS const unsigned char* p = wl + G_A + tri + 16 * s * GP + 64 * it; qf[s] = cat4(tr_read(p), tr_read(p + 4 * GP)); }
#pragma unroll
            for (int vb = 0; vb < 2; ++vb)
#pragma unroll
                for (int s = 0; s < 2; ++s) o[vb][it] = MFMA32(sf[vb][s], qf[s], o[vb][it]);
#pragma unroll
            for (int jt = 0; jt < 2; ++jt) {
                if (dir == 0 ? (jt > it) : (jt < it)) continue;
                f32x16 sc;
#pragma unroll
                for (int i = 0; i < 16; ++i) sc[i] = 0.f;
#pragma unroll
                for (int s = 0; s < 2; ++s) { LAS const unsigned char* p = wl + G_B + tri + 16 * s * GP + 64 * jt; const bf16x8 kf = cat4(tr_read(p), tr_read(p + 4 * GP)); sc = MFMA32(kf, qf[s], sc); }
                if (jt == it) {
#pragma unroll
                    for (int i = 0; i < 16; ++i) { const int j = crow(i, hi); const bool ok = dir == 0 ? (j <= kk) : (j >= kk); sc[i] = ok ? sc[i] : 0.f; }
                }
#pragma unroll
                for (int s2 = 0; s2 < 2; ++s2) {
                    const bf16x8 pf = pack8(sc[8 * s2 + 0], sc[8 * s2 + 1], sc[8 * s2 + 2], sc[8 * s2 + 3], sc[8 * s2 + 4], sc[8 * s2 + 5], sc[8 * s2 + 6], sc[8 * s2 + 7]);
                    LAS const unsigned char* vp = wl + G_V + trv + (32 * jt + 16 * s2) * GP;
                    const bf16x8 v0 = cat4(tr_read(vp), tr_read(vp + 8 * GP));
                    const bf16x8 v1 = cat4(tr_read(vp + 64), tr_read(vp + 8 * GP + 64));
                    o[0][it] = MFMA32(v0, pf, o[0][it]); o[1][it] = MFMA32(v1, pf, o[1][it]);
                }
                __builtin_amdgcn_sched_barrier(0);
            }
            __builtin_amdgcn_sched_barrier(0);
        }
    }
#pragma unroll
    for (int it = 0; it < 2; ++it) {
        float ss = 0.f;
#pragma unroll
        for (int vb = 0; vb < 2; ++vb)
#pragma unroll
            for (int i = 0; i < 16; ++i) ss += o[vb][it][i] * o[vb][it][i];
        ss += __shfl_xor(ss, 32);
        const float rstd = __builtin_amdgcn_rsqf(ss * (1.f / 64.f) + NEPS);
        const size_t row = (size_t)(row0 + 32 * it + kk);
#pragma unroll
        for (int vb = 0; vb < 2; ++vb)
#pragma unroll
            for (int g = 0; g < 4; ++g) { const int v = 32 * vb + 8 * g + 4 * hi;
                const f32x4 gn = *(const f32x4*)(gnorm + v); const v2u gw = *(const v2u*)(P + row * PP + C_GG + hh * 64 + v);
                const float g0 = bflo(gw.x), g1 = bfhi(gw.x), g2 = bflo(gw.y), g3 = bfhi(gw.y);
                v2u w; w.x = pk2(o[vb][it][4 * g] * rstd * gn.x * silu_f(g0), o[vb][it][4 * g + 1] * rstd * gn.y * silu_f(g1));
                w.y = pk2(o[vb][it][4 * g + 2] * rstd * gn.z * silu_f(g2), o[vb][it][4 * g + 3] * rstd * gn.w * silu_f(g3));
                *(v2u*)(MIX + row * 1024 + hh * 64 + v) = w; }
    }
}
__device__ __forceinline__ void phase_r1(const float* const* in, float* xout, unsigned char* ws, LAS unsigned char* lds, int l, bool upd, int G, int tid, int wave, int lane, bool dry) {
    const float* x0 = in[0]; const float* ctx0 = in[2]; const float* gains = in[6] + (size_t)l * 4096; const float* wr = in[14] + (size_t)l * 1024 * 16;
    const float* mod = (const float*)(ws + WS_MOD) + (size_t)l * 9 * 6144;
    const bf16_t* Y = (const bf16_t*)(ws + WS_R2 + (size_t)MT * 2048); bf16_t* H = (bf16_t*)(ws + WS_H); bf16_t* XB = (bf16_t*)(ws + WS_XB);
    float* AFF = (float*)(ws + WS_AFF); float* AFFC = (float*)(ws + WS_AFFC);
    LAS float* V = (LAS float*)lds;
    LAS float* RT = V + 6144;
    __syncthreads();
    for (int i = tid; i < 16384; i += 512) { const int d = i >> 4, e = i & 15; RT[e * 1024 + d] = wr[i]; }
    for (int t = blockIdx.x; t < 256; t += G) {
        const int b = t >> 5;
        __syncthreads();
        for (int n = tid; n < 1024; n += 512) { const float gpa = gains[1024 + n], gpf = gains[2048 + n];
            V[n] = gpa * mod[b * 6144 + 2048 + n]; V[1024 + n] = gpf * (1.f + mod[b * 6144 + 4096 + n]); V[2048 + n] = mod[b * 6144 + 3072 + n];
            V[3072 + n] = gpa * mod[8 * 6144 + 2048 + n]; V[4096 + n] = gpf * (1.f + mod[8 * 6144 + 4096 + n]); V[5120 + n] = mod[8 * 6144 + 3072 + n]; }
        __syncthreads();
        const int nrows = upd ? 9 : 8;
#pragma unroll 1
        for (int i0 = 0; i0 < 9; i0 += 3) {
            f32x4 yv[3][4], xq[3][4];
#pragma unroll
            for (int k = 0; k < 3; ++k) { const int i = i0 + k; if (i < nrows) {
                const bool isc = (i == 8); const int row = isc ? (ML + 8 * t + wave) : (64 * t + 8 * wave + i);
                ld_row_bf16(Y + (size_t)row * 1024, lane, yv[k]);
                if (l == 0) ld_row_f32(isc ? (ctx0 + (size_t)(8 * t + wave) * 1024) : (x0 + (size_t)row * 1024), lane, xq[k]); else ld_row_bf16(XB + (size_t)row * 1024, lane, xq[k]); } }
#pragma unroll
            for (int k = 0; k < 3; ++k) { const int i = i0 + k; if (i < nrows) {
            const bool isc = (i == 8);
            const int row = isc ? (ML + 8 * t + wave) : (64 * t + 8 * wave + i);
            bf16_t* xd = (dry ? (bf16_t*)(ws + WS_R1) : XB) + (size_t)row * 1024;
            LAS const float* vv = V + (isc ? 3072 : 0);
            f32x4 (&y)[4] = yv[k]; f32x4 (&xv)[4] = xq[k]; f32x4 a[4];
            const float rsy = __builtin_amdgcn_rsqf(wave_sum(sumsq16(y)) * (1.f / 1024.f) + NEPS);
            ld_vec_lds(vv, lane, a);
#pragma unroll
            for (int j = 0; j < 4; ++j) xv[j] = xv[j] + a[j] * (y[j] * rsy);
            st_row_bf16(xd, lane, xv);
            const float rs1 = __builtin_amdgcn_rsqf(wave_sum(sumsq16(xv)) * (1.f / 1024.f) + NEPS);
            f32x4 s[4]; ld_vec_lds(vv + 1024, lane, a); ld_vec_lds(vv + 2048, lane, s);
#pragma unroll
            for (int j = 0; j < 4; ++j) xv[j] = xv[j] * rs1 * a[j] + s[j];
            st_row_bf16((dry ? (bf16_t*)(ws + WS_R2) : H) + (size_t)row * 1024, lane, xv);
            float lg[16];
#pragma unroll
            for (int e = 0; e < 16; ++e) { float p = 0.f;
#pragma unroll
                for (int j = 0; j < 4; ++j) { const f32x4 w = *(LAS const f32x4*)(RT + e * 1024 + 256 * j + 4 * lane); p += (xv[j].x * w.x + xv[j].y * w.y) + (xv[j].z * w.z + xv[j].w * w.w); }
                lg[e] = p;
                if ((e & 3) == 3) asm volatile("" ::: "memory"); }
#pragma unroll
            for (int i2 = 0; i2 < 8; ++i2) { const bool up = (lane & 32) != 0; const float keep = up ? lg[i2 + 8] : lg[i2], send = up ? lg[i2] : lg[i2 + 8]; lg[i2] = keep + __shfl_xor(send, 32); }
#pragma unroll
            for (int i2 = 0; i2 < 4; ++i2) { const bool up = (lane & 16) != 0; const float keep = up ? lg[i2 + 4] : lg[i2], send = up ? lg[i2] : lg[i2 + 4]; lg[i2] = keep + __shfl_xor(send, 16); }
#pragma unroll
            for (int i2 = 0; i2 < 2; ++i2) { const bool up = (lane & 8) != 0; const float keep = up ? lg[i2 + 2] : lg[i2], send = up ? lg[i2] : lg[i2 + 2]; lg[i2] = keep + __shfl_xor(send, 8); }
            { const bool up = (lane & 4) != 0; const float keep = up ? lg[1] : lg[0], send = up ? lg[0] : lg[1]; lg[0] = keep + __shfl_xor(send, 4); }
            float lgt = lg[0]; lgt += __shfl_xor(lgt, 1); lgt += __shfl_xor(lgt, 2);
            const int ex = ((lane >> 5) & 1) * 8 + ((lane >> 4) & 1) * 4 + ((lane >> 3) & 1) * 2 + ((lane >> 2) & 1);
            float mx = lgt;
            mx = fmaxf(mx, __shfl_xor(mx, 4)); mx = fmaxf(mx, __shfl_xor(mx, 8)); mx = fmaxf(mx, __shfl_xor(mx, 16)); mx = fmaxf(mx, __shfl_xor(mx, 32));
            const float pe = fexp(lgt - mx);
            float den = pe; den += __shfl_xor(den, 4); den += __shfl_xor(den, 8); den += __shfl_xor(den, 16); den += __shfl_xor(den, 32);
            const float mine = pe / den;
            if ((lane & 3) == 0) {
                if (isc) { const int cr = 8 * t + wave; AFFC[((size_t)(cr >> 8) * 16 + ex) * 256 + (cr & 255)] = mine; }
                else AFF[((size_t)(row >> 11) * 16 + ex) * 2048 + (row & 2047)] = mine;
            }
            } }
        }
    }
}

template <bool CTX>
__device__ __forceinline__ void topk_wave(unsigned char* ws, int item, int lane) {
    constexpr int NT = CTX ? 256 : 2048, CAP = CTX ? 32 : 256, PER = NT / 64;
    const int e = item & 15, b = item >> 4;
    const float* arow = (const float*)(ws + (CTX ? WS_AFFC : WS_AFF)) + (size_t)(b * 16 + e) * NT;
    float* gate = (float*)(ws + (CTX ? WS_GATEC : WS_GATE)) + (size_t)(b * 16 + e) * CAP;
    short* INV = (short*)(ws + WS_INV);
    int* rowidx = (int*)(ws + WS_ROWIDX) + (CTX ? ((128 + e) * 256 + b * 32) : ((b * 16 + e) * 256));
    unsigned v[PER];
#pragma unroll
    for (int i = 0; i < PER / 4; ++i) { const v4u q = *(const v4u*)(arow + lane * PER + 4 * i); v[4 * i] = q.x; v[4 * i + 1] = q.y; v[4 * i + 2] = q.z; v[4 * i + 3] = q.w; }
    unsigned T = 0;
    for (int bit = 29; bit >= 0; --bit) {
        const unsigned cand = T | (1u << bit); int c = 0;
#pragma unroll
        for (int i = 0; i < PER; ++i) c += __popcll(__ballot(v[i] >= cand));
        if (c >= CAP) T = cand;
    }
    int ngt = 0, cg = 0, ce = 0;
#pragma unroll
    for (int i = 0; i < PER; ++i) { ngt += __popcll(__ballot(v[i] > T)); cg += (v[i] > T) ? 1 : 0; ce += (v[i] == T) ? 1 : 0; }
    const int need = CAP - ngt;
    int pg = cg, pe = ce;
#pragma unroll
    for (int d = 1; d < 64; d <<= 1) { const int tg = __shfl_up(pg, d), te = __shfl_up(pe, d); if (lane >= d) { pg += tg; pe += te; } }
    pg -= cg; pe -= ce;
#pragma unroll
    for (int i = 0; i < PER; ++i) {
        const bool gt = v[i] > T, eq = v[i] == T;
        const bool sel = gt || (eq && pe < need);
        const int slot = pg + (pe < need ? pe : need);
        const int tok = lane * PER + i, grow = CTX ? (ML + b * CTXL + tok) : (b * SEQ + tok);
        if (sel) { rowidx[slot] = grow; gate[slot] = __uint_as_float(v[i]); }
        INV[(size_t)grow * 16 + e] = sel ? (short)slot : (short)-1;
        pg += gt ? 1 : 0; pe += eq ? 1 : 0;
    }
}

__device__ __forceinline__ void topk_wg2(unsigned char* ws, int item, LAS unsigned char* lds, int tid, int wave, int lane) {
    constexpr int CAP = 256;
    const int e = item & 15, b = item >> 4;
    const float* arow = (const float*)(ws + WS_AFF) + (size_t)(b * 16 + e) * 2048;
    float* gate = (float*)(ws + WS_GATE) + (size_t)(b * 16 + e) * CAP;
    short* INV = (short*)(ws + WS_INV);
    int* rowidx = (int*)(ws + WS_ROWIDX) + (b * 16 + e) * 256;
    LAS int* cnt = (LAS int*)lds;
    const v4u q = *(const v4u*)(arow + 4 * tid);
    const unsigned v[4] = {q.x, q.y, q.z, q.w};
    unsigned T = 0;
    __syncthreads();
    for (int bit = 29; bit >= 0; --bit) {
        const unsigned cand = T | (1u << bit); int c = 0;
#pragma unroll
        for (int i = 0; i < 4; ++i) c += __popcll(__ballot(v[i] >= cand));
        LAS int* cb = cnt + (bit & 1) * 8;
        if (lane == 0) cb[wave] = c;
        __syncthreads();
        int tot = 0;
#pragma unroll
        for (int w = 0; w < 8; ++w) tot += cb[w];
        if (tot >= CAP) T = cand;
    }
    int cg = 0, ce = 0, wg_ = 0, we_ = 0;
#pragma unroll
    for (int i = 0; i < 4; ++i) { wg_ += __popcll(__ballot(v[i] > T)); we_ += __popcll(__ballot(v[i] == T)); cg += (v[i] > T) ? 1 : 0; ce += (v[i] == T) ? 1 : 0; }
    if (lane == 0) { cnt[16 + wave] = wg_; cnt[24 + wave] = we_; }
    int pg = cg, pe = ce;
#pragma unroll
    for (int d = 1; d < 64; d <<= 1) { const int tg = __shfl_up(pg, d), te = __shfl_up(pe, d); if (lane >= d) { pg += tg; pe += te; } }
    pg -= cg; pe -= ce;
    __syncthreads();
    int ngt = 0;
#pragma unroll
    for (int w = 0; w < 8; ++w) { const int g_ = cnt[16 + w], e_ = cnt[24 + w]; ngt += g_; if (w < wave) { pg += g_; pe += e_; } }
    const int need = CAP - ngt;
#pragma unroll
    for (int i = 0; i < 4; ++i) {
        const bool gt = v[i] > T, eq = v[i] == T;
        const bool sel = gt || (eq && pe < need);
        const int slot = pg + (pe < need ? pe : need);
        const int grow = b * SEQ + 4 * tid + i;
        if (sel) { rowidx[slot] = grow; gate[slot] = __uint_as_float(v[i]); }
        INV[(size_t)grow * 16 + e] = sel ? (short)slot : (short)-1;
        pg += gt ? 1 : 0; pe += eq ? 1 : 0;
    }
}

__device__ __forceinline__ void phase_r5(const float* const* in, float* xout, unsigned char* ws, LAS unsigned char* lds, int l, bool upd, int G, int tid, int wave, int lane, bool dry) {
    const float* gains = in[6];
    const float* mod = (const float*)(ws + WS_MOD);
    const bf16_t* YE = (const bf16_t*)(ws + WS_R1); bf16_t* H = (bf16_t*)(ws + WS_H); bf16_t* XB = (bf16_t*)(ws + WS_XB);
    const float* GATE = (const float*)(ws + WS_GATE); const float* GATEC = (const float*)(ws + WS_GATEC); const short* INV = (const short*)(ws + WS_INV);
    LAS float* V = (LAS float*)lds;
    LAS int* CL = (LAS int*)(lds + 24576);
    for (int t = blockIdx.x; t < 256; t += G) {
        const int b = t >> 5;
        __syncthreads();
        for (int n = tid; n < 1024; n += 512) { const float gpf = gains[(size_t)l * 4096 + 3072 + n];
            V[n] = gpf * mod[((size_t)l * 9 + b) * 6144 + 5120 + n]; V[3072 + n] = gpf * mod[((size_t)l * 9 + 8) * 6144 + 5120 + n];
            if (l == 0) { const float gna = gains[4096 + n];
                V[1024 + n] = gna * (1.f + mod[((size_t)9 + b) * 6144 + 1024 + n]); V[2048 + n] = mod[((size_t)9 + b) * 6144 + n];
                V[4096 + n] = gna * (1.f + mod[((size_t)9 + 8) * 6144 + 1024 + n]); V[5120 + n] = mod[((size_t)9 + 8) * 6144 + n]; } }
        if (tid < (upd ? 72 : 64)) {
            const bool isc = tid >= 64; const int cr = 8 * t + (tid - 64);
            const int row = isc ? (ML + cr) : (64 * t + tid); const int bb = isc ? (cr >> 8) : b;
            const v4u i0 = *(const v4u*)(INV + (size_t)row * 16), i1 = *(const v4u*)(INV + (size_t)row * 16 + 8);
            const unsigned iw[8] = {i0.x, i0.y, i0.z, i0.w, i1.x, i1.y, i1.z, i1.w};
            float gv[16]; int sl[16];
#pragma unroll
            for (int e = 0; e < 16; ++e) { sl[e] = (int)(short)((iw[e >> 1] >> (16 * (e & 1))) & 0xffffu); const int s0 = sl[e] < 0 ? 0 : sl[e];
                gv[e] = isc ? GATEC[(size_t)(bb * 16 + e) * 32 + s0] : GATE[(size_t)(bb * 16 + e) * 256 + s0]; }
            int cnt = 0; LAS int* cl = CL + tid * 33;
#pragma unroll
            for (int e = 0; e < 16; ++e) if (sl[e] >= 0) { cl[1 + 2 * cnt] = isc ? ((128 + e) * 256 + bb * 32 + sl[e]) : ((bb * 16 + e) * 256 + sl[e]); cl[2 + 2 * cnt] = (int)__float_as_uint(gv[e]); ++cnt; }
            cl[0] = cnt;
        }
        __syncthreads();
        const int nrows = upd ? 9 : 8;
#pragma unroll 1
        for (int i0 = 0; i0 < 9; i0 += 3) {
            f32x4 xq[3][4];
#pragma unroll
            for (int k = 0; k < 3; ++k) { const int i = i0 + k; if (i < nrows) { const bool isc = (i == 8);
                ld_row_bf16(XB + (size_t)(isc ? (ML + 8 * t + wave) : (64 * t + 8 * wave + i)) * 1024, lane, xq[k]); } }
#pragma unroll
            for (int k = 0; k < 3; ++k) { const int i = i0 + k; if (i < nrows) {
            const bool isc = (i == 8);
            const int row = isc ? (ML + 8 * t + wave) : (64 * t + 8 * wave + i);
            LAS const float* vv = V + (isc ? 3072 : 0);
            LAS const int* cl = CL + (isc ? (64 + wave) : (8 * wave + i)) * 33;
            const int n = __builtin_amdgcn_readfirstlane(cl[0]);
            f32x4 acc[4];
#pragma unroll
            for (int j = 0; j < 4; ++j) acc[j] = (f32x4){0.f, 0.f, 0.f, 0.f};
            for (int j0 = 0; j0 < n; j0 += 4) {
                v2u raw[4][4]; float g[4];
#pragma unroll
                for (int q = 0; q < 4; ++q) {
                    if (j0 + q < n) { const int yr = __builtin_amdgcn_readfirstlane(cl[1 + 2 * (j0 + q)]); g[q] = __uint_as_float((unsigned)__builtin_amdgcn_readfirstlane(cl[2 + 2 * (j0 + q)]));
                        const bf16_t* yp = YE + (size_t)yr * 1024;
#pragma unroll
                        for (int j = 0; j < 4; ++j) raw[q][j] = *(const v2u*)(yp + 256 * j + 4 * lane); }
                    else { g[q] = 0.f;
#pragma unroll
                        for (int j = 0; j < 4; ++j) raw[q][j] = (v2u){0u, 0u}; }
                }
#pragma unroll
                for (int q = 0; q < 4; ++q)
#pragma unroll
                    for (int j = 0; j < 4; ++j) acc[j] += (f32x4){bflo(raw[q][j].x), bfhi(raw[q][j].x), bflo(raw[q][j].y), bfhi(raw[q][j].y)} * g[q];
            }
            const float rsm = __builtin_amdgcn_rsqf(wave_sum(sumsq16(acc)) * (1.f / 1024.f) + NEPS);
            f32x4 (&xv)[4] = xq[k]; f32x4 a[4]; ld_vec_lds(vv, lane, a);
#pragma unroll
            for (int j = 0; j < 4; ++j) xv[j] = xv[j] + a[j] * (acc[j] * rsm);
            if (l == 0) st_row_bf16((dry ? (bf16_t*)(ws + WS_R2) : XB) + (size_t)row * 1024, lane, xv);
            else st_row_f32((dry ? (float*)(ws + WS_R2) : xout) + (size_t)row * 1024, lane, xv);
            if (l == 0 && !dry) {
                const float rs2 = __builtin_amdgcn_rsqf(wave_sum(sumsq16(xv)) * (1.f / 1024.f) + NEPS);
                f32x4 s[4]; ld_vec_lds(vv + 1024, lane, a); ld_vec_lds(vv + 2048, lane, s);
#pragma unroll
                for (int j = 0; j < 4; ++j) xv[j] = xv[j] * rs2 * a[j] + s[j];
                st_row_bf16(H + (size_t)row * 1024, lane, xv);
            }
            } }
        }
    }
}
#ifndef MK_PER_PHASE
#define MK_PER_PHASE 0
#endif
constexpr int N_PHASES = 22;
struct Args { const float* in[18]; float* out; unsigned char* ws; int ph_lo, ph_hi; };
__device__ __forceinline__ const Args* kargs_opaque() {
    auto p = __builtin_amdgcn_kernarg_segment_ptr(); asm volatile("" : "+s"(p)); return (const Args*)p; }
#define PHASE_REGS() int tid = threadIdx.x; asm volatile("" : "+v"(tid)); const int lane = tid & 63, wave = __builtin_amdgcn_readfirstlane(tid >> 6); \
    const Args* A = kargs_opaque(); unsigned char* ws = A->ws; const int G = gridDim.x, bx = blockIdx.x; \
    const int vcu = (G % 8 == 0) ? (bx % 8) * (G / 8) + bx / 8 : bx; const int gw = vcu * NWAVES + wave, NGW = G * NWAVES; \
    LAS unsigned char* wl = lds + wave * WAVE_LDS; (void)gw; (void)NGW; (void)wl; (void)lane; (void)ws
#ifndef CONV_BUDGET
#define CONV_BUDGET 1
#endif
#ifndef PH_MASK
#define PH_MASK 0xFFFFFFFFu
#endif
#define EN(j) (((PH_MASK) >> (j)) & 1u)
#ifndef REP_MASK
#define REP_MASK 0u
#endif
#define REPS(j) ((((REP_MASK) >> (j)) & 1u) ? 2 : 1)
__global__ void __launch_bounds__(NWAVES * 64, 2) fwd_kernel(Args args) {
    extern __shared__ __attribute__((aligned(16))) unsigned char lds_raw[];
    LAS unsigned char* lds = (LAS unsigned char*)lds_raw;
    volatile LAS unsigned* MISC = (volatile LAS unsigned*)(lds + MISC_OFF);
    for (int u = threadIdx.x; u < (LDS_BYTES - LDSCTL_OFF) / 4; u += NWAVES * 64) ((LAS unsigned*)(lds + LDSCTL_OFF))[u] = 0u;
    __syncthreads();
    const int lo = args.ph_lo, hi = args.ph_hi;
    XcdBarrier bar; bar.bar = (unsigned*)(args.ws + WS_CTL) + CW_BAR; bar.x = 0; bar.st = nullptr;
    if (hi - lo > 1) bar = xcd_barrier_post((unsigned*)(args.ws + WS_CTL) + CW_BAR, MISC + 8);
#define IN(k) (lo <= (k) && (k) < hi)
#ifdef STAMP_A
#define STAMP(k) do { if (blockIdx.x == 0 && threadIdx.x == 0) ((unsigned long long*)(args.ws + WS_CTL))[1536 + (k)] = __builtin_amdgcn_s_memrealtime(); } while (0)
#else
#define STAMP(k) do { } while (0)
#endif
#define SEAM(k) do { if (IN((k) + 1)) { xcd_barrier(bar); if (REPS(12) == 2) xcd_barrier(bar); } STAMP((k) + 1); } while (0)
    STAMP(0);
    if (EN(0) && IN(0)) { for (int rep = 0; rep < REPS(0); ++rep) { PHASE_REGS(); phase_p0(A->in, ws, wl, gw, NGW, lane); } SEAM(0); }
    if (EN(1) && IN(1)) { for (int rep = 0; rep < REPS(1); ++rep) { PHASE_REGS(); phase_a0(A->in, ws, lds, G, tid, wave, lane); } SEAM(1); }
    for (int l = 0; l < 2; ++l) {
        const int base = 2 + 10 * l; const bool upd = (l == 0);
        if (EN(2) && IN(base + 0)) { for (int rep = 0; rep < REPS(2); ++rep) {
            PHASE_REGS();
            pg8::Gemm g{(const bf16_t*)(ws + WS_H), (const bf16_t*)(ws + WS_WIN) + (size_t)l * PP * 1024, MT, PP, 1024}; pg8::StaticOrder S; S.init(MT, PP, G, bx);
            pg8::EpiProj E{(bf16_t*)(ws + WS_R1), PP, (const pg8::f32x2*)(ws + WS_TAB), ML};
            pg8::gemm_phase<pg8::EpiProj, pg8::StaticOrder, true, true>(lds, g, S, E);
            if (upd && CV_G1 > 0 && G == 256 && bx >= 208 && !(rep + 1 < REPS(2))) tr_stream(A->in, ws, P0_A + (bx - 208) * NWAVES + wave, 384, P0_A + CV_N1, (LAS float*)wl, lane);
            if (!CONV_IN_P0) { const int nwg_ = (MT / 256) * (PP / 256); if ((nwg_ - bx + G - 1) / G < (nwg_ + G - 1) / G) conv_pull(A->in, ws, l, 1, 12 * CONV_BUDGET, (LAS float*)wl, lane); }
            }
            SEAM(base + 0);
        }
        if (EN(3) && IN(base + 1)) { for (int rep = 0; rep < REPS(3); ++rep) {
            PHASE_REGS();
            const bf16_t* PROJ = (const bf16_t*)(ws + WS_R1); bf16_t* MIX = (bf16_t*)(ws + WS_R2);
            const float* a_up = A->in[9] + (size_t)l * 2 * 16 * 128; const float* a_bias = A->in[10] + (size_t)l * 2 * 128;
            const float* rpb = A->in[12] + (size_t)l * 4 * 465; const float* sink = A->in[13] + (size_t)l * 8;
            const int n_cn = upd ? 128 : 0, n_cs = upd ? 256 : 0;
            const bool xmap = (G == 256);
            const int xcd = bx & 7, cu = bx >> 3;
            const int n_att = xmap ? 12 : 0;
            const int tail_total = (xmap ? 0 : 1024 + 2048) + 1152 + n_cn + n_cs;
            volatile LAS unsigned* qctr = (volatile LAS unsigned*)(lds + MISC_OFF) + 16 + l * 2 + rep;
            const int n_conv = 0, n_mix = (n_conv + 2) / 3 * 4;
            for (;;) {
                int j = 0; if (lane == 0) j = (int)__hip_atomic_fetch_add((LAS unsigned*)qctr, 1u, __ATOMIC_RELAXED, __HIP_MEMORY_SCOPE_WORKGROUP);
                j = __builtin_amdgcn_readfirstlane(j);
                if (j < n_mix) {
                    if ((j & 3) != 3) { const int ci = (j >> 2) * 3 + (j & 3), r = ci * G + bx; if (ci < n_conv && r < 12288 && !(rep + 1 < REPS(3))) expert_conv_item(A->in, ws, l, r, (LAS float*)wl, lane); continue; }
                    j = j >> 2;
                } else j = j - n_mix + n_mix / 4;
                int mode, item;
                if (j < n_att) {
                    if (j < 4) { mode = 0; item = (xcd * 4 + j) * 32 + cu; }
                    else { const int jj = j - 4, group = xcd * 2 + (jj >> 2), i = cu * 4 + (jj & 3); const int bb = group >> 1, hq = (group & 1) * 4 + (i >> 5); mode = 1; item = (i & 31) + 32 * hq + 256 * bb; }
                } else {
                    int r = (j - n_att) * G + bx;
                    if (r >= tail_total) break;
                    mode = -1; item = 0;
                    if (!xmap) { if (r < 1024) { mode = 0; item = r; } else if (r < 3072) { mode = 1; item = r - 1024; } r -= 3072; }
                    if (mode < 0) {
                        if (r < 1152) { if (rep + 1 < REPS(3)) continue; gla_local_item(PROJ, (float*)(ws + WS_UST), (float*)(ws + WS_DEC), r, wl, lane, a_up, a_bias); continue; } r -= 1152;
                        if (r < n_cs) { mode = 3; item = r; } else { mode = 2; item = r - n_cs; }
                    }
                }
                attn_item(mode, PROJ, MIX, item, wl, lane, rpb, sink, rep + 1 < REPS(3));
            }
            }
            SEAM(base + 1);
        }
        if (EN(4) && IN(base + 2)) { for (int rep = 0; rep < REPS(4); ++rep) {
            PHASE_REGS();
            for (int gid = bx * (NWAVES * 64) + tid; gid < 64 * 2048; gid += G * NWAVES * 64) gla_prefix((float*)(ws + WS_UST), (const float*)(ws + WS_DEC), gid, rep + 1 < REPS(4));
            }
            SEAM(base + 2);
        }
        if (EN(5) && IN(base + 3)) { for (int rep = 0; rep < REPS(5); ++rep) {
            PHASE_REGS();
            const float* a_up = A->in[9] + (size_t)l * 2 * 16 * 128; const float* a_bias = A->in[10] + (size_t)l * 2 * 128; const float* gnorm = A->in[11] + (size_t)l * 64;
            for (int it = gw; it < 1152; it += NGW) { if (!upd && (it % 36) < 4) continue;
                gla_out_item((const bf16_t*)(ws + WS_R1), (const float*)(ws + WS_UST), (bf16_t*)(ws + WS_R2), it, wl, lane, a_up, a_bias, gnorm); }
            if (upd && G == 256 && gw >= 1152 && !(rep + 1 < REPS(5))) tr_stream(A->in, ws, TR_ALL - CONV_M3 + (gw - 1152), NGW - 1152, TR_ALL, (LAS float*)wl, lane);
            }
            SEAM(base + 3);
        }
        if (EN(6) && IN(base + 4)) { for (int rep = 0; rep < REPS(6); ++rep) {
            PHASE_REGS();
            const int M2 = upd ? MT : ML;
            pg8::Gemm g{(const bf16_t*)(ws + WS_R2), (const bf16_t*)(ws + WS_WOUT) + (size_t)l * 1024 * 1024, M2, 1024, 1024}; pg8::StaticOrder S; S.init(M2, 1024, G, bx);
            pg8::EpiStore E{(bf16_t*)(ws + WS_R2 + (size_t)MT * 2048), 1024};
            pg8::gemm_phase<pg8::EpiStore, pg8::StaticOrder, true, true>(lds, g, S, E);
            if (upd && CV_G2 > 0 && G == 256 && bx >= 32 && !(rep + 1 < REPS(6))) tr_stream(A->in, ws, P0_A + CV_N1 + (bx - 32) * NWAVES + wave, 1792, TR_L, (LAS float*)wl, lane);
            if (!CONV_IN_P0) { const int nwg_ = (M2 / 256) * 4; if ((nwg_ - bx + G - 1) / G < (nwg_ + G - 1) / G) conv_pull(A->in, ws, l, 1, 3 * CONV_BUDGET, (LAS float*)wl, lane); }
            }
            SEAM(base + 4);
        }
        if (EN(7) && IN(base + 5)) { for (int rep = 0; rep < REPS(7); ++rep) { PHASE_REGS(); phase_r1(A->in, A->out, ws, lds, l, upd, G, tid, wave, lane, rep + 1 < REPS(7)); } SEAM(base + 5); }
        if (EN(8) && IN(base + 6)) { for (int rep = 0; rep < REPS(8); ++rep) {
            PHASE_REGS();
            if (!CONV_IN_P0) conv_pull(A->in, ws, l, l, 1 << 30, (LAS float*)wl, lane);
            for (int it = bx; it < 128; it += G) topk_wg2(ws, it, lds, tid, wave, lane);
            if (upd) { const int w2 = (bx >= 128 ? bx - 128 : bx + G - 128) * NWAVES + wave; for (int it = w2; it < 128; it += NGW) topk_wave<true>(ws, it, lane); }
            }
            SEAM(base + 6);
        }
        if (EN(9) && IN(base + 7)) { for (int rep = 0; rep < REPS(9); ++rep) {
            PHASE_REGS();
            pg8::Gemm g{(const bf16_t*)(ws + WS_H), (const bf16_t*)(ws + WS_WGU) + (size_t)l * 16 * 2048 * 1024, 0, 0, 1024, (const int*)(ws + WS_ROWIDX)}; pg8::MoeOrder S; S.init(upd ? 9 : 8, 8, G, bx);
            pg8::EpiSwiGLU E{(bf16_t*)(ws + WS_R2), 1024};
            pg8::gemm_phase<pg8::EpiSwiGLU, pg8::MoeOrder, true, true, true>(lds, g, S, E);
            if (upd && CV_G3 > 0 && G == 256 && bx >= 128 && !(rep + 1 < REPS(9))) tr_stream(A->in, ws, P0_B + (bx - 128) * NWAVES + wave, 1024, P0_B + CV_N3, (LAS float*)wl, lane);
            if (!CONV_IN_P0) { const int nwg_ = 16 * (upd ? 9 : 8) * 8; if ((nwg_ - bx + G - 1) / G < (nwg_ + G - 1) / G) conv_pull(A->in, ws, l + 1, 1, 4 * CONV_BUDGET, (LAS float*)wl, lane); }
            }
            SEAM(base + 7);
        }
        if (EN(10) && IN(base + 8)) { for (int rep = 0; rep < REPS(10); ++rep) {
            PHASE_REGS();
            pg8::Gemm g{(const bf16_t*)(ws + WS_R2), (const bf16_t*)(ws + WS_WD) + (size_t)l * 16 * 1024 * 1024, 0, 0, 1024}; pg8::MoeOrder S; S.init(upd ? 9 : 8, 4, G, bx);
            pg8::EpiStore E{(bf16_t*)(ws + WS_R1), 1024};
            pg8::gemm_phase<pg8::EpiStore, pg8::MoeOrder, true, true>(lds, g, S, E);
            if (upd && CV_G4 > 0 && G == 256 && bx >= 64 && !(rep + 1 < REPS(10))) tr_stream(A->in, ws, P0_B + CV_N3 + (bx - 64) * NWAVES + wave, 1536, P0_B + CV_N3 + CV_N4, (LAS float*)wl, lane);
            if (!CONV_IN_P0) { const int nwg_ = 16 * (upd ? 9 : 8) * 4; if ((nwg_ - bx + G - 1) / G < (nwg_ + G - 1) / G) conv_pull(A->in, ws, l + 1, 1, 3 * CONV_BUDGET, (LAS float*)wl, lane); }
            }
            SEAM(base + 8);
        }
        if (EN(11) && IN(base + 9)) { for (int rep = 0; rep < REPS(11); ++rep) { PHASE_REGS(); phase_r5(A->in, A->out, ws, lds, l, upd, G, tid, wave, lane, rep + 1 < REPS(11)); } SEAM(base + 9); }
    }
#ifdef STAMP_A
    if (blockIdx.x == 0 && threadIdx.x == 0) { const unsigned long long* st_ = (const unsigned long long*)(args.ws + WS_CTL) + 1536; const float d_ = (float)(st_[STAMP_B] - st_[STAMP_A]); args.out[0] = 200.f * floorf(d_ / 200.f + 0.5f); }
#endif
#undef IN
#undef SEAM
}

extern "C" void kernel_launch(void* const* d_in, const int* in_sizes, int n_in, void* d_out, int out_size, void* d_ws, size_t ws_size, hipStream_t stream) {
    static int grid = 0;
    if (grid == 0) {
        if (n_in != 18 || out_size != ML * DM || ws_size < WS_END) { fprintf(stderr, "kernel_launch: unexpected sizes: n_in %d out %d ws %zu (need %zu)\n", n_in, out_size, ws_size, (size_t)WS_END); grid = -1; return; }
        int dev = 0, cus = 0, per_cu = 0;
        if (hipGetDevice(&dev) != hipSuccess || hipDeviceGetAttribute(&cus, hipDeviceAttributeMultiprocessorCount, dev) != hipSuccess) { grid = -1; return; }
        if (hipFuncSetAttribute((const void*)fwd_kernel, hipFuncAttributeMaxDynamicSharedMemorySize, LDS_BYTES) != hipSuccess) { fprintf(stderr, "kernel_launch: hipFuncSetAttribute failed\n"); grid = -1; return; }
        if (hipOccupancyMaxActiveBlocksPerMultiprocessor(&per_cu, (const void*)fwd_kernel, NWAVES * 64, LDS_BYTES) != hipSuccess || per_cu < 1) { fprintf(stderr, "kernel_launch: occupancy query says %d blocks per CU\n", per_cu); (void)hipGetLastError(); grid = -1; return; }
        grid = cus;
    }
    if (grid < 0) return;
    (void)hipMemsetAsync((char*)d_ws + WS_CTL, 0, CTL_ZERO_BYTES, stream);
    Args a{};
    for (int i = 0; i < 18; ++i) a.in[i] = (const float*)d_in[i];
    a.out = (float*)d_out; a.ws = (unsigned char*)d_ws;
#if MK_PER_PHASE
    for (int p = 0; p < N_PHASES; ++p) { a.ph_lo = p; a.ph_hi = p + 1; hipLaunchKernelGGL(fwd_kernel, dim3(grid), dim3(NWAVES * 64), LDS_BYTES, stream, a); }
#else
    a.ph_lo = 0; a.ph_hi = N_PHASES;
    void* kargs[] = {&a};
    hipError_t e = hipLaunchCooperativeKernel((const void*)fwd_kernel, dim3(grid), dim3(NWAVES * 64), kargs, LDS_BYTES, stream);
    if (e != hipSuccess) fprintf(stderr, "kernel_launch: cooperative launch failed: %s (grid %d)\n", hipGetErrorString(e), grid);
#endif
}
```

```cpp
#include <hip/hip_runtime.h>
#include <cstdio>
#include <cstdint>
#include <cmath>

namespace pg8 {
#define PG8_LAS __attribute__((address_space(3)))
typedef unsigned short bf16_t;
typedef short bf16x8 __attribute__((ext_vector_type(8)));
typedef float f32x4 __attribute__((ext_vector_type(4)));
typedef unsigned u32x4 __attribute__((ext_vector_type(4)));
constexpr int BM = 256, BK = 64, HALF = 128, HTB = HALF * BK * 2  , STAGE_BYTES = 8 * HTB, NXCD = 8, WGM = 8;

__host__ __device__ __forceinline__ int lds_byte(int r, int c) { const int st = (r >> 4) * 2 + (c >> 5), rr = r & 15, cc = c & 31, ob = rr * 64 + cc * 2; return st * 1024 + (ob ^ (((ob >> 9) & 1) << 5)); }
__host__ __device__ __forceinline__ void stage_rc(int b, int& R, int& C) { const int st = b / 1024, sb = b % 1024, swz = sb ^ (((sb >> 9) & 1) << 5); R = (st >> 1) * 16 + swz / 64; C = (st & 1) * 32 + (swz % 64) / 2; }
__host__ __device__ __forceinline__ int perm32(int rho) { const int n = rho >> 4, i = rho & 15; return 8 * (i >> 2) + 4 * n + (i & 3); }

struct Unit { int pm, pn, pb; };
struct Gemm { const bf16_t* A; const bf16_t* Bt; int M, N, K; const int* rowidx; };

struct StaticOrder {
    int nM, nN, nwg, G, c;
    __host__ __device__ void init(int M, int N, int G_, int c_) { nM = M / BM; nN = N / BM; nwg = nM * nN; G = G_; c = c_; }
    __host__ __device__ bool next(int i, Unit& u) const {
        const long L = (long)i * G + c; if (L >= nwg) return false;
        int wgid = (int)L; { const int q = nwg / NXCD, r = nwg % NXCD, xcd = wgid % NXCD, off = wgid / NXCD; wgid = (xcd < r ? xcd * (q + 1) : r * (q + 1) + (xcd - r) * q) + off; }
        const int nig = WGM * nN, gid = wgid / nig, fm = gid * WGM, gsz = (nM - fm) < WGM ? (nM - fm) : WGM;
        u.pm = fm + ((wgid % nig) % gsz); u.pn = (wgid % nig) / gsz; u.pb = u.pn; return true;
    }
    __device__ __forceinline__ void a_ready(const Unit&) const {}
    __device__ __forceinline__ void done(const Unit&) const {}
};

__device__ __forceinline__ unsigned cvt_pk_bf16(float lo, float hi) { unsigned r; asm volatile("v_cvt_pk_bf16_f32 %0, %1, %2" : "=v"(r) : "v"(lo), "v"(hi)); return r; }
typedef float f32x2 __attribute__((ext_vector_type(2)));
#ifndef EPI_WT
#define EPI_WT 0
#endif
__device__ __forceinline__ void st16(bf16_t* base, size_t elem_off, u32x4 w) {
#if EPI_WT
    const __amdgpu_buffer_rsrc_t r = __builtin_amdgcn_make_buffer_rsrc((void*)base, 0, 0x7fffffff, 0x00020000);
    __builtin_amdgcn_raw_buffer_store_b128(w, r, (unsigned)(elem_off * 2), 0, 16);
#else
    *(u32x4*)(base + elem_off) = w;
#endif
}
struct EpiStore {
    static constexpr bool PERM = true, AFTER_DRAIN = false;
    bf16_t* O; int ldc;
    __device__ __forceinline__ void operator()(const f32x4 (&acc)[2][2][4][2], const Unit& u, int wr, int wc, int fr, int fq) const {
        const int row0 = u.pm * BM + wr * 64 + fr, col0 = u.pn * BM + wc * 32 + 8 * fq;
#pragma unroll
        for (int ai = 0; ai < 2; ++ai)
#pragma unroll
            for (int m = 0; m < 4; ++m) { bf16_t* rowp = O + (size_t)(row0 + ai * HALF + m * 16) * ldc + col0;
#pragma unroll
                for (int bj = 0; bj < 2; ++bj) { const f32x4 v0 = acc[ai][bj][m][0], v1 = acc[ai][bj][m][1];
                    u32x4 w; w.x = cvt_pk_bf16(v0[0], v0[1]); w.y = cvt_pk_bf16(v0[2], v0[3]); w.z = cvt_pk_bf16(v1[0], v1[1]); w.w = cvt_pk_bf16(v1[2], v1[3]);
                    st16(O, (size_t)(rowp - O) + bj * HALF, w); } }
    }
};
struct EpiProj {
    static constexpr bool PERM = true, AFTER_DRAIN = false;
    bf16_t* O; int ldc; const f32x2* tab; int ml;
    __device__ __forceinline__ void operator()(const f32x4 (&acc)[2][2][4][2], const Unit& u, int wr, int wc, int fr, int fq) const {
        const int row0 = u.pm * BM + wr * 64 + fr;
        const bool latent = (u.pm * BM) < ml;
#pragma unroll
        for (int bj = 0; bj < 2; ++bj) {
            const int c0 = u.pn * BM + bj * HALF + wc * 32;
            const bool rope = latent && ((c0 >= 928 && c0 < 1056) || (c0 >= 1824 && c0 < 2336));
            const bool rowhalf = (((c0 - 32) & 63) == 0);
            const bool qscale = (c0 >= 1568 && c0 < 2336);
#pragma unroll
            for (int ai = 0; ai < 2; ++ai)
#pragma unroll
                for (int m = 0; m < 4; ++m) {
                    const int row = row0 + ai * HALF + m * 16;
                    f32x4 v0 = acc[ai][bj][m][0], v1 = acc[ai][bj][m][1];
                    if (rope) {
                        const int t = row & 2047, pos = rowhalf ? (t >> 6) : (t & 63);
                        const f32x2* tp = tab + pos * 16 + 8 * (fq & 1);
                        const float sg = (fq < 2) ? -1.f : 1.f;
#pragma unroll
                        for (int e = 0; e < 4; ++e) {
                            const float x0 = v0[e], x1 = v1[e];
                            const float p0 = __shfl_xor(x0, 32), p1 = __shfl_xor(x1, 32);
                            const f32x2 c0s = tp[e], c1s = tp[4 + e];
                            v0[e] = x0 * c0s.x + sg * p0 * c0s.y; v1[e] = x1 * c1s.x + sg * p1 * c1s.y;
                        }
                    }
                    if (qscale) { v0 = v0 * 0.18033688011112042f; v1 = v1 * 0.18033688011112042f; }
                    u32x4 w; w.x = cvt_pk_bf16(v0[0], v0[1]); w.y = cvt_pk_bf16(v0[2], v0[3]); w.z = cvt_pk_bf16(v1[0], v1[1]); w.w = cvt_pk_bf16(v1[2], v1[3]);
                    st16(O, (size_t)row * ldc + c0 + 8 * fq, w);
                }
        }
    }
};
struct EpiSwiGLU {
    static constexpr bool PERM = true, AFTER_DRAIN = false;
    bf16_t* O; int ldc;
    __device__ __forceinline__ void operator()(const f32x4 (&acc)[2][2][4][2], const Unit& u, int wr, int wc, int fr, int fq) const {
        const int row0 = u.pm * BM + wr * 64 + fr, col0 = u.pn * HALF + wc * 32 + 8 * fq;
#pragma unroll
        for (int ai = 0; ai < 2; ++ai)
#pragma unroll
            for (int m = 0; m < 4; ++m) {
                float h[8];
#pragma unroll
                for (int n = 0; n < 2; ++n)
#pragma unroll
                    for (int e = 0; e < 4; ++e) { const float g = acc[ai][0][m][n][e], up = acc[ai][1][m][n][e];
                        h[n * 4 + e] = g * __builtin_amdgcn_rcpf(1.f + __builtin_amdgcn_exp2f(-1.4426950408889634f * g)) * up; }
                u32x4 w; w.x = cvt_pk_bf16(h[0], h[1]); w.y = cvt_pk_bf16(h[2], h[3]); w.z = cvt_pk_bf16(h[4], h[5]); w.w = cvt_pk_bf16(h[6], h[7]);
                st16(O, (size_t)(row0 + ai * HALF + m * 16) * ldc + col0, w);
            }
    }
};
struct MoeOrder {
    int npe, nN, nwg, G, c;
    __host__ __device__ void init(int npe_, int nN_, int G_, int c_) { npe = npe_; nN = nN_; nwg = 16 * npe * nN; G = G_; c = c_; }
    __host__ __device__ bool next(int i, Unit& u) const {
        const long L = (long)i * G + c; if (L >= nwg) return false;
        int wgid = (int)L; { const int q = nwg / NXCD, r = nwg % NXCD, xcd = wgid % NXCD, off = wgid / NXCD; wgid = (xcd < r ? xcd * (q + 1) : r * (q + 1) + (xcd - r) * q) + off; }
        const int per = npe * nN, e = wgid / per, rem = wgid % per, j = rem / nN, pn = rem % nN;
        u.pm = (j < 8) ? (j * 16 + e) : (128 + e); u.pn = pn; u.pb = e * nN + pn; return true;
    }
    __device__ __forceinline__ void a_ready(const Unit&) const {}
    __device__ __forceinline__ void done(const Unit&) const {}
};

template <class Epi, class Sched, bool ALIGN_EPI = false, bool SP2 = false, bool GATHER = false>
__device__ __forceinline__ void gemm_phase(PG8_LAS unsigned char* lds, const Gemm g, const Sched& S, const Epi& E) {
    int tid_ = threadIdx.x; asm volatile("" : "+v"(tid_));
    const int tid = tid_, wid = __builtin_amdgcn_readfirstlane(tid >> 6), lane = tid & 63, wr = wid >> 2, wc = wid & 3, fr = lane & 15, fq = lane >> 4;
    const int K = g.K, nt = K / BK;
    static_assert(!GATHER || SP2, "GATHER is wired into the SP2 loop only");
    unsigned voffA[2], voffB[2]; int RA[2], CA[2]; unsigned vAc[2][2], vAn[2][2];
#pragma unroll
    for (int i = 0; i < 2; ++i) { int R, C; stage_rc(tid * 16 + i * 8192, R, C); const int Rb = Epi::PERM ? ((R & ~31) + perm32(R & 31)) : R; RA[i] = R; CA[i] = C;
        voffA[i] = (unsigned)(R * K + C) * 2u; voffB[i] = (unsigned)(Rb * K + C) * 2u; vAc[0][i] = vAc[1][i] = vAn[0][i] = vAn[1][i] = 0u; }
    auto load_idx = [&](int pm, unsigned (&v)[2][2]) {
#pragma unroll
        for (int h = 0; h < 2; ++h)
#pragma unroll
            for (int i = 0; i < 2; ++i) v[h][i] = (unsigned)(g.rowidx[pm * BM + h * HALF + RA[i]] * K + CA[i]) * 2u;
    };
    const size_t kstep = (size_t)(BK * 2);
    const size_t hstep = (size_t)HALF * K * 2;
    const size_t tstep = 2 * hstep;
    const unsigned ldsw = (unsigned)wid * 1024u;
    const int aoff = lds_byte(wr * 64 + fr, fq * 8), boff = lds_byte(wc * 32 + fr, fq * 8);
#define PG8_SA(b, h) (((b) * 2 + (h)) * HTB)
#define PG8_SB(b, h) ((4 + (b) * 2 + (h)) * HTB)
#define PG8_STAGE(bufoff, gbase, voff) do { _Pragma("unroll") for (int _i = 0; _i < 2; ++_i) \
        __builtin_amdgcn_global_load_lds((const unsigned*)((const char*)(gbase) + (voff)[_i]), (PG8_LAS unsigned*)(lds + (bufoff) + ldsw + _i * 8192), 16, 0, 0); } while (0)
#define PG8_STAGE_A(bufoff, gbase, h, nx) do { if constexpr (GATHER) { const unsigned v_[2] = { (nx) ? vAn[h][0] : vAc[h][0], (nx) ? vAn[h][1] : vAc[h][1] }; PG8_STAGE(bufoff, gbase, v_); } \
        else { PG8_STAGE(bufoff, (gbase) + (h) * hstep, voffA); } } while (0)
#define PG8_LDA(dst, b, h) do { _Pragma("unroll") for (int m = 0; m < 4; ++m) _Pragma("unroll") for (int k = 0; k < 2; ++k) dst[m][k] = *(const PG8_LAS bf16x8*)(lds + PG8_SA(b, h) + aoff + m * 2048 + k * 1024); } while (0)
#define PG8_LDB(dst, b, h) do { _Pragma("unroll") for (int n = 0; n < 2; ++n) _Pragma("unroll") for (int k = 0; k < 2; ++k) dst[n][k] = *(const PG8_LAS bf16x8*)(lds + PG8_SB(b, h) + boff + n * 2048 + k * 1024); } while (0)
#define PG8_MMA(ai, bj, At, Bt) do { __builtin_amdgcn_s_setprio(1); _Pragma("unroll") for (int m = 0; m < 4; ++m) _Pragma("unroll") for (int n = 0; n < 2; ++n) _Pragma("unroll") for (int k = 0; k < 2; ++k) \
        acc[ai][bj][m][n] = __builtin_amdgcn_mfma_f32_16x16x32_bf16(Bt[n][k], At[m][k], acc[ai][bj][m][n], 0, 0, 0); __builtin_amdgcn_s_setprio(0); } while (0)
#define PG8_WAIT_V(n) asm volatile("s_waitcnt vmcnt(" #n ")" ::: "memory")
#define PG8_WAIT_L(n) asm volatile("s_waitcnt lgkmcnt(" #n ")" ::: "memory")
#define PG8_BAR __builtin_amdgcn_s_barrier()
#define PG8_SCHED __builtin_amdgcn_sched_barrier(0)
    Unit cur, nxt; int ui = 0;
    if (!S.next(0, cur)) return;
    f32x4 acc[2][2][4][2];
#pragma unroll
    for (int a = 0; a < 2; ++a)
#pragma unroll
        for (int b = 0; b < 2; ++b)
#pragma unroll
            for (int m = 0; m < 4; ++m)
#pragma unroll
                for (int n = 0; n < 2; ++n) acc[a][b][m][n] = (f32x4){0.f, 0.f, 0.f, 0.f};
    bf16x8 At[4][2], B0[2][2], B1[2][2];
    const char* cA = (const char*)g.A + (GATHER ? (size_t)0 : (size_t)cur.pm * tstep); const char* cB = (const char*)g.Bt + (size_t)cur.pb * tstep;
    if constexpr (GATHER) load_idx(cur.pm, vAc);
    S.a_ready(cur);
    if constexpr (SP2) {
        PG8_STAGE(PG8_SB(0, 0), cB, voffB); PG8_STAGE(PG8_SB(0, 1), cB + hstep, voffB); PG8_STAGE_A(PG8_SA(0, 0), cA, 0, false); PG8_STAGE_A(PG8_SA(0, 1), cA, 1, false);
        if (wr == 1) PG8_BAR;
        PG8_WAIT_V(2); PG8_BAR;
        PG8_STAGE(PG8_SB(1, 0), cB + kstep, voffB); PG8_STAGE_A(PG8_SA(1, 0), cA + kstep, 0, false); PG8_STAGE(PG8_SB(1, 1), cB + hstep + kstep, voffB);
        PG8_WAIT_V(6); PG8_BAR;
    } else {
        PG8_STAGE(PG8_SB(0, 0), cB, voffB); PG8_STAGE(PG8_SA(0, 0), cA, voffA); PG8_STAGE(PG8_SB(0, 1), cB + hstep, voffB); PG8_STAGE(PG8_SA(0, 1), cA + hstep, voffA);
        if (wr == 1) PG8_BAR;
        PG8_WAIT_V(4); PG8_BAR;
        PG8_STAGE(PG8_SB(1, 0), cB + kstep, voffB); PG8_STAGE(PG8_SA(1, 0), cA + kstep, voffA); PG8_STAGE(PG8_SB(1, 1), cB + hstep + kstep, voffB);
        PG8_WAIT_V(6); PG8_BAR;
    }
    for (;;) {
        const bool has_next = S.next(ui + 1, nxt);
        if constexpr (GATHER) { if (has_next) {
#pragma unroll
            for (int h = 0; h < 2; ++h)
#pragma unroll
                for (int i = 0; i < 2; ++i) __builtin_amdgcn_global_load_lds((const unsigned*)(g.rowidx + nxt.pm * BM + h * HALF + RA[i]), (PG8_LAS unsigned*)(lds + STAGE_BYTES + (h * 2 + i) * 2048 + wid * 256), 4, 0, 0); } }
        const char* nA = (has_next && !GATHER) ? (const char*)g.A + (size_t)nxt.pm * tstep : cA; const char* nB = has_next ? (const char*)g.Bt + (size_t)nxt.pb * tstep : cB;
        for (int t = 0; t < nt; t += 2) {
            const bool last = (t == nt - 2); const bool nxu = last && has_next; (void)nxu;
            if constexpr (GATHER) { if (nxu) {
#pragma unroll
                for (int h = 0; h < 2; ++h)
#pragma unroll
                    for (int i = 0; i < 2; ++i) { const int ix = *(const PG8_LAS int*)(lds + STAGE_BYTES + (h * 2 + i) * 2048 + tid * 4); vAn[h][i] = (unsigned)(ix * K + CA[i]) * 2u; } } }
            const char* a1 = cA + (size_t)(t + 1) * kstep;
            const char* a2 = last ? nA : cA + (size_t)(t + 2) * kstep; const char* b2 = last ? nB : cB + (size_t)(t + 2) * kstep;
            const char* a3 = a2 + kstep; const char* b3 = b2 + kstep;
            if (last && has_next) S.a_ready(nxt);
            if constexpr (SP2) {
            PG8_LDB(B0, 0, 0); PG8_LDB(B1, 0, 1); PG8_SCHED; PG8_LDA(At, 0, 0); PG8_STAGE_A(PG8_SA(1, 1), a1, 1, false);
            PG8_WAIT_V(8); PG8_WAIT_L(0); PG8_BAR; PG8_MMA(0, 0, At, B0); PG8_MMA(0, 1, At, B1); PG8_BAR; PG8_SCHED;
            PG8_LDA(At, 0, 1); PG8_STAGE(PG8_SB(0, 0), b2, voffB); PG8_STAGE(PG8_SB(0, 1), b2 + hstep, voffB); PG8_STAGE_A(PG8_SA(0, 0), a2, 0, nxu);
            PG8_WAIT_V(8); PG8_WAIT_L(0); PG8_BAR; PG8_MMA(1, 0, At, B0); PG8_MMA(1, 1, At, B1); PG8_BAR; PG8_SCHED;
            PG8_LDB(B0, 1, 0); PG8_LDB(B1, 1, 1); PG8_SCHED; PG8_LDA(At, 1, 0); PG8_STAGE_A(PG8_SA(0, 1), a2, 1, nxu);
            PG8_WAIT_V(8); PG8_WAIT_L(0); PG8_BAR; PG8_MMA(0, 0, At, B0); PG8_MMA(0, 1, At, B1); PG8_BAR; PG8_SCHED;
            PG8_LDA(At, 1, 1); PG8_STAGE(PG8_SB(1, 0), b3, voffB); PG8_STAGE(PG8_SB(1, 1), b3 + hstep, voffB); PG8_STAGE_A(PG8_SA(1, 0), a3, 0, nxu);
            PG8_WAIT_V(8); PG8_WAIT_L(0); PG8_BAR; PG8_MMA(1, 0, At, B0); PG8_MMA(1, 1, At, B1); PG8_BAR; PG8_SCHED;
            } else {
            PG8_LDB(B0, 0, 0); PG8_SCHED; PG8_LDA(At, 0, 0); PG8_STAGE(PG8_SA(1, 1), a1 + hstep, voffA);
            PG8_WAIT_L(8); PG8_BAR; PG8_WAIT_L(0); PG8_MMA(0, 0, At, B0); PG8_BAR; PG8_SCHED;
            PG8_LDB(B1, 0, 1); PG8_STAGE(PG8_SB(0, 0), b2, voffB);
            PG8_BAR; PG8_WAIT_L(0); PG8_MMA(0, 1, At, B1); PG8_BAR;
            PG8_LDA(At, 0, 1); PG8_STAGE(PG8_SA(0, 0), a2, voffA);
            PG8_BAR; PG8_WAIT_L(0); PG8_MMA(1, 0, At, B0); PG8_BAR; PG8_SCHED;
            PG8_STAGE(PG8_SB(0, 1), b2 + hstep, voffB);
            PG8_WAIT_V(6); PG8_BAR; PG8_MMA(1, 1, At, B1); PG8_BAR;
            PG8_LDB(B0, 1, 0); PG8_SCHED; PG8_LDA(At, 1, 0); PG8_STAGE(PG8_SA(0, 1), a2 + hstep, voffA);
            PG8_WAIT_L(8); PG8_BAR; PG8_WAIT_L(0); PG8_MMA(0, 0, At, B0); PG8_BAR; PG8_SCHED;
            PG8_LDB(B1, 1, 1); PG8_STAGE(PG8_SB(1, 0), b3, voffB);
            PG8_BAR; PG8_WAIT_L(0); PG8_MMA(0, 1, At, B1); PG8_BAR;
            PG8_LDA(At, 1, 1); PG8_STAGE(PG8_SA(1, 0), a3, voffA);
            PG8_BAR; PG8_WAIT_L(0); PG8_MMA(1, 0, At, B0); PG8_BAR; PG8_SCHED;
            PG8_STAGE(PG8_SB(1, 1), b3 + hstep, voffB);
            PG8_WAIT_V(6); PG8_BAR; PG8_MMA(1, 1, At, B1); PG8_BAR;
            }
        }
        if constexpr (ALIGN_EPI) { if (wr == 0) PG8_BAR; }
        if constexpr (!Epi::AFTER_DRAIN) { E(acc, cur, wr, wc, fr, fq); S.done(cur); }
        if (!has_next) break;
#pragma unroll
        for (int a = 0; a < 2; ++a)
#pragma unroll
            for (int b = 0; b < 2; ++b)
#pragma unroll
                for (int m = 0; m < 4; ++m)
#pragma unroll
                    for (int n = 0; n < 2; ++n) acc[a][b][m][n] = (f32x4){0.f, 0.f, 0.f, 0.f};
        cur = nxt; cA = nA; cB = nB; ++ui;
        if constexpr (GATHER) {
#pragma unroll
            for (int h = 0; h < 2; ++h) { vAc[h][0] = vAn[h][0]; vAc[h][1] = vAn[h][1]; } }
        if constexpr (ALIGN_EPI) { if (wr == 1) PG8_BAR; }
    }
    PG8_WAIT_V(0);
    if constexpr (!ALIGN_EPI) { if (wr == 0) PG8_BAR; }
    PG8_BAR;
    if constexpr (Epi::AFTER_DRAIN) { E.fused(acc, cur, wr, wc, fr, fq, lds, wid, lane); S.done(cur); }
#undef PG8_SA
#undef PG8_SB
#undef PG8_STAGE
#undef PG8_STAGE_A
#undef PG8_LDA
#undef PG8_LDB
#undef PG8_MMA
#undef PG8_WAIT_V
#undef PG8_WAIT_L
#undef PG8_BAR
#undef PG8_SCHED
}
}
constexpr int NB = 8, SEQ = 2048, DM = 1024, CTXL = 256, ML = NB * SEQ, MC = NB * CTXL, MT = ML + MC;
constexpr int PP = 2560;
constexpr int INW = 2336;
constexpr int C_GK = 0, C_GV = 128, C_GAF = 384, C_GAB = 400, C_NK = 416, C_NV = 672, C_SK = 928, C_SV = 1056, C_GQ = 1184, C_GG = 1312, C_NQ = 1568, C_SQ = 1824;
constexpr int NWAVES = 8;
constexpr float NEPS = 1e-6f;
constexpr float LOG2E = 1.4426950408889634f;

constexpr size_t MiB = 1u << 20;
constexpr size_t WS_CTL = 0, CTL_ZERO_BYTES = 65536;
constexpr size_t WS_TAB = 1 * MiB;
constexpr size_t WS_MOD = 1 * MiB + 65536;
constexpr size_t WS_MODP = 2 * MiB;
constexpr size_t WS_WIN = 6 * MiB;
constexpr size_t WS_WOUT = 16 * MiB;
constexpr size_t WS_WGU = 20 * MiB;
constexpr size_t WS_WD = 148 * MiB;
constexpr size_t WS_H = 212 * MiB;
constexpr size_t WS_R1 = 248 * MiB;
constexpr size_t WS_R2 = 338 * MiB;
constexpr size_t WS_XB = 410 * MiB;
constexpr size_t WS_UST = 446 * MiB;
constexpr size_t WS_MISC = 464 * MiB;
constexpr size_t WS_DEC = WS_MISC;
constexpr size_t WS_AFF = WS_MISC + 1 * MiB;
constexpr size_t WS_AFFC = WS_MISC + 2 * MiB;
constexpr size_t WS_GATE = WS_MISC + 2 * MiB + 262144;
constexpr size_t WS_GATEC = WS_MISC + 2 * MiB + 524288;
constexpr size_t WS_INV = WS_MISC + 3 * MiB;
constexpr size_t WS_ROWIDX = WS_MISC + 3 * MiB + 786432;
constexpr size_t WS_END = 468 * MiB;
constexpr int CW_BAR = 4096;
constexpr int CW_QUEUE = 1024;
constexpr int CW_CONV = 2048;

constexpr int WAVE_LDS = 19456;
constexpr int RING_BYTES = NWAVES * WAVE_LDS;
constexpr int LDSCTL_OFF = RING_BYTES, MISC_OFF = LDSCTL_OFF + 320;
constexpr int LDS_BYTES = RING_BYTES + 1024;
static_assert(RING_BYTES >= pg8::STAGE_BYTES && LDS_BYTES <= 163840, "LDS map");

#define GAS __attribute__((address_space(1)))
#define LAS __attribute__((address_space(3)))
typedef unsigned short bf16_t;
typedef unsigned v4u __attribute__((ext_vector_type(4)));
typedef unsigned v2u __attribute__((ext_vector_type(2)));
typedef float f32x4 __attribute__((ext_vector_type(4)));
typedef float f32x2 __attribute__((ext_vector_type(2)));
typedef float f32x16 __attribute__((ext_vector_type(16)));
typedef short bf16x8 __attribute__((ext_vector_type(8)));
typedef short s16x4 __attribute__((ext_vector_type(4)));
typedef GAS unsigned gu32;
#define RLX_AGENT __ATOMIC_RELAXED, __HIP_MEMORY_SCOPE_AGENT
typedef __bf16 bf16x2_t __attribute__((ext_vector_type(2)));
__device__ __forceinline__ unsigned pk2(float lo, float hi) { f32x2 v = {lo, hi}; bf16x2_t b = __builtin_convertvector(v, bf16x2_t); return __builtin_bit_cast(unsigned, b); }
__device__ __forceinline__ float bflo(unsigned w) { return __uint_as_float(w << 16); }
__device__ __forceinline__ float bfhi(unsigned w) { return __uint_as_float(w & 0xffff0000u); }
__device__ __forceinline__ float bf1(bf16_t w) { return __uint_as_float((unsigned)w << 16); }
__device__ __forceinline__ float wave_sum(float v) {
#pragma unroll
    for (int o = 1; o < 64; o <<= 1) v += __shfl_xor(v, o);
    return v;
}
__device__ __forceinline__ float fexp2(float x) { return __builtin_amdgcn_exp2f(x); }
__device__ __forceinline__ float fexp(float x) { return __builtin_amdgcn_exp2f(x * LOG2E); }
__device__ __forceinline__ float flog(float x) { return __builtin_amdgcn_logf(x) * 0.6931471805599453f; }
__device__ __forceinline__ float frcp(float x) { return __builtin_amdgcn_rcpf(x); }
__device__ __forceinline__ float silu_f(float x) { return x * frcp(1.f + fexp(-x)); }
__device__ __forceinline__ int crow(int r, int hi) { return (r & 3) + 8 * (r >> 2) + 4 * hi; }
__device__ __forceinline__ s16x4 tr_read(LAS const unsigned char* p) { return __builtin_bit_cast(s16x4, __builtin_amdgcn_ds_read_tr16_b64_v4i16((LAS s16x4*)p)); }
__device__ __forceinline__ bf16x8 cat4(s16x4 a, s16x4 b) { return (bf16x8){a[0], a[1], a[2], a[3], b[0], b[1], b[2], b[3]}; }
__device__ __forceinline__ bf16x8 pack8(float a0, float a1, float a2, float a3, float a4, float a5, float a6, float a7) {
    v4u w; w.x = pk2(a0, a1); w.y = pk2(a2, a3); w.z = pk2(a4, a5); w.w = pk2(a6, a7); return __builtin_bit_cast(bf16x8, w); }
#define MFMA32(a, b, c) __builtin_amdgcn_mfma_f32_32x32x16_bf16((a), (b), (c), 0, 0, 0)

#ifndef EARLY_WB
#define EARLY_WB 0
#endif
#define XB_TMO      128
#define XB_XCNT(j)  (256  + 64 * (j))
#define XB_XSUB(j)  (1280 + 64 * (j))
#define XB_XGEN(j)  (2304 + 64 * (j))
#define XB_TOP      3328
#define XB_TOPGEN   3392
#define XCD_BAR_WORDS 3456
#define XB_SPIN_CAP (1u << 18)

__device__ __forceinline__ unsigned xb_ld(unsigned* p)              { return __hip_atomic_load(p, __ATOMIC_RELAXED, __HIP_MEMORY_SCOPE_AGENT); }
__device__ __forceinline__ unsigned xb_add(unsigned* p, unsigned v) { return __hip_atomic_fetch_add(p, v, __ATOMIC_RELAXED, __HIP_MEMORY_SCOPE_AGENT); }
__device__ __forceinline__ unsigned xb_xcc_id() { return (unsigned)__builtin_amdgcn_s_getreg((3 << 11) | 20) & 0xFu; }
#define XB_SPIN(cond, bar) do { unsigned _sp = 0; while (cond) { __builtin_amdgcn_s_sleep(1); \
    if ((++_sp & 255u) == 0u) { if (xb_ld(&(bar)[XB_TMO])) break; if (_sp > XB_SPIN_CAP) { atomicAdd(&(bar)[XB_TMO], 1u); break; } } } } while (0)

struct XcdBarrier {
    unsigned* bar; unsigned x;
    volatile LAS unsigned* st;
};

__device__ __forceinline__ XcdBarrier xcd_barrier_post(unsigned* bar, volatile LAS unsigned* st) {
    XcdBarrier b; b.bar = bar; b.x = xb_xcc_id(); b.st = st;
    if (threadIdx.x == 0) (void)xb_add(&bar[XB_XCNT(b.x)], 1u);
    return b;
}
__device__ __forceinline__ void xcd_barrier_complete(unsigned* bar, unsigned x, unsigned& nloc, unsigned& nx) {
    const unsigned G = gridDim.x * gridDim.y * gridDim.z;
    unsigned sum, cnt, mine, sp = 0u;
    for (;;) {
        sum = 0u; cnt = 0u; mine = 0u;
#pragma unroll
        for (unsigned j = 0; j < 16; ++j) { const unsigned c = xb_ld(&bar[XB_XCNT(j)]); sum += c; cnt += (c > 0u) ? 1u : 0u; mine = (j == x) ? c : mine; }
        if (sum == G) break;
        __builtin_amdgcn_s_sleep(1);
        if ((++sp & 255u) == 0u) { if (xb_ld(&bar[XB_TMO])) break; if (sp > XB_SPIN_CAP) { atomicAdd(&bar[XB_TMO], 1u); break; } }
    }
    nloc = mine > 0u ? mine : 1u; nx = cnt > 0u ? cnt : 1u;
}

__device__ __forceinline__ void xcd_barrier(const XcdBarrier& b) {
    asm volatile("s_waitcnt vmcnt(0)" ::: "memory");
    __syncthreads();
    if (threadIdx.x == 0) {
        unsigned* bar = b.bar;
        __builtin_amdgcn_s_waitcnt(0);
        unsigned nloc = b.st[0], nx = b.st[1];
        if (nloc == 0u) { xcd_barrier_complete(bar, b.x, nloc, nx); b.st[0] = nloc; b.st[1] = nx; }
#if EARLY_WB
        __builtin_amdgcn_fence(__ATOMIC_RELEASE, "agent");
        asm volatile("s_waitcnt vmcnt(0)" ::: "memory");
#endif
        const unsigned old = xb_add(&bar[XB_XSUB(b.x)], 1u);
        const unsigned gen = old / nloc;
        if (old + 1u == (gen + 1u) * nloc) {
            __builtin_amdgcn_fence(__ATOMIC_RELEASE, "agent");
            asm volatile("s_waitcnt vmcnt(0)" ::: "memory");
            const unsigned og = xb_add(&bar[XB_TOP], 1u);
            const unsigned tg = og / nx;
            if (og + 1u == (tg + 1u) * nx) xb_add(&bar[XB_TOPGEN], 1u);
            else XB_SPIN(xb_ld(&bar[XB_TOPGEN]) == tg, bar);
            __builtin_amdgcn_fence(__ATOMIC_ACQUIRE, "agent");
            xb_add(&bar[XB_XGEN(b.x)], 1u);
            asm volatile("s_waitcnt vmcnt(0)" ::: "memory");
        } else {
            XB_SPIN(xb_ld(&bar[XB_XGEN(b.x)]) == gen, bar);
            __builtin_amdgcn_fence(__ATOMIC_ACQUIRE, "agent");
            asm volatile("s_waitcnt vmcnt(0)" ::: "memory");
        }
    }
    __syncthreads();
}
__device__ __forceinline__ void ld_row_f32(const float* p, int lane, f32x4 (&v)[4]) {
#pragma unroll
    for (int j = 0; j < 4; ++j) v[j] = *(const f32x4*)(p + 256 * j + 4 * lane);
}
__device__ __forceinline__ void st_row_f32(float* p, int lane, const f32x4 (&v)[4]) {
#pragma unroll
    for (int j = 0; j < 4; ++j) *(f32x4*)(p + 256 * j + 4 * lane) = v[j];
}
__device__ __forceinline__ void ld_row_bf16(const bf16_t* p, int lane, f32x4 (&v)[4]) {
#pragma unroll
    for (int j = 0; j < 4; ++j) { const v2u w = *(const v2u*)(p + 256 * j + 4 * lane); v[j] = (f32x4){bflo(w.x), bfhi(w.x), bflo(w.y), bfhi(w.y)}; }
}
__device__ __forceinline__ void st_row_bf16(bf16_t* p, int lane, const f32x4 (&v)[4]) {
#pragma unroll
    for (int j = 0; j < 4; ++j) { v2u w; w.x = pk2(v[j].x, v[j].y); w.y = pk2(v[j].z, v[j].w); *(v2u*)(p + 256 * j + 4 * lane) = w; }
}
__device__ __forceinline__ void ld_vec_lds(LAS const float* p, int lane, f32x4 (&v)[4]) {
#pragma unroll
    for (int j = 0; j < 4; ++j) v[j] = *(LAS const f32x4*)(p + 256 * j + 4 * lane);
}
__device__ __forceinline__ float sumsq16(const f32x4 (&v)[4]) {
    float s = 0.f;
#pragma unroll
    for (int j = 0; j < 4; ++j) s += (v[j].x * v[j].x + v[j].y * v[j].y) + (v[j].z * v[j].z + v[j].w * v[j].w);
    return s;
}
__device__ __forceinline__ float modfin(const float* modp, const float* bmod, int l, int r, int n) {
    float s = bmod[l * 6144 + n];
#pragma unroll
    for (int kc = 0; kc < 8; ++kc) s += modp[((size_t)(l * 8 + kc) * 9 + r) * 6144 + n];
    return s;
}

#ifndef CV_G1
#define CV_G1 4
#endif
#ifndef CV_G2
#define CV_G2 6
#endif
#ifndef CV_G3
#define CV_G3 4
#endif
#ifndef CV_G4
#define CV_G4 4
#endif
#ifndef CONV_M3
#define CONV_M3 2944
#endif
#ifndef CONV_IN_P0
#define CONV_IN_P0 1
#endif
__device__ __forceinline__ void tr_item64(const float* W, int N, int Nvalid, bf16_t* WT, int Kd, int k0, int n0, int dst_row0, LAS float* scr, int lane) {
    const int q = lane & 15, kr = lane >> 4;
    f32x4 t[16];
#pragma unroll
    for (int i = 0; i < 16; ++i) { const int kk = 4 * i + kr; const int n = n0 + 4 * q;
        t[i] = (n < Nvalid) ? *(const f32x4*)(W + (size_t)(k0 + kk) * N + n) : (f32x4){0.f, 0.f, 0.f, 0.f}; }
#pragma unroll
    for (int i = 0; i < 16; ++i) { const int kk = 4 * i + kr; LAS float* d = scr + kk * 65 + 4 * q; d[0] = t[i].x; d[1] = t[i].y; d[2] = t[i].z; d[3] = t[i].w; }
    const int c = lane & 7, nl = lane >> 3;
#pragma unroll
    for (int j = 0; j < 8; ++j) { const int n = nl + 8 * j; LAS const float* s = scr + (8 * c) * 65 + n;
        v4u o; o.x = pk2(s[0 * 65], s[1 * 65]); o.y = pk2(s[2 * 65], s[3 * 65]); o.z = pk2(s[4 * 65], s[5 * 65]); o.w = pk2(s[6 * 65], s[7 * 65]);
        *(v4u*)(WT + (size_t)(dst_row0 + n) * Kd + k0 + 8 * c) = o; }
}
__device__ __forceinline__ void expert_conv_item(const float* const* in, unsigned char* ws, int l, int r, LAS float* scr, int lane) {
    const float* w_gate = in[15]; const float* w_up = in[16]; const float* w_down = in[17];
    const int which = r >> 12; r &= 4095;
    const int e = r >> 8, kb = (r & 255) >> 4, nb = r & 15, n0 = 64 * nb;
    const size_t eoff = (size_t)(l * 16 + e) * 1024 * 1024;
    if (which == 0) tr_item64(w_gate + eoff, 1024, 1024, (bf16_t*)(ws + WS_WGU) + 2 * eoff, 1024, 64 * kb, n0, (n0 >> 7) * 256 + (n0 & 127), scr, lane);
    else if (which == 1) tr_item64(w_up + eoff, 1024, 1024, (bf16_t*)(ws + WS_WGU) + 2 * eoff, 1024, 64 * kb, n0, (n0 >> 7) * 256 + 128 + (n0 & 127), scr, lane);
    else tr_item64(w_down + eoff, 1024, 1024, (bf16_t*)(ws + WS_WD) + eoff, 1024, 64 * kb, n0, n0, scr, lane);
}
__device__ __forceinline__ void conv_pull(const float* const* in, unsigned char* ws, int l_lo, int l_hi, int budget, LAS float* scr, int lane) {
    for (int l = l_lo; l <= l_hi && l < 2; ++l) {
        unsigned* ctr = (unsigned*)(ws + WS_CTL) + CW_CONV + 64 * l;
        while (budget > 0) {
            const int c = budget < 8 ? budget : 8;
            unsigned r = 0; if (lane == 0) r = __hip_atomic_fetch_add(ctr, (unsigned)c, __ATOMIC_RELAXED, __HIP_MEMORY_SCOPE_AGENT);
            r = (unsigned)__builtin_amdgcn_readfirstlane((int)r);
            if (r >= 12288u) break;
            for (int k = 0; k < c && (int)r + k < 12288; ++k) expert_conv_item(in, ws, l, (int)r + k, scr, lane);
            budget -= c;
        }
    }
}
struct TrDesc { const float* src; bf16_t* dst; int N, Nvalid, k0, n0, drow; };
constexpr int TR_IN = 16 * 40, TR_OUT = 16 * 16, TR_E = 16 * 16 * 16, TR_L = TR_IN + TR_OUT + 3 * TR_E, TR_ALL = 2 * TR_L;
constexpr int CV_N1 = CV_G1 * 384, CV_N2 = CV_G2 * 1792, CV_N3 = CV_G3 * 1024, CV_N4 = CV_G4 * 1536;
constexpr int P0_A = TR_L - CV_N1 - CV_N2;
constexpr int P0_B = TR_ALL - CONV_M3 - CV_N3 - CV_N4;
static_assert(P0_A >= 896 && P0_B >= TR_L, "tail conversion budgets exceed the expert tiles");
__device__ __forceinline__ void tr_desc(const float* const* in, unsigned char* ws, int r, TrDesc& d) {
    const int l = r / TR_L; r -= l * TR_L;
    if (r < TR_IN) { const int kb = r / 40, nb = r % 40; d.src = in[7] + (size_t)l * 1024 * INW; d.dst = (bf16_t*)(ws + WS_WIN) + (size_t)l * PP * 1024; d.N = INW; d.Nvalid = INW; d.k0 = 64 * kb; d.n0 = 64 * nb; d.drow = 64 * nb; return; }
    r -= TR_IN;
    if (r < TR_OUT) { const int kb = r / 16, nb = r % 16; d.src = in[8] + (size_t)l * 1024 * 1024; d.dst = (bf16_t*)(ws + WS_WOUT) + (size_t)l * 1024 * 1024; d.N = 1024; d.Nvalid = 1024; d.k0 = 64 * kb; d.n0 = 64 * nb; d.drow = 64 * nb; return; }
    r -= TR_OUT;
    const int which = r >> 12; r &= 4095;
    const int e = r >> 8, kb = (r & 255) >> 4, nb = r & 15, n0 = 64 * nb;
    const size_t eoff = (size_t)(l * 16 + e) * 1024 * 1024;
    d.N = 1024; d.Nvalid = 1024; d.k0 = 64 * kb; d.n0 = n0;
    if (which == 0) { d.src = in[15] + eoff; d.dst = (bf16_t*)(ws + WS_WGU) + 2 * eoff; d.drow = (n0 >> 7) * 256 + (n0 & 127); }
    else if (which == 1) { d.src = in[16] + eoff; d.dst = (bf16_t*)(ws + WS_WGU) + 2 * eoff; d.drow = (n0 >> 7) * 256 + 128 + (n0 & 127); }
    else { d.src = in[17] + eoff; d.dst = (bf16_t*)(ws + WS_WD) + eoff; d.drow = n0; }
}
__device__ __forceinline__ void tr_load(const TrDesc& d, int lane, f32x4 (&t)[16]) {
    const int q = lane & 15, kr = lane >> 4, n = d.n0 + 4 * q;
    const float* p = d.src + (size_t)(d.k0 + kr) * d.N + (n < d.Nvalid ? n : 0);
#pragma unroll
    for (int i = 0; i < 16; ++i) t[i] = *(const f32x4*)(p + (size_t)(4 * i) * d.N);
}
__device__ __forceinline__ void tr_finish(const TrDesc& d, f32x4 (&t)[16], LAS float* scr, int lane) {
    const int q = lane & 15, kr = lane >> 4; const bool valid = (d.n0 + 4 * q) < d.Nvalid;
#pragma unroll
    for (int i = 0; i < 16; ++i) { const int kk = 4 * i + kr; LAS float* s = scr + kk * 65 + 4 * q; const f32x4 v = valid ? t[i] : (f32x4){0.f, 0.f, 0.f, 0.f}; s[0] = v.x; s[1] = v.y; s[2] = v.z; s[3] = v.w; }
    const int c = lane & 7, nl = lane >> 3;
#pragma unroll
    for (int j = 0; j < 8; ++j) { const int n = nl + 8 * j; LAS const float* s = scr + (8 * c) * 65 + n;
        v4u o; o.x = pk2(s[0 * 65], s[1 * 65]); o.y = pk2(s[2 * 65], s[3 * 65]); o.z = pk2(s[4 * 65], s[5 * 65]); o.w = pk2(s[6 * 65], s[7 * 65]);
        *(v4u*)(d.dst + (size_t)(d.drow + n) * 1024 + d.k0 + 8 * c) = o; }
}
__device__ __forceinline__ void tr_stream(const float* const* in, unsigned char* ws, int first, int stride, int hi, LAS float* scr, int lane, int cut = 1 << 30, int jump = 0) {
#define TR_ID(x) ((x) < cut ? (x) : (x) + jump)
    if (first >= hi) return;
    const int n_my = (hi - first + stride - 1) / stride;
    TrDesc dA, dB; f32x4 tA[16], tB[16];
    tr_desc(in, ws, TR_ID(first), dA); tr_load(dA, lane, tA);
    for (int i = 0; i < n_my; i += 2) {
        { const int nx = i + 1 < n_my ? i + 1 : n_my - 1; tr_desc(in, ws, TR_ID(first + nx * stride), dB); tr_load(dB, lane, tB); }
        tr_finish(dA, tA, scr, lane);
        if (i + 1 >= n_my) break;
        { const int nx = i + 2 < n_my ? i + 2 : n_my - 1; tr_desc(in, ws, TR_ID(first + nx * stride), dA); tr_load(dA, lane, tA); }
        tr_finish(dB, tB, scr, lane);
    }
#undef TR_ID
}
__device__ __forceinline__ void phase_p0(const float* const* in, unsigned char* ws, LAS unsigned char* wl, int gw, int NGW, int lane) {
    const float* cvec = in[1]; const float* cctx = in[3]; const float* wmod = in[4];
    const float* w_in = in[7]; const float* w_out = in[8];
    float* modp = (float*)(ws + WS_MODP);
    constexpr int NI_MOD = 2 * 8 * 24, NI_ROPE = 16;
    constexpr int NI_IN = 16 * 40, NI_OUT = 16 * 16, NI_E = 16 * 16 * 16;
    constexpr int NI_L = NI_IN + NI_OUT + (CONV_IN_P0 ? 3 * NI_E : 0);
    constexpr int NITEMS = NI_MOD + NI_ROPE + 2 * NI_L;
    LAS float* scr = (LAS float*)wl;
    for (int it = gw; it < NI_MOD + NI_ROPE; it += NGW) {
        int r = it;
        if (r < NI_MOD) {
            const int cb = r % 24, kc = (r / 24) & 7, l = r / 192;
            for (int idx = lane; idx < 128 * 9; idx += 64) { const int rr = idx / 128, k = idx % 128; const float cv = (rr < 8) ? cvec[rr * 1024 + kc * 128 + k] : cctx[kc * 128 + k]; scr[k * 12 + rr] = silu_f(cv); }
            f32x4 acc[9];
#pragma unroll
            for (int rr = 0; rr < 9; ++rr) acc[rr] = (f32x4){0.f, 0.f, 0.f, 0.f};
            const float* wp = wmod + ((size_t)l * 1024 + kc * 128) * 6144 + cb * 256 + 4 * lane;
#pragma unroll 4
            for (int k = 0; k < 128; ++k) { const f32x4 w = *(const f32x4*)(wp + (size_t)k * 6144);
                const f32x4 s0 = *(LAS const f32x4*)(scr + k * 12), s1 = *(LAS const f32x4*)(scr + k * 12 + 4); const float s8 = scr[k * 12 + 8];
                acc[0] += w * s0.x; acc[1] += w * s0.y; acc[2] += w * s0.z; acc[3] += w * s0.w; acc[4] += w * s1.x; acc[5] += w * s1.y; acc[6] += w * s1.z; acc[7] += w * s1.w; acc[8] += w * s8; }
#pragma unroll
            for (int rr = 0; rr < 9; ++rr) *(f32x4*)(modp + ((size_t)(l * 8 + kc) * 9 + rr) * 6144 + cb * 256 + 4 * lane) = acc[rr];
            continue;
        }
        r -= NI_MOD;
        if (r < NI_ROPE) {
            const int id = r * 64 + lane, pos = id >> 4, i = id & 15;
            const float fr = fexp2(-(float)i * (13.287712379549449f / 16.f));
            float rev = (float)pos * fr * 0.15915494309189535f; rev -= floorf(rev);
            f32x2 cs; cs.x = __builtin_amdgcn_cosf(rev); cs.y = __builtin_amdgcn_sinf(rev);
            ((f32x2*)(ws + WS_TAB))[id] = cs;
            continue;
        }
        break;
    }
    if (NGW == 2048) tr_stream(in, ws, (gw + NGW - (NI_MOD + NI_ROPE)) % NGW, NGW, P0_A + (P0_B - TR_L), scr, lane, P0_A, TR_L - P0_A);
    else tr_stream(in, ws, gw, NGW, TR_ALL, scr, lane);
}

__device__ __forceinline__ void phase_a0(const float* const* in, unsigned char* ws, LAS unsigned char* lds, int G, int tid, int wave, int lane) {
    const float* x = in[0]; const float* ctx = in[2]; const float* bmod = in[5]; const float* gains = in[6];
    const float* modp = (const float*)(ws + WS_MODP); float* mod = (float*)(ws + WS_MOD); bf16_t* H = (bf16_t*)(ws + WS_H);
    LAS float* V = (LAS float*)lds;
    for (int row = blockIdx.x; row < 18; row += G) { const int l = row / 9, r = row % 9;
        for (int n = tid; n < 6144; n += 512) mod[(size_t)row * 6144 + n] = modfin(modp, bmod, l, r, n); }
    for (int t = blockIdx.x; t < 256; t += G) {
        const int b = t >> 5;
        __syncthreads();
        for (int n = tid; n < 1024; n += 512) { const float g = gains[n];
            V[n] = g * (1.f + modfin(modp, bmod, 0, b, 1024 + n)); V[1024 + n] = modfin(modp, bmod, 0, b, n);
            V[2048 + n] = g * (1.f + modfin(modp, bmod, 0, 8, 1024 + n)); V[3072 + n] = modfin(modp, bmod, 0, 8, n); }
        __syncthreads();
#pragma unroll 1
        for (int i0 = 0; i0 < 9; i0 += 3) {
            f32x4 xq[3][4];
#pragma unroll
            for (int k = 0; k < 3; ++k) { const int i = i0 + k; const bool isc = (i == 8);
                const float* src = isc ? (ctx + (size_t)(8 * t + wave) * 1024) : (x + (size_t)(64 * t + 8 * wave + i) * 1024); ld_row_f32(src, lane, xq[k]); }
#pragma unroll
            for (int k = 0; k < 3; ++k) { const int i = i0 + k; const bool isc = (i == 8);
                const int row = isc ? (ML + 8 * t + wave) : (64 * t + 8 * wave + i);
                f32x4 (&v)[4] = xq[k]; f32x4 a[4], s[4];
                const float rstd = __builtin_amdgcn_rsqf(wave_sum(sumsq16(v)) * (1.f / 1024.f) + NEPS);
                ld_vec_lds(V + (isc ? 2048 : 0), lane, a); ld_vec_lds(V + (isc ? 3072 : 1024), lane, s);
#pragma unroll
                for (int j = 0; j < 4; ++j) v[j] = v[j] * rstd * a[j] + s[j];
                st_row_bf16(H + (size_t)row * 1024, lane, v);
            }
        }
    }
}
constexpr int VP = 192;
struct AttnTile { f32x16 o0, o1; float m, lsum; };
__device__ __forceinline__ void attn_softmax(f32x16& s, AttnTile& T) {
    float bm = fmaxf(fmaxf(s[0], s[1]), fmaxf(s[2], s[3]));
#pragma unroll
    for (int i = 4; i < 16; i += 4) bm = fmaxf(bm, fmaxf(fmaxf(s[i], s[i + 1]), fmaxf(s[i + 2], s[i + 3])));
    bm = fmaxf(bm, __shfl_xor(bm, 32));
    const float mo = T.m, mn = fmaxf(mo, bm);
    T.m = mn;
    float ps = 0.f;
#pragma unroll
    for (int i = 0; i < 16; ++i) { s[i] = fexp2(s[i] - mn); ps += s[i]; }
    if (__any(mn != mo)) {
        const float alpha = fexp2(mo - mn);
        T.lsum *= alpha;
#pragma unroll
        for (int i = 0; i < 16; ++i) { T.o0[i] *= alpha; T.o1[i] *= alpha; }
    }
    T.lsum += ps;
}
__device__ __forceinline__ void attn_item(const int MODE, const bf16_t* P, bf16_t* MIX, int item, LAS unsigned char* wl, int lane,
                                          const float* __restrict__ rpb, const float* __restrict__ sink, const bool dry = false) {
    asm volatile("" : "+v"(lane));
    const int ql = lane & 31, hi = lane >> 5;
    int b, hq, qcol, kcol, vcol, ocol, qrow0, r = 0, rs = 0, q64 = 0, nloc, kb_lo = 0;
    if (MODE == 0) { r = item & 31; hq = (item >> 5) & 3; b = item >> 7;
        qcol = C_NQ + hq * 64; kcol = C_NK + hq * 64; vcol = C_NV + hq * 64; ocol = 256 + hq * 64; qrow0 = b * SEQ + r * 64;
        rs = r - 4; rs = rs < 0 ? 0 : (rs > 24 ? 24 : rs); nloc = 16; }
    else if (MODE == 1) { q64 = item & 31; hq = (item >> 5) & 7; b = item >> 8;
        qcol = C_SQ + hq * 64; kcol = C_SK + (hq >> 2) * 64; vcol = C_SV + (hq >> 2) * 64; ocol = 512 + hq * 64; qrow0 = b * SEQ + q64 * 64;
        kb_lo = 2 * q64 - 4; if (kb_lo < 0) kb_lo = 0; int kb_hi = 2 * q64 + 5; if (kb_hi > 63) kb_hi = 63; nloc = kb_hi - kb_lo + 1; }
    else if (MODE == 2) { q64 = item & 3; hq = (item >> 2) & 3; b = item >> 4;
        qcol = C_NQ + hq * 64; kcol = C_NK + hq * 64; vcol = C_NV + hq * 64; ocol = 256 + hq * 64; qrow0 = ML + b * CTXL + q64 * 64; nloc = 0; }
    else { q64 = item & 3; hq = (item >> 2) & 7; b = item >> 5;
        qcol = C_SQ + hq * 64; kcol = C_SK + (hq >> 2) * 64; vcol = C_SV + (hq >> 2) * 64; ocol = 512 + hq * 64; qrow0 = ML + b * CTXL + q64 * 64; nloc = 0; }
    const int nblk = 8 + nloc;
    LAS unsigned char* vl = wl;
    LAS float* rl = (LAS float*)(wl + 32 * VP);
    if (MODE == 0) { for (int i = lane; i < 465; i += 64) rl[i] = rpb[hq * 465 + i] * LOG2E; }
    LAS unsigned char* qimg = wl + 32 * VP + 1920;
    constexpr int QP = 144;
#pragma unroll
    for (int i = 0; i < 8; ++i) { const int c = lane + 64 * i; const v4u v = *(const v4u*)(P + (size_t)(qrow0 + (c >> 3)) * PP + qcol + (c & 7) * 8); *(LAS v4u*)(qimg + (c >> 3) * QP + (c & 7) * 16) = v; }
    LAS const unsigned char* qrd = qimg + ql * QP + 16 * hi;
    auto blk_row0 = [&](int blk) -> int {
        if (blk < 8) return ML + b * CTXL + blk * 32;
        const int lb = blk - 8;
        if (MODE == 0) return b * SEQ + (rs + (lb >> 1)) * 64 + (lb & 1) * 32;
        return b * SEQ + 32 * (kb_lo + lb);
    };
    auto load_blk = [&](int blk, bf16x8 (&kn)[4], v4u (&vn)[4]) {
        const int r0 = blk_row0(blk);
        const bf16_t* kp = P + (size_t)(r0 + ql) * PP + kcol + 8 * hi;
#pragma unroll
        for (int ds = 0; ds < 4; ++ds) kn[ds] = *(const bf16x8*)(kp + 16 * ds);
#pragma unroll
        for (int i = 0; i < 4; ++i) { const int c = lane + 64 * i; vn[i] = *(const v4u*)(P + (size_t)(r0 + (c >> 3)) * PP + vcol + (c & 7) * 8); }
    };
    AttnTile T[2];
#pragma unroll
    for (int t = 0; t < 2; ++t) { T[t].m = -INFINITY; T[t].lsum = 0.f;
#pragma unroll
        for (int i = 0; i < 16; ++i) { T[t].o0[i] = 0.f; T[t].o1[i] = 0.f; } }
    const int tr_off = (4 * hi + ((lane & 15) >> 2)) * VP + (16 * ((lane >> 4) & 1) + 4 * (lane & 3)) * 2;
    auto step = [&](int blk, bf16x8 (&kf)[4], v4u (&vr)[4]) {
#pragma unroll
        for (int i = 0; i < 4; ++i) { const int c = lane + 64 * i; *(LAS v4u*)(vl + (c >> 3) * VP + (c & 7) * 16) = vr[i]; }
        f32x16 sc[2];
#pragma unroll
        for (int t = 0; t < 2; ++t) {
#pragma unroll
            for (int i = 0; i < 16; ++i) sc[t][i] = 0.f;
#pragma unroll
            for (int ds = 0; ds < 4; ++ds) sc[t] = MFMA32(kf[ds], *(LAS const bf16x8*)(qrd + 32 * t * QP + 32 * ds), sc[t]);
        }
        if (blk + 2 < nblk) load_blk(blk + 2, kf, vr);
        bf16x8 vf[2][2];
#pragma unroll
        for (int ks = 0; ks < 2; ++ks) { LAS const unsigned char* vb = vl + tr_off + 16 * ks * VP;
            vf[ks][0] = cat4(tr_read(vb), tr_read(vb + 8 * VP)); vf[ks][1] = cat4(tr_read(vb + 64), tr_read(vb + 8 * VP + 64)); }
#pragma unroll
        for (int t = 0; t < 2; ++t) {
            f32x16& s = sc[t];
            if (MODE == 0 && blk >= 8) {
                const int lb = blk - 8, j = lb >> 1, ch = lb & 1, c = t * 32 + ql;
                int cs = c - 8; cs = cs < 0 ? 0 : (cs > 48 ? 48 : cs);
                LAS const float* rrow = rl + (rs + j - r + 7) * 31 + (15 - c);
#pragma unroll
                for (int i = 0; i < 16; ++i) { const int kc = ch * 32 + crow(i, hi); const bool ok = (kc >= cs) && (kc < cs + 16);
                    const float bias = rrow[ok ? kc : c];
                    s[i] = ok ? (s[i] + bias) : -INFINITY; }
            } else if (MODE == 1 && blk >= 8) {
                const int rel = (kb_lo + blk - 8) - (2 * q64 + t);
                if (rel <= -4 || rel >= 4) {
#pragma unroll
                    for (int i = 0; i < 16; ++i) { const int kk = crow(i, hi); const bool ok = (rel == -4) ? (kk >= ql) : ((rel == 4) ? (kk <= ql) : false);
                        s[i] = ok ? s[i] : -INFINITY; }
                }
            }
            attn_softmax(s, T[t]);
#pragma unroll
            for (int ks = 0; ks < 2; ++ks) {
                const bf16x8 pf = pack8(s[8 * ks + 0], s[8 * ks + 1], s[8 * ks + 2], s[8 * ks + 3], s[8 * ks + 4], s[8 * ks + 5], s[8 * ks + 6], s[8 * ks + 7]);
                T[t].o0 = MFMA32(vf[ks][0], pf, T[t].o0); T[t].o1 = MFMA32(vf[ks][1], pf, T[t].o1);
            }
            __builtin_amdgcn_sched_barrier(0);
        }
    };
    bf16x8 kA[4], kB[4]; v4u vA[4], vB[4];
    load_blk(0, kA, vA); load_blk(1, kB, vB);
    for (int blk = 0; blk < nblk; blk += 2) { step(blk, kA, vA); if (blk + 1 < nblk) step(blk + 1, kB, vB); }
#pragma unroll
    for (int t = 0; t < 2; ++t) {
        float lt = T[t].lsum + __shfl_xor(T[t].lsum, 32);
        if (MODE == 1 || MODE == 3) lt += fexp2(sink[hq] * LOG2E - T[t].m);
        const float inv = frcp(lt);
        bf16_t* op = MIX + (size_t)(qrow0 + 32 * t + ql) * 1024 + ocol + 4 * hi;
#pragma unroll
        for (int g = 0; g < 4; ++g) {
            v2u w0, w1; w0.x = pk2(T[t].o0[4 * g] * inv, T[t].o0[4 * g + 1] * inv); w0.y = pk2(T[t].o0[4 * g + 2] * inv, T[t].o0[4 * g + 3] * inv);
            w1.x = pk2(T[t].o1[4 * g] * inv, T[t].o1[4 * g + 1] * inv); w1.y = pk2(T[t].o1[4 * g + 2] * inv, T[t].o1[4 * g + 3] * inv);
            *(v2u*)(op + 8 * g) = w0; *(v2u*)(op + 32 + 8 * g) = w1;
        }
    }
}
constexpr int GP = 144;
constexpr int G_V = 0, G_A = 64 * GP, G_B = 64 * GP + 32 * GP;
static_assert(G_B + 32 * GP <= WAVE_LDS, "gla LDS");

struct GlaCum { float cum[2][16]; float tot; };
__device__ __forceinline__ void gla_cum(const bf16_t* P, int row0, int hh, int dir, const float* __restrict__ a_up, const float* __restrict__ a_bias, int lane, GlaCum& C) {
    const int kk = lane & 31, hi = lane >> 5;
    const float* up = a_up + (size_t)dir * 16 * 128 + (size_t)(8 * hi) * 128 + hh * 32 + kk;
    const bf16x8 ub = pack8(up[0], up[128], up[256], up[384], up[512], up[640], up[768], up[896]);
    const float bias = a_bias[dir * 128 + hh * 32 + kk];
    float gs[2][4];
#pragma unroll
    for (int tt = 0; tt < 2; ++tt) {
        const bf16x8 al = *(const bf16x8*)(P + (size_t)(row0 + 32 * tt + kk) * PP + C_GAF + 16 * dir + 8 * hi);
        f32x16 z;
#pragma unroll
        for (int i = 0; i < 16; ++i) z[i] = 0.f;
        z = MFMA32(al, ub, z);
#pragma unroll
        for (int g = 0; g < 4; ++g) { float run = 0.f;
#pragma unroll
            for (int e = 0; e < 4; ++e) { const float zz = z[4 * g + e] + bias; const float ls = fminf(zz, 0.f) - flog(1.f + fexp(-fabsf(zz)));
                const float l = ls * (1.f / 16.f);
                if (dir == 0) { run += l; C.cum[tt][4 * g + e] = run; } else { C.cum[tt][4 * g + e] = run; run += l; } }
            gs[tt][g] = run; }
    }
    float off = 0.f;
#pragma unroll
    for (int tt = 0; tt < 2; ++tt)
#pragma unroll
        for (int g = 0; g < 4; ++g) { const float other = __shfl_xor(gs[tt][g], 32); const float mine = off + (hi ? other : 0.f);
#pragma unroll
            for (int e = 0; e < 4; ++e) C.cum[tt][4 * g + e] += mine;
            off += gs[tt][g] + other; }
    C.tot = off;
    if (dir == 1) {
#pragma unroll
        for (int tt = 0; tt < 2; ++tt)
#pragma unroll
            for (int r = 0; r < 16; ++r) C.cum[tt][r] = off - C.cum[tt][r];
    }
}
__device__ __forceinline__ void gla_ld_tc(const bf16_t* P, int row0, int col, int lane, float (&x)[2][16]) {
    const int kk = lane & 31, hi = lane >> 5;
#pragma unroll
    for (int tt = 0; tt < 2; ++tt)
#pragma unroll
        for (int r = 0; r < 16; ++r) x[tt][r] = bf1(P[(size_t)(row0 + 32 * tt + crow(r, hi)) * PP + col + kk]);
}
__device__ __forceinline__ void gla_st_img(LAS unsigned char* img, int lane, const float (&x)[2][16]) {
    const int kk = lane & 31, hi = lane >> 5;
#pragma unroll
    for (int tt = 0; tt < 2; ++tt)
#pragma unroll
        for (int g = 0; g < 4; ++g) { v2u w; w.x = pk2(x[tt][4 * g], x[tt][4 * g + 1]); w.y = pk2(x[tt][4 * g + 2], x[tt][4 * g + 3]);
            *(LAS v2u*)(img + kk * GP + (32 * tt + 8 * g + 4 * hi) * 2) = w; }
}
__device__ __forceinline__ void gla_stage_v(const bf16_t* P, int row0, int hh, LAS unsigned char* wl, int lane) {
#pragma unroll
    for (int i = 0; i < 8; ++i) { const int c = lane + 64 * i; const v4u v = *(const v4u*)(P + (size_t)(row0 + (c >> 3)) * PP + C_GV + hh * 64 + (c & 7) * 8);
        *(LAS v4u*)(wl + G_V + (c >> 3) * GP + (c & 7) * 16) = v; }
}
__device__ __forceinline__ int gla_row0(int b, int nc) { return nc < 4 ? (ML + b * CTXL + 64 * nc) : (b * SEQ + 64 * (nc - 4)); }

__device__ __forceinline__ void gla_local_item(const bf16_t* P, float* UST, float* DEC, int item, LAS unsigned char* wl, int lane,
                                               const float* __restrict__ a_up, const float* __restrict__ a_bias) {
    asm volatile("" : "+v"(lane));
    const int nc = item % 36, hh = (item / 36) & 3, b = item / 144;
    const int row0 = gla_row0(b, nc), kk = lane & 31, hi = lane >> 5;
    gla_stage_v(P, row0, hh, wl, lane);
    float kv[2][16]; gla_ld_tc(P, row0, C_GK + hh * 32, lane, kv);
#pragma unroll
    for (int dir = 0; dir < 2; ++dir) {
        GlaCum C; gla_cum(P, row0, hh, dir, a_up, a_bias, lane, C);
        float kd[2][16];
#pragma unroll
        for (int tt = 0; tt < 2; ++tt)
#pragma unroll
            for (int r = 0; r < 16; ++r) kd[tt][r] = kv[tt][r] * fexp(C.tot - C.cum[tt][r]);
        gla_st_img(wl + (dir == 0 ? G_A : G_B), lane, kd);
        if (hi == 0) DEC[((size_t)((b * 4 + hh) * 2 + dir) * 36 + nc) * 32 + kk] = fexp(C.tot);
    }
    const int trv = ((lane & 15) >> 2) * GP + (16 * ((lane >> 4) & 1) + 4 * (lane & 3)) * 2;
#pragma unroll
    for (int dir = 0; dir < 2; ++dir) {
        f32x16 u0, u1;
#pragma unroll
        for (int i = 0; i < 16; ++i) { u0[i] = 0.f; u1[i] = 0.f; }
        LAS const unsigned char* img = wl + (dir == 0 ? G_A : G_B);
#pragma unroll
        for (int s = 0; s < 4; ++s) {
            const bf16x8 kb = *(LAS const bf16x8*)(img + kk * GP + (16 * s + 8 * hi) * 2);
            LAS const unsigned char* vb = wl + G_V + trv + (16 * s + 8 * hi) * GP;
            const bf16x8 v0 = cat4(tr_read(vb), tr_read(vb + 4 * GP));
            const bf16x8 v1 = cat4(tr_read(vb + 64), tr_read(vb + 4 * GP + 64));
            u0 = MFMA32(v0, kb, u0); u1 = MFMA32(v1, kb, u1);
        }
        float* up = UST + ((size_t)((b * 4 + hh) * 2 + dir) * 36 + nc) * 2048 + kk;
#pragma unroll
        for (int i = 0; i < 16; ++i) { up[(size_t)crow(i, hi) * 32] = u0[i]; up[(size_t)(32 + crow(i, hi)) * 32] = u1[i]; }
    }
}

__device__ __forceinline__ void gla_prefix(float* UST, const float* DEC, int gid, bool dry) {
    const int bhd = gid >> 11, e = gid & 2047, k = e & 31, dir = bhd & 1;
    float* base = UST + (size_t)bhd * 36 * 2048 + e; const float* dec = DEC + (size_t)bhd * 36 * 32 + k;
    float s = 0.f;
#pragma unroll 4
    for (int ci = 0; ci < 36; ++ci) {
        const int sl = dir == 0 ? ci : (ci < 4 ? 3 - ci : 39 - ci);
        const float u = base[(size_t)sl * 2048], d = dec[sl * 32];
        if (!dry) base[(size_t)sl * 2048] = s;
        s = d * s + u;
    }
}

__device__ __forceinline__ void gla_out_item(const bf16_t* P, const float* UST, bf16_t* MIX, int item, LAS unsigned char* wl, int lane,
                                             const float* __restrict__ a_up, const float* __restrict__ a_bias, const float* __restrict__ gnorm) {
    const int nc = item % 36, hh = (item / 36) & 3, b = item / 144;
    const int row0 = gla_row0(b, nc), kk = lane & 31, hi = lane >> 5;
    gla_stage_v(P, row0, hh, wl, lane);
    f32x16 o[2][2];
#pragma unroll
    for (int a = 0; a < 2; ++a)
#pragma unroll
        for (int c = 0; c < 2; ++c)
#pragma unroll
            for (int i = 0; i < 16; ++i) o[a][c][i] = 0.f;
    unsigned qp[2][8], kp[2][8];
#pragma unroll
    for (int tt = 0; tt < 2; ++tt) {
#pragma unroll
        for (int g = 0; g < 4; ++g)
#pragma unroll
            for (int e2 = 0; e2 < 2; ++e2) { const size_t ro = (size_t)(row0 + 32 * tt + 8 * g + 4 * hi + 2 * e2) * PP + hh * 32 + kk;
                qp[tt][2 * g + e2] = (unsigned)P[ro + C_GQ] | ((unsigned)P[ro + PP + C_GQ] << 16); kp[tt][2 * g + e2] = (unsigned)P[ro + C_GK] | ((unsigned)P[ro + PP + C_GK] << 16); }
        asm volatile("" ::: "memory");
    }
    const int g16 = (lane >> 4) & 1, qq = (lane & 15) >> 2, pp = lane & 3;
    const int tri = (8 * hi + qq) * GP + (16 * g16 + 4 * pp) * 2;
    const int trv = (4 * hi + qq) * GP + (16 * g16 + 4 * pp) * 2;
#pragma unroll
    for (int dir = 0; dir < 2; ++dir) {
        GlaCum C; gla_cum(P, row0, hh, dir, a_up, a_bias, lane, C);
#pragma unroll
        for (int tt = 0; tt < 2; ++tt) {
            float cum[16];
#pragma unroll
            for (int r = 0; r < 16; ++r) cum[r] = C.cum[tt][r];
#pragma unroll
            for (int g = 0; g < 4; ++g) {
                float xq[4], xk[4];
#pragma unroll
                for (int e = 0; e < 4; ++e) { const unsigned qw = qp[tt][2 * g + (e >> 1)], kw = kp[tt][2 * g + (e >> 1)];
                    xq[e] = ((e & 1) ? bfhi(qw) : bflo(qw)) * 0.17677669529663687f * fexp(cum[4 * g + e]); xk[e] = ((e & 1) ? bfhi(kw) : bflo(kw)) * fexp(-cum[4 * g + e]); }
                v2u wq, wk; wq.x = pk2(xq[0], xq[1]); wq.y = pk2(xq[2], xq[3]); wk.x = pk2(xk[0], xk[1]); wk.y = pk2(xk[2], xk[3]);
                const int off = kk * GP + (32 * tt + 8 * g + 4 * hi) * 2;
                *(LAS v2u*)(wl + G_A + off) = wq; *(LAS v2u*)(wl + G_B + off) = wk;
            }
        }
        const float* sp = UST + ((size_t)((b * 4 + hh) * 2 + dir) * 36 + nc) * 2048;
        bf16x8 sf[2][2];
#pragma unroll
        for (int vb = 0; vb < 2; ++vb)
#pragma unroll
            for (int s = 0; s < 2; ++s) { const float* p = sp + (size_t)(32 * vb + kk) * 32 + 16 * s + 8 * hi; const f32x4 a = *(const f32x4*)p, c = *(const f32x4*)(p + 4);
                sf[vb][s] = pack8(a.x, a.y, a.z, a.w, c.x, c.y, c.z, c.w); }
#pragma unroll
        for (int it = 0; it < 2; ++it) {
            bf16x8 qf[2];
#pragma unroll
            for (int s = 0; s < 2; ++s) { LAS const unsigned char* p = wl + G_A + tri + 16 * s * GP + 64 * it; qf[s] = cat4(tr_read(p), tr_read(p + 4 * GP)); }
#pragma unroll
            for (int vb = 0; vb < 2; ++vb)
#pragma unroll
                for (int s = 0; s < 2; ++s) o[vb][it] = MFMA32(sf[vb][s], qf[s], o[vb][it]);
#pragma unroll
            for (int jt = 0; jt < 2; ++jt) {
                if (dir == 0 ? (jt > it) : (jt < it)) continue;
                f32x16 sc;
#pragma unroll
                for (int i = 0; i < 16; ++i) sc[i] = 0.f;
#pragma unroll
                for (int s = 0; s < 2; ++s) { LAS const unsigned char* p = wl + G_B + tri + 16 * s * GP + 64 * jt; const bf16x8 kf = cat4(tr_read(p), tr_read(p + 4 * GP)); sc = MFMA32(kf, qf[s], sc); }
                if (jt == it) {
#pragma unroll
                    for (int i = 0; i < 16; ++i) { const int j = crow(i, hi); const bool ok = dir == 0 ? (j <= kk) : (j >= kk); sc[i] = ok ? sc[i] : 0.f; }
                }
#pragma unroll
                for (int s2 = 0; s2 < 2; ++s2) {
                    const bf16x8 pf = pack8(sc[8 * s2 + 0], sc[8 * s2 + 1], sc[8 * s2 + 2], sc[8 * s2 + 3], sc[8 * s2 + 4], sc[8 * s2 + 5], sc[8 * s2 + 6], sc[8 * s2 + 7]);
                    LAS const unsigned char* vp = wl + G_V + trv + (32 * jt + 16 * s2) * GP;
                    const bf16x8 v0 = cat4(tr_read(vp), tr_read(vp + 8 * GP));
                    const bf16x8 v1 = cat4(tr_read(vp + 64), tr_read(vp + 8 * GP + 64));
                    o[0][it] = MFMA32(v0, pf, o[0][it]); o[1][it] = MFMA32(v1, pf, o[1][it]);
                }
                __builtin_amdgcn_sched_barrier(0);
            }
            __builtin_amdgcn_sched_barrier(0);
        }
    }
#pragma unroll
    for (int it = 0; it < 2; ++it) {
        float ss = 0.f;
#pragma unroll
        for (int vb = 0; vb < 2; ++vb)
#pragma unroll
            for (int i = 0; i < 16; ++i) ss += o[vb][it][i] * o[vb][it][i];
        ss += __shfl_xor(ss, 32);
        const float rstd = __builtin_amdgcn_rsqf(ss * (1.f / 64.f) + NEPS);
        const size_t row = (size_t)(row0 + 32 * it + kk);
#pragma unroll
        for (int vb = 0; vb < 2; ++vb)
#pragma unroll
            for (int g = 0; g < 4; ++g) { const int v = 32 * vb + 8 * g + 4 * hi;
                const f32x4 gn = *(const f32x4*)(gnorm + v); const v2u gw = *(const v2u*)(P + row * PP + C_GG + hh * 64 + v);
                const float g0 = bflo(gw.x), g1 = bfhi(gw.x), g2 = bflo(gw.y), g3 = bfhi(gw.y);
                v2u w; w.x = pk2(o[vb][it][4 * g] * rstd * gn.x * silu_f(g0), o[vb][it][4 * g + 1] * rstd * gn.y * silu_f(g1));
                w.y = pk2(o[vb][it][4 * g + 2] * rstd * gn.z * silu_f(g2), o[vb][it][4 * g + 3] * rstd * gn.w * silu_f(g3));
                *(v2u*)(MIX + row * 1024 + hh * 64 + v) = w; }
    }
}
__device__ __forceinline__ void phase_r1(const float* const* in, float* xout, unsigned char* ws, LAS unsigned char* lds, int l, bool upd, int G, int tid, int wave, int lane, bool dry) {
    const float* x0 = in[0]; const float* ctx0 = in[2]; const float* gains = in[6] + (size_t)l * 4096; const float* wr = in[14] + (size_t)l * 1024 * 16;
    const float* mod = (const float*)(ws + WS_MOD) + (size_t)l * 9 * 6144;
    const bf16_t* Y = (const bf16_t*)(ws + WS_R2 + (size_t)MT * 2048); bf16_t* H = (bf16_t*)(ws + WS_H); bf16_t* XB = (bf16_t*)(ws + WS_XB);
    float* AFF = (float*)(ws + WS_AFF); float* AFFC = (float*)(ws + WS_AFFC);
    LAS float* V = (LAS float*)lds;
    LAS float* RT = V + 6144;
    __syncthreads();
    for (int i = tid; i < 16384; i += 512) { const int d = i >> 4, e = i & 15; RT[e * 1024 + d] = wr[i]; }
    for (int t = blockIdx.x; t < 256; t += G) {
        const int b = t >> 5;
        __syncthreads();
        for (int n = tid; n < 1024; n += 512) { const float gpa = gains[1024 + n], gpf = gains[2048 + n];
            V[n] = gpa * mod[b * 6144 + 2048 + n]; V[1024 + n] = gpf * (1.f + mod[b * 6144 + 4096 + n]); V[2048 + n] = mod[b * 6144 + 3072 + n];
            V[3072 + n] = gpa * mod[8 * 6144 + 2048 + n]; V[4096 + n] = gpf * (1.f + mod[8 * 6144 + 4096 + n]); V[5120 + n] = mod[8 * 6144 + 3072 + n]; }
        __syncthreads();
        const int nrows = upd ? 9 : 8;
#pragma unroll 1
        for (int i0 = 0; i0 < 9; i0 += 3) {
            f32x4 yv[3][4], xq[3][4];
#pragma unroll
            for (int k = 0; k < 3; ++k) { const int i = i0 + k; if (i < nrows) {
                const bool isc = (i == 8); const int row = isc ? (ML + 8 * t + wave) : (64 * t + 8 * wave + i);
                ld_row_bf16(Y + (size_t)row * 1024, lane, yv[k]);
                if (l == 0) ld_row_f32(isc ? (ctx0 + (size_t)(8 * t + wave) * 1024) : (x0 + (size_t)row * 1024), lane, xq[k]); else ld_row_bf16(XB + (size_t)row * 1024, lane, xq[k]); } }
#pragma unroll
            for (int k = 0; k < 3; ++k) { const int i = i0 + k; if (i < nrows) {
            const bool isc = (i == 8);
            const int row = isc ? (ML + 8 * t + wave) : (64 * t + 8 * wave + i);
            bf16_t* xd = (dry ? (bf16_t*)(ws + WS_R1) : XB) + (size_t)row * 1024;
            LAS const float* vv = V + (isc ? 3072 : 0);
            f32x4 (&y)[4] = yv[k]; f32x4 (&xv)[4] = xq[k]; f32x4 a[4];
            const float rsy = __builtin_amdgcn_rsqf(wave_sum(sumsq16(y)) * (1.f / 1024.f) + NEPS);
            ld_vec_lds(vv, lane, a);
#pragma unroll
            for (int j = 0; j < 4; ++j) xv[j] = xv[j] + a[j] * (y[j] * rsy);
            st_row_bf16(xd, lane, xv);
            const float rs1 = __builtin_amdgcn_rsqf(wave_sum(sumsq16(xv)) * (1.f / 1024.f) + NEPS);
            f32x4 s[4]; ld_vec_lds(vv + 1024, lane, a); ld_vec_lds(vv + 2048, lane, s);
#pragma unroll
            for (int j = 0; j < 4; ++j) xv[j] = xv[j] * rs1 * a[j] + s[j];
            st_row_bf16((dry ? (bf16_t*)(ws + WS_R2) : H) + (size_t)row * 1024, lane, xv);
            float lg[16];
#pragma unroll
            for (int e = 0; e < 16; ++e) { float p = 0.f;
#pragma unroll
                for (int j = 0; j < 4; ++j) { const f32x4 w = *(LAS const f32x4*)(RT + e * 1024 + 256 * j + 4 * lane); p += (xv[j].x * w.x + xv[j].y * w.y) + (xv[j].z * w.z + xv[j].w * w.w); }
                lg[e] = p;
                if ((e & 3) == 3) asm volatile("" ::: "memory"); }
#pragma unroll
            for (int i2 = 0; i2 < 8; ++i2) { const bool up = (lane & 32) != 0; const float keep = up ? lg[i2 + 8] : lg[i2], send = up ? lg[i2] : lg[i2 + 8]; lg[i2] = keep + __shfl_xor(send, 32); }
#pragma unroll
            for (int i2 = 0; i2 < 4; ++i2) { const bool up = (lane & 16) != 0; const float keep = up ? lg[i2 + 4] : lg[i2], send = up ? lg[i2] : lg[i2 + 4]; lg[i2] = keep + __shfl_xor(send, 16); }
#pragma unroll
            for (int i2 = 0; i2 < 2; ++i2) { const bool up = (lane & 8) != 0; const float keep = up ? lg[i2 + 2] : lg[i2], send = up ? lg[i2] : lg[i2 + 2]; lg[i2] = keep + __shfl_xor(send, 8); }
            { const bool up = (lane & 4) != 0; const float keep = up ? lg[1] : lg[0], send = up ? lg[0] : lg[1]; lg[0] = keep + __shfl_xor(send, 4); }
            float lgt = lg[0]; lgt += __shfl_xor(lgt, 1); lgt += __shfl_xor(lgt, 2);
            const int ex = ((lane >> 5) & 1) * 8 + ((lane >> 4) & 1) * 4 + ((lane >> 3) & 1) * 2 + ((lane >> 2) & 1);
            float mx = lgt;
            mx = fmaxf(mx, __shfl_xor(mx, 4)); mx = fmaxf(mx, __shfl_xor(mx, 8)); mx = fmaxf(mx, __shfl_xor(mx, 16)); mx = fmaxf(mx, __shfl_xor(mx, 32));
            const float pe = fexp(lgt - mx);
            float den = pe; den += __shfl_xor(den, 4); den += __shfl_xor(den, 8); den += __shfl_xor(den, 16); den += __shfl_xor(den, 32);
            const float mine = pe / den;
            if ((lane & 3) == 0) {
                if (isc) { const int cr = 8 * t + wave; AFFC[((size_t)(cr >> 8) * 16 + ex) * 256 + (cr & 255)] = mine; }
                else AFF[((size_t)(row >> 11) * 16 + ex) * 2048 + (row & 2047)] = mine;
            }
            } }
        }
    }
}

template <bool CTX>
__device__ __forceinline__ void topk_wave(unsigned char* ws, int item, int lane) {
    constexpr int NT = CTX ? 256 : 2048, CAP = CTX ? 32 : 256, PER = NT / 64;
    const int e = item & 15, b = item >> 4;
    const float* arow = (const float*)(ws + (CTX ? WS_AFFC : WS_AFF)) + (size_t)(b * 16 + e) * NT;
    float* gate = (float*)(ws + (CTX ? WS_GATEC : WS_GATE)) + (size_t)(b * 16 + e) * CAP;
    short* INV = (short*)(ws + WS_INV);
    int* rowidx = (int*)(ws + WS_ROWIDX) + (CTX ? ((128 + e) * 256 + b * 32) : ((b * 16 + e) * 256));
    unsigned v[PER];
#pragma unroll
    for (int i = 0; i < PER / 4; ++i) { const v4u q = *(const v4u*)(arow + lane * PER + 4 * i); v[4 * i] = q.x; v[4 * i + 1] = q.y; v[4 * i + 2] = q.z; v[4 * i + 3] = q.w; }
    unsigned T = 0;
    for (int bit = 29; bit >= 0; --bit) {
        const unsigned cand = T | (1u << bit); int c = 0;
#pragma unroll
        for (int i = 0; i < PER; ++i) c += __popcll(__ballot(v[i] >= cand));
        if (c >= CAP) T = cand;
    }
    int ngt = 0, cg = 0, ce = 0;
#pragma unroll
    for (int i = 0; i < PER; ++i) { ngt += __popcll(__ballot(v[i] > T)); cg += (v[i] > T) ? 1 : 0; ce += (v[i] == T) ? 1 : 0; }
    const int need = CAP - ngt;
    int pg = cg, pe = ce;
#pragma unroll
    for (int d = 1; d < 64; d <<= 1) { const int tg = __shfl_up(pg, d), te = __shfl_up(pe, d); if (lane >= d) { pg += tg; pe += te; } }
    pg -= cg; pe -= ce;
#pragma unroll
    for (int i = 0; i < PER; ++i) {
        const bool gt = v[i] > T, eq = v[i] == T;
        const bool sel = gt || (eq && pe < need);
        const int slot = pg + (pe < need ? pe : need);
        const int tok = lane * PER + i, grow = CTX ? (ML + b * CTXL + tok) : (b * SEQ + tok);
        if (sel) { rowidx[slot] = grow; gate[slot] = __uint_as_float(v[i]); }
        INV[(size_t)grow * 16 + e] = sel ? (short)slot : (short)-1;
        pg += gt ? 1 : 0; pe += eq ? 1 : 0;
    }
}

__device__ __forceinline__ void topk_wg2(unsigned char* ws, int item, LAS unsigned char* lds, int tid, int wave, int lane) {
    constexpr int CAP = 256;
    const int e = item & 15, b = item >> 4;
    const float* arow = (const float*)(ws + WS_AFF) + (size_t)(b * 16 + e) * 2048;
    float* gate = (float*)(ws + WS_GATE) + (size_t)(b * 16 + e) * CAP;
    short* INV = (short*)(ws + WS_INV);
    int* rowidx = (int*)(ws + WS_ROWIDX) + (b * 16 + e) * 256;
    LAS int* cnt = (LAS int*)lds;
    const v4u q = *(const v4u*)(arow + 4 * tid);
    const unsigned v[4] = {q.x, q.y, q.z, q.w};
    unsigned T = 0;
    __syncthreads();
    for (int bit = 29; bit >= 0; --bit) {
        const unsigned cand = T | (1u << bit); int c = 0;
#pragma unroll
        for (int i = 0; i < 4; ++i) c += __popcll(__ballot(v[i] >= cand));
        LAS int* cb = cnt + (bit & 1) * 8;
        if (lane == 0) cb[wave] = c;
        __syncthreads();
        int tot = 0;
#pragma unroll
        for (int w = 0; w < 8; ++w) tot += cb[w];
        if (tot >= CAP) T = cand;
    }
    int cg = 0, ce = 0, wg_ = 0, we_ = 0;
#pragma unroll
    for (int i = 0; i < 4; ++i) { wg_ += __popcll(__ballot(v[i] > T)); we_ += __popcll(__ballot(v[i] == T)); cg += (v[i] > T) ? 1 : 0; ce += (v[i] == T) ? 1 : 0; }
    if (lane == 0) { cnt[16 + wave] = wg_; cnt[24 + wave] = we_; }
    int pg = cg, pe = ce;
#pragma unroll
    for (int d = 1; d < 64; d <<= 1) { const int tg = __shfl_up(pg, d), te = __shfl_up(pe, d); if (lane >= d) { pg += tg; pe += te; } }
    pg -= cg; pe -= ce;
    __syncthreads();
    int ngt = 0;
#pragma unroll
    for (int w = 0; w < 8; ++w) { const int g_ = cnt[16 + w], e_ = cnt[24 + w]; ngt += g_; if (w < wave) { pg += g_; pe += e_; } }
    const int need = CAP - ngt;
#pragma unroll
    for (int i = 0; i < 4; ++i) {
        const bool gt = v[i] > T, eq = v[i] == T;
        const bool sel = gt || (eq && pe < need);
        const int slot = pg + (pe < need ? pe : need);
        const int grow = b * SEQ + 4 * tid + i;
        if (sel) { rowidx[slot] = grow; gate[slot] = __uint_as_float(v[i]); }
        INV[(size_t)grow * 16 + e] = sel ? (short)slot : (short)-1;
        pg += gt ? 1 : 0; pe += eq ? 1 : 0;
    }
}

__device__ __forceinline__ void phase_r5(const float* const* in, float* xout, unsigned char* ws, LAS unsigned char* lds, int l, bool upd, int G, int tid, int wave, int lane, bool dry) {
    const float* gains = in[6];
    const float* mod = (const float*)(ws + WS_MOD);
    const bf16_t* YE = (const bf16_t*)(ws + WS_R1); bf16_t* H = (bf16_t*)(ws + WS_H); bf16_t* XB = (bf16_t*)(ws + WS_XB);
    const float* GATE = (const float*)(ws + WS_GATE); const float* GATEC = (const float*)(ws + WS_GATEC); const short* INV = (const short*)(ws + WS_INV);
    LAS float* V = (LAS float*)lds;
    LAS int* CL = (LAS int*)(lds + 24576);
    for (int t = blockIdx.x; t < 256; t += G) {
        const int b = t >> 5;
        __syncthreads();
        for (int n = tid; n < 1024; n += 512) { const float gpf = gains[(size_t)l * 4096 + 3072 + n];
            V[n] = gpf * mod[((size_t)l * 9 + b) * 6144 + 5120 + n]; V[3072 + n] = gpf * mod[((size_t)l * 9 + 8) * 6144 + 5120 + n];
            if (l == 0) { const float gna = gains[4096 + n];
                V[1024 + n] = gna * (1.f + mod[((size_t)9 + b) * 6144 + 1024 + n]); V[2048 + n] = mod[((size_t)9 + b) * 6144 + n];
                V[4096 + n] = gna * (1.f + mod[((size_t)9 + 8) * 6144 + 1024 + n]); V[5120 + n] = mod[((size_t)9 + 8) * 6144 + n]; } }
        if (tid < (upd ? 72 : 64)) {
            const bool isc = tid >= 64; const int cr = 8 * t + (tid - 64);
            const int row = isc ? (ML + cr) : (64 * t + tid); const int bb = isc ? (cr >> 8) : b;
            const v4u i0 = *(const v4u*)(INV + (size_t)row * 16), i1 = *(const v4u*)(INV + (size_t)row * 16 + 8);
            const unsigned iw[8] = {i0.x, i0.y, i0.z, i0.w, i1.x, i1.y, i1.z, i1.w};
            float gv[16]; int sl[16];
#pragma unroll
            for (int e = 0; e < 16; ++e) { sl[e] = (int)(short)((iw[e >> 1] >> (16 * (e & 1))) & 0xffffu); const int s0 = sl[e] < 0 ? 0 : sl[e];
                gv[e] = isc ? GATEC[(size_t)(bb * 16 + e) * 32 + s0] : GATE[(size_t)(bb * 16 + e) * 256 + s0]; }
            int cnt = 0; LAS int* cl = CL + tid * 33;
#pragma unroll
            for (int e = 0; e < 16; ++e) if (sl[e] >= 0) { cl[1 + 2 * cnt] = isc ? ((128 + e) * 256 + bb * 32 + sl[e]) : ((bb * 16 + e) * 256 + sl[e]); cl[2 + 2 * cnt] = (int)__float_as_uint(gv[e]); ++cnt; }
            cl[0] = cnt;
        }
        __syncthreads();
        const int nrows = upd ? 9 : 8;
#pragma unroll 1
        for (int i0 = 0; i0 < 9; i0 += 3) {
            f32x4 xq[3][4];
#pragma unroll
            for (int k = 0; k < 3; ++k) { const int i = i0 + k; if (i < nrows) { const bool isc = (i == 8);
                ld_row_bf16(XB + (size_t)(isc ? (ML + 8 * t + wave) : (64 * t + 8 * wave + i)) * 1024, lane, xq[k]); } }
#pragma unroll
            for (int k = 0; k < 3; ++k) { const int i = i0 + k; if (i < nrows) {
            const bool isc = (i == 8);
            const int row = isc ? (ML + 8 * t + wave) : (64 * t + 8 * wave + i);
            LAS const float* vv = V + (isc ? 3072 : 0);
            LAS const int* cl = CL + (isc ? (64 + wave) : (8 * wave + i)) * 33;
            const int n = __builtin_amdgcn_readfirstlane(cl[0]);
            f32x4 acc[4];
#pragma unroll
            for (int j = 0; j < 4; ++j) acc[j] = (f32x4){0.f, 0.f, 0.f, 0.f};
            for (int j0 = 0; j0 < n; j0 += 4) {
                v2u raw[4][4]; float g[4];
#pragma unroll
                for (int q = 0; q < 4; ++q) {
                    if (j0 + q < n) { const int yr = __builtin_amdgcn_readfirstlane(cl[1 + 2 * (j0 + q)]); g[q] = __uint_as_float((unsigned)__builtin_amdgcn_readfirstlane(cl[2 + 2 * (j0 + q)]));
                        const bf16_t* yp = YE + (size_t)yr * 1024;
#pragma unroll
                        for (int j = 0; j < 4; ++j) raw[q][j] = *(const v2u*)(yp + 256 * j + 4 * lane); }
                    else { g[q] = 0.f;
#pragma unroll
                        for (int j = 0; j < 4; ++j) raw[q][j] = (v2u){0u, 0u}; }
                }
#pragma unroll
                for (int q = 0; q < 4; ++q)
#pragma unroll
                    for (int j = 0; j < 4; ++j) acc[j] += (f32x4){bflo(raw[q][j].x), bfhi(raw[q][j].x), bflo(raw[q][j].y), bfhi(raw[q][j].y)} * g[q];
            }
            const float rsm = __builtin_amdgcn_rsqf(wave_sum(sumsq16(acc)) * (1.f / 1024.f) + NEPS);
            f32x4 (&xv)[4] = xq[k]; f32x4 a[4]; ld_vec_lds(vv, lane, a);
#pragma unroll
            for (int j = 0; j < 4; ++j) xv[j] = xv[j] + a[j] * (acc[j] * rsm);
            if (l == 0) st_row_bf16((dry ? (bf16_t*)(ws + WS_R2) : XB) + (size_t)row * 1024, lane, xv);
            else st_row_f32((dry ? (float*)(ws + WS_R2) : xout) + (size_t)row * 1024, lane, xv);
            if (l == 0 && !dry) {
                const float rs2 = __builtin_amdgcn_rsqf(wave_sum(sumsq16(xv)) * (1.f / 1024.f) + NEPS);
                f32x4 s[4]; ld_vec_lds(vv + 1024, lane, a); ld_vec_lds(vv + 2048, lane, s);
#pragma unroll
                for (int j = 0; j < 4; ++j) xv[j] = xv[j] * rs2 * a[j] + s[j];
                st_row_bf16(H + (size_t)row * 1024, lane, xv);
            }
            } }
        }
    }
}
#ifndef MK_PER_PHASE
#define MK_PER_PHASE 0
#endif
constexpr int N_PHASES = 22;
struct Args { const float* in[18]; float* out; unsigned char* ws; int ph_lo, ph_hi; };
__device__ __forceinline__ const Args* kargs_opaque() {
    auto p = __builtin_amdgcn_kernarg_segment_ptr(); asm volatile("" : "+s"(p)); return (const Args*)p; }
#define PHASE_REGS() int tid = threadIdx.x; asm volatile("" : "+v"(tid)); const int lane = tid & 63, wave = __builtin_amdgcn_readfirstlane(tid >> 6); \
    const Args* A = kargs_opaque(); unsigned char* ws = A->ws; const int G = gridDim.x, bx = blockIdx.x; \
    const int vcu = (G % 8 == 0) ? (bx % 8) * (G / 8) + bx / 8 : bx; const int gw = vcu * NWAVES + wave, NGW = G * NWAVES; \
    LAS unsigned char* wl = lds + wave * WAVE_LDS; (void)gw; (void)NGW; (void)wl; (void)lane; (void)ws
#ifndef CONV_BUDGET
#define CONV_BUDGET 1
#endif
#ifndef PH_MASK
#define PH_MASK 0xFFFFFFFFu
#endif
#define EN(j) (((PH_MASK) >> (j)) & 1u)
#ifndef REP_MASK
#define REP_MASK 0u
#endif
#define REPS(j) ((((REP_MASK) >> (j)) & 1u) ? 2 : 1)
__global__ void __launch_bounds__(NWAVES * 64, 2) fwd_kernel(Args args) {
    extern __shared__ __attribute__((aligned(16))) unsigned char lds_raw[];
    LAS unsigned char* lds = (LAS unsigned char*)lds_raw;
    volatile LAS unsigned* MISC = (volatile LAS unsigned*)(lds + MISC_OFF);
    for (int u = threadIdx.x; u < (LDS_BYTES - LDSCTL_OFF) / 4; u += NWAVES * 64) ((LAS unsigned*)(lds + LDSCTL_OFF))[u] = 0u;
    __syncthreads();
    const int lo = args.ph_lo, hi = args.ph_hi;
    XcdBarrier bar; bar.bar = (unsigned*)(args.ws + WS_CTL) + CW_BAR; bar.x = 0; bar.st = nullptr;
    if (hi - lo > 1) bar = xcd_barrier_post((unsigned*)(args.ws + WS_CTL) + CW_BAR, MISC + 8);
#define IN(k) (lo <= (k) && (k) < hi)
#ifdef STAMP_A
#define STAMP(k) do { if (blockIdx.x == 0 && threadIdx.x == 0) ((unsigned long long*)(args.ws + WS_CTL))[1536 + (k)] = __builtin_amdgcn_s_memrealtime(); } while (0)
#else
#define STAMP(k) do { } while (0)
#endif
#define SEAM(k) do { if (IN((k) + 1)) { xcd_barrier(bar); if (REPS(12) == 2) xcd_barrier(bar); } STAMP((k) + 1); } while (0)
    STAMP(0);
    if (EN(0) && IN(0)) { for (int rep = 0; rep < REPS(0); ++rep) { PHASE_REGS(); phase_p0(A->in, ws, wl, gw, NGW, lane); } SEAM(0); }
    if (EN(1) && IN(1)) { for (int rep = 0; rep < REPS(1); ++rep) { PHASE_REGS(); phase_a0(A->in, ws, lds, G, tid, wave, lane); } SEAM(1); }
    for (int l = 0; l < 2; ++l) {
        const int base = 2 + 10 * l; const bool upd = (l == 0);
        if (EN(2) && IN(base + 0)) { for (int rep = 0; rep < REPS(2); ++rep) {
            PHASE_REGS();
            pg8::Gemm g{(const bf16_t*)(ws + WS_H), (const bf16_t*)(ws + WS_WIN) + (size_t)l * PP * 1024, MT, PP, 1024}; pg8::StaticOrder S; S.init(MT, PP, G, bx);
            pg8::EpiProj E{(bf16_t*)(ws + WS_R1), PP, (const pg8::f32x2*)(ws + WS_TAB), ML};
            pg8::gemm_phase<pg8::EpiProj, pg8::StaticOrder, true, true>(lds, g, S, E);
            if (upd && CV_G1 > 0 && G == 256 && bx >= 208 && !(rep + 1 < REPS(2))) tr_stream(A->in, ws, P0_A + (bx - 208) * NWAVES + wave, 384, P0_A + CV_N1, (LAS float*)wl, lane);
            if (!CONV_IN_P0) { const int nwg_ = (MT / 256) * (PP / 256); if ((nwg_ - bx + G - 1) / G < (nwg_ + G - 1) / G) conv_pull(A->in, ws, l, 1, 12 * CONV_BUDGET, (LAS float*)wl, lane); }
            }
            SEAM(base + 0);
        }
        if (EN(3) && IN(base + 1)) { for (int rep = 0; rep < REPS(3); ++rep) {
            PHASE_REGS();
            const bf16_t* PROJ = (const bf16_t*)(ws + WS_R1); bf16_t* MIX = (bf16_t*)(ws + WS_R2);
            const float* a_up = A->in[9] + (size_t)l * 2 * 16 * 128; const float* a_bias = A->in[10] + (size_t)l * 2 * 128;
            const float* rpb = A->in[12] + (size_t)l * 4 * 465; const float* sink = A->in[13] + (size_t)l * 8;
            const int n_cn = upd ? 128 : 0, n_cs = upd ? 256 : 0;
            const bool xmap = (G == 256);
            const int xcd = bx & 7, cu = bx >> 3;
            const int n_att = xmap ? 12 : 0;
            const int tail_total = (xmap ? 0 : 1024 + 2048) + 1152 + n_cn + n_cs;
            volatile LAS unsigned* qctr = (volatile LAS unsigned*)(lds + MISC_OFF) + 16 + l * 2 + rep;
            const int n_conv = 0, n_mix = (n_conv + 2) / 3 * 4;
            for (;;) {
                int j = 0; if (lane == 0) j = (int)__hip_atomic_fetch_add((LAS unsigned*)qctr, 1u, __ATOMIC_RELAXED, __HIP_MEMORY_SCOPE_WORKGROUP);
                j = __builtin_amdgcn_readfirstlane(j);
                if (j < n_mix) {
                    if ((j & 3) != 3) { const int ci = (j >> 2) * 3 + (j & 3), r = ci * G + bx; if (ci < n_conv && r < 12288 && !(rep + 1 < REPS(3))) expert_conv_item(A->in, ws, l, r, (LAS float*)wl, lane); continue; }
                    j = j >> 2;
                } else j = j - n_mix + n_mix / 4;
                int mode, item;
                if (j < n_att) {
                    if (j < 4) { mode = 0; item = (xcd * 4 + j) * 32 + cu; }
                    else { const int jj = j - 4, group = xcd * 2 + (jj >> 2), i = cu * 4 + (jj & 3); const int bb = group >> 1, hq = (group & 1) * 4 + (i >> 5); mode = 1; item = (i & 31) + 32 * hq + 256 * bb; }
                } else {
                    int r = (j - n_att) * G + bx;
                    if (r >= tail_total) break;
                    mode = -1; item = 0;
                    if (!xmap) { if (r < 1024) { mode = 0; item = r; } else if (r < 3072) { mode = 1; item = r - 1024; } r -= 3072; }
                    if (mode < 0) {
                        if (r < 1152) { if (rep + 1 < REPS(3)) continue; gla_local_item(PROJ, (float*)(ws + WS_UST), (float*)(ws + WS_DEC), r, wl, lane, a_up, a_bias); continue; } r -= 1152;
                        if (r < n_cs) { mode = 3; item = r; } else { mode = 2; item = r - n_cs; }
                    }
                }
                attn_item(mode, PROJ, MIX, item, wl, lane, rpb, sink, rep + 1 < REPS(3));
            }
            }
            SEAM(base + 1);
        }
        if (EN(4) && IN(base + 2)) { for (int rep = 0; rep < REPS(4); ++rep) {
            PHASE_REGS();
            for (int gid = bx * (NWAVES * 64) + tid; gid < 64 * 2048; gid += G * NWAVES * 64) gla_prefix((float*)(ws + WS_UST), (const float*)(ws + WS_DEC), gid, rep + 1 < REPS(4));
            }
            SEAM(base + 2);
        }
        if (EN(5) && IN(base + 3)) { for (int rep = 0; rep < REPS(5); ++rep) {
            PHASE_REGS();
            const float* a_up = A->in[9] + (size_t)l * 2 * 16 * 128; const float* a_bias = A->in[10] + (size_t)l * 2 * 128; const float* gnorm = A->in[11] + (size_t)l * 64;
            for (int it = gw; it < 1152; it += NGW) { if (!upd && (it % 36) < 4) continue;
                gla_out_item((const bf16_t*)(ws + WS_R1), (const float*)(ws + WS_UST), (bf16_t*)(ws + WS_R2), it, wl, lane, a_up, a_bias, gnorm); }
            if (upd && G == 256 && gw >= 1152 && !(rep + 1 < REPS(5))) tr_stream(A->in, ws, TR_ALL - CONV_M3 + (gw - 1152), NGW - 1152, TR_ALL, (LAS float*)wl, lane);
            }
            SEAM(base + 3);
        }
        if (EN(6) && IN(base + 4)) { for (int rep = 0; rep < REPS(6); ++rep) {
            PHASE_REGS();
            const int M2 = upd ? MT : ML;
            pg8::Gemm g{(const bf16_t*)(ws + WS_R2), (const bf16_t*)(ws + WS_WOUT) + (size_t)l * 1024 * 1024, M2, 1024, 1024}; pg8::StaticOrder S; S.init(M2, 1024, G, bx);
            pg8::EpiStore E{(bf16_t*)(ws + WS_R2 + (size_t)MT * 2048), 1024};
            pg8::gemm_phase<pg8::EpiStore, pg8::StaticOrder, true, true>(lds, g, S, E);
            if (upd && CV_G2 > 0 && G == 256 && bx >= 32 && !(rep + 1 < REPS(6))) tr_stream(A->in, ws, P0_A + CV_N1 + (bx - 32) * NWAVES + wave, 1792, TR_L, (LAS float*)wl, lane);
            if (!CONV_IN_P0) { const int nwg_ = (M2 / 256) * 4; if ((nwg_ - bx + G - 1) / G < (nwg_ + G - 1) / G) conv_pull(A->in, ws, l, 1, 3 * CONV_BUDGET, (LAS float*)wl, lane); }
            }
            SEAM(base + 4);
        }
        if (EN(7) && IN(base + 5)) { for (int rep = 0; rep < REPS(7); ++rep) { PHASE_REGS(); phase_r1(A->in, A->out, ws, lds, l, upd, G, tid, wave, lane, rep + 1 < REPS(7)); } SEAM(base + 5); }
        if (EN(8) && IN(base + 6)) { for (int rep = 0; rep < REPS(8); ++rep) {
            PHASE_REGS();
            if (!CONV_IN_P0) conv_pull(A->in, ws, l, l, 1 << 30, (LAS float*)wl, lane);
            for (int it = bx; it < 128; it += G) topk_wg2(ws, it, lds, tid, wave, lane);
            if (upd) { const int w2 = (bx >= 128 ? bx - 128 : bx + G - 128) * NWAVES + wave; for (int it = w2; it < 128; it += NGW) topk_wave<true>(ws, it, lane); }
            }
            SEAM(base + 6);
        }
        if (EN(9) && IN(base + 7)) { for (int rep = 0; rep < REPS(9); ++rep) {
            PHASE_REGS();
            pg8::Gemm g{(const bf16_t*)(ws + WS_H), (const bf16_t*)(ws + WS_WGU) + (size_t)l * 16 * 2048 * 1024, 0, 0, 1024, (const int*)(ws + WS_ROWIDX)}; pg8::MoeOrder S; S.init(upd ? 9 : 8, 8, G, bx);
            pg8::EpiSwiGLU E{(bf16_t*)(ws + WS_R2), 1024};
            pg8::gemm_phase<pg8::EpiSwiGLU, pg8::MoeOrder, true, true, true>(lds, g, S, E);
            if (upd && CV_G3 > 0 && G == 256 && bx >= 128 && !(rep + 1 < REPS(9))) tr_stream(A->in, ws, P0_B + (bx - 128) * NWAVES + wave, 1024, P0_B + CV_N3, (LAS float*)wl, lane);
            if (!CONV_IN_P0) { const int nwg_ = 16 * (upd ? 9 : 8) * 8; if ((nwg_ - bx + G - 1) / G < (nwg_ + G - 1) / G) conv_pull(A->in, ws, l + 1, 1, 4 * CONV_BUDGET, (LAS float*)wl, lane); }
            }
            SEAM(base + 7);
        }
        if (EN(10) && IN(base + 8)) { for (int rep = 0; rep < REPS(10); ++rep) {
            PHASE_REGS();
            pg8::Gemm g{(const bf16_t*)(ws + WS_R2), (const bf16_t*)(ws + WS_WD) + (size_t)l * 16 * 1024 * 1024, 0, 0, 1024}; pg8::MoeOrder S; S.init(upd ? 9 : 8, 4, G, bx);
            pg8::EpiStore E{(bf16_t*)(ws + WS_R1), 1024};
            pg8::gemm_phase<pg8::EpiStore, pg8::MoeOrder, true, true>(lds, g, S, E);
            if (upd && CV_G4 > 0 && G == 256 && bx >= 64 && !(rep + 1 < REPS(10))) tr_stream(A->in, ws, P0_B + CV_N3 + (bx - 64) * NWAVES + wave, 1536, P0_B + CV_N3 + CV_N4, (LAS float*)wl, lane);
            if (!CONV_IN_P0) { const int nwg_ = 16 * (upd ? 9 : 8) * 4; if ((nwg_ - bx + G - 1) / G < (nwg_ + G - 1) / G) conv_pull(A->in, ws, l + 1, 1, 3 * CONV_BUDGET, (LAS float*)wl, lane); }
            }
            SEAM(base + 8);
        }
        if (EN(11) && IN(base + 9)) { for (int rep = 0; rep < REPS(11); ++rep) { PHASE_REGS(); phase_r5(A->in, A->out, ws, lds, l, upd, G, tid, wave, lane, rep + 1 < REPS(11)); } SEAM(base + 9); }
    }
#ifdef STAMP_A
    if (blockIdx.x == 0 && threadIdx.x == 0) { const unsigned long long* st_ = (const unsigned long long*)(args.ws + WS_CTL) + 1536; const float d_ = (float)(st_[STAMP_B] - st_[STAMP_A]); args.out[0] = 200.f * floorf(d_ / 200.f + 0.5f); }
#endif
#undef IN
#undef SEAM
}

extern "C" void kernel_launch(void* const* d_in, const int* in_sizes, int n_in, void* d_out, int out_size, void* d_ws, size_t ws_size, hipStream_t stream) {
    static int grid = 0;
    if (grid == 0) {
        if (n_in != 18 || out_size != ML * DM || ws_size < WS_END) { fprintf(stderr, "kernel_launch: unexpected sizes: n_in %d out %d ws %zu (need %zu)\n", n_in, out_size, ws_size, (size_t)WS_END); grid = -1; return; }
        int dev = 0, cus = 0, per_cu = 0;
        if (hipGetDevice(&dev) != hipSuccess || hipDeviceGetAttribute(&cus, hipDeviceAttributeMultiprocessorCount, dev) != hipSuccess) { grid = -1; return; }
        if (hipFuncSetAttribute((const void*)fwd_kernel, hipFuncAttributeMaxDynamicSharedMemorySize, LDS_BYTES) != hipSuccess) { fprintf(stderr, "kernel_launch: hipFuncSetAttribute failed\n"); grid = -1; return; }
        if (hipOccupancyMaxActiveBlocksPerMultiprocessor(&per_cu, (const void*)fwd_kernel, NWAVES * 64, LDS_BYTES) != hipSuccess || per_cu < 1) { fprintf(stderr, "kernel_launch: occupancy query says %d blocks per CU\n", per_cu); (void)hipGetLastError(); grid = -1; return; }
        grid = cus;
    }
    if (grid < 0) return;
    (void)hipMemsetAsync((char*)d_ws + WS_CTL, 0, CTL_ZERO_BYTES, stream);
    Args a{};
    for (int i = 0; i < 18; ++i) a.in[i] = (const float*)d_in[i];
    a.out = (float*)d_out; a.ws = (unsigned char*)d_ws;
#if MK_PER_PHASE
    for (int p = 0; p < N_PHASES; ++p) { a.ph_lo = p; a.ph_hi = p + 1; hipLaunchKernelGGL(fwd_kernel, dim3(grid), dim3(NWAVES * 64), LDS_BYTES, stream, a); }
#else
    a.ph_lo = 0; a.ph_hi = N_PHASES;
    void* kargs[] = {&a};
    hipError_t e = hipLaunchCooperativeKernel((const void*)fwd_kernel, dim3(grid), dim3(NWAVES * 64), kargs, LDS_BYTES, stream);
    if (e != hipSuccess) fprintf(stderr, "kernel_launch: cooperative launch failed: %s (grid %d)\n", hipGetErrorString(e), grid);
#endif
}
```

```cpp
#include <hip/hip_runtime.h>
#include <cstdio>
#include <cstdint>
#include <cmath>

namespace pg8 {
#define PG8_LAS __attribute__((address_space(3)))
typedef unsigned short bf16_t;
typedef short bf16x8 __attribute__((ext_vector_type(8)));
typedef float f32x4 __attribute__((ext_vector_type(4)));
typedef unsigned u32x4 __attribute__((ext_vector_type(4)));
constexpr int BM = 256, BK = 64, HALF = 128, HTB = HALF * BK * 2  , STAGE_BYTES = 8 * HTB, NXCD = 8, WGM = 8;

__host__ __device__ __forceinline__ int lds_byte(int r, int c) { const int st = (r >> 4) * 2 + (c >> 5), rr = r & 15, cc = c & 31, ob = rr * 64 + cc * 2; return st * 1024 + (ob ^ (((ob >> 9) & 1) << 5)); }
__host__ __device__ __forceinline__ void stage_rc(int b, int& R, int& C) { const int st = b / 1024, sb = b % 1024, swz = sb ^ (((sb >> 9) & 1) << 5); R = (st >> 1) * 16 + swz / 64; C = (st & 1) * 32 + (swz % 64) / 2; }
__host__ __device__ __forceinline__ int perm32(int rho) { const int n = rho >> 4, i = rho & 15; return 8 * (i >> 2) + 4 * n + (i & 3); }

struct Unit { int pm, pn, pb; };
struct Gemm { const bf16_t* A; const bf16_t* Bt; int M, N, K; const int* rowidx; };

struct StaticOrder {
    int nM, nN, nwg, G, c;
    __host__ __device__ void init(int M, int N, int G_, int c_) { nM = M / BM; nN = N / BM; nwg = nM * nN; G = G_; c = c_; }
    __host__ __device__ bool next(int i, Unit& u) const {
        const long L = (long)i * G + c; if (L >= nwg) return false;
        int wgid = (int)L; { const int q = nwg / NXCD, r = nwg % NXCD, xcd = wgid % NXCD, off = wgid / NXCD; wgid = (xcd < r ? xcd * (q + 1) : r * (q + 1) + (xcd - r) * q) + off; }
        const int nig = WGM * nN, gid = wgid / nig, fm = gid * WGM, gsz = (nM - fm) < WGM ? (nM - fm) : WGM;
        u.pm = fm + ((wgid % nig) % gsz); u.pn = (wgid % nig) / gsz; u.pb = u.pn; return true;
    }
    __device__ __forceinline__ void a_ready(const Unit&) const {}
    __device__ __forceinline__ void done(const Unit&) const {}
};

__device__ __forceinline__ unsigned cvt_pk_bf16(float lo, float hi) { unsigned r; asm volatile("v_cvt_pk_bf16_f32 %0, %1, %2" : "=v"(r) : "v"(lo), "v"(hi)); return r; }
typedef float f32x2 __attribute__((ext_vector_type(2)));
#ifndef EPI_WT
#define EPI_WT 0
#endif
__device__ __forceinline__ void st16(bf16_t* base, size_t elem_off, u32x4 w) {
#if EPI_WT
    const __amdgpu_buffer_rsrc_t r = __builtin_amdgcn_make_buffer_rsrc((void*)base, 0, 0x7fffffff, 0x00020000);
    __builtin_amdgcn_raw_buffer_store_b128(w, r, (unsigned)(elem_off * 2), 0, 16);
#else
    *(u32x4*)(base + elem_off) = w;
#endif
}
struct EpiStore {
    static constexpr bool PERM = true, AFTER_DRAIN = false;
    bf16_t* O; int ldc;
    __device__ __forceinline__ void operator()(const f32x4 (&acc)[2][2][4][2], const Unit& u, int wr, int wc, int fr, int fq) const {
        const int row0 = u.pm * BM + wr * 64 + fr, col0 = u.pn * BM + wc * 32 + 8 * fq;
#pragma unroll
        for (int ai = 0; ai < 2; ++ai)
#pragma unroll
            for (int m = 0; m < 4; ++m) { bf16_t* rowp = O + (size_t)(row0 + ai * HALF + m * 16) * ldc + col0;
#pragma unroll
                for (int bj = 0; bj < 2; ++bj) { const f32x4 v0 = acc[ai][bj][m][0], v1 = acc[ai][bj][m][1];
                    u32x4 w; w.x = cvt_pk_bf16(v0[0], v0[1]); w.y = cvt_pk_bf16(v0[2], v0[3]); w.z = cvt_pk_bf16(v1[0], v1[1]); w.w = cvt_pk_bf16(v1[2], v1[3]);
                    st16(O, (size_t)(rowp - O) + bj * HALF, w); } }
    }
};
struct EpiProj {
    static constexpr bool PERM = true, AFTER_DRAIN = false;
    bf16_t* O; int ldc; const f32x2* tab; int ml;
    __device__ __forceinline__ void operator()(const f32x4 (&acc)[2][2][4][2], const Unit& u, int wr, int wc, int fr, int fq) const {
        const int row0 = u.pm * BM + wr * 64 + fr;
        const bool latent = (u.pm * BM) < ml;
#pragma unroll
        for (int bj = 0; bj < 2; ++bj) {
            const int c0 = u.pn * BM + bj * HALF + wc * 32;
            const bool rope = latent && ((c0 >= 928 && c0 < 1056) || (c0 >= 1824 && c0 < 2336));
            const bool rowhalf = (((c0 - 32) & 63) == 0);
            const bool qscale = (c0 >= 1568 && c0 < 2336);
#pragma unroll
            for (int ai = 0; ai < 2; ++ai)
#pragma unroll
                for (int m = 0; m < 4; ++m) {
                    const int row = row0 + ai * HALF + m * 16;
                    f32x4 v0 = acc[ai][bj][m][0], v1 = acc[ai][bj][m][1];
                    if (rope) {
                        const int t = row & 2047, pos = rowhalf ? (t >> 6) : (t & 63);
                        const f32x2* tp = tab + pos * 16 + 8 * (fq & 1);
                        const float sg = (fq < 2) ? -1.f : 1.f;
#pragma unroll
                        for (int e = 0; e < 4; ++e) {
                            const float x0 = v0[e], x1 = v1[e];
                            const float p0 = __shfl_xor(x0, 32), p1 = __shfl_xor(x1, 32);
                            const f32x2 c0s = tp[e], c1s = tp[4 + e];
                            v0[e] = x0 * c0s.x + sg * p0 * c0s.y; v1[e] = x1 * c1s.x + sg * p1 * c1s.y;
                        }
                    }
                    if (qscale) { v0 = v0 * 0.18033688011112042f; v1 = v1 * 0.18033688011112042f; }
                    u32x4 w; w.x = cvt_pk_bf16(v0[0], v0[1]); w.y = cvt_pk_bf16(v0[2], v0[3]); w.z = cvt_pk_bf16(v1[0], v1[1]); w.w = cvt_pk_bf16(v1[2], v1[3]);
                    st16(O, (size_t)row * ldc + c0 + 8 * fq, w);
                }
        }
    }
};
struct EpiSwiGLU {
    static constexpr bool PERM = true, AFTER_DRAIN = false;
    bf16_t* O; int ldc;
    __device__ __forceinline__ void operator()(const f32x4 (&acc)[2][2][4][2], const Unit& u, int wr, int wc, int fr, int fq) const {
        const int row0 = u.pm * BM + wr * 64 + fr, col0 = u.pn * HALF + wc * 32 + 8 * fq;
#pragma unroll
        for (int ai = 0; ai < 2; ++ai)
#pragma unroll
            for (int m = 0; m < 4; ++m) {
                float h[8];
#pragma unroll
                for (int n = 0; n < 2; ++n)
#pragma unroll
                    for (int e = 0; e < 4; ++e) { const float g = acc[ai][0][m][n][e], up = acc[ai][1][m][n][e];
                        h[n * 4 + e] = g * __builtin_amdgcn_rcpf(1.f + __builtin_amdgcn_exp2f(-1.4426950408889634f * g)) * up; }
                u32x4 w; w.x = cvt_pk_bf16(h[0], h[1]); w.y = cvt_pk_bf16(h[2], h[3]); w.z = cvt_pk_bf16(h[4], h[5]); w.w = cvt_pk_bf16(h[6], h[7]);
                st16(O, (size_t)(row0 + ai * HALF + m * 16) * ldc + col0, w);
            }
    }
};
struct MoeOrder {
    int npe, nN, nwg, G, c;
    __host__ __device__ void init(int npe_, int nN_, int G_, int c_) { npe = npe_; nN = nN_; nwg = 16 * npe * nN; G = G_; c = c_; }
    __host__ __device__ bool next(int i, Unit& u) const {
        const long L = (long)i * G + c; if (L >= nwg) return false;
        int wgid = (int)L; { const int q = nwg / NXCD, r = nwg % NXCD, xcd = wgid % NXCD, off = wgid / NXCD; wgid = (xcd < r ? xcd * (q + 1) : r * (q + 1) + (xcd - r) * q) + off; }
        const int per = npe * nN, e = wgid / per, rem = wgid % per, j = rem / nN, pn = rem % nN;
        u.pm = (j < 8) ? (j * 16 + e) : (128 + e); u.pn = pn; u.pb = e * nN + pn; return true;
    }
    __device__ __forceinline__ void a_ready(const Unit&) const {}
    __device__ __forceinline__ void done(const Unit&) const {}
};

template <class Epi, class Sched, bool ALIGN_EPI = false, bool SP2 = false, bool GATHER = false>
__device__ __forceinline__ void gemm_phase(PG8_LAS unsigned char* lds, const Gemm g, const Sched& S, const Epi& E) {
    int tid_ = threadIdx.x; asm volatile("" : "+v"(tid_));
    const int tid = tid_, wid = __builtin_amdgcn_readfirstlane(tid >> 6), lane = tid & 63, wr = wid >> 2, wc = wid & 3, fr = lane & 15, fq = lane >> 4;
    const int K = g.K, nt = K / BK;
    static_assert(!GATHER || SP2, "GATHER is wired into the SP2 loop only");
    unsigned voffA[2], voffB[2]; int RA[2], CA[2]; unsigned vAc[2][2], vAn[2][2];
#pragma unroll
    for (int i = 0; i < 2; ++i) { int R, C; stage_rc(tid * 16 + i * 8192, R, C); const int Rb = Epi::PERM ? ((R & ~31) + perm32(R & 31)) : R; RA[i] = R; CA[i] = C;
        voffA[i] = (unsigned)(R * K + C) * 2u; voffB[i] = (unsigned)(Rb * K + C) * 2u; vAc[0][i] = vAc[1][i] = vAn[0][i] = vAn[1][i] = 0u; }
    auto load_idx = [&](int pm, unsigned (&v)[2][2]) {
#pragma unroll
        for (int h = 0; h < 2; ++h)
#pragma unroll
            for (int i = 0; i < 2; ++i) v[h][i] = (unsigned)(g.rowidx[pm * BM + h * HALF + RA[i]] * K + CA[i]) * 2u;
    };
    const size_t kstep = (size_t)(BK * 2);
    const size_t hstep = (size_t)HALF * K * 2;
    const size_t tstep = 2 * hstep;
    const unsigned ldsw = (unsigned)wid * 1024u;
    const int aoff = lds_byte(wr * 64 + fr, fq * 8), boff = lds_byte(wc * 32 + fr, fq * 8);
#define PG8_SA(b, h) (((b) * 2 + (h)) * HTB)
#define PG8_SB(b, h) ((4 + (b) * 2 + (h)) * HTB)
#define PG8_STAGE(bufoff, gbase, voff) do { _Pragma("unroll") for (int _i = 0; _i < 2; ++_i) \
        __builtin_amdgcn_global_load_lds((const unsigned*)((const char*)(gbase) + (voff)[_i]), (PG8_LAS unsigned*)(lds + (bufoff) + ldsw + _i * 8192), 16, 0, 0); } while (0)
#define PG8_STAGE_A(bufoff, gbase, h, nx) do { if constexpr (GATHER) { const unsigned v_[2] = { (nx) ? vAn[h][0] : vAc[h][0], (nx) ? vAn[h][1] : vAc[h][1] }; PG8_STAGE(bufoff, gbase, v_); } \
        else { PG8_STAGE(bufoff, (gbase) + (h) * hstep, voffA); } } while (0)
#define PG8_LDA(dst, b, h) do { _Pragma("unroll") for (int m = 0; m < 4; ++m) _Pragma("unroll") for (int k = 0; k < 2; ++k) dst[m][k] = *(const PG8_LAS bf16x8*)(lds + PG8_SA(b, h) + aoff + m * 2048 + k * 1024); } while (0)
#define PG8_LDB(dst, b, h) do { _Pragma("unroll") for (int n = 0; n < 2; ++n) _Pragma("unroll") for (int k = 0; k < 2; ++k) dst[n][k] = *(const PG8_LAS bf16x8*)(lds + PG8_SB(b, h) + boff + n * 2048 + k * 1024); } while (0)
#define PG8_MMA(ai, bj, At, Bt) do { __builtin_amdgcn_s_setprio(1); _Pragma("unroll") for (int m = 0; m < 4; ++m) _Pragma("unroll") for (int n = 0; n < 2; ++n) _Pragma("unroll") for (int k = 0; k < 2; ++k) \
        acc[ai][bj][m][n] = __builtin_amdgcn_mfma_f32_16x16x32_bf16(Bt[n][k], At[m][k], acc[ai][bj][m][n], 0, 0, 0); __builtin_amdgcn_s_setprio(0); } while (0)
#define PG8_WAIT_V(n) asm volatile("s_waitcnt vmcnt(" #n ")" ::: "memory")
#define PG8_WAIT_L(n) asm volatile("s_waitcnt lgkmcnt(" #n ")" ::: "memory")
#define PG8_BAR __builtin_amdgcn_s_barrier()
#define PG8_SCHED __builtin_amdgcn_sched_barrier(0)
    Unit cur, nxt; int ui = 0;
    if (!S.next(0, cur)) return;
    f32x4 acc[2][2][4][2];
#pragma unroll
    for (int a = 0; a < 2; ++a)
#pragma unroll
        for (int b = 0; b < 2; ++b)
#pragma unroll
            for (int m = 0; m < 4; ++m)
#pragma unroll
                for (int n = 0; n < 2; ++n) acc[a][b][m][n] = (f32x4){0.f, 0.f, 0.f, 0.f};
    bf16x8 At[4][2], B0[2][2], B1[2][2];
    const char* cA = (const char*)g.A + (GATHER ? (size_t)0 : (size_t)cur.pm * tstep); const char* cB = (const char*)g.Bt + (size_t)cur.pb * tstep;
    if constexpr (GATHER) load_idx(cur.pm, vAc);
    S.a_ready(cur);
    if constexpr (SP2) {
        PG8_STAGE(PG8_SB(0, 0), cB, voffB); PG8_STAGE(PG8_SB(0, 1), cB + hstep, voffB); PG8_STAGE_A(PG8_SA(0, 0), cA, 0, false); PG8_STAGE_A(PG8_SA(0, 1), cA, 1, false);
        if (wr == 1) PG8_BAR;
        PG8_WAIT_V(2); PG8_BAR;
        PG8_STAGE(PG8_SB(1, 0), cB + kstep, voffB); PG8_STAGE_A(PG8_SA(1, 0), cA + kstep, 0, false); PG8_STAGE(PG8_SB(1, 1), cB + hstep + kstep, voffB);
        PG8_WAIT_V(6); PG8_BAR;
    } else {
        PG8_STAGE(PG8_SB(0, 0), cB, voffB); PG8_STAGE(PG8_SA(0, 0), cA, voffA); PG8_STAGE(PG8_SB(0, 1), cB + hstep, voffB); PG8_STAGE(PG8_SA(0, 1), cA + hstep, voffA);
        if (wr == 1) PG8_BAR;
        PG8_WAIT_V(4); PG8_BAR;
        PG8_STAGE(PG8_SB(1, 0), cB + kstep, voffB); PG8_STAGE(PG8_SA(1, 0), cA + kstep, voffA); PG8_STAGE(PG8_SB(1, 1), cB + hstep + kstep, voffB);
        PG8_WAIT_V(6); PG8_BAR;
    }
    for (;;) {
        const bool has_next = S.next(ui + 1, nxt);
        if constexpr (GATHER) { if (has_next) {
#pragma unroll
            for (int h = 0; h < 2; ++h)
#pragma unroll
                for (int i = 0; i < 2; ++i) __builtin_amdgcn_global_load_lds((const unsigned*)(g.rowidx + nxt.pm * BM + h * HALF + RA[i]), (PG8_LAS unsigned*)(lds + STAGE_BYTES + (h * 2 + i) * 2048 + wid * 256), 4, 0, 0); } }
        const char* nA = (has_next && !GATHER) ? (const char*)g.A + (size_t)nxt.pm * tstep : cA; const char* nB = has_next ? (const char*)g.Bt + (size_t)nxt.pb * tstep : cB;
        for (int t = 0; t < nt; t += 2) {
            const bool last = (t == nt - 2); const bool nxu = last && has_next; (void)nxu;
            if constexpr (GATHER) { if (nxu) {
#pragma unroll
                for (int h = 0; h < 2; ++h)
#pragma unroll
                    for (int i = 0; i < 2; ++i) { const int ix = *(const PG8_LAS int*)(lds + STAGE_BYTES + (h * 2 + i) * 2048 + tid * 4); vAn[h][i] = (unsigned)(ix * K + CA[i]) * 2u; } } }
            const char* a1 = cA + (size_t)(t + 1) * kstep;
            const char* a2 = last ? nA : cA + (size_t)(t + 2) * kstep; const char* b2 = last ? nB : cB + (size_t)(t + 2) * kstep;
            const char* a3 = a2 + kstep; const char* b3 = b2 + kstep;
            if (last && has_next) S.a_ready(nxt);
            if constexpr (SP2) {
            PG8_LDB(B0, 0, 0); PG8_LDB(B1, 0, 1); PG8_SCHED; PG8_LDA(At, 0, 0); PG8_STAGE_A(PG8_SA(1, 1), a1, 1, false);
            PG8_WAIT_V(8); PG8_WAIT_L(0); PG8_BAR; PG8_MMA(0, 0, At, B0); PG8_MMA(0, 1, At, B1); PG8_BAR; PG8_SCHED;
            PG8_LDA(At, 0, 1); PG8_STAGE(PG8_SB(0, 0), b2, voffB); PG8_STAGE(PG8_SB(0, 1), b2 + hstep, voffB); PG8_STAGE_A(PG8_SA(0, 0), a2, 0, nxu);
            PG8_WAIT_V(8); PG8_WAIT_L(0); PG8_BAR; PG8_MMA(1, 0, At, B0); PG8_MMA(1, 1, At, B1); PG8_BAR; PG8_SCHED;
            PG8_LDB(B0, 1, 0); PG8_LDB(B1, 1, 1); PG8_SCHED; PG8_LDA(At, 1, 0); PG8_STAGE_A(PG8_SA(0, 1), a2, 1, nxu);
            PG8_WAIT_V(8); PG8_WAIT_L(0); PG8_BAR; PG8_MMA(0, 0, At, B0); PG8_MMA(0, 1, At, B1); PG8_BAR; PG8_SCHED;
            PG8_LDA(At, 1, 1); PG8_STAGE(PG8_SB(1, 0), b3, voffB); PG8_STAGE(PG8_SB(1, 1), b3 + hstep, voffB); PG8_STAGE_A(PG8_SA(1, 0), a3, 0, nxu);
            PG8_WAIT_V(8); PG8_WAIT_L(0); PG8_BAR; PG8_MMA(1, 0, At, B0); PG8_MMA(1, 1, At, B1); PG8_BAR; PG8_SCHED;
            } else {
            PG8_LDB(B0, 0, 0); PG8_SCHED; PG8_LDA(At, 0, 0); PG8_STAGE(PG8_SA(1, 1), a1 + hstep, voffA);
            PG8_WAIT_L(8); PG8_BAR; PG8_WAIT_L(0); PG8_MMA(0, 0, At, B0); PG8_BAR; PG8_SCHED;
            PG8_LDB(B1, 0, 1); PG8_STAGE(PG8_SB(0, 0), b2, voffB);
            PG8_BAR; PG8_WAIT_L(0); PG8_MMA(0, 1, At, B1); PG8_BAR;
            PG8_LDA(At, 0, 1); PG8_STAGE(PG8_SA(0, 0), a2, voffA);
            PG8_BAR; PG8_WAIT_L(0); PG8_MMA(1, 0, At, B0); PG8_BAR; PG8_SCHED;
            PG8_STAGE(PG8_SB(0, 1), b2 + hstep, voffB);
            PG8_WAIT_V(6); PG8_BAR; PG8_MMA(1, 1, At, B1); PG8_BAR;
            PG8_LDB(B0, 1, 0); PG8_SCHED; PG8_LDA(At, 1, 0); PG8_STAGE(PG8_SA(0, 1), a2 + hstep, voffA);
            PG8_WAIT_L(8); PG8_BAR; PG8_WAIT_L(0); PG8_MMA(0, 0, At, B0); PG8_BAR; PG8_SCHED;
            PG8_LDB(B1, 1, 1); PG8_STAGE(PG8_SB(1, 0), b3, voffB);
            PG8_BAR; PG8_WAIT_L(0); PG8_MMA(0, 1, At, B1); PG8_BAR;
            PG8_LDA(At, 1, 1); PG8_STAGE(PG8_SA(1, 0), a3, voffA);
            PG8_BAR; PG8_WAIT_L(0); PG8_MMA(1, 0, At, B0); PG8_BAR; PG8_SCHED;
            PG8_STAGE(PG8_SB(1, 1), b3 + hstep, voffB);
            PG8_WAIT_V(6); PG8_BAR; PG8_MMA(1, 1, At, B1); PG8_BAR;
            }
        }
        if constexpr (ALIGN_EPI) { if (wr == 0) PG8_BAR; }
        if constexpr (!Epi::AFTER_DRAIN) { E(acc, cur, wr, wc, fr, fq); S.done(cur); }
        if (!has_next) break;
#pragma unroll
        for (int a = 0; a < 2; ++a)
#pragma unroll
            for (int b = 0; b < 2; ++b)
#pragma unroll
                for (int m = 0; m < 4; ++m)
#pragma unroll
                    for (int n = 0; n < 2; ++n) acc[a][b][m][n] = (f32x4){0.f, 0.f, 0.f, 0.f};
        cur = nxt; cA = nA; cB = nB; ++ui;
        if constexpr (GATHER) {
#pragma unroll
            for (int h = 0; h < 2; ++h) { vAc[h][0] = vAn[h][0]; vAc[h][1] = vAn[h][1]; } }
        if constexpr (ALIGN_EPI) { if (wr == 1) PG8_BAR; }
    }
    PG8_WAIT_V(0);
    if constexpr (!ALIGN_EPI) { if (wr == 0) PG8_BAR; }
    PG8_BAR;
    if constexpr (Epi::AFTER_DRAIN) { E.fused(acc, cur, wr, wc, fr, fq, lds, wid, lane); S.done(cur); }
#undef PG8_SA
#undef PG8_SB
#undef PG8_STAGE
#undef PG8_STAGE_A
#undef PG8_LDA
#undef PG8_LDB
#undef PG8_MMA
#undef PG8_WAIT_V
#undef PG8_WAIT_L
#undef PG8_BAR
#undef PG8_SCHED
}
}
constexpr int NB = 8, SEQ = 2048, DM = 1024, CTXL = 256, ML = NB * SEQ, MC = NB * CTXL, MT = ML + MC;
constexpr int PP = 2560;
constexpr int INW = 2336;
constexpr int C_GK = 0, C_GV = 128, C_GAF = 384, C_GAB = 400, C_NK = 416, C_NV = 672, C_SK = 928, C_SV = 1056, C_GQ = 1184, C_GG = 1312, C_NQ = 1568, C_SQ = 1824;
constexpr int NWAVES = 8;
constexpr float NEPS = 1e-6f;
constexpr float LOG2E = 1.4426950408889634f;

constexpr size_t MiB = 1u << 20;
constexpr size_t WS_CTL = 0, CTL_ZERO_BYTES = 65536;
constexpr size_t WS_TAB = 1 * MiB;
constexpr size_t WS_MOD = 1 * MiB + 65536;
constexpr size_t WS_MODP = 2 * MiB;
constexpr size_t WS_WIN = 6 * MiB;
constexpr size_t WS_WOUT = 16 * MiB;
constexpr size_t WS_WGU = 20 * MiB;
constexpr size_t WS_WD = 148 * MiB;
constexpr size_t WS_H = 212 * MiB;
constexpr size_t WS_R1 = 248 * MiB;
constexpr size_t WS_R2 = 338 * MiB;
constexpr size_t WS_XB = 410 * MiB;
constexpr size_t WS_UST = 446 * MiB;
constexpr size_t WS_MISC = 464 * MiB;
constexpr size_t WS_DEC = WS_MISC;
constexpr size_t WS_AFF = WS_MISC + 1 * MiB;
constexpr size_t WS_AFFC = WS_MISC + 2 * MiB;
constexpr size_t WS_GATE = WS_MISC + 2 * MiB + 262144;
constexpr size_t WS_GATEC = WS_MISC + 2 * MiB + 524288;
constexpr size_t WS_INV = WS_MISC + 3 * MiB;
constexpr size_t WS_ROWIDX = WS_MISC + 3 * MiB + 786432;
constexpr size_t WS_END = 468 * MiB;
constexpr int CW_BAR = 4096;
constexpr int CW_QUEUE = 1024;
constexpr int CW_CONV = 2048;

constexpr int WAVE_LDS = 19456;
constexpr int RING_BYTES = NWAVES * WAVE_LDS;
constexpr int LDSCTL_OFF = RING_BYTES, MISC_OFF = LDSCTL_OFF + 320;
constexpr int LDS_BYTES = RING_BYTES + 1024;
static_assert(RING_BYTES >= pg8::STAGE_BYTES && LDS_BYTES <= 163840, "LDS map");

#define GAS __attribute__((address_space(1)))
#define LAS __attribute__((address_space(3)))
typedef unsigned short bf16_t;
typedef unsigned v4u __attribute__((ext_vector_type(4)));
typedef unsigned v2u __attribute__((ext_vector_type(2)));
typedef float f32x4 __attribute__((ext_vector_type(4)));
typedef float f32x2 __attribute__((ext_vector_type(2)));
typedef float f32x16 __attribute__((ext_vector_type(16)));
typedef short bf16x8 __attribute__((ext_vector_type(8)));
typedef short s16x4 __attribute__((ext_vector_type(4)));
typedef GAS unsigned gu32;
#define RLX_AGENT __ATOMIC_RELAXED, __HIP_MEMORY_SCOPE_AGENT
typedef __bf16 bf16x2_t __attribute__((ext_vector_type(2)));
__device__ __forceinline__ unsigned pk2(float lo, float hi) { f32x2 v = {lo, hi}; bf16x2_t b = __builtin_convertvector(v, bf16x2_t); return __builtin_bit_cast(unsigned, b); }
__device__ __forceinline__ float bflo(unsigned w) { return __uint_as_float(w << 16); }
__device__ __forceinline__ float bfhi(unsigned w) { return __uint_as_float(w & 0xffff0000u); }
__device__ __forceinline__ float bf1(bf16_t w) { return __uint_as_float((unsigned)w << 16); }
__device__ __forceinline__ float wave_sum(float v) {
#pragma unroll
    for (int o = 1; o < 64; o <<= 1) v += __shfl_xor(v, o);
    return v;
}
__device__ __forceinline__ float fexp2(float x) { return __builtin_amdgcn_exp2f(x); }
__device__ __forceinline__ float fexp(float x) { return __builtin_amdgcn_exp2f(x * LOG2E); }
__device__ __forceinline__ float flog(float x) { return __builtin_amdgcn_logf(x) * 0.6931471805599453f; }
__device__ __forceinline__ float frcp(float x) { return __builtin_amdgcn_rcpf(x); }
__device__ __forceinline__ float silu_f(float x) { return x * frcp(1.f + fexp(-x)); }
__device__ __forceinline__ int crow(int r, int hi) { return (r & 3) + 8 * (r >> 2) + 4 * hi; }
__device__ __forceinline__ s16x4 tr_read(LAS const unsigned char* p) { return __builtin_bit_cast(s16x4, __builtin_amdgcn_ds_read_tr16_b64_v4i16((LAS s16x4*)p)); }
__device__ __forceinline__ bf16x8 cat4(s16x4 a, s16x4 b) { return (bf16x8){a[0], a[1], a[2], a[3], b[0], b[1], b[2], b[3]}; }
__device__ __forceinline__ bf16x8 pack8(float a0, float a1, float a2, float a3, float a4, float a5, float a6, float a7) {
    v4u w; w.x = pk2(a0, a1); w.y = pk2(a2, a3); w.z = pk2(a4, a5); w.w = pk2(a6, a7); return __builtin_bit_cast(bf16x8, w); }
#define MFMA32(a, b, c) __builtin_amdgcn_mfma_f32_32x32x16_bf16((a), (b), (c), 0, 0, 0)

#ifndef EARLY_WB
#define EARLY_WB 0
#endif
#define XB_TMO      128
#define XB_XCNT(j)  (256  + 64 * (j))
#define XB_XSUB(j)  (1280 + 64 * (j))
#define XB_XGEN(j)  (2304 + 64 * (j))
#define XB_TOP      3328
#define XB_TOPGEN   3392
#define XCD_BAR_WORDS 3456
#define XB_SPIN_CAP (1u << 18)

__device__ __forceinline__ unsigned xb_ld(unsigned* p)              { return __hip_atomic_load(p, __ATOMIC_RELAXED, __HIP_MEMORY_SCOPE_AGENT); }
__device__ __forceinline__ unsigned xb_add(unsigned* p, unsigned v) { return __hip_atomic_fetch_add(p, v, __ATOMIC_RELAXED, __HIP_MEMORY_SCOPE_AGENT); }
__device__ __forceinline__ unsigned xb_xcc_id() { return (unsigned)__builtin_amdgcn_s_getreg((3 << 11) | 20) & 0xFu; }
#define XB_SPIN(cond, bar) do { unsigned _sp = 0; while (cond) { __builtin_amdgcn_s_sleep(1); \
    if ((++_sp & 255u) == 0u) { if (xb_ld(&(bar)[XB_TMO])) break; if (_sp > XB_SPIN_CAP) { atomicAdd(&(bar)[XB_TMO], 1u); break; } } } } while (0)

struct XcdBarrier {
    unsigned* bar; unsigned x;
    volatile LAS unsigned* st;
};

__device__ __forceinline__ XcdBarrier xcd_barrier_post(unsigned* bar, volatile LAS unsigned* st) {
    XcdBarrier b; b.bar = bar; b.x = xb_xcc_id(); b.st = st;
    if (threadIdx.x == 0) (void)xb_add(&bar[XB_XCNT(b.x)], 1u);
    return b;
}
__device__ __forceinline__ void xcd_barrier_complete(unsigned* bar, unsigned x, unsigned& nloc, unsigned& nx) {
    const unsigned G = gridDim.x * gridDim.y * gridDim.z;
    unsigned sum, cnt, mine, sp = 0u;
    for (;;) {
        sum = 0u; cnt = 0u; mine = 0u;
#pragma unroll
        for (unsigned j = 0; j < 16; ++j) { const unsigned c = xb_ld(&bar[XB_XCNT(j)]); sum += c; cnt += (c > 0u) ? 1u : 0u; mine = (j == x) ? c : mine; }
        if (sum == G) break;
        __builtin_amdgcn_s_sleep(1);
        if ((++sp & 255u) == 0u) { if (xb_ld(&bar[XB_TMO])) break; if (sp > XB_SPIN_CAP) { atomicAdd(&bar[XB_TMO], 1u); break; } }
    }
    nloc = mine > 0u ? mine : 1u; nx = cnt > 0u ? cnt : 1u;
}

__device__ __forceinline__ void xcd_barrier(const XcdBarrier& b) {
    asm volatile("s_waitcnt vmcnt(0)" ::: "memory");
    __syncthreads();
    if (threadIdx.x == 0) {
        unsigned* bar = b.bar;
        __builtin_amdgcn_s_waitcnt(0);
        unsigned nloc = b.st[0], nx = b.st[1];
        if (nloc == 0u) { xcd_barrier_complete(bar, b.x, nloc, nx); b.st[0] = nloc; b.st[1] = nx; }
#if EARLY_WB
        __builtin_amdgcn_fence(__ATOMIC_RELEASE, "agent");
        asm volatile("s_waitcnt vmcnt(0)" ::: "memory");
#endif
        const unsigned old = xb_add(&bar[XB_XSUB(b.x)], 1u);
        const unsigned gen = old / nloc;
        if (old + 1u == (gen + 1u) * nloc) {
            __builtin_amdgcn_fence(__ATOMIC_RELEASE, "agent");
            asm volatile("s_waitcnt vmcnt(0)" ::: "memory");
            const unsigned og = xb_add(&bar[XB_TOP], 1u);
            const unsigned tg = og / nx;
            if (og + 1u == (tg + 1u) * nx) xb_add(&bar[XB_TOPGEN], 1u);
            else XB_SPIN(xb_ld(&bar[XB_TOPGEN]) == tg, bar);
            __builtin_amdgcn_fence(__ATOMIC_ACQUIRE, "agent");
            xb_add(&bar[XB_XGEN(b.x)], 1u);
            asm volatile("s_waitcnt vmcnt(0)" ::: "memory");
        } else {
            XB_SPIN(xb_ld(&bar[XB_XGEN(b.x)]) == gen, bar);
            __builtin_amdgcn_fence(__ATOMIC_ACQUIRE, "agent");
            asm volatile("s_waitcnt vmcnt(0)" ::: "memory");
        }
    }
    __syncthreads();
}
__device__ __forceinline__ void ld_row_f32(const float* p, int lane, f32x4 (&v)[4]) {
#pragma unroll
    for (int j = 0; j < 4; ++j) v[j] = *(const f32x4*)(p + 256 * j + 4 * lane);
}
__device__ __forceinline__ void st_row_f32(float* p, int lane, const f32x4 (&v)[4]) {
#pragma unroll
    for (int j = 0; j < 4; ++j) *(f32x4*)(p + 256 * j + 4 * lane) = v[j];
}
__device__ __forceinline__ void ld_row_bf16(const bf16_t* p, int lane, f32x4 (&v)[4]) {
#pragma unroll
    for (int j = 0; j < 4; ++j) { const v2u w = *(const v2u*)(p + 256 * j + 4 * lane); v[j] = (f32x4){bflo(w.x), bfhi(w.x), bflo(w.y), bfhi(w.y)}; }
}
__device__ __forceinline__ void st_row_bf16(bf16_t* p, int lane, const f32x4 (&v)[4]) {
#pragma unroll
    for (int j = 0; j < 4; ++j) { v2u w; w.x = pk2(v[j].x, v[j].y); w.y = pk2(v[j].z, v[j].w); *(v2u*)(p + 256 * j + 4 * lane) = w; }
}
__device__ __forceinline__ void ld_vec_lds(LAS const float* p, int lane, f32x4 (&v)[4]) {
#pragma unroll
    for (int j = 0; j < 4; ++j) v[j] = *(LAS const f32x4*)(p + 256 * j + 4 * lane);
}
__device__ __forceinline__ float sumsq16(const f32x4 (&v)[4]) {
    float s = 0.f;
#pragma unroll
    for (int j = 0; j < 4; ++j) s += (v[j].x * v[j].x + v[j].y * v[j].y) + (v[j].z * v[j].z + v[j].w * v[j].w);
    return s;
}
__device__ __forceinline__ float modfin(const float* modp, const float* bmod, int l, int r, int n) {
    float s = bmod[l * 6144 + n];
#pragma unroll
    for (int kc = 0; kc < 8; ++kc) s += modp[((size_t)(l * 8 + kc) * 9 + r) * 6144 + n];
    return s;
}

#ifndef CV_G1
#define CV_G1 4
#endif
#ifndef CV_G2
#define CV_G2 6
#endif
#ifndef CV_M1
#define CV_M1 0
#endif
#ifndef CV_G3
#define CV_G3 4
#endif
#ifndef CV_G4
#define CV_G4 4
#endif
#ifndef CONV_M3
#define CONV_M3 2944
#endif
#ifndef CONV_IN_P0
#define CONV_IN_P0 1
#endif
__device__ __forceinline__ void tr_item64(const float* W, int N, int Nvalid, bf16_t* WT, int Kd, int k0, int n0, int dst_row0, LAS float* scr, int lane) {
    const int q = lane & 15, kr = lane >> 4;
    f32x4 t[16];
#pragma unroll
    for (int i = 0; i < 16; ++i) { const int kk = 4 * i + kr; const int n = n0 + 4 * q;
        t[i] = (n < Nvalid) ? *(const f32x4*)(W + (size_t)(k0 + kk) * N + n) : (f32x4){0.f, 0.f, 0.f, 0.f}; }
#pragma unroll
    for (int i = 0; i < 16; ++i) { const int kk = 4 * i + kr; LAS float* d = scr + kk * 65 + 4 * q; d[0] = t[i].x; d[1] = t[i].y; d[2] = t[i].z; d[3] = t[i].w; }
    const int c = lane & 7, nl = lane >> 3;
#pragma unroll
    for (int j = 0; j < 8; ++j) { const int n = nl + 8 * j; LAS const float* s = scr + (8 * c) * 65 + n;
        v4u o; o.x = pk2(s[0 * 65], s[1 * 65]); o.y = pk2(s[2 * 65], s[3 * 65]); o.z = pk2(s[4 * 65], s[5 * 65]); o.w = pk2(s[6 * 65], s[7 * 65]);
        *(v4u*)(WT + (size_t)(dst_row0 + n) * Kd + k0 + 8 * c) = o; }
}
__device__ __forceinline__ void expert_conv_item(const float* const* in, unsigned char* ws, int l, int r, LAS float* scr, int lane) {
    const float* w_gate = in[15]; const float* w_up = in[16]; const float* w_down = in[17];
    const int which = r >> 12; r &= 4095;
    const int e = r >> 8, kb = (r & 255) >> 4, nb = r & 15, n0 = 64 * nb;
    const size_t eoff = (size_t)(l * 16 + e) * 1024 * 1024;
    if (which == 0) tr_item64(w_gate + eoff, 1024, 1024, (bf16_t*)(ws + WS_WGU) + 2 * eoff, 1024, 64 * kb, n0, (n0 >> 7) * 256 + (n0 & 127), scr, lane);
    else if (which == 1) tr_item64(w_up + eoff, 1024, 1024, (bf16_t*)(ws + WS_WGU) + 2 * eoff, 1024, 64 * kb, n0, (n0 >> 7) * 256 + 128 + (n0 & 127), scr, lane);
    else tr_item64(w_down + eoff, 1024, 1024, (bf16_t*)(ws + WS_WD) + eoff, 1024, 64 * kb, n0, n0, scr, lane);
}
__device__ __forceinline__ void conv_pull(const float* const* in, unsigned char* ws, int l_lo, int l_hi, int budget, LAS float* scr, int lane) {
    for (int l = l_lo; l <= l_hi && l < 2; ++l) {
        unsigned* ctr = (unsigned*)(ws + WS_CTL) + CW_CONV + 64 * l;
        while (budget > 0) {
            const int c = budget < 8 ? budget : 8;
            unsigned r = 0; if (lane == 0) r = __hip_atomic_fetch_add(ctr, (unsigned)c, __ATOMIC_RELAXED, __HIP_MEMORY_SCOPE_AGENT);
            r = (unsigned)__builtin_amdgcn_readfirstlane((int)r);
            if (r >= 12288u) break;
            for (int k = 0; k < c && (int)r + k < 12288; ++k) expert_conv_item(in, ws, l, (int)r + k, scr, lane);
            budget -= c;
        }
    }
}
struct TrDesc { const float* src; bf16_t* dst; int N, Nvalid, k0, n0, drow; };
constexpr int TR_IN = 16 * 40, TR_OUT = 16 * 16, TR_E = 16 * 16 * 16, TR_L = TR_IN + TR_OUT + 3 * TR_E, TR_ALL = 2 * TR_L;
constexpr int CV_N1 = CV_G1 * 384, CV_N2 = CV_G2 * 1792, CV_N3 = CV_G3 * 1024, CV_N4 = CV_G4 * 1536;
constexpr int P0_A = TR_L - CV_N1 - CV_N2;
constexpr int P0_B = TR_ALL - CONV_M3 - CV_N3 - CV_N4;
static_assert(P0_A >= 896 && P0_B >= TR_L, "tail conversion budgets exceed the expert tiles");
__device__ __forceinline__ void tr_desc(const float* const* in, unsigned char* ws, int r, TrDesc& d) {
    const int l = r / TR_L; r -= l * TR_L;
    if (r < TR_IN) { const int kb = r / 40, nb = r % 40; d.src = in[7] + (size_t)l * 1024 * INW; d.dst = (bf16_t*)(ws + WS_WIN) + (size_t)l * PP * 1024; d.N = INW; d.Nvalid = INW; d.k0 = 64 * kb; d.n0 = 64 * nb; d.drow = 64 * nb; return; }
    r -= TR_IN;
    if (r < TR_OUT) { const int kb = r / 16, nb = r % 16; d.src = in[8] + (size_t)l * 1024 * 1024; d.dst = (bf16_t*)(ws + WS_WOUT) + (size_t)l * 1024 * 1024; d.N = 1024; d.Nvalid = 1024; d.k0 = 64 * kb; d.n0 = 64 * nb; d.drow = 64 * nb; return; }
    r -= TR_OUT;
    const int which = r >> 12; r &= 4095;
    const int e = r >> 8, kb = (r & 255) >> 4, nb = r & 15, n0 = 64 * nb;
    const size_t eoff = (size_t)(l * 16 + e) * 1024 * 1024;
    d.N = 1024; d.Nvalid = 1024; d.k0 = 64 * kb; d.n0 = n0;
    if (which == 0) { d.src = in[15] + eoff; d.dst = (bf16_t*)(ws + WS_WGU) + 2 * eoff; d.drow = (n0 >> 7) * 256 + (n0 & 127); }
    else if (which == 1) { d.src = in[16] + eoff; d.dst = (bf16_t*)(ws + WS_WGU) + 2 * eoff; d.drow = (n0 >> 7) * 256 + 128 + (n0 & 127); }
    else { d.src = in[17] + eoff; d.dst = (bf16_t*)(ws + WS_WD) + eoff; d.drow = n0; }
}
__device__ __forceinline__ void tr_load(const TrDesc& d, int lane, f32x4 (&t)[16]) {
    const int q = lane & 15, kr = lane >> 4, n = d.n0 + 4 * q;
    const float* p = d.src + (size_t)(d.k0 + kr) * d.N + (n < d.Nvalid ? n : 0);
#pragma unroll
    for (int i = 0; i < 16; ++i) t[i] = *(const f32x4*)(p + (size_t)(4 * i) * d.N);
}
__device__ __forceinline__ void tr_finish(const TrDesc& d, f32x4 (&t)[16], LAS float* scr, int lane) {
    const int q = lane & 15, kr = lane >> 4; const bool valid = (d.n0 + 4 * q) < d.Nvalid;
#pragma unroll
    for (int i = 0; i < 16; ++i) { const int kk = 4 * i + kr; LAS float* s = scr + kk * 65 + 4 * q; const f32x4 v = valid ? t[i] : (f32x4){0.f, 0.f, 0.f, 0.f}; s[0] = v.x; s[1] = v.y; s[2] = v.z; s[3] = v.w; }
    const int c = lane & 7, nl = lane >> 3;
#pragma unroll
    for (int j = 0; j < 8; ++j) { const int n = nl + 8 * j; LAS const float* s = scr + (8 * c) * 65 + n;
        v4u o; o.x = pk2(s[0 * 65], s[1 * 65]); o.y = pk2(s[2 * 65], s[3 * 65]); o.z = pk2(s[4 * 65], s[5 * 65]); o.w = pk2(s[6 * 65], s[7 * 65]);
        *(v4u*)(d.dst + (size_t)(d.drow + n) * 1024 + d.k0 + 8 * c) = o; }
}
__device__ __forceinline__ void tr_stream(const float* const* in, unsigned char* ws, int first, int stride, int hi, LAS float* scr, int lane, int cut = 1 << 30, int jump = 0) {
#define TR_ID(x) ((x) < cut ? (x) : (x) + jump)
    if (first >= hi) return;
    const int n_my = (hi - first + stride - 1) / stride;
    TrDesc dA, dB; f32x4 tA[16], tB[16];
    tr_desc(in, ws, TR_ID(first), dA); tr_load(dA, lane, tA);
    for (int i = 0; i < n_my; i += 2) {
        { const int nx = i + 1 < n_my ? i + 1 : n_my - 1; tr_desc(in, ws, TR_ID(first + nx * stride), dB); tr_load(dB, lane, tB); }
        tr_finish(dA, tA, scr, lane);
        if (i + 1 >= n_my) break;
        { const int nx = i + 2 < n_my ? i + 2 : n_my - 1; tr_desc(in, ws, TR_ID(first + nx * stride), dA); tr_load(dA, lane, tA); }
        tr_finish(dB, tB, scr, lane);
    }
#undef TR_ID
}
__device__ __forceinline__ void phase_p0(const float* const* in, unsigned char* ws, LAS unsigned char* wl, int gw, int NGW, int lane) {
    const float* cvec = in[1]; const float* cctx = in[3]; const float* wmod = in[4];
    const float* w_in = in[7]; const float* w_out = in[8];
    float* modp = (float*)(ws + WS_MODP);
    constexpr int NI_MOD = 2 * 8 * 24, NI_ROPE = 16;
    constexpr int NI_IN = 16 * 40, NI_OUT = 16 * 16, NI_E = 16 * 16 * 16;
    constexpr int NI_L = NI_IN + NI_OUT + (CONV_IN_P0 ? 3 * NI_E : 0);
    constexpr int NITEMS = NI_MOD + NI_ROPE + 2 * NI_L;
    LAS float* scr = (LAS float*)wl;
    for (int it = gw; it < NI_MOD + NI_ROPE; it += NGW) {
        int r = it;
        if (r < NI_MOD) {
            const int cb = r % 24, kc = (r / 24) & 7, l = r / 192;
            for (int idx = lane; idx < 128 * 9; idx += 64) { const int rr = idx / 128, k = idx % 128; const float cv = (rr < 8) ? cvec[rr * 1024 + kc * 128 + k] : cctx[kc * 128 + k]; scr[k * 12 + rr] = silu_f(cv); }
            f32x4 acc[9];
#pragma unroll
            for (int rr = 0; rr < 9; ++rr) acc[rr] = (f32x4){0.f, 0.f, 0.f, 0.f};
            const float* wp = wmod + ((size_t)l * 1024 + kc * 128) * 6144 + cb * 256 + 4 * lane;
#pragma unroll 4
            for (int k = 0; k < 128; ++k) { const f32x4 w = *(const f32x4*)(wp + (size_t)k * 6144);
                const f32x4 s0 = *(LAS const f32x4*)(scr + k * 12), s1 = *(LAS const f32x4*)(scr + k * 12 + 4); const float s8 = scr[k * 12 + 8];
                acc[0] += w * s0.x; acc[1] += w * s0.y; acc[2] += w * s0.z; acc[3] += w * s0.w; acc[4] += w * s1.x; acc[5] += w * s1.y; acc[6] += w * s1.z; acc[7] += w * s1.w; acc[8] += w * s8; }
#pragma unroll
            for (int rr = 0; rr < 9; ++rr) *(f32x4*)(modp + ((size_t)(l * 8 + kc) * 9 + rr) * 6144 + cb * 256 + 4 * lane) = acc[rr];
            continue;
        }
        r -= NI_MOD;
        if (r < NI_ROPE) {
            const int id = r * 64 + lane, pos = id >> 4, i = id & 15;
            const float fr = fexp2(-(float)i * (13.287712379549449f / 16.f));
            float rev = (float)pos * fr * 0.15915494309189535f; rev -= floorf(rev);
            f32x2 cs; cs.x = __builtin_amdgcn_cosf(rev); cs.y = __builtin_amdgcn_sinf(rev);
            ((f32x2*)(ws + WS_TAB))[id] = cs;
            continue;
        }
        break;
    }
    if (NGW == 2048) tr_stream(in, ws, (gw + NGW - (NI_MOD + NI_ROPE)) % NGW, NGW, P0_A + (P0_B - TR_L), scr, lane, P0_A, TR_L - P0_A);
    else tr_stream(in, ws, gw, NGW, TR_ALL, scr, lane);
}

__device__ __forceinline__ void phase_a0(const float* const* in, unsigned char* ws, LAS unsigned char* lds, int G, int tid, int wave, int lane) {
    const float* x = in[0]; const float* ctx = in[2]; const float* bmod = in[5]; const float* gains = in[6];
    const float* modp = (const float*)(ws + WS_MODP); float* mod = (float*)(ws + WS_MOD); bf16_t* H = (bf16_t*)(ws + WS_H);
    LAS float* V = (LAS float*)lds;
    for (int row = blockIdx.x; row < 18; row += G) { const int l = row / 9, r = row % 9;
        for (int n = tid; n < 6144; n += 512) mod[(size_t)row * 6144 + n] = modfin(modp, bmod, l, r, n); }
    for (int t = blockIdx.x; t < 256; t += G) {
        const int b = t >> 5;
        __syncthreads();
        for (int n = tid; n < 1024; n += 512) { const float g = gains[n];
            V[n] = g * (1.f + modfin(modp, bmod, 0, b, 1024 + n)); V[1024 + n] = modfin(modp, bmod, 0, b, n);
            V[2048 + n] = g * (1.f + modfin(modp, bmod, 0, 8, 1024 + n)); V[3072 + n] = modfin(modp, bmod, 0, 8, n); }
        __syncthreads();
#pragma unroll 1
        for (int i0 = 0; i0 < 9; i0 += 3) {
            f32x4 xq[3][4];
#pragma unroll
            for (int k = 0; k < 3; ++k) { const int i = i0 + k; const bool isc = (i == 8);
                const float* src = isc ? (ctx + (size_t)(8 * t + wave) * 1024) : (x + (size_t)(64 * t + 8 * wave + i) * 1024); ld_row_f32(src, lane, xq[k]); }
#pragma unroll
            for (int k = 0; k < 3; ++k) { const int i = i0 + k; const bool isc = (i == 8);
                const int row = isc ? (ML + 8 * t + wave) : (64 * t + 8 * wave + i);
                f32x4 (&v)[4] = xq[k]; f32x4 a[4], s[4];
                const float rstd = __builtin_amdgcn_rsqf(wave_sum(sumsq16(v)) * (1.f / 1024.f) + NEPS);
                ld_vec_lds(V + (isc ? 2048 : 0), lane, a); ld_vec_lds(V + (isc ? 3072 : 1024), lane, s);
#pragma unroll
                for (int j = 0; j < 4; ++j) v[j] = v[j] * rstd * a[j] + s[j];
                st_row_bf16(H + (size_t)row * 1024, lane, v);
            }
        }
    }
}
constexpr int VP = 192;
struct AttnTile { f32x16 o0, o1; float m, lsum; };
__device__ __forceinline__ void attn_softmax(f32x16& s, AttnTile& T) {
    float bm = fmaxf(fmaxf(s[0], s[1]), fmaxf(s[2], s[3]));
#pragma unroll
    for (int i = 4; i < 16; i += 4) bm = fmaxf(bm, fmaxf(fmaxf(s[i], s[i + 1]), fmaxf(s[i + 2], s[i + 3])));
    bm = fmaxf(bm, __shfl_xor(bm, 32));
    const float mo = T.m, mn = fmaxf(mo, bm);
    T.m = mn;
    float ps = 0.f;
#pragma unroll
    for (int i = 0; i < 16; ++i) { s[i] = fexp2(s[i] - mn); ps += s[i]; }
    if (__any(mn != mo)) {
        const float alpha = fexp2(mo - mn);
        T.lsum *= alpha;
#pragma unroll
        for (int i = 0; i < 16; ++i) { T.o0[i] *= alpha; T.o1[i] *= alpha; }
    }
    T.lsum += ps;
}
__device__ __forceinline__ void attn_item(const int MODE, const bf16_t* P, bf16_t* MIX, int item, LAS unsigned char* wl, int lane,
                                          const float* __restrict__ rpb, const float* __restrict__ sink, const bool dry = false) {
    asm volatile("" : "+v"(lane));
    const int ql = lane & 31, hi = lane >> 5;
    int b, hq, qcol, kcol, vcol, ocol, qrow0, r = 0, rs = 0, q64 = 0, nloc, kb_lo = 0;
    if (MODE == 0) { r = item & 31; hq = (item >> 5) & 3; b = item >> 7;
        qcol = C_NQ + hq * 64; kcol = C_NK + hq * 64; vcol = C_NV + hq * 64; ocol = 256 + hq * 64; qrow0 = b * SEQ + r * 64;
        rs = r - 4; rs = rs < 0 ? 0 : (rs > 24 ? 24 : rs); nloc = 16; }
    else if (MODE == 1) { q64 = item & 31; hq = (item >> 5) & 7; b = item >> 8;
        qcol = C_SQ + hq * 64; kcol = C_SK + (hq >> 2) * 64; vcol = C_SV + (hq >> 2) * 64; ocol = 512 + hq * 64; qrow0 = b * SEQ + q64 * 64;
        kb_lo = 2 * q64 - 4; if (kb_lo < 0) kb_lo = 0; int kb_hi = 2 * q64 + 5; if (kb_hi > 63) kb_hi = 63; nloc = kb_hi - kb_lo + 1; }
    else if (MODE == 2) { q64 = item & 3; hq = (item >> 2) & 3; b = item >> 4;
        qcol = C_NQ + hq * 64; kcol = C_NK + hq * 64; vcol = C_NV + hq * 64; ocol = 256 + hq * 64; qrow0 = ML + b * CTXL + q64 * 64; nloc = 0; }
    else { q64 = item & 3; hq = (item >> 2) & 7; b = item >> 5;
        qcol = C_SQ + hq * 64; kcol = C_SK + (hq >> 2) * 64; vcol = C_SV + (hq >> 2) * 64; ocol = 512 + hq * 64; qrow0 = ML + b * CTXL + q64 * 64; nloc = 0; }
    const int nblk = 8 + nloc;
    LAS unsigned char* vl = wl;
    LAS float* rl = (LAS float*)(wl + 32 * VP);
    if (MODE == 0) { for (int i = lane; i < 465; i += 64) rl[i] = rpb[hq * 465 + i] * LOG2E; }
    LAS unsigned char* qimg = wl + 32 * VP + 1920;
    constexpr int QP = 144;
#pragma unroll
    for (int i = 0; i < 8; ++i) { const int c = lane + 64 * i; const v4u v = *(const v4u*)(P + (size_t)(qrow0 + (c >> 3)) * PP + qcol + (c & 7) * 8); *(LAS v4u*)(qimg + (c >> 3) * QP + (c & 7) * 16) = v; }
    LAS const unsigned char* qrd = qimg + ql * QP + 16 * hi;
    auto blk_row0 = [&](int blk) -> int {
        if (blk < 8) return ML + b * CTXL + blk * 32;
        const int lb = blk - 8;
        if (MODE == 0) return b * SEQ + (rs + (lb >> 1)) * 64 + (lb & 1) * 32;
        return b * SEQ + 32 * (kb_lo + lb);
    };
    auto load_blk = [&](int blk, bf16x8 (&kn)[4], v4u (&vn)[4]) {
        const int r0 = blk_row0(blk);
        const bf16_t* kp = P + (size_t)(r0 + ql) * PP + kcol + 8 * hi;
#pragma unroll
        for (int ds = 0; ds < 4; ++ds) kn[ds] = *(const bf16x8*)(kp + 16 * ds);
#pragma unroll
        for (int i = 0; i < 4; ++i) { const int c = lane + 64 * i; vn[i] = *(const v4u*)(P + (size_t)(r0 + (c >> 3)) * PP + vcol + (c & 7) * 8); }
    };
    AttnTile T[2];
#pragma unroll
    for (int t = 0; t < 2; ++t) { T[t].m = -INFINITY; T[t].lsum = 0.f;
#pragma unroll
        for (int i = 0; i < 16; ++i) { T[t].o0[i] = 0.f; T[t].o1[i] = 0.f; } }
    const int tr_off = (4 * hi + ((lane & 15) >> 2)) * VP + (16 * ((lane >> 4) & 1) + 4 * (lane & 3)) * 2;
    auto step = [&](int blk, bf16x8 (&kf)[4], v4u (&vr)[4]) {
#pragma unroll
        for (int i = 0; i < 4; ++i) { const int c = lane + 64 * i; *(LAS v4u*)(vl + (c >> 3) * VP + (c & 7) * 16) = vr[i]; }
        f32x16 sc[2];
#pragma unroll
        for (int t = 0; t < 2; ++t) {
#pragma unroll
            for (int i = 0; i < 16; ++i) sc[t][i] = 0.f;
#pragma unroll
            for (int ds = 0; ds < 4; ++ds) sc[t] = MFMA32(kf[ds], *(LAS const bf16x8*)(qrd + 32 * t * QP + 32 * ds), sc[t]);
        }
        if (blk + 2 < nblk) load_blk(blk + 2, kf, vr);
        bf16x8 vf[2][2];
#pragma unroll
        for (int ks = 0; ks < 2; ++ks) { LAS const unsigned char* vb = vl + tr_off + 16 * ks * VP;
            vf[ks][0] = cat4(tr_read(vb), tr_read(vb + 8 * VP)); vf[ks][1] = cat4(tr_read(vb + 64), tr_read(vb + 8 * VP + 64)); }
#pragma unroll
        for (int t = 0; t < 2; ++t) {
            f32x16& s = sc[t];
            if (MODE == 0 && blk >= 8) {
                const int lb = blk - 8, j = lb >> 1, ch = lb & 1, c = t * 32 + ql;
                int cs = c - 8; cs = cs < 0 ? 0 : (cs > 48 ? 48 : cs);
                LAS const float* rrow = rl + (rs + j - r + 7) * 31 + (15 - c);
#pragma unroll
                for (int i = 0; i < 16; ++i) { const int kc = ch * 32 + crow(i, hi); const bool ok = (kc >= cs) && (kc < cs + 16);
                    const float bias = rrow[ok ? kc : c];
                    s[i] = ok ? (s[i] + bias) : -INFINITY; }
            } else if (MODE == 1 && blk >= 8) {
                const int rel = (kb_lo + blk - 8) - (2 * q64 + t);
                if (rel <= -4 || rel >= 4) {
#pragma unroll
                    for (int i = 0; i < 16; ++i) { const int kk = crow(i, hi); const bool ok = (rel == -4) ? (kk >= ql) : ((rel == 4) ? (kk <= ql) : false);
                        s[i] = ok ? s[i] : -INFINITY; }
                }
            }
            attn_softmax(s, T[t]);
#pragma unroll
            for (int ks = 0; ks < 2; ++ks) {
                const bf16x8 pf = pack8(s[8 * ks + 0], s[8 * ks + 1], s[8 * ks + 2], s[8 * ks + 3], s[8 * ks + 4], s[8 * ks + 5], s[8 * ks + 6], s[8 * ks + 7]);
                T[t].o0 = MFMA32(vf[ks][0], pf, T[t].o0); T[t].o1 = MFMA32(vf[ks][1], pf, T[t].o1);
            }
            __builtin_amdgcn_sched_barrier(0);
        }
    };
    bf16x8 kA[4], kB[4]; v4u vA[4], vB[4];
    load_blk(0, kA, vA); load_blk(1, kB, vB);
    for (int blk = 0; blk < nblk; blk += 2) { step(blk, kA, vA); if (blk + 1 < nblk) step(blk + 1, kB, vB); }
#pragma unroll
    for (int t = 0; t < 2; ++t) {
        float lt = T[t].lsum + __shfl_xor(T[t].lsum, 32);
        if (MODE == 1 || MODE == 3) lt += fexp2(sink[hq] * LOG2E - T[t].m);
        const float inv = frcp(lt);
        bf16_t* op = MIX + (size_t)(qrow0 + 32 * t + ql) * 1024 + ocol + 4 * hi;
#pragma unroll
        for (int g = 0; g < 4; ++g) {
            v2u w0, w1; w0.x = pk2(T[t].o0[4 * g] * inv, T[t].o0[4 * g + 1] * inv); w0.y = pk2(T[t].o0[4 * g + 2] * inv, T[t].o0[4 * g + 3] * inv);
            w1.x = pk2(T[t].o1[4 * g] * inv, T[t].o1[4 * g + 1] * inv); w1.y = pk2(T[t].o1[4 * g + 2] * inv, T[t].o1[4 * g + 3] * inv);
            *(v2u*)(op + 8 * g) = w0; *(v2u*)(op + 32 + 8 * g) = w1;
        }
    }
}
constexpr int GP = 144;
constexpr int G_V = 0, G_A = 64 * GP, G_B = 64 * GP + 32 * GP;
static_assert(G_B + 32 * GP <= WAVE_LDS, "gla LDS");

struct GlaCum { float cum[2][16]; float tot; };
__device__ __forceinline__ void gla_cum(const bf16_t* P, int row0, int hh, int dir, const float* __restrict__ a_up, const float* __restrict__ a_bias, int lane, GlaCum& C) {
    const int kk = lane & 31, hi = lane >> 5;
    const float* up = a_up + (size_t)dir * 16 * 128 + (size_t)(8 * hi) * 128 + hh * 32 + kk;
    const bf16x8 ub = pack8(up[0], up[128], up[256], up[384], up[512], up[640], up[768], up[896]);
    const float bias = a_bias[dir * 128 + hh * 32 + kk];
    float gs[2][4];
#pragma unroll
    for (int tt = 0; tt < 2; ++tt) {
        const bf16x8 al = *(const bf16x8*)(P + (size_t)(row0 + 32 * tt + kk) * PP + C_GAF + 16 * dir + 8 * hi);
        f32x16 z;
#pragma unroll
        for (int i = 0; i < 16; ++i) z[i] = 0.f;
        z = MFMA32(al, ub, z);
#pragma unroll
        for (int g = 0; g < 4; ++g) { float run = 0.f;
#pragma unroll
            for (int e = 0; e < 4; ++e) { const float zz = z[4 * g + e] + bias; const float ls = fminf(zz, 0.f) - flog(1.f + fexp(-fabsf(zz)));
                const float l = ls * (1.f / 16.f);
                if (dir == 0) { run += l; C.cum[tt][4 * g + e] = run; } else { C.cum[tt][4 * g + e] = run; run += l; } }
            gs[tt][g] = run; }
    }
    float off = 0.f;
#pragma unroll
    for (int tt = 0; tt < 2; ++tt)
#pragma unroll
        for (int g = 0; g < 4; ++g) { const float other = __shfl_xor(gs[tt][g], 32); const float mine = off + (hi ? other : 0.f);
#pragma unroll
            for (int e = 0; e < 4; ++e) C.cum[tt][4 * g + e] += mine;
            off += gs[tt][g] + other; }
    C.tot = off;
    if (dir == 1) {
#pragma unroll
        for (int tt = 0; tt < 2; ++tt)
#pragma unroll
            for (int r = 0; r < 16; ++r) C.cum[tt][r] = off - C.cum[tt][r];
    }
}
__device__ __forceinline__ void gla_ld_tc(const bf16_t* P, int row0, int col, int lane, float (&x)[2][16]) {
    const int kk = lane & 31, hi = lane >> 5;
#pragma unroll
    for (int tt = 0; tt < 2; ++tt)
#pragma unroll
        for (int r = 0; r < 16; ++r) x[tt][r] = bf1(P[(size_t)(row0 + 32 * tt + crow(r, hi)) * PP + col + kk]);
}
__device__ __forceinline__ void gla_st_img(LAS unsigned char* img, int lane, const float (&x)[2][16]) {
    const int kk = lane & 31, hi = lane >> 5;
#pragma unroll
    for (int tt = 0; tt < 2; ++tt)
#pragma unroll
        for (int g = 0; g < 4; ++g) { v2u w; w.x = pk2(x[tt][4 * g], x[tt][4 * g + 1]); w.y = pk2(x[tt][4 * g + 2], x[tt][4 * g + 3]);
            *(LAS v2u*)(img + kk * GP + (32 * tt + 8 * g + 4 * hi) * 2) = w; }
}
__device__ __forceinline__ void gla_stage_v(const bf16_t* P, int row0, int hh, LAS unsigned char* wl, int lane) {
#pragma unroll
    for (int i = 0; i < 8; ++i) { const int c = lane + 64 * i; const v4u v = *(const v4u*)(P + (size_t)(row0 + (c >> 3)) * PP + C_GV + hh * 64 + (c & 7) * 8);
        *(LAS v4u*)(wl + G_V + (c >> 3) * GP + (c & 7) * 16) = v; }
}
__device__ __forceinline__ int gla_row0(int b, int nc) { return nc < 4 ? (ML + b * CTXL + 64 * nc) : (b * SEQ + 64 * (nc - 4)); }

__device__ __forceinline__ void gla_local_item(const bf16_t* P, float* UST, float* DEC, int item, LAS unsigned char* wl, int lane,
                                               const float* __restrict__ a_up, const float* __restrict__ a_bias) {
    asm volatile("" : "+v"(lane));
    const int nc = item % 36, hh = (item / 36) & 3, b = item / 144;
    const int row0 = gla_row0(b, nc), kk = lane & 31, hi = lane >> 5;
    gla_stage_v(P, row0, hh, wl, lane);
    float kv[2][16]; gla_ld_tc(P, row0, C_GK + hh * 32, lane, kv);
#pragma unroll
    for (int dir = 0; dir < 2; ++dir) {
        GlaCum C; gla_cum(P, row0, hh, dir, a_up, a_bias, lane, C);
        float kd[2][16];
#pragma unroll
        for (int tt = 0; tt < 2; ++tt)
#pragma unroll
            for (int r = 0; r < 16; ++r) kd[tt][r] = kv[tt][r] * fexp(C.tot - C.cum[tt][r]);
        gla_st_img(wl + (dir == 0 ? G_A : G_B), lane, kd);
        if (hi == 0) DEC[((size_t)((b * 4 + hh) * 2 + dir) * 36 + nc) * 32 + kk] = fexp(C.tot);
    }
    const int trv = ((lane & 15) >> 2) * GP + (16 * ((lane >> 4) & 1) + 4 * (lane & 3)) * 2;
#pragma unroll
    for (int dir = 0; dir < 2; ++dir) {
        f32x16 u0, u1;
#pragma unroll
        for (int i = 0; i < 16; ++i) { u0[i] = 0.f; u1[i] = 0.f; }
        LAS const unsigned char* img = wl + (dir == 0 ? G_A : G_B);
#pragma unroll
        for (int s = 0; s < 4; ++s) {
            const bf16x8 kb = *(LAS const bf16x8*)(img + kk * GP + (16 * s + 8 * hi) * 2);
            LAS const unsigned char* vb = wl + G_V + trv + (16 * s + 8 * hi) * GP;
            const bf16x8 v0 = cat4(tr_read(vb), tr_read(vb + 4 * GP));
            const bf16x8 v1 = cat4(tr_read(vb + 64), tr_read(vb + 4 * GP + 64));
            u0 = MFMA32(v0, kb, u0); u1 = MFMA32(v1, kb, u1);
        }
        float* up = UST + ((size_t)((b * 4 + hh) * 2 + dir) * 36 + nc) * 2048 + kk;
#pragma unroll
        for (int i = 0; i < 16; ++i) { up[(size_t)crow(i, hi) * 32] = u0[i]; up[(size_t)(32 + crow(i, hi)) * 32] = u1[i]; }
    }
}

__device__ __forceinline__ void gla_prefix(float* UST, const float* DEC, int gid, bool dry) {
    const int bhd = gid >> 11, e = gid & 2047, k = e & 31, dir = bhd & 1;
    float* base = UST + (size_t)bhd * 36 * 2048 + e; const float* dec = DEC + (size_t)bhd * 36 * 32 + k;
    float s = 0.f;
#pragma unroll 4
    for (int ci = 0; ci < 36; ++ci) {
        const int sl = dir == 0 ? ci : (ci < 4 ? 3 - ci : 39 - ci);
        const float u = base[(size_t)sl * 2048], d = dec[sl * 32];
        if (!dry) base[(size_t)sl * 2048] = s;
        s = d * s + u;
    }
}

__device__ __forceinline__ void gla_out_item(const bf16_t* P, const float* UST, bf16_t* MIX, int item, LAS unsigned char* wl, int lane,
                                             const float* __restrict__ a_up, const float* __restrict__ a_bias, const float* __restrict__ gnorm) {
    const int nc = item % 36, hh = (item / 36) & 3, b = item / 144;
    const int row0 = gla_row0(b, nc), kk = lane & 31, hi = lane >> 5;
    gla_stage_v(P, row0, hh, wl, lane);
    f32x16 o[2][2];
#pragma unroll
    for (int a = 0; a < 2; ++a)
#pragma unroll
        for (int c = 0; c < 2; ++c)
#pragma unroll
            for (int i = 0; i < 16; ++i) o[a][c][i] = 0.f;
    unsigned qp[2][8], kp[2][8];
#pragma unroll
    for (int tt = 0; tt < 2; ++tt) {
#pragma unroll
        for (int g = 0; g < 4; ++g)
#pragma unroll
            for (int e2 = 0; e2 < 2; ++e2) { const size_t ro = (size_t)(row0 + 32 * tt + 8 * g + 4 * hi + 2 * e2) * PP + hh * 32 + kk;
                qp[tt][2 * g + e2] = (unsigned)P[ro + C_GQ] | ((unsigned)P[ro + PP + C_GQ] << 16); kp[tt][2 * g + e2] = (unsigned)P[ro + C_GK] | ((unsigned)P[ro + PP + C_GK] << 16); }
        asm volatile("" ::: "memory");
    }
    const int g16 = (lane >> 4) & 1, qq = (lane & 15) >> 2, pp = lane & 3;
    const int tri = (8 * hi + qq) * GP + (16 * g16 + 4 * pp) * 2;
    const int trv = (4 * hi + qq) * GP + (16 * g16 + 4 * pp) * 2;
#pragma unroll
    for (int dir = 0; dir < 2; ++dir) {
        GlaCum C; gla_cum(P, row0, hh, dir, a_up, a_bias, lane, C);
#pragma unroll
        for (int tt = 0; tt < 2; ++tt) {
            float cum[16];
#pragma unroll
            for (int r = 0; r < 16; ++r) cum[r] = C.cum[tt][r];
#pragma unroll
            for (int g = 0; g < 4; ++g) {
                float xq[4], xk[4];
#pragma unroll
                for (int e = 0; e < 4; ++e) { const unsigned qw = qp[tt][2 * g + (e >> 1)], kw = kp[tt][2 * g + (e >> 1)];
                    xq[e] = ((e & 1) ? bfhi(qw) : bflo(qw)) * 0.17677669529663687f * fexp(cum[4 * g + e]); xk[e] = ((e & 1) ? bfhi(kw) : bflo(kw)) * fexp(-cum[4 * g + e]); }
                v2u wq, wk; wq.x = pk2(xq[0], xq[1]); wq.y = pk2(xq[2], xq[3]); wk.x = pk2(xk[0], xk[1]); wk.y = pk2(xk[2], xk[3]);
                const int off = kk * GP + (32 * tt + 8 * g + 4 * hi) * 2;
                *(LAS v2u*)(wl + G_A + off) = wq; *(LAS v2u*)(wl + G_B + off) = wk;
            }
        }
        const float* sp = UST + ((size_t)((b * 4 + hh) * 2 + dir) * 36 + nc) * 2048;
        bf16x8 sf[2][2];
#pragma unroll
        for (int vb = 0; vb < 2; ++vb)
#pragma unroll
            for (int s = 0; s < 2; ++s) { const float* p = sp + (size_t)(32 * vb + kk) * 32 + 16 * s + 8 * hi; const f32x4 a = *(const f32x4*)p, c = *(const f32x4*)(p + 4);
                sf[vb][s] = pack8(a.x, a.y, a.z, a.w, c.x, c.y, c.z, c.w); }
#pragma unroll
        for (int it = 0; it < 2; ++it) {
            bf16x8 qf[2];
#pragma unroll
            for (int s = 0; s < 2; ++s) { LAS const unsigned char* p = wl + G_A + tri + 16 * s * GP + 64 * it; qf[s] = cat4(tr_read(p), tr_read(p + 4 * GP)); }
#pragma unroll
            for (int vb = 0; vb < 2; ++vb)
#pragma unroll
                for (int s = 0; s < 2; ++s) o[vb][it] = MFMA32(sf[vb][s], qf[s], o[vb][it]);
#pragma unroll
            for (int jt = 0; jt < 2; ++jt) {
                if (dir == 0 ? (jt > it) : (jt < it)) continue;
                f32x16 sc;
#pragma unroll
                for (int i = 0; i < 16; ++i) sc[i] = 0.f;
#pragma unroll
                for (int s = 0; s < 2; ++s) { LAS const unsigned char* p = wl + G_B + tri + 16 * s * GP + 64 * jt; const bf16x8 kf = cat4(tr_read(p), tr_read(p + 4 * GP)); sc = MFMA32(kf, qf[s], sc); }
                if (jt == it) {
#pragma unroll
                    for (int i = 0; i < 16; ++i) { const int j = crow(i, hi); const bool ok = dir == 0 ? (j <= kk) : (j >= kk); sc[i] = ok ? sc[i] : 0.f; }
                }
#pragma unroll
                for (int s2 = 0; s2 < 2; ++s2) {
                    const bf16x8 pf = pack8(sc[8 * s2 + 0], sc[8 * s2 + 1], sc[8 * s2 + 2], sc[8 * s2 + 3], sc[8 * s2 + 4], sc[8 * s2 + 5], sc[8 * s2 + 6], sc[8 * s2 + 7]);
                    LAS const unsigned char* vp = wl + G_V + trv + (32 * jt + 16 * s2) * GP;
                    const bf16x8 v0 = cat4(tr_read(vp), tr_read(vp + 8 * GP));
                    const bf16x8 v1 = cat4(tr_read(vp + 64), tr_read(vp + 8 * GP + 64));
                    o[0][it] = MFMA32(v0, pf, o[0][it]); o[1][it] = MFMA32(v1, pf, o[1][it]);
                }
                __builtin_amdgcn_sched_barrier(0);
            }
            __builtin_amdgcn_sched_barrier(0);
        }
    }
#pragma unroll
    for (int it = 0; it < 2; ++it) {
        float ss = 0.f;
#pragma unroll
        for (int vb = 0; vb < 2; ++vb)
#pragma unroll
            for (int i = 0; i < 16; ++i) ss += o[vb][it][i] * o[vb][it][i];
        ss += __shfl_xor(ss, 32);
        const float rstd = __builtin_amdgcn_rsqf(ss * (1.f / 64.f) + NEPS);
        const size_t row = (size_t)(row0 + 32 * it + kk);
#pragma unroll
        for (int vb = 0; vb < 2; ++vb)
#pragma unroll
            for (int g = 0; g < 4; ++g) { const int v = 32 * vb + 8 * g + 4 * hi;
                const f32x4 gn = *(const f32x4*)(gnorm + v); const v2u gw = *(const v2u*)(P + row * PP + C_GG + hh * 64 + v);
                const float g0 = bflo(gw.x), g1 = bfhi(gw.x), g2 = bflo(gw.y), g3 = bfhi(gw.y);
                v2u w; w.x = pk2(o[vb][it][4 * g] * rstd * gn.x * silu_f(g0), o[vb][it][4 * g + 1] * rstd * gn.y * silu_f(g1));
                w.y = pk2(o[vb][it][4 * g + 2] * rstd * gn.z * silu_f(g2), o[vb][it][4 * g + 3] * rstd * gn.w * silu_f(g3));
                *(v2u*)(MIX + row * 1024 + hh * 64 + v) = w; }
    }
}
__device__ __forceinline__ void phase_r1(const float* const* in, float* xout, unsigned char* ws, LAS unsigned char* lds, int l, bool upd, int G, int tid, int wave, int lane, bool dry) {
    const float* x0 = in[0]; const float* ctx0 = in[2]; const float* gains = in[6] + (size_t)l * 4096; const float* wr = in[14] + (size_t)l * 1024 * 16;
    const float* mod = (const float*)(ws + WS_MOD) + (size_t)l * 9 * 6144;
    const bf16_t* Y = (const bf16_t*)(ws + WS_R2 + (size_t)MT * 2048); bf16_t* H = (bf16_t*)(ws + WS_H); bf16_t* XB = (bf16_t*)(ws + WS_XB);
    float* AFF = (float*)(ws + WS_AFF); float* AFFC = (float*)(ws + WS_AFFC);
    LAS float* V = (LAS float*)lds;
    LAS float* RT = V + 6144;
    __syncthreads();
    constexpr int RTP = 1028;
    for (int i = tid; i < 16384; i += 512) { const int d = i >> 4, e = i & 15; RT[e * RTP + d] = wr[i]; }
    for (int t = blockIdx.x; t < 256; t += G) {
        const int b = t >> 5;
        __syncthreads();
        for (int n = tid; n < 1024; n += 512) { const float gpa = gains[1024 + n], gpf = gains[2048 + n];
            V[n] = gpa * mod[b * 6144 + 2048 + n]; V[1024 + n] = gpf * (1.f + mod[b * 6144 + 4096 + n]); V[2048 + n] = mod[b * 6144 + 3072 + n];
            V[3072 + n] = gpa * mod[8 * 6144 + 2048 + n]; V[4096 + n] = gpf * (1.f + mod[8 * 6144 + 4096 + n]); V[5120 + n] = mod[8 * 6144 + 3072 + n]; }
        __syncthreads();
        const int nrows = upd ? 9 : 8;
#pragma unroll 1
        for (int i0 = 0; i0 < 9; i0 += 3) {
            f32x4 yv[3][4], xq[3][4];
#pragma unroll
            for (int k = 0; k < 3; ++k) { const int i = (i0 + k < nrows) ? (i0 + k) : 7;
                const bool isc = (i == 8); const int row = isc ? (ML + 8 * t + wave) : (64 * t + 8 * wave + i);
                ld_row_bf16(Y + (size_t)row * 1024, lane, yv[k]);
                if (l == 0) ld_row_f32(isc ? (ctx0 + (size_t)(8 * t + wave) * 1024) : (x0 + (size_t)row * 1024), lane, xq[k]); else ld_row_bf16(XB + (size_t)row * 1024, lane, xq[k]); }
#pragma unroll
            for (int k = 0; k < 3; ++k) { const bool act = (i0 + k < nrows); const int i = act ? (i0 + k) : 7;
            const bool isc = (i == 8);
            const int row = isc ? (ML + 8 * t + wave) : (64 * t + 8 * wave + i);
            bf16_t* xd = (dry ? (bf16_t*)(ws + WS_R1) : XB) + (size_t)row * 1024;
            LAS const float* vv = V + (isc ? 3072 : 0);
            f32x4 (&y)[4] = yv[k]; f32x4 (&xv)[4] = xq[k]; f32x4 a[4];
            const float rsy = __builtin_amdgcn_rsqf(wave_sum(sumsq16(y)) * (1.f / 1024.f) + NEPS);
            ld_vec_lds(vv, lane, a);
#pragma unroll
            for (int j = 0; j < 4; ++j) xv[j] = xv[j] + a[j] * (y[j] * rsy);
            if (act) st_row_bf16(xd, lane, xv);
            const float rs1 = __builtin_amdgcn_rsqf(wave_sum(sumsq16(xv)) * (1.f / 1024.f) + NEPS);
            f32x4 s[4]; ld_vec_lds(vv + 1024, lane, a); ld_vec_lds(vv + 2048, lane, s);
#pragma unroll
            for (int j = 0; j < 4; ++j) xv[j] = xv[j] * rs1 * a[j] + s[j];
            if (act) st_row_bf16((dry ? (bf16_t*)(ws + WS_R2) : H) + (size_t)row * 1024, lane, xv);
            }
            float lg3[3][16];
#pragma unroll
            for (int e = 0; e < 16; ++e) { f32x2 pa[3];
#pragma unroll
                for (int k = 0; k < 3; ++k) pa[k] = (f32x2){0.f, 0.f};
#pragma unroll
                for (int j = 0; j < 4; ++j) { const f32x4 w = *(LAS const f32x4*)(RT + e * RTP + 256 * j + 4 * lane); const f32x2 wl = {w.x, w.y}, wh = {w.z, w.w};
#pragma unroll
                    for (int k = 0; k < 3; ++k) { pa[k] += (f32x2){xq[k][j].x, xq[k][j].y} * wl; pa[k] += (f32x2){xq[k][j].z, xq[k][j].w} * wh; } }
#pragma unroll
                for (int k = 0; k < 3; ++k) lg3[k][e] = pa[k].x + pa[k].y;
                asm volatile("" : "+v"(lg3[0][e]), "+v"(lg3[1][e]), "+v"(lg3[2][e]));
                if ((e & 3) == 3) asm volatile("" ::: "memory"); }
#pragma unroll
            for (int k = 0; k < 3; ++k) { const bool act = (i0 + k < nrows); const int i = i0 + k; {
            const bool isc = (i == 8);
            const int row = isc ? (ML + 8 * t + wave) : (64 * t + 8 * wave + i);
            float (&lg)[16] = lg3[k];
#pragma unroll
            for (int i2 = 0; i2 < 8; ++i2) { const bool up = (lane & 32) != 0; const float keep = up ? lg[i2 + 8] : lg[i2], send = up ? lg[i2] : lg[i2 + 8]; lg[i2] = keep + __shfl_xor(send, 32); }
#pragma unroll
            for (int i2 = 0; i2 < 4; ++i2) { const bool up = (lane & 16) != 0; const float keep = up ? lg[i2 + 4] : lg[i2], send = up ? lg[i2] : lg[i2 + 4]; lg[i2] = keep + __shfl_xor(send, 16); }
#pragma unroll
            for (int i2 = 0; i2 < 2; ++i2) { const bool up = (lane & 8) != 0; const float keep = up ? lg[i2 + 2] : lg[i2], send = up ? lg[i2] : lg[i2 + 2]; lg[i2] = keep + __shfl_xor(send, 8); }
            { const bool up = (lane & 4) != 0; const float keep = up ? lg[1] : lg[0], send = up ? lg[0] : lg[1]; lg[0] = keep + __shfl_xor(send, 4); }
            float lgt = lg[0]; lgt += __shfl_xor(lgt, 1); lgt += __shfl_xor(lgt, 2);
            const int ex = ((lane >> 5) & 1) * 8 + ((lane >> 4) & 1) * 4 + ((lane >> 3) & 1) * 2 + ((lane >> 2) & 1);
            float mx = lgt;
            mx = fmaxf(mx, __shfl_xor(mx, 4)); mx = fmaxf(mx, __shfl_xor(mx, 8)); mx = fmaxf(mx, __shfl_xor(mx, 16)); mx = fmaxf(mx, __shfl_xor(mx, 32));
            const float pe = fexp(lgt - mx);
            float den = pe; den += __shfl_xor(den, 4); den += __shfl_xor(den, 8); den += __shfl_xor(den, 16); den += __shfl_xor(den, 32);
            const float mine = pe / den;
            if ((lane & 3) == 0 && act) {
                if (isc) { const int cr = 8 * t + wave; AFFC[((size_t)(cr >> 8) * 16 + ex) * 256 + (cr & 255)] = mine; }
                else AFF[((size_t)(row >> 11) * 16 + ex) * 2048 + (row & 2047)] = mine;
            }
            } }
        }
    }
}

template <bool CTX>
__device__ __forceinline__ void topk_wave(unsigned char* ws, int item, int lane) {
    constexpr int NT = CTX ? 256 : 2048, CAP = CTX ? 32 : 256, PER = NT / 64;
    const int e = item & 15, b = item >> 4;
    const float* arow = (const float*)(ws + (CTX ? WS_AFFC : WS_AFF)) + (size_t)(b * 16 + e) * NT;
    float* gate = (float*)(ws + (CTX ? WS_GATEC : WS_GATE)) + (size_t)(b * 16 + e) * CAP;
    short* INV = (short*)(ws + WS_INV);
    int* rowidx = (int*)(ws + WS_ROWIDX) + (CTX ? ((128 + e) * 256 + b * 32) : ((b * 16 + e) * 256));
    unsigned v[PER];
#pragma unroll
    for (int i = 0; i < PER / 4; ++i) { const v4u q = *(const v4u*)(arow + lane * PER + 4 * i); v[4 * i] = q.x; v[4 * i + 1] = q.y; v[4 * i + 2] = q.z; v[4 * i + 3] = q.w; }
    unsigned T = 0;
    for (int bit = 29; bit >= 0; --bit) {
        const unsigned cand = T | (1u << bit); int c = 0;
#pragma unroll
        for (int i = 0; i < PER; ++i) c += __popcll(__ballot(v[i] >= cand));
        if (c >= CAP) T = cand;
    }
    int ngt = 0, cg = 0, ce = 0;
#pragma unroll
    for (int i = 0; i < PER; ++i) { ngt += __popcll(__ballot(v[i] > T)); cg += (v[i] > T) ? 1 : 0; ce += (v[i] == T) ? 1 : 0; }
    const int need = CAP - ngt;
    int pg = cg, pe = ce;
#pragma unroll
    for (int d = 1; d < 64; d <<= 1) { const int tg = __shfl_up(pg, d), te = __shfl_up(pe, d); if (lane >= d) { pg += tg; pe += te; } }
    pg -= cg; pe -= ce;
#pragma unroll
    for (int i = 0; i < PER; ++i) {
        const bool gt = v[i] > T, eq = v[i] == T;
        const bool sel = gt || (eq && pe < need);
        const int slot = pg + (pe < need ? pe : need);
        const int tok = lane * PER + i, grow = CTX ? (ML + b * CTXL + tok) : (b * SEQ + tok);
        if (sel) { rowidx[slot] = grow; gate[slot] = __uint_as_float(v[i]); }
        INV[(size_t)grow * 16 + e] = sel ? (short)slot : (short)-1;
        pg += gt ? 1 : 0; pe += eq ? 1 : 0;
    }
}

__device__ __forceinline__ void topk_wg2(unsigned char* ws, int item, LAS unsigned char* lds, int tid, int wave, int lane) {
    constexpr int CAP = 256;
    const int e = item & 15, b = item >> 4;
    const float* arow = (const float*)(ws + WS_AFF) + (size_t)(b * 16 + e) * 2048;
    float* gate = (float*)(ws + WS_GATE) + (size_t)(b * 16 + e) * CAP;
    short* INV = (short*)(ws + WS_INV);
    int* rowidx = (int*)(ws + WS_ROWIDX) + (b * 16 + e) * 256;
    LAS int* cnt = (LAS int*)lds;
    const v4u q = *(const v4u*)(arow + 4 * tid);
    const unsigned v[4] = {q.x, q.y, q.z, q.w};
    unsigned T = 0;
    __syncthreads();
    for (int bit = 29; bit >= 0; --bit) {
        const unsigned cand = T | (1u << bit); int c = 0;
#pragma unroll
        for (int i = 0; i < 4; ++i) c += __popcll(__ballot(v[i] >= cand));
        LAS int* cb = cnt + (bit & 1) * 8;
        if (lane == 0) cb[wave] = c;
        __syncthreads();
        int tot = 0;
#pragma unroll
        for (int w = 0; w < 8; ++w) tot += cb[w];
        if (tot >= CAP) T = cand;
    }
    int cg = 0, ce = 0, wg_ = 0, we_ = 0;
#pragma unroll
    for (int i = 0; i < 4; ++i) { wg_ += __popcll(__ballot(v[i] > T)); we_ += __popcll(__ballot(v[i] == T)); cg += (v[i] > T) ? 1 : 0; ce += (v[i] == T) ? 1 : 0; }
    if (lane == 0) { cnt[16 + wave] = wg_; cnt[24 + wave] = we_; }
    int pg = cg, pe = ce;
#pragma unroll
    for (int d = 1; d < 64; d <<= 1) { const int tg = __shfl_up(pg, d), te = __shfl_up(pe, d); if (lane >= d) { pg += tg; pe += te; } }
    pg -= cg; pe -= ce;
    __syncthreads();
    int ngt = 0;
#pragma unroll
    for (int w = 0; w < 8; ++w) { const int g_ = cnt[16 + w], e_ = cnt[24 + w]; ngt += g_; if (w < wave) { pg += g_; pe += e_; } }
    const int need = CAP - ngt;
#pragma unroll
    for (int i = 0; i < 4; ++i) {
        const bool gt = v[i] > T, eq = v[i] == T;
        const bool sel = gt || (eq && pe < need);
        const int slot = pg + (pe < need ? pe : need);
        const int grow = b * SEQ + 4 * tid + i;
        if (sel) { rowidx[slot] = grow; gate[slot] = __uint_as_float(v[i]); }
        INV[(size_t)grow * 16 + e] = sel ? (short)slot : (short)-1;
        pg += gt ? 1 : 0; pe += eq ? 1 : 0;
    }
}

__device__ __forceinline__ void phase_r5(const float* const* in, float* xout, unsigned char* ws, LAS unsigned char* lds, int l, bool upd, int G, int tid, int wave, int lane, bool dry) {
    const float* gains = in[6];
    const float* mod = (const float*)(ws + WS_MOD);
    const bf16_t* YE = (const bf16_t*)(ws + WS_R1); bf16_t* H = (bf16_t*)(ws + WS_H); bf16_t* XB = (bf16_t*)(ws + WS_XB);
    const float* GATE = (const float*)(ws + WS_GATE); const float* GATEC = (const float*)(ws + WS_GATEC); const short* INV = (const short*)(ws + WS_INV);
    LAS float* V = (LAS float*)lds;
    LAS int* CL = (LAS int*)(lds + 24576);
    for (int t = blockIdx.x; t < 256; t += G) {
        const int b = t >> 5;
        __syncthreads();
        for (int n = tid; n < 1024; n += 512) { const float gpf = gains[(size_t)l * 4096 + 3072 + n];
            V[n] = gpf * mod[((size_t)l * 9 + b) * 6144 + 5120 + n]; V[3072 + n] = gpf * mod[((size_t)l * 9 + 8) * 6144 + 5120 + n];
            if (l == 0) { const float gna = gains[4096 + n];
                V[1024 + n] = gna * (1.f + mod[((size_t)9 + b) * 6144 + 1024 + n]); V[2048 + n] = mod[((size_t)9 + b) * 6144 + n];
                V[4096 + n] = gna * (1.f + mod[((size_t)9 + 8) * 6144 + 1024 + n]); V[5120 + n] = mod[((size_t)9 + 8) * 6144 + n]; } }
        if (tid < (upd ? 72 : 64)) {
            const bool isc = tid >= 64; const int cr = 8 * t + (tid - 64);
            const int row = isc ? (ML + cr) : (64 * t + tid); const int bb = isc ? (cr >> 8) : b;
            const v4u i0 = *(const v4u*)(INV + (size_t)row * 16), i1 = *(const v4u*)(INV + (size_t)row * 16 + 8);
            const unsigned iw[8] = {i0.x, i0.y, i0.z, i0.w, i1.x, i1.y, i1.z, i1.w};
            float gv[16]; int sl[16];
#pragma unroll
            for (int e = 0; e < 16; ++e) { sl[e] = (int)(short)((iw[e >> 1] >> (16 * (e & 1))) & 0xffffu); const int s0 = sl[e] < 0 ? 0 : sl[e];
                gv[e] = isc ? GATEC[(size_t)(bb * 16 + e) * 32 + s0] : GATE[(size_t)(bb * 16 + e) * 256 + s0]; }
            int cnt = 0; LAS int* cl = CL + tid * 33;
#pragma unroll
            for (int e = 0; e < 16; ++e) if (sl[e] >= 0) { cl[1 + 2 * cnt] = isc ? ((128 + e) * 256 + bb * 32 + sl[e]) : ((bb * 16 + e) * 256 + sl[e]); cl[2 + 2 * cnt] = (int)__float_as_uint(gv[e]); ++cnt; }
            cl[0] = cnt;
        }
        __syncthreads();
        const int nrows = upd ? 9 : 8;
#pragma unroll 1
        for (int i0 = 0; i0 < 9; i0 += 3) {
            f32x4 xq[3][4];
#pragma unroll
            for (int k = 0; k < 3; ++k) { const int i = i0 + k; if (i < nrows) { const bool isc = (i == 8);
                ld_row_bf16(XB + (size_t)(isc ? (ML + 8 * t + wave) : (64 * t + 8 * wave + i)) * 1024, lane, xq[k]); } }
#pragma unroll
            for (int k = 0; k < 3; ++k) { const int i = i0 + k; if (i < nrows) {
            const bool isc = (i == 8);
            const int row = isc ? (ML + 8 * t + wave) : (64 * t + 8 * wave + i);
            LAS const float* vv = V + (isc ? 3072 : 0);
            LAS const int* cl = CL + (isc ? (64 + wave) : (8 * wave + i)) * 33;
            const int n = __builtin_amdgcn_readfirstlane(cl[0]);
            f32x4 acc[4];
#pragma unroll
            for (int j = 0; j < 4; ++j) acc[j] = (f32x4){0.f, 0.f, 0.f, 0.f};
            for (int j0 = 0; j0 < n; j0 += 4) {
                v2u raw[4][4]; float g[4];
#pragma unroll
                for (int q = 0; q < 4; ++q) {
                    if (j0 + q < n) { const int yr = __builtin_amdgcn_readfirstlane(cl[1 + 2 * (j0 + q)]); g[q] = __uint_as_float((unsigned)__builtin_amdgcn_readfirstlane(cl[2 + 2 * (j0 + q)]));
                        const bf16_t* yp = YE + (size_t)yr * 1024;
#pragma unroll
                        for (int j = 0; j < 4; ++j) raw[q][j] = *(const v2u*)(yp + 256 * j + 4 * lane); }
                    else { g[q] = 0.f;
#pragma unroll
                        for (int j = 0; j < 4; ++j) raw[q][j] = (v2u){0u, 0u}; }
                }
#pragma unroll
                for (int q = 0; q < 4; ++q)
#pragma unroll
                    for (int j = 0; j < 4; ++j) acc[j] += (f32x4){bflo(raw[q][j].x), bfhi(raw[q][j].x), bflo(raw[q][j].y), bfhi(raw[q][j].y)} * g[q];
            }
            const float rsm = __builtin_amdgcn_rsqf(wave_sum(sumsq16(acc)) * (1.f / 1024.f) + NEPS);
            f32x4 (&xv)[4] = xq[k]; f32x4 a[4]; ld_vec_lds(vv, lane, a);
#pragma unroll
            for (int j = 0; j < 4; ++j) xv[j] = xv[j] + a[j] * (acc[j] * rsm);
            if (l == 0) st_row_bf16((dry ? (bf16_t*)(ws + WS_R2) : XB) + (size_t)row * 1024, lane, xv);
            else st_row_f32((dry ? (float*)(ws + WS_R2) : xout) + (size_t)row * 1024, lane, xv);
            if (l == 0 && !dry) {
                const float rs2 = __builtin_amdgcn_rsqf(wave_sum(sumsq16(xv)) * (1.f / 1024.f) + NEPS);
                f32x4 s[4]; ld_vec_lds(vv + 1024, lane, a); ld_vec_lds(vv + 2048, lane, s);
#pragma unroll
                for (int j = 0; j < 4; ++j) xv[j] = xv[j] * rs2 * a[j] + s[j];
                st_row_bf16(H + (size_t)row * 1024, lane, xv);
            }
            } }
        }
    }
}
#ifndef MK_PER_PHASE
#define MK_PER_PHASE 0
#endif
constexpr int N_PHASES = 22;
struct Args { const float* in[18]; float* out; unsigned char* ws; int ph_lo, ph_hi; };
__device__ __forceinline__ const Args* kargs_opaque() {
    auto p = __builtin_amdgcn_kernarg_segment_ptr(); asm volatile("" : "+s"(p)); return (const Args*)p; }
#define PHASE_REGS() int tid = threadIdx.x; asm volatile("" : "+v"(tid)); const int lane = tid & 63, wave = __builtin_amdgcn_readfirstlane(tid >> 6); \
    const Args* A = kargs_opaque(); unsigned char* ws = A->ws; const int G = gridDim.x, bx = blockIdx.x; \
    const int vcu = (G % 8 == 0) ? (bx % 8) * (G / 8) + bx / 8 : bx; const int gw = vcu * NWAVES + wave, NGW = G * NWAVES; \
    LAS unsigned char* wl = lds + wave * WAVE_LDS; (void)gw; (void)NGW; (void)wl; (void)lane; (void)ws
#ifndef CONV_BUDGET
#define CONV_BUDGET 1
#endif
#ifndef PH_MASK
#define PH_MASK 0xFFFFFFFFu
#endif
#define EN(j) (((PH_MASK) >> (j)) & 1u)
#ifndef REP_MASK
#define REP_MASK 0u
#endif
#define REPS(j) ((((REP_MASK) >> (j)) & 1u) ? 2 : 1)
__global__ void __launch_bounds__(NWAVES * 64, 2) fwd_kernel(Args args) {
    extern __shared__ __attribute__((aligned(16))) unsigned char lds_raw[];
    LAS unsigned char* lds = (LAS unsigned char*)lds_raw;
    volatile LAS unsigned* MISC = (volatile LAS unsigned*)(lds + MISC_OFF);
    for (int u = threadIdx.x; u < (LDS_BYTES - LDSCTL_OFF) / 4; u += NWAVES * 64) ((LAS unsigned*)(lds + LDSCTL_OFF))[u] = 0u;
    __syncthreads();
    const int lo = args.ph_lo, hi = args.ph_hi;
    XcdBarrier bar; bar.bar = (unsigned*)(args.ws + WS_CTL) + CW_BAR; bar.x = 0; bar.st = nullptr;
    if (hi - lo > 1) bar = xcd_barrier_post((unsigned*)(args.ws + WS_CTL) + CW_BAR, MISC + 8);
#define IN(k) (lo <= (k) && (k) < hi)
#ifdef STAMP_A
#define STAMP(k) do { if (blockIdx.x == 0 && threadIdx.x == 0) ((unsigned long long*)(args.ws + WS_CTL))[1536 + (k)] = __builtin_amdgcn_s_memrealtime(); } while (0)
#else
#define STAMP(k) do { } while (0)
#endif
#define SEAM(k) do { if (IN((k) + 1)) { xcd_barrier(bar); if (REPS(12) == 2) xcd_barrier(bar); } STAMP((k) + 1); } while (0)
    STAMP(0);
    if (EN(0) && IN(0)) { for (int rep = 0; rep < REPS(0); ++rep) { PHASE_REGS(); phase_p0(A->in, ws, wl, gw, NGW, lane); } SEAM(0); }
    if (EN(1) && IN(1)) { for (int rep = 0; rep < REPS(1); ++rep) { PHASE_REGS(); phase_a0(A->in, ws, lds, G, tid, wave, lane); } SEAM(1); }
    for (int l = 0; l < 2; ++l) {
        const int base = 2 + 10 * l; const bool upd = (l == 0);
        if (EN(2) && IN(base + 0)) { for (int rep = 0; rep < REPS(2); ++rep) {
            PHASE_REGS();
            pg8::Gemm g{(const bf16_t*)(ws + WS_H), (const bf16_t*)(ws + WS_WIN) + (size_t)l * PP * 1024, MT, PP, 1024}; pg8::StaticOrder S; S.init(MT, PP, G, bx);
            pg8::EpiProj E{(bf16_t*)(ws + WS_R1), PP, (const pg8::f32x2*)(ws + WS_TAB), ML};
            pg8::gemm_phase<pg8::EpiProj, pg8::StaticOrder, true, true>(lds, g, S, E);
            if (upd && CV_G1 > 0 && G == 256 && bx >= 208 && !(rep + 1 < REPS(2))) tr_stream(A->in, ws, P0_A + (bx - 208) * NWAVES + wave, 384, P0_A + CV_N1, (LAS float*)wl, lane);
            if (!CONV_IN_P0) { const int nwg_ = (MT / 256) * (PP / 256); if ((nwg_ - bx + G - 1) / G < (nwg_ + G - 1) / G) conv_pull(A->in, ws, l, 1, 12 * CONV_BUDGET, (LAS float*)wl, lane); }
            }
            SEAM(base + 0);
        }
        if (EN(3) && IN(base + 1)) { for (int rep = 0; rep < REPS(3); ++rep) {
            PHASE_REGS();
            const bf16_t* PROJ = (const bf16_t*)(ws + WS_R1); bf16_t* MIX = (bf16_t*)(ws + WS_R2);
            const float* a_up = A->in[9] + (size_t)l * 2 * 16 * 128; const float* a_bias = A->in[10] + (size_t)l * 2 * 128;
            const float* rpb = A->in[12] + (size_t)l * 4 * 465; const float* sink = A->in[13] + (size_t)l * 8;
            const int n_cn = upd ? 128 : 0, n_cs = upd ? 256 : 0;
            const bool xmap = (G == 256);
            const int xcd = bx & 7, cu = bx >> 3;
            const int n_att = xmap ? 12 : 0;
            const int tail_total = (xmap ? 0 : 1024 + 2048) + 1152 + n_cn + n_cs;
            volatile LAS unsigned* qctr = (volatile LAS unsigned*)(lds + MISC_OFF) + 16 + l * 2 + rep;
            const int n_conv = 0, n_mix = (n_conv + 2) / 3 * 4;
            if (CV_M1 > 0 && upd && G == 256 && wave == 7 && !(rep + 1 < REPS(3))) tr_stream(A->in, ws, P0_A + CV_N1 + bx, 256, P0_A + CV_N1 + 256 * CV_M1, (LAS float*)wl, lane);
            for (;;) {
                int j = 0; if (lane == 0) j = (int)__hip_atomic_fetch_add((LAS unsigned*)qctr, 1u, __ATOMIC_RELAXED, __HIP_MEMORY_SCOPE_WORKGROUP);
                j = __builtin_amdgcn_readfirstlane(j);
                if (j < n_mix) {
                    if ((j & 3) != 3) { const int ci = (j >> 2) * 3 + (j & 3), r = ci * G + bx; if (ci < n_conv && r < 12288 && !(rep + 1 < REPS(3))) expert_conv_item(A->in, ws, l, r, (LAS float*)wl, lane); continue; }
                    j = j >> 2;
                } else j = j - n_mix + n_mix / 4;
                int mode, item;
                if (j < n_att) {
                    if (j < 4) { mode = 0; item = (xcd * 4 + j) * 32 + cu; }
                    else { const int jj = j - 4, group = xcd * 2 + (jj >> 2), i = cu * 4 + (jj & 3); const int bb = group >> 1, hq = (group & 1) * 4 + (i >> 5); mode = 1; item = (i & 31) + 32 * hq + 256 * bb; }
                } else {
                    int r = (j - n_att) * G + bx;
                    if (r >= tail_total) break;
                    mode = -1; item = 0;
                    if (!xmap) { if (r < 1024) { mode = 0; item = r; } else if (r < 3072) { mode = 1; item = r - 1024; } r -= 3072; }
                    if (mode < 0) {
                        if (r < 1152) { if (rep + 1 < REPS(3)) continue; gla_local_item(PROJ, (float*)(ws + WS_UST), (float*)(ws + WS_DEC), r, wl, lane, a_up, a_bias); continue; } r -= 1152;
                        if (r < n_cs) { mode = 3; item = r; } else { mode = 2; item = r - n_cs; }
                    }
                }
                attn_item(mode, PROJ, MIX, item, wl, lane, rpb, sink, rep + 1 < REPS(3));
            }
            }
            SEAM(base + 1);
        }
        if (EN(4) && IN(base + 2)) { for (int rep = 0; rep < REPS(4); ++rep) {
            PHASE_REGS();
            for (int gid = bx * (NWAVES * 64) + tid; gid < 64 * 2048; gid += G * NWAVES * 64) gla_prefix((float*)(ws + WS_UST), (const float*)(ws + WS_DEC), gid, rep + 1 < REPS(4));
            }
            SEAM(base + 2);
        }
        if (EN(5) && IN(base + 3)) { for (int rep = 0; rep < REPS(5); ++rep) {
            PHASE_REGS();
            const float* a_up = A->in[9] + (size_t)l * 2 * 16 * 128; const float* a_bias = A->in[10] + (size_t)l * 2 * 128; const float* gnorm = A->in[11] + (size_t)l * 64;
            for (int it = gw; it < 1152; it += NGW) { if (!upd && (it % 36) < 4) continue;
                gla_out_item((const bf16_t*)(ws + WS_R1), (const float*)(ws + WS_UST), (bf16_t*)(ws + WS_R2), it, wl, lane, a_up, a_bias, gnorm); }
            if (upd && G == 256 && gw >= 1152 && !(rep + 1 < REPS(5))) tr_stream(A->in, ws, TR_ALL - CONV_M3 + (gw - 1152), NGW - 1152, TR_ALL, (LAS float*)wl, lane);
            }
            SEAM(base + 3);
        }
        if (EN(6) && IN(base + 4)) { for (int rep = 0; rep < REPS(6); ++rep) {
            PHASE_REGS();
            const int M2 = upd ? MT : ML;
            pg8::Gemm g{(const bf16_t*)(ws + WS_R2), (const bf16_t*)(ws + WS_WOUT) + (size_t)l * 1024 * 1024, M2, 1024, 1024}; pg8::StaticOrder S; S.init(M2, 1024, G, bx);
            pg8::EpiStore E{(bf16_t*)(ws + WS_R2 + (size_t)MT * 2048), 1024};
            pg8::gemm_phase<pg8::EpiStore, pg8::StaticOrder, true, true>(lds, g, S, E);
            if (upd && CV_G2 > 0 && G == 256 && bx >= 32 && !(rep + 1 < REPS(6))) tr_stream(A->in, ws, P0_A + CV_N1 + 256 * CV_M1 + (bx - 32) * NWAVES + wave, 1792, TR_L, (LAS float*)wl, lane);
            if (!CONV_IN_P0) { const int nwg_ = (M2 / 256) * 4; if ((nwg_ - bx + G - 1) / G < (nwg_ + G - 1) / G) conv_pull(A->in, ws, l, 1, 3 * CONV_BUDGET, (LAS float*)wl, lane); }
            }
            SEAM(base + 4);
        }
        if (EN(7) && IN(base + 5)) { for (int rep = 0; rep < REPS(7); ++rep) { PHASE_REGS(); phase_r1(A->in, A->out, ws, lds, l, upd, G, tid, wave, lane, rep + 1 < REPS(7)); } SEAM(base + 5); }
        if (EN(8) && IN(base + 6)) { for (int rep = 0; rep < REPS(8); ++rep) {
            PHASE_REGS();
            if (!CONV_IN_P0) conv_pull(A->in, ws, l, l, 1 << 30, (LAS float*)wl, lane);
            for (int it = bx; it < 128; it += G) topk_wg2(ws, it, lds, tid, wave, lane);
            if (upd) { const int w2 = (bx >= 128 ? bx - 128 : bx + G - 128) * NWAVES + wave; for (int it = w2; it < 128; it += NGW) topk_wave<true>(ws, it, lane); }
            }
            SEAM(base + 6);
        }
        if (EN(9) && IN(base + 7)) { for (int rep = 0; rep < REPS(9); ++rep) {
            PHASE_REGS();
            pg8::Gemm g{(const bf16_t*)(ws + WS_H), (const bf16_t*)(ws + WS_WGU) + (size_t)l * 16 * 2048 * 1024, 0, 0, 1024, (const int*)(ws + WS_ROWIDX)}; pg8::MoeOrder S; S.init(upd ? 9 : 8, 8, G, bx);
            pg8::EpiSwiGLU E{(bf16_t*)(ws + WS_R2), 1024};
            pg8::gemm_phase<pg8::EpiSwiGLU, pg8::MoeOrder, true, true, true>(lds, g, S, E);
            if (upd && CV_G3 > 0 && G == 256 && bx >= 128 && !(rep + 1 < REPS(9))) tr_stream(A->in, ws, P0_B + (bx - 128) * NWAVES + wave, 1024, P0_B + CV_N3, (LAS float*)wl, lane);
            if (!CONV_IN_P0) { const int nwg_ = 16 * (upd ? 9 : 8) * 8; if ((nwg_ - bx + G - 1) / G < (nwg_ + G - 1) / G) conv_pull(A->in, ws, l + 1, 1, 4 * CONV_BUDGET, (LAS float*)wl, lane); }
            }
            SEAM(base + 7);
        }
        if (EN(10) && IN(base + 8)) { for (int rep = 0; rep < REPS(10); ++rep) {
            PHASE_REGS();
            pg8::Gemm g{(const bf16_t*)(ws + WS_R2), (const bf16_t*)(ws + WS_WD) + (size_t)l * 16 * 1024 * 1024, 0, 0, 1024}; pg8::MoeOrder S; S.init(upd ? 9 : 8, 4, G, bx);
            pg8::EpiStore E{(bf16_t*)(ws + WS_R1), 1024};
            pg8::gemm_phase<pg8::EpiStore, pg8::MoeOrder, true, true>(lds, g, S, E);
            if (upd && CV_G4 > 0 && G == 256 && bx >= 64 && !(rep + 1 < REPS(10))) tr_stream(A->in, ws, P0_B + CV_N3 + (bx - 64) * NWAVES + wave, 1536, P0_B + CV_N3 + CV_N4, (LAS float*)wl, lane);
            if (!CONV_IN_P0) { const int nwg_ = 16 * (upd ? 9 : 8) * 4; if ((nwg_ - bx + G - 1) / G < (nwg_ + G - 1) / G) conv_pull(A->in, ws, l + 1, 1, 3 * CONV_BUDGET, (LAS float*)wl, lane); }
            }
            SEAM(base + 8);
        }
        if (EN(11) && IN(base + 9)) { for (int rep = 0; rep < REPS(11); ++rep) { PHASE_REGS(); phase_r5(A->in, A->out, ws, lds, l, upd, G, tid, wave, lane, rep + 1 < REPS(11)); } SEAM(base + 9); }
    }
#ifdef STAMP_A
    if (blockIdx.x == 0 && threadIdx.x == 0) { const unsigned long long* st_ = (const unsigned long long*)(args.ws + WS_CTL) + 1536; const float d_ = (float)(st_[STAMP_B] - st_[STAMP_A]); args.out[0] = 200.f * floorf(d_ / 200.f + 0.5f); }
#endif
#undef IN
#undef SEAM
}

extern "C" void kernel_launch(void* const* d_in, const int* in_sizes, int n_in, void* d_out, int out_size, void* d_ws, size_t ws_size, hipStream_t stream) {
    static int grid = 0;
    if (grid == 0) {
        if (n_in != 18 || out_size != ML * DM || ws_size < WS_END) { fprintf(stderr, "kernel_launch: unexpected sizes: n_in %d out %d ws %zu (need %zu)\n", n_in, out_size, ws_size, (size_t)WS_END); grid = -1; return; }
        int dev = 0, cus = 0, per_cu = 0;
        if (hipGetDevice(&dev) != hipSuccess || hipDeviceGetAttribute(&cus, hipDeviceAttributeMultiprocessorCount, dev) != hipSuccess) { grid = -1; return; }
        if (hipFuncSetAttribute((const void*)fwd_kernel, hipFuncAttributeMaxDynamicSharedMemorySize, LDS_BYTES) != hipSuccess) { fprintf(stderr, "kernel_launch: hipFuncSetAttribute failed\n"); grid = -1; return; }
        if (hipOccupancyMaxActiveBlocksPerMultiprocessor(&per_cu, (const void*)fwd_kernel, NWAVES * 64, LDS_BYTES) != hipSuccess || per_cu < 1) { fprintf(stderr, "kernel_launch: occupancy query says %d blocks per CU\n", per_cu); (void)hipGetLastError(); grid = -1; return; }
        grid = cus;
    }
    if (grid < 0) return;
    (void)hipMemsetAsync((char*)d_ws + WS_CTL, 0, CTL_ZERO_BYTES, stream);
    Args a{};
    for (int i = 0; i < 18; ++i) a.in[i] = (const float*)d_in[i];
    a.out = (float*)d_out; a.ws = (unsigned char*)d_ws;
#if MK_PER_PHASE
    for (int p = 0; p < N_PHASES; ++p) { a.ph_lo = p; a.ph_hi = p + 1; hipLaunchKernelGGL(fwd_kernel, dim3(grid), dim3(NWAVES * 64), LDS_BYTES, stream, a); }
#else
    a.ph_lo = 0; a.ph_hi = N_PHASES;
    void* kargs[] = {&a};
    hipError_t e = hipLaunchCooperativeKernel((const void*)fwd_kernel, dim3(grid), dim3(NWAVES * 64), kargs, LDS_BYTES, stream);
    if (e != hipSuccess) fprintf(stderr, "kernel_launch: cooperative launch failed: %s (grid %d)\n", hipGetErrorString(e), grid);
#endif
}
```

```cpp
#include <hip/hip_runtime.h>
#include <cstdio>
#include <cstdint>
#include <cmath>

namespace pg8 {
#define PG8_LAS __attribute__((address_space(3)))
typedef unsigned short bf16_t;
typedef short bf16x8 __attribute__((ext_vector_type(8)));
typedef float f32x4 __attribute__((ext_vector_type(4)));
typedef unsigned u32x4 __attribute__((ext_vector_type(4)));
constexpr int BM = 256, BK = 64, HALF = 128, HTB = HALF * BK * 2  , STAGE_BYTES = 8 * HTB, NXCD = 8, WGM = 8;

__host__ __device__ __forceinline__ int lds_byte(int r, int c) { const int st = (r >> 4) * 2 + (c >> 5), rr = r & 15, cc = c & 31, ob = rr * 64 + cc * 2; return st * 1024 + (ob ^ (((ob >> 9) & 1) << 5)); }
__host__ __device__ __forceinline__ void stage_rc(int b, int& R, int& C) { const int st = b / 1024, sb = b % 1024, swz = sb ^ (((sb >> 9) & 1) << 5); R = (st >> 1) * 16 + swz / 64; C = (st & 1) * 32 + (swz % 64) / 2; }
__host__ __device__ __forceinline__ int perm32(int rho) { const int n = rho >> 4, i = rho & 15; return 8 * (i >> 2) + 4 * n + (i & 3); }

struct Unit { int pm, pn, pb; };
struct Gemm { const bf16_t* A; const bf16_t* Bt; int M, N, K; const int* rowidx; };

struct StaticOrder {
    int nM, nN, nwg, G, c;
    __host__ __device__ void init(int M, int N, int G_, int c_) { nM = M / BM; nN = N / BM; nwg = nM * nN; G = G_; c = c_; }
    __host__ __device__ bool next(int i, Unit& u) const {
        const long L = (long)i * G + c; if (L >= nwg) return false;
        int wgid = (int)L; { const int q = nwg / NXCD, r = nwg % NXCD, xcd = wgid % NXCD, off = wgid / NXCD; wgid = (xcd < r ? xcd * (q + 1) : r * (q + 1) + (xcd - r) * q) + off; }
        const int nig = WGM * nN, gid = wgid / nig, fm = gid * WGM, gsz = (nM - fm) < WGM ? (nM - fm) : WGM;
        u.pm = fm + ((wgid % nig) % gsz); u.pn = (wgid % nig) / gsz; u.pb = u.pn; return true;
    }
    __device__ __forceinline__ void a_ready(const Unit&) const {}
    __device__ __forceinline__ void done(const Unit&) const {}
};

__device__ __forceinline__ unsigned cvt_pk_bf16(float lo, float hi) { unsigned r; asm volatile("v_cvt_pk_bf16_f32 %0, %1, %2" : "=v"(r) : "v"(lo), "v"(hi)); return r; }
typedef float f32x2 __attribute__((ext_vector_type(2)));
#ifndef EPI_WT
#define EPI_WT 0
#endif
__device__ __forceinline__ void st16(bf16_t* base, size_t elem_off, u32x4 w) {
#if EPI_WT
    const __amdgpu_buffer_rsrc_t r = __builtin_amdgcn_make_buffer_rsrc((void*)base, 0, 0x7fffffff, 0x00020000);
    __builtin_amdgcn_raw_buffer_store_b128(w, r, (unsigned)(elem_off * 2), 0, 16);
#else
    *(u32x4*)(base + elem_off) = w;
#endif
}
struct EpiStore {
    static constexpr bool PERM = true, AFTER_DRAIN = false;
    bf16_t* O; int ldc;
    __device__ __forceinline__ void operator()(const f32x4 (&acc)[2][2][4][2], const Unit& u, int wr, int wc, int fr, int fq) const {
        const int row0 = u.pm * BM + wr * 64 + fr, col0 = u.pn * BM + wc * 32 + 8 * fq;
#pragma unroll
        for (int ai = 0; ai < 2; ++ai)
#pragma unroll
            for (int m = 0; m < 4; ++m) { bf16_t* rowp = O + (size_t)(row0 + ai * HALF + m * 16) * ldc + col0;
#pragma unroll
                for (int bj = 0; bj < 2; ++bj) { const f32x4 v0 = acc[ai][bj][m][0], v1 = acc[ai][bj][m][1];
                    u32x4 w; w.x = cvt_pk_bf16(v0[0], v0[1]); w.y = cvt_pk_bf16(v0[2], v0[3]); w.z = cvt_pk_bf16(v1[0], v1[1]); w.w = cvt_pk_bf16(v1[2], v1[3]);
                    st16(O, (size_t)(rowp - O) + bj * HALF, w); } }
    }
};
struct EpiProj {
    static constexpr bool PERM = true, AFTER_DRAIN = false;
    bf16_t* O; int ldc; const f32x2* tab; int ml;
    __device__ __forceinline__ void operator()(const f32x4 (&acc)[2][2][4][2], const Unit& u, int wr, int wc, int fr, int fq) const {
        const int row0 = u.pm * BM + wr * 64 + fr;
        const bool latent = (u.pm * BM) < ml;
#pragma unroll
        for (int bj = 0; bj < 2; ++bj) {
            const int c0 = u.pn * BM + bj * HALF + wc * 32;
            const bool rope = latent && ((c0 >= 928 && c0 < 1056) || (c0 >= 1824 && c0 < 2336));
            const bool rowhalf = (((c0 - 32) & 63) == 0);
            const bool qscale = (c0 >= 1568 && c0 < 2336);
#pragma unroll
            for (int ai = 0; ai < 2; ++ai)
#pragma unroll
                for (int m = 0; m < 4; ++m) {
                    const int row = row0 + ai * HALF + m * 16;
                    f32x4 v0 = acc[ai][bj][m][0], v1 = acc[ai][bj][m][1];
                    if (rope) {
                        const int t = row & 2047, pos = rowhalf ? (t >> 6) : (t & 63);
                        const f32x2* tp = tab + pos * 16 + 8 * (fq & 1);
                        const float sg = (fq < 2) ? -1.f : 1.f;
#pragma unroll
                        for (int e = 0; e < 4; ++e) {
                            const float x0 = v0[e], x1 = v1[e];
                            const float p0 = __shfl_xor(x0, 32), p1 = __shfl_xor(x1, 32);
                            const f32x2 c0s = tp[e], c1s = tp[4 + e];
                            v0[e] = x0 * c0s.x + sg * p0 * c0s.y; v1[e] = x1 * c1s.x + sg * p1 * c1s.y;
                        }
                    }
                    if (qscale) { v0 = v0 * 0.18033688011112042f; v1 = v1 * 0.18033688011112042f; }
                    u32x4 w; w.x = cvt_pk_bf16(v0[0], v0[1]); w.y = cvt_pk_bf16(v0[2], v0[3]); w.z = cvt_pk_bf16(v1[0], v1[1]); w.w = cvt_pk_bf16(v1[2], v1[3]);
                    st16(O, (size_t)row * ldc + c0 + 8 * fq, w);
                }
        }
    }
};
struct EpiSwiGLU {
    static constexpr bool PERM = true, AFTER_DRAIN = false;
    bf16_t* O; int ldc;
    __device__ __forceinline__ void operator()(const f32x4 (&acc)[2][2][4][2], const Unit& u, int wr, int wc, int fr, int fq) const {
        const int row0 = u.pm * BM + wr * 64 + fr, col0 = u.pn * HALF + wc * 32 + 8 * fq;
#pragma unroll
        for (int ai = 0; ai < 2; ++ai)
#pragma unroll
            for (int m = 0; m < 4; ++m) {
                float h[8];
#pragma unroll
                for (int n = 0; n < 2; ++n)
#pragma unroll
                    for (int e = 0; e < 4; ++e) { const float g = acc[ai][0][m][n][e], up = acc[ai][1][m][n][e];
                        h[n * 4 + e] = g * __builtin_amdgcn_rcpf(1.f + __builtin_amdgcn_exp2f(-1.4426950408889634f * g)) * up; }
                u32x4 w; w.x = cvt_pk_bf16(h[0], h[1]); w.y = cvt_pk_bf16(h[2], h[3]); w.z = cvt_pk_bf16(h[4], h[5]); w.w = cvt_pk_bf16(h[6], h[7]);
                st16(O, (size_t)(row0 + ai * HALF + m * 16) * ldc + col0, w);
            }
    }
};
struct MoeOrder {
    int npe, nN, nwg, G, c;
    __host__ __device__ void init(int npe_, int nN_, int G_, int c_) { npe = npe_; nN = nN_; nwg = 16 * npe * nN; G = G_; c = c_; }
    __host__ __device__ bool next(int i, Unit& u) const {
        const long L = (long)i * G + c; if (L >= nwg) return false;
        int wgid = (int)L; { const int q = nwg / NXCD, r = nwg % NXCD, xcd = wgid % NXCD, off = wgid / NXCD; wgid = (xcd < r ? xcd * (q + 1) : r * (q + 1) + (xcd - r) * q) + off; }
        const int per = npe * nN, e = wgid / per, rem = wgid % per, j = rem / nN, pn = rem % nN;
        u.pm = (j < 8) ? (j * 16 + e) : (128 + e); u.pn = pn; u.pb = e * nN + pn; return true;
    }
    __device__ __forceinline__ void a_ready(const Unit&) const {}
    __device__ __forceinline__ void done(const Unit&) const {}
};

template <class Epi, class Sched, bool ALIGN_EPI = false, bool SP2 = false, bool GATHER = false>
__device__ __forceinline__ void gemm_phase(PG8_LAS unsigned char* lds, const Gemm g, const Sched& S, const Epi& E) {
    int tid_ = threadIdx.x; asm volatile("" : "+v"(tid_));
    const int tid = tid_, wid = __builtin_amdgcn_readfirstlane(tid >> 6), lane = tid & 63, wr = wid >> 2, wc = wid & 3, fr = lane & 15, fq = lane >> 4;
    const int K = g.K, nt = K / BK;
    static_assert(!GATHER || SP2, "GATHER is wired into the SP2 loop only");
    unsigned voffA[2], voffB[2]; int RA[2], CA[2]; unsigned vAc[2][2], vAn[2][2];
#pragma unroll
    for (int i = 0; i < 2; ++i) { int R, C; stage_rc(tid * 16 + i * 8192, R, C); const int Rb = Epi::PERM ? ((R & ~31) + perm32(R & 31)) : R; RA[i] = R; CA[i] = C;
        voffA[i] = (unsigned)(R * K + C) * 2u; voffB[i] = (unsigned)(Rb * K + C) * 2u; vAc[0][i] = vAc[1][i] = vAn[0][i] = vAn[1][i] = 0u; }
    auto load_idx = [&](int pm, unsigned (&v)[2][2]) {
#pragma unroll
        for (int h = 0; h < 2; ++h)
#pragma unroll
            for (int i = 0; i < 2; ++i) v[h][i] = (unsigned)(g.rowidx[pm * BM + h * HALF + RA[i]] * K + CA[i]) * 2u;
    };
    const size_t kstep = (size_t)(BK * 2);
    const size_t hstep = (size_t)HALF * K * 2;
    const size_t tstep = 2 * hstep;
    const unsigned ldsw = (unsigned)wid * 1024u;
    const int aoff = lds_byte(wr * 64 + fr, fq * 8), boff = lds_byte(wc * 32 + fr, fq * 8);
#define PG8_SA(b, h) (((b) * 2 + (h)) * HTB)
#define PG8_SB(b, h) ((4 + (b) * 2 + (h)) * HTB)
#define PG8_STAGE(bufoff, gbase, voff) do { _Pragma("unroll") for (int _i = 0; _i < 2; ++_i) \
        __builtin_amdgcn_global_load_lds((const unsigned*)((const char*)(gbase) + (voff)[_i]), (PG8_LAS unsigned*)(lds + (bufoff) + ldsw + _i * 8192), 16, 0, 0); } while (0)
#define PG8_STAGE_A(bufoff, gbase, h, nx) do { if constexpr (GATHER) { const unsigned v_[2] = { (nx) ? vAn[h][0] : vAc[h][0], (nx) ? vAn[h][1] : vAc[h][1] }; PG8_STAGE(bufoff, gbase, v_); } \
        else { PG8_STAGE(bufoff, (gbase) + (h) * hstep, voffA); } } while (0)
#define PG8_LDA(dst, b, h) do { _Pragma("unroll") for (int m = 0; m < 4; ++m) _Pragma("unroll") for (int k = 0; k < 2; ++k) dst[m][k] = *(const PG8_LAS bf16x8*)(lds + PG8_SA(b, h) + aoff + m * 2048 + k * 1024); } while (0)
#define PG8_LDB(dst, b, h) do { _Pragma("unroll") for (int n = 0; n < 2; ++n) _Pragma("unroll") for (int k = 0; k < 2; ++k) dst[n][k] = *(const PG8_LAS bf16x8*)(lds + PG8_SB(b, h) + boff + n * 2048 + k * 1024); } while (0)
#define PG8_MMA(ai, bj, At, Bt) do { __builtin_amdgcn_s_setprio(1); _Pragma("unroll") for (int m = 0; m < 4; ++m) _Pragma("unroll") for (int n = 0; n < 2; ++n) _Pragma("unroll") for (int k = 0; k < 2; ++k) \
        acc[ai][bj][m][n] = __builtin_amdgcn_mfma_f32_16x16x32_bf16(Bt[n][k], At[m][k], acc[ai][bj][m][n], 0, 0, 0); __builtin_amdgcn_s_setprio(0); } while (0)
#define PG8_WAIT_V(n) asm volatile("s_waitcnt vmcnt(" #n ")" ::: "memory")
#define PG8_WAIT_L(n) asm volatile("s_waitcnt lgkmcnt(" #n ")" ::: "memory")
#define PG8_BAR __builtin_amdgcn_s_barrier()
#define PG8_SCHED __builtin_amdgcn_sched_barrier(0)
    Unit cur, nxt; int ui = 0;
    if (!S.next(0, cur)) return;
    f32x4 acc[2][2][4][2];
#pragma unroll
    for (int a = 0; a < 2; ++a)
#pragma unroll
        for (int b = 0; b < 2; ++b)
#pragma unroll
            for (int m = 0; m < 4; ++m)
#pragma unroll
                for (int n = 0; n < 2; ++n) acc[a][b][m][n] = (f32x4){0.f, 0.f, 0.f, 0.f};
    bf16x8 At[4][2], B0[2][2], B1[2][2];
    const char* cA = (const char*)g.A + (GATHER ? (size_t)0 : (size_t)cur.pm * tstep); const char* cB = (const char*)g.Bt + (size_t)cur.pb * tstep;
    if constexpr (GATHER) load_idx(cur.pm, vAc);
    S.a_ready(cur);
    if constexpr (SP2) {
        PG8_STAGE(PG8_SB(0, 0), cB, voffB); PG8_STAGE(PG8_SB(0, 1), cB + hstep, voffB); PG8_STAGE_A(PG8_SA(0, 0), cA, 0, false); PG8_STAGE_A(PG8_SA(0, 1), cA, 1, false);
        if (wr == 1) PG8_BAR;
        PG8_WAIT_V(2); PG8_BAR;
        PG8_STAGE(PG8_SB(1, 0), cB + kstep, voffB); PG8_STAGE_A(PG8_SA(1, 0), cA + kstep, 0, false); PG8_STAGE(PG8_SB(1, 1), cB + hstep + kstep, voffB);
        PG8_WAIT_V(6); PG8_BAR;
    } else {
        PG8_STAGE(PG8_SB(0, 0), cB, voffB); PG8_STAGE(PG8_SA(0, 0), cA, voffA); PG8_STAGE(PG8_SB(0, 1), cB + hstep, voffB); PG8_STAGE(PG8_SA(0, 1), cA + hstep, voffA);
        if (wr == 1) PG8_BAR;
        PG8_WAIT_V(4); PG8_BAR;
        PG8_STAGE(PG8_SB(1, 0), cB + kstep, voffB); PG8_STAGE(PG8_SA(1, 0), cA + kstep, voffA); PG8_STAGE(PG8_SB(1, 1), cB + hstep + kstep, voffB);
        PG8_WAIT_V(6); PG8_BAR;
    }
    for (;;) {
        const bool has_next = S.next(ui + 1, nxt);
        if constexpr (GATHER) { if (has_next) {
#pragma unroll
            for (int h = 0; h < 2; ++h)
#pragma unroll
                for (int i = 0; i < 2; ++i) __builtin_amdgcn_global_load_lds((const unsigned*)(g.rowidx + nxt.pm * BM + h * HALF + RA[i]), (PG8_LAS unsigned*)(lds + STAGE_BYTES + (h * 2 + i) * 2048 + wid * 256), 4, 0, 0); } }
        const char* nA = (has_next && !GATHER) ? (const char*)g.A + (size_t)nxt.pm * tstep : cA; const char* nB = has_next ? (const char*)g.Bt + (size_t)nxt.pb * tstep : cB;
        for (int t = 0; t < nt; t += 2) {
            const bool last = (t == nt - 2); const bool nxu = last && has_next; (void)nxu;
            if constexpr (GATHER) { if (nxu) {
#pragma unroll
                for (int h = 0; h < 2; ++h)
#pragma unroll
                    for (int i = 0; i < 2; ++i) { const int ix = *(const PG8_LAS int*)(lds + STAGE_BYTES + (h * 2 + i) * 2048 + tid * 4); vAn[h][i] = (unsigned)(ix * K + CA[i]) * 2u; } } }
            const char* a1 = cA + (size_t)(t + 1) * kstep;
            const char* a2 = last ? nA : cA + (size_t)(t + 2) * kstep; const char* b2 = last ? nB : cB + (size_t)(t + 2) * kstep;
            const char* a3 = a2 + kstep; const char* b3 = b2 + kstep;
            if (last && has_next) S.a_ready(nxt);
            if constexpr (SP2) {
            PG8_LDB(B0, 0, 0); PG8_LDB(B1, 0, 1); PG8_SCHED; PG8_LDA(At, 0, 0); PG8_STAGE_A(PG8_SA(1, 1), a1, 1, false);
            PG8_WAIT_V(8); PG8_WAIT_L(0); PG8_BAR; PG8_MMA(0, 0, At, B0); PG8_MMA(0, 1, At, B1); PG8_BAR; PG8_SCHED;
            PG8_LDA(At, 0, 1); PG8_STAGE(PG8_SB(0, 0), b2, voffB); PG8_STAGE(PG8_SB(0, 1), b2 + hstep, voffB); PG8_STAGE_A(PG8_SA(0, 0), a2, 0, nxu);
            PG8_WAIT_V(8); PG8_WAIT_L(0); PG8_BAR; PG8_MMA(1, 0, At, B0); PG8_MMA(1, 1, At, B1); PG8_BAR; PG8_SCHED;
            PG8_LDB(B0, 1, 0); PG8_LDB(B1, 1, 1); PG8_SCHED; PG8_LDA(At, 1, 0); PG8_STAGE_A(PG8_SA(0, 1), a2, 1, nxu);
            PG8_WAIT_V(8); PG8_WAIT_L(0); PG8_BAR; PG8_MMA(0, 0, At, B0); PG8_MMA(0, 1, At, B1); PG8_BAR; PG8_SCHED;
            PG8_LDA(At, 1, 1); PG8_STAGE(PG8_SB(1, 0), b3, voffB); PG8_STAGE(PG8_SB(1, 1), b3 + hstep, voffB); PG8_STAGE_A(PG8_SA(1, 0), a3, 0, nxu);
            PG8_WAIT_V(8); PG8_WAIT_L(0); PG8_BAR; PG8_MMA(1, 0, At, B0); PG8_MMA(1, 1, At, B1); PG8_BAR; PG8_SCHED;
            } else {
            PG8_LDB(B0, 0, 0); PG8_SCHED; PG8_LDA(At, 0, 0); PG8_STAGE(PG8_SA(1, 1), a1 + hstep, voffA);
            PG8_WAIT_L(8); PG8_BAR; PG8_WAIT_L(0); PG8_MMA(0, 0, At, B0); PG8_BAR; PG8_SCHED;
            PG8_LDB(B1, 0, 1); PG8_STAGE(PG8_SB(0, 0), b2, voffB);
            PG8_BAR; PG8_WAIT_L(0); PG8_MMA(0, 1, At, B1); PG8_BAR;
            PG8_LDA(At, 0, 1); PG8_STAGE(PG8_SA(0, 0), a2, voffA);
            PG8_BAR; PG8_WAIT_L(0); PG8_MMA(1, 0, At, B0); PG8_BAR; PG8_SCHED;
            PG8_STAGE(PG8_SB(0, 1), b2 + hstep, voffB);
            PG8_WAIT_V(6); PG8_BAR; PG8_MMA(1, 1, At, B1); PG8_BAR;
            PG8_LDB(B0, 1, 0); PG8_SCHED; PG8_LDA(At, 1, 0); PG8_STAGE(PG8_SA(0, 1), a2 + hstep, voffA);
            PG8_WAIT_L(8); PG8_BAR; PG8_WAIT_L(0); PG8_MMA(0, 0, At, B0); PG8_BAR; PG8_SCHED;
            PG8_LDB(B1, 1, 1); PG8_STAGE(PG8_SB(1, 0), b3, voffB);
            PG8_BAR; PG8_WAIT_L(0); PG8_MMA(0, 1, At, B1); PG8_BAR;
            PG8_LDA(At, 1, 1); PG8_STAGE(PG8_SA(1, 0), a3, voffA);
            PG8_BAR; PG8_WAIT_L(0); PG8_MMA(1, 0, At, B0); PG8_BAR; PG8_SCHED;
            PG8_STAGE(PG8_SB(1, 1), b3 + hstep, voffB);
            PG8_WAIT_V(6); PG8_BAR; PG8_MMA(1, 1, At, B1); PG8_BAR;
            }
        }
        if constexpr (ALIGN_EPI) { if (wr == 0) PG8_BAR; }
        if constexpr (!Epi::AFTER_DRAIN) { E(acc, cur, wr, wc, fr, fq); S.done(cur); }
        if (!has_next) break;
#pragma unroll
        for (int a = 0; a < 2; ++a)
#pragma unroll
            for (int b = 0; b < 2; ++b)
#pragma unroll
                for (int m = 0; m < 4; ++m)
#pragma unroll
                    for (int n = 0; n < 2; ++n) acc[a][b][m][n] = (f32x4){0.f, 0.f, 0.f, 0.f};
        cur = nxt; cA = nA; cB = nB; ++ui;
        if constexpr (GATHER) {
#pragma unroll
            for (int h = 0; h < 2; ++h) { vAc[h][0] = vAn[h][0]; vAc[h][1] = vAn[h][1]; } }
        if constexpr (ALIGN_EPI) { if (wr == 1) PG8_BAR; }
    }
    PG8_WAIT_V(0);
    if constexpr (!ALIGN_EPI) { if (wr == 0) PG8_BAR; }
    PG8_BAR;
    if constexpr (Epi::AFTER_DRAIN) { E.fused(acc, cur, wr, wc, fr, fq, lds, wid, lane); S.done(cur); }
#undef PG8_SA
#undef PG8_SB
#undef PG8_STAGE
#undef PG8_STAGE_A
#undef PG8_LDA
#undef PG8_LDB
#undef PG8_MMA
#undef PG8_WAIT_V
#undef PG8_WAIT_L
#undef PG8_BAR
#undef PG8_SCHED
}
}
constexpr int NB = 8, SEQ = 2048, DM = 1024, CTXL = 256, ML = NB * SEQ, MC = NB * CTXL, MT = ML + MC;
constexpr int PP = 2560;
constexpr int INW = 2336;
constexpr int C_GK = 0, C_GV = 128, C_GAF = 384, C_GAB = 400, C_NK = 416, C_NV = 672, C_SK = 928, C_SV = 1056, C_GQ = 1184, C_GG = 1312, C_NQ = 1568, C_SQ = 1824;
constexpr int NWAVES = 8;
constexpr float NEPS = 1e-6f;
constexpr float LOG2E = 1.4426950408889634f;

constexpr size_t MiB = 1u << 20;
constexpr size_t WS_CTL = 0, CTL_ZERO_BYTES = 65536;
constexpr size_t WS_TAB = 1 * MiB;
constexpr size_t WS_MOD = 1 * MiB + 65536;
constexpr size_t WS_MODP = 2 * MiB;
constexpr size_t WS_WIN = 6 * MiB;
constexpr size_t WS_WOUT = 16 * MiB;
constexpr size_t WS_WGU = 20 * MiB;
constexpr size_t WS_WD = 148 * MiB;
constexpr size_t WS_H = 212 * MiB;
constexpr size_t WS_R1 = 248 * MiB;
constexpr size_t WS_R2 = 338 * MiB;
constexpr size_t WS_XB = 410 * MiB;
constexpr size_t WS_UST = 446 * MiB;
constexpr size_t WS_MISC = 464 * MiB;
constexpr size_t WS_DEC = WS_MISC;
constexpr size_t WS_AFF = WS_MISC + 1 * MiB;
constexpr size_t WS_AFFC = WS_MISC + 2 * MiB;
constexpr size_t WS_GATE = WS_MISC + 2 * MiB + 262144;
constexpr size_t WS_GATEC = WS_MISC + 2 * MiB + 524288;
constexpr size_t WS_INV = WS_MISC + 3 * MiB;
constexpr size_t WS_ROWIDX = WS_MISC + 3 * MiB + 786432;
constexpr size_t WS_END = 468 * MiB;
constexpr int CW_BAR = 4096;
constexpr int CW_QUEUE = 1024;
constexpr int CW_CONV = 2048;

constexpr int WAVE_LDS = 19456;
constexpr int RING_BYTES = NWAVES * WAVE_LDS;
constexpr int LDSCTL_OFF = RING_BYTES, MISC_OFF = LDSCTL_OFF + 320;
constexpr int LDS_BYTES = RING_BYTES + 1024;
static_assert(RING_BYTES >= pg8::STAGE_BYTES && LDS_BYTES <= 163840, "LDS map");

#define GAS __attribute__((address_space(1)))
#define LAS __attribute__((address_space(3)))
typedef unsigned short bf16_t;
typedef unsigned v4u __attribute__((ext_vector_type(4)));
typedef unsigned v2u __attribute__((ext_vector_type(2)));
typedef float f32x4 __attribute__((ext_vector_type(4)));
typedef float f32x2 __attribute__((ext_vector_type(2)));
typedef float f32x16 __attribute__((ext_vector_type(16)));
typedef short bf16x8 __attribute__((ext_vector_type(8)));
typedef short s16x4 __attribute__((ext_vector_type(4)));
typedef GAS unsigned gu32;
#define RLX_AGENT __ATOMIC_RELAXED, __HIP_MEMORY_SCOPE_AGENT
typedef __bf16 bf16x2_t __attribute__((ext_vector_type(2)));
__device__ __forceinline__ unsigned pk2(float lo, float hi) { f32x2 v = {lo, hi}; bf16x2_t b = __builtin_convertvector(v, bf16x2_t); return __builtin_bit_cast(unsigned, b); }
__device__ __forceinline__ float bflo(unsigned w) { return __uint_as_float(w << 16); }
__device__ __forceinline__ float bfhi(unsigned w) { return __uint_as_float(w & 0xffff0000u); }
__device__ __forceinline__ float bf1(bf16_t w) { return __uint_as_float((unsigned)w << 16); }
__device__ __forceinline__ float wave_sum(float v) {
#pragma unroll
    for (int o = 1; o < 64; o <<= 1) v += __shfl_xor(v, o);
    return v;
}
__device__ __forceinline__ float fexp2(float x) { return __builtin_amdgcn_exp2f(x); }
__device__ __forceinline__ float fexp(float x) { return __builtin_amdgcn_exp2f(x * LOG2E); }
__device__ __forceinline__ float flog(float x) { return __builtin_amdgcn_logf(x) * 0.6931471805599453f; }
__device__ __forceinline__ float frcp(float x) { return __builtin_amdgcn_rcpf(x); }
__device__ __forceinline__ float silu_f(float x) { return x * frcp(1.f + fexp(-x)); }
__device__ __forceinline__ int crow(int r, int hi) { return (r & 3) + 8 * (r >> 2) + 4 * hi; }
__device__ __forceinline__ s16x4 tr_read(LAS const unsigned char* p) { return __builtin_bit_cast(s16x4, __builtin_amdgcn_ds_read_tr16_b64_v4i16((LAS s16x4*)p)); }
__device__ __forceinline__ bf16x8 cat4(s16x4 a, s16x4 b) { return (bf16x8){a[0], a[1], a[2], a[3], b[0], b[1], b[2], b[3]}; }
__device__ __forceinline__ bf16x8 pack8(float a0, float a1, float a2, float a3, float a4, float a5, float a6, float a7) {
    v4u w; w.x = pk2(a0, a1); w.y = pk2(a2, a3); w.z = pk2(a4, a5); w.w = pk2(a6, a7); return __builtin_bit_cast(bf16x8, w); }
#define MFMA32(a, b, c) __builtin_amdgcn_mfma_f32_32x32x16_bf16((a), (b), (c), 0, 0, 0)

#ifndef EARLY_WB
#define EARLY_WB 0
#endif
#define XB_TMO      128
#define XB_XCNT(j)  (256  + 64 * (j))
#define XB_XSUB(j)  (1280 + 64 * (j))
#define XB_XGEN(j)  (2304 + 64 * (j))
#define XB_TOP      3328
#define XB_TOPGEN   3392
#define XCD_BAR_WORDS 3456
#define XB_SPIN_CAP (1u << 18)

__device__ __forceinline__ unsigned xb_ld(unsigned* p)              { return __hip_atomic_load(p, __ATOMIC_RELAXED, __HIP_MEMORY_SCOPE_AGENT); }
__device__ __forceinline__ unsigned xb_add(unsigned* p, unsigned v) { return __hip_atomic_fetch_add(p, v, __ATOMIC_RELAXED, __HIP_MEMORY_SCOPE_AGENT); }
__device__ __forceinline__ unsigned xb_xcc_id() { return (unsigned)__builtin_amdgcn_s_getreg((3 << 11) | 20) & 0xFu; }
#define XB_SPIN(cond, bar) do { unsigned _sp = 0; while (cond) { __builtin_amdgcn_s_sleep(1); \
    if ((++_sp & 255u) == 0u) { if (xb_ld(&(bar)[XB_TMO])) break; if (_sp > XB_SPIN_CAP) { atomicAdd(&(bar)[XB_TMO], 1u); break; } } } } while (0)

struct XcdBarrier {
    unsigned* bar; unsigned x;
    volatile LAS unsigned* st;
};

__device__ __forceinline__ XcdBarrier xcd_barrier_post(unsigned* bar, volatile LAS unsigned* st) {
    XcdBarrier b; b.bar = bar; b.x = xb_xcc_id(); b.st = st;
    if (threadIdx.x == 0) (void)xb_add(&bar[XB_XCNT(b.x)], 1u);
    return b;
}
__device__ __forceinline__ void xcd_barrier_complete(unsigned* bar, unsigned x, unsigned& nloc, unsigned& nx) {
    const unsigned G = gridDim.x * gridDim.y * gridDim.z;
    unsigned sum, cnt, mine, sp = 0u;
    for (;;) {
        sum = 0u; cnt = 0u; mine = 0u;
#pragma unroll
        for (unsigned j = 0; j < 16; ++j) { const unsigned c = xb_ld(&bar[XB_XCNT(j)]); sum += c; cnt += (c > 0u) ? 1u : 0u; mine = (j == x) ? c : mine; }
        if (sum == G) break;
        __builtin_amdgcn_s_sleep(1);
        if ((++sp & 255u) == 0u) { if (xb_ld(&bar[XB_TMO])) break; if (sp > XB_SPIN_CAP) { atomicAdd(&bar[XB_TMO], 1u); break; } }
    }
    nloc = mine > 0u ? mine : 1u; nx = cnt > 0u ? cnt : 1u;
}

__device__ __forceinline__ void xcd_barrier(const XcdBarrier& b) {
    asm volatile("s_waitcnt vmcnt(0)" ::: "memory");
    __syncthreads();
    if (threadIdx.x == 0) {
        unsigned* bar = b.bar;
        __builtin_amdgcn_s_waitcnt(0);
        unsigned nloc = b.st[0], nx = b.st[1];
        if (nloc == 0u) { xcd_barrier_complete(bar, b.x, nloc, nx); b.st[0] = nloc; b.st[1] = nx; }
#if EARLY_WB
        __builtin_amdgcn_fence(__ATOMIC_RELEASE, "agent");
        asm volatile("s_waitcnt vmcnt(0)" ::: "memory");
#endif
        const unsigned old = xb_add(&bar[XB_XSUB(b.x)], 1u);
        const unsigned gen = old / nloc;
        if (old + 1u == (gen + 1u) * nloc) {
            __builtin_amdgcn_fence(__ATOMIC_RELEASE, "agent");
            asm volatile("s_waitcnt vmcnt(0)" ::: "memory");
            const unsigned og = xb_add(&bar[XB_TOP], 1u);
            const unsigned tg = og / nx;
            if (og + 1u == (tg + 1u) * nx) xb_add(&bar[XB_TOPGEN], 1u);
            else XB_SPIN(xb_ld(&bar[XB_TOPGEN]) == tg, bar);
            __builtin_amdgcn_fence(__ATOMIC_ACQUIRE, "agent");
            xb_add(&bar[XB_XGEN(b.x)], 1u);
            asm volatile("s_waitcnt vmcnt(0)" ::: "memory");
        } else {
            XB_SPIN(xb_ld(&bar[XB_XGEN(b.x)]) == gen, bar);
            __builtin_amdgcn_fence(__ATOMIC_ACQUIRE, "agent");
            asm volatile("s_waitcnt vmcnt(0)" ::: "memory");
        }
    }
    __syncthreads();
}
__device__ __forceinline__ void ld_row_f32(const float* p, int lane, f32x4 (&v)[4]) {
#pragma unroll
    for (int j = 0; j < 4; ++j) v[j] = *(const f32x4*)(p + 256 * j + 4 * lane);
}
__device__ __forceinline__ void st_row_f32(float* p, int lane, const f32x4 (&v)[4]) {
#pragma unroll
    for (int j = 0; j < 4; ++j) *(f32x4*)(p + 256 * j + 4 * lane) = v[j];
}
__device__ __forceinline__ void ld_row_bf16(const bf16_t* p, int lane, f32x4 (&v)[4]) {
#pragma unroll
    for (int j = 0; j < 4; ++j) { const v2u w = *(const v2u*)(p + 256 * j + 4 * lane); v[j] = (f32x4){bflo(w.x), bfhi(w.x), bflo(w.y), bfhi(w.y)}; }
}
__device__ __forceinline__ void st_row_bf16(bf16_t* p, int lane, const f32x4 (&v)[4]) {
#pragma unroll
    for (int j = 0; j < 4; ++j) { v2u w; w.x = pk2(v[j].x, v[j].y); w.y = pk2(v[j].z, v[j].w); *(v2u*)(p + 256 * j + 4 * lane) = w; }
}
__device__ __forceinline__ void ld_vec_lds(LAS const float* p, int lane, f32x4 (&v)[4]) {
#pragma unroll
    for (int j = 0; j < 4; ++j) v[j] = *(LAS const f32x4*)(p + 256 * j + 4 * lane);
}
__device__ __forceinline__ float sumsq16(const f32x4 (&v)[4]) {
    float s = 0.f;
#pragma unroll
    for (int j = 0; j < 4; ++j) s += (v[j].x * v[j].x + v[j].y * v[j].y) + (v[j].z * v[j].z + v[j].w * v[j].w);
    return s;
}
__device__ __forceinline__ float modfin(const float* modp, const float* bmod, int l, int r, int n) {
    float s = bmod[l * 6144 + n];
#pragma unroll
    for (int kc = 0; kc < 8; ++kc) s += modp[((size_t)(l * 8 + kc) * 9 + r) * 6144 + n];
    return s;
}

#ifndef CV_G1
#define CV_G1 4
#endif
#ifndef CV_G2
#define CV_G2 6
#endif
#ifndef CV_M1
#define CV_M1 0
#endif
#ifndef CV_G3
#define CV_G3 4
#endif
#ifndef CV_G4
#define CV_G4 4
#endif
#ifndef CONV_M3
#define CONV_M3 2944
#endif
#ifndef CONV_IN_P0
#define CONV_IN_P0 1
#endif
__device__ __forceinline__ void tr_item64(const float* W, int N, int Nvalid, bf16_t* WT, int Kd, int k0, int n0, int dst_row0, LAS float* scr, int lane) {
    const int q = lane & 15, kr = lane >> 4;
    f32x4 t[16];
#pragma unroll
    for (int i = 0; i < 16; ++i) { const int kk = 4 * i + kr; const int n = n0 + 4 * q;
        t[i] = (n < Nvalid) ? *(const f32x4*)(W + (size_t)(k0 + kk) * N + n) : (f32x4){0.f, 0.f, 0.f, 0.f}; }
#pragma unroll
    for (int i = 0; i < 16; ++i) { const int kk = 4 * i + kr; LAS float* d = scr + kk * 65 + 4 * q; d[0] = t[i].x; d[1] = t[i].y; d[2] = t[i].z; d[3] = t[i].w; }
    const int c = lane & 7, nl = lane >> 3;
#pragma unroll
    for (int j = 0; j < 8; ++j) { const int n = nl + 8 * j; LAS const float* s = scr + (8 * c) * 65 + n;
        v4u o; o.x = pk2(s[0 * 65], s[1 * 65]); o.y = pk2(s[2 * 65], s[3 * 65]); o.z = pk2(s[4 * 65], s[5 * 65]); o.w = pk2(s[6 * 65], s[7 * 65]);
        *(v4u*)(WT + (size_t)(dst_row0 + n) * Kd + k0 + 8 * c) = o; }
}
__device__ __forceinline__ void expert_conv_item(const float* const* in, unsigned char* ws, int l, int r, LAS float* scr, int lane) {
    const float* w_gate = in[15]; const float* w_up = in[16]; const float* w_down = in[17];
    const int which = r >> 12; r &= 4095;
    const int e = r >> 8, kb = (r & 255) >> 4, nb = r & 15, n0 = 64 * nb;
    const size_t eoff = (size_t)(l * 16 + e) * 1024 * 1024;
    if (which == 0) tr_item64(w_gate + eoff, 1024, 1024, (bf16_t*)(ws + WS_WGU) + 2 * eoff, 1024, 64 * kb, n0, (n0 >> 7) * 256 + (n0 & 127), scr, lane);
    else if (which == 1) tr_item64(w_up + eoff, 1024, 1024, (bf16_t*)(ws + WS_WGU) + 2 * eoff, 1024, 64 * kb, n0, (n0 >> 7) * 256 + 128 + (n0 & 127), scr, lane);
    else tr_item64(w_down + eoff, 1024, 1024, (bf16_t*)(ws + WS_WD) + eoff, 1024, 64 * kb, n0, n0, scr, lane);
}
__device__ __forceinline__ void conv_pull(const float* const* in, unsigned char* ws, int l_lo, int l_hi, int budget, LAS float* scr, int lane) {
    for (int l = l_lo; l <= l_hi && l < 2; ++l) {
        unsigned* ctr = (unsigned*)(ws + WS_CTL) + CW_CONV + 64 * l;
        while (budget > 0) {
            const int c = budget < 8 ? budget : 8;
            unsigned r = 0; if (lane == 0) r = __hip_atomic_fetch_add(ctr, (unsigned)c, __ATOMIC_RELAXED, __HIP_MEMORY_SCOPE_AGENT);
            r = (unsigned)__builtin_amdgcn_readfirstlane((int)r);
            if (r >= 12288u) break;
            for (int k = 0; k < c && (int)r + k < 12288; ++k) expert_conv_item(in, ws, l, (int)r + k, scr, lane);
            budget -= c;
        }
    }
}
struct TrDesc { const float* src; bf16_t* dst; int N, Nvalid, k0, n0, drow; };
constexpr int TR_IN = 16 * 40, TR_OUT = 16 * 16, TR_E = 16 * 16 * 16, TR_L = TR_IN + TR_OUT + 3 * TR_E, TR_ALL = 2 * TR_L;
constexpr int CV_N1 = CV_G1 * 384, CV_N2 = CV_G2 * 1792, CV_N3 = CV_G3 * 1024, CV_N4 = CV_G4 * 1536;
constexpr int P0_A = TR_L - CV_N1 - CV_N2;
constexpr int P0_B = TR_ALL - CONV_M3 - CV_N3 - CV_N4;
static_assert(P0_A >= 896 && P0_B >= TR_L, "tail conversion budgets exceed the expert tiles");
__device__ __forceinline__ void tr_desc(const float* const* in, unsigned char* ws, int r, TrDesc& d) {
    const int l = r / TR_L; r -= l * TR_L;
    if (r < TR_IN) { const int kb = r / 40, nb = r % 40; d.src = in[7] + (size_t)l * 1024 * INW; d.dst = (bf16_t*)(ws + WS_WIN) + (size_t)l * PP * 1024; d.N = INW; d.Nvalid = INW; d.k0 = 64 * kb; d.n0 = 64 * nb; d.drow = 64 * nb; return; }
    r -= TR_IN;
    if (r < TR_OUT) { const int kb = r / 16, nb = r % 16; d.src = in[8] + (size_t)l * 1024 * 1024; d.dst = (bf16_t*)(ws + WS_WOUT) + (size_t)l * 1024 * 1024; d.N = 1024; d.Nvalid = 1024; d.k0 = 64 * kb; d.n0 = 64 * nb; d.drow = 64 * nb; return; }
    r -= TR_OUT;
    const int which = r >> 12; r &= 4095;
    const int e = r >> 8, kb = (r & 255) >> 4, nb = r & 15, n0 = 64 * nb;
    const size_t eoff = (size_t)(l * 16 + e) * 1024 * 1024;
    d.N = 1024; d.Nvalid = 1024; d.k0 = 64 * kb; d.n0 = n0;
    if (which == 0) { d.src = in[15] + eoff; d.dst = (bf16_t*)(ws + WS_WGU) + 2 * eoff; d.drow = (n0 >> 7) * 256 + (n0 & 127); }
    else if (which == 1) { d.src = in[16] + eoff; d.dst = (bf16_t*)(ws + WS_WGU) + 2 * eoff; d.drow = (n0 >> 7) * 256 + 128 + (n0 & 127); }
    else { d.src = in[17] + eoff; d.dst = (bf16_t*)(ws + WS_WD) + eoff; d.drow = n0; }
}
__device__ __forceinline__ void tr_load(const TrDesc& d, int lane, f32x4 (&t)[16]) {
    const int q = lane & 15, kr = lane >> 4, n = d.n0 + 4 * q;
    const float* p = d.src + (size_t)(d.k0 + kr) * d.N + (n < d.Nvalid ? n : 0);
#pragma unroll
    for (int i = 0; i < 16; ++i) t[i] = *(const f32x4*)(p + (size_t)(4 * i) * d.N);
}
__device__ __forceinline__ void tr_finish(const TrDesc& d, f32x4 (&t)[16], LAS float* scr, int lane) {
    const int q = lane & 15, kr = lane >> 4; const bool valid = (d.n0 + 4 * q) < d.Nvalid;
#pragma unroll
    for (int i = 0; i < 16; ++i) { const int kk = 4 * i + kr; LAS float* s = scr + kk * 65 + 4 * q; const f32x4 v = valid ? t[i] : (f32x4){0.f, 0.f, 0.f, 0.f}; s[0] = v.x; s[1] = v.y; s[2] = v.z; s[3] = v.w; }
    const int c = lane & 7, nl = lane >> 3;
#pragma unroll
    for (int j = 0; j < 8; ++j) { const int n = nl + 8 * j; LAS const float* s = scr + (8 * c) * 65 + n;
        v4u o; o.x = pk2(s[0 * 65], s[1 * 65]); o.y = pk2(s[2 * 65], s[3 * 65]); o.z = pk2(s[4 * 65], s[5 * 65]); o.w = pk2(s[6 * 65], s[7 * 65]);
        *(v4u*)(d.dst + (size_t)(d.drow + n) * 1024 + d.k0 + 8 * c) = o; }
}
__device__ __forceinline__ void tr_stream(const float* const* in, unsigned char* ws, int first, int stride, int hi, LAS float* scr, int lane, int cut = 1 << 30, int jump = 0) {
#define TR_ID(x) ((x) < cut ? (x) : (x) + jump)
    if (first >= hi) return;
    const int n_my = (hi - first + stride - 1) / stride;
    TrDesc dA, dB; f32x4 tA[16], tB[16];
    tr_desc(in, ws, TR_ID(first), dA); tr_load(dA, lane, tA);
    for (int i = 0; i < n_my; i += 2) {
        { const int nx = i + 1 < n_my ? i + 1 : n_my - 1; tr_desc(in, ws, TR_ID(first + nx * stride), dB); tr_load(dB, lane, tB); }
        tr_finish(dA, tA, scr, lane);
        if (i + 1 >= n_my) break;
        { const int nx = i + 2 < n_my ? i + 2 : n_my - 1; tr_desc(in, ws, TR_ID(first + nx * stride), dA); tr_load(dA, lane, tA); }
        tr_finish(dB, tB, scr, lane);
    }
#undef TR_ID
}
__device__ __forceinline__ void phase_p0(const float* const* in, unsigned char* ws, LAS unsigned char* wl, int gw, int NGW, int lane) {
    const float* cvec = in[1]; const float* cctx = in[3]; const float* wmod = in[4];
    const float* w_in = in[7]; const float* w_out = in[8];
    float* modp = (float*)(ws + WS_MODP);
    constexpr int NI_MOD = 2 * 8 * 24, NI_ROPE = 16;
    constexpr int NI_IN = 16 * 40, NI_OUT = 16 * 16, NI_E = 16 * 16 * 16;
    constexpr int NI_L = NI_IN + NI_OUT + (CONV_IN_P0 ? 3 * NI_E : 0);
    constexpr int NITEMS = NI_MOD + NI_ROPE + 2 * NI_L;
    LAS float* scr = (LAS float*)wl;
    for (int it = gw; it < NI_MOD + NI_ROPE; it += NGW) {
        int r = it;
        if (r < NI_MOD) {
            const int cb = r % 24, kc = (r / 24) & 7, l = r / 192;
            for (int idx = lane; idx < 128 * 9; idx += 64) { const int rr = idx / 128, k = idx % 128; const float cv = (rr < 8) ? cvec[rr * 1024 + kc * 128 + k] : cctx[kc * 128 + k]; scr[k * 12 + rr] = silu_f(cv); }
            f32x4 acc[9];
#pragma unroll
            for (int rr = 0; rr < 9; ++rr) acc[rr] = (f32x4){0.f, 0.f, 0.f, 0.f};
            const float* wp = wmod + ((size_t)l * 1024 + kc * 128) * 6144 + cb * 256 + 4 * lane;
#pragma unroll 4
            for (int k = 0; k < 128; ++k) { const f32x4 w = *(const f32x4*)(wp + (size_t)k * 6144);
                const f32x4 s0 = *(LAS const f32x4*)(scr + k * 12), s1 = *(LAS const f32x4*)(scr + k * 12 + 4); const float s8 = scr[k * 12 + 8];
                acc[0] += w * s0.x; acc[1] += w * s0.y; acc[2] += w * s0.z; acc[3] += w * s0.w; acc[4] += w * s1.x; acc[5] += w * s1.y; acc[6] += w * s1.z; acc[7] += w * s1.w; acc[8] += w * s8; }
#pragma unroll
            for (int rr = 0; rr < 9; ++rr) *(f32x4*)(modp + ((size_t)(l * 8 + kc) * 9 + rr) * 6144 + cb * 256 + 4 * lane) = acc[rr];
            continue;
        }
        r -= NI_MOD;
        if (r < NI_ROPE) {
            const int id = r * 64 + lane, pos = id >> 4, i = id & 15;
            const float fr = fexp2(-(float)i * (13.287712379549449f / 16.f));
            float rev = (float)pos * fr * 0.15915494309189535f; rev -= floorf(rev);
            f32x2 cs; cs.x = __builtin_amdgcn_cosf(rev); cs.y = __builtin_amdgcn_sinf(rev);
            ((f32x2*)(ws + WS_TAB))[id] = cs;
            continue;
        }
        break;
    }
    if (NGW == 2048) tr_stream(in, ws, (gw + NGW - (NI_MOD + NI_ROPE)) % NGW, NGW, P0_A + (P0_B - TR_L), scr, lane, P0_A, TR_L - P0_A);
    else tr_stream(in, ws, gw, NGW, TR_ALL, scr, lane);
}

__device__ __forceinline__ void phase_a0(const float* const* in, unsigned char* ws, LAS unsigned char* lds, int G, int tid, int wave, int lane) {
    const float* x = in[0]; const float* ctx = in[2]; const float* bmod = in[5]; const float* gains = in[6];
    const float* modp = (const float*)(ws + WS_MODP); float* mod = (float*)(ws + WS_MOD); bf16_t* H = (bf16_t*)(ws + WS_H);
    LAS float* V = (LAS float*)lds;
    for (int idx = blockIdx.x * 512 + tid; idx < 18 * 6144; idx += G * 512) { const int row = idx / 6144, n = idx - row * 6144; mod[idx] = modfin(modp, bmod, row / 9, row % 9, n); }
    for (int t = blockIdx.x; t < 256; t += G) {
        const int b = t >> 5;
        f32x4 xq[9][4];
#pragma unroll
        for (int i = 0; i < 9; ++i) { const bool isc = (i == 8);
            const float* src = isc ? (ctx + (size_t)(8 * t + wave) * 1024) : (x + (size_t)(64 * t + 8 * wave + i) * 1024); ld_row_f32(src, lane, xq[i]); }
        __syncthreads();
        for (int n = tid; n < 1024; n += 512) { const float g = gains[n];
            V[n] = g * (1.f + modfin(modp, bmod, 0, b, 1024 + n)); V[1024 + n] = modfin(modp, bmod, 0, b, n);
            V[2048 + n] = g * (1.f + modfin(modp, bmod, 0, 8, 1024 + n)); V[3072 + n] = modfin(modp, bmod, 0, 8, n); }
        __syncthreads();
#pragma unroll
        for (int i = 0; i < 9; ++i) { const bool isc = (i == 8);
            const int row = isc ? (ML + 8 * t + wave) : (64 * t + 8 * wave + i);
            f32x4 (&v)[4] = xq[i]; f32x4 a[4], s[4];
            const float rstd = __builtin_amdgcn_rsqf(wave_sum(sumsq16(v)) * (1.f / 1024.f) + NEPS);
            ld_vec_lds(V + (isc ? 2048 : 0), lane, a); ld_vec_lds(V + (isc ? 3072 : 1024), lane, s);
#pragma unroll
            for (int j = 0; j < 4; ++j) v[j] = v[j] * rstd * a[j] + s[j];
            st_row_bf16(H + (size_t)row * 1024, lane, v);
        }
    }
}
constexpr int VP = 192;
struct AttnTile { f32x16 o0, o1; float m, lsum; };
__device__ __forceinline__ void attn_softmax(f32x16& s, AttnTile& T) {
    float bm = fmaxf(fmaxf(s[0], s[1]), fmaxf(s[2], s[3]));
#pragma unroll
    for (int i = 4; i < 16; i += 4) bm = fmaxf(bm, fmaxf(fmaxf(s[i], s[i + 1]), fmaxf(s[i + 2], s[i + 3])));
    bm = fmaxf(bm, __shfl_xor(bm, 32));
    const float mo = T.m, mn = fmaxf(mo, bm);
    T.m = mn;
    float ps = 0.f;
#pragma unroll
    for (int i = 0; i < 16; ++i) { s[i] = fexp2(s[i] - mn); ps += s[i]; }
    if (__any(mn != mo)) {
        const float alpha = fexp2(mo - mn);
        T.lsum *= alpha;
#pragma unroll
        for (int i = 0; i < 16; ++i) { T.o0[i] *= alpha; T.o1[i] *= alpha; }
    }
    T.lsum += ps;
}
__device__ __forceinline__ void attn_item(const int MODE, const bf16_t* P, bf16_t* MIX, int item, LAS unsigned char* wl, int lane,
                                          const float* __restrict__ rpb, const float* __restrict__ sink, const bool dry = false) {
    asm volatile("" : "+v"(lane));
    const int ql = lane & 31, hi = lane >> 5;
    int b, hq, qcol, kcol, vcol, ocol, qrow0, r = 0, rs = 0, q64 = 0, nloc, kb_lo = 0;
    if (MODE == 0) { r = item & 31; hq = (item >> 5) & 3; b = item >> 7;
        qcol = C_NQ + hq * 64; kcol = C_NK + hq * 64; vcol = C_NV + hq * 64; ocol = 256 + hq * 64; qrow0 = b * SEQ + r * 64;
        rs = r - 4; rs = rs < 0 ? 0 : (rs > 24 ? 24 : rs); nloc = 16; }
    else if (MODE == 1) { q64 = item & 31; hq = (item >> 5) & 7; b = item >> 8;
        qcol = C_SQ + hq * 64; kcol = C_SK + (hq >> 2) * 64; vcol = C_SV + (hq >> 2) * 64; ocol = 512 + hq * 64; qrow0 = b * SEQ + q64 * 64;
        kb_lo = 2 * q64 - 4; if (kb_lo < 0) kb_lo = 0; int kb_hi = 2 * q64 + 5; if (kb_hi > 63) kb_hi = 63; nloc = kb_hi - kb_lo + 1; }
    else if (MODE == 2) { q64 = item & 3; hq = (item >> 2) & 3; b = item >> 4;
        qcol = C_NQ + hq * 64; kcol = C_NK + hq * 64; vcol = C_NV + hq * 64; ocol = 256 + hq * 64; qrow0 = ML + b * CTXL + q64 * 64; nloc = 0; }
    else { q64 = item & 3; hq = (item >> 2) & 7; b = item >> 5;
        qcol = C_SQ + hq * 64; kcol = C_SK + (hq >> 2) * 64; vcol = C_SV + (hq >> 2) * 64; ocol = 512 + hq * 64; qrow0 = ML + b * CTXL + q64 * 64; nloc = 0; }
    const int nblk = 8 + nloc;
    LAS unsigned char* vl = wl;
    LAS float* rl = (LAS float*)(wl + 32 * VP);
    if (MODE == 0) { for (int i = lane; i < 465; i += 64) rl[i] = rpb[hq * 465 + i] * LOG2E; }
    LAS unsigned char* qimg = wl + 32 * VP + 1920;
    constexpr int QP = 144;
#pragma unroll
    for (int i = 0; i < 8; ++i) { const int c = lane + 64 * i; const v4u v = *(const v4u*)(P + (size_t)(qrow0 + (c >> 3)) * PP + qcol + (c & 7) * 8); *(LAS v4u*)(qimg + (c >> 3) * QP + (c & 7) * 16) = v; }
    LAS const unsigned char* qrd = qimg + ql * QP + 16 * hi;
    auto blk_row0 = [&](int blk) -> int {
        if (blk < 8) return ML + b * CTXL + blk * 32;
        const int lb = blk - 8;
        if (MODE == 0) return b * SEQ + (rs + (lb >> 1)) * 64 + (lb & 1) * 32;
        return b * SEQ + 32 * (kb_lo + lb);
    };
    auto load_blk = [&](int blk, bf16x8 (&kn)[4], v4u (&vn)[4]) {
        const int r0 = blk_row0(blk);
        const bf16_t* kp = P + (size_t)(r0 + ql) * PP + kcol + 8 * hi;
#pragma unroll
        for (int ds = 0; ds < 4; ++ds) kn[ds] = *(const bf16x8*)(kp + 16 * ds);
#pragma unroll
        for (int i = 0; i < 4; ++i) { const int c = lane + 64 * i; vn[i] = *(const v4u*)(P + (size_t)(r0 + (c >> 3)) * PP + vcol + (c & 7) * 8); }
    };
    AttnTile T[2];
#pragma unroll
    for (int t = 0; t < 2; ++t) { T[t].m = -INFINITY; T[t].lsum = 0.f;
#pragma unroll
        for (int i = 0; i < 16; ++i) { T[t].o0[i] = 0.f; T[t].o1[i] = 0.f; } }
    const int tr_off = (4 * hi + ((lane & 15) >> 2)) * VP + (16 * ((lane >> 4) & 1) + 4 * (lane & 3)) * 2;
    auto step = [&](int blk, bf16x8 (&kf)[4], v4u (&vr)[4]) {
#pragma unroll
        for (int i = 0; i < 4; ++i) { const int c = lane + 64 * i; *(LAS v4u*)(vl + (c >> 3) * VP + (c & 7) * 16) = vr[i]; }
        f32x16 sc[2];
#pragma unroll
        for (int t = 0; t < 2; ++t) {
#pragma unroll
            for (int i = 0; i < 16; ++i) sc[t][i] = 0.f;
#pragma unroll
            for (int ds = 0; ds < 4; ++ds) sc[t] = MFMA32(kf[ds], *(LAS const bf16x8*)(qrd + 32 * t * QP + 32 * ds), sc[t]);
        }
        if (blk + 2 < nblk) load_blk(blk + 2, kf, vr);
        bf16x8 vf[2][2];
#pragma unroll
        for (int ks = 0; ks < 2; ++ks) { LAS const unsigned char* vb = vl + tr_off + 16 * ks * VP;
            vf[ks][0] = cat4(tr_read(vb), tr_read(vb + 8 * VP)); vf[ks][1] = cat4(tr_read(vb + 64), tr_read(vb + 8 * VP + 64)); }
#pragma unroll
        for (int t = 0; t < 2; ++t) {
            f32x16& s = sc[t];
            if (MODE == 0 && blk >= 8) {
                const int lb = blk - 8, j = lb >> 1, ch = lb & 1, c = t * 32 + ql;
                int cs = c - 8; cs = cs < 0 ? 0 : (cs > 48 ? 48 : cs);
                LAS const float* rrow = rl + (rs + j - r + 7) * 31 + (15 - c);
#pragma unroll
                for (int i = 0; i < 16; ++i) { const int kc = ch * 32 + crow(i, hi); const bool ok = (kc >= cs) && (kc < cs + 16);
                    const float bias = rrow[ok ? kc : c];
                    s[i] = ok ? (s[i] + bias) : -INFINITY; }
            } else if (MODE == 1 && blk >= 8) {
                const int rel = (kb_lo + blk - 8) - (2 * q64 + t);
                if (rel <= -4 || rel >= 4) {
#pragma unroll
                    for (int i = 0; i < 16; ++i) { const int kk = crow(i, hi); const bool ok = (rel == -4) ? (kk >= ql) : ((rel == 4) ? (kk <= ql) : false);
                        s[i] = ok ? s[i] : -INFINITY; }
                }
            }
            attn_softmax(s, T[t]);
#pragma unroll
            for (int ks = 0; ks < 2; ++ks) {
                const bf16x8 pf = pack8(s[8 * ks + 0], s[8 * ks + 1], s[8 * ks + 2], s[8 * ks + 3], s[8 * ks + 4], s[8 * ks + 5], s[8 * ks + 6], s[8 * ks + 7]);
                T[t].o0 = MFMA32(vf[ks][0], pf, T[t].o0); T[t].o1 = MFMA32(vf[ks][1], pf, T[t].o1);
            }
            __builtin_amdgcn_sched_barrier(0);
        }
    };
    bf16x8 kA[4], kB[4]; v4u vA[4], vB[4];
    load_blk(0, kA, vA); load_blk(1, kB, vB);
    for (int blk = 0; blk < nblk; blk += 2) { step(blk, kA, vA); if (blk + 1 < nblk) step(blk + 1, kB, vB); }
#pragma unroll
    for (int t = 0; t < 2; ++t) {
        float lt = T[t].lsum + __shfl_xor(T[t].lsum, 32);
        if (MODE == 1 || MODE == 3) lt += fexp2(sink[hq] * LOG2E - T[t].m);
        const float inv = frcp(lt);
        bf16_t* op = MIX + (size_t)(qrow0 + 32 * t + ql) * 1024 + ocol + 4 * hi;
#pragma unroll
        for (int g = 0; g < 4; ++g) {
            v2u w0, w1; w0.x = pk2(T[t].o0[4 * g] * inv, T[t].o0[4 * g + 1] * inv); w0.y = pk2(T[t].o0[4 * g + 2] * inv, T[t].o0[4 * g + 3] * inv);
            w1.x = pk2(T[t].o1[4 * g] * inv, T[t].o1[4 * g + 1] * inv); w1.y = pk2(T[t].o1[4 * g + 2] * inv, T[t].o1[4 * g + 3] * inv);
            *(v2u*)(op + 8 * g) = w0; *(v2u*)(op + 32 + 8 * g) = w1;
        }
    }
}
constexpr int GP = 144;
constexpr int G_V = 0, G_A = 64 * GP, G_B = 64 * GP + 32 * GP;
static_assert(G_B + 32 * GP <= WAVE_LDS, "gla LDS");

struct GlaCum { float cum[2][16]; float tot; };
__device__ __forceinline__ void gla_cum(const bf16_t* P, int row0, int hh, int dir, const float* __restrict__ a_up, const float* __restrict__ a_bias, int lane, GlaCum& C) {
    const int kk = lane & 31, hi = lane >> 5;
    const float* up = a_up + (size_t)dir * 16 * 128 + (size_t)(8 * hi) * 128 + hh * 32 + kk;
    const bf16x8 ub = pack8(up[0], up[128], up[256], up[384], up[512], up[640], up[768], up[896]);
    const float bias = a_bias[dir * 128 + hh * 32 + kk];
    float gs[2][4];
#pragma unroll
    for (int tt = 0; tt < 2; ++tt) {
        const bf16x8 al = *(const bf16x8*)(P + (size_t)(row0 + 32 * tt + kk) * PP + C_GAF + 16 * dir + 8 * hi);
        f32x16 z;
#pragma unroll
        for (int i = 0; i < 16; ++i) z[i] = 0.f;
        z = MFMA32(al, ub, z);
#pragma unroll
        for (int g = 0; g < 4; ++g) { float run = 0.f;
#pragma unroll
            for (int e = 0; e < 4; ++e) { const float zz = z[4 * g + e] + bias; const float ls = fminf(zz, 0.f) - flog(1.f + fexp(-fabsf(zz)));
                const float l = ls * (1.f / 16.f);
                if (dir == 0) { run += l; C.cum[tt][4 * g + e] = run; } else { C.cum[tt][4 * g + e] = run; run += l; } }
            gs[tt][g] = run; }
    }
    float off = 0.f;
#pragma unroll
    for (int tt = 0; tt < 2; ++tt)
#pragma unroll
        for (int g = 0; g < 4; ++g) { const float other = __shfl_xor(gs[tt][g], 32); const float mine = off + (hi ? other : 0.f);
#pragma unroll
            for (int e = 0; e < 4; ++e) C.cum[tt][4 * g + e] += mine;
            off += gs[tt][g] + other; }
    C.tot = off;
    if (dir == 1) {
#pragma unroll
        for (int tt = 0; tt < 2; ++tt)
#pragma unroll
            for (int r = 0; r < 16; ++r) C.cum[tt][r] = off - C.cum[tt][r];
    }
}
__device__ __forceinline__ void gla_ld_tc(const bf16_t* P, int row0, int col, int lane, float (&x)[2][16]) {
    const int kk = lane & 31, hi = lane >> 5;
#pragma unroll
    for (int tt = 0; tt < 2; ++tt)
#pragma unroll
        for (int r = 0; r < 16; ++r) x[tt][r] = bf1(P[(size_t)(row0 + 32 * tt + crow(r, hi)) * PP + col + kk]);
}
__device__ __forceinline__ void gla_st_img(LAS unsigned char* img, int lane, const float (&x)[2][16]) {
    const int kk = lane & 31, hi = lane >> 5;
#pragma unroll
    for (int tt = 0; tt < 2; ++tt)
#pragma unroll
        for (int g = 0; g < 4; ++g) { v2u w; w.x = pk2(x[tt][4 * g], x[tt][4 * g + 1]); w.y = pk2(x[tt][4 * g + 2], x[tt][4 * g + 3]);
            *(LAS v2u*)(img + kk * GP + (32 * tt + 8 * g + 4 * hi) * 2) = w; }
}
__device__ __forceinline__ void gla_stage_v(const bf16_t* P, int row0, int hh, LAS unsigned char* wl, int lane) {
#pragma unroll
    for (int i = 0; i < 8; ++i) { const int c = lane + 64 * i; const v4u v = *(const v4u*)(P + (size_t)(row0 + (c >> 3)) * PP + C_GV + hh * 64 + (c & 7) * 8);
        *(LAS v4u*)(wl + G_V + (c >> 3) * GP + (c & 7) * 16) = v; }
}
__device__ __forceinline__ int gla_row0(int b, int nc) { return nc < 4 ? (ML + b * CTXL + 64 * nc) : (b * SEQ + 64 * (nc - 4)); }

__device__ __forceinline__ void gla_local_item(const bf16_t* P, float* UST, float* DEC, int item, LAS unsigned char* wl, int lane,
                                               const float* __restrict__ a_up, const float* __restrict__ a_bias) {
    asm volatile("" : "+v"(lane));
    const int nc = item % 36, hh = (item / 36) & 3, b = item / 144;
    const int row0 = gla_row0(b, nc), kk = lane & 31, hi = lane >> 5;
    gla_stage_v(P, row0, hh, wl, lane);
    float kv[2][16]; gla_ld_tc(P, row0, C_GK + hh * 32, lane, kv);
#pragma unroll
    for (int dir = 0; dir < 2; ++dir) {
        GlaCum C; gla_cum(P, row0, hh, dir, a_up, a_bias, lane, C);
        float kd[2][16];
#pragma unroll
        for (int tt = 0; tt < 2; ++tt)
#pragma unroll
            for (int r = 0; r < 16; ++r) kd[tt][r] = kv[tt][r] * fexp(C.tot - C.cum[tt][r]);
        gla_st_img(wl + (dir == 0 ? G_A : G_B), lane, kd);
        if (hi == 0) DEC[((size_t)((b * 4 + hh) * 2 + dir) * 36 + nc) * 32 + kk] = fexp(C.tot);
    }
    const int trv = ((lane & 15) >> 2) * GP + (16 * ((lane >> 4) & 1) + 4 * (lane & 3)) * 2;
#pragma unroll
    for (int dir = 0; dir < 2; ++dir) {
        f32x16 u0, u1;
#pragma unroll
        for (int i = 0; i < 16; ++i) { u0[i] = 0.f; u1[i] = 0.f; }
        LAS const unsigned char* img = wl + (dir == 0 ? G_A : G_B);
#pragma unroll
        for (int s = 0; s < 4; ++s) {
            const bf16x8 kb = *(LAS const bf16x8*)(img + kk * GP + (16 * s + 8 * hi) * 2);
            LAS const unsigned char* vb = wl + G_V + trv + (16 * s + 8 * hi) * GP;
            const bf16x8 v0 = cat4(tr_read(vb), tr_read(vb + 4 * GP));
            const bf16x8 v1 = cat4(tr_read(vb + 64), tr_read(vb + 4 * GP + 64));
            u0 = MFMA32(v0, kb, u0); u1 = MFMA32(v1, kb, u1);
        }
        float* up = UST + ((size_t)((b * 4 + hh) * 2 + dir) * 36 + nc) * 2048 + kk;
#pragma unroll
        for (int i = 0; i < 16; ++i) { up[(size_t)crow(i, hi) * 32] = u0[i]; up[(size_t)(32 + crow(i, hi)) * 32] = u1[i]; }
    }
}

__device__ __forceinline__ void gla_prefix(float* UST, const float* DEC, int gid, bool dry) {
    const int bhd = gid >> 11, e = gid & 2047, k = e & 31, dir = bhd & 1;
    float* base = UST + (size_t)bhd * 36 * 2048 + e; const float* dec = DEC + (size_t)bhd * 36 * 32 + k;
    float s = 0.f;
#pragma unroll 4
    for (int ci = 0; ci < 36; ++ci) {
        const int sl = dir == 0 ? ci : (ci < 4 ? 3 - ci : 39 - ci);
        const float u = base[(size_t)sl * 2048], d = dec[sl * 32];
        if (!dry) base[(size_t)sl * 2048] = s;
        s = d * s + u;
    }
}

__device__ __forceinline__ void gla_out_item(const bf16_t* P, const float* UST, bf16_t* MIX, int item, LAS unsigned char* wl, int lane,
                                             const float* __restrict__ a_up, const float* __restrict__ a_bias, const float* __restrict__ gnorm) {
    const int nc = item % 36, hh = (item / 36) & 3, b = item / 144;
    const int row0 = gla_row0(b, nc), kk = lane & 31, hi = lane >> 5;
    gla_stage_v(P, row0, hh, wl, lane);
    f32x16 o[2][2];
#pragma unroll
    for (int a = 0; a < 2; ++a)
#pragma unroll
        for (int c = 0; c < 2; ++c)
#pragma unroll
            for (int i = 0; i < 16; ++i) o[a][c][i] = 0.f;
    unsigned qp[2][8], kp[2][8];
#pragma unroll
    for (int tt = 0; tt < 2; ++tt) {
#pragma unroll
        for (int g = 0; g < 4; ++g)
#pragma unroll
            for (int e2 = 0; e2 < 2; ++e2) { const size_t ro = (size_t)(row0 + 32 * tt + 8 * g + 4 * hi + 2 * e2) * PP + hh * 32 + kk;
                qp[tt][2 * g + e2] = (unsigned)P[ro + C_GQ] | ((unsigned)P[ro + PP + C_GQ] << 16); kp[tt][2 * g + e2] = (unsigned)P[ro + C_GK] | ((unsigned)P[ro + PP + C_GK] << 16); }
        asm volatile("" ::: "memory");
    }
    const int g16 = (lane >> 4) & 1, qq = (lane & 15) >> 2, pp = lane & 3;
    const int tri = (8 * hi + qq) * GP + (16 * g16 + 4 * pp) * 2;
    const int trv = (4 * hi + qq) * GP + (16 * g16 + 4 * pp) * 2;
#pragma unroll
    for (int dir = 0; dir < 2; ++dir) {
        GlaCum C; gla_cum(P, row0, hh, dir, a_up, a_bias, lane, C);
#pragma unroll
        for (int tt = 0; tt < 2; ++tt) {
            float cum[16];
#pragma unroll
            for (int r = 0; r < 16; ++r) cum[r] = C.cum[tt][r];
#pragma unroll
            for (int g = 0; g < 4; ++g) {
                float xq[4], xk[4];
#pragma unroll
                for (int e = 0; e < 4; ++e) { const unsigned qw = qp[tt][2 * g + (e >> 1)], kw = kp[tt][2 * g + (e >> 1)];
                    xq[e] = ((e & 1) ? bfhi(qw) : bflo(qw)) * 0.17677669529663687f * fexp(cum[4 * g + e]); xk[e] = ((e & 1) ? bfhi(kw) : bflo(kw)) * fexp(-cum[4 * g + e]); }
                v2u wq, wk; wq.x = pk2(xq[0], xq[1]); wq.y = pk2(xq[2], xq[3]); wk.x = pk2(xk[0], xk[1]); wk.y = pk2(xk[2], xk[3]);
                const int off = kk * GP + (32 * tt + 8 * g + 4 * hi) * 2;
                *(LAS v2u*)(wl + G_A + off) = wq; *(LAS v2u*)(wl + G_B + off) = wk;
            }
        }
        const float* sp = UST + ((size_t)((b * 4 + hh) * 2 + dir) * 36 + nc) * 2048;
        bf16x8 sf[2][2];
#pragma unroll
        for (int vb = 0; vb < 2; ++vb)
#pragma unroll
            for (int s = 0; s < 2; ++s) { const float* p = sp + (size_t)(32 * vb + kk) * 32 + 16 * s + 8 * hi; const f32x4 a = *(const f32x4*)p, c = *(const f32x4*)(p + 4);
                sf[vb][s] = pack8(a.x, a.y, a.z, a.w, c.x, c.y, c.z, c.w); }
#pragma unroll
        for (int it = 0; it < 2; ++it) {
            bf16x8 qf[2];
#pragma unroll
            for (int s = 0; s < 2; ++s) { LAS const unsigned char* p = wl + G_A + tri + 16 * s * GP + 64 * it; qf[s] = cat4(tr_read(p), tr_read(p + 4 * GP)); }
#pragma unroll
            for (int vb = 0; vb < 2; ++vb)
#pragma unroll
                for (int s = 0; s < 2; ++s) o[vb][it] = MFMA32(sf[vb][s], qf[s], o[vb][it]);
#pragma unroll
            for (int jt = 0; jt < 2; ++jt) {
                if (dir == 0 ? (jt > it) : (jt < it)) continue;
                f32x16 sc;
#pragma unroll
                for (int i = 0; i < 16; ++i) sc[i] = 0.f;
#pragma unroll
                for (int s = 0; s < 2; ++s) { LAS const unsigned char* p = wl + G_B + tri + 16 * s * GP + 64 * jt; const bf16x8 kf = cat4(tr_read(p), tr_read(p + 4 * GP)); sc = MFMA32(kf, qf[s], sc); }
                if (jt == it) {
#pragma unroll
                    for (int i = 0; i < 16; ++i) { const int j = crow(i, hi); const bool ok = dir == 0 ? (j <= kk) : (j >= kk); sc[i] = ok ? sc[i] : 0.f; }
                }
#pragma unroll
                for (int s2 = 0; s2 < 2; ++s2) {
                    const bf16x8 pf = pack8(sc[8 * s2 + 0], sc[8 * s2 + 1], sc[8 * s2 + 2], sc[8 * s2 + 3], sc[8 * s2 + 4], sc[8 * s2 + 5], sc[8 * s2 + 6], sc[8 * s2 + 7]);
                    LAS const unsigned char* vp = wl + G_V + trv + (32 * jt + 16 * s2) * GP;
                    const bf16x8 v0 = cat4(tr_read(vp), tr_read(vp + 8 * GP));
                    const bf16x8 v1 = cat4(tr_read(vp + 64), tr_read(vp + 8 * GP + 64));
                    o[0][it] = MFMA32(v0, pf, o[0][it]); o[1][it] = MFMA32(v1, pf, o[1][it]);
                }
                __builtin_amdgcn_sched_barrier(0);
            }
            __builtin_amdgcn_sched_barrier(0);
        }
    }
#pragma unroll
    for (int it = 0; it < 2; ++it) {
        float ss = 0.f;
#pragma unroll
        for (int vb = 0; vb < 2; ++vb)
#pragma unroll
            for (int i = 0; i < 16; ++i) ss += o[vb][it][i] * o[vb][it][i];
        ss += __shfl_xor(ss, 32);
        const float rstd = __builtin_amdgcn_rsqf(ss * (1.f / 64.f) + NEPS);
        const size_t row = (size_t)(row0 + 32 * it + kk);
#pragma unroll
        for (int vb = 0; vb < 2; ++vb)
#pragma unroll
            for (int g = 0; g < 4; ++g) { const int v = 32 * vb + 8 * g + 4 * hi;
                const f32x4 gn = *(const f32x4*)(gnorm + v); const v2u gw = *(const v2u*)(P + row * PP + C_GG + hh * 64 + v);
                const float g0 = bflo(gw.x), g1 = bfhi(gw.x), g2 = bflo(gw.y), g3 = bfhi(gw.y);
                v2u w; w.x = pk2(o[vb][it][4 * g] * rstd * gn.x * silu_f(g0), o[vb][it][4 * g + 1] * rstd * gn.y * silu_f(g1));
                w.y = pk2(o[vb][it][4 * g + 2] * rstd * gn.z * silu_f(g2), o[vb][it][4 * g + 3] * rstd * gn.w * silu_f(g3));
                *(v2u*)(MIX + row * 1024 + hh * 64 + v) = w; }
    }
}
__device__ __forceinline__ void phase_r1(const float* const* in, float* xout, unsigned char* ws, LAS unsigned char* lds, int l, bool upd, int G, int tid, int wave, int lane, bool dry) {
    const float* x0 = in[0]; const float* ctx0 = in[2]; const float* gains = in[6] + (size_t)l * 4096; const float* wr = in[14] + (size_t)l * 1024 * 16;
    const float* mod = (const float*)(ws + WS_MOD) + (size_t)l * 9 * 6144;
    const bf16_t* Y = (const bf16_t*)(ws + WS_R2 + (size_t)MT * 2048); bf16_t* H = (bf16_t*)(ws + WS_H); bf16_t* XB = (bf16_t*)(ws + WS_XB);
    float* AFF = (float*)(ws + WS_AFF); float* AFFC = (float*)(ws + WS_AFFC);
    LAS float* V = (LAS float*)lds;
    LAS float* RT = V + 6144;
    __syncthreads();
    constexpr int RTP = 1028;
    for (int i = tid; i < 16384; i += 512) { const int d = i >> 4, e = i & 15; RT[e * RTP + d] = wr[i]; }
    for (int t = blockIdx.x; t < 256; t += G) {
        const int b = t >> 5;
        __syncthreads();
        for (int n = tid; n < 1024; n += 512) { const float gpa = gains[1024 + n], gpf = gains[2048 + n];
            V[n] = gpa * mod[b * 6144 + 2048 + n]; V[1024 + n] = gpf * (1.f + mod[b * 6144 + 4096 + n]); V[2048 + n] = mod[b * 6144 + 3072 + n];
            V[3072 + n] = gpa * mod[8 * 6144 + 2048 + n]; V[4096 + n] = gpf * (1.f + mod[8 * 6144 + 4096 + n]); V[5120 + n] = mod[8 * 6144 + 3072 + n]; }
        __syncthreads();
        const int nrows = upd ? 9 : 8;
#pragma unroll 1
        for (int i0 = 0; i0 < 9; i0 += 3) {
            f32x4 yv[3][4], xq[3][4];
#pragma unroll
            for (int k = 0; k < 3; ++k) { const int i = (i0 + k < nrows) ? (i0 + k) : 7;
                const bool isc = (i == 8); const int row = isc ? (ML + 8 * t + wave) : (64 * t + 8 * wave + i);
                ld_row_bf16(Y + (size_t)row * 1024, lane, yv[k]);
                if (l == 0) ld_row_f32(isc ? (ctx0 + (size_t)(8 * t + wave) * 1024) : (x0 + (size_t)row * 1024), lane, xq[k]); else ld_row_bf16(XB + (size_t)row * 1024, lane, xq[k]); }
#pragma unroll
            for (int k = 0; k < 3; ++k) { const bool act = (i0 + k < nrows); const int i = act ? (i0 + k) : 7;
            const bool isc = (i == 8);
            const int row = isc ? (ML + 8 * t + wave) : (64 * t + 8 * wave + i);
            bf16_t* xd = (dry ? (bf16_t*)(ws + WS_R1) : XB) + (size_t)row * 1024;
            LAS const float* vv = V + (isc ? 3072 : 0);
            f32x4 (&y)[4] = yv[k]; f32x4 (&xv)[4] = xq[k]; f32x4 a[4];
            const float rsy = __builtin_amdgcn_rsqf(wave_sum(sumsq16(y)) * (1.f / 1024.f) + NEPS);
            ld_vec_lds(vv, lane, a);
#pragma unroll
            for (int j = 0; j < 4; ++j) xv[j] = xv[j] + a[j] * (y[j] * rsy);
            if (act) st_row_bf16(xd, lane, xv);
            const float rs1 = __builtin_amdgcn_rsqf(wave_sum(sumsq16(xv)) * (1.f / 1024.f) + NEPS);
            f32x4 s[4]; ld_vec_lds(vv + 1024, lane, a); ld_vec_lds(vv + 2048, lane, s);
#pragma unroll
            for (int j = 0; j < 4; ++j) xv[j] = xv[j] * rs1 * a[j] + s[j];
            if (act) st_row_bf16((dry ? (bf16_t*)(ws + WS_R2) : H) + (size_t)row * 1024, lane, xv);
            }
            float lg3[3][16];
#pragma unroll
            for (int e = 0; e < 16; ++e) { f32x2 pa[3];
#pragma unroll
                for (int k = 0; k < 3; ++k) pa[k] = (f32x2){0.f, 0.f};
#pragma unroll
                for (int j = 0; j < 4; ++j) { const f32x4 w = *(LAS const f32x4*)(RT + e * RTP + 256 * j + 4 * lane); const f32x2 wl = {w.x, w.y}, wh = {w.z, w.w};
#pragma unroll
                    for (int k = 0; k < 3; ++k) { pa[k] += (f32x2){xq[k][j].x, xq[k][j].y} * wl; pa[k] += (f32x2){xq[k][j].z, xq[k][j].w} * wh; } }
#pragma unroll
                for (int k = 0; k < 3; ++k) lg3[k][e] = pa[k].x + pa[k].y;
                asm volatile("" : "+v"(lg3[0][e]), "+v"(lg3[1][e]), "+v"(lg3[2][e]));
                if ((e & 3) == 3) asm volatile("" ::: "memory"); }
#pragma unroll
            for (int k = 0; k < 3; ++k) { const bool act = (i0 + k < nrows); const int i = i0 + k; {
            const bool isc = (i == 8);
            const int row = isc ? (ML + 8 * t + wave) : (64 * t + 8 * wave + i);
            float (&lg)[16] = lg3[k];
#pragma unroll
            for (int i2 = 0; i2 < 8; ++i2) { const bool up = (lane & 32) != 0; const float keep = up ? lg[i2 + 8] : lg[i2], send = up ? lg[i2] : lg[i2 + 8]; lg[i2] = keep + __shfl_xor(send, 32); }
#pragma unroll
            for (int i2 = 0; i2 < 4; ++i2) { const bool up = (lane & 16) != 0; const float keep = up ? lg[i2 + 4] : lg[i2], send = up ? lg[i2] : lg[i2 + 4]; lg[i2] = keep + __shfl_xor(send, 16); }
#pragma unroll
            for (int i2 = 0; i2 < 2; ++i2) { const bool up = (lane & 8) != 0; const float keep = up ? lg[i2 + 2] : lg[i2], send = up ? lg[i2] : lg[i2 + 2]; lg[i2] = keep + __shfl_xor(send, 8); }
            { const bool up = (lane & 4) != 0; const float keep = up ? lg[1] : lg[0], send = up ? lg[0] : lg[1]; lg[0] = keep + __shfl_xor(send, 4); }
            float lgt = lg[0]; lgt += __shfl_xor(lgt, 1); lgt += __shfl_xor(lgt, 2);
            const int ex = ((lane >> 5) & 1) * 8 + ((lane >> 4) & 1) * 4 + ((lane >> 3) & 1) * 2 + ((lane >> 2) & 1);
            float mx = lgt;
            mx = fmaxf(mx, __shfl_xor(mx, 4)); mx = fmaxf(mx, __shfl_xor(mx, 8)); mx = fmaxf(mx, __shfl_xor(mx, 16)); mx = fmaxf(mx, __shfl_xor(mx, 32));
            const float pe = fexp(lgt - mx);
            float den = pe; den += __shfl_xor(den, 4); den += __shfl_xor(den, 8); den += __shfl_xor(den, 16); den += __shfl_xor(den, 32);
            const float mine = pe / den;
            if ((lane & 3) == 0 && act) {
                if (isc) { const int cr = 8 * t + wave; AFFC[((size_t)(cr >> 8) * 16 + ex) * 256 + (cr & 255)] = mine; }
                else AFF[((size_t)(row >> 11) * 16 + ex) * 2048 + (row & 2047)] = mine;
            }
            } }
        }
    }
}

template <bool CTX>
__device__ __forceinline__ void topk_wave(unsigned char* ws, int item, int lane) {
    constexpr int NT = CTX ? 256 : 2048, CAP = CTX ? 32 : 256, PER = NT / 64;
    const int e = item & 15, b = item >> 4;
    const float* arow = (const float*)(ws + (CTX ? WS_AFFC : WS_AFF)) + (size_t)(b * 16 + e) * NT;
    float* gate = (float*)(ws + (CTX ? WS_GATEC : WS_GATE)) + (size_t)(b * 16 + e) * CAP;
    short* INV = (short*)(ws + WS_INV);
    int* rowidx = (int*)(ws + WS_ROWIDX) + (CTX ? ((128 + e) * 256 + b * 32) : ((b * 16 + e) * 256));
    unsigned v[PER];
#pragma unroll
    for (int i = 0; i < PER / 4; ++i) { const v4u q = *(const v4u*)(arow + lane * PER + 4 * i); v[4 * i] = q.x; v[4 * i + 1] = q.y; v[4 * i + 2] = q.z; v[4 * i + 3] = q.w; }
    unsigned T = 0;
    for (int bit = 29; bit >= 0; --bit) {
        const unsigned cand = T | (1u << bit); int c = 0;
#pragma unroll
        for (int i = 0; i < PER; ++i) c += __popcll(__ballot(v[i] >= cand));
        if (c >= CAP) T = cand;
    }
    int ngt = 0, cg = 0, ce = 0;
#pragma unroll
    for (int i = 0; i < PER; ++i) { ngt += __popcll(__ballot(v[i] > T)); cg += (v[i] > T) ? 1 : 0; ce += (v[i] == T) ? 1 : 0; }
    const int need = CAP - ngt;
    int pg = cg, pe = ce;
#pragma unroll
    for (int d = 1; d < 64; d <<= 1) { const int tg = __shfl_up(pg, d), te = __shfl_up(pe, d); if (lane >= d) { pg += tg; pe += te; } }
    pg -= cg; pe -= ce;
#pragma unroll
    for (int i = 0; i < PER; ++i) {
        const bool gt = v[i] > T, eq = v[i] == T;
        const bool sel = gt || (eq && pe < need);
        const int slot = pg + (pe < need ? pe : need);
        const int tok = lane * PER + i, grow = CTX ? (ML + b * CTXL + tok) : (b * SEQ + tok);
        if (sel) { rowidx[slot] = grow; gate[slot] = __uint_as_float(v[i]); }
        INV[(size_t)grow * 16 + e] = sel ? (short)slot : (short)-1;
        pg += gt ? 1 : 0; pe += eq ? 1 : 0;
    }
}

__device__ __forceinline__ void topk_wg2(unsigned char* ws, int item, LAS unsigned char* lds, int tid, int wave, int lane) {
    constexpr int CAP = 256;
    const int e = item & 15, b = item >> 4;
    const float* arow = (const float*)(ws + WS_AFF) + (size_t)(b * 16 + e) * 2048;
    float* gate = (float*)(ws + WS_GATE) + (size_t)(b * 16 + e) * CAP;
    short* INV = (short*)(ws + WS_INV);
    int* rowidx = (int*)(ws + WS_ROWIDX) + (b * 16 + e) * 256;
    LAS int* cnt = (LAS int*)lds;
    const v4u q = *(const v4u*)(arow + 4 * tid);
    const unsigned v[4] = {q.x, q.y, q.z, q.w};
    unsigned T = 0;
    __syncthreads();
    for (int bit = 29; bit >= 0; --bit) {
        const unsigned cand = T | (1u << bit); int c = 0;
#pragma unroll
        for (int i = 0; i < 4; ++i) c += __popcll(__ballot(v[i] >= cand));
        LAS int* cb = cnt + (bit & 1) * 8;
        if (lane == 0) cb[wave] = c;
        __syncthreads();
        int tot = 0;
#pragma unroll
        for (int w = 0; w < 8; ++w) tot += cb[w];
        if (tot >= CAP) T = cand;
    }
    int cg = 0, ce = 0, wg_ = 0, we_ = 0;
#pragma unroll
    for (int i = 0; i < 4; ++i) { wg_ += __popcll(__ballot(v[i] > T)); we_ += __popcll(__ballot(v[i] == T)); cg += (v[i] > T) ? 1 : 0; ce += (v[i] == T) ? 1 : 0; }
    if (lane == 0) { cnt[16 + wave] = wg_; cnt[24 + wave] = we_; }
    int pg = cg, pe = ce;
#pragma unroll
    for (int d = 1; d < 64; d <<= 1) { const int tg = __shfl_up(pg, d), te = __shfl_up(pe, d); if (lane >= d) { pg += tg; pe += te; } }
    pg -= cg; pe -= ce;
    __syncthreads();
    int ngt = 0;
#pragma unroll
    for (int w = 0; w < 8; ++w) { const int g_ = cnt[16 + w], e_ = cnt[24 + w]; ngt += g_; if (w < wave) { pg += g_; pe += e_; } }
    const int need = CAP - ngt;
#pragma unroll
    for (int i = 0; i < 4; ++i) {
        const bool gt = v[i] > T, eq = v[i] == T;
        const bool sel = gt || (eq && pe < need);
        const int slot = pg + (pe < need ? pe : need);
        const int grow = b * SEQ + 4 * tid + i;
        if (sel) { rowidx[slot] = grow; gate[slot] = __uint_as_float(v[i]); }
        INV[(size_t)grow * 16 + e] = sel ? (short)slot : (short)-1;
        pg += gt ? 1 : 0; pe += eq ? 1 : 0;
    }
}

__device__ __forceinline__ void phase_r5(const float* const* in, float* xout, unsigned char* ws, LAS unsigned char* lds, int l, bool upd, int G, int tid, int wave, int lane, bool dry) {
    const float* gains = in[6];
    const float* mod = (const float*)(ws + WS_MOD);
    const bf16_t* YE = (const bf16_t*)(ws + WS_R1); bf16_t* H = (bf16_t*)(ws + WS_H); bf16_t* XB = (bf16_t*)(ws + WS_XB);
    const float* GATE = (const float*)(ws + WS_GATE); const float* GATEC = (const float*)(ws + WS_GATEC); const short* INV = (const short*)(ws + WS_INV);
    LAS float* V = (LAS float*)lds;
    LAS int* CL = (LAS int*)(lds + 24576);
    for (int t = blockIdx.x; t < 256; t += G) {
        const int b = t >> 5;
        __syncthreads();
        for (int n = tid; n < 1024; n += 512) { const float gpf = gains[(size_t)l * 4096 + 3072 + n];
            V[n] = gpf * mod[((size_t)l * 9 + b) * 6144 + 5120 + n]; V[3072 + n] = gpf * mod[((size_t)l * 9 + 8) * 6144 + 5120 + n];
            if (l == 0) { const float gna = gains[4096 + n];
                V[1024 + n] = gna * (1.f + mod[((size_t)9 + b) * 6144 + 1024 + n]); V[2048 + n] = mod[((size_t)9 + b) * 6144 + n];
                V[4096 + n] = gna * (1.f + mod[((size_t)9 + 8) * 6144 + 1024 + n]); V[5120 + n] = mod[((size_t)9 + 8) * 6144 + n]; } }
        if (tid < (upd ? 72 : 64)) {
            const bool isc = tid >= 64; const int cr = 8 * t + (tid - 64);
            const int row = isc ? (ML + cr) : (64 * t + tid); const int bb = isc ? (cr >> 8) : b;
            const v4u i0 = *(const v4u*)(INV + (size_t)row * 16), i1 = *(const v4u*)(INV + (size_t)row * 16 + 8);
            const unsigned iw[8] = {i0.x, i0.y, i0.z, i0.w, i1.x, i1.y, i1.z, i1.w};
            float gv[16]; int sl[16];
#pragma unroll
            for (int e = 0; e < 16; ++e) { sl[e] = (int)(short)((iw[e >> 1] >> (16 * (e & 1))) & 0xffffu); const int s0 = sl[e] < 0 ? 0 : sl[e];
                gv[e] = isc ? GATEC[(size_t)(bb * 16 + e) * 32 + s0] : GATE[(size_t)(bb * 16 + e) * 256 + s0]; }
            int cnt = 0; LAS int* cl = CL + tid * 33;
#pragma unroll
            for (int e = 0; e < 16; ++e) if (sl[e] >= 0) { cl[1 + 2 * cnt] = isc ? ((128 + e) * 256 + bb * 32 + sl[e]) : ((bb * 16 + e) * 256 + sl[e]); cl[2 + 2 * cnt] = (int)__float_as_uint(gv[e]); ++cnt; }
            cl[0] = cnt;
        }
        __syncthreads();
        const int nrows = upd ? 9 : 8;
#pragma unroll 1
        for (int i0 = 0; i0 < 9; i0 += 3) {
            f32x4 xq[3][4];
#pragma unroll
            for (int k = 0; k < 3; ++k) { const int i = i0 + k; if (i < nrows) { const bool isc = (i == 8);
                ld_row_bf16(XB + (size_t)(isc ? (ML + 8 * t + wave) : (64 * t + 8 * wave + i)) * 1024, lane, xq[k]); } }
#pragma unroll
            for (int k = 0; k < 3; ++k) { const int i = i0 + k; if (i < nrows) {
            const bool isc = (i == 8);
            const int row = isc ? (ML + 8 * t + wave) : (64 * t + 8 * wave + i);
            LAS const float* vv = V + (isc ? 3072 : 0);
            LAS const int* cl = CL + (isc ? (64 + wave) : (8 * wave + i)) * 33;
            const int n = __builtin_amdgcn_readfirstlane(cl[0]);
            f32x4 acc[4];
#pragma unroll
            for (int j = 0; j < 4; ++j) acc[j] = (f32x4){0.f, 0.f, 0.f, 0.f};
            for (int j0 = 0; j0 < n; j0 += 4) {
                v2u raw[4][4]; float g[4];
#pragma unroll
                for (int q = 0; q < 4; ++q) {
                    if (j0 + q < n) { const int yr = __builtin_amdgcn_readfirstlane(cl[1 + 2 * (j0 + q)]); g[q] = __uint_as_float((unsigned)__builtin_amdgcn_readfirstlane(cl[2 + 2 * (j0 + q)]));
                        const bf16_t* yp = YE + (size_t)yr * 1024;
#pragma unroll
                        for (int j = 0; j < 4; ++j) raw[q][j] = *(const v2u*)(yp + 256 * j + 4 * lane); }
                    else { g[q] = 0.f;
#pragma unroll
                        for (int j = 0; j < 4; ++j) raw[q][j] = (v2u){0u, 0u}; }
                }
#pragma unroll
                for (int q = 0; q < 4; ++q)
#pragma unroll
                    for (int j = 0; j < 4; ++j) acc[j] += (f32x4){bflo(raw[q][j].x), bfhi(raw[q][j].x), bflo(raw[q][j].y), bfhi(raw[q][j].y)} * g[q];
            }
            const float rsm = __builtin_amdgcn_rsqf(wave_sum(sumsq16(acc)) * (1.f / 1024.f) + NEPS);
            f32x4 (&xv)[4] = xq[k]; f32x4 a[4]; ld_vec_lds(vv, lane, a);
#pragma unroll
            for (int j = 0; j < 4; ++j) xv[j] = xv[j] + a[j] * (acc[j] * rsm);
            if (l == 0) st_row_bf16((dry ? (bf16_t*)(ws + WS_R2) : XB) + (size_t)row * 1024, lane, xv);
            else st_row_f32((dry ? (float*)(ws + WS_R2) : xout) + (size_t)row * 1024, lane, xv);
            if (l == 0 && !dry) {
                const float rs2 = __builtin_amdgcn_rsqf(wave_sum(sumsq16(xv)) * (1.f / 1024.f) + NEPS);
                f32x4 s[4]; ld_vec_lds(vv + 1024, lane, a); ld_vec_lds(vv + 2048, lane, s);
#pragma unroll
                for (int j = 0; j < 4; ++j) xv[j] = xv[j] * rs2 * a[j] + s[j];
                st_row_bf16(H + (size_t)row * 1024, lane, xv);
            }
            } }
        }
    }
}
#ifndef MK_PER_PHASE
#define MK_PER_PHASE 0
#endif
constexpr int N_PHASES = 22;
struct Args { const float* in[18]; float* out; unsigned char* ws; int ph_lo, ph_hi; };
__device__ __forceinline__ const Args* kargs_opaque() {
    auto p = __builtin_amdgcn_kernarg_segment_ptr(); asm volatile("" : "+s"(p)); return (const Args*)p; }
#define PHASE_REGS() int tid = threadIdx.x; asm volatile("" : "+v"(tid)); const int lane = tid & 63, wave = __builtin_amdgcn_readfirstlane(tid >> 6); \
    const Args* A = kargs_opaque(); unsigned char* ws = A->ws; const int G = gridDim.x, bx = blockIdx.x; \
    const int vcu = (G % 8 == 0) ? (bx % 8) * (G / 8) + bx / 8 : bx; const int gw = vcu * NWAVES + wave, NGW = G * NWAVES; \
    LAS unsigned char* wl = lds + wave * WAVE_LDS; (void)gw; (void)NGW; (void)wl; (void)lane; (void)ws
#ifndef CONV_BUDGET
#define CONV_BUDGET 1
#endif
#ifndef PH_MASK
#define PH_MASK 0xFFFFFFFFu
#endif
#define EN(j) (((PH_MASK) >> (j)) & 1u)
#ifndef REP_MASK
#define REP_MASK 0u
#endif
#define REPS(j) ((((REP_MASK) >> (j)) & 1u) ? 2 : 1)
__global__ void __launch_bounds__(NWAVES * 64, 2) fwd_kernel(Args args) {
    extern __shared__ __attribute__((aligned(16))) unsigned char lds_raw[];
    LAS unsigned char* lds = (LAS unsigned char*)lds_raw;
    volatile LAS unsigned* MISC = (volatile LAS unsigned*)(lds + MISC_OFF);
    for (int u = threadIdx.x; u < (LDS_BYTES - LDSCTL_OFF) / 4; u += NWAVES * 64) ((LAS unsigned*)(lds + LDSCTL_OFF))[u] = 0u;
    __syncthreads();
    const int lo = args.ph_lo, hi = args.ph_hi;
    XcdBarrier bar; bar.bar = (unsigned*)(args.ws + WS_CTL) + CW_BAR; bar.x = 0; bar.st = nullptr;
    if (hi - lo > 1) bar = xcd_barrier_post((unsigned*)(args.ws + WS_CTL) + CW_BAR, MISC + 8);
#define IN(k) (lo <= (k) && (k) < hi)
#ifdef STAMP_A
#define STAMP(k) do { if (blockIdx.x == 0 && threadIdx.x == 0) ((unsigned long long*)(args.ws + WS_CTL))[1536 + (k)] = __builtin_amdgcn_s_memrealtime(); } while (0)
#else
#define STAMP(k) do { } while (0)
#endif
#define SEAM(k) do { if (IN((k) + 1)) { xcd_barrier(bar); if (REPS(12) == 2) xcd_barrier(bar); } STAMP((k) + 1); } while (0)
    STAMP(0);
    if (EN(0) && IN(0)) { for (int rep = 0; rep < REPS(0); ++rep) { PHASE_REGS(); phase_p0(A->in, ws, wl, gw, NGW, lane); } SEAM(0); }
    if (EN(1) && IN(1)) { for (int rep = 0; rep < REPS(1); ++rep) { PHASE_REGS(); phase_a0(A->in, ws, lds, G, tid, wave, lane); } SEAM(1); }
    for (int l = 0; l < 2; ++l) {
        const int base = 2 + 10 * l; const bool upd = (l == 0);
        if (EN(2) && IN(base + 0)) { for (int rep = 0; rep < REPS(2); ++rep) {
            PHASE_REGS();
            pg8::Gemm g{(const bf16_t*)(ws + WS_H), (const bf16_t*)(ws + WS_WIN) + (size_t)l * PP * 1024, MT, PP, 1024}; pg8::StaticOrder S; S.init(MT, PP, G, bx);
            pg8::EpiProj E{(bf16_t*)(ws + WS_R1), PP, (const pg8::f32x2*)(ws + WS_TAB), ML};
            pg8::gemm_phase<pg8::EpiProj, pg8::StaticOrder, true, true>(lds, g, S, E);
            if (upd && CV_G1 > 0 && G == 256 && bx >= 208 && !(rep + 1 < REPS(2))) tr_stream(A->in, ws, P0_A + (bx - 208) * NWAVES + wave, 384, P0_A + CV_N1, (LAS float*)wl, lane);
            if (!CONV_IN_P0) { const int nwg_ = (MT / 256) * (PP / 256); if ((nwg_ - bx + G - 1) / G < (nwg_ + G - 1) / G) conv_pull(A->in, ws, l, 1, 12 * CONV_BUDGET, (LAS float*)wl, lane); }
            }
            SEAM(base + 0);
        }
        if (EN(3) && IN(base + 1)) { for (int rep = 0; rep < REPS(3); ++rep) {
            PHASE_REGS();
            const bf16_t* PROJ = (const bf16_t*)(ws + WS_R1); bf16_t* MIX = (bf16_t*)(ws + WS_R2);
            const float* a_up = A->in[9] + (size_t)l * 2 * 16 * 128; const float* a_bias = A->in[10] + (size_t)l * 2 * 128;
            const float* rpb = A->in[12] + (size_t)l * 4 * 465; const float* sink = A->in[13] + (size_t)l * 8;
            const int n_cn = upd ? 128 : 0, n_cs = upd ? 256 : 0;
            const bool xmap = (G == 256);
            const int xcd = bx & 7, cu = bx >> 3;
            const int n_att = xmap ? 12 : 0;
            const int tail_total = (xmap ? 0 : 1024 + 2048) + 1152 + n_cn + n_cs;
            volatile LAS unsigned* qctr = (volatile LAS unsigned*)(lds + MISC_OFF) + 16 + l * 2 + rep;
            const int n_conv = 0, n_mix = (n_conv + 2) / 3 * 4;
            if (CV_M1 > 0 && upd && G == 256 && wave == 7 && !(rep + 1 < REPS(3))) tr_stream(A->in, ws, P0_A + CV_N1 + bx, 256, P0_A + CV_N1 + 256 * CV_M1, (LAS float*)wl, lane);
            for (;;) {
                int j = 0; if (lane == 0) j = (int)__hip_atomic_fetch_add((LAS unsigned*)qctr, 1u, __ATOMIC_RELAXED, __HIP_MEMORY_SCOPE_WORKGROUP);
                j = __builtin_amdgcn_readfirstlane(j);
                if (j < n_mix) {
                    if ((j & 3) != 3) { const int ci = (j >> 2) * 3 + (j & 3), r = ci * G + bx; if (ci < n_conv && r < 12288 && !(rep + 1 < REPS(3))) expert_conv_item(A->in, ws, l, r, (LAS float*)wl, lane); continue; }
                    j = j >> 2;
                } else j = j - n_mix + n_mix / 4;
                int mode, item;
                if (j < n_att) {
                    if (j < 4) { mode = 0; item = (xcd * 4 + j) * 32 + cu; }
                    else { const int jj = j - 4, group = xcd * 2 + (jj >> 2), i = cu * 4 + (jj & 3); const int bb = group >> 1, hq = (group & 1) * 4 + (i >> 5); mode = 1; item = (i & 31) + 32 * hq + 256 * bb; }
                } else {
                    int r = (j - n_att) * G + bx;
                    if (r >= tail_total) break;
                    mode = -1; item = 0;
                    if (!xmap) { if (r < 1024) { mode = 0; item = r; } else if (r < 3072) { mode = 1; item = r - 1024; } r -= 3072; }
                    if (mode < 0) {
                        if (r < 1152) { if (rep + 1 < REPS(3)) continue; gla_local_item(PROJ, (float*)(ws + WS_UST), (float*)(ws + WS_DEC), r, wl, lane, a_up, a_bias); continue; } r -= 1152;
                        if (r < n_cs) { mode = 3; item = r; } else { mode = 2; item = r - n_cs; }
                    }
                }
                attn_item(mode, PROJ, MIX, item, wl, lane, rpb, sink, rep + 1 < REPS(3));
            }
            }
            SEAM(base + 1);
        }
        if (EN(4) && IN(base + 2)) { for (int rep = 0; rep < REPS(4); ++rep) {
            PHASE_REGS();
            for (int gid = bx * (NWAVES * 64) + tid; gid < 64 * 2048; gid += G * NWAVES * 64) gla_prefix((float*)(ws + WS_UST), (const float*)(ws + WS_DEC), gid, rep + 1 < REPS(4));
            }
            SEAM(base + 2);
        }
        if (EN(5) && IN(base + 3)) { for (int rep = 0; rep < REPS(5); ++rep) {
            PHASE_REGS();
            const float* a_up = A->in[9] + (size_t)l * 2 * 16 * 128; const float* a_bias = A->in[10] + (size_t)l * 2 * 128; const float* gnorm = A->in[11] + (size_t)l * 64;
            for (int it = gw; it < 1152; it += NGW) { if (!upd && (it % 36) < 4) continue;
                gla_out_item((const bf16_t*)(ws + WS_R1), (const float*)(ws + WS_UST), (bf16_t*)(ws + WS_R2), it, wl, lane, a_up, a_bias, gnorm); }
            if (upd && G == 256 && gw >= 1152 && !(rep + 1 < REPS(5))) tr_stream(A->in, ws, TR_ALL - CONV_M3 + (gw - 1152), NGW - 1152, TR_ALL, (LAS float*)wl, lane);
            }
            SEAM(base + 3);
        }
        if (EN(6) && IN(base + 4)) { for (int rep = 0; rep < REPS(6); ++rep) {
            PHASE_REGS();
            const int M2 = upd ? MT : ML;
            pg8::Gemm g{(const bf16_t*)(ws + WS_R2), (const bf16_t*)(ws + WS_WOUT) + (size_t)l * 1024 * 1024, M2, 1024, 1024}; pg8::StaticOrder S; S.init(M2, 1024, G, bx);
            pg8::EpiStore E{(bf16_t*)(ws + WS_R2 + (size_t)MT * 2048), 1024};
            pg8::gemm_phase<pg8::EpiStore, pg8::StaticOrder, true, true>(lds, g, S, E);
            if (upd && CV_G2 > 0 && G == 256 && bx >= 32 && !(rep + 1 < REPS(6))) tr_stream(A->in, ws, P0_A + CV_N1 + 256 * CV_M1 + (bx - 32) * NWAVES + wave, 1792, TR_L, (LAS float*)wl, lane);
            if (!CONV_IN_P0) { const int nwg_ = (M2 / 256) * 4; if ((nwg_ - bx + G - 1) / G < (nwg_ + G - 1) / G) conv_pull(A->in, ws, l, 1, 3 * CONV_BUDGET, (LAS float*)wl, lane); }
            }
            SEAM(base + 4);
        }
        if (EN(7) && IN(base + 5)) { for (int rep = 0; rep < REPS(7); ++rep) { PHASE_REGS(); phase_r1(A->in, A->out, ws, lds, l, upd, G, tid, wave, lane, rep + 1 < REPS(7)); } SEAM(base + 5); }
        if (EN(8) && IN(base + 6)) { for (int rep = 0; rep < REPS(8); ++rep) {
            PHASE_REGS();
            if (!CONV_IN_P0) conv_pull(A->in, ws, l, l, 1 << 30, (LAS float*)wl, lane);
            for (int it = bx; it < 128; it += G) topk_wg2(ws, it, lds, tid, wave, lane);
            if (upd) { const int w2 = (bx >= 128 ? bx - 128 : bx + G - 128) * NWAVES + wave; for (int it = w2; it < 128; it += NGW) topk_wave<true>(ws, it, lane); }
            }
            SEAM(base + 6);
        }
        if (EN(9) && IN(base + 7)) { for (int rep = 0; rep < REPS(9); ++rep) {
            PHASE_REGS();
            pg8::Gemm g{(const bf16_t*)(ws + WS_H), (const bf16_t*)(ws + WS_WGU) + (size_t)l * 16 * 2048 * 1024, 0, 0, 1024, (const int*)(ws + WS_ROWIDX)}; pg8::MoeOrder S; S.init(upd ? 9 : 8, 8, G, bx);
            pg8::EpiSwiGLU E{(bf16_t*)(ws + WS_R2), 1024};
            pg8::gemm_phase<pg8::EpiSwiGLU, pg8::MoeOrder, true, true, true>(lds, g, S, E);
            if (upd && CV_G3 > 0 && G == 256 && bx >= 128 && !(rep + 1 < REPS(9))) tr_stream(A->in, ws, P0_B + (bx - 128) * NWAVES + wave, 1024, P0_B + CV_N3, (LAS float*)wl, lane);
            if (!CONV_IN_P0) { const int nwg_ = 16 * (upd ? 9 : 8) * 8; if ((nwg_ - bx + G - 1) / G < (nwg_ + G - 1) / G) conv_pull(A->in, ws, l + 1, 1, 4 * CONV_BUDGET, (LAS float*)wl, lane); }
            }
            SEAM(base + 7);
        }
        if (EN(10) && IN(base + 8)) { for (int rep = 0; rep < REPS(10); ++rep) {
            PHASE_REGS();
            pg8::Gemm g{(const bf16_t*)(ws + WS_R2), (const bf16_t*)(ws + WS_WD) + (size_t)l * 16 * 1024 * 1024, 0, 0, 1024}; pg8::MoeOrder S; S.init(upd ? 9 : 8, 4, G, bx);
            pg8::EpiStore E{(bf16_t*)(ws + WS_R1), 1024};
            pg8::gemm_phase<pg8::EpiStore, pg8::MoeOrder, true, true>(lds, g, S, E);
            if (upd && CV_G4 > 0 && G == 256 && bx >= 64 && !(rep + 1 < REPS(10))) tr_stream(A->in, ws, P0_B + CV_N3 + (bx - 64) * NWAVES + wave, 1536, P0_B + CV_N3 + CV_N4, (LAS float*)wl, lane);
            if (!CONV_IN_P0) { const int nwg_ = 16 * (upd ? 9 : 8) * 4; if ((nwg_ - bx + G - 1) / G < (nwg_ + G - 1) / G) conv_pull(A->in, ws, l + 1, 1, 3 * CONV_BUDGET, (LAS float*)wl, lane); }
            }
            SEAM(base + 8);
        }
        if (EN(11) && IN(base + 9)) { for (int rep = 0; rep < REPS(11); ++rep) { PHASE_REGS(); phase_r5(A->in, A->out, ws, lds, l, upd, G, tid, wave, lane, rep + 1 < REPS(11)); } SEAM(base + 9); }
    }
#ifdef STAMP_A
    if (blockIdx.x == 0 && threadIdx.x == 0) { const unsigned long long* st_ = (const unsigned long long*)(args.ws + WS_CTL) + 1536; const float d_ = (float)(st_[STAMP_B] - st_[STAMP_A]); args.out[0] = 200.f * floorf(d_ / 200.f + 0.5f); }
#endif
#undef IN
#undef SEAM
}

extern "C" void kernel_launch(void* const* d_in, const int* in_sizes, int n_in, void* d_out, int out_size, void* d_ws, size_t ws_size, hipStream_t stream) {
    static int grid = 0;
    if (grid == 0) {
        if (n_in != 18 || out_size != ML * DM || ws_size < WS_END) { fprintf(stderr, "kernel_launch: unexpected sizes: n_in %d out %d ws %zu (need %zu)\n", n_in, out_size, ws_size, (size_t)WS_END); grid = -1; return; }
        int dev = 0, cus = 0, per_cu = 0;
        if (hipGetDevice(&dev) != hipSuccess || hipDeviceGetAttribute(&cus, hipDeviceAttributeMultiprocessorCount, dev) != hipSuccess) { grid = -1; return; }
        if (hipFuncSetAttribute((const void*)fwd_kernel, hipFuncAttributeMaxDynamicSharedMemorySize, LDS_BYTES) != hipSuccess) { fprintf(stderr, "kernel_launch: hipFuncSetAttribute failed\n"); grid = -1; return; }
        if (hipOccupancyMaxActiveBlocksPerMultiprocessor(&per_cu, (const void*)fwd_kernel, NWAVES * 64, LDS_BYTES) != hipSuccess || per_cu < 1) { fprintf(stderr, "kernel_launch: occupancy query says %d blocks per CU\n", per_cu); (void)hipGetLastError(); grid = -1; return; }
        grid = cus;
    }
    if (grid < 0) return;
    (void)hipMemsetAsync((char*)d_ws + WS_CTL, 0, CTL_ZERO_BYTES, stream);
    Args a{};
    for (int i = 0; i < 18; ++i) a.in[i] = (const float*)d_in[i];
    a.out = (float*)d_out; a.ws = (unsigned char*)d_ws;
#if MK_PER_PHASE
    for (int p = 0; p < N_PHASES; ++p) { a.ph_lo = p; a.ph_hi = p + 1; hipLaunchKernelGGL(fwd_kernel, dim3(grid), dim3(NWAVES * 64), LDS_BYTES, stream, a); }
#else
    a.ph_lo = 0; a.ph_hi = N_PHASES;
    void* kargs[] = {&a};
    hipError_t e = hipLaunchCooperativeKernel((const void*)fwd_kernel, dim3(grid), dim3(NWAVES * 64), kargs, LDS_BYTES, stream);
    if (e != hipSuccess) fprintf(stderr, "kernel_launch: cooperative launch failed: %s (grid %d)\n", hipGetErrorString(e), grid);
#endif
}
```

```cpp
#include <hip/hip_runtime.h>
#include <cstdio>
#include <cstdint>
#include <cmath>

namespace pg8 {
#define PG8_LAS __attribute__((address_space(3)))
typedef unsigned short bf16_t;
typedef short bf16x8 __attribute__((ext_vector_type(8)));
typedef float f32x4 __attribute__((ext_vector_type(4)));
typedef unsigned u32x4 __attribute__((ext_vector_type(4)));
constexpr int BM = 256, BK = 64, HALF = 128, HTB = HALF * BK * 2  , STAGE_BYTES = 8 * HTB, NXCD = 8, WGM = 8;

__host__ __device__ __forceinline__ int lds_byte(int r, int c) { const int st = (r >> 4) * 2 + (c >> 5), rr = r & 15, cc = c & 31, ob = rr * 64 + cc * 2; return st * 1024 + (ob ^ (((ob >> 9) & 1) << 5)); }
__host__ __device__ __forceinline__ void stage_rc(int b, int& R, int& C) { const int st = b / 1024, sb = b % 1024, swz = sb ^ (((sb >> 9) & 1) << 5); R = (st >> 1) * 16 + swz / 64; C = (st & 1) * 32 + (swz % 64) / 2; }
__host__ __device__ __forceinline__ int perm32(int rho) { const int n = rho >> 4, i = rho & 15; return 8 * (i >> 2) + 4 * n + (i & 3); }

struct Unit { int pm, pn, pb; };
struct Gemm { const bf16_t* A; const bf16_t* Bt; int M, N, K; const int* rowidx; };

struct StaticOrder {
    int nM, nN, nwg, G, c;
    __host__ __device__ void init(int M, int N, int G_, int c_) { nM = M / BM; nN = N / BM; nwg = nM * nN; G = G_; c = c_; }
    __host__ __device__ bool next(int i, Unit& u) const {
        const long L = (long)i * G + c; if (L >= nwg) return false;
        int wgid = (int)L; { const int q = nwg / NXCD, r = nwg % NXCD, xcd = wgid % NXCD, off = wgid / NXCD; wgid = (xcd < r ? xcd * (q + 1) : r * (q + 1) + (xcd - r) * q) + off; }
        const int nig = WGM * nN, gid = wgid / nig, fm = gid * WGM, gsz = (nM - fm) < WGM ? (nM - fm) : WGM;
        u.pm = fm + ((wgid % nig) % gsz); u.pn = (wgid % nig) / gsz; u.pb = u.pn; return true;
    }
    __device__ __forceinline__ void a_ready(const Unit&) const {}
    __device__ __forceinline__ void done(const Unit&) const {}
};

__device__ __forceinline__ unsigned cvt_pk_bf16(float lo, float hi) { unsigned r; asm volatile("v_cvt_pk_bf16_f32 %0, %1, %2" : "=v"(r) : "v"(lo), "v"(hi)); return r; }
typedef float f32x2 __attribute__((ext_vector_type(2)));
#ifndef EPI_WT
#define EPI_WT 0
#endif
__device__ __forceinline__ void st16(bf16_t* base, size_t elem_off, u32x4 w) {
#if EPI_WT
    const __amdgpu_buffer_rsrc_t r = __builtin_amdgcn_make_buffer_rsrc((void*)base, 0, 0x7fffffff, 0x00020000);
    __builtin_amdgcn_raw_buffer_store_b128(w, r, (unsigned)(elem_off * 2), 0, 16);
#else
    *(u32x4*)(base + elem_off) = w;
#endif
}
struct EpiStore {
    static constexpr bool PERM = true, AFTER_DRAIN = false;
    bf16_t* O; int ldc;
    __device__ __forceinline__ void operator()(const f32x4 (&acc)[2][2][4][2], const Unit& u, int wr, int wc, int fr, int fq) const {
        const int row0 = u.pm * BM + wr * 64 + fr, col0 = u.pn * BM + wc * 32 + 8 * fq;
#pragma unroll
        for (int ai = 0; ai < 2; ++ai)
#pragma unroll
            for (int m = 0; m < 4; ++m) { bf16_t* rowp = O + (size_t)(row0 + ai * HALF + m * 16) * ldc + col0;
#pragma unroll
                for (int bj = 0; bj < 2; ++bj) { const f32x4 v0 = acc[ai][bj][m][0], v1 = acc[ai][bj][m][1];
                    u32x4 w; w.x = cvt_pk_bf16(v0[0], v0[1]); w.y = cvt_pk_bf16(v0[2], v0[3]); w.z = cvt_pk_bf16(v1[0], v1[1]); w.w = cvt_pk_bf16(v1[2], v1[3]);
                    st16(O, (size_t)(rowp - O) + bj * HALF, w); } }
    }
};
struct EpiProj {
    static constexpr bool PERM = true, AFTER_DRAIN = false;
    bf16_t* O; int ldc; const f32x2* tab; int ml;
    __device__ __forceinline__ void operator()(const f32x4 (&acc)[2][2][4][2], const Unit& u, int wr, int wc, int fr, int fq) const {
        const int row0 = u.pm * BM + wr * 64 + fr;
        const bool latent = (u.pm * BM) < ml;
#pragma unroll
        for (int bj = 0; bj < 2; ++bj) {
            const int c0 = u.pn * BM + bj * HALF + wc * 32;
            const bool rope = latent && ((c0 >= 928 && c0 < 1056) || (c0 >= 1824 && c0 < 2336));
            const bool rowhalf = (((c0 - 32) & 63) == 0);
            const bool qscale = (c0 >= 1568 && c0 < 2336);
#pragma unroll
            for (int ai = 0; ai < 2; ++ai)
#pragma unroll
                for (int m = 0; m < 4; ++m) {
                    const int row = row0 + ai * HALF + m * 16;
                    f32x4 v0 = acc[ai][bj][m][0], v1 = acc[ai][bj][m][1];
                    if (rope) {
                        const int t = row & 2047, pos = rowhalf ? (t >> 6) : (t & 63);
                        const f32x2* tp = tab + pos * 16 + 8 * (fq & 1);
                        const float sg = (fq < 2) ? -1.f : 1.f;
#pragma unroll
                        for (int e = 0; e < 4; ++e) {
                            const float x0 = v0[e], x1 = v1[e];
                            const float p0 = __shfl_xor(x0, 32), p1 = __shfl_xor(x1, 32);
                            const f32x2 c0s = tp[e], c1s = tp[4 + e];
                            v0[e] = x0 * c0s.x + sg * p0 * c0s.y; v1[e] = x1 * c1s.x + sg * p1 * c1s.y;
                        }
                    }
                    if (qscale) { v0 = v0 * 0.18033688011112042f; v1 = v1 * 0.18033688011112042f; }
                    u32x4 w; w.x = cvt_pk_bf16(v0[0], v0[1]); w.y = cvt_pk_bf16(v0[2], v0[3]); w.z = cvt_pk_bf16(v1[0], v1[1]); w.w = cvt_pk_bf16(v1[2], v1[3]);
                    st16(O, (size_t)row * ldc + c0 + 8 * fq, w);
                }
        }
    }
};
struct EpiSwiGLU {
    static constexpr bool PERM = true, AFTER_DRAIN = false;
    bf16_t* O; int ldc;
    __device__ __forceinline__ void operator()(const f32x4 (&acc)[2][2][4][2], const Unit& u, int wr, int wc, int fr, int fq) const {
        const int row0 = u.pm * BM + wr * 64 + fr, col0 = u.pn * HALF + wc * 32 + 8 * fq;
#pragma unroll
        for (int ai = 0; ai < 2; ++ai)
#pragma unroll
            for (int m = 0; m < 4; ++m) {
                float h[8];
#pragma unroll
                for (int n = 0; n < 2; ++n)
#pragma unroll
                    for (int e = 0; e < 4; ++e) { const float g = acc[ai][0][m][n][e], up = acc[ai][1][m][n][e];
                        h[n * 4 + e] = g * __builtin_amdgcn_rcpf(1.f + __builtin_amdgcn_exp2f(-1.4426950408889634f * g)) * up; }
                u32x4 w; w.x = cvt_pk_bf16(h[0], h[1]); w.y = cvt_pk_bf16(h[2], h[3]); w.z = cvt_pk_bf16(h[4], h[5]); w.w = cvt_pk_bf16(h[6], h[7]);
                st16(O, (size_t)(row0 + ai * HALF + m * 16) * ldc + col0, w);
            }
    }
};
struct MoeOrder {
    int npe, nN, nwg, G, c;
    __host__ __device__ void init(int npe_, int nN_, int G_, int c_) { npe = npe_; nN = nN_; nwg = 16 * npe * nN; G = G_; c = c_; }
    __host__ __device__ bool next(int i, Unit& u) const {
        const long L = (long)i * G + c; if (L >= nwg) return false;
        int wgid = (int)L; { const int q = nwg / NXCD, r = nwg % NXCD, xcd = wgid % NXCD, off = wgid / NXCD; wgid = (xcd < r ? xcd * (q + 1) : r * (q + 1) + (xcd - r) * q) + off; }
        const int per = npe * nN, e = wgid / per, rem = wgid % per, j = rem / nN, pn = rem % nN;
        u.pm = (j < 8) ? (j * 16 + e) : (128 + e); u.pn = pn; u.pb = e * nN + pn; return true;
    }
    __device__ __forceinline__ void a_ready(const Unit&) const {}
    __device__ __forceinline__ void done(const Unit&) const {}
};

template <class Epi, class Sched, bool ALIGN_EPI = false, bool SP2 = false, bool GATHER = false>
__device__ __forceinline__ void gemm_phase(PG8_LAS unsigned char* lds, const Gemm g, const Sched& S, const Epi& E) {
    int tid_ = threadIdx.x; asm volatile("" : "+v"(tid_));
    const int tid = tid_, wid = __builtin_amdgcn_readfirstlane(tid >> 6), lane = tid & 63, wr = wid >> 2, wc = wid & 3, fr = lane & 15, fq = lane >> 4;
    const int K = g.K, nt = K / BK;
    static_assert(!GATHER || SP2, "GATHER is wired into the SP2 loop only");
    unsigned voffA[2], voffB[2]; int RA[2], CA[2]; unsigned vAc[2][2], vAn[2][2];
#pragma unroll
    for (int i = 0; i < 2; ++i) { int R, C; stage_rc(tid * 16 + i * 8192, R, C); const int Rb = Epi::PERM ? ((R & ~31) + perm32(R & 31)) : R; RA[i] = R; CA[i] = C;
        voffA[i] = (unsigned)(R * K + C) * 2u; voffB[i] = (unsigned)(Rb * K + C) * 2u; vAc[0][i] = vAc[1][i] = vAn[0][i] = vAn[1][i] = 0u; }
    auto load_idx = [&](int pm, unsigned (&v)[2][2]) {
#pragma unroll
        for (int h = 0; h < 2; ++h)
#pragma unroll
            for (int i = 0; i < 2; ++i) v[h][i] = (unsigned)(g.rowidx[pm * BM + h * HALF + RA[i]] * K + CA[i]) * 2u;
    };
    const size_t kstep = (size_t)(BK * 2);
    const size_t hstep = (size_t)HALF * K * 2;
    const size_t tstep = 2 * hstep;
    const unsigned ldsw = (unsigned)wid * 1024u;
    const int aoff = lds_byte(wr * 64 + fr, fq * 8), boff = lds_byte(wc * 32 + fr, fq * 8);
#define PG8_SA(b, h) (((b) * 2 + (h)) * HTB)
#define PG8_SB(b, h) ((4 + (b) * 2 + (h)) * HTB)
#define PG8_STAGE(bufoff, gbase, voff) do { _Pragma("unroll") for (int _i = 0; _i < 2; ++_i) \
        __builtin_amdgcn_global_load_lds((const unsigned*)((const char*)(gbase) + (voff)[_i]), (PG8_LAS unsigned*)(lds + (bufoff) + ldsw + _i * 8192), 16, 0, 0); } while (0)
#define PG8_STAGE_A(bufoff, gbase, h, nx) do { if constexpr (GATHER) { const unsigned v_[2] = { (nx) ? vAn[h][0] : vAc[h][0], (nx) ? vAn[h][1] : vAc[h][1] }; PG8_STAGE(bufoff, gbase, v_); } \
        else { PG8_STAGE(bufoff, (gbase) + (h) * hstep, voffA); } } while (0)
#define PG8_LDA(dst, b, h) do { _Pragma("unroll") for (int m = 0; m < 4; ++m) _Pragma("unroll") for (int k = 0; k < 2; ++k) dst[m][k] = *(const PG8_LAS bf16x8*)(lds + PG8_SA(b, h) + aoff + m * 2048 + k * 1024); } while (0)
#define PG8_LDB(dst, b, h) do { _Pragma("unroll") for (int n = 0; n < 2; ++n) _Pragma("unroll") for (int k = 0; k < 2; ++k) dst[n][k] = *(const PG8_LAS bf16x8*)(lds + PG8_SB(b, h) + boff + n * 2048 + k * 1024); } while (0)
#define PG8_MMA(ai, bj, At, Bt) do { __builtin_amdgcn_s_setprio(1); _Pragma("unroll") for (int m = 0; m < 4; ++m) _Pragma("unroll") for (int n = 0; n < 2; ++n) _Pragma("unroll") for (int k = 0; k < 2; ++k) \
        acc[ai][bj][m][n] = __builtin_amdgcn_mfma_f32_16x16x32_bf16(Bt[n][k], At[m][k], acc[ai][bj][m][n], 0, 0, 0); __builtin_amdgcn_s_setprio(0); } while (0)
#define PG8_WAIT_V(n) asm volatile("s_waitcnt vmcnt(" #n ")" ::: "memory")
#define PG8_WAIT_L(n) asm volatile("s_waitcnt lgkmcnt(" #n ")" ::: "memory")
#define PG8_BAR __builtin_amdgcn_s_barrier()
#define PG8_SCHED __builtin_amdgcn_sched_barrier(0)
    Unit cur, nxt; int ui = 0;
    if (!S.next(0, cur)) return;
    f32x4 acc[2][2][4][2];
#pragma unroll
    for (int a = 0; a < 2; ++a)
#pragma unroll
        for (int b = 0; b < 2; ++b)
#pragma unroll
            for (int m = 0; m < 4; ++m)
#pragma unroll
                for (int n = 0; n < 2; ++n) acc[a][b][m][n] = (f32x4){0.f, 0.f, 0.f, 0.f};
    bf16x8 At[4][2], B0[2][2], B1[2][2];
    const char* cA = (const char*)g.A + (GATHER ? (size_t)0 : (size_t)cur.pm * tstep); const char* cB = (const char*)g.Bt + (size_t)cur.pb * tstep;
    if constexpr (GATHER) load_idx(cur.pm, vAc);
    S.a_ready(cur);
    if constexpr (SP2) {
        PG8_STAGE(PG8_SB(0, 0), cB, voffB); PG8_STAGE(PG8_SB(0, 1), cB + hstep, voffB); PG8_STAGE_A(PG8_SA(0, 0), cA, 0, false); PG8_STAGE_A(PG8_SA(0, 1), cA, 1, false);
        if (wr == 1) PG8_BAR;
        PG8_WAIT_V(2); PG8_BAR;
        PG8_STAGE(PG8_SB(1, 0), cB + kstep, voffB); PG8_STAGE_A(PG8_SA(1, 0), cA + kstep, 0, false); PG8_STAGE(PG8_SB(1, 1), cB + hstep + kstep, voffB);
        PG8_WAIT_V(6); PG8_BAR;
    } else {
        PG8_STAGE(PG8_SB(0, 0), cB, voffB); PG8_STAGE(PG8_SA(0, 0), cA, voffA); PG8_STAGE(PG8_SB(0, 1), cB + hstep, voffB); PG8_STAGE(PG8_SA(0, 1), cA + hstep, voffA);
        if (wr == 1) PG8_BAR;
        PG8_WAIT_V(4); PG8_BAR;
        PG8_STAGE(PG8_SB(1, 0), cB + kstep, voffB); PG8_STAGE(PG8_SA(1, 0), cA + kstep, voffA); PG8_STAGE(PG8_SB(1, 1), cB + hstep + kstep, voffB);
        PG8_WAIT_V(6); PG8_BAR;
    }
    for (;;) {
        const bool has_next = S.next(ui + 1, nxt);
        if constexpr (GATHER) { if (has_next) {
#pragma unroll
            for (int h = 0; h < 2; ++h)
#pragma unroll
                for (int i = 0; i < 2; ++i) __builtin_amdgcn_global_load_lds((const unsigned*)(g.rowidx + nxt.pm * BM + h * HALF + RA[i]), (PG8_LAS unsigned*)(lds + STAGE_BYTES + (h * 2 + i) * 2048 + wid * 256), 4, 0, 0); } }
        const char* nA = (has_next && !GATHER) ? (const char*)g.A + (size_t)nxt.pm * tstep : cA; const char* nB = has_next ? (const char*)g.Bt + (size_t)nxt.pb * tstep : cB;
        for (int t = 0; t < nt; t += 2) {
            const bool last = (t == nt - 2); const bool nxu = last && has_next; (void)nxu;
            if constexpr (GATHER) { if (nxu) {
#pragma unroll
                for (int h = 0; h < 2; ++h)
#pragma unroll
                    for (int i = 0; i < 2; ++i) { const int ix = *(const PG8_LAS int*)(lds + STAGE_BYTES + (h * 2 + i) * 2048 + tid * 4); vAn[h][i] = (unsigned)(ix * K + CA[i]) * 2u; } } }
            const char* a1 = cA + (size_t)(t + 1) * kstep;
            const char* a2 = last ? nA : cA + (size_t)(t + 2) * kstep; const char* b2 = last ? nB : cB + (size_t)(t + 2) * kstep;
            const char* a3 = a2 + kstep; const char* b3 = b2 + kstep;
            if (last && has_next) S.a_ready(nxt);
            if constexpr (SP2) {
            PG8_LDB(B0, 0, 0); PG8_LDB(B1, 0, 1); PG8_SCHED; PG8_LDA(At, 0, 0); PG8_STAGE_A(PG8_SA(1, 1), a1, 1, false);
            PG8_WAIT_V(8); PG8_WAIT_L(0); PG8_BAR; PG8_MMA(0, 0, At, B0); PG8_MMA(0, 1, At, B1); PG8_BAR; PG8_SCHED;
            PG8_LDA(At, 0, 1); PG8_STAGE(PG8_SB(0, 0), b2, voffB); PG8_STAGE(PG8_SB(0, 1), b2 + hstep, voffB); PG8_STAGE_A(PG8_SA(0, 0), a2, 0, nxu);
            PG8_WAIT_V(8); PG8_WAIT_L(0); PG8_BAR; PG8_MMA(1, 0, At, B0); PG8_MMA(1, 1, At, B1); PG8_BAR; PG8_SCHED;
            PG8_LDB(B0, 1, 0); PG8_LDB(B1, 1, 1); PG8_SCHED; PG8_LDA(At, 1, 0); PG8_STAGE_A(PG8_SA(0, 1), a2, 1, nxu);
            PG8_WAIT_V(8); PG8_WAIT_L(0); PG8_BAR; PG8_MMA(0, 0, At, B0); PG8_MMA(0, 1, At, B1); PG8_BAR; PG8_SCHED;
            PG8_LDA(At, 1, 1); PG8_STAGE(PG8_SB(1, 0), b3, voffB); PG8_STAGE(PG8_SB(1, 1), b3 + hstep, voffB); PG8_STAGE_A(PG8_SA(1, 0), a3, 0, nxu);
            PG8_WAIT_V(8); PG8_WAIT_L(0); PG8_BAR; PG8_MMA(1, 0, At, B0); PG8_MMA(1, 1, At, B1); PG8_BAR; PG8_SCHED;
            } else {
            PG8_LDB(B0, 0, 0); PG8_SCHED; PG8_LDA(At, 0, 0); PG8_STAGE(PG8_SA(1, 1), a1 + hstep, voffA);
            PG8_WAIT_L(8); PG8_BAR; PG8_WAIT_L(0); PG8_MMA(0, 0, At, B0); PG8_BAR; PG8_SCHED;
            PG8_LDB(B1, 0, 1); PG8_STAGE(PG8_SB(0, 0), b2, voffB);
            PG8_BAR; PG8_WAIT_L(0); PG8_MMA(0, 1, At, B1); PG8_BAR;
            PG8_LDA(At, 0, 1); PG8_STAGE(PG8_SA(0, 0), a2, voffA);
            PG8_BAR; PG8_WAIT_L(0); PG8_MMA(1, 0, At, B0); PG8_BAR; PG8_SCHED;
            PG8_STAGE(PG8_SB(0, 1), b2 + hstep, voffB);
            PG8_WAIT_V(6); PG8_BAR; PG8_MMA(1, 1, At, B1); PG8_BAR;
            PG8_LDB(B0, 1, 0); PG8_SCHED; PG8_LDA(At, 1, 0); PG8_STAGE(PG8_SA(0, 1), a2 + hstep, voffA);
            PG8_WAIT_L(8); PG8_BAR; PG8_WAIT_L(0); PG8_MMA(0, 0, At, B0); PG8_BAR; PG8_SCHED;
            PG8_LDB(B1, 1, 1); PG8_STAGE(PG8_SB(1, 0), b3, voffB);
            PG8_BAR; PG8_WAIT_L(0); PG8_MMA(0, 1, At, B1); PG8_BAR;
            PG8_LDA(At, 1, 1); PG8_STAGE(PG8_SA(1, 0), a3, voffA);
            PG8_BAR; PG8_WAIT_L(0); PG8_MMA(1, 0, At, B0); PG8_BAR; PG8_SCHED;
            PG8_STAGE(PG8_SB(1, 1), b3 + hstep, voffB);
            PG8_WAIT_V(6); PG8_BAR; PG8_MMA(1, 1, At, B1); PG8_BAR;
            }
        }
        if constexpr (ALIGN_EPI) { if (wr == 0) PG8_BAR; }
        if constexpr (!Epi::AFTER_DRAIN) { E(acc, cur, wr, wc, fr, fq); S.done(cur); }
        if (!has_next) break;
#pragma unroll
        for (int a = 0; a < 2; ++a)
#pragma unroll
            for (int b = 0; b < 2; ++b)
#pragma unroll
                for (int m = 0; m < 4; ++m)
#pragma unroll
                    for (int n = 0; n < 2; ++n) acc[a][b][m][n] = (f32x4){0.f, 0.f, 0.f, 0.f};
        cur = nxt; cA = nA; cB = nB; ++ui;
        if constexpr (GATHER) {
#pragma unroll
            for (int h = 0; h < 2; ++h) { vAc[h][0] = vAn[h][0]; vAc[h][1] = vAn[h][1]; } }
        if constexpr (ALIGN_EPI) { if (wr == 1) PG8_BAR; }
    }
    PG8_WAIT_V(0);
    if constexpr (!ALIGN_EPI) { if (wr == 0) PG8_BAR; }
    PG8_BAR;
    if constexpr (Epi::AFTER_DRAIN) { E.fused(acc, cur, wr, wc, fr, fq, lds, wid, lane); S.done(cur); }
#undef PG8_SA
#undef PG8_SB
#undef PG8_STAGE
#undef PG8_STAGE_A
#undef PG8_LDA
#undef PG8_LDB
#undef PG8_MMA
#undef PG8_WAIT_V
#undef PG8_WAIT_L
#undef PG8_BAR
#undef PG8_SCHED
}
}
constexpr int NB = 8, SEQ = 2048, DM = 1024, CTXL = 256, ML = NB * SEQ, MC = NB * CTXL, MT = ML + MC;
constexpr int PP = 2560;
constexpr int INW = 2336;
constexpr int C_GK = 0, C_GV = 128, C_GAF = 384, C_GAB = 400, C_NK = 416, C_NV = 672, C_SK = 928, C_SV = 1056, C_GQ = 1184, C_GG = 1312, C_NQ = 1568, C_SQ = 1824;
constexpr int NWAVES = 8;
constexpr float NEPS = 1e-6f;
constexpr float LOG2E = 1.4426950408889634f;

constexpr size_t MiB = 1u << 20;
constexpr size_t WS_CTL = 0, CTL_ZERO_BYTES = 65536;
constexpr size_t WS_TAB = 1 * MiB;
constexpr size_t WS_MOD = 1 * MiB + 65536;
constexpr size_t WS_MODP = 2 * MiB;
constexpr size_t WS_WIN = 6 * MiB;
constexpr size_t WS_WOUT = 16 * MiB;
constexpr size_t WS_WGU = 20 * MiB;
constexpr size_t WS_WD = 148 * MiB;
constexpr size_t WS_H = 212 * MiB;
constexpr size_t WS_R1 = 248 * MiB;
constexpr size_t WS_R2 = 338 * MiB;
constexpr size_t WS_XB = 410 * MiB;
constexpr size_t WS_UST = 446 * MiB;
constexpr size_t WS_MISC = 464 * MiB;
constexpr size_t WS_DEC = WS_MISC;
constexpr size_t WS_AFF = WS_MISC + 1 * MiB;
constexpr size_t WS_AFFC = WS_MISC + 2 * MiB;
constexpr size_t WS_GATE = WS_MISC + 2 * MiB + 262144;
constexpr size_t WS_GATEC = WS_MISC + 2 * MiB + 524288;
constexpr size_t WS_INV = WS_MISC + 3 * MiB;
constexpr size_t WS_ROWIDX = WS_MISC + 3 * MiB + 786432;
constexpr size_t WS_END = 468 * MiB;
constexpr int CW_BAR = 4096;
constexpr int CW_QUEUE = 1024;
constexpr int CW_CONV = 2048;

constexpr int WAVE_LDS = 19456;
constexpr int RING_BYTES = NWAVES * WAVE_LDS;
constexpr int LDSCTL_OFF = RING_BYTES, MISC_OFF = LDSCTL_OFF + 320;
constexpr int LDS_BYTES = RING_BYTES + 1024;
static_assert(RING_BYTES >= pg8::STAGE_BYTES && LDS_BYTES <= 163840, "LDS map");

#define GAS __attribute__((address_space(1)))
#define LAS __attribute__((address_space(3)))
typedef unsigned short bf16_t;
typedef unsigned v4u __attribute__((ext_vector_type(4)));
typedef unsigned v2u __attribute__((ext_vector_type(2)));
typedef float f32x4 __attribute__((ext_vector_type(4)));
typedef float f32x2 __attribute__((ext_vector_type(2)));
typedef float f32x16 __attribute__((ext_vector_type(16)));
typedef short bf16x8 __attribute__((ext_vector_type(8)));
typedef short s16x4 __attribute__((ext_vector_type(4)));
typedef GAS unsigned gu32;
#define RLX_AGENT __ATOMIC_RELAXED, __HIP_MEMORY_SCOPE_AGENT
typedef __bf16 bf16x2_t __attribute__((ext_vector_type(2)));
__device__ __forceinline__ unsigned pk2(float lo, float hi) { f32x2 v = {lo, hi}; bf16x2_t b = __builtin_convertvector(v, bf16x2_t); return __builtin_bit_cast(unsigned, b); }
__device__ __forceinline__ float bflo(unsigned w) { return __uint_as_float(w << 16); }
__device__ __forceinline__ float bfhi(unsigned w) { return __uint_as_float(w & 0xffff0000u); }
__device__ __forceinline__ float bf1(bf16_t w) { return __uint_as_float((unsigned)w << 16); }
__device__ __forceinline__ float wave_sum(float v) {
#pragma unroll
    for (int o = 1; o < 64; o <<= 1) v += __shfl_xor(v, o);
    return v;
}
__device__ __forceinline__ float fexp2(float x) { return __builtin_amdgcn_exp2f(x); }
__device__ __forceinline__ float fexp(float x) { return __builtin_amdgcn_exp2f(x * LOG2E); }
__device__ __forceinline__ float flog(float x) { return __builtin_amdgcn_logf(x) * 0.6931471805599453f; }
__device__ __forceinline__ float frcp(float x) { return __builtin_amdgcn_rcpf(x); }
__device__ __forceinline__ float silu_f(float x) { return x * frcp(1.f + fexp(-x)); }
__device__ __forceinline__ int crow(int r, int hi) { return (r & 3) + 8 * (r >> 2) + 4 * hi; }
__device__ __forceinline__ s16x4 tr_read(LAS const unsigned char* p) { return __builtin_bit_cast(s16x4, __builtin_amdgcn_ds_read_tr16_b64_v4i16((LAS s16x4*)p)); }
__device__ __forceinline__ bf16x8 cat4(s16x4 a, s16x4 b) { return (bf16x8){a[0], a[1], a[2], a[3], b[0], b[1], b[2], b[3]}; }
__device__ __forceinline__ bf16x8 pack8(float a0, float a1, float a2, float a3, float a4, float a5, float a6, float a7) {
    v4u w; w.x = pk2(a0, a1); w.y = pk2(a2, a3); w.z = pk2(a4, a5); w.w = pk2(a6, a7); return __builtin_bit_cast(bf16x8, w); }
#define MFMA32(a, b, c) __builtin_amdgcn_mfma_f32_32x32x16_bf16((a), (b), (c), 0, 0, 0)

#ifndef EARLY_WB
#define EARLY_WB 0
#endif
#define XB_TMO      128
#define XB_XCNT(j)  (256  + 64 * (j))
#define XB_XSUB(j)  (1280 + 64 * (j))
#define XB_XGEN(j)  (2304 + 64 * (j))
#define XB_TOP      3328
#define XB_TOPGEN   3392
#define XCD_BAR_WORDS 3456
#define XB_SPIN_CAP (1u << 18)

__device__ __forceinline__ unsigned xb_ld(unsigned* p)              { return __hip_atomic_load(p, __ATOMIC_RELAXED, __HIP_MEMORY_SCOPE_AGENT); }
__device__ __forceinline__ unsigned xb_add(unsigned* p, unsigned v) { return __hip_atomic_fetch_add(p, v, __ATOMIC_RELAXED, __HIP_MEMORY_SCOPE_AGENT); }
__device__ __forceinline__ unsigned xb_xcc_id() { return (unsigned)__builtin_amdgcn_s_getreg((3 << 11) | 20) & 0xFu; }
#define XB_SPIN(cond, bar) do { unsigned _sp = 0; while (cond) { __builtin_amdgcn_s_sleep(1); \
    if ((++_sp & 255u) == 0u) { if (xb_ld(&(bar)[XB_TMO])) break; if (_sp > XB_SPIN_CAP) { atomicAdd(&(bar)[XB_TMO], 1u); break; } } } } while (0)

struct XcdBarrier {
    unsigned* bar; unsigned x;
    volatile LAS unsigned* st;
};

__device__ __forceinline__ XcdBarrier xcd_barrier_post(unsigned* bar, volatile LAS unsigned* st) {
    XcdBarrier b; b.bar = bar; b.x = xb_xcc_id(); b.st = st;
    if (threadIdx.x == 0) (void)xb_add(&bar[XB_XCNT(b.x)], 1u);
    return b;
}
__device__ __forceinline__ void xcd_barrier_complete(unsigned* bar, unsigned x, unsigned& nloc, unsigned& nx) {
    const unsigned G = gridDim.x * gridDim.y * gridDim.z;
    unsigned sum, cnt, mine, sp = 0u;
    for (;;) {
        sum = 0u; cnt = 0u; mine = 0u;
#pragma unroll
        for (unsigned j = 0; j < 16; ++j) { const unsigned c = xb_ld(&bar[XB_XCNT(j)]); sum += c; cnt += (c > 0u) ? 1u : 0u; mine = (j == x) ? c : mine; }
        if (sum == G) break;
        __builtin_amdgcn_s_sleep(1);
        if ((++sp & 255u) == 0u) { if (xb_ld(&bar[XB_TMO])) break; if (sp > XB_SPIN_CAP) { atomicAdd(&bar[XB_TMO], 1u); break; } }
    }
    nloc = mine > 0u ? mine : 1u; nx = cnt > 0u ? cnt : 1u;
}

__device__ __forceinline__ void xcd_barrier(const XcdBarrier& b) {
    asm volatile("s_waitcnt vmcnt(0)" ::: "memory");
    __syncthreads();
    if (threadIdx.x == 0) {
        unsigned* bar = b.bar;
        __builtin_amdgcn_s_waitcnt(0);
        unsigned nloc = b.st[0], nx = b.st[1];
        if (nloc == 0u) { xcd_barrier_complete(bar, b.x, nloc, nx); b.st[0] = nloc; b.st[1] = nx; }
#if EARLY_WB
        __builtin_amdgcn_fence(__ATOMIC_RELEASE, "agent");
        asm volatile("s_waitcnt vmcnt(0)" ::: "memory");
#endif
        const unsigned old = xb_add(&bar[XB_XSUB(b.x)], 1u);
        const unsigned gen = old / nloc;
        if (old + 1u == (gen + 1u) * nloc) {
            __builtin_amdgcn_fence(__ATOMIC_RELEASE, "agent");
            asm volatile("s_waitcnt vmcnt(0)" ::: "memory");
            const unsigned og = xb_add(&bar[XB_TOP], 1u);
            const unsigned tg = og / nx;
            if (og + 1u == (tg + 1u) * nx) xb_add(&bar[XB_TOPGEN], 1u);
            else XB_SPIN(xb_ld(&bar[XB_TOPGEN]) == tg, bar);
            __builtin_amdgcn_fence(__ATOMIC_ACQUIRE, "agent");
            xb_add(&bar[XB_XGEN(b.x)], 1u);
            asm volatile("s_waitcnt vmcnt(0)" ::: "memory");
        } else {
            XB_SPIN(xb_ld(&bar[XB_XGEN(b.x)]) == gen, bar);
            __builtin_amdgcn_fence(__ATOMIC_ACQUIRE, "agent");
            asm volatile("s_waitcnt vmcnt(0)" ::: "memory");
        }
    }
    __syncthreads();
}

template <class F>
__device__ __forceinline__ void xcd_barrier_overlap(const XcdBarrier& b, F&& work) {
    asm volatile("s_waitcnt vmcnt(0)" ::: "memory");
    __syncthreads();
    int tw_ = (int)threadIdx.x; asm volatile("" : "+v"(tw_));
    if (tw_ >= 64) work(tw_ - 64, NWAVES * 64 - 64);
    else if (threadIdx.x == 0) {
        unsigned* bar = b.bar;
        __builtin_amdgcn_s_waitcnt(0);
        unsigned nloc = b.st[0], nx = b.st[1];
        if (nloc == 0u) { xcd_barrier_complete(bar, b.x, nloc, nx); b.st[0] = nloc; b.st[1] = nx; }
#if EARLY_WB
        __builtin_amdgcn_fence(__ATOMIC_RELEASE, "agent");
        asm volatile("s_waitcnt vmcnt(0)" ::: "memory");
#endif
        const unsigned old = xb_add(&bar[XB_XSUB(b.x)], 1u);
        const unsigned gen = old / nloc;
        if (old + 1u == (gen + 1u) * nloc) {
            __builtin_amdgcn_fence(__ATOMIC_RELEASE, "agent");
            asm volatile("s_waitcnt vmcnt(0)" ::: "memory");
            const unsigned og = xb_add(&bar[XB_TOP], 1u);
            const unsigned tg = og / nx;
            if (og + 1u == (tg + 1u) * nx) xb_add(&bar[XB_TOPGEN], 1u);
            else XB_SPIN(xb_ld(&bar[XB_TOPGEN]) == tg, bar);
            __builtin_amdgcn_fence(__ATOMIC_ACQUIRE, "agent");
            xb_add(&bar[XB_XGEN(b.x)], 1u);
            asm volatile("s_waitcnt vmcnt(0)" ::: "memory");
        } else {
            XB_SPIN(xb_ld(&bar[XB_XGEN(b.x)]) == gen, bar);
            __builtin_amdgcn_fence(__ATOMIC_ACQUIRE, "agent");
            asm volatile("s_waitcnt vmcnt(0)" ::: "memory");
        }
    }
    __syncthreads();
}
__device__ __forceinline__ void ld_row_f32(const float* p, int lane, f32x4 (&v)[4]) {
#pragma unroll
    for (int j = 0; j < 4; ++j) v[j] = *(const f32x4*)(p + 256 * j + 4 * lane);
}
__device__ __forceinline__ void st_row_f32(float* p, int lane, const f32x4 (&v)[4]) {
#pragma unroll
    for (int j = 0; j < 4; ++j) *(f32x4*)(p + 256 * j + 4 * lane) = v[j];
}
__device__ __forceinline__ void ld_row_bf16(const bf16_t* p, int lane, f32x4 (&v)[4]) {
#pragma unroll
    for (int j = 0; j < 4; ++j) { const v2u w = *(const v2u*)(p + 256 * j + 4 * lane); v[j] = (f32x4){bflo(w.x), bfhi(w.x), bflo(w.y), bfhi(w.y)}; }
}
__device__ __forceinline__ void st_row_bf16(bf16_t* p, int lane, const f32x4 (&v)[4]) {
#pragma unroll
    for (int j = 0; j < 4; ++j) { v2u w; w.x = pk2(v[j].x, v[j].y); w.y = pk2(v[j].z, v[j].w); *(v2u*)(p + 256 * j + 4 * lane) = w; }
}
__device__ __forceinline__ void ld_vec_lds(LAS const float* p, int lane, f32x4 (&v)[4]) {
#pragma unroll
    for (int j = 0; j < 4; ++j) v[j] = *(LAS const f32x4*)(p + 256 * j + 4 * lane);
}
__device__ __forceinline__ float sumsq16(const f32x4 (&v)[4]) {
    float s = 0.f;
#pragma unroll
    for (int j = 0; j < 4; ++j) s += (v[j].x * v[j].x + v[j].y * v[j].y) + (v[j].z * v[j].z + v[j].w * v[j].w);
    return s;
}
__device__ __forceinline__ float modfin(const float* modp, const float* bmod, int l, int r, int n) {
    float s = bmod[l * 6144 + n];
#pragma unroll
    for (int kc = 0; kc < 8; ++kc) s += modp[((size_t)(l * 8 + kc) * 9 + r) * 6144 + n];
    return s;
}

#ifndef CV_G1
#define CV_G1 4
#endif
#ifndef CV_G2
#define CV_G2 6
#endif
#ifndef CV_M1
#define CV_M1 0
#endif
#ifndef CV_G3
#define CV_G3 4
#endif
#ifndef CV_G4
#define CV_G4 4
#endif
#ifndef CONV_M3
#define CONV_M3 2944
#endif
#ifndef CONV_IN_P0
#define CONV_IN_P0 1
#endif
__device__ __forceinline__ void tr_item64(const float* W, int N, int Nvalid, bf16_t* WT, int Kd, int k0, int n0, int dst_row0, LAS float* scr, int lane) {
    const int q = lane & 15, kr = lane >> 4;
    f32x4 t[16];
#pragma unroll
    for (int i = 0; i < 16; ++i) { const int kk = 4 * i + kr; const int n = n0 + 4 * q;
        t[i] = (n < Nvalid) ? *(const f32x4*)(W + (size_t)(k0 + kk) * N + n) : (f32x4){0.f, 0.f, 0.f, 0.f}; }
#pragma unroll
    for (int i = 0; i < 16; ++i) { const int kk = 4 * i + kr; LAS float* d = scr + kk * 65 + 4 * q; d[0] = t[i].x; d[1] = t[i].y; d[2] = t[i].z; d[3] = t[i].w; }
    const int c = lane & 7, nl = lane >> 3;
#pragma unroll
    for (int j = 0; j < 8; ++j) { const int n = nl + 8 * j; LAS const float* s = scr + (8 * c) * 65 + n;
        v4u o; o.x = pk2(s[0 * 65], s[1 * 65]); o.y = pk2(s[2 * 65], s[3 * 65]); o.z = pk2(s[4 * 65], s[5 * 65]); o.w = pk2(s[6 * 65], s[7 * 65]);
        *(v4u*)(WT + (size_t)(dst_row0 + n) * Kd + k0 + 8 * c) = o; }
}
__device__ __forceinline__ void expert_conv_item(const float* const* in, unsigned char* ws, int l, int r, LAS float* scr, int lane) {
    const float* w_gate = in[15]; const float* w_up = in[16]; const float* w_down = in[17];
    const int which = r >> 12; r &= 4095;
    const int e = r >> 8, kb = (r & 255) >> 4, nb = r & 15, n0 = 64 * nb;
    const size_t eoff = (size_t)(l * 16 + e) * 1024 * 1024;
    if (which == 0) tr_item64(w_gate + eoff, 1024, 1024, (bf16_t*)(ws + WS_WGU) + 2 * eoff, 1024, 64 * kb, n0, (n0 >> 7) * 256 + (n0 & 127), scr, lane);
    else if (which == 1) tr_item64(w_up + eoff, 1024, 1024, (bf16_t*)(ws + WS_WGU) + 2 * eoff, 1024, 64 * kb, n0, (n0 >> 7) * 256 + 128 + (n0 & 127), scr, lane);
    else tr_item64(w_down + eoff, 1024, 1024, (bf16_t*)(ws + WS_WD) + eoff, 1024, 64 * kb, n0, n0, scr, lane);
}
__device__ __forceinline__ void conv_pull(const float* const* in, unsigned char* ws, int l_lo, int l_hi, int budget, LAS float* scr, int lane) {
    for (int l = l_lo; l <= l_hi && l < 2; ++l) {
        unsigned* ctr = (unsigned*)(ws + WS_CTL) + CW_CONV + 64 * l;
        while (budget > 0) {
            const int c = budget < 8 ? budget : 8;
            unsigned r = 0; if (lane == 0) r = __hip_atomic_fetch_add(ctr, (unsigned)c, __ATOMIC_RELAXED, __HIP_MEMORY_SCOPE_AGENT);
            r = (unsigned)__builtin_amdgcn_readfirstlane((int)r);
            if (r >= 12288u) break;
            for (int k = 0; k < c && (int)r + k < 12288; ++k) expert_conv_item(in, ws, l, (int)r + k, scr, lane);
            budget -= c;
        }
    }
}
struct TrDesc { const float* src; bf16_t* dst; int N, Nvalid, k0, n0, drow; };
constexpr int TR_IN = 16 * 40, TR_OUT = 16 * 16, TR_E = 16 * 16 * 16, TR_L = TR_IN + TR_OUT + 3 * TR_E, TR_ALL = 2 * TR_L;
constexpr int CV_N1 = CV_G1 * 384, CV_N2 = CV_G2 * 1792, CV_N3 = CV_G3 * 1024, CV_N4 = CV_G4 * 1536;
constexpr int P0_A = TR_L - CV_N1 - CV_N2;
constexpr int P0_B = TR_ALL - CONV_M3 - CV_N3 - CV_N4;
static_assert(P0_A >= 896 && P0_B >= TR_L, "tail conversion budgets exceed the expert tiles");
__device__ __forceinline__ void tr_desc(const float* const* in, unsigned char* ws, int r, TrDesc& d) {
    const int l = r / TR_L; r -= l * TR_L;
    if (r < TR_IN) { const int kb = r / 40, nb = r % 40; d.src = in[7] + (size_t)l * 1024 * INW; d.dst = (bf16_t*)(ws + WS_WIN) + (size_t)l * PP * 1024; d.N = INW; d.Nvalid = INW; d.k0 = 64 * kb; d.n0 = 64 * nb; d.drow = 64 * nb; return; }
    r -= TR_IN;
    if (r < TR_OUT) { const int kb = r / 16, nb = r % 16; d.src = in[8] + (size_t)l * 1024 * 1024; d.dst = (bf16_t*)(ws + WS_WOUT) + (size_t)l * 1024 * 1024; d.N = 1024; d.Nvalid = 1024; d.k0 = 64 * kb; d.n0 = 64 * nb; d.drow = 64 * nb; return; }
    r -= TR_OUT;
    const int which = r >> 12; r &= 4095;
    const int e = r >> 8, kb = (r & 255) >> 4, nb = r & 15, n0 = 64 * nb;
    const size_t eoff = (size_t)(l * 16 + e) * 1024 * 1024;
    d.N = 1024; d.Nvalid = 1024; d.k0 = 64 * kb; d.n0 = n0;
    if (which == 0) { d.src = in[15] + eoff; d.dst = (bf16_t*)(ws + WS_WGU) + 2 * eoff; d.drow = (n0 >> 7) * 256 + (n0 & 127); }
    else if (which == 1) { d.src = in[16] + eoff; d.dst = (bf16_t*)(ws + WS_WGU) + 2 * eoff; d.drow = (n0 >> 7) * 256 + 128 + (n0 & 127); }
    else { d.src = in[17] + eoff; d.dst = (bf16_t*)(ws + WS_WD) + eoff; d.drow = n0; }
}
__device__ __forceinline__ void tr_load(const TrDesc& d, int lane, f32x4 (&t)[16]) {
    const int q = lane & 15, kr = lane >> 4, n = d.n0 + 4 * q;
    const float* p = d.src + (size_t)(d.k0 + kr) * d.N + (n < d.Nvalid ? n : 0);
#pragma unroll
    for (int i = 0; i < 16; ++i) t[i] = *(const f32x4*)(p + (size_t)(4 * i) * d.N);
}
__device__ __forceinline__ void tr_finish(const TrDesc& d, f32x4 (&t)[16], LAS float* scr, int lane) {
    const int q = lane & 15, kr = lane >> 4; const bool valid = (d.n0 + 4 * q) < d.Nvalid;
#pragma unroll
    for (int i = 0; i < 16; ++i) { const int kk = 4 * i + kr; LAS float* s = scr + kk * 65 + 4 * q; const f32x4 v = valid ? t[i] : (f32x4){0.f, 0.f, 0.f, 0.f}; s[0] = v.x; s[1] = v.y; s[2] = v.z; s[3] = v.w; }
    const int c = lane & 7, nl = lane >> 3;
#pragma unroll
    for (int j = 0; j < 8; ++j) { const int n = nl + 8 * j; LAS const float* s = scr + (8 * c) * 65 + n;
        v4u o; o.x = pk2(s[0 * 65], s[1 * 65]); o.y = pk2(s[2 * 65], s[3 * 65]); o.z = pk2(s[4 * 65], s[5 * 65]); o.w = pk2(s[6 * 65], s[7 * 65]);
        *(v4u*)(d.dst + (size_t)(d.drow + n) * 1024 + d.k0 + 8 * c) = o; }
}
__device__ __forceinline__ void tr_stream(const float* const* in, unsigned char* ws, int first, int stride, int hi, LAS float* scr, int lane, int cut = 1 << 30, int jump = 0) {
#define TR_ID(x) ((x) < cut ? (x) : (x) + jump)
    if (first >= hi) return;
    const int n_my = (hi - first + stride - 1) / stride;
    TrDesc dA, dB; f32x4 tA[16], tB[16];
    tr_desc(in, ws, TR_ID(first), dA); tr_load(dA, lane, tA);
    for (int i = 0; i < n_my; i += 2) {
        { const int nx = i + 1 < n_my ? i + 1 : n_my - 1; tr_desc(in, ws, TR_ID(first + nx * stride), dB); tr_load(dB, lane, tB); }
        tr_finish(dA, tA, scr, lane);
        if (i + 1 >= n_my) break;
        { const int nx = i + 2 < n_my ? i + 2 : n_my - 1; tr_desc(in, ws, TR_ID(first + nx * stride), dA); tr_load(dA, lane, tA); }
        tr_finish(dB, tB, scr, lane);
    }
#undef TR_ID
}
__device__ __forceinline__ void phase_p0(const float* const* in, unsigned char* ws, LAS unsigned char* wl, int gw, int NGW, int lane) {
    const float* cvec = in[1]; const float* cctx = in[3]; const float* wmod = in[4];
    const float* w_in = in[7]; const float* w_out = in[8];
    float* modp = (float*)(ws + WS_MODP);
    constexpr int NI_MOD = 2 * 8 * 24, NI_ROPE = 16;
    constexpr int NI_IN = 16 * 40, NI_OUT = 16 * 16, NI_E = 16 * 16 * 16;
    constexpr int NI_L = NI_IN + NI_OUT + (CONV_IN_P0 ? 3 * NI_E : 0);
    constexpr int NITEMS = NI_MOD + NI_ROPE + 2 * NI_L;
    LAS float* scr = (LAS float*)wl;
    for (int it = gw; it < NI_MOD + NI_ROPE; it += NGW) {
        int r = it;
        if (r < NI_MOD) {
            const int cb = r % 24, kc = (r / 24) & 7, l = r / 192;
            for (int idx = lane; idx < 128 * 9; idx += 64) { const int rr = idx / 128, k = idx % 128; const float cv = (rr < 8) ? cvec[rr * 1024 + kc * 128 + k] : cctx[kc * 128 + k]; scr[k * 12 + rr] = silu_f(cv); }
            f32x4 acc[9];
#pragma unroll
            for (int rr = 0; rr < 9; ++rr) acc[rr] = (f32x4){0.f, 0.f, 0.f, 0.f};
            const float* wp = wmod + ((size_t)l * 1024 + kc * 128) * 6144 + cb * 256 + 4 * lane;
#pragma unroll 4
            for (int k = 0; k < 128; ++k) { const f32x4 w = *(const f32x4*)(wp + (size_t)k * 6144);
                const f32x4 s0 = *(LAS const f32x4*)(scr + k * 12), s1 = *(LAS const f32x4*)(scr + k * 12 + 4); const float s8 = scr[k * 12 + 8];
                acc[0] += w * s0.x; acc[1] += w * s0.y; acc[2] += w * s0.z; acc[3] += w * s0.w; acc[4] += w * s1.x; acc[5] += w * s1.y; acc[6] += w * s1.z; acc[7] += w * s1.w; acc[8] += w * s8; }
#pragma unroll
            for (int rr = 0; rr < 9; ++rr) *(f32x4*)(modp + ((size_t)(l * 8 + kc) * 9 + rr) * 6144 + cb * 256 + 4 * lane) = acc[rr];
            continue;
        }
        r -= NI_MOD;
        if (r < NI_ROPE) {
            const int id = r * 64 + lane, pos = id >> 4, i = id & 15;
            const float fr = fexp2(-(float)i * (13.287712379549449f / 16.f));
            float rev = (float)pos * fr * 0.15915494309189535f; rev -= floorf(rev);
            f32x2 cs; cs.x = __builtin_amdgcn_cosf(rev); cs.y = __builtin_amdgcn_sinf(rev);
            ((f32x2*)(ws + WS_TAB))[id] = cs;
            continue;
        }
        break;
    }
    if (NGW == 2048) tr_stream(in, ws, (gw + NGW - (NI_MOD + NI_ROPE)) % NGW, NGW, P0_A + (P0_B - TR_L), scr, lane, P0_A, TR_L - P0_A);
    else tr_stream(in, ws, gw, NGW, TR_ALL, scr, lane);
}

__device__ __forceinline__ void phase_a0(const float* const* in, unsigned char* ws, LAS unsigned char* lds, int G, int tid, int wave, int lane) {
    const float* x = in[0]; const float* ctx = in[2]; const float* bmod = in[5]; const float* gains = in[6];
    const float* modp = (const float*)(ws + WS_MODP); float* mod = (float*)(ws + WS_MOD); bf16_t* H = (bf16_t*)(ws + WS_H);
    LAS float* V = (LAS float*)lds;
    for (int idx = blockIdx.x * 512 + tid; idx < 18 * 6144; idx += G * 512) { const int row = idx / 6144, n = idx - row * 6144; mod[idx] = modfin(modp, bmod, row / 9, row % 9, n); }
    for (int t = blockIdx.x; t < 256; t += G) {
        const int b = t >> 5;
        f32x4 xq[9][4];
#pragma unroll
        for (int i = 0; i < 9; ++i) { const bool isc = (i == 8);
            const float* src = isc ? (ctx + (size_t)(8 * t + wave) * 1024) : (x + (size_t)(64 * t + 8 * wave + i) * 1024); ld_row_f32(src, lane, xq[i]); }
        __syncthreads();
        for (int n = tid; n < 1024; n += 512) { const float g = gains[n];
            V[n] = g * (1.f + modfin(modp, bmod, 0, b, 1024 + n)); V[1024 + n] = modfin(modp, bmod, 0, b, n);
            V[2048 + n] = g * (1.f + modfin(modp, bmod, 0, 8, 1024 + n)); V[3072 + n] = modfin(modp, bmod, 0, 8, n); }
        __syncthreads();
#pragma unroll
        for (int i = 0; i < 9; ++i) { const bool isc = (i == 8);
            const int row = isc ? (ML + 8 * t + wave) : (64 * t + 8 * wave + i);
            f32x4 (&v)[4] = xq[i]; f32x4 a[4], s[4];
            const float rstd = __builtin_amdgcn_rsqf(wave_sum(sumsq16(v)) * (1.f / 1024.f) + NEPS);
            ld_vec_lds(V + (isc ? 2048 : 0), lane, a); ld_vec_lds(V + (isc ? 3072 : 1024), lane, s);
#pragma unroll
            for (int j = 0; j < 4; ++j) v[j] = v[j] * rstd * a[j] + s[j];
            st_row_bf16(H + (size_t)row * 1024, lane, v);
        }
    }
}
constexpr int VP = 192;
struct AttnTile { f32x16 o0, o1; float m, lsum; };
__device__ __forceinline__ void attn_softmax(f32x16& s, AttnTile& T) {
    float bm = fmaxf(fmaxf(s[0], s[1]), fmaxf(s[2], s[3]));
#pragma unroll
    for (int i = 4; i < 16; i += 4) bm = fmaxf(bm, fmaxf(fmaxf(s[i], s[i + 1]), fmaxf(s[i + 2], s[i + 3])));
    bm = fmaxf(bm, __shfl_xor(bm, 32));
    const float mo = T.m, mn = fmaxf(mo, bm);
    T.m = mn;
    float ps = 0.f;
#pragma unroll
    for (int i = 0; i < 16; ++i) { s[i] = fexp2(s[i] - mn); ps += s[i]; }
    if (__any(mn != mo)) {
        const float alpha = fexp2(mo - mn);
        T.lsum *= alpha;
#pragma unroll
        for (int i = 0; i < 16; ++i) { T.o0[i] *= alpha; T.o1[i] *= alpha; }
    }
    T.lsum += ps;
}
__device__ __forceinline__ void attn_item(const int MODE, const bf16_t* P, bf16_t* MIX, int item, LAS unsigned char* wl, int lane,
                                          const float* __restrict__ rpb, const float* __restrict__ sink, const bool dry = false) {
    asm volatile("" : "+v"(lane));
    const int ql = lane & 31, hi = lane >> 5;
    int b, hq, qcol, kcol, vcol, ocol, qrow0, r = 0, rs = 0, q64 = 0, nloc, kb_lo = 0;
    if (MODE == 0) { r = item & 31; hq = (item >> 5) & 3; b = item >> 7;
        qcol = C_NQ + hq * 64; kcol = C_NK + hq * 64; vcol = C_NV + hq * 64; ocol = 256 + hq * 64; qrow0 = b * SEQ + r * 64;
        rs = r - 4; rs = rs < 0 ? 0 : (rs > 24 ? 24 : rs); nloc = 16; }
    else if (MODE == 1) { q64 = item & 31; hq = (item >> 5) & 7; b = item >> 8;
        qcol = C_SQ + hq * 64; kcol = C_SK + (hq >> 2) * 64; vcol = C_SV + (hq >> 2) * 64; ocol = 512 + hq * 64; qrow0 = b * SEQ + q64 * 64;
        kb_lo = 2 * q64 - 4; if (kb_lo < 0) kb_lo = 0; int kb_hi = 2 * q64 + 5; if (kb_hi > 63) kb_hi = 63; nloc = kb_hi - kb_lo + 1; }
    else if (MODE == 2) { q64 = item & 3; hq = (item >> 2) & 3; b = item >> 4;
        qcol = C_NQ + hq * 64; kcol = C_NK + hq * 64; vcol = C_NV + hq * 64; ocol = 256 + hq * 64; qrow0 = ML + b * CTXL + q64 * 64; nloc = 0; }
    else { q64 = item & 3; hq = (item >> 2) & 7; b = item >> 5;
        qcol = C_SQ + hq * 64; kcol = C_SK + (hq >> 2) * 64; vcol = C_SV + (hq >> 2) * 64; ocol = 512 + hq * 64; qrow0 = ML + b * CTXL + q64 * 64; nloc = 0; }
    const int nblk = 8 + nloc;
    LAS unsigned char* vl = wl;
    LAS float* rl = (LAS float*)(wl + 32 * VP);
    if (MODE == 0) { for (int i = lane; i < 465; i += 64) rl[i] = rpb[hq * 465 + i] * LOG2E; }
    LAS unsigned char* qimg = wl + 32 * VP + 1920;
    constexpr int QP = 144;
#pragma unroll
    for (int i = 0; i < 8; ++i) { const int c = lane + 64 * i; const v4u v = *(const v4u*)(P + (size_t)(qrow0 + (c >> 3)) * PP + qcol + (c & 7) * 8); *(LAS v4u*)(qimg + (c >> 3) * QP + (c & 7) * 16) = v; }
    LAS const unsigned char* qrd = qimg + ql * QP + 16 * hi;
    auto blk_row0 = [&](int blk) -> int {
        if (blk < 8) return ML + b * CTXL + blk * 32;
        const int lb = blk - 8;
        if (MODE == 0) return b * SEQ + (rs + (lb >> 1)) * 64 + (lb & 1) * 32;
        return b * SEQ + 32 * (kb_lo + lb);
    };
    auto load_blk = [&](int blk, bf16x8 (&kn)[4], v4u (&vn)[4]) {
        const int r0 = blk_row0(blk);
        const bf16_t* kp = P + (size_t)(r0 + ql) * PP + kcol + 8 * hi;
#pragma unroll
        for (int ds = 0; ds < 4; ++ds) kn[ds] = *(const bf16x8*)(kp + 16 * ds);
#pragma unroll
        for (int i = 0; i < 4; ++i) { const int c = lane + 64 * i; vn[i] = *(const v4u*)(P + (size_t)(r0 + (c >> 3)) * PP + vcol + (c & 7) * 8); }
    };
    AttnTile T[2];
#pragma unroll
    for (int t = 0; t < 2; ++t) { T[t].m = -INFINITY; T[t].lsum = 0.f;
#pragma unroll
        for (int i = 0; i < 16; ++i) { T[t].o0[i] = 0.f; T[t].o1[i] = 0.f; } }
    const int tr_off = (4 * hi + ((lane & 15) >> 2)) * VP + (16 * ((lane >> 4) & 1) + 4 * (lane & 3)) * 2;
    auto step = [&](int blk, bf16x8 (&kf)[4], v4u (&vr)[4]) {
#pragma unroll
        for (int i = 0; i < 4; ++i) { const int c = lane + 64 * i; *(LAS v4u*)(vl + (c >> 3) * VP + (c & 7) * 16) = vr[i]; }
        f32x16 sc[2];
#pragma unroll
        for (int t = 0; t < 2; ++t) {
#pragma unroll
            for (int i = 0; i < 16; ++i) sc[t][i] = 0.f;
#pragma unroll
            for (int ds = 0; ds < 4; ++ds) sc[t] = MFMA32(kf[ds], *(LAS const bf16x8*)(qrd + 32 * t * QP + 32 * ds), sc[t]);
        }
        if (blk + 2 < nblk) load_blk(blk + 2, kf, vr);
        bf16x8 vf[2][2];
#pragma unroll
        for (int ks = 0; ks < 2; ++ks) { LAS const unsigned char* vb = vl + tr_off + 16 * ks * VP;
            vf[ks][0] = cat4(tr_read(vb), tr_read(vb + 8 * VP)); vf[ks][1] = cat4(tr_read(vb + 64), tr_read(vb + 8 * VP + 64)); }
#pragma unroll
        for (int t = 0; t < 2; ++t) {
            f32x16& s = sc[t];
            if (MODE == 0 && blk >= 8) {
                const int lb = blk - 8, j = lb >> 1, ch = lb & 1, c = t * 32 + ql;
                int cs = c - 8; cs = cs < 0 ? 0 : (cs > 48 ? 48 : cs);
                LAS const float* rrow = rl + (rs + j - r + 7) * 31 + (15 - c);
#pragma unroll
                for (int i = 0; i < 16; ++i) { const int kc = ch * 32 + crow(i, hi); const bool ok = (kc >= cs) && (kc < cs + 16);
                    const float bias = rrow[ok ? kc : c];
                    s[i] = ok ? (s[i] + bias) : -INFINITY; }
            } else if (MODE == 1 && blk >= 8) {
                const int rel = (kb_lo + blk - 8) - (2 * q64 + t);
                if (rel <= -4 || rel >= 4) {
#pragma unroll
                    for (int i = 0; i < 16; ++i) { const int kk = crow(i, hi); const bool ok = (rel == -4) ? (kk >= ql) : ((rel == 4) ? (kk <= ql) : false);
                        s[i] = ok ? s[i] : -INFINITY; }
                }
            }
            attn_softmax(s, T[t]);
#pragma unroll
            for (int ks = 0; ks < 2; ++ks) {
                const bf16x8 pf = pack8(s[8 * ks + 0], s[8 * ks + 1], s[8 * ks + 2], s[8 * ks + 3], s[8 * ks + 4], s[8 * ks + 5], s[8 * ks + 6], s[8 * ks + 7]);
                T[t].o0 = MFMA32(vf[ks][0], pf, T[t].o0); T[t].o1 = MFMA32(vf[ks][1], pf, T[t].o1);
            }
            __builtin_amdgcn_sched_barrier(0);
        }
    };
    bf16x8 kA[4], kB[4]; v4u vA[4], vB[4];
    load_blk(0, kA, vA); load_blk(1, kB, vB);
    for (int blk = 0; blk < nblk; blk += 2) { step(blk, kA, vA); if (blk + 1 < nblk) step(blk + 1, kB, vB); }
#pragma unroll
    for (int t = 0; t < 2; ++t) {
        float lt = T[t].lsum + __shfl_xor(T[t].lsum, 32);
        if (MODE == 1 || MODE == 3) lt += fexp2(sink[hq] * LOG2E - T[t].m);
        const float inv = frcp(lt);
        bf16_t* op = MIX + (size_t)(qrow0 + 32 * t + ql) * 1024 + ocol + 4 * hi;
#pragma unroll
        for (int g = 0; g < 4; ++g) {
            v2u w0, w1; w0.x = pk2(T[t].o0[4 * g] * inv, T[t].o0[4 * g + 1] * inv); w0.y = pk2(T[t].o0[4 * g + 2] * inv, T[t].o0[4 * g + 3] * inv);
            w1.x = pk2(T[t].o1[4 * g] * inv, T[t].o1[4 * g + 1] * inv); w1.y = pk2(T[t].o1[4 * g + 2] * inv, T[t].o1[4 * g + 3] * inv);
            *(v2u*)(op + 8 * g) = w0; *(v2u*)(op + 32 + 8 * g) = w1;
        }
    }
}
constexpr int GP = 144;
constexpr int G_V = 0, G_A = 64 * GP, G_B = 64 * GP + 32 * GP;
static_assert(G_B + 32 * GP <= WAVE_LDS, "gla LDS");

struct GlaCum { float cum[2][16]; float tot; };
__device__ __forceinline__ void gla_cum(const bf16_t* P, int row0, int hh, int dir, const float* __restrict__ a_up, const float* __restrict__ a_bias, int lane, GlaCum& C) {
    const int kk = lane & 31, hi = lane >> 5;
    const float* up = a_up + (size_t)dir * 16 * 128 + (size_t)(8 * hi) * 128 + hh * 32 + kk;
    const bf16x8 ub = pack8(up[0], up[128], up[256], up[384], up[512], up[640], up[768], up[896]);
    const float bias = a_bias[dir * 128 + hh * 32 + kk];
    float gs[2][4];
#pragma unroll
    for (int tt = 0; tt < 2; ++tt) {
        const bf16x8 al = *(const bf16x8*)(P + (size_t)(row0 + 32 * tt + kk) * PP + C_GAF + 16 * dir + 8 * hi);
        f32x16 z;
#pragma unroll
        for (int i = 0; i < 16; ++i) z[i] = 0.f;
        z = MFMA32(al, ub, z);
#pragma unroll
        for (int g = 0; g < 4; ++g) { float run = 0.f;
#pragma unroll
            for (int e = 0; e < 4; ++e) { const float zz = z[4 * g + e] + bias; const float ls = fminf(zz, 0.f) - flog(1.f + fexp(-fabsf(zz)));
                const float l = ls * (1.f / 16.f);
                if (dir == 0) { run += l; C.cum[tt][4 * g + e] = run; } else { C.cum[tt][4 * g + e] = run; run += l; } }
            gs[tt][g] = run; }
    }
    float off = 0.f;
#pragma unroll
    for (int tt = 0; tt < 2; ++tt)
#pragma unroll
        for (int g = 0; g < 4; ++g) { const float other = __shfl_xor(gs[tt][g], 32); const float mine = off + (hi ? other : 0.f);
#pragma unroll
            for (int e = 0; e < 4; ++e) C.cum[tt][4 * g + e] += mine;
            off += gs[tt][g] + other; }
    C.tot = off;
    if (dir == 1) {
#pragma unroll
        for (int tt = 0; tt < 2; ++tt)
#pragma unroll
            for (int r = 0; r < 16; ++r) C.cum[tt][r] = off - C.cum[tt][r];
    }
}
__device__ __forceinline__ void gla_ld_tc(const bf16_t* P, int row0, int col, int lane, float (&x)[2][16]) {
    const int kk = lane & 31, hi = lane >> 5;
#pragma unroll
    for (int tt = 0; tt < 2; ++tt)
#pragma unroll
        for (int r = 0; r < 16; ++r) x[tt][r] = bf1(P[(size_t)(row0 + 32 * tt + crow(r, hi)) * PP + col + kk]);
}
__device__ __forceinline__ void gla_st_img(LAS unsigned char* img, int lane, const float (&x)[2][16]) {
    const int kk = lane & 31, hi = lane >> 5;
#pragma unroll
    for (int tt = 0; tt < 2; ++tt)
#pragma unroll
        for (int g = 0; g < 4; ++g) { v2u w; w.x = pk2(x[tt][4 * g], x[tt][4 * g + 1]); w.y = pk2(x[tt][4 * g + 2], x[tt][4 * g + 3]);
            *(LAS v2u*)(img + kk * GP + (32 * tt + 8 * g + 4 * hi) * 2) = w; }
}
__device__ __forceinline__ void gla_stage_v(const bf16_t* P, int row0, int hh, LAS unsigned char* wl, int lane) {
#pragma unroll
    for (int i = 0; i < 8; ++i) { const int c = lane + 64 * i; const v4u v = *(const v4u*)(P + (size_t)(row0 + (c >> 3)) * PP + C_GV + hh * 64 + (c & 7) * 8);
        *(LAS v4u*)(wl + G_V + (c >> 3) * GP + (c & 7) * 16) = v; }
}
__device__ __forceinline__ int gla_row0(int b, int nc) { return nc < 4 ? (ML + b * CTXL + 64 * nc) : (b * SEQ + 64 * (nc - 4)); }

__device__ __forceinline__ void gla_local_item(const bf16_t* P, float* UST, float* DEC, int item, LAS unsigned char* wl, int lane,
                                               const float* __restrict__ a_up, const float* __restrict__ a_bias) {
    asm volatile("" : "+v"(lane));
    const int nc = item % 36, hh = (item / 36) & 3, b = item / 144;
    const int row0 = gla_row0(b, nc), kk = lane & 31, hi = lane >> 5;
    gla_stage_v(P, row0, hh, wl, lane);
    float kv[2][16]; gla_ld_tc(P, row0, C_GK + hh * 32, lane, kv);
#pragma unroll
    for (int dir = 0; dir < 2; ++dir) {
        GlaCum C; gla_cum(P, row0, hh, dir, a_up, a_bias, lane, C);
        float kd[2][16];
#pragma unroll
        for (int tt = 0; tt < 2; ++tt)
#pragma unroll
            for (int r = 0; r < 16; ++r) kd[tt][r] = kv[tt][r] * fexp(C.tot - C.cum[tt][r]);
        gla_st_img(wl + (dir == 0 ? G_A : G_B), lane, kd);
        if (hi == 0) DEC[((size_t)((b * 4 + hh) * 2 + dir) * 36 + nc) * 32 + kk] = fexp(C.tot);
    }
    const int trv = ((lane & 15) >> 2) * GP + (16 * ((lane >> 4) & 1) + 4 * (lane & 3)) * 2;
#pragma unroll
    for (int dir = 0; dir < 2; ++dir) {
        f32x16 u0, u1;
#pragma unroll
        for (int i = 0; i < 16; ++i) { u0[i] = 0.f; u1[i] = 0.f; }
        LAS const unsigned char* img = wl + (dir == 0 ? G_A : G_B);
#pragma unroll
        for (int s = 0; s < 4; ++s) {
            const bf16x8 kb = *(LAS const bf16x8*)(img + kk * GP + (16 * s + 8 * hi) * 2);
            LAS const unsigned char* vb = wl + G_V + trv + (16 * s + 8 * hi) * GP;
            const bf16x8 v0 = cat4(tr_read(vb), tr_read(vb + 4 * GP));
            const bf16x8 v1 = cat4(tr_read(vb + 64), tr_read(vb + 4 * GP + 64));
            u0 = MFMA32(v0, kb, u0); u1 = MFMA32(v1, kb, u1);
        }
        float* up = UST + ((size_t)((b * 4 + hh) * 2 + dir) * 36 + nc) * 2048 + kk;
#pragma unroll
        for (int i = 0; i < 16; ++i) { up[(size_t)crow(i, hi) * 32] = u0[i]; up[(size_t)(32 + crow(i, hi)) * 32] = u1[i]; }
    }
}

__device__ __forceinline__ void gla_prefix(float* UST, const float* DEC, int gid, bool dry) {
    const int bhd = gid >> 11, e = gid & 2047, k = e & 31, dir = bhd & 1;
    float* base = UST + (size_t)bhd * 36 * 2048 + e; const float* dec = DEC + (size_t)bhd * 36 * 32 + k;
    float s = 0.f;
#pragma unroll 4
    for (int ci = 0; ci < 36; ++ci) {
        const int sl = dir == 0 ? ci : (ci < 4 ? 3 - ci : 39 - ci);
        const float u = base[(size_t)sl * 2048], d = dec[sl * 32];
        if (!dry) base[(size_t)sl * 2048] = s;
        s = d * s + u;
    }
}

__device__ __forceinline__ void gla_out_item(const bf16_t* P, const float* UST, bf16_t* MIX, int item, LAS unsigned char* wl, int lane,
                                             const float* __restrict__ a_up, const float* __restrict__ a_bias, const float* __restrict__ gnorm) {
    const int nc = item % 36, hh = (item / 36) & 3, b = item / 144;
    const int row0 = gla_row0(b, nc), kk = lane & 31, hi = lane >> 5;
    gla_stage_v(P, row0, hh, wl, lane);
    f32x16 o[2][2];
#pragma unroll
    for (int a = 0; a < 2; ++a)
#pragma unroll
        for (int c = 0; c < 2; ++c)
#pragma unroll
            for (int i = 0; i < 16; ++i) o[a][c][i] = 0.f;
    unsigned qp[2][8], kp[2][8];
#pragma unroll
    for (int tt = 0; tt < 2; ++tt) {
#pragma unroll
        for (int g = 0; g < 4; ++g)
#pragma unroll
            for (int e2 = 0; e2 < 2; ++e2) { const size_t ro = (size_t)(row0 + 32 * tt + 8 * g + 4 * hi + 2 * e2) * PP + hh * 32 + kk;
                qp[tt][2 * g + e2] = (unsigned)P[ro + C_GQ] | ((unsigned)P[ro + PP + C_GQ] << 16); kp[tt][2 * g + e2] = (unsigned)P[ro + C_GK] | ((unsigned)P[ro + PP + C_GK] << 16); }
        asm volatile("" ::: "memory");
    }
    const int g16 = (lane >> 4) & 1, qq = (lane & 15) >> 2, pp = lane & 3;
    const int tri = (8 * hi + qq) * GP + (16 * g16 + 4 * pp) * 2;
    const int trv = (4 * hi + qq) * GP + (16 * g16 + 4 * pp) * 2;
#pragma unroll
    for (int dir = 0; dir < 2; ++dir) {
        GlaCum C; gla_cum(P, row0, hh, dir, a_up, a_bias, lane, C);
#pragma unroll
        for (int tt = 0; tt < 2; ++tt) {
            float cum[16];
#pragma unroll
            for (int r = 0; r < 16; ++r) cum[r] = C.cum[tt][r];
#pragma unroll
            for (int g = 0; g < 4; ++g) {
                float xq[4], xk[4];
#pragma unroll
                for (int e = 0; e < 4; ++e) { const unsigned qw = qp[tt][2 * g + (e >> 1)], kw = kp[tt][2 * g + (e >> 1)];
                    xq[e] = ((e & 1) ? bfhi(qw) : bflo(qw)) * 0.17677669529663687f * fexp(cum[4 * g + e]); xk[e] = ((e & 1) ? bfhi(kw) : bflo(kw)) * fexp(-cum[4 * g + e]); }
                v2u wq, wk; wq.x = pk2(xq[0], xq[1]); wq.y = pk2(xq[2], xq[3]); wk.x = pk2(xk[0], xk[1]); wk.y = pk2(xk[2], xk[3]);
                const int off = kk * GP + (32 * tt + 8 * g + 4 * hi) * 2;
                *(LAS v2u*)(wl + G_A + off) = wq; *(LAS v2u*)(wl + G_B + off) = wk;
            }
        }
        const float* sp = UST + ((size_t)((b * 4 + hh) * 2 + dir) * 36 + nc) * 2048;
        bf16x8 sf[2][2];
#pragma unroll
        for (int vb = 0; vb < 2; ++vb)
#pragma unroll
            for (int s = 0; s < 2; ++s) { const float* p = sp + (size_t)(32 * vb + kk) * 32 + 16 * s + 8 * hi; const f32x4 a = *(const f32x4*)p, c = *(const f32x4*)(p + 4);
                sf[vb][s] = pack8(a.x, a.y, a.z, a.w, c.x, c.y, c.z, c.w); }
#pragma unroll
        for (int it = 0; it < 2; ++it) {
            bf16x8 qf[2];
#pragma unroll
            for (int s = 0; s < 2; ++s) { LAS const unsigned char* p = wl + G_A + tri + 16 * s * GP + 64 * it; qf[s] = cat4(tr_read(p), tr_read(p + 4 * GP)); }
#pragma unroll
            for (int vb = 0; vb < 2; ++vb)
#pragma unroll
                for (int s = 0; s < 2; ++s) o[vb][it] = MFMA32(sf[vb][s], qf[s], o[vb][it]);
#pragma unroll
            for (int jt = 0; jt < 2; ++jt) {
                if (dir == 0 ? (jt > it) : (jt < it)) continue;
                f32x16 sc;
#pragma unroll
                for (int i = 0; i < 16; ++i) sc[i] = 0.f;
#pragma unroll
                for (int s = 0; s < 2; ++s) { LAS const unsigned char* p = wl + G_B + tri + 16 * s * GP + 64 * jt; const bf16x8 kf = cat4(tr_read(p), tr_read(p + 4 * GP)); sc = MFMA32(kf, qf[s], sc); }
                if (jt == it) {
#pragma unroll
                    for (int i = 0; i < 16; ++i) { const int j = crow(i, hi); const bool ok = dir == 0 ? (j <= kk) : (j >= kk); sc[i] = ok ? sc[i] : 0.f; }
                }
#pragma unroll
                for (int s2 = 0; s2 < 2; ++s2) {
                    const bf16x8 pf = pack8(sc[8 * s2 + 0], sc[8 * s2 + 1], sc[8 * s2 + 2], sc[8 * s2 + 3], sc[8 * s2 + 4], sc[8 * s2 + 5], sc[8 * s2 + 6], sc[8 * s2 + 7]);
                    LAS const unsigned char* vp = wl + G_V + trv + (32 * jt + 16 * s2) * GP;
                    const bf16x8 v0 = cat4(tr_read(vp), tr_read(vp + 8 * GP));
                    const bf16x8 v1 = cat4(tr_read(vp + 64), tr_read(vp + 8 * GP + 64));
                    o[0][it] = MFMA32(v0, pf, o[0][it]); o[1][it] = MFMA32(v1, pf, o[1][it]);
                }
                __builtin_amdgcn_sched_barrier(0);
            }
            __builtin_amdgcn_sched_barrier(0);
        }
    }
#pragma unroll
    for (int it = 0; it < 2; ++it) {
        float ss = 0.f;
#pragma unroll
        for (int vb = 0; vb < 2; ++vb)
#pragma unroll
            for (int i = 0; i < 16; ++i) ss += o[vb][it][i] * o[vb][it][i];
        ss += __shfl_xor(ss, 32);
        const float rstd = __builtin_amdgcn_rsqf(ss * (1.f / 64.f) + NEPS);
        const size_t row = (size_t)(row0 + 32 * it + kk);
#pragma unroll
        for (int vb = 0; vb < 2; ++vb)
#pragma unroll
            for (int g = 0; g < 4; ++g) { const int v = 32 * vb + 8 * g + 4 * hi;
                const f32x4 gn = *(const f32x4*)(gnorm + v); const v2u gw = *(const v2u*)(P + row * PP + C_GG + hh * 64 + v);
                const float g0 = bflo(gw.x), g1 = bfhi(gw.x), g2 = bflo(gw.y), g3 = bfhi(gw.y);
                v2u w; w.x = pk2(o[vb][it][4 * g] * rstd * gn.x * silu_f(g0), o[vb][it][4 * g + 1] * rstd * gn.y * silu_f(g1));
                w.y = pk2(o[vb][it][4 * g + 2] * rstd * gn.z * silu_f(g2), o[vb][it][4 * g + 3] * rstd * gn.w * silu_f(g3));
                *(v2u*)(MIX + row * 1024 + hh * 64 + v) = w; }
    }
}
constexpr int RTP = 1028;
__device__ __forceinline__ void r1_fill_rt(const float* const* in, LAS unsigned char* lds, int l, int t0, int nthr) {
    const float* wr = in[14] + (size_t)l * 1024 * 16; LAS float* RT = (LAS float*)lds + 6144;
    for (int i = t0; i < 16384; i += nthr) { const int d = i >> 4, e = i & 15; RT[e * RTP + d] = wr[i]; }
}
__device__ __forceinline__ void r1_fill_vec(const float* const* in, const unsigned char* ws, LAS unsigned char* lds, int l, int t, int t0, int nthr) {
    const float* gains = in[6] + (size_t)l * 4096; const float* mod = (const float*)(ws + WS_MOD) + (size_t)l * 9 * 6144; LAS float* V = (LAS float*)lds; const int b = t >> 5;
    for (int n = t0; n < 1024; n += nthr) { const float gpa = gains[1024 + n], gpf = gains[2048 + n];
        V[n] = gpa * mod[b * 6144 + 2048 + n]; V[1024 + n] = gpf * (1.f + mod[b * 6144 + 4096 + n]); V[2048 + n] = mod[b * 6144 + 3072 + n];
        V[3072 + n] = gpa * mod[8 * 6144 + 2048 + n]; V[4096 + n] = gpf * (1.f + mod[8 * 6144 + 4096 + n]); V[5120 + n] = mod[8 * 6144 + 3072 + n]; }
}
__device__ __forceinline__ void phase_r1(const float* const* in, float* xout, unsigned char* ws, LAS unsigned char* lds, int l, bool upd, int G, int tid, int wave, int lane, bool dry, bool pre_done) {
    const float* x0 = in[0]; const float* ctx0 = in[2];
    const bf16_t* Y = (const bf16_t*)(ws + WS_R2 + (size_t)MT * 2048); bf16_t* H = (bf16_t*)(ws + WS_H); bf16_t* XB = (bf16_t*)(ws + WS_XB);
    float* AFF = (float*)(ws + WS_AFF); float* AFFC = (float*)(ws + WS_AFFC);
    LAS float* V = (LAS float*)lds;
    LAS float* RT = V + 6144;
    if (!pre_done) { __syncthreads(); r1_fill_rt(in, lds, l, tid, 512); }
    for (int t = blockIdx.x; t < 256; t += G) {
        if (!(pre_done && t == (int)blockIdx.x)) { __syncthreads(); r1_fill_vec(in, ws, lds, l, t, tid, 512); __syncthreads(); }
        const int nrows = upd ? 9 : 8;
#pragma unroll 1
        for (int i0 = 0; i0 < 9; i0 += 3) {
            f32x4 yv[3][4], xq[3][4];
#pragma unroll
            for (int k = 0; k < 3; ++k) { const int i = (i0 + k < nrows) ? (i0 + k) : 7;
                const bool isc = (i == 8); const int row = isc ? (ML + 8 * t + wave) : (64 * t + 8 * wave + i);
                ld_row_bf16(Y + (size_t)row * 1024, lane, yv[k]);
                if (l == 0) ld_row_f32(isc ? (ctx0 + (size_t)(8 * t + wave) * 1024) : (x0 + (size_t)row * 1024), lane, xq[k]); else ld_row_bf16(XB + (size_t)row * 1024, lane, xq[k]); }
#pragma unroll
            for (int k = 0; k < 3; ++k) { const bool act = (i0 + k < nrows); const int i = act ? (i0 + k) : 7;
            const bool isc = (i == 8);
            const int row = isc ? (ML + 8 * t + wave) : (64 * t + 8 * wave + i);
            bf16_t* xd = (dry ? (bf16_t*)(ws + WS_R1) : XB) + (size_t)row * 1024;
            LAS const float* vv = V + (isc ? 3072 : 0);
            f32x4 (&y)[4] = yv[k]; f32x4 (&xv)[4] = xq[k]; f32x4 a[4];
            const float rsy = __builtin_amdgcn_rsqf(wave_sum(sumsq16(y)) * (1.f / 1024.f) + NEPS);
            ld_vec_lds(vv, lane, a);
#pragma unroll
            for (int j = 0; j < 4; ++j) xv[j] = xv[j] + a[j] * (y[j] * rsy);
            if (act) st_row_bf16(xd, lane, xv);
            const float rs1 = __builtin_amdgcn_rsqf(wave_sum(sumsq16(xv)) * (1.f / 1024.f) + NEPS);
            f32x4 s[4]; ld_vec_lds(vv + 1024, lane, a); ld_vec_lds(vv + 2048, lane, s);
#pragma unroll
            for (int j = 0; j < 4; ++j) xv[j] = xv[j] * rs1 * a[j] + s[j];
            if (act) st_row_bf16((dry ? (bf16_t*)(ws + WS_R2) : H) + (size_t)row * 1024, lane, xv);
            }
            float lg3[3][16];
#pragma unroll
            for (int e = 0; e < 16; ++e) { f32x2 pa[3];
#pragma unroll
                for (int k = 0; k < 3; ++k) pa[k] = (f32x2){0.f, 0.f};
#pragma unroll
                for (int j = 0; j < 4; ++j) { const f32x4 w = *(LAS const f32x4*)(RT + e * RTP + 256 * j + 4 * lane); const f32x2 wl = {w.x, w.y}, wh = {w.z, w.w};
#pragma unroll
                    for (int k = 0; k < 3; ++k) { pa[k] += (f32x2){xq[k][j].x, xq[k][j].y} * wl; pa[k] += (f32x2){xq[k][j].z, xq[k][j].w} * wh; } }
#pragma unroll
                for (int k = 0; k < 3; ++k) lg3[k][e] = pa[k].x + pa[k].y;
                asm volatile("" : "+v"(lg3[0][e]), "+v"(lg3[1][e]), "+v"(lg3[2][e]));
                if ((e & 3) == 3) asm volatile("" ::: "memory"); }
#pragma unroll
            for (int k = 0; k < 3; ++k) { const bool act = (i0 + k < nrows); const int i = i0 + k; {
            const bool isc = (i == 8);
            const int row = isc ? (ML + 8 * t + wave) : (64 * t + 8 * wave + i);
            float (&lg)[16] = lg3[k];
#pragma unroll
            for (int i2 = 0; i2 < 8; ++i2) { const bool up = (lane & 32) != 0; const float keep = up ? lg[i2 + 8] : lg[i2], send = up ? lg[i2] : lg[i2 + 8]; lg[i2] = keep + __shfl_xor(send, 32); }
#pragma unroll
            for (int i2 = 0; i2 < 4; ++i2) { const bool up = (lane & 16) != 0; const float keep = up ? lg[i2 + 4] : lg[i2], send = up ? lg[i2] : lg[i2 + 4]; lg[i2] = keep + __shfl_xor(send, 16); }
#pragma unroll
            for (int i2 = 0; i2 < 2; ++i2) { const bool up = (lane & 8) != 0; const float keep = up ? lg[i2 + 2] : lg[i2], send = up ? lg[i2] : lg[i2 + 2]; lg[i2] = keep + __shfl_xor(send, 8); }
            { const bool up = (lane & 4) != 0; const float keep = up ? lg[1] : lg[0], send = up ? lg[0] : lg[1]; lg[0] = keep + __shfl_xor(send, 4); }
            float lgt = lg[0]; lgt += __shfl_xor(lgt, 1); lgt += __shfl_xor(lgt, 2);
            const int ex = ((lane >> 5) & 1) * 8 + ((lane >> 4) & 1) * 4 + ((lane >> 3) & 1) * 2 + ((lane >> 2) & 1);
            float mx = lgt;
            mx = fmaxf(mx, __shfl_xor(mx, 4)); mx = fmaxf(mx, __shfl_xor(mx, 8)); mx = fmaxf(mx, __shfl_xor(mx, 16)); mx = fmaxf(mx, __shfl_xor(mx, 32));
            const float pe = fexp(lgt - mx);
            float den = pe; den += __shfl_xor(den, 4); den += __shfl_xor(den, 8); den += __shfl_xor(den, 16); den += __shfl_xor(den, 32);
            const float mine = pe / den;
            if ((lane & 3) == 0 && act) {
                if (isc) { const int cr = 8 * t + wave; AFFC[((size_t)(cr >> 8) * 16 + ex) * 256 + (cr & 255)] = mine; }
                else AFF[((size_t)(row >> 11) * 16 + ex) * 2048 + (row & 2047)] = mine;
            }
            } }
        }
    }
}

template <bool CTX>
__device__ __forceinline__ void topk_wave(unsigned char* ws, int item, int lane) {
    constexpr int NT = CTX ? 256 : 2048, CAP = CTX ? 32 : 256, PER = NT / 64;
    const int e = item & 15, b = item >> 4;
    const float* arow = (const float*)(ws + (CTX ? WS_AFFC : WS_AFF)) + (size_t)(b * 16 + e) * NT;
    float* gate = (float*)(ws + (CTX ? WS_GATEC : WS_GATE)) + (size_t)(b * 16 + e) * CAP;
    short* INV = (short*)(ws + WS_INV);
    int* rowidx = (int*)(ws + WS_ROWIDX) + (CTX ? ((128 + e) * 256 + b * 32) : ((b * 16 + e) * 256));
    unsigned v[PER];
#pragma unroll
    for (int i = 0; i < PER / 4; ++i) { const v4u q = *(const v4u*)(arow + lane * PER + 4 * i); v[4 * i] = q.x; v[4 * i + 1] = q.y; v[4 * i + 2] = q.z; v[4 * i + 3] = q.w; }
    unsigned T = 0;
    for (int bit = 29; bit >= 0; --bit) {
        const unsigned cand = T | (1u << bit); int c = 0;
#pragma unroll
        for (int i = 0; i < PER; ++i) c += __popcll(__ballot(v[i] >= cand));
        if (c >= CAP) T = cand;
    }
    int ngt = 0, cg = 0, ce = 0;
#pragma unroll
    for (int i = 0; i < PER; ++i) { ngt += __popcll(__ballot(v[i] > T)); cg += (v[i] > T) ? 1 : 0; ce += (v[i] == T) ? 1 : 0; }
    const int need = CAP - ngt;
    int pg = cg, pe = ce;
#pragma unroll
    for (int d = 1; d < 64; d <<= 1) { const int tg = __shfl_up(pg, d), te = __shfl_up(pe, d); if (lane >= d) { pg += tg; pe += te; } }
    pg -= cg; pe -= ce;
#pragma unroll
    for (int i = 0; i < PER; ++i) {
        const bool gt = v[i] > T, eq = v[i] == T;
        const bool sel = gt || (eq && pe < need);
        const int slot = pg + (pe < need ? pe : need);
        const int tok = lane * PER + i, grow = CTX ? (ML + b * CTXL + tok) : (b * SEQ + tok);
        if (sel) { rowidx[slot] = grow; gate[slot] = __uint_as_float(v[i]); }
        INV[(size_t)grow * 16 + e] = sel ? (short)slot : (short)-1;
        pg += gt ? 1 : 0; pe += eq ? 1 : 0;
    }
}

__device__ __forceinline__ void topk_wg2(unsigned char* ws, int item, LAS unsigned char* lds, int tid, int wave, int lane) {
    constexpr int CAP = 256;
    const int e = item & 15, b = item >> 4;
    const float* arow = (const float*)(ws + WS_AFF) + (size_t)(b * 16 + e) * 2048;
    float* gate = (float*)(ws + WS_GATE) + (size_t)(b * 16 + e) * CAP;
    short* INV = (short*)(ws + WS_INV);
    int* rowidx = (int*)(ws + WS_ROWIDX) + (b * 16 + e) * 256;
    LAS int* cnt = (LAS int*)lds;
    const v4u q = *(const v4u*)(arow + 4 * tid);
    const unsigned v[4] = {q.x, q.y, q.z, q.w};
    unsigned T = 0;
    __syncthreads();
    for (int bit = 29; bit >= 0; --bit) {
        const unsigned cand = T | (1u << bit); int c = 0;
#pragma unroll
        for (int i = 0; i < 4; ++i) c += __popcll(__ballot(v[i] >= cand));
        LAS int* cb = cnt + (bit & 1) * 8;
        if (lane == 0) cb[wave] = c;
        __syncthreads();
        int tot = 0;
#pragma unroll
        for (int w = 0; w < 8; ++w) tot += cb[w];
        if (tot >= CAP) T = cand;
    }
    int cg = 0, ce = 0, wg_ = 0, we_ = 0;
#pragma unroll
    for (int i = 0; i < 4; ++i) { wg_ += __popcll(__ballot(v[i] > T)); we_ += __popcll(__ballot(v[i] == T)); cg += (v[i] > T) ? 1 : 0; ce += (v[i] == T) ? 1 : 0; }
    if (lane == 0) { cnt[16 + wave] = wg_; cnt[24 + wave] = we_; }
    int pg = cg, pe = ce;
#pragma unroll
    for (int d = 1; d < 64; d <<= 1) { const int tg = __shfl_up(pg, d), te = __shfl_up(pe, d); if (lane >= d) { pg += tg; pe += te; } }
    pg -= cg; pe -= ce;
    __syncthreads();
    int ngt = 0;
#pragma unroll
    for (int w = 0; w < 8; ++w) { const int g_ = cnt[16 + w], e_ = cnt[24 + w]; ngt += g_; if (w < wave) { pg += g_; pe += e_; } }
    const int need = CAP - ngt;
#pragma unroll
    for (int i = 0; i < 4; ++i) {
        const bool gt = v[i] > T, eq = v[i] == T;
        const bool sel = gt || (eq && pe < need);
        const int slot = pg + (pe < need ? pe : need);
        const int grow = b * SEQ + 4 * tid + i;
        if (sel) { rowidx[slot] = grow; gate[slot] = __uint_as_float(v[i]); }
        INV[(size_t)grow * 16 + e] = sel ? (short)slot : (short)-1;
        pg += gt ? 1 : 0; pe += eq ? 1 : 0;
    }
}

__device__ __forceinline__ void r5_fill(const float* const* in, const unsigned char* ws, LAS unsigned char* lds, int l, bool upd, int t, int t0, int nthr) {
    const float* gains = in[6]; const float* mod = (const float*)(ws + WS_MOD);
    const float* GATE = (const float*)(ws + WS_GATE); const float* GATEC = (const float*)(ws + WS_GATEC); const short* INV = (const short*)(ws + WS_INV);
    LAS float* V = (LAS float*)lds; LAS int* CL = (LAS int*)(lds + 24576); const int b = t >> 5;
    for (int n = t0; n < 1024; n += nthr) { const float gpf = gains[(size_t)l * 4096 + 3072 + n];
        V[n] = gpf * mod[((size_t)l * 9 + b) * 6144 + 5120 + n]; V[3072 + n] = gpf * mod[((size_t)l * 9 + 8) * 6144 + 5120 + n];
        if (l == 0) { const float gna = gains[4096 + n];
            V[1024 + n] = gna * (1.f + mod[((size_t)9 + b) * 6144 + 1024 + n]); V[2048 + n] = mod[((size_t)9 + b) * 6144 + n];
            V[4096 + n] = gna * (1.f + mod[((size_t)9 + 8) * 6144 + 1024 + n]); V[5120 + n] = mod[((size_t)9 + 8) * 6144 + n]; } }
    if (t0 < (upd ? 72 : 64)) {
        const bool isc = t0 >= 64; const int cr = 8 * t + (t0 - 64);
        const int row = isc ? (ML + cr) : (64 * t + t0); const int bb = isc ? (cr >> 8) : b;
        const v4u i0 = *(const v4u*)(INV + (size_t)row * 16), i1 = *(const v4u*)(INV + (size_t)row * 16 + 8);
        const unsigned iw[8] = {i0.x, i0.y, i0.z, i0.w, i1.x, i1.y, i1.z, i1.w};
        float gv[16]; int sl[16];
#pragma unroll
        for (int e = 0; e < 16; ++e) { sl[e] = (int)(short)((iw[e >> 1] >> (16 * (e & 1))) & 0xffffu); const int s0 = sl[e] < 0 ? 0 : sl[e];
            gv[e] = isc ? GATEC[(size_t)(bb * 16 + e) * 32 + s0] : GATE[(size_t)(bb * 16 + e) * 256 + s0]; }
        int cnt = 0; LAS int* cl = CL + t0 * 33;
#pragma unroll
        for (int e = 0; e < 16; ++e) if (sl[e] >= 0) { cl[1 + 2 * cnt] = isc ? ((128 + e) * 256 + bb * 32 + sl[e]) : ((bb * 16 + e) * 256 + sl[e]); cl[2 + 2 * cnt] = (int)__float_as_uint(gv[e]); ++cnt; }
        cl[0] = cnt;
    }
}
__device__ __forceinline__ void phase_r5(const float* const* in, float* xout, unsigned char* ws, LAS unsigned char* lds, int l, bool upd, int G, int tid, int wave, int lane, bool dry, bool pre_done) {
    const bf16_t* YE = (const bf16_t*)(ws + WS_R1); bf16_t* H = (bf16_t*)(ws + WS_H); bf16_t* XB = (bf16_t*)(ws + WS_XB);
    LAS float* V = (LAS float*)lds;
    LAS int* CL = (LAS int*)(lds + 24576);
    for (int t = blockIdx.x; t < 256; t += G) {
        if (!(pre_done && t == (int)blockIdx.x)) { __syncthreads(); r5_fill(in, ws, lds, l, upd, t, tid, 512); __syncthreads(); }
        const int nrows = upd ? 9 : 8;
#pragma unroll 1
        for (int i0 = 0; i0 < 9; i0 += 3) {
            f32x4 xq[3][4];
#pragma unroll
            for (int k = 0; k < 3; ++k) { const int i = i0 + k; if (i < nrows) { const bool isc = (i == 8);
                ld_row_bf16(XB + (size_t)(isc ? (ML + 8 * t + wave) : (64 * t + 8 * wave + i)) * 1024, lane, xq[k]); } }
#pragma unroll
            for (int k = 0; k < 3; ++k) { const int i = i0 + k; if (i < nrows) {
            const bool isc = (i == 8);
            const int row = isc ? (ML + 8 * t + wave) : (64 * t + 8 * wave + i);
            LAS const float* vv = V + (isc ? 3072 : 0);
            LAS const int* cl = CL + (isc ? (64 + wave) : (8 * wave + i)) * 33;
            const int n = __builtin_amdgcn_readfirstlane(cl[0]);
            f32x4 acc[4];
#pragma unroll
            for (int j = 0; j < 4; ++j) acc[j] = (f32x4){0.f, 0.f, 0.f, 0.f};
            for (int j0 = 0; j0 < n; j0 += 4) {
                v2u raw[4][4]; float g[4];
#pragma unroll
                for (int q = 0; q < 4; ++q) {
                    if (j0 + q < n) { const int yr = __builtin_amdgcn_readfirstlane(cl[1 + 2 * (j0 + q)]); g[q] = __uint_as_float((unsigned)__builtin_amdgcn_readfirstlane(cl[2 + 2 * (j0 + q)]));
                        const bf16_t* yp = YE + (size_t)yr * 1024;
#pragma unroll
                        for (int j = 0; j < 4; ++j) raw[q][j] = *(const v2u*)(yp + 256 * j + 4 * lane); }
                    else { g[q] = 0.f;
#pragma unroll
                        for (int j = 0; j < 4; ++j) raw[q][j] = (v2u){0u, 0u}; }
                }
#pragma unroll
                for (int q = 0; q < 4; ++q)
#pragma unroll
                    for (int j = 0; j < 4; ++j) acc[j] += (f32x4){bflo(raw[q][j].x), bfhi(raw[q][j].x), bflo(raw[q][j].y), bfhi(raw[q][j].y)} * g[q];
            }
            const float rsm = __builtin_amdgcn_rsqf(wave_sum(sumsq16(acc)) * (1.f / 1024.f) + NEPS);
            f32x4 (&xv)[4] = xq[k]; f32x4 a[4]; ld_vec_lds(vv, lane, a);
#pragma unroll
            for (int j = 0; j < 4; ++j) xv[j] = xv[j] + a[j] * (acc[j] * rsm);
            if (l == 0) st_row_bf16((dry ? (bf16_t*)(ws + WS_R2) : XB) + (size_t)row * 1024, lane, xv);
            else st_row_f32((dry ? (float*)(ws + WS_R2) : xout) + (size_t)row * 1024, lane, xv);
            if (l == 0 && !dry) {
                const float rs2 = __builtin_amdgcn_rsqf(wave_sum(sumsq16(xv)) * (1.f / 1024.f) + NEPS);
                f32x4 s[4]; ld_vec_lds(vv + 1024, lane, a); ld_vec_lds(vv + 2048, lane, s);
#pragma unroll
                for (int j = 0; j < 4; ++j) xv[j] = xv[j] * rs2 * a[j] + s[j];
                st_row_bf16(H + (size_t)row * 1024, lane, xv);
            }
            } }
        }
    }
}
#ifndef MK_PER_PHASE
#define MK_PER_PHASE 0
#endif
constexpr int N_PHASES = 22;
struct Args { const float* in[18]; float* out; unsigned char* ws; int ph_lo, ph_hi; };
__device__ __forceinline__ const Args* kargs_opaque() {
    auto p = __builtin_amdgcn_kernarg_segment_ptr(); asm volatile("" : "+s"(p)); return (const Args*)p; }
#define PHASE_REGS() int tid = threadIdx.x; asm volatile("" : "+v"(tid)); const int lane = tid & 63, wave = __builtin_amdgcn_readfirstlane(tid >> 6); \
    const Args* A = kargs_opaque(); unsigned char* ws = A->ws; const int G = gridDim.x, bx = blockIdx.x; \
    const int vcu = (G % 8 == 0) ? (bx % 8) * (G / 8) + bx / 8 : bx; const int gw = vcu * NWAVES + wave, NGW = G * NWAVES; \
    LAS unsigned char* wl = lds + wave * WAVE_LDS; (void)gw; (void)NGW; (void)wl; (void)lane; (void)ws
#ifndef CONV_BUDGET
#define CONV_BUDGET 1
#endif
#ifndef PH_MASK
#define PH_MASK 0xFFFFFFFFu
#endif
#define EN(j) (((PH_MASK) >> (j)) & 1u)
#ifndef REP_MASK
#define REP_MASK 0u
#endif
#define REPS(j) ((((REP_MASK) >> (j)) & 1u) ? 2 : 1)
__global__ void __launch_bounds__(NWAVES * 64, 2) fwd_kernel(Args args) {
    extern __shared__ __attribute__((aligned(16))) unsigned char lds_raw[];
    LAS unsigned char* lds = (LAS unsigned char*)lds_raw;
    volatile LAS unsigned* MISC = (volatile LAS unsigned*)(lds + MISC_OFF);
    for (int u = threadIdx.x; u < (LDS_BYTES - LDSCTL_OFF) / 4; u += NWAVES * 64) ((LAS unsigned*)(lds + LDSCTL_OFF))[u] = 0u;
    __syncthreads();
    const int lo = args.ph_lo, hi = args.ph_hi;
    XcdBarrier bar; bar.bar = (unsigned*)(args.ws + WS_CTL) + CW_BAR; bar.x = 0; bar.st = nullptr;
    if (hi - lo > 1) bar = xcd_barrier_post((unsigned*)(args.ws + WS_CTL) + CW_BAR, MISC + 8);
#define IN(k) (lo <= (k) && (k) < hi)
#ifdef STAMP_A
#define STAMP(k) do { if (blockIdx.x == 0 && threadIdx.x == 0) ((unsigned long long*)(args.ws + WS_CTL))[1536 + (k)] = __builtin_amdgcn_s_memrealtime(); } while (0)
#else
#define STAMP(k) do { } while (0)
#endif
#define SEAM(k) do { if (IN((k) + 1)) { xcd_barrier(bar); if (REPS(12) == 2) xcd_barrier(bar); } STAMP((k) + 1); } while (0)
#define SEAM_OV(k, WORK) do { if (IN((k) + 1)) { const Args* A_ = kargs_opaque(); unsigned char* ws_ = A_->ws; (void)ws_; \
        xcd_barrier_overlap(bar, [&](int t0, int nthr) { if (blockIdx.x < 256) { WORK; } }); if (REPS(12) == 2) xcd_barrier(bar); pre = (blockIdx.x < 256); } STAMP((k) + 1); } while (0)
    STAMP(0);
    if (EN(0) && IN(0)) { for (int rep = 0; rep < REPS(0); ++rep) { PHASE_REGS(); phase_p0(A->in, ws, wl, gw, NGW, lane); } SEAM(0); }
    if (EN(1) && IN(1)) { for (int rep = 0; rep < REPS(1); ++rep) { PHASE_REGS(); phase_a0(A->in, ws, lds, G, tid, wave, lane); } SEAM(1); }
    for (int l = 0; l < 2; ++l) {
        const int base = 2 + 10 * l; const bool upd = (l == 0); bool pre = false;
        if (EN(2) && IN(base + 0)) { for (int rep = 0; rep < REPS(2); ++rep) {
            PHASE_REGS();
            pg8::Gemm g{(const bf16_t*)(ws + WS_H), (const bf16_t*)(ws + WS_WIN) + (size_t)l * PP * 1024, MT, PP, 1024}; pg8::StaticOrder S; S.init(MT, PP, G, bx);
            pg8::EpiProj E{(bf16_t*)(ws + WS_R1), PP, (const pg8::f32x2*)(ws + WS_TAB), ML};
            pg8::gemm_phase<pg8::EpiProj, pg8::StaticOrder, true, true>(lds, g, S, E);
            if (upd && CV_G1 > 0 && G == 256 && bx >= 208 && !(rep + 1 < REPS(2))) tr_stream(A->in, ws, P0_A + (bx - 208) * NWAVES + wave, 384, P0_A + CV_N1, (LAS float*)wl, lane);
            if (!CONV_IN_P0) { const int nwg_ = (MT / 256) * (PP / 256); if ((nwg_ - bx + G - 1) / G < (nwg_ + G - 1) / G) conv_pull(A->in, ws, l, 1, 12 * CONV_BUDGET, (LAS float*)wl, lane); }
            }
            SEAM(base + 0);
        }
        if (EN(3) && IN(base + 1)) { for (int rep = 0; rep < REPS(3); ++rep) {
            PHASE_REGS();
            const bf16_t* PROJ = (const bf16_t*)(ws + WS_R1); bf16_t* MIX = (bf16_t*)(ws + WS_R2);
            const float* a_up = A->in[9] + (size_t)l * 2 * 16 * 128; const float* a_bias = A->in[10] + (size_t)l * 2 * 128;
            const float* rpb = A->in[12] + (size_t)l * 4 * 465; const float* sink = A->in[13] + (size_t)l * 8;
            const int n_cn = upd ? 128 : 0, n_cs = upd ? 256 : 0;
            const bool xmap = (G == 256);
            const int xcd = bx & 7, cu = bx >> 3;
            const int n_att = xmap ? 12 : 0;
            const int tail_total = (xmap ? 0 : 1024 + 2048) + 1152 + n_cn + n_cs;
            volatile LAS unsigned* qctr = (volatile LAS unsigned*)(lds + MISC_OFF) + 16 + l * 2 + rep;
            const int n_conv = 0, n_mix = (n_conv + 2) / 3 * 4;
            if (CV_M1 > 0 && upd && G == 256 && wave == 7 && !(rep + 1 < REPS(3))) tr_stream(A->in, ws, P0_A + CV_N1 + bx, 256, P0_A + CV_N1 + 256 * CV_M1, (LAS float*)wl, lane);
            for (;;) {
                int j = 0; if (lane == 0) j = (int)__hip_atomic_fetch_add((LAS unsigned*)qctr, 1u, __ATOMIC_RELAXED, __HIP_MEMORY_SCOPE_WORKGROUP);
                j = __builtin_amdgcn_readfirstlane(j);
                if (j < n_mix) {
                    if ((j & 3) != 3) { const int ci = (j >> 2) * 3 + (j & 3), r = ci * G + bx; if (ci < n_conv && r < 12288 && !(rep + 1 < REPS(3))) expert_conv_item(A->in, ws, l, r, (LAS float*)wl, lane); continue; }
                    j = j >> 2;
                } else j = j - n_mix + n_mix / 4;
                int mode, item;
                if (j < n_att) {
                    if (j < 4) { mode = 0; item = (xcd * 4 + j) * 32 + cu; }
                    else { const int jj = j - 4, group = xcd * 2 + (jj >> 2), i = cu * 4 + (jj & 3); const int bb = group >> 1, hq = (group & 1) * 4 + (i >> 5); mode = 1; item = (i & 31) + 32 * hq + 256 * bb; }
                } else {
                    int r = (j - n_att) * G + bx;
                    if (r >= tail_total) break;
                    mode = -1; item = 0;
                    if (!xmap) { if (r < 1024) { mode = 0; item = r; } else if (r < 3072) { mode = 1; item = r - 1024; } r -= 3072; }
                    if (mode < 0) {
                        if (r < 1152) { if (rep + 1 < REPS(3)) continue; gla_local_item(PROJ, (float*)(ws + WS_UST), (float*)(ws + WS_DEC), r, wl, lane, a_up, a_bias); continue; } r -= 1152;
                        if (r < n_cs) { mode = 3; item = r; } else { mode = 2; item = r - n_cs; }
                    }
                }
                attn_item(mode, PROJ, MIX, item, wl, lane, rpb, sink, rep + 1 < REPS(3));
            }
            }
            SEAM(base + 1);
        }
        if (EN(4) && IN(base + 2)) { for (int rep = 0; rep < REPS(4); ++rep) {
            PHASE_REGS();
            for (int gid = bx * (NWAVES * 64) + tid; gid < 64 * 2048; gid += G * NWAVES * 64) gla_prefix((float*)(ws + WS_UST), (const float*)(ws + WS_DEC), gid, rep + 1 < REPS(4));
            }
            SEAM(base + 2);
        }
        if (EN(5) && IN(base + 3)) { for (int rep = 0; rep < REPS(5); ++rep) {
            PHASE_REGS();
            const float* a_up = A->in[9] + (size_t)l * 2 * 16 * 128; const float* a_bias = A->in[10] + (size_t)l * 2 * 128; const float* gnorm = A->in[11] + (size_t)l * 64;
            for (int it = gw; it < 1152; it += NGW) { if (!upd && (it % 36) < 4) continue;
                gla_out_item((const bf16_t*)(ws + WS_R1), (const float*)(ws + WS_UST), (bf16_t*)(ws + WS_R2), it, wl, lane, a_up, a_bias, gnorm); }
            if (upd && G == 256 && gw >= 1152 && !(rep + 1 < REPS(5))) tr_stream(A->in, ws, TR_ALL - CONV_M3 + (gw - 1152), NGW - 1152, TR_ALL, (LAS float*)wl, lane);
            }
            SEAM(base + 3);
        }
        if (EN(6) && IN(base + 4)) { for (int rep = 0; rep < REPS(6); ++rep) {
            PHASE_REGS();
            const int M2 = upd ? MT : ML;
            pg8::Gemm g{(const bf16_t*)(ws + WS_R2), (const bf16_t*)(ws + WS_WOUT) + (size_t)l * 1024 * 1024, M2, 1024, 1024}; pg8::StaticOrder S; S.init(M2, 1024, G, bx);
            pg8::EpiStore E{(bf16_t*)(ws + WS_R2 + (size_t)MT * 2048), 1024};
            pg8::gemm_phase<pg8::EpiStore, pg8::StaticOrder, true, true>(lds, g, S, E);
            if (upd && CV_G2 > 0 && G == 256 && bx >= 32 && !(rep + 1 < REPS(6))) tr_stream(A->in, ws, P0_A + CV_N1 + 256 * CV_M1 + (bx - 32) * NWAVES + wave, 1792, TR_L, (LAS float*)wl, lane);
            if (!CONV_IN_P0) { const int nwg_ = (M2 / 256) * 4; if ((nwg_ - bx + G - 1) / G < (nwg_ + G - 1) / G) conv_pull(A->in, ws, l, 1, 3 * CONV_BUDGET, (LAS float*)wl, lane); }
            }
            SEAM_OV(base + 4, (r1_fill_rt(A_->in, lds, l, t0, nthr), r1_fill_vec(A_->in, ws_, lds, l, (int)blockIdx.x, t0, nthr)));
        }
        if (EN(7) && IN(base + 5)) { for (int rep = 0; rep < REPS(7); ++rep) { PHASE_REGS(); phase_r1(A->in, A->out, ws, lds, l, upd, G, tid, wave, lane, rep + 1 < REPS(7), pre); } pre = false; SEAM(base + 5); }
        if (EN(8) && IN(base + 6)) { for (int rep = 0; rep < REPS(8); ++rep) {
            PHASE_REGS();
            if (!CONV_IN_P0) conv_pull(A->in, ws, l, l, 1 << 30, (LAS float*)wl, lane);
            for (int it = bx; it < 128; it += G) topk_wg2(ws, it, lds, tid, wave, lane);
            if (upd) { const int w2 = (bx >= 128 ? bx - 128 : bx + G - 128) * NWAVES + wave; for (int it = w2; it < 128; it += NGW) topk_wave<true>(ws, it, lane); }
            }
            SEAM(base + 6);
        }
        if (EN(9) && IN(base + 7)) { for (int rep = 0; rep < REPS(9); ++rep) {
            PHASE_REGS();
            pg8::Gemm g{(const bf16_t*)(ws + WS_H), (const bf16_t*)(ws + WS_WGU) + (size_t)l * 16 * 2048 * 1024, 0, 0, 1024, (const int*)(ws + WS_ROWIDX)}; pg8::MoeOrder S; S.init(upd ? 9 : 8, 8, G, bx);
            pg8::EpiSwiGLU E{(bf16_t*)(ws + WS_R2), 1024};
            pg8::gemm_phase<pg8::EpiSwiGLU, pg8::MoeOrder, true, true, true>(lds, g, S, E);
            if (upd && CV_G3 > 0 && G == 256 && bx >= 128 && !(rep + 1 < REPS(9))) tr_stream(A->in, ws, P0_B + (bx - 128) * NWAVES + wave, 1024, P0_B + CV_N3, (LAS float*)wl, lane);
            if (!CONV_IN_P0) { const int nwg_ = 16 * (upd ? 9 : 8) * 8; if ((nwg_ - bx + G - 1) / G < (nwg_ + G - 1) / G) conv_pull(A->in, ws, l + 1, 1, 4 * CONV_BUDGET, (LAS float*)wl, lane); }
            }
            SEAM(base + 7);
        }
        if (EN(10) && IN(base + 8)) { for (int rep = 0; rep < REPS(10); ++rep) {
            PHASE_REGS();
            pg8::Gemm g{(const bf16_t*)(ws + WS_R2), (const bf16_t*)(ws + WS_WD) + (size_t)l * 16 * 1024 * 1024, 0, 0, 1024}; pg8::MoeOrder S; S.init(upd ? 9 : 8, 4, G, bx);
            pg8::EpiStore E{(bf16_t*)(ws + WS_R1), 1024};
            pg8::gemm_phase<pg8::EpiStore, pg8::MoeOrder, true, true>(lds, g, S, E);
            if (upd && CV_G4 > 0 && G == 256 && bx >= 64 && !(rep + 1 < REPS(10))) tr_stream(A->in, ws, P0_B + CV_N3 + (bx - 64) * NWAVES + wave, 1536, P0_B + CV_N3 + CV_N4, (LAS float*)wl, lane);
            if (!CONV_IN_P0) { const int nwg_ = 16 * (upd ? 9 : 8) * 4; if ((nwg_ - bx + G - 1) / G < (nwg_ + G - 1) / G) conv_pull(A->in, ws, l + 1, 1, 3 * CONV_BUDGET, (LAS float*)wl, lane); }
            }
            SEAM_OV(base + 8, r5_fill(A_->in, ws_, lds, l, upd, (int)blockIdx.x, t0, nthr));
        }
        if (EN(11) && IN(base + 9)) { for (int rep = 0; rep < REPS(11); ++rep) { PHASE_REGS(); phase_r5(A->in, A->out, ws, lds, l, upd, G, tid, wave, lane, rep + 1 < REPS(11), pre); } pre = false; SEAM(base + 9); }
    }
#ifdef STAMP_A
    if (blockIdx.x == 0 && threadIdx.x == 0) { const unsigned long long* st_ = (const unsigned long long*)(args.ws + WS_CTL) + 1536; const float d_ = (float)(st_[STAMP_B] - st_[STAMP_A]); args.out[0] = 200.f * floorf(d_ / 200.f + 0.5f); }
#endif
#undef IN
#undef SEAM
}

extern "C" void kernel_launch(void* const* d_in, const int* in_sizes, int n_in, void* d_out, int out_size, void* d_ws, size_t ws_size, hipStream_t stream) {
    static int grid = 0;
    if (grid == 0) {
        if (n_in != 18 || out_size != ML * DM || ws_size < WS_END) { fprintf(stderr, "kernel_launch: unexpected sizes: n_in %d out %d ws %zu (need %zu)\n", n_in, out_size, ws_size, (size_t)WS_END); grid = -1; return; }
        int dev = 0, cus = 0, per_cu = 0;
        if (hipGetDevice(&dev) != hipSuccess || hipDeviceGetAttribute(&cus, hipDeviceAttributeMultiprocessorCount, dev) != hipSuccess) { grid = -1; return; }
        if (hipFuncSetAttribute((const void*)fwd_kernel, hipFuncAttributeMaxDynamicSharedMemorySize, LDS_BYTES) != hipSuccess) { fprintf(stderr, "kernel_launch: hipFuncSetAttribute failed\n"); grid = -1; return; }
        if (hipOccupancyMaxActiveBlocksPerMultiprocessor(&per_cu, (const void*)fwd_kernel, NWAVES * 64, LDS_BYTES) != hipSuccess || per_cu < 1) { fprintf(stderr, "kernel_launch: occupancy query says %d blocks per CU\n", per_cu); (void)hipGetLastError(); grid = -1; return; }
        grid = cus;
    }
    if (grid < 0) return;
    (void)hipMemsetAsync((char*)d_ws + WS_CTL, 0, CTL_ZERO_BYTES, stream);
    Args a{};
    for (int i = 0; i < 18; ++i) a.in[i] = (const float*)d_in[i];
    a.out = (float*)d_out; a.ws = (unsigned char*)d_ws;
#if MK_PER_PHASE
    for (int p = 0; p < N_PHASES; ++p) { a.ph_lo = p; a.ph_hi = p + 1; hipLaunchKernelGGL(fwd_kernel, dim3(grid), dim3(NWAVES * 64), LDS_BYTES, stream, a); }
#else
    a.ph_lo = 0; a.ph_hi = N_PHASES;
    void* kargs[] = {&a};
    hipError_t e = hipLaunchCooperativeKernel((const void*)fwd_kernel, dim3(grid), dim3(NWAVES * 64), kargs, LDS_BYTES, stream);
    if (e != hipSuccess) fprintf(stderr, "kernel_launch: cooperative launch failed: %s (grid %d)\n", hipGetErrorString(e), grid);
#endif
}
```

```cpp
#include <hip/hip_runtime.h>
#include <cstdio>
#include <cstdint>
#include <cmath>

namespace pg8 {
#define PG8_LAS __attribute__((address_space(3)))
typedef unsigned short bf16_t;
typedef short bf16x8 __attribute__((ext_vector_type(8)));
typedef float f32x4 __attribute__((ext_vector_type(4)));
typedef unsigned u32x4 __attribute__((ext_vector_type(4)));
constexpr int BM = 256, BK = 64, HALF = 128, HTB = HALF * BK * 2  , STAGE_BYTES = 8 * HTB, NXCD = 8, WGM = 8;

__host__ __device__ __forceinline__ int lds_byte(int r, int c) { const int st = (r >> 4) * 2 + (c >> 5), rr = r & 15, cc = c & 31, ob = rr * 64 + cc * 2; return st * 1024 + (ob ^ (((ob >> 9) & 1) << 5)); }
__host__ __device__ __forceinline__ void stage_rc(int b, int& R, int& C) { const int st = b / 1024, sb = b % 1024, swz = sb ^ (((sb >> 9) & 1) << 5); R = (st >> 1) * 16 + swz / 64; C = (st & 1) * 32 + (swz % 64) / 2; }
__host__ __device__ __forceinline__ int perm32(int rho) { const int n = rho >> 4, i = rho & 15; return 8 * (i >> 2) + 4 * n + (i & 3); }

struct Unit { int pm, pn, pb; };
struct Gemm { const bf16_t* A; const bf16_t* Bt; int M, N, K; const int* rowidx; };

struct StaticOrder {
    int nM, nN, nwg, G, c;
    __host__ __device__ void init(int M, int N, int G_, int c_) { nM = M / BM; nN = N / BM; nwg = nM * nN; G = G_; c = c_; }
    __host__ __device__ bool next(int i, Unit& u) const {
        const long L = (long)i * G + c; if (L >= nwg) return false;
        int wgid = (int)L; { const int q = nwg / NXCD, r = nwg % NXCD, xcd = wgid % NXCD, off = wgid / NXCD; wgid = (xcd < r ? xcd * (q + 1) : r * (q + 1) + (xcd - r) * q) + off; }
        const int nig = WGM * nN, gid = wgid / nig, fm = gid * WGM, gsz = (nM - fm) < WGM ? (nM - fm) : WGM;
        u.pm = fm + ((wgid % nig) % gsz); u.pn = (wgid % nig) / gsz; u.pb = u.pn; return true;
    }
    __device__ __forceinline__ void a_ready(const Unit&) const {}
    __device__ __forceinline__ void done(const Unit&) const {}
};

__device__ __forceinline__ unsigned cvt_pk_bf16(float lo, float hi) { unsigned r; asm volatile("v_cvt_pk_bf16_f32 %0, %1, %2" : "=v"(r) : "v"(lo), "v"(hi)); return r; }
typedef float f32x2 __attribute__((ext_vector_type(2)));
#ifndef EPI_WT
#define EPI_WT 0
#endif
__device__ __forceinline__ void st16(bf16_t* base, size_t elem_off, u32x4 w) {
#if EPI_WT
    const __amdgpu_buffer_rsrc_t r = __builtin_amdgcn_make_buffer_rsrc((void*)base, 0, 0x7fffffff, 0x00020000);
    __builtin_amdgcn_raw_buffer_store_b128(w, r, (unsigned)(elem_off * 2), 0, 16);
#else
    *(u32x4*)(base + elem_off) = w;
#endif
}
struct EpiStore {
    static constexpr bool PERM = true, AFTER_DRAIN = false;
    bf16_t* O; int ldc;
    __device__ __forceinline__ void operator()(const f32x4 (&acc)[2][2][4][2], const Unit& u, int wr, int wc, int fr, int fq) const {
        const int row0 = u.pm * BM + wr * 64 + fr, col0 = u.pn * BM + wc * 32 + 8 * fq;
#pragma unroll
        for (int ai = 0; ai < 2; ++ai)
#pragma unroll
            for (int m = 0; m < 4; ++m) { bf16_t* rowp = O + (size_t)(row0 + ai * HALF + m * 16) * ldc + col0;
#pragma unroll
                for (int bj = 0; bj < 2; ++bj) { const f32x4 v0 = acc[ai][bj][m][0], v1 = acc[ai][bj][m][1];
                    u32x4 w; w.x = cvt_pk_bf16(v0[0], v0[1]); w.y = cvt_pk_bf16(v0[2], v0[3]); w.z = cvt_pk_bf16(v1[0], v1[1]); w.w = cvt_pk_bf16(v1[2], v1[3]);
                    st16(O, (size_t)(rowp - O) + bj * HALF, w); } }
    }
};
struct EpiProj {
    static constexpr bool PERM = true, AFTER_DRAIN = false;
    bf16_t* O; int ldc; const PG8_LAS f32x2* tab; int ml;
    __device__ __forceinline__ void operator()(const f32x4 (&acc)[2][2][4][2], const Unit& u, int wr, int wc, int fr, int fq) const {
        const int row0 = u.pm * BM + wr * 64 + fr;
        const bool latent = (u.pm * BM) < ml;
#pragma unroll
        for (int bj = 0; bj < 2; ++bj) {
            const int c0 = u.pn * BM + bj * HALF + wc * 32;
            if (c0 >= 2336) continue;
            const bool rope = latent && ((c0 >= 928 && c0 < 1056) || (c0 >= 1824 && c0 < 2336));
            const bool rowhalf = (((c0 - 32) & 63) == 0);
            const bool qscale = (c0 >= 1568 && c0 < 2336);
#pragma unroll
            for (int ai = 0; ai < 2; ++ai)
#pragma unroll
                for (int m = 0; m < 4; ++m) {
                    const int row = row0 + ai * HALF + m * 16;
                    f32x4 v0 = acc[ai][bj][m][0], v1 = acc[ai][bj][m][1];
                    if (rope) {
                        const int t = row & 2047, pos = rowhalf ? (t >> 6) : (t & 63);
                        const PG8_LAS f32x2* tp = tab + pos * 16 + 8 * (fq & 1);
                        const float sg = (fq < 2) ? -1.f : 1.f;
#pragma unroll
                        for (int e = 0; e < 4; ++e) {
                            const float x0 = v0[e], x1 = v1[e];
                            float p0, p1; { const auto r0 = __builtin_amdgcn_permlane32_swap(__float_as_uint(x0), __float_as_uint(x0), false, false), r1 = __builtin_amdgcn_permlane32_swap(__float_as_uint(x1), __float_as_uint(x1), false, false);
                                p0 = __uint_as_float(fq >= 2 ? r0[0] : r0[1]); p1 = __uint_as_float(fq >= 2 ? r1[0] : r1[1]); }
                            const f32x2 c0s = tp[e], c1s = tp[4 + e];
                            v0[e] = x0 * c0s.x + sg * p0 * c0s.y; v1[e] = x1 * c1s.x + sg * p1 * c1s.y;
                        }
                    }
                    if (qscale) { v0 = v0 * 0.18033688011112042f; v1 = v1 * 0.18033688011112042f; }
                    u32x4 w; w.x = cvt_pk_bf16(v0[0], v0[1]); w.y = cvt_pk_bf16(v0[2], v0[3]); w.z = cvt_pk_bf16(v1[0], v1[1]); w.w = cvt_pk_bf16(v1[2], v1[3]);
                    st16(O, (size_t)row * ldc + c0 + 8 * fq, w);
                }
        }
    }
};
struct EpiSwiGLU {
    static constexpr bool PERM = true, AFTER_DRAIN = false;
    bf16_t* O; int ldc;
    __device__ __forceinline__ void operator()(const f32x4 (&acc)[2][2][4][2], const Unit& u, int wr, int wc, int fr, int fq) const {
        const int row0 = u.pm * BM + wr * 64 + fr, col0 = u.pn * HALF + wc * 32 + 8 * fq;
#pragma unroll
        for (int ai = 0; ai < 2; ++ai)
#pragma unroll
            for (int m = 0; m < 4; ++m) {
                float h[8];
#pragma unroll
                for (int n = 0; n < 2; ++n)
#pragma unroll
                    for (int e = 0; e < 4; e += 2) {
                        const f32x2 g = {acc[ai][0][m][n][e], acc[ai][0][m][n][e + 1]}, up = {acc[ai][1][m][n][e], acc[ai][1][m][n][e + 1]};
                        const f32x2 t = g * (f32x2){-1.4426950408889634f, -1.4426950408889634f};
                        const f32x2 d = (f32x2){__builtin_amdgcn_exp2f(t.x), __builtin_amdgcn_exp2f(t.y)} + (f32x2){1.f, 1.f};
                        const f32x2 r = {__builtin_amdgcn_rcpf(d.x), __builtin_amdgcn_rcpf(d.y)};
                        const f32x2 o = (g * r) * up;
                        h[n * 4 + e] = o.x; h[n * 4 + e + 1] = o.y; }
                u32x4 w; w.x = cvt_pk_bf16(h[0], h[1]); w.y = cvt_pk_bf16(h[2], h[3]); w.z = cvt_pk_bf16(h[4], h[5]); w.w = cvt_pk_bf16(h[6], h[7]);
                st16(O, (size_t)(row0 + ai * HALF + m * 16) * ldc + col0, w);
            }
    }
};
struct MoeOrder {
    int npe, nN, nwg, G, c;
    __host__ __device__ void init(int npe_, int nN_, int G_, int c_) { npe = npe_; nN = nN_; nwg = 16 * npe * nN; G = G_; c = c_; }
    __host__ __device__ bool next(int i, Unit& u) const {
        const long L = (long)i * G + c; if (L >= nwg) return false;
        int wgid = (int)L; { const int q = nwg / NXCD, r = nwg % NXCD, xcd = wgid % NXCD, off = wgid / NXCD; wgid = (xcd < r ? xcd * (q + 1) : r * (q + 1) + (xcd - r) * q) + off; }
        const int per = npe * nN, e = wgid / per, rem = wgid % per, j = rem / nN, pn = rem % nN;
        u.pm = (j < 8) ? (j * 16 + e) : (128 + e); u.pn = pn; u.pb = e * nN + pn; return true;
    }
    __device__ __forceinline__ void a_ready(const Unit&) const {}
    __device__ __forceinline__ void done(const Unit&) const {}
};

template <class Epi, class Sched, bool ALIGN_EPI = false, bool SP2 = false, bool GATHER = false>
__device__ __forceinline__ void gemm_phase(PG8_LAS unsigned char* lds, const Gemm g, const Sched& S, const Epi& E) {
    int tid_ = threadIdx.x; asm volatile("" : "+v"(tid_));
    const int tid = tid_, wid = __builtin_amdgcn_readfirstlane(tid >> 6), lane = tid & 63, wr = wid >> 2, wc = wid & 3, fr = lane & 15, fq = lane >> 4;
    const int K = g.K, nt = K / BK;
    static_assert(!GATHER || SP2, "GATHER is wired into the SP2 loop only");
    unsigned voffA[2], voffB[2]; int RA[2], CA[2]; unsigned vAc[2][2], vAn[2][2];
#pragma unroll
    for (int i = 0; i < 2; ++i) { int R, C; stage_rc(tid * 16 + i * 8192, R, C); const int Rb = Epi::PERM ? ((R & ~31) + perm32(R & 31)) : R; RA[i] = R; CA[i] = C;
        voffA[i] = (unsigned)(R * K + C) * 2u; voffB[i] = (unsigned)(Rb * K + C) * 2u; vAc[0][i] = vAc[1][i] = vAn[0][i] = vAn[1][i] = 0u; }
    auto load_idx = [&](int pm, unsigned (&v)[2][2]) {
#pragma unroll
        for (int h = 0; h < 2; ++h)
#pragma unroll
            for (int i = 0; i < 2; ++i) v[h][i] = (unsigned)(g.rowidx[pm * BM + h * HALF + RA[i]] * K + CA[i]) * 2u;
    };
    const size_t kstep = (size_t)(BK * 2);
    const size_t hstep = (size_t)HALF * K * 2;
    const size_t tstep = 2 * hstep;
    const unsigned ldsw = (unsigned)wid * 1024u;
    const int aoff = lds_byte(wr * 64 + fr, fq * 8), boff = lds_byte(wc * 32 + fr, fq * 8);
#define PG8_SA(b, h) (((b) * 2 + (h)) * HTB)
#define PG8_SB(b, h) ((4 + (b) * 2 + (h)) * HTB)
#define PG8_STAGE(bufoff, gbase, voff) do { _Pragma("unroll") for (int _i = 0; _i < 2; ++_i) \
        __builtin_amdgcn_global_load_lds((const unsigned*)((const char*)(gbase) + (voff)[_i]), (PG8_LAS unsigned*)(lds + (bufoff) + ldsw + _i * 8192), 16, 0, 0); } while (0)
#define PG8_STAGE_A(bufoff, gbase, h, nx) do { if constexpr (GATHER) { const unsigned v_[2] = { (nx) ? vAn[h][0] : vAc[h][0], (nx) ? vAn[h][1] : vAc[h][1] }; PG8_STAGE(bufoff, gbase, v_); } \
        else { PG8_STAGE(bufoff, (gbase) + (h) * hstep, voffA); } } while (0)
#define PG8_LDA(dst, b, h) do { _Pragma("unroll") for (int m = 0; m < 4; ++m) _Pragma("unroll") for (int k = 0; k < 2; ++k) dst[m][k] = *(const PG8_LAS bf16x8*)(lds + PG8_SA(b, h) + aoff + m * 2048 + k * 1024); } while (0)
#define PG8_LDB(dst, b, h) do { _Pragma("unroll") for (int n = 0; n < 2; ++n) _Pragma("unroll") for (int k = 0; k < 2; ++k) dst[n][k] = *(const PG8_LAS bf16x8*)(lds + PG8_SB(b, h) + boff + n * 2048 + k * 1024); } while (0)
#define PG8_MMA(ai, bj, At, Bt) do { __builtin_amdgcn_s_setprio(1); _Pragma("unroll") for (int m = 0; m < 4; ++m) _Pragma("unroll") for (int n = 0; n < 2; ++n) _Pragma("unroll") for (int k = 0; k < 2; ++k) \
        acc[ai][bj][m][n] = __builtin_amdgcn_mfma_f32_16x16x32_bf16(Bt[n][k], At[m][k], acc[ai][bj][m][n], 0, 0, 0); __builtin_amdgcn_s_setprio(0); } while (0)
#define PG8_WAIT_V(n) asm volatile("s_waitcnt vmcnt(" #n ")" ::: "memory")
#define PG8_WAIT_L(n) asm volatile("s_waitcnt lgkmcnt(" #n ")" ::: "memory")
#define PG8_BAR __builtin_amdgcn_s_barrier()
#define PG8_SCHED __builtin_amdgcn_sched_barrier(0)
    Unit cur, nxt; int ui = 0;
    if (!S.next(0, cur)) return;
    f32x4 acc[2][2][4][2];
#pragma unroll
    for (int a = 0; a < 2; ++a)
#pragma unroll
        for (int b = 0; b < 2; ++b)
#pragma unroll
            for (int m = 0; m < 4; ++m)
#pragma unroll
                for (int n = 0; n < 2; ++n) acc[a][b][m][n] = (f32x4){0.f, 0.f, 0.f, 0.f};
    bf16x8 At[4][2], B0[2][2], B1[2][2];
    const char* cA = (const char*)g.A + (GATHER ? (size_t)0 : (size_t)cur.pm * tstep); const char* cB = (const char*)g.Bt + (size_t)cur.pb * tstep;
    if constexpr (GATHER) { PG8_STAGE(PG8_SB(0, 0), cB, voffB); PG8_STAGE(PG8_SB(0, 1), cB + hstep, voffB);
        load_idx(cur.pm, vAc); asm volatile("" : "+v"(vAc[0][0]), "+v"(vAc[0][1]), "+v"(vAc[1][0]), "+v"(vAc[1][1])); }
    S.a_ready(cur);
    if constexpr (SP2) {
        if constexpr (!GATHER) { PG8_STAGE(PG8_SB(0, 0), cB, voffB); PG8_STAGE(PG8_SB(0, 1), cB + hstep, voffB); }
        PG8_STAGE_A(PG8_SA(0, 0), cA, 0, false); PG8_STAGE_A(PG8_SA(0, 1), cA, 1, false);
        if (wr == 1) PG8_BAR;
        PG8_WAIT_V(2); PG8_BAR;
        PG8_STAGE(PG8_SB(1, 0), cB + kstep, voffB); PG8_STAGE_A(PG8_SA(1, 0), cA + kstep, 0, false); PG8_STAGE(PG8_SB(1, 1), cB + hstep + kstep, voffB);
        PG8_WAIT_V(6); PG8_BAR;
    } else {
        PG8_STAGE(PG8_SB(0, 0), cB, voffB); PG8_STAGE(PG8_SA(0, 0), cA, voffA); PG8_STAGE(PG8_SB(0, 1), cB + hstep, voffB); PG8_STAGE(PG8_SA(0, 1), cA + hstep, voffA);
        if (wr == 1) PG8_BAR;
        PG8_WAIT_V(4); PG8_BAR;
        PG8_STAGE(PG8_SB(1, 0), cB + kstep, voffB); PG8_STAGE(PG8_SA(1, 0), cA + kstep, voffA); PG8_STAGE(PG8_SB(1, 1), cB + hstep + kstep, voffB);
        PG8_WAIT_V(6); PG8_BAR;
    }
    for (;;) {
        const bool has_next = S.next(ui + 1, nxt);
        if constexpr (GATHER) { if (has_next) {
#pragma unroll
            for (int h = 0; h < 2; ++h)
#pragma unroll
                for (int i = 0; i < 2; ++i) __builtin_amdgcn_global_load_lds((const unsigned*)(g.rowidx + nxt.pm * BM + h * HALF + RA[i]), (PG8_LAS unsigned*)(lds + STAGE_BYTES + (h * 2 + i) * 2048 + wid * 256), 4, 0, 0); } }
        const char* nA = (has_next && !GATHER) ? (const char*)g.A + (size_t)nxt.pm * tstep : cA; const char* nB = has_next ? (const char*)g.Bt + (size_t)nxt.pb * tstep : cB;
        for (int t = 0; t < nt; t += 2) {
            const bool last = (t == nt - 2); const bool nxu = last && has_next; (void)nxu;
            if constexpr (GATHER) { if (nxu) {
#pragma unroll
                for (int h = 0; h < 2; ++h)
#pragma unroll
                    for (int i = 0; i < 2; ++i) { const int ix = *(const PG8_LAS int*)(lds + STAGE_BYTES + (h * 2 + i) * 2048 + tid * 4); vAn[h][i] = (unsigned)(ix * K + CA[i]) * 2u; } } }
            const char* a1 = cA + (size_t)(t + 1) * kstep;
            const char* a2 = last ? nA : cA + (size_t)(t + 2) * kstep; const char* b2 = last ? nB : cB + (size_t)(t + 2) * kstep;
            const char* a3 = a2 + kstep; const char* b3 = b2 + kstep;
            if (last && has_next) S.a_ready(nxt);
            if constexpr (SP2) {
            PG8_LDB(B0, 0, 0); PG8_LDB(B1, 0, 1); PG8_SCHED; PG8_LDA(At, 0, 0); PG8_STAGE_A(PG8_SA(1, 1), a1, 1, false);
            PG8_WAIT_V(8); PG8_WAIT_L(0); PG8_BAR; PG8_MMA(0, 0, At, B0); PG8_MMA(0, 1, At, B1); PG8_BAR; PG8_SCHED;
            PG8_LDA(At, 0, 1); PG8_STAGE(PG8_SB(0, 0), b2, voffB); PG8_STAGE(PG8_SB(0, 1), b2 + hstep, voffB); PG8_STAGE_A(PG8_SA(0, 0), a2, 0, nxu);
            PG8_WAIT_V(8); PG8_WAIT_L(0); PG8_BAR; PG8_MMA(1, 0, At, B0); PG8_MMA(1, 1, At, B1); PG8_BAR; PG8_SCHED;
            PG8_LDB(B0, 1, 0); PG8_LDB(B1, 1, 1); PG8_SCHED; PG8_LDA(At, 1, 0); PG8_STAGE_A(PG8_SA(0, 1), a2, 1, nxu);
            PG8_WAIT_V(8); PG8_WAIT_L(0); PG8_BAR; PG8_MMA(0, 0, At, B0); PG8_MMA(0, 1, At, B1); PG8_BAR; PG8_SCHED;
            PG8_LDA(At, 1, 1); PG8_STAGE(PG8_SB(1, 0), b3, voffB); PG8_STAGE(PG8_SB(1, 1), b3 + hstep, voffB); PG8_STAGE_A(PG8_SA(1, 0), a3, 0, nxu);
            PG8_WAIT_V(8); PG8_WAIT_L(0); PG8_BAR; PG8_MMA(1, 0, At, B0); PG8_MMA(1, 1, At, B1); PG8_BAR; PG8_SCHED;
            } else {
            PG8_LDB(B0, 0, 0); PG8_SCHED; PG8_LDA(At, 0, 0); PG8_STAGE(PG8_SA(1, 1), a1 + hstep, voffA);
            PG8_WAIT_L(8); PG8_BAR; PG8_WAIT_L(0); PG8_MMA(0, 0, At, B0); PG8_BAR; PG8_SCHED;
            PG8_LDB(B1, 0, 1); PG8_STAGE(PG8_SB(0, 0), b2, voffB);
            PG8_BAR; PG8_WAIT_L(0); PG8_MMA(0, 1, At, B1); PG8_BAR;
            PG8_LDA(At, 0, 1); PG8_STAGE(PG8_SA(0, 0), a2, voffA);
            PG8_BAR; PG8_WAIT_L(0); PG8_MMA(1, 0, At, B0); PG8_BAR; PG8_SCHED;
            PG8_STAGE(PG8_SB(0, 1), b2 + hstep, voffB);
            PG8_WAIT_V(6); PG8_BAR; PG8_MMA(1, 1, At, B1); PG8_BAR;
            PG8_LDB(B0, 1, 0); PG8_SCHED; PG8_LDA(At, 1, 0); PG8_STAGE(PG8_SA(0, 1), a2 + hstep, voffA);
            PG8_WAIT_L(8); PG8_BAR; PG8_WAIT_L(0); PG8_MMA(0, 0, At, B0); PG8_BAR; PG8_SCHED;
            PG8_LDB(B1, 1, 1); PG8_STAGE(PG8_SB(1, 0), b3, voffB);
            PG8_BAR; PG8_WAIT_L(0); PG8_MMA(0, 1, At, B1); PG8_BAR;
            PG8_LDA(At, 1, 1); PG8_STAGE(PG8_SA(1, 0), a3, voffA);
            PG8_BAR; PG8_WAIT_L(0); PG8_MMA(1, 0, At, B0); PG8_BAR; PG8_SCHED;
            PG8_STAGE(PG8_SB(1, 1), b3 + hstep, voffB);
            PG8_WAIT_V(6); PG8_BAR; PG8_MMA(1, 1, At, B1); PG8_BAR;
            }
        }
        if constexpr (ALIGN_EPI) { if (wr == 0) PG8_BAR; }
        if constexpr (!Epi::AFTER_DRAIN) { E(acc, cur, wr, wc, fr, fq); S.done(cur); }
        if (!has_next) break;
#pragma unroll
        for (int a = 0; a < 2; ++a)
#pragma unroll
            for (int b = 0; b < 2; ++b)
#pragma unroll
                for (int m = 0; m < 4; ++m)
#pragma unroll
                    for (int n = 0; n < 2; ++n) acc[a][b][m][n] = (f32x4){0.f, 0.f, 0.f, 0.f};
        cur = nxt; cA = nA; cB = nB; ++ui;
        if constexpr (GATHER) {
#pragma unroll
            for (int h = 0; h < 2; ++h) { vAc[h][0] = vAn[h][0]; vAc[h][1] = vAn[h][1]; } }
        if constexpr (ALIGN_EPI) { if (wr == 1) PG8_BAR; }
    }
    PG8_WAIT_V(0);
    if constexpr (!ALIGN_EPI) { if (wr == 0) PG8_BAR; }
    PG8_BAR;
    if constexpr (Epi::AFTER_DRAIN) { E.fused(acc, cur, wr, wc, fr, fq, lds, wid, lane); S.done(cur); }
#undef PG8_SA
#undef PG8_SB
#undef PG8_STAGE
#undef PG8_STAGE_A
#undef PG8_LDA
#undef PG8_LDB
#undef PG8_MMA
#undef PG8_WAIT_V
#undef PG8_WAIT_L
#undef PG8_BAR
#undef PG8_SCHED
}
}
constexpr int NB = 8, SEQ = 2048, DM = 1024, CTXL = 256, ML = NB * SEQ, MC = NB * CTXL, MT = ML + MC;
constexpr int PP = 2560;
constexpr int INW = 2336;
constexpr int C_GK = 0, C_GV = 128, C_GAF = 384, C_GAB = 400, C_NK = 416, C_NV = 672, C_SK = 928, C_SV = 1056, C_GQ = 1184, C_GG = 1312, C_NQ = 1568, C_SQ = 1824;
constexpr int NWAVES = 8;
constexpr float NEPS = 1e-6f;
constexpr float LOG2E = 1.4426950408889634f;

constexpr size_t MiB = 1u << 20;
constexpr size_t WS_CTL = 0, CTL_ZERO_BYTES = 65536;
constexpr size_t WS_TAB = 1 * MiB;
constexpr size_t WS_MOD = 1 * MiB + 65536;
constexpr size_t WS_MODP = 2 * MiB;
constexpr size_t WS_WIN = 6 * MiB;
constexpr size_t WS_WOUT = 16 * MiB;
constexpr size_t WS_WGU = 20 * MiB;
constexpr size_t WS_WD = 148 * MiB;
constexpr size_t WS_H = 212 * MiB;
constexpr size_t WS_R1 = 248 * MiB;
constexpr size_t WS_R2 = 338 * MiB;
constexpr size_t WS_XB = 410 * MiB;
constexpr size_t WS_UST = 446 * MiB;
constexpr size_t WS_MISC = 464 * MiB;
constexpr size_t WS_DEC = WS_MISC;
constexpr size_t WS_AFF = WS_MISC + 1 * MiB;
constexpr size_t WS_AFFC = WS_MISC + 2 * MiB;
constexpr size_t WS_GATE = WS_MISC + 2 * MiB + 262144;
constexpr size_t WS_GATEC = WS_MISC + 2 * MiB + 524288;
constexpr size_t WS_INV = WS_MISC + 3 * MiB;
constexpr size_t WS_ROWIDX = WS_MISC + 3 * MiB + 786432;
constexpr size_t WS_END = 468 * MiB;
constexpr int CW_BAR = 4096;
constexpr int CW_QUEUE = 1024;
constexpr int CW_CONV = 2048;

constexpr int WAVE_LDS = 19456;
constexpr int RING_BYTES = NWAVES * WAVE_LDS;
constexpr int LDSCTL_OFF = RING_BYTES, MISC_OFF = LDSCTL_OFF + 320;
constexpr int LDS_BYTES = RING_BYTES + 1024;
static_assert(RING_BYTES >= pg8::STAGE_BYTES && LDS_BYTES <= 163840, "LDS map");

#define GAS __attribute__((address_space(1)))
#define LAS __attribute__((address_space(3)))
typedef unsigned short bf16_t;
typedef unsigned v4u __attribute__((ext_vector_type(4)));
typedef unsigned v2u __attribute__((ext_vector_type(2)));
typedef float f32x4 __attribute__((ext_vector_type(4)));
typedef float f32x2 __attribute__((ext_vector_type(2)));
typedef float f32x16 __attribute__((ext_vector_type(16)));
typedef short bf16x8 __attribute__((ext_vector_type(8)));
typedef short s16x4 __attribute__((ext_vector_type(4)));
typedef GAS unsigned gu32;
#define RLX_AGENT __ATOMIC_RELAXED, __HIP_MEMORY_SCOPE_AGENT
typedef __bf16 bf16x2_t __attribute__((ext_vector_type(2)));
__device__ __forceinline__ unsigned pk2(float lo, float hi) { f32x2 v = {lo, hi}; bf16x2_t b = __builtin_convertvector(v, bf16x2_t); return __builtin_bit_cast(unsigned, b); }
__device__ __forceinline__ float bflo(unsigned w) { return __uint_as_float(w << 16); }
__device__ __forceinline__ float bfhi(unsigned w) { return __uint_as_float(w & 0xffff0000u); }
__device__ __forceinline__ float bf1(bf16_t w) { return __uint_as_float((unsigned)w << 16); }
template <int CTRL> __device__ __forceinline__ float dppf(float v) { return __uint_as_float((unsigned)__builtin_amdgcn_update_dpp(0, (int)__float_as_uint(v), CTRL, 0xf, 0xf, true)); }
#define SWAP16(a, b, lo, hi) const auto lo##hi = __builtin_amdgcn_permlane16_swap(__float_as_uint(a), __float_as_uint(b), false, false); const float lo = __uint_as_float(lo##hi[0]), hi = __uint_as_float(lo##hi[1])
#define SWAP32(a, b, lo, hi) const auto lo##hi = __builtin_amdgcn_permlane32_swap(__float_as_uint(a), __float_as_uint(b), false, false); const float lo = __uint_as_float(lo##hi[0]), hi = __uint_as_float(lo##hi[1])
__device__ __forceinline__ float x16_sum(float v) { SWAP16(v, v, a, b); return a + b; }
__device__ __forceinline__ float x32_sum(float v) { SWAP32(v, v, a, b); return a + b; }
__device__ __forceinline__ float x16_max(float v) { SWAP16(v, v, a, b); return fmaxf(a, b); }
__device__ __forceinline__ float x32_max(float v) { SWAP32(v, v, a, b); return fmaxf(a, b); }
__device__ __forceinline__ float x32_other(float v, bool upper) { SWAP32(v, v, a, b); return upper ? a : b; }
__device__ __forceinline__ float pair32_sum(float a, float b) { SWAP32(a, b, lo, hi); return lo + hi; }
__device__ __forceinline__ float pair16_sum(float a, float b) { SWAP16(a, b, lo, hi); return lo + hi; }
__device__ __forceinline__ float wave_sum(float v) {
    v += dppf<0xB1>(v); v += dppf<0x4E>(v); v += dppf<0x141>(v); v += dppf<0x140>(v);
    v = x16_sum(v); return x32_sum(v);
}
__device__ __forceinline__ float fexp2(float x) { return __builtin_amdgcn_exp2f(x); }
__device__ __forceinline__ float fexp(float x) { return __builtin_amdgcn_exp2f(x * LOG2E); }
__device__ __forceinline__ float flog(float x) { return __builtin_amdgcn_logf(x) * 0.6931471805599453f; }
__device__ __forceinline__ float frcp(float x) { return __builtin_amdgcn_rcpf(x); }
__device__ __forceinline__ float silu_f(float x) { return x * frcp(1.f + fexp(-x)); }
__device__ __forceinline__ int crow(int r, int hi) { return (r & 3) + 8 * (r >> 2) + 4 * hi; }
__device__ __forceinline__ s16x4 tr_read(LAS const unsigned char* p) { return __builtin_bit_cast(s16x4, __builtin_amdgcn_ds_read_tr16_b64_v4i16((LAS s16x4*)p)); }
__device__ __forceinline__ bf16x8 cat4(s16x4 a, s16x4 b) { return (bf16x8){a[0], a[1], a[2], a[3], b[0], b[1], b[2], b[3]}; }
__device__ __forceinline__ bf16x8 pack8(float a0, float a1, float a2, float a3, float a4, float a5, float a6, float a7) {
    v4u w; w.x = pk2(a0, a1); w.y = pk2(a2, a3); w.z = pk2(a4, a5); w.w = pk2(a6, a7); return __builtin_bit_cast(bf16x8, w); }
#define MFMA32(a, b, c) __builtin_amdgcn_mfma_f32_32x32x16_bf16((a), (b), (c), 0, 0, 0)

#ifndef EARLY_WB
#define EARLY_WB 0
#endif
#define XB_TMO      128
#define XB_XCNT(j)  (256  + 64 * (j))
#define XB_XSUB(j)  (1280 + 64 * (j))
#define XB_XGEN(j)  (2304 + 64 * (j))
#define XB_TOP      3328
#define XB_TOPGEN   3392
#define XCD_BAR_WORDS 3456
#define XB_SPIN_CAP (1u << 18)

__device__ __forceinline__ unsigned xb_ld(unsigned* p)              { return __hip_atomic_load(p, __ATOMIC_RELAXED, __HIP_MEMORY_SCOPE_AGENT); }
__device__ __forceinline__ unsigned xb_add(unsigned* p, unsigned v) { return __hip_atomic_fetch_add(p, v, __ATOMIC_RELAXED, __HIP_MEMORY_SCOPE_AGENT); }
__device__ __forceinline__ unsigned xb_xcc_id() { return (unsigned)__builtin_amdgcn_s_getreg((3 << 11) | 20) & 0xFu; }
#define XB_SPIN(cond, bar) do { unsigned _sp = 0; while (cond) { __builtin_amdgcn_s_sleep(1); \
    if ((++_sp & 255u) == 0u) { if (xb_ld(&(bar)[XB_TMO])) break; if (_sp > XB_SPIN_CAP) { atomicAdd(&(bar)[XB_TMO], 1u); break; } } } } while (0)

struct XcdBarrier {
    unsigned* bar; unsigned x;
    volatile LAS unsigned* st;
};

__device__ __forceinline__ XcdBarrier xcd_barrier_post(unsigned* bar, volatile LAS unsigned* st) {
    XcdBarrier b; b.bar = bar; b.x = xb_xcc_id(); b.st = st;
    if (threadIdx.x == 0) (void)xb_add(&bar[XB_XCNT(b.x)], 1u);
    return b;
}
__device__ __forceinline__ void xcd_barrier_complete(unsigned* bar, unsigned x, unsigned& nloc, unsigned& nx) {
    const unsigned G = gridDim.x * gridDim.y * gridDim.z;
    unsigned sum, cnt, mine, sp = 0u;
    for (;;) {
        sum = 0u; cnt = 0u; mine = 0u;
#pragma unroll
        for (unsigned j = 0; j < 16; ++j) { const unsigned c = xb_ld(&bar[XB_XCNT(j)]); sum += c; cnt += (c > 0u) ? 1u : 0u; mine = (j == x) ? c : mine; }
        if (sum == G) break;
        __builtin_amdgcn_s_sleep(1);
        if ((++sp & 255u) == 0u) { if (xb_ld(&bar[XB_TMO])) break; if (sp > XB_SPIN_CAP) { atomicAdd(&bar[XB_TMO], 1u); break; } }
    }
    nloc = mine > 0u ? mine : 1u; nx = cnt > 0u ? cnt : 1u;
}
__device__ __forceinline__ bool xcd_census_uniform(unsigned* bar) {
    unsigned c[16];
#pragma unroll
    for (unsigned j = 0; j < 16; ++j) c[j] = xb_ld(&bar[XB_XCNT(j)]);
    unsigned bad = (gridDim.x * gridDim.y * gridDim.z == 256u) ? 0u : 1u;
#pragma unroll
    for (unsigned j = 0; j < 16; ++j) bad |= c[j] ^ (j < 8u ? 32u : 0u);
    return bad == 0u;
}
__device__ __forceinline__ void xcd_barrier(const XcdBarrier& b) {
    asm volatile("s_waitcnt vmcnt(0)" ::: "memory");
    __syncthreads();
    if (threadIdx.x == 0) {
        unsigned* bar = b.bar;
        __builtin_amdgcn_s_waitcnt(0);
        unsigned nloc = b.st[0], nx = b.st[1];
        if (nloc == 0u) { xcd_barrier_complete(bar, b.x, nloc, nx); b.st[0] = nloc; b.st[1] = nx; b.st[2] = xcd_census_uniform(bar) ? 1u : 2u; }
#if EARLY_WB
        __builtin_amdgcn_fence(__ATOMIC_RELEASE, "agent");
        asm volatile("s_waitcnt vmcnt(0)" ::: "memory");
#endif
        const unsigned old = xb_add(&bar[XB_XSUB(b.x)], 1u);
        const unsigned gen = old / nloc;
        if (old + 1u == (gen + 1u) * nloc) {
            __builtin_amdgcn_fence(__ATOMIC_RELEASE, "agent");
            asm volatile("s_waitcnt vmcnt(0)" ::: "memory");
            const unsigned og = xb_add(&bar[XB_TOP], 1u);
            const unsigned tg = og / nx;
            if (og + 1u == (tg + 1u) * nx) xb_add(&bar[XB_TOPGEN], 1u);
            else XB_SPIN(xb_ld(&bar[XB_TOPGEN]) == tg, bar);
            __builtin_amdgcn_fence(__ATOMIC_ACQUIRE, "agent");
            xb_add(&bar[XB_XGEN(b.x)], 1u);
            asm volatile("s_waitcnt vmcnt(0)" ::: "memory");
        } else {
            XB_SPIN(xb_ld(&bar[XB_XGEN(b.x)]) == gen, bar);
            __builtin_amdgcn_fence(__ATOMIC_ACQUIRE, "agent");
            asm volatile("s_waitcnt vmcnt(0)" ::: "memory");
        }
    }
    __syncthreads();
}

template <class F>
__device__ __forceinline__ void xcd_barrier_work(const XcdBarrier& b, unsigned rk_max, F&& work) {
    asm volatile("s_waitcnt vmcnt(0)" ::: "memory");
    __syncthreads();
    int tw_ = (int)threadIdx.x; asm volatile("" : "+v"(tw_));
    if (tw_ >= 64) {
        unsigned r_; while ((r_ = b.st[3]) == 0u) __builtin_amdgcn_s_sleep(1);
        r_ = (unsigned)__builtin_amdgcn_readfirstlane((int)r_);
        if (r_ <= rk_max) work((int)r_ - 1, (tw_ >> 6) - 1, tw_ & 63);
    } else if (threadIdx.x == 0) {
        unsigned* bar = b.bar;
        __builtin_amdgcn_s_waitcnt(0);
        unsigned nloc = b.st[0], nx = b.st[1];
        if (nloc == 0u) { xcd_barrier_complete(bar, b.x, nloc, nx); b.st[0] = nloc; b.st[1] = nx; b.st[2] = xcd_census_uniform(bar) ? 1u : 2u; }
#if EARLY_WB
        __builtin_amdgcn_fence(__ATOMIC_RELEASE, "agent");
        asm volatile("s_waitcnt vmcnt(0)" ::: "memory");
#endif
        const unsigned old = xb_add(&bar[XB_XSUB(b.x)], 1u);
        const unsigned gen = old / nloc;
        b.st[3] = (b.st[2] == 1u) ? (old - gen * nloc + 1u) : 0x7fffffffu;
        if (old + 1u == (gen + 1u) * nloc) {
            __builtin_amdgcn_fence(__ATOMIC_RELEASE, "agent");
            asm volatile("s_waitcnt vmcnt(0)" ::: "memory");
            const unsigned og = xb_add(&bar[XB_TOP], 1u);
            const unsigned tg = og / nx;
            if (og + 1u == (tg + 1u) * nx) xb_add(&bar[XB_TOPGEN], 1u);
            else XB_SPIN(xb_ld(&bar[XB_TOPGEN]) == tg, bar);
            __builtin_amdgcn_fence(__ATOMIC_ACQUIRE, "agent");
            xb_add(&bar[XB_XGEN(b.x)], 1u);
            asm volatile("s_waitcnt vmcnt(0)" ::: "memory");
        } else {
            XB_SPIN(xb_ld(&bar[XB_XGEN(b.x)]) == gen, bar);
            __builtin_amdgcn_fence(__ATOMIC_ACQUIRE, "agent");
            asm volatile("s_waitcnt vmcnt(0)" ::: "memory");
        }
    }
    __syncthreads();
    if (threadIdx.x == 0) b.st[3] = 0u;
}

template <class F>
__device__ __forceinline__ void xcd_barrier_overlap(const XcdBarrier& b, F&& work) {
    asm volatile("s_waitcnt vmcnt(0)" ::: "memory");
    __syncthreads();
    int tw_ = (int)threadIdx.x; asm volatile("" : "+v"(tw_));
    if (tw_ >= 64) work(tw_ - 64, NWAVES * 64 - 64);
    else if (threadIdx.x == 0) {
        unsigned* bar = b.bar;
        __builtin_amdgcn_s_waitcnt(0);
        unsigned nloc = b.st[0], nx = b.st[1];
        if (nloc == 0u) { xcd_barrier_complete(bar, b.x, nloc, nx); b.st[0] = nloc; b.st[1] = nx; b.st[2] = xcd_census_uniform(bar) ? 1u : 2u; }
#if EARLY_WB
        __builtin_amdgcn_fence(__ATOMIC_RELEASE, "agent");
        asm volatile("s_waitcnt vmcnt(0)" ::: "memory");
#endif
        const unsigned old = xb_add(&bar[XB_XSUB(b.x)], 1u);
        const unsigned gen = old / nloc;
        if (old + 1u == (gen + 1u) * nloc) {
            __builtin_amdgcn_fence(__ATOMIC_RELEASE, "agent");
            asm volatile("s_waitcnt vmcnt(0)" ::: "memory");
            const unsigned og = xb_add(&bar[XB_TOP], 1u);
            const unsigned tg = og / nx;
            if (og + 1u == (tg + 1u) * nx) xb_add(&bar[XB_TOPGEN], 1u);
            else XB_SPIN(xb_ld(&bar[XB_TOPGEN]) == tg, bar);
            __builtin_amdgcn_fence(__ATOMIC_ACQUIRE, "agent");
            xb_add(&bar[XB_XGEN(b.x)], 1u);
            asm volatile("s_waitcnt vmcnt(0)" ::: "memory");
        } else {
            XB_SPIN(xb_ld(&bar[XB_XGEN(b.x)]) == gen, bar);
            __builtin_amdgcn_fence(__ATOMIC_ACQUIRE, "agent");
            asm volatile("s_waitcnt vmcnt(0)" ::: "memory");
        }
    }
    __syncthreads();
}
__device__ __forceinline__ void ld_row_f32(const float* p, int lane, f32x4 (&v)[4]) {
#pragma unroll
    for (int j = 0; j < 4; ++j) v[j] = *(const f32x4*)(p + 256 * j + 4 * lane);
}
__device__ __forceinline__ void ld_row_f32_nt(const float* p, int lane, f32x4 (&v)[4]) {
#pragma unroll
    for (int j = 0; j < 4; ++j) v[j] = __builtin_nontemporal_load((const f32x4*)(p + 256 * j + 4 * lane));
}
__device__ __forceinline__ void st_row_f32_nt(float* p, int lane, const f32x4 (&v)[4]) {
#pragma unroll
    for (int j = 0; j < 4; ++j) __builtin_nontemporal_store(v[j], (f32x4*)(p + 256 * j + 4 * lane));
}
__device__ __forceinline__ void ld_row_bf16_nt(const bf16_t* p, int lane, f32x4 (&v)[4]) {
#pragma unroll
    for (int j = 0; j < 4; ++j) { const v2u w = __builtin_nontemporal_load((const v2u*)(p + 256 * j + 4 * lane)); v[j] = (f32x4){bflo(w.x), bfhi(w.x), bflo(w.y), bfhi(w.y)}; }
}
__device__ __forceinline__ void st_row_f32(float* p, int lane, const f32x4 (&v)[4]) {
#pragma unroll
    for (int j = 0; j < 4; ++j) *(f32x4*)(p + 256 * j + 4 * lane) = v[j];
}
__device__ __forceinline__ void ld_row_bf16(const bf16_t* p, int lane, f32x4 (&v)[4]) {
#pragma unroll
    for (int j = 0; j < 4; ++j) { const v2u w = *(const v2u*)(p + 256 * j + 4 * lane); v[j] = (f32x4){bflo(w.x), bfhi(w.x), bflo(w.y), bfhi(w.y)}; }
}
__device__ __forceinline__ void st_row_bf16(bf16_t* p, int lane, const f32x4 (&v)[4]) {
#pragma unroll
    for (int j = 0; j < 4; ++j) { v2u w; w.x = pk2(v[j].x, v[j].y); w.y = pk2(v[j].z, v[j].w); *(v2u*)(p + 256 * j + 4 * lane) = w; }
}
__device__ __forceinline__ void st_row_bf16_nt(bf16_t* p, int lane, const f32x4 (&v)[4]) {
#pragma unroll
    for (int j = 0; j < 4; ++j) { v2u w; w.x = pk2(v[j].x, v[j].y); w.y = pk2(v[j].z, v[j].w); __builtin_nontemporal_store(w, (v2u*)(p + 256 * j + 4 * lane)); }
}
__device__ __forceinline__ void ld_vec_lds(LAS const float* p, int lane, f32x4 (&v)[4]) {
#pragma unroll
    for (int j = 0; j < 4; ++j) v[j] = *(LAS const f32x4*)(p + 256 * j + 4 * lane);
}
__device__ __forceinline__ float sumsq16(const f32x4 (&v)[4]) {
    float s = 0.f;
#pragma unroll
    for (int j = 0; j < 4; ++j) s += (v[j].x * v[j].x + v[j].y * v[j].y) + (v[j].z * v[j].z + v[j].w * v[j].w);
    return s;
}
__device__ __forceinline__ float modfin(const float* modp, const float* bmod, int l, int r, int n) {
    float p[8];
#pragma unroll
    for (int kc = 0; kc < 8; ++kc) p[kc] = modp[((size_t)(l * 8 + kc) * 9 + r) * 6144 + n];
    float s = bmod[l * 6144 + n];
    asm volatile("" : "+v"(p[0]), "+v"(p[1]), "+v"(p[2]), "+v"(p[3]), "+v"(p[4]), "+v"(p[5]), "+v"(p[6]), "+v"(p[7]));
#pragma unroll
    for (int kc = 0; kc < 8; ++kc) s += p[kc];
    return s;
}

#ifndef CV_G1
#define CV_G1 4
#endif
#ifndef CV_G2
#define CV_G2 6
#endif
#ifndef CV_M1
#define CV_M1 0
#endif
#ifndef CV_G3
#define CV_G3 4
#endif
#ifndef CV_G4
#define CV_G4 5
#endif
#ifndef CONV_M3
#define CONV_M3 1408
#endif
#ifndef CONV_IN_P0
#define CONV_IN_P0 1
#endif
__device__ __forceinline__ void tr_item64(const float* W, int N, int Nvalid, bf16_t* WT, int Kd, int k0, int n0, int dst_row0, LAS float* scr, int lane) {
    const int q = lane & 15, kr = lane >> 4;
    f32x4 t[16];
#pragma unroll
    for (int i = 0; i < 16; ++i) { const int kk = 4 * i + kr; const int n = n0 + 4 * q;
        t[i] = (n < Nvalid) ? *(const f32x4*)(W + (size_t)(k0 + kk) * N + n) : (f32x4){0.f, 0.f, 0.f, 0.f}; }
#pragma unroll
    for (int i = 0; i < 16; ++i) { const int kk = 4 * i + kr; LAS float* d = scr + kk * 65 + 4 * q; d[0] = t[i].x; d[1] = t[i].y; d[2] = t[i].z; d[3] = t[i].w; }
    const int c = lane & 7, nl = lane >> 3;
#pragma unroll
    for (int j = 0; j < 8; ++j) { const int n = nl + 8 * j; LAS const float* s = scr + (8 * c) * 65 + n;
        v4u o; o.x = pk2(s[0 * 65], s[1 * 65]); o.y = pk2(s[2 * 65], s[3 * 65]); o.z = pk2(s[4 * 65], s[5 * 65]); o.w = pk2(s[6 * 65], s[7 * 65]);
        *(v4u*)(WT + (size_t)(dst_row0 + n) * Kd + k0 + 8 * c) = o; }
}
__device__ __forceinline__ void expert_conv_item(const float* const* in, unsigned char* ws, int l, int r, LAS float* scr, int lane) {
    const float* w_gate = in[15]; const float* w_up = in[16]; const float* w_down = in[17];
    const int which = r >> 12; r &= 4095;
    const int e = r >> 8, kb = (r & 255) >> 4, nb = r & 15, n0 = 64 * nb;
    const size_t eoff = (size_t)(l * 16 + e) * 1024 * 1024;
    if (which == 0) tr_item64(w_gate + eoff, 1024, 1024, (bf16_t*)(ws + WS_WGU) + 2 * eoff, 1024, 64 * kb, n0, (n0 >> 7) * 256 + (n0 & 127), scr, lane);
    else if (which == 1) tr_item64(w_up + eoff, 1024, 1024, (bf16_t*)(ws + WS_WGU) + 2 * eoff, 1024, 64 * kb, n0, (n0 >> 7) * 256 + 128 + (n0 & 127), scr, lane);
    else tr_item64(w_down + eoff, 1024, 1024, (bf16_t*)(ws + WS_WD) + eoff, 1024, 64 * kb, n0, n0, scr, lane);
}
__device__ __forceinline__ void conv_pull(const float* const* in, unsigned char* ws, int l_lo, int l_hi, int budget, LAS float* scr, int lane) {
    for (int l = l_lo; l <= l_hi && l < 2; ++l) {
        unsigned* ctr = (unsigned*)(ws + WS_CTL) + CW_CONV + 64 * l;
        while (budget > 0) {
            const int c = budget < 8 ? budget : 8;
            unsigned r = 0; if (lane == 0) r = __hip_atomic_fetch_add(ctr, (unsigned)c, __ATOMIC_RELAXED, __HIP_MEMORY_SCOPE_AGENT);
            r = (unsigned)__builtin_amdgcn_readfirstlane((int)r);
            if (r >= 12288u) break;
            for (int k = 0; k < c && (int)r + k < 12288; ++k) expert_conv_item(in, ws, l, (int)r + k, scr, lane);
            budget -= c;
        }
    }
}
struct TrDesc { const float* src; bf16_t* dst; int N, Nvalid, k0, n0, drow; };
constexpr int TR_IN = 16 * 40, TR_OUT = 16 * 16, TR_E = 16 * 16 * 16, TR_L = TR_IN + TR_OUT + 3 * TR_E, TR_ALL = 2 * TR_L;
constexpr int CV_N1 = CV_G1 * 384, CV_N2 = CV_G2 * 1792, CV_N3 = CV_G3 * 1024, CV_N4 = CV_G4 * 1536;
constexpr int P0_A = TR_L - CV_N1 - CV_N2;
constexpr int P0_B = TR_ALL - CONV_M3 - CV_N3 - CV_N4;
static_assert(P0_A >= 896 && P0_B >= TR_L, "tail conversion budgets exceed the expert tiles");
__device__ __forceinline__ void tr_desc(const float* const* in, unsigned char* ws, int r, TrDesc& d) {
    const int l = r / TR_L; r -= l * TR_L;
    if (r < TR_IN) { const int kb = r / 40, nb = r % 40; d.src = in[7] + (size_t)l * 1024 * INW; d.dst = (bf16_t*)(ws + WS_WIN) + (size_t)l * PP * 1024; d.N = INW; d.Nvalid = INW; d.k0 = 64 * kb; d.n0 = 64 * nb; d.drow = 64 * nb; return; }
    r -= TR_IN;
    if (r < TR_OUT) { const int kb = r / 16, nb = r % 16; d.src = in[8] + (size_t)l * 1024 * 1024; d.dst = (bf16_t*)(ws + WS_WOUT) + (size_t)l * 1024 * 1024; d.N = 1024; d.Nvalid = 1024; d.k0 = 64 * kb; d.n0 = 64 * nb; d.drow = 64 * nb; return; }
    r -= TR_OUT;
    const int which = r >> 12; r &= 4095;
    const int e = r >> 8, kb = (r & 255) >> 4, nb = r & 15, n0 = 64 * nb;
    const size_t eoff = (size_t)(l * 16 + e) * 1024 * 1024;
    d.N = 1024; d.Nvalid = 1024; d.k0 = 64 * kb; d.n0 = n0;
    if (which == 0) { d.src = in[15] + eoff; d.dst = (bf16_t*)(ws + WS_WGU) + 2 * eoff; d.drow = (n0 >> 7) * 256 + (n0 & 127); }
    else if (which == 1) { d.src = in[16] + eoff; d.dst = (bf16_t*)(ws + WS_WGU) + 2 * eoff; d.drow = (n0 >> 7) * 256 + 128 + (n0 & 127); }
    else { d.src = in[17] + eoff; d.dst = (bf16_t*)(ws + WS_WD) + eoff; d.drow = n0; }
}
__device__ __forceinline__ void tr_load(const TrDesc& d, int lane, f32x4 (&t)[16]) {
    const int q = lane & 15, kr = lane >> 4, n = d.n0 + 4 * q;
    const float* p = d.src + (size_t)(d.k0 + kr) * d.N + (n < d.Nvalid ? n : 0);
#pragma unroll
    for (int i = 0; i < 16; ++i) t[i] = __builtin_nontemporal_load((const f32x4*)(p + (size_t)(4 * i) * d.N));
}
__device__ __forceinline__ void tr_finish(const TrDesc& d, f32x4 (&t)[16], LAS float* scr, int lane) {
    const int q = lane & 15, kr = lane >> 4; const bool valid = (d.n0 + 4 * q) < d.Nvalid;
#pragma unroll
    for (int i = 0; i < 16; ++i) { const int kk = 4 * i + kr; LAS float* s = scr + kk * 65 + 4 * q; const f32x4 v = valid ? t[i] : (f32x4){0.f, 0.f, 0.f, 0.f}; s[0] = v.x; s[1] = v.y; s[2] = v.z; s[3] = v.w; }
    const int c = lane & 7, nl = lane >> 3;
#pragma unroll
    for (int j = 0; j < 8; ++j) { const int n = nl + 8 * j; LAS const float* s = scr + (8 * c) * 65 + n;
        v4u o; o.x = pk2(s[0 * 65], s[1 * 65]); o.y = pk2(s[2 * 65], s[3 * 65]); o.z = pk2(s[4 * 65], s[5 * 65]); o.w = pk2(s[6 * 65], s[7 * 65]);
        __builtin_nontemporal_store(o, (v4u*)(d.dst + (size_t)(d.drow + n) * 1024 + d.k0 + 8 * c)); }
}
__device__ __forceinline__ void tr_stream(const float* const* in, unsigned char* ws, int first, int stride, int hi, LAS float* scr, int lane, int cut = 1 << 30, int jump = 0) {
#define TR_ID(x) ((x) < cut ? (x) : (x) + jump)
    if (first >= hi) return;
    const int n_my = (hi - first + stride - 1) / stride;
    TrDesc dA, dB; f32x4 tA[16], tB[16];
    tr_desc(in, ws, TR_ID(first), dA); tr_load(dA, lane, tA);
    for (int i = 0; i < n_my; i += 2) {
        { const int nx = i + 1 < n_my ? i + 1 : n_my - 1; tr_desc(in, ws, TR_ID(first + nx * stride), dB); tr_load(dB, lane, tB); }
        tr_finish(dA, tA, scr, lane);
        if (i + 1 >= n_my) break;
        { const int nx = i + 2 < n_my ? i + 2 : n_my - 1; tr_desc(in, ws, TR_ID(first + nx * stride), dA); tr_load(dA, lane, tA); }
        tr_finish(dB, tB, scr, lane);
    }
#undef TR_ID
}
__device__ __forceinline__ void tr_one(const float* const* in, unsigned char* ws, int id, LAS float* scr, int lane) { TrDesc d; f32x4 t[16]; tr_desc(in, ws, id, d); tr_load(d, lane, t); tr_finish(d, t, scr, lane); }
#ifndef BC_RK
#define BC_RK 24
#endif
#ifndef BC_N0
#define BC_N0 7
#endif
#ifndef BC_N1
#define BC_N1 5
#endif
constexpr int BC_T = 8 * BC_RK * 7;
constexpr int BC_L0 = TR_L - BC_N0 * BC_T, BC_L1 = P0_B + CV_N3 + CV_N4 - BC_N1 * BC_T;
static_assert(BC_L0 >= P0_A + CV_N1 && BC_L1 >= P0_B + CV_N3 && BC_T <= 4096, "in-barrier conversion ranges");
__device__ __forceinline__ void phase_p0(const float* const* in, unsigned char* ws, LAS unsigned char* wl, int gw, int NGW, int lane, int vcu, int wave) {
    const float* cvec = in[1]; const float* cctx = in[3]; const float* wmod = in[4];
    const float* w_in = in[7]; const float* w_out = in[8];
    float* modp = (float*)(ws + WS_MODP);
    constexpr int NI_MOD = 2 * 8 * 24, NI_ROPE = 16;
    constexpr int NI_IN = 16 * 40, NI_OUT = 16 * 16, NI_E = 16 * 16 * 16;
    constexpr int NI_L = NI_IN + NI_OUT + (CONV_IN_P0 ? 3 * NI_E : 0);
    constexpr int NITEMS = NI_MOD + NI_ROPE + 2 * NI_L;
    LAS float* scr = (LAS float*)wl;
    const bool spread = (NGW == 2048);
    for (int it = spread ? (wave < 2 ? wave * 256 + vcu : NI_MOD + NI_ROPE) : gw; it < NI_MOD + NI_ROPE; it += NGW) {
        int r = it;
        if (r < NI_MOD) {
            const int cb = r % 24, kc = (r / 24) & 7, l = r / 192;
            { float cv[18];
#pragma unroll
                for (int q = 0; q < 18; ++q) { const int idx = lane + 64 * q, rr = idx >> 7, k = idx & 127; cv[q] = (rr < 8) ? cvec[rr * 1024 + kc * 128 + k] : cctx[kc * 128 + k]; }
#pragma unroll
                for (int q = 0; q < 18; ++q) { const int idx = lane + 64 * q, rr = idx >> 7, k = idx & 127; scr[k * 12 + rr] = silu_f(cv[q]); } }
            f32x4 acc[9];
#pragma unroll
            for (int rr = 0; rr < 9; ++rr) acc[rr] = (f32x4){0.f, 0.f, 0.f, 0.f};
            const float* wp = wmod + ((size_t)l * 1024 + kc * 128) * 6144 + cb * 256 + 4 * lane;
#pragma unroll 1
            for (int k0 = 0; k0 < 128; k0 += 16) {
                f32x4 w16[16];
#pragma unroll
                for (int u = 0; u < 16; ++u) w16[u] = __builtin_nontemporal_load((const f32x4*)(wp + (size_t)(k0 + u) * 6144));
                asm volatile("" ::: "memory");
#pragma unroll
                for (int u = 0; u < 16; ++u) { const int k = k0 + u; const f32x4 w = w16[u];
                    const f32x4 s0 = *(LAS const f32x4*)(scr + k * 12), s1 = *(LAS const f32x4*)(scr + k * 12 + 4); const float s8 = scr[k * 12 + 8];
                    acc[0] += w * s0.x; acc[1] += w * s0.y; acc[2] += w * s0.z; acc[3] += w * s0.w; acc[4] += w * s1.x; acc[5] += w * s1.y; acc[6] += w * s1.z; acc[7] += w * s1.w; acc[8] += w * s8; }
            }
#pragma unroll
            for (int rr = 0; rr < 9; ++rr) *(f32x4*)(modp + ((size_t)(l * 8 + kc) * 9 + rr) * 6144 + cb * 256 + 4 * lane) = acc[rr];
            continue;
        }
        r -= NI_MOD;
        if (r < NI_ROPE) {
            const int id = r * 64 + lane, pos = id >> 4, i = id & 15;
            const float fr = fexp2(-(float)i * (13.287712379549449f / 16.f));
            float rev = (float)pos * fr * 0.15915494309189535f; rev -= floorf(rev);
            f32x2 cs; cs.x = __builtin_amdgcn_cosf(rev); cs.y = __builtin_amdgcn_sinf(rev);
            ((f32x2*)(ws + WS_TAB))[id] = cs;
            continue;
        }
        break;
    }
    if (spread) { const int tix = (wave - 2) * 256 + vcu; if (wave >= 2 && tix < P0_A + (P0_B - TR_L)) tr_one(in, ws, tix < P0_A ? tix : tix + (TR_L - P0_A), scr, lane); }
    else tr_stream(in, ws, gw, NGW, TR_ALL, scr, lane);
}

__device__ __forceinline__ void phase_a0(const float* const* in, unsigned char* ws, LAS unsigned char* lds, int G, int tid, int wave, int lane) {
    const float* x = in[0]; const float* ctx = in[2]; const float* bmod = in[5]; const float* gains = in[6];
    const float* modp = (const float*)(ws + WS_MODP); float* mod = (float*)(ws + WS_MOD); bf16_t* H = (bf16_t*)(ws + WS_H);
    LAS float* V = (LAS float*)lds;
    for (int idx = blockIdx.x * 512 + tid; idx < 18 * 6144; idx += G * 512) { const int row = idx / 6144, n = idx - row * 6144; mod[idx] = modfin(modp, bmod, row / 9, row % 9, n); }
    for (int t = blockIdx.x; t < 256; t += G) {
        const int b = t >> 5;
        f32x4 xq[9][4];
#pragma unroll
        for (int i = 0; i < 9; ++i) { const bool isc = (i == 8);
            const float* src = isc ? (ctx + (size_t)(8 * t + wave) * 1024) : (x + (size_t)(64 * t + 8 * wave + i) * 1024); ld_row_f32_nt(src, lane, xq[i]); }
        __syncthreads();
        for (int n = tid; n < 1024; n += 512) { const float g = gains[n];
            V[n] = g * (1.f + modfin(modp, bmod, 0, b, 1024 + n)); V[1024 + n] = modfin(modp, bmod, 0, b, n);
            V[2048 + n] = g * (1.f + modfin(modp, bmod, 0, 8, 1024 + n)); V[3072 + n] = modfin(modp, bmod, 0, 8, n); }
        __syncthreads();
#pragma unroll
        for (int i = 0; i < 9; ++i) { const bool isc = (i == 8);
            const int row = isc ? (ML + 8 * t + wave) : (64 * t + 8 * wave + i);
            f32x4 (&v)[4] = xq[i]; f32x4 a[4], s[4];
            const float rstd = __builtin_amdgcn_rsqf(wave_sum(sumsq16(v)) * (1.f / 1024.f) + NEPS);
            ld_vec_lds(V + (isc ? 2048 : 0), lane, a); ld_vec_lds(V + (isc ? 3072 : 1024), lane, s);
#pragma unroll
            for (int j = 0; j < 4; ++j) v[j] = v[j] * rstd * a[j] + s[j];
            st_row_bf16(H + (size_t)row * 1024, lane, v);
        }
    }
}
constexpr int VP = 192;
struct AttnTile { f32x16 o0, o1; float m, lsum; };
__device__ __forceinline__ void attn_softmax(f32x16& s, AttnTile& T) {
    float bm = fmaxf(fmaxf(s[0], s[1]), fmaxf(s[2], s[3]));
#pragma unroll
    for (int i = 4; i < 16; i += 4) bm = fmaxf(bm, fmaxf(fmaxf(s[i], s[i + 1]), fmaxf(s[i + 2], s[i + 3])));
    bm = x32_max(bm);
    const float mo = T.m, mn = fmaxf(mo, bm);
    T.m = mn;
    float ps = 0.f;
#pragma unroll
    for (int i = 0; i < 16; ++i) { s[i] = fexp2(s[i] - mn); ps += s[i]; }
    if (__any(mn != mo)) {
        const float alpha = fexp2(mo - mn);
        T.lsum *= alpha;
#pragma unroll
        for (int i = 0; i < 16; ++i) { T.o0[i] *= alpha; T.o1[i] *= alpha; }
    }
    T.lsum += ps;
}
__device__ __forceinline__ void attn_item(const int MODE, const bf16_t* P, bf16_t* MIX, int item, LAS unsigned char* wl, int lane,
                                          const float* __restrict__ rpb, const float* __restrict__ sink, const bool dry = false) {
    asm volatile("" : "+v"(lane));
    const int ql = lane & 31, hi = lane >> 5;
    int b, hq, qcol, kcol, vcol, ocol, qrow0, r = 0, rs = 0, q64 = 0, nloc, kb_lo = 0, trow = 32, tcol = 0;
    if (MODE == 0) { r = item & 31; hq = (item >> 5) & 3; b = item >> 7;
        qcol = C_NQ + hq * 64; kcol = C_NK + hq * 64; vcol = C_NV + hq * 64; ocol = 256 + hq * 64; qrow0 = b * SEQ + r * 64;
        rs = r - 4; rs = rs < 0 ? 0 : (rs > 24 ? 24 : rs); nloc = 16; }
    else if (MODE == 1) { q64 = item & 63; hq = 2 * ((item >> 6) & 3); b = item >> 8;
        qcol = C_SQ + hq * 64; kcol = C_SK + (hq >> 2) * 64; vcol = C_SV + (hq >> 2) * 64; ocol = 512 + hq * 64; qrow0 = b * SEQ + q64 * 32; trow = 0; tcol = 64;
        kb_lo = q64 - 4; if (kb_lo < 0) kb_lo = 0; int kb_hi = q64 + 4; if (kb_hi > 63) kb_hi = 63; nloc = kb_hi - kb_lo + 1; }
    else if (MODE == 2) { q64 = item & 3; hq = (item >> 2) & 3; b = item >> 4;
        qcol = C_NQ + hq * 64; kcol = C_NK + hq * 64; vcol = C_NV + hq * 64; ocol = 256 + hq * 64; qrow0 = ML + b * CTXL + q64 * 64; nloc = 0; }
    else { q64 = item & 3; hq = (item >> 2) & 7; b = item >> 5;
        qcol = C_SQ + hq * 64; kcol = C_SK + (hq >> 2) * 64; vcol = C_SV + (hq >> 2) * 64; ocol = 512 + hq * 64; qrow0 = ML + b * CTXL + q64 * 64; nloc = 0; }
    const int nblk = 8 + nloc;
    LAS unsigned char* vl = wl;
    LAS float* rl = (LAS float*)(wl + 32 * VP);
    if (MODE == 0) { float bv[8];
#pragma unroll
        for (int q = 0; q < 8; ++q) { const int i = lane + 64 * q; bv[q] = rpb[hq * 465 + (i < 465 ? i : 464)]; }
#pragma unroll
        for (int q = 0; q < 8; ++q) { const int i = lane + 64 * q; if (i < 465) rl[i] = bv[q] * LOG2E; } }
    LAS unsigned char* qimg = wl + 32 * VP + 1920;
    constexpr int QP = 144;
    LAS const unsigned char* qrd = qimg + ql * QP + 16 * hi;
    auto blk_row0 = [&](int blk) -> int {
        if (blk < 8) return ML + b * CTXL + blk * 32;
        const int lb = blk - 8;
        if (MODE == 0) return b * SEQ + (rs + (lb >> 1)) * 64 + (lb & 1) * 32;
        return b * SEQ + 32 * (kb_lo + lb);
    };
    auto load_blk = [&](int blk, bf16x8 (&kn)[4], v4u (&vn)[4]) {
        const int r0 = blk_row0(blk);
        const bf16_t* kp = P + (size_t)(r0 + ql) * PP + kcol + 8 * hi;
#pragma unroll
        for (int ds = 0; ds < 4; ++ds) kn[ds] = *(const bf16x8*)(kp + 16 * ds);
#pragma unroll
        for (int i = 0; i < 4; ++i) { const int c = lane + 64 * i; vn[i] = *(const v4u*)(P + (size_t)(r0 + (c >> 3)) * PP + vcol + (c & 7) * 8); }
    };
    bf16x8 kA[4], kB[4]; v4u vA[4], vB[4];
    { v4u qv[8];
#pragma unroll
      for (int i = 0; i < 8; ++i) { const int c = lane + 64 * i; const int r64 = c >> 3, tt = r64 >> 5; qv[i] = *(const v4u*)(P + (size_t)(qrow0 + (r64 & 31) + tt * trow) * PP + qcol + tt * tcol + (c & 7) * 8); }
      load_blk(0, kA, vA); load_blk(1, kB, vB);
      asm volatile("" ::: "memory");
#pragma unroll
      for (int i = 0; i < 8; ++i) { const int c = lane + 64 * i; *(LAS v4u*)(qimg + (c >> 3) * QP + (c & 7) * 16) = qv[i]; } }
    AttnTile T[2];
#pragma unroll
    for (int t = 0; t < 2; ++t) { T[t].m = -INFINITY; T[t].lsum = 0.f;
#pragma unroll
        for (int i = 0; i < 16; ++i) { T[t].o0[i] = 0.f; T[t].o1[i] = 0.f; } }
    const int tr_off = (4 * hi + ((lane & 15) >> 2)) * VP + (16 * ((lane >> 4) & 1) + 4 * (lane & 3)) * 2;
    auto step = [&](int blk, bf16x8 (&kf)[4], v4u (&vr)[4]) {
#pragma unroll
        for (int i = 0; i < 4; ++i) { const int c = lane + 64 * i; *(LAS v4u*)(vl + (c >> 3) * VP + (c & 7) * 16) = vr[i]; }
        f32x16 sc[2];
        bf16x8 qf[2][4];
#pragma unroll
        for (int t = 0; t < 2; ++t)
#pragma unroll
            for (int ds = 0; ds < 4; ++ds) qf[t][ds] = *(LAS const bf16x8*)(qrd + 32 * t * QP + 32 * ds);
        asm volatile("" : "+v"(qf[0][0]), "+v"(qf[0][1]), "+v"(qf[0][2]), "+v"(qf[0][3]), "+v"(qf[1][0]), "+v"(qf[1][1]), "+v"(qf[1][2]), "+v"(qf[1][3]));
#pragma unroll
        for (int t = 0; t < 2; ++t) {
#pragma unroll
            for (int i = 0; i < 16; ++i) sc[t][i] = 0.f;
#pragma unroll
            for (int ds = 0; ds < 4; ++ds) sc[t] = MFMA32(kf[ds], qf[t][ds], sc[t]);
        }
        if (blk + 2 < nblk) load_blk(blk + 2, kf, vr);
        bf16x8 vf[2][2];
#pragma unroll
        for (int ks = 0; ks < 2; ++ks) { LAS const unsigned char* vb = vl + tr_off + 16 * ks * VP;
            vf[ks][0] = cat4(tr_read(vb), tr_read(vb + 8 * VP)); vf[ks][1] = cat4(tr_read(vb + 64), tr_read(vb + 8 * VP + 64)); }
#pragma unroll
        for (int t = 0; t < 2; ++t) {
            f32x16& s = sc[t];
            if (MODE == 0 && blk >= 8) {
                const int lb = blk - 8, j = lb >> 1, ch = lb & 1, c = t * 32 + ql;
                int cs = c - 8; cs = cs < 0 ? 0 : (cs > 48 ? 48 : cs);
                LAS const float* rb = rl + (rs + j - r + 7) * 31 + (15 - c) + ch * 32 + 4 * hi;
                const int kb = ch * 32 + 4 * hi - cs;
#pragma unroll
                for (int h2 = 0; h2 < 2; ++h2) {
                    float bias[8];
#pragma unroll
                    for (int i = 0; i < 8; ++i) { const int q = 8 * h2 + i; bias[i] = rb[(q & 3) + 8 * (q >> 2)]; }
                    asm volatile("" : "+v"(bias[0]), "+v"(bias[1]), "+v"(bias[2]), "+v"(bias[3]), "+v"(bias[4]), "+v"(bias[5]), "+v"(bias[6]), "+v"(bias[7]));
#pragma unroll
                    for (int i = 0; i < 8; ++i) { const int q = 8 * h2 + i; const bool ok = (unsigned)(kb + (q & 3) + 8 * (q >> 2)) < 16u; s[q] = ok ? (s[q] + bias[i]) : -INFINITY; }
                }
            } else if (MODE == 1 && blk >= 8) {
                const int rel = (kb_lo + blk - 8) - q64;
                if (rel <= -4 || rel >= 4) {
#pragma unroll
                    for (int i = 0; i < 16; ++i) { const int kk = crow(i, hi); const bool ok = (rel == -4) ? (kk >= ql) : ((rel == 4) ? (kk <= ql) : false);
                        s[i] = ok ? s[i] : -INFINITY; }
                }
            }
            attn_softmax(s, T[t]);
#pragma unroll
            for (int ks = 0; ks < 2; ++ks) {
                const bf16x8 pf = pack8(s[8 * ks + 0], s[8 * ks + 1], s[8 * ks + 2], s[8 * ks + 3], s[8 * ks + 4], s[8 * ks + 5], s[8 * ks + 6], s[8 * ks + 7]);
                T[t].o0 = MFMA32(vf[ks][0], pf, T[t].o0); T[t].o1 = MFMA32(vf[ks][1], pf, T[t].o1);
            }
            __builtin_amdgcn_sched_barrier(0);
        }
    };
    for (int blk = 0; blk < nblk; blk += 2) { step(blk, kA, vA); if (blk + 1 < nblk) step(blk + 1, kB, vB); }
#pragma unroll
    for (int t = 0; t < 2; ++t) {
        float lt = x32_sum(T[t].lsum);
        if (MODE == 1 || MODE == 3) lt += fexp2(sink[hq + (tcol ? t : 0)] * LOG2E - T[t].m);
        const float inv = frcp(lt);
        bf16_t* op = MIX + (size_t)(qrow0 + trow * t + ql) * 1024 + ocol + tcol * t + 4 * hi;
#pragma unroll
        for (int g = 0; g < 4; ++g) {
            v2u w0, w1; w0.x = pk2(T[t].o0[4 * g] * inv, T[t].o0[4 * g + 1] * inv); w0.y = pk2(T[t].o0[4 * g + 2] * inv, T[t].o0[4 * g + 3] * inv);
            w1.x = pk2(T[t].o1[4 * g] * inv, T[t].o1[4 * g + 1] * inv); w1.y = pk2(T[t].o1[4 * g + 2] * inv, T[t].o1[4 * g + 3] * inv);
            *(v2u*)(op + 8 * g) = w0; *(v2u*)(op + 32 + 8 * g) = w1;
        }
    }
}
constexpr int GP = 144;
constexpr int G_V = 0, G_A = 64 * GP, G_B = 64 * GP + 32 * GP;
static_assert(G_B + 32 * GP <= WAVE_LDS, "gla LDS");

struct GlaCum { float cum[2][16]; float tot; };
__device__ __forceinline__ void gla_cum(const bf16_t* P, int row0, int hh, int dir, const float* __restrict__ a_up, const float* __restrict__ a_bias, int lane, GlaCum& C) {
    const int kk = lane & 31, hi = lane >> 5;
    const float* up = a_up + (size_t)dir * 16 * 128 + (size_t)(8 * hi) * 128 + hh * 32 + kk;
    const bf16x8 ub = pack8(up[0], up[128], up[256], up[384], up[512], up[640], up[768], up[896]);
    const float bias = a_bias[dir * 128 + hh * 32 + kk];
    float gs[2][4];
#pragma unroll
    for (int tt = 0; tt < 2; ++tt) {
        const bf16x8 al = *(const bf16x8*)(P + (size_t)(row0 + 32 * tt + kk) * PP + C_GAF + 16 * dir + 8 * hi);
        f32x16 z;
#pragma unroll
        for (int i = 0; i < 16; ++i) z[i] = 0.f;
        z = MFMA32(al, ub, z);
#pragma unroll
        for (int g = 0; g < 4; ++g) { float run = 0.f;
#pragma unroll
            for (int e = 0; e < 4; ++e) { const float zz = z[4 * g + e] + bias; const float ls = fminf(zz, 0.f) - flog(1.f + fexp(-fabsf(zz)));
                const float l = ls * (1.f / 16.f);
                if (dir == 0) { run += l; C.cum[tt][4 * g + e] = run; } else { C.cum[tt][4 * g + e] = run; run += l; } }
            gs[tt][g] = run; }
    }
    float off = 0.f;
#pragma unroll
    for (int tt = 0; tt < 2; ++tt)
#pragma unroll
        for (int g = 0; g < 4; ++g) { const float other = x32_other(gs[tt][g], hi != 0); const float mine = off + (hi ? other : 0.f);
#pragma unroll
            for (int e = 0; e < 4; ++e) C.cum[tt][4 * g + e] += mine;
            off += gs[tt][g] + other; }
    C.tot = off;
    if (dir == 1) {
#pragma unroll
        for (int tt = 0; tt < 2; ++tt)
#pragma unroll
            for (int r = 0; r < 16; ++r) C.cum[tt][r] = off - C.cum[tt][r];
    }
}
__device__ __forceinline__ void gla_ld_tc(const bf16_t* P, int row0, int col, int lane, float (&x)[2][16]) {
    const int kk = lane & 31, hi = lane >> 5;
    bf16_t raw[2][16];
#pragma unroll
    for (int tt = 0; tt < 2; ++tt)
#pragma unroll
        for (int r = 0; r < 16; ++r) raw[tt][r] = P[(size_t)(row0 + 32 * tt + crow(r, hi)) * PP + col + kk];
    asm volatile("" ::: "memory");
#pragma unroll
    for (int tt = 0; tt < 2; ++tt)
#pragma unroll
        for (int r = 0; r < 16; ++r) x[tt][r] = bf1(raw[tt][r]);
}
__device__ __forceinline__ void gla_st_img(LAS unsigned char* img, int lane, const float (&x)[2][16]) {
    const int kk = lane & 31, hi = lane >> 5;
#pragma unroll
    for (int tt = 0; tt < 2; ++tt)
#pragma unroll
        for (int g = 0; g < 4; ++g) { v2u w; w.x = pk2(x[tt][4 * g], x[tt][4 * g + 1]); w.y = pk2(x[tt][4 * g + 2], x[tt][4 * g + 3]);
            *(LAS v2u*)(img + kk * GP + (32 * tt + 8 * g + 4 * hi) * 2) = w; }
}
__device__ __forceinline__ void gla_stage_v(const bf16_t* P, int row0, int hh, LAS unsigned char* wl, int lane) {
    v4u vv[8];
#pragma unroll
    for (int i = 0; i < 8; ++i) { const int c = lane + 64 * i; vv[i] = *(const v4u*)(P + (size_t)(row0 + (c >> 3)) * PP + C_GV + hh * 64 + (c & 7) * 8); }
    asm volatile("" ::: "memory");
#pragma unroll
    for (int i = 0; i < 8; ++i) { const int c = lane + 64 * i; *(LAS v4u*)(wl + G_V + (c >> 3) * GP + (c & 7) * 16) = vv[i]; }
}
__device__ __forceinline__ int gla_row0(int b, int nc) { return nc < 4 ? (ML + b * CTXL + 64 * nc) : (b * SEQ + 64 * (nc - 4)); }

__device__ __forceinline__ void gla_local_item(const bf16_t* P, float* UST, float* DEC, int item, LAS unsigned char* wl, int lane,
                                               const float* __restrict__ a_up, const float* __restrict__ a_bias) {
    asm volatile("" : "+v"(lane));
    const int nc = item % 36, hh = (item / 36) & 3, b = item / 144;
    const int row0 = gla_row0(b, nc), kk = lane & 31, hi = lane >> 5;
    gla_stage_v(P, row0, hh, wl, lane);
    float kv[2][16]; gla_ld_tc(P, row0, C_GK + hh * 32, lane, kv);
#pragma unroll
    for (int dir = 0; dir < 2; ++dir) {
        GlaCum C; gla_cum(P, row0, hh, dir, a_up, a_bias, lane, C);
        float kd[2][16];
#pragma unroll
        for (int tt = 0; tt < 2; ++tt)
#pragma unroll
            for (int r = 0; r < 16; ++r) kd[tt][r] = kv[tt][r] * fexp(C.tot - C.cum[tt][r]);
        gla_st_img(wl + (dir == 0 ? G_A : G_B), lane, kd);
        if (hi == 0) DEC[((size_t)((b * 4 + hh) * 2 + dir) * 36 + nc) * 32 + kk] = fexp(C.tot);
    }
    const int trv = ((lane & 15) >> 2) * GP + (16 * ((lane >> 4) & 1) + 4 * (lane & 3)) * 2;
#pragma unroll
    for (int dir = 0; dir < 2; ++dir) {
        f32x16 u0, u1;
#pragma unroll
        for (int i = 0; i < 16; ++i) { u0[i] = 0.f; u1[i] = 0.f; }
        LAS const unsigned char* img = wl + (dir == 0 ? G_A : G_B);
#pragma unroll
        for (int s = 0; s < 4; ++s) {
            const bf16x8 kb = *(LAS const bf16x8*)(img + kk * GP + (16 * s + 8 * hi) * 2);
            LAS const unsigned char* vb = wl + G_V + trv + (16 * s + 8 * hi) * GP;
            const bf16x8 v0 = cat4(tr_read(vb), tr_read(vb + 4 * GP));
            const bf16x8 v1 = cat4(tr_read(vb + 64), tr_read(vb + 4 * GP + 64));
            u0 = MFMA32(v0, kb, u0); u1 = MFMA32(v1, kb, u1);
        }
        float* up = UST + ((size_t)((b * 4 + hh) * 2 + dir) * 36 + nc) * 2048 + kk;
#pragma unroll
        for (int i = 0; i < 16; ++i) { up[(size_t)crow(i, hi) * 32] = u0[i]; up[(size_t)(32 + crow(i, hi)) * 32] = u1[i]; }
    }
}

__device__ __forceinline__ void gla_prefix(float* UST, const float* DEC, int gid, bool dry) {
    const int bhd = gid >> 11, e = gid & 2047, k = e & 31, dir = bhd & 1;
    float* base = UST + (size_t)bhd * 36 * 2048 + e; const float* dec = DEC + (size_t)bhd * 36 * 32 + k;
    float u[36], d[36];
#pragma unroll
    for (int ci = 0; ci < 36; ++ci) { const int sl = dir == 0 ? ci : (ci < 4 ? 3 - ci : 39 - ci); u[ci] = base[(size_t)sl * 2048]; d[ci] = dec[sl * 32]; }
    float s = 0.f;
#pragma unroll
    for (int ci = 0; ci < 36; ++ci) {
        const int sl = dir == 0 ? ci : (ci < 4 ? 3 - ci : 39 - ci);
        if (!dry) base[(size_t)sl * 2048] = s;
        s = d[ci] * s + u[ci];
    }
}

__device__ __forceinline__ void gla_out_item(const bf16_t* P, const float* UST, bf16_t* MIX, int item, LAS unsigned char* wl, int lane,
                                             const float* __restrict__ a_up, const float* __restrict__ a_bias, const float* __restrict__ gnorm) {
    const int nc = item % 36, hh = (item / 36) & 3, b = item / 144;
    const int row0 = gla_row0(b, nc), kk = lane & 31, hi = lane >> 5;
    gla_stage_v(P, row0, hh, wl, lane);
    f32x16 o[2][2];
#pragma unroll
    for (int a = 0; a < 2; ++a)
#pragma unroll
        for (int c = 0; c < 2; ++c)
#pragma unroll
            for (int i = 0; i < 16; ++i) o[a][c][i] = 0.f;
    unsigned qp[2][8], kp[2][8];
#pragma unroll
    for (int tt = 0; tt < 2; ++tt) {
#pragma unroll
        for (int g = 0; g < 4; ++g)
#pragma unroll
            for (int e2 = 0; e2 < 2; ++e2) { const size_t ro = (size_t)(row0 + 32 * tt + 8 * g + 4 * hi + 2 * e2) * PP + hh * 32 + kk;
                qp[tt][2 * g + e2] = (unsigned)P[ro + C_GQ] | ((unsigned)P[ro + PP + C_GQ] << 16); kp[tt][2 * g + e2] = (unsigned)P[ro + C_GK] | ((unsigned)P[ro + PP + C_GK] << 16); }
        asm volatile("" ::: "memory");
    }
    const int g16 = (lane >> 4) & 1, qq = (lane & 15) >> 2, pp = lane & 3;
    const int tri = (8 * hi + qq) * GP + (16 * g16 + 4 * pp) * 2;
    const int trv = (4 * hi + qq) * GP + (16 * g16 + 4 * pp) * 2;
#pragma unroll
    for (int dir = 0; dir < 2; ++dir) {
        GlaCum C; gla_cum(P, row0, hh, dir, a_up, a_bias, lane, C);
#pragma unroll
        for (int tt = 0; tt < 2; ++tt) {
            float cum[16];
#pragma unroll
            for (int r = 0; r < 16; ++r) cum[r] = C.cum[tt][r];
#pragma unroll
            for (int g = 0; g < 4; ++g) {
                float xq[4], xk[4];
#pragma unroll
                for (int e = 0; e < 4; ++e) { const unsigned qw = qp[tt][2 * g + (e >> 1)], kw = kp[tt][2 * g + (e >> 1)];
                    xq[e] = ((e & 1) ? bfhi(qw) : bflo(qw)) * 0.17677669529663687f * fexp(cum[4 * g + e]); xk[e] = ((e & 1) ? bfhi(kw) : bflo(kw)) * fexp(-cum[4 * g + e]); }
                v2u wq, wk; wq.x = pk2(xq[0], xq[1]); wq.y = pk2(xq[2], xq[3]); wk.x = pk2(xk[0], xk[1]); wk.y = pk2(xk[2], xk[3]);
                const int off = kk * GP + (32 * tt + 8 * g + 4 * hi) * 2;
                *(LAS v2u*)(wl + G_A + off) = wq; *(LAS v2u*)(wl + G_B + off) = wk;
            }
        }
        const float* sp = UST + ((size_t)((b * 4 + hh) * 2 + dir) * 36 + nc) * 2048;
        bf16x8 sf[2][2];
#pragma unroll
        for (int vb = 0; vb < 2; ++vb)
#pragma unroll
            for (int s = 0; s < 2; ++s) { const float* p = sp + (size_t)(32 * vb + kk) * 32 + 16 * s + 8 * hi; const f32x4 a = *(const f32x4*)p, c = *(const f32x4*)(p + 4);
                sf[vb][s] = pack8(a.x, a.y, a.z, a.w, c.x, c.y, c.z, c.w); }
#pragma unroll
        for (int it = 0; it < 2; ++it) {
            bf16x8 qf[2];
#pragma unroll
            for (int s = 0; s < 2; ++s) { LAS const unsigned char* p = wl + G_A + tri + 16 * s * GP + 64 * it; qf[s] = cat4(tr_read(p), tr_read(p + 4 * GP)); }
#pragma unroll
            for (int vb = 0; vb < 2; ++vb)
#pragma unroll
                for (int s = 0; s < 2; ++s) o[vb][it] = MFMA32(sf[vb][s], qf[s], o[vb][it]);
#pragma unroll
            for (int jt = 0; jt < 2; ++jt) {
                if (dir == 0 ? (jt > it) : (jt < it)) continue;
                f32x16 sc;
#pragma unroll
                for (int i = 0; i < 16; ++i) sc[i] = 0.f;
#pragma unroll
                for (int s = 0; s < 2; ++s) { LAS const unsigned char* p = wl + G_B + tri + 16 * s * GP + 64 * jt; const bf16x8 kf = cat4(tr_read(p), tr_read(p + 4 * GP)); sc = MFMA32(kf, qf[s], sc); }
                if (jt == it) {
#pragma unroll
                    for (int i = 0; i < 16; ++i) { const int j = crow(i, hi); const bool ok = dir == 0 ? (j <= kk) : (j >= kk); sc[i] = ok ? sc[i] : 0.f; }
                }
#pragma unroll
                for (int s2 = 0; s2 < 2; ++s2) {
                    const bf16x8 pf = pack8(sc[8 * s2 + 0], sc[8 * s2 + 1], sc[8 * s2 + 2], sc[8 * s2 + 3], sc[8 * s2 + 4], sc[8 * s2 + 5], sc[8 * s2 + 6], sc[8 * s2 + 7]);
                    LAS const unsigned char* vp = wl + G_V + trv + (32 * jt + 16 * s2) * GP;
                    const bf16x8 v0 = cat4(tr_read(vp), tr_read(vp + 8 * GP));
                    const bf16x8 v1 = cat4(tr_read(vp + 64), tr_read(vp + 8 * GP + 64));
                    o[0][it] = MFMA32(v0, pf, o[0][it]); o[1][it] = MFMA32(v1, pf, o[1][it]);
                }
                __builtin_amdgcn_sched_barrier(0);
            }
            __builtin_amdgcn_sched_barrier(0);
        }
    }
    v2u gwv[2][2][4]; f32x4 gnv[2][4];
#pragma unroll
    for (int vb = 0; vb < 2; ++vb)
#pragma unroll
        for (int g = 0; g < 4; ++g) { const int v = 32 * vb + 8 * g + 4 * hi; gnv[vb][g] = *(const f32x4*)(gnorm + v);
#pragma unroll
            for (int it = 0; it < 2; ++it) gwv[it][vb][g] = *(const v2u*)(P + (size_t)(row0 + 32 * it + kk) * PP + C_GG + hh * 64 + v); }
    asm volatile("" ::: "memory");
#pragma unroll
    for (int it = 0; it < 2; ++it) {
        float ss = 0.f;
#pragma unroll
        for (int vb = 0; vb < 2; ++vb)
#pragma unroll
            for (int i = 0; i < 16; ++i) ss += o[vb][it][i] * o[vb][it][i];
        ss = x32_sum(ss);
        const float rstd = __builtin_amdgcn_rsqf(ss * (1.f / 64.f) + NEPS);
        const size_t row = (size_t)(row0 + 32 * it + kk);
#pragma unroll
        for (int vb = 0; vb < 2; ++vb)
#pragma unroll
            for (int g = 0; g < 4; ++g) { const int v = 32 * vb + 8 * g + 4 * hi;
                const f32x4 gn = gnv[vb][g]; const v2u gw = gwv[it][vb][g];
                const float g0 = bflo(gw.x), g1 = bfhi(gw.x), g2 = bflo(gw.y), g3 = bfhi(gw.y);
                v2u w; w.x = pk2(o[vb][it][4 * g] * rstd * gn.x * silu_f(g0), o[vb][it][4 * g + 1] * rstd * gn.y * silu_f(g1));
                w.y = pk2(o[vb][it][4 * g + 2] * rstd * gn.z * silu_f(g2), o[vb][it][4 * g + 3] * rstd * gn.w * silu_f(g3));
                *(v2u*)(MIX + row * 1024 + hh * 64 + v) = w; }
    }
}
constexpr int RTP = 1028;
__device__ __forceinline__ void r1_fill_rt(const float* const* in, LAS unsigned char* lds, int l, int t0, int nthr) {
    const float* wr = in[14] + (size_t)l * 1024 * 16; LAS float* RT = (LAS float*)lds + 6144;
    for (int q0 = t0; q0 < 4096; q0 += 10 * nthr) {
        f32x4 w[10];
#pragma unroll
        for (int k = 0; k < 10; ++k) { const int q = q0 + k * nthr; w[k] = *(const f32x4*)(wr + 4 * (q < 4096 ? q : 4095)); }
        asm volatile("" ::: "memory");
#pragma unroll
        for (int k = 0; k < 10; ++k) { const int q = q0 + k * nthr; if (q < 4096) { const int d = q >> 2, e = 4 * (q & 3); RT[e * RTP + d] = w[k].x; RT[(e + 1) * RTP + d] = w[k].y; RT[(e + 2) * RTP + d] = w[k].z; RT[(e + 3) * RTP + d] = w[k].w; } }
    }
}
__device__ __forceinline__ void r1_fill_vec(const float* const* in, const unsigned char* ws, LAS unsigned char* lds, int l, int t, int t0, int nthr) {
    const float* gains = in[6] + (size_t)l * 4096; const float* mod = (const float*)(ws + WS_MOD) + (size_t)l * 9 * 6144; LAS float* V = (LAS float*)lds; const int b = t >> 5;
    for (int n = t0; n < 1024; n += nthr) { const float gpa = gains[1024 + n], gpf = gains[2048 + n];
        const float m0 = mod[b * 6144 + 2048 + n], m1 = mod[b * 6144 + 4096 + n], m2 = mod[b * 6144 + 3072 + n], m3 = mod[8 * 6144 + 2048 + n], m4 = mod[8 * 6144 + 4096 + n], m5 = mod[8 * 6144 + 3072 + n];
        asm volatile("" ::: "memory");
        V[n] = gpa * m0; V[1024 + n] = gpf * (1.f + m1); V[2048 + n] = m2; V[3072 + n] = gpa * m3; V[4096 + n] = gpf * (1.f + m4); V[5120 + n] = m5; }
}
__device__ __forceinline__ void phase_r1(const float* const* in, float* xout, unsigned char* ws, LAS unsigned char* lds, int l, bool upd, int G, int tid, int wave, int lane, bool dry, bool pre_done) {
    const float* x0 = in[0]; const float* ctx0 = in[2];
    const bf16_t* Y = (const bf16_t*)(ws + WS_R2 + (size_t)MT * 2048); bf16_t* H = (bf16_t*)(ws + WS_H); bf16_t* XB = (bf16_t*)(ws + WS_XB);
    float* AFF = (float*)(ws + WS_AFF); float* AFFC = (float*)(ws + WS_AFFC);
    LAS float* V = (LAS float*)lds;
    LAS float* RT = V + 6144;
    if (!pre_done) { __syncthreads(); r1_fill_rt(in, lds, l, tid, 512); }
    for (int t = blockIdx.x; t < 256; t += G) {
        if (!(pre_done && t == (int)blockIdx.x)) { __syncthreads(); r1_fill_vec(in, ws, lds, l, t, tid, 512); __syncthreads(); }
        const int nrows = upd ? 9 : 8;
#pragma unroll 1
        for (int i0 = 0; i0 < 9; i0 += 3) {
            f32x4 yv[3][4], xq[3][4];
#pragma unroll
            for (int k = 0; k < 3; ++k) { const int i = (i0 + k < nrows) ? (i0 + k) : 7;
                const bool isc = (i == 8); const int row = isc ? (ML + 8 * t + wave) : (64 * t + 8 * wave + i);
                ld_row_bf16_nt(Y + (size_t)row * 1024, lane, yv[k]);
                if (l == 0) ld_row_f32_nt(isc ? (ctx0 + (size_t)(8 * t + wave) * 1024) : (x0 + (size_t)row * 1024), lane, xq[k]); else ld_row_bf16_nt(XB + (size_t)row * 1024, lane, xq[k]); }
#pragma unroll
            for (int k = 0; k < 3; ++k) { const bool act = (i0 + k < nrows); const int i = act ? (i0 + k) : 7;
            const bool isc = (i == 8);
            const int row = isc ? (ML + 8 * t + wave) : (64 * t + 8 * wave + i);
            bf16_t* xd = (dry ? (bf16_t*)(ws + WS_R1) : XB) + (size_t)row * 1024;
            LAS const float* vv = V + (isc ? 3072 : 0);
            f32x4 (&y)[4] = yv[k]; f32x4 (&xv)[4] = xq[k]; f32x4 a[4];
            const float rsy = __builtin_amdgcn_rsqf(wave_sum(sumsq16(y)) * (1.f / 1024.f) + NEPS);
            ld_vec_lds(vv, lane, a);
#pragma unroll
            for (int j = 0; j < 4; ++j) xv[j] = xv[j] + a[j] * (y[j] * rsy);
            if (act) st_row_bf16_nt(xd, lane, xv);
            const float rs1 = __builtin_amdgcn_rsqf(wave_sum(sumsq16(xv)) * (1.f / 1024.f) + NEPS);
            f32x4 s[4]; ld_vec_lds(vv + 1024, lane, a); ld_vec_lds(vv + 2048, lane, s);
#pragma unroll
            for (int j = 0; j < 4; ++j) xv[j] = xv[j] * rs1 * a[j] + s[j];
            if (act) st_row_bf16((dry ? (bf16_t*)(ws + WS_R2) : H) + (size_t)row * 1024, lane, xv);
            }
            float lg3[3][16];
#pragma unroll
            for (int e = 0; e < 16; ++e) { f32x2 pa[3];
#pragma unroll
                for (int k = 0; k < 3; ++k) pa[k] = (f32x2){0.f, 0.f};
#pragma unroll
                for (int j = 0; j < 4; ++j) { const f32x4 w = *(LAS const f32x4*)(RT + e * RTP + 256 * j + 4 * lane); const f32x2 wl = {w.x, w.y}, wh = {w.z, w.w};
#pragma unroll
                    for (int k = 0; k < 3; ++k) { pa[k] += (f32x2){xq[k][j].x, xq[k][j].y} * wl; pa[k] += (f32x2){xq[k][j].z, xq[k][j].w} * wh; } }
#pragma unroll
                for (int k = 0; k < 3; ++k) lg3[k][e] = pa[k].x + pa[k].y;
                asm volatile("" : "+v"(lg3[0][e]), "+v"(lg3[1][e]), "+v"(lg3[2][e]));
                if ((e & 3) == 3) asm volatile("" ::: "memory"); }
#pragma unroll
            for (int k = 0; k < 3; ++k) { const bool act = (i0 + k < nrows); const int i = i0 + k; {
            const bool isc = (i == 8);
            const int row = isc ? (ML + 8 * t + wave) : (64 * t + 8 * wave + i);
            float (&lg)[16] = lg3[k];
#pragma unroll
            for (int i2 = 0; i2 < 8; ++i2) lg[i2] = pair32_sum(lg[i2], lg[i2 + 8]);
#pragma unroll
            for (int i2 = 0; i2 < 4; ++i2) lg[i2] = pair16_sum(lg[i2], lg[i2 + 4]);
#pragma unroll
            for (int i2 = 0; i2 < 2; ++i2) { const bool up = (lane & 8) != 0; const float keep = up ? lg[i2 + 2] : lg[i2], send = up ? lg[i2] : lg[i2 + 2]; lg[i2] = keep + dppf<0x128>(send); }
            { const bool up = (lane & 4) != 0; const float keep = up ? lg[1] : lg[0], send = up ? lg[0] : lg[1];
              int pw = __builtin_amdgcn_update_dpp(0, (int)__float_as_uint(send), 0x104, 0xf, 0x5, false); pw = __builtin_amdgcn_update_dpp(pw, (int)__float_as_uint(send), 0x114, 0xf, 0xa, false);
              lg[0] = keep + __uint_as_float((unsigned)pw); }
            float lgt = lg[0]; lgt += dppf<0xB1>(lgt); lgt += dppf<0x4E>(lgt);
            const int ex = ((lane >> 5) & 1) * 8 + ((lane >> 4) & 1) * 4 + ((lane >> 3) & 1) * 2 + ((lane >> 2) & 1);
            float mx = lgt;
            mx = fmaxf(mx, dppf<0x141>(mx)); mx = fmaxf(mx, dppf<0x140>(mx)); mx = x16_max(mx); mx = x32_max(mx);
            const float pe = fexp(lgt - mx);
            float den = pe; den += dppf<0x141>(den); den += dppf<0x140>(den); den = x16_sum(den); den = x32_sum(den);
            const float mine = pe / den;
            if ((lane & 3) == 0 && act) {
                if (isc) { const int cr = 8 * t + wave; AFFC[((size_t)(cr >> 8) * 16 + ex) * 256 + (cr & 255)] = mine; }
                else AFF[((size_t)(row >> 11) * 16 + ex) * 2048 + (row & 2047)] = mine;
            }
            } }
        }
    }
}

template <bool CTX>
__device__ __forceinline__ void topk_wave(unsigned char* ws, int item, int lane) {
    constexpr int NT = CTX ? 256 : 2048, CAP = CTX ? 32 : 256, PER = NT / 64;
    const int e = item & 15, b = item >> 4;
    const float* arow = (const float*)(ws + (CTX ? WS_AFFC : WS_AFF)) + (size_t)(b * 16 + e) * NT;
    float* gate = (float*)(ws + (CTX ? WS_GATEC : WS_GATE)) + (size_t)(b * 16 + e) * CAP;
    short* INV = (short*)(ws + WS_INV);
    int* rowidx = (int*)(ws + WS_ROWIDX) + (CTX ? ((128 + e) * 256 + b * 32) : ((b * 16 + e) * 256));
    unsigned v[PER];
#pragma unroll
    for (int i = 0; i < PER / 4; ++i) { const v4u q = *(const v4u*)(arow + lane * PER + 4 * i); v[4 * i] = q.x; v[4 * i + 1] = q.y; v[4 * i + 2] = q.z; v[4 * i + 3] = q.w; }
    unsigned T = 0;
    for (int bit = 29; bit >= 0; --bit) {
        const unsigned cand = T | (1u << bit); int c = 0;
#pragma unroll
        for (int i = 0; i < PER; ++i) c += __popcll(__ballot(v[i] >= cand));
        if (c >= CAP) T = cand;
    }
    int ngt = 0, cg = 0, ce = 0;
#pragma unroll
    for (int i = 0; i < PER; ++i) { ngt += __popcll(__ballot(v[i] > T)); cg += (v[i] > T) ? 1 : 0; ce += (v[i] == T) ? 1 : 0; }
    const int need = CAP - ngt;
    int pg = cg, pe = ce;
#pragma unroll
    for (int d = 1; d < 64; d <<= 1) { const int tg = __shfl_up(pg, d), te = __shfl_up(pe, d); if (lane >= d) { pg += tg; pe += te; } }
    pg -= cg; pe -= ce;
#pragma unroll
    for (int i = 0; i < PER; ++i) {
        const bool gt = v[i] > T, eq = v[i] == T;
        const bool sel = gt || (eq && pe < need);
        const int slot = pg + (pe < need ? pe : need);
        const int tok = lane * PER + i, grow = CTX ? (ML + b * CTXL + tok) : (b * SEQ + tok);
        if (sel) { rowidx[slot] = grow; gate[slot] = __uint_as_float(v[i]); }
        INV[(size_t)grow * 16 + e] = sel ? (short)slot : (short)-1;
        pg += gt ? 1 : 0; pe += eq ? 1 : 0;
    }
}

__device__ __forceinline__ void topk_wg2(unsigned char* ws, int item, LAS unsigned char* lds, int tid, int wave, int lane) {
    constexpr int CAP = 256;
    const int e = item & 15, b = item >> 4;
    const float* arow = (const float*)(ws + WS_AFF) + (size_t)(b * 16 + e) * 2048;
    float* gate = (float*)(ws + WS_GATE) + (size_t)(b * 16 + e) * CAP;
    short* INV = (short*)(ws + WS_INV);
    int* rowidx = (int*)(ws + WS_ROWIDX) + (b * 16 + e) * 256;
    LAS int* cnt = (LAS int*)lds;
    const v4u q = *(const v4u*)(arow + 4 * tid);
    const unsigned v[4] = {q.x, q.y, q.z, q.w};
    unsigned T = 0;
    __syncthreads();
    for (int bit = 29; bit >= 0; --bit) {
        const unsigned cand = T | (1u << bit); int c = 0;
#pragma unroll
        for (int i = 0; i < 4; ++i) c += __popcll(__ballot(v[i] >= cand));
        LAS int* cb = cnt + (bit & 1) * 8;
        if (lane == 0) cb[wave] = c;
        __syncthreads();
        int tot = 0;
#pragma unroll
        for (int w = 0; w < 8; ++w) tot += cb[w];
        if (tot >= CAP) T = cand;
    }
    int cg = 0, ce = 0, wg_ = 0, we_ = 0;
#pragma unroll
    for (int i = 0; i < 4; ++i) { wg_ += __popcll(__ballot(v[i] > T)); we_ += __popcll(__ballot(v[i] == T)); cg += (v[i] > T) ? 1 : 0; ce += (v[i] == T) ? 1 : 0; }
    if (lane == 0) { cnt[16 + wave] = wg_; cnt[24 + wave] = we_; }
    int pg = cg, pe = ce;
#pragma unroll
    for (int d = 1; d < 64; d <<= 1) { const int tg = __shfl_up(pg, d), te = __shfl_up(pe, d); if (lane >= d) { pg += tg; pe += te; } }
    pg -= cg; pe -= ce;
    __syncthreads();
    int ngt = 0;
#pragma unroll
    for (int w = 0; w < 8; ++w) { const int g_ = cnt[16 + w], e_ = cnt[24 + w]; ngt += g_; if (w < wave) { pg += g_; pe += e_; } }
    const int need = CAP - ngt;
#pragma unroll
    for (int i = 0; i < 4; ++i) {
        const bool gt = v[i] > T, eq = v[i] == T;
        const bool sel = gt || (eq && pe < need);
        const int slot = pg + (pe < need ? pe : need);
        const int grow = b * SEQ + 4 * tid + i;
        if (sel) { rowidx[slot] = grow; gate[slot] = __uint_as_float(v[i]); }
        INV[(size_t)grow * 16 + e] = sel ? (short)slot : (short)-1;
        pg += gt ? 1 : 0; pe += eq ? 1 : 0;
    }
}

__device__ __forceinline__ void r5_fill(const float* const* in, const unsigned char* ws, LAS unsigned char* lds, int l, bool upd, int t, int t0, int nthr) {
    const float* gains = in[6]; const float* mod = (const float*)(ws + WS_MOD);
    const float* GATE = (const float*)(ws + WS_GATE); const float* GATEC = (const float*)(ws + WS_GATEC); const short* INV = (const short*)(ws + WS_INV);
    LAS float* V = (LAS float*)lds; LAS int* CL = (LAS int*)(lds + 24576); const int b = t >> 5;
    for (int n = t0; n < 1024; n += nthr) { const float gpf = gains[(size_t)l * 4096 + 3072 + n];
        const float m0 = mod[((size_t)l * 9 + b) * 6144 + 5120 + n], m1 = mod[((size_t)l * 9 + 8) * 6144 + 5120 + n];
        const float gna = gains[4096 + n], m2 = mod[((size_t)9 + b) * 6144 + 1024 + n], m3 = mod[((size_t)9 + b) * 6144 + n], m4 = mod[((size_t)9 + 8) * 6144 + 1024 + n], m5 = mod[((size_t)9 + 8) * 6144 + n];
        asm volatile("" ::: "memory");
        V[n] = gpf * m0; V[3072 + n] = gpf * m1;
        if (l == 0) { V[1024 + n] = gna * (1.f + m2); V[2048 + n] = m3; V[4096 + n] = gna * (1.f + m4); V[5120 + n] = m5; } }
    if (t0 < (upd ? 72 : 64)) {
        const bool isc = t0 >= 64; const int cr = 8 * t + (t0 - 64);
        const int row = isc ? (ML + cr) : (64 * t + t0); const int bb = isc ? (cr >> 8) : b;
        const v4u i0 = *(const v4u*)(INV + (size_t)row * 16), i1 = *(const v4u*)(INV + (size_t)row * 16 + 8);
        const unsigned iw[8] = {i0.x, i0.y, i0.z, i0.w, i1.x, i1.y, i1.z, i1.w};
        float gv[16]; int sl[16];
#pragma unroll
        for (int e = 0; e < 16; ++e) { sl[e] = (int)(short)((iw[e >> 1] >> (16 * (e & 1))) & 0xffffu); const int s0 = sl[e] < 0 ? 0 : sl[e];
            gv[e] = isc ? GATEC[(size_t)(bb * 16 + e) * 32 + s0] : GATE[(size_t)(bb * 16 + e) * 256 + s0]; }
        int cnt = 0; LAS int* cl = CL + t0 * 33;
#pragma unroll
        for (int e = 0; e < 16; ++e) if (sl[e] >= 0) { cl[1 + 2 * cnt] = isc ? ((128 + e) * 256 + bb * 32 + sl[e]) : ((bb * 16 + e) * 256 + sl[e]); cl[2 + 2 * cnt] = (int)__float_as_uint(gv[e]); ++cnt; }
        cl[0] = cnt;
    }
}
__device__ __forceinline__ void phase_r5(const float* const* in, float* xout, unsigned char* ws, LAS unsigned char* lds, int l, bool upd, int G, int tid, int wave, int lane, bool dry, bool pre_done) {
    const bf16_t* YE = (const bf16_t*)(ws + WS_R1); bf16_t* H = (bf16_t*)(ws + WS_H); bf16_t* XB = (bf16_t*)(ws + WS_XB);
    LAS float* V = (LAS float*)lds;
    LAS int* CL = (LAS int*)(lds + 24576);
    for (int t = blockIdx.x; t < 256; t += G) {
        if (!(pre_done && t == (int)blockIdx.x)) { __syncthreads(); r5_fill(in, ws, lds, l, upd, t, tid, 512); __syncthreads(); }
        const int nrows = upd ? 9 : 8;
#pragma unroll 1
        for (int i0 = 0; i0 < 9; i0 += 3) {
            f32x4 xq[3][4];
#pragma unroll
            for (int k = 0; k < 3; ++k) { const int i = i0 + k; if (i < nrows) { const bool isc = (i == 8);
                ld_row_bf16_nt(XB + (size_t)(isc ? (ML + 8 * t + wave) : (64 * t + 8 * wave + i)) * 1024, lane, xq[k]); } }
#pragma unroll
            for (int k = 0; k < 3; ++k) { const int i = i0 + k; if (i < nrows) {
            const bool isc = (i == 8);
            const int row = isc ? (ML + 8 * t + wave) : (64 * t + 8 * wave + i);
            LAS const float* vv = V + (isc ? 3072 : 0);
            LAS const int* cl = CL + (isc ? (64 + wave) : (8 * wave + i)) * 33;
            const int n = __builtin_amdgcn_readfirstlane(cl[0]);
            f32x4 acc[4];
#pragma unroll
            for (int j = 0; j < 4; ++j) acc[j] = (f32x4){0.f, 0.f, 0.f, 0.f};
            for (int j0 = 0; j0 < n; j0 += 4) {
                v2u raw[4][4]; float g[4];
#pragma unroll
                for (int q = 0; q < 4; ++q) {
                    if (j0 + q < n) { const int yr = __builtin_amdgcn_readfirstlane(cl[1 + 2 * (j0 + q)]); g[q] = __uint_as_float((unsigned)__builtin_amdgcn_readfirstlane(cl[2 + 2 * (j0 + q)]));
                        const bf16_t* yp = YE + (size_t)yr * 1024;
#pragma unroll
                        for (int j = 0; j < 4; ++j) raw[q][j] = __builtin_nontemporal_load((const v2u*)(yp + 256 * j + 4 * lane)); }
                    else { g[q] = 0.f;
#pragma unroll
                        for (int j = 0; j < 4; ++j) raw[q][j] = (v2u){0u, 0u}; }
                }
#pragma unroll
                for (int q = 0; q < 4; ++q)
#pragma unroll
                    for (int j = 0; j < 4; ++j) acc[j] += (f32x4){bflo(raw[q][j].x), bfhi(raw[q][j].x), bflo(raw[q][j].y), bfhi(raw[q][j].y)} * g[q];
            }
            const float rsm = __builtin_amdgcn_rsqf(wave_sum(sumsq16(acc)) * (1.f / 1024.f) + NEPS);
            f32x4 (&xv)[4] = xq[k]; f32x4 a[4]; ld_vec_lds(vv, lane, a);
#pragma unroll
            for (int j = 0; j < 4; ++j) xv[j] = xv[j] + a[j] * (acc[j] * rsm);
            if (l == 0) st_row_bf16_nt((dry ? (bf16_t*)(ws + WS_R2) : XB) + (size_t)row * 1024, lane, xv);
            else st_row_f32_nt((dry ? (float*)(ws + WS_R2) : xout) + (size_t)row * 1024, lane, xv);
            if (l == 0 && !dry) {
                const float rs2 = __builtin_amdgcn_rsqf(wave_sum(sumsq16(xv)) * (1.f / 1024.f) + NEPS);
                f32x4 s[4]; ld_vec_lds(vv + 1024, lane, a); ld_vec_lds(vv + 2048, lane, s);
#pragma unroll
                for (int j = 0; j < 4; ++j) xv[j] = xv[j] * rs2 * a[j] + s[j];
                st_row_bf16(H + (size_t)row * 1024, lane, xv);
            }
            } }
        }
    }
}
#ifndef MK_PER_PHASE
#define MK_PER_PHASE 0
#endif
constexpr int N_PHASES = 22;
struct Args { const float* in[18]; float* out; unsigned char* ws; int ph_lo, ph_hi; };
__device__ __forceinline__ const Args* kargs_opaque() {
    auto p = __builtin_amdgcn_kernarg_segment_ptr(); asm volatile("" : "+s"(p)); return (const Args*)p; }
#define PHASE_REGS() int tid = threadIdx.x; asm volatile("" : "+v"(tid)); const int lane = tid & 63, wave = __builtin_amdgcn_readfirstlane(tid >> 6); \
    const Args* A = kargs_opaque(); unsigned char* ws = A->ws; const int G = gridDim.x, bx = blockIdx.x; \
    const int vcu = (G % 8 == 0) ? (bx % 8) * (G / 8) + bx / 8 : bx; const int gw = vcu * NWAVES + wave, NGW = G * NWAVES; \
    LAS unsigned char* wl = lds + wave * WAVE_LDS; (void)gw; (void)NGW; (void)wl; (void)lane; (void)ws
#ifndef CONV_BUDGET
#define CONV_BUDGET 1
#endif
#ifndef PH_MASK
#define PH_MASK 0xFFFFFFFFu
#endif
#define EN(j) (((PH_MASK) >> (j)) & 1u)
#ifndef REP_MASK
#define REP_MASK 0u
#endif
#define REPS(j) ((((REP_MASK) >> (j)) & 1u) ? 2 : 1)
__global__ void __launch_bounds__(NWAVES * 64, 2) fwd_kernel(Args args) {
    extern __shared__ __attribute__((aligned(16))) unsigned char lds_raw[];
    LAS unsigned char* lds = (LAS unsigned char*)lds_raw;
    volatile LAS unsigned* MISC = (volatile LAS unsigned*)(lds + MISC_OFF);
    for (int u = threadIdx.x; u < (LDS_BYTES - LDSCTL_OFF) / 4; u += NWAVES * 64) ((LAS unsigned*)(lds + LDSCTL_OFF))[u] = 0u;
    __syncthreads();
    const int lo = args.ph_lo, hi = args.ph_hi;
    XcdBarrier bar; bar.bar = (unsigned*)(args.ws + WS_CTL) + CW_BAR; bar.x = 0; bar.st = nullptr;
    if (hi - lo > 1) bar = xcd_barrier_post((unsigned*)(args.ws + WS_CTL) + CW_BAR, MISC + 8);
#define IN(k) (lo <= (k) && (k) < hi)
#ifdef STAMP_A
#define STAMP(k) do { if (blockIdx.x == 0 && threadIdx.x == 0) ((unsigned long long*)(args.ws + WS_CTL))[1536 + (k)] = __builtin_amdgcn_s_memrealtime(); } while (0)
#else
#define STAMP(k) do { } while (0)
#endif
#define SEAM(k) do { if (IN((k) + 1)) { xcd_barrier(bar); if (REPS(12) == 2) xcd_barrier(bar); } STAMP((k) + 1); } while (0)
#define SEAM_OV(k, WORK) do { if (IN((k) + 1)) { const Args* A_ = kargs_opaque(); unsigned char* ws_ = A_->ws; (void)ws_; \
        xcd_barrier_overlap(bar, [&](int t0, int nthr) { if (blockIdx.x < 256) { WORK; } }); if (REPS(12) == 2) xcd_barrier(bar); pre = (blockIdx.x < 256); } STAMP((k) + 1); } while (0)
#define SEAM_CVX(k, on, idbase) do { if (IN((k) + 1)) { if ((on) && gridDim.x == 256) { const unsigned xq_ = bar.x; \
            xcd_barrier_work(bar, BC_RK, [&](int rank, int w, int ln) { const Args* A_ = kargs_opaque(); tr_one(A_->in, A_->ws, (idbase) + ((int)xq_ * BC_RK + rank) * 7 + w, (LAS float*)(lds + (w + 1) * WAVE_LDS), ln); }); } \
        else xcd_barrier(bar); if (REPS(12) == 2) xcd_barrier(bar); } STAMP((k) + 1); } while (0)
#define SEAM_CV(k, j) SEAM_CVX(k, (j) < BC_N0, BC_L0 + (j) * BC_T)
    STAMP(0);
    if (EN(0) && IN(0)) { for (int rep = 0; rep < REPS(0); ++rep) { PHASE_REGS(); phase_p0(A->in, ws, wl, gw, NGW, lane, vcu, wave); } SEAM(0); }
    if (EN(1) && IN(1)) { for (int rep = 0; rep < REPS(1); ++rep) { PHASE_REGS(); phase_a0(A->in, ws, lds, G, tid, wave, lane); } SEAM_CV(1, 0); }
    for (int l = 0; l < 2; ++l) {
        const int base = 2 + 10 * l; const bool upd = (l == 0); bool pre = false;
        if (EN(2) && IN(base + 0)) { for (int rep = 0; rep < REPS(2); ++rep) {
            PHASE_REGS();
            pg8::Gemm g{(const bf16_t*)(ws + WS_H), (const bf16_t*)(ws + WS_WIN) + (size_t)l * PP * 1024, MT, PP, 1024}; pg8::StaticOrder S; S.init(MT, PP, G, bx);
            { const pg8::f32x2* tg = (const pg8::f32x2*)(ws + WS_TAB); LAS pg8::f32x2* tl = (LAS pg8::f32x2*)(lds + pg8::STAGE_BYTES);
              for (int i = tid; i < 1024; i += NWAVES * 64) tl[i] = tg[i];
              __syncthreads(); }
            pg8::EpiProj E{(bf16_t*)(ws + WS_R1), PP, (const PG8_LAS pg8::f32x2*)(lds + pg8::STAGE_BYTES), ML};
            pg8::gemm_phase<pg8::EpiProj, pg8::StaticOrder, true, true>(lds, g, S, E);
            if (upd && CV_G1 > 0 && G == 256 && bx >= 208 && !(rep + 1 < REPS(2))) tr_stream(A->in, ws, P0_A + (bx - 208) * NWAVES + wave, 384, P0_A + CV_N1, (LAS float*)wl, lane);
            if (!CONV_IN_P0) { const int nwg_ = (MT / 256) * (PP / 256); if ((nwg_ - bx + G - 1) / G < (nwg_ + G - 1) / G) conv_pull(A->in, ws, l, 1, 12 * CONV_BUDGET, (LAS float*)wl, lane); }
            }
            if (upd) SEAM_CV(base + 0, 1); else SEAM_CVX(base + 0, 2 < BC_N1, BC_L1 + 2 * BC_T);
        }
        if (EN(3) && IN(base + 1)) { for (int rep = 0; rep < REPS(3); ++rep) {
            PHASE_REGS();
            const bf16_t* PROJ = (const bf16_t*)(ws + WS_R1); bf16_t* MIX = (bf16_t*)(ws + WS_R2);
            const float* a_up = A->in[9] + (size_t)l * 2 * 16 * 128; const float* a_bias = A->in[10] + (size_t)l * 2 * 128;
            const float* rpb = A->in[12] + (size_t)l * 4 * 465; const float* sink = A->in[13] + (size_t)l * 8;
            const int n_cn = upd ? 128 : 0, n_cs = upd ? 256 : 0;
            const bool xmap = (G == 256);
            const int xcd = bx & 7, cu = bx >> 3;
            const int n_att = xmap ? 12 : 0;
            const int tail_total = (xmap ? 0 : 1024 + 2048) + 1152 + n_cn + n_cs;
            volatile LAS unsigned* qctr = (volatile LAS unsigned*)(lds + MISC_OFF) + 16 + l * 2 + rep;
            const int n_conv = 0, n_mix = (n_conv + 2) / 3 * 4;
            if (CV_M1 > 0 && upd && G == 256 && wave == 7 && !(rep + 1 < REPS(3))) tr_stream(A->in, ws, P0_A + CV_N1 + bx, 256, P0_A + CV_N1 + 256 * CV_M1, (LAS float*)wl, lane);
            for (;;) {
                int j = 0; if (lane == 0) j = (int)__hip_atomic_fetch_add((LAS unsigned*)qctr, 1u, __ATOMIC_RELAXED, __HIP_MEMORY_SCOPE_WORKGROUP);
                j = __builtin_amdgcn_readfirstlane(j);
                if (j < n_mix) {
                    if ((j & 3) != 3) { const int ci = (j >> 2) * 3 + (j & 3), r = ci * G + bx; if (ci < n_conv && r < 12288 && !(rep + 1 < REPS(3))) expert_conv_item(A->in, ws, l, r, (LAS float*)wl, lane); continue; }
                    j = j >> 2;
                } else j = j - n_mix + n_mix / 4;
                int mode, item;
                if (j < n_att) {
                    if (j < 4) { mode = 0; item = (xcd * 4 + j) * 32 + cu; }
                    else { const int jj = j - 4, group = xcd * 2 + (jj >> 2), i = cu * 4 + (jj & 3); const int bb = group >> 1, hp = (group & 1) * 2 + (i >> 6); mode = 1; item = (i & 63) + 64 * hp + 256 * bb; }
                } else {
                    int r = (j - n_att) * G + bx;
                    if (r >= tail_total) break;
                    mode = -1; item = 0;
                    if (!xmap) { if (r < 1024) { mode = 0; item = r; } else if (r < 3072) { mode = 1; item = r - 1024; } r -= 3072; }
                    if (mode < 0) {
                        if (r < 1152) { if (rep + 1 < REPS(3)) continue; gla_local_item(PROJ, (float*)(ws + WS_UST), (float*)(ws + WS_DEC), r, wl, lane, a_up, a_bias); continue; } r -= 1152;
                        if (r < n_cs) { mode = 3; item = r; } else { mode = 2; item = r - n_cs; }
                    }
                }
                attn_item(mode, PROJ, MIX, item, wl, lane, rpb, sink, rep + 1 < REPS(3));
            }
            }
            if (upd) SEAM_CV(base + 1, 2); else SEAM_CVX(base + 1, 3 < BC_N1, BC_L1 + 3 * BC_T);
        }
        if (EN(4) && IN(base + 2)) { for (int rep = 0; rep < REPS(4); ++rep) {
            PHASE_REGS();
            for (int gid = bx * (NWAVES * 64) + tid; gid < 64 * 2048; gid += G * NWAVES * 64) gla_prefix((float*)(ws + WS_UST), (const float*)(ws + WS_DEC), gid, rep + 1 < REPS(4));
            }
            if (upd) SEAM_CV(base + 2, 3); else SEAM_CVX(base + 2, 4 < BC_N1, BC_L1 + 4 * BC_T);
        }
        if (EN(5) && IN(base + 3)) { for (int rep = 0; rep < REPS(5); ++rep) {
            PHASE_REGS();
            const float* a_up = A->in[9] + (size_t)l * 2 * 16 * 128; const float* a_bias = A->in[10] + (size_t)l * 2 * 128; const float* gnorm = A->in[11] + (size_t)l * 64;
            const int slot = (G == 256) ? wave * 256 + vcu : gw;
            for (int it = slot; it < 1152; it += NGW) { if (!upd && (it % 36) < 4) continue;
                gla_out_item((const bf16_t*)(ws + WS_R1), (const float*)(ws + WS_UST), (bf16_t*)(ws + WS_R2), it, wl, lane, a_up, a_bias, gnorm); }
            if (upd && G == 256 && slot >= 1152 && !(rep + 1 < REPS(5))) tr_stream(A->in, ws, TR_ALL - CONV_M3 + (slot - 1152), NGW - 1152, TR_ALL, (LAS float*)wl, lane);
            }
            if (upd) SEAM_CV(base + 3, 4); else SEAM(base + 3);
        }
        if (EN(6) && IN(base + 4)) { for (int rep = 0; rep < REPS(6); ++rep) {
            PHASE_REGS();
            const int M2 = upd ? MT : ML;
            pg8::Gemm g{(const bf16_t*)(ws + WS_R2), (const bf16_t*)(ws + WS_WOUT) + (size_t)l * 1024 * 1024, M2, 1024, 1024}; pg8::StaticOrder S; S.init(M2, 1024, G, bx);
            pg8::EpiStore E{(bf16_t*)(ws + WS_R2 + (size_t)MT * 2048), 1024};
            pg8::gemm_phase<pg8::EpiStore, pg8::StaticOrder, true, true>(lds, g, S, E);
            if (upd && CV_G2 > 0 && G == 256 && bx >= 32 && !(rep + 1 < REPS(6))) tr_stream(A->in, ws, P0_A + CV_N1 + 256 * CV_M1 + (bx - 32) * NWAVES + wave, 1792, (MISC[10] == 1u) ? BC_L0 : TR_L, (LAS float*)wl, lane);
            if (!CONV_IN_P0) { const int nwg_ = (M2 / 256) * 4; if ((nwg_ - bx + G - 1) / G < (nwg_ + G - 1) / G) conv_pull(A->in, ws, l, 1, 3 * CONV_BUDGET, (LAS float*)wl, lane); }
            }
            SEAM_OV(base + 4, (r1_fill_rt(A_->in, lds, l, t0, nthr), r1_fill_vec(A_->in, ws_, lds, l, (int)blockIdx.x, t0, nthr)));
        }
        if (EN(7) && IN(base + 5)) { for (int rep = 0; rep < REPS(7); ++rep) { PHASE_REGS(); phase_r1(A->in, A->out, ws, lds, l, upd, G, tid, wave, lane, rep + 1 < REPS(7), pre); } pre = false; if (upd) SEAM_CV(base + 5, 5); else SEAM(base + 5); }
        if (EN(8) && IN(base + 6)) { for (int rep = 0; rep < REPS(8); ++rep) {
            PHASE_REGS();
            if (!CONV_IN_P0) conv_pull(A->in, ws, l, l, 1 << 30, (LAS float*)wl, lane);
            for (int it = bx; it < 128; it += G) topk_wg2(ws, it, lds, tid, wave, lane);
            if (upd) { const int w2 = (bx >= 128 ? bx - 128 : bx + G - 128) * NWAVES + wave; for (int it = w2; it < 128; it += NGW) topk_wave<true>(ws, it, lane); }
            }
            if (upd) SEAM_CV(base + 6, 6); else SEAM(base + 6);
        }
        if (EN(9) && IN(base + 7)) { for (int rep = 0; rep < REPS(9); ++rep) {
            PHASE_REGS();
            pg8::Gemm g{(const bf16_t*)(ws + WS_H), (const bf16_t*)(ws + WS_WGU) + (size_t)l * 16 * 2048 * 1024, 0, 0, 1024, (const int*)(ws + WS_ROWIDX)}; pg8::MoeOrder S; S.init(upd ? 9 : 8, 8, G, bx);
            pg8::EpiSwiGLU E{(bf16_t*)(ws + WS_R2), 1024};
            pg8::gemm_phase<pg8::EpiSwiGLU, pg8::MoeOrder, true, true, true>(lds, g, S, E);
            if (upd && CV_G3 > 0 && G == 256 && bx >= 128 && !(rep + 1 < REPS(9))) tr_stream(A->in, ws, P0_B + (bx - 128) * NWAVES + wave, 1024, P0_B + CV_N3, (LAS float*)wl, lane);
            if (!CONV_IN_P0) { const int nwg_ = 16 * (upd ? 9 : 8) * 8; if ((nwg_ - bx + G - 1) / G < (nwg_ + G - 1) / G) conv_pull(A->in, ws, l + 1, 1, 4 * CONV_BUDGET, (LAS float*)wl, lane); }
            }
            if (upd) SEAM_CVX(base + 7, 0 < BC_N1, BC_L1 + 0 * BC_T); else SEAM(base + 7);
        }
        if (EN(10) && IN(base + 8)) { for (int rep = 0; rep < REPS(10); ++rep) {
            PHASE_REGS();
            pg8::Gemm g{(const bf16_t*)(ws + WS_R2), (const bf16_t*)(ws + WS_WD) + (size_t)l * 16 * 1024 * 1024, 0, 0, 1024}; pg8::MoeOrder S; S.init(upd ? 9 : 8, 4, G, bx);
            pg8::EpiStore E{(bf16_t*)(ws + WS_R1), 1024};
            pg8::gemm_phase<pg8::EpiStore, pg8::MoeOrder, true, true>(lds, g, S, E);
            if (upd && CV_G4 > 0 && G == 256 && bx >= 64 && !(rep + 1 < REPS(10))) tr_stream(A->in, ws, P0_B + CV_N3 + (bx - 64) * NWAVES + wave, 1536, (MISC[10] == 1u) ? BC_L1 : P0_B + CV_N3 + CV_N4, (LAS float*)wl, lane);
            if (!CONV_IN_P0) { const int nwg_ = 16 * (upd ? 9 : 8) * 4; if ((nwg_ - bx + G - 1) / G < (nwg_ + G - 1) / G) conv_pull(A->in, ws, l + 1, 1, 3 * CONV_BUDGET, (LAS float*)wl, lane); }
            }
            SEAM_OV(base + 8, r5_fill(A_->in, ws_, lds, l, upd, (int)blockIdx.x, t0, nthr));
        }
        if (EN(11) && IN(base + 9)) { for (int rep = 0; rep < REPS(11); ++rep) { PHASE_REGS(); phase_r5(A->in, A->out, ws, lds, l, upd, G, tid, wave, lane, rep + 1 < REPS(11), pre); } pre = false; if (upd) SEAM_CVX(base + 9, 1 < BC_N1, BC_L1 + 1 * BC_T); else SEAM(base + 9); }
    }
#ifdef STAMP_A
    if (blockIdx.x == 0 && threadIdx.x == 0) { const unsigned long long* st_ = (const unsigned long long*)(args.ws + WS_CTL) + 1536; const float d_ = (float)(st_[STAMP_B] - st_[STAMP_A]); args.out[0] = 200.f * floorf(d_ / 200.f + 0.5f); }
#endif
#undef IN
#undef SEAM
}

extern "C" void kernel_launch(void* const* d_in, const int* in_sizes, int n_in, void* d_out, int out_size, void* d_ws, size_t ws_size, hipStream_t stream) {
    static int grid = 0;
    if (grid == 0) {
        if (n_in != 18 || out_size != ML * DM || ws_size < WS_END) { fprintf(stderr, "kernel_launch: unexpected sizes: n_in %d out %d ws %zu (need %zu)\n", n_in, out_size, ws_size, (size_t)WS_END); grid = -1; return; }
        int dev = 0, cus = 0, per_cu = 0;
        if (hipGetDevice(&dev) != hipSuccess || hipDeviceGetAttribute(&cus, hipDeviceAttributeMultiprocessorCount, dev) != hipSuccess) { grid = -1; return; }
        if (hipFuncSetAttribute((const void*)fwd_kernel, hipFuncAttributeMaxDynamicSharedMemorySize, LDS_BYTES) != hipSuccess) { fprintf(stderr, "kernel_launch: hipFuncSetAttribute failed\n"); grid = -1; return; }
        if (hipOccupancyMaxActiveBlocksPerMultiprocessor(&per_cu, (const void*)fwd_kernel, NWAVES * 64, LDS_BYTES) != hipSuccess || per_cu < 1) { fprintf(stderr, "kernel_launch: occupancy query says %d blocks per CU\n", per_cu); (void)hipGetLastError(); grid = -1; return; }
        grid = cus;
    }
    if (grid < 0) return;
    (void)hipMemsetAsync((char*)d_ws + WS_CTL, 0, CTL_ZERO_BYTES, stream);
    Args a{};
    for (int i = 0; i < 18; ++i) a.in[i] = (const float*)d_in[i];
    a.out = (float*)d_out; a.ws = (unsigned char*)d_ws;
#if MK_PER_PHASE
    for (int p = 0; p < N_PHASES; ++p) { a.ph_lo = p; a.ph_hi = p + 1; hipLaunchKernelGGL(fwd_kernel, dim3(grid), dim3(NWAVES * 64), LDS_BYTES, stream, a); }
#else
    a.ph_lo = 0; a.ph_hi = N_PHASES;
    void* kargs[] = {&a};
    hipError_t e = hipLaunchCooperativeKernel((const void*)fwd_kernel, dim3(grid), dim3(NWAVES * 64), kargs, LDS_BYTES, stream);
    if (e != hipSuccess) fprintf(stderr, "kernel_launch: cooperative launch failed: %s (grid %d)\n", hipGetErrorString(e), grid);
#endif
}
```
